# Optimizing an MI355X kernel written in HIP

```python
import math
import jax, jax.numpy as jnp
from jax import lax
import numpy as np

D_MODEL = 2048
BATCH = 16
SEQ = 2048
DEPTH = 1

CHUNK = 64
N_META = 16
ATTN_HEADS = 8
ATTN_HEAD_DIM = 64
ATTN_VDIM = 2 * ATTN_HEAD_DIM
ATTN_WIDTH = ATTN_HEADS * 2 * ATTN_HEAD_DIM
Q_BLOCK = 128
SSM_WIDTH = D_MODEL // 4
SSM_GROUP = 16
SSM_GROUPS = SSM_WIDTH // SSM_GROUP
SSM_STATE = 64
DT_MIN = 1e-3
DT_MAX = 1e-1
N_EXPERT_GROUPS = 4
EXPERTS_PER_GROUP = 8
N_EXPERTS = N_EXPERT_GROUPS * EXPERTS_PER_GROUP
TOP_K = 2
D_FF_EXPERT = D_MODEL // 4
ROW_BLOCK = 128
IN_COLS = SSM_WIDTH + 3 * ATTN_WIDTH + 2 * D_MODEL
LN_EPS = 1e-5
DEEPNORM_ALPHA = (2.0 * DEPTH) ** 0.25
DEEPNORM_BETA = (8.0 * DEPTH) ** -0.25

kernel_name = "hybrid_s5_diffattn_hmoe_deepnorm"


def layer_norm(x, g, b):
    xf = x.astype(jnp.float32)
    mu = jnp.mean(xf, axis=-1, keepdims=True)
    var = jnp.mean(jnp.square(xf - mu), axis=-1, keepdims=True)
    return ((xf - mu) * lax.rsqrt(var + LN_EPS) * g + b).astype(x.dtype)


def chunk_index(pos):
    return jnp.where(pos < N_META, 0, 1 + (pos - N_META) // CHUNK)


def _ssm_combine(earlier, later):
    a1r, a1i, b1r, b1i = earlier
    a2r, a2i, b2r, b2i = later
    ar = a2r * a1r - a2i * a1i
    ai = a2r * a1i + a2i * a1r
    br = a2r * b1r - a2i * b1i + b2r
    bi = a2r * b1i + a2i * b1r + b2i
    return ar, ai, br, bi


def s5_branch(u, a_re, a_im, log_dt, b_re, b_im, c_re, c_im, d_skip, w_glu):
    bsz, L, _ = u.shape
    f32 = jnp.float32
    uf = u.astype(f32).reshape(bsz, L, SSM_GROUPS, SSM_GROUP)
    lam_re = jnp.minimum(a_re.astype(f32), -1e-4)
    lam_im = a_im.astype(f32)
    dt = jnp.exp(log_dt.astype(f32))[:, None]
    mag = jnp.exp(lam_re * dt)
    ab_re = mag * jnp.cos(lam_im * dt)
    ab_im = mag * jnp.sin(lam_im * dt)
    den = lam_re * lam_re + lam_im * lam_im
    nr = ab_re - 1.0
    ni = ab_im
    z_re = (nr * lam_re + ni * lam_im) / den
    z_im = (ni * lam_re - nr * lam_im) / den
    br32 = b_re.astype(f32)
    bi32 = b_im.astype(f32)
    bb_re = z_re[..., None] * br32 - z_im[..., None] * bi32
    bb_im = z_re[..., None] * bi32 + z_im[..., None] * br32
    bu_re = jnp.einsum('blgc,gpc->blgp', uf, bb_re)
    bu_im = jnp.einsum('blgc,gpc->blgp', uf, bb_im)
    a_re_t = jnp.broadcast_to(ab_re, (1, L, SSM_GROUPS, SSM_STATE))
    a_im_t = jnp.broadcast_to(ab_im, (1, L, SSM_GROUPS, SSM_STATE))
    _, _, s_re, s_im = lax.associative_scan(_ssm_combine, (a_re_t, a_im_t, bu_re, bu_im), axis=1)
    y = (jnp.einsum('blgp,gcp->blgc', s_re, c_re.astype(f32))
         - jnp.einsum('blgp,gcp->blgc', s_im, c_im.astype(f32)))
    y = y + d_skip.astype(f32) * uf
    y = jax.nn.gelu(y.reshape(bsz, L, SSM_WIDTH))
    y = y * jax.nn.sigmoid(y @ w_glu.astype(f32))
    return y.astype(u.dtype)


def diff_attention(q, k, v, lam, lambda_init, subln_g):
    bsz, L = q.shape[0], q.shape[1]
    nqb = -(-L // Q_BLOCK)
    lq = nqb * Q_BLOCK
    qp = jnp.pad(q, ((0, 0), (0, lq - L), (0, 0), (0, 0), (0, 0)))
    qb = qp.reshape(bsz, nqb, Q_BLOCK, ATTN_HEADS, 2, ATTN_HEAD_DIM).transpose(1, 0, 2, 3, 4, 5)
    qpos = jnp.arange(lq).reshape(nqb, Q_BLOCK)
    kchunk = chunk_index(jnp.arange(L))
    scale = ATTN_HEAD_DIM ** -0.5

    def block(args):
        qblk, pos = args
        s = jnp.einsum('bqhmd,bkhmd->bhmqk', qblk, k).astype(jnp.float32) * scale
        allowed = chunk_index(pos)[:, None] >= kchunk[None, :]
        s = jnp.where(allowed, s, -1e30)
        p = jax.nn.softmax(s, axis=-1)
        a = p[:, :, 0] - lam * p[:, :, 1]
        return jnp.einsum('bhqk,bkhe->bqhe', a.astype(v.dtype), v)

    o = lax.map(block, (qb, qpos))
    o = o.transpose(1, 0, 2, 3, 4).reshape(bsz, lq, ATTN_HEADS, ATTN_VDIM)[:, :L]
    of = o.astype(jnp.float32)
    of = of * lax.rsqrt(jnp.mean(of * of, axis=-1, keepdims=True) + LN_EPS) * subln_g * (1.0 - lambda_init)
    return of.reshape(bsz, L, ATTN_WIDTH).astype(q.dtype)


def hier_moe(h, w_rg, b_rg, w_re, b_re, w_gate, w_up, w_down):
    bsz, L, d = h.shape
    x = h.reshape(-1, d)
    T = bsz * L
    g_prob = jax.nn.softmax((x @ w_rg + b_rg).astype(jnp.float32), axis=-1)
    g_val, g_idx = lax.top_k(g_prob, 1)
    e_logits = (x @ w_re + b_re).astype(jnp.float32).reshape(T, N_EXPERT_GROUPS, EXPERTS_PER_GROUP)
    e_sel = jnp.take_along_axis(e_logits, g_idx[:, :, None], axis=1)[:, 0]
    e_val, e_idx = lax.top_k(jax.nn.softmax(e_sel, axis=-1), TOP_K)
    e_val = e_val / jnp.sum(e_val, axis=-1, keepdims=True)
    weights = g_val * e_val
    expert = g_idx * EXPERTS_PER_GROUP + e_idx

    A = T * TOP_K
    flat_e = expert.reshape(-1).astype(jnp.int32)
    flat_tok = jnp.repeat(jnp.arange(T, dtype=jnp.int32), TOP_K)
    flat_w = weights.reshape(-1)
    order = jnp.argsort(flat_e)
    se = flat_e[order]
    stok = flat_tok[order]
    sw = flat_w[order]
    counts = jnp.bincount(flat_e, length=N_EXPERTS)
    starts = jnp.cumsum(counts) - counts
    padded = (counts + ROW_BLOCK - 1) // ROW_BLOCK * ROW_BLOCK
    pad_ends = jnp.cumsum(padded)
    pad_starts = pad_ends - padded
    dest = pad_starts[se] + (jnp.arange(A) - starts[se])
    n_blocks = -(-(A + N_EXPERTS * (ROW_BLOCK - 1)) // ROW_BLOCK)
    R = n_blocks * ROW_BLOCK
    row_tok = jnp.full((R,), T, jnp.int32).at[dest].set(stok)
    row_w = jnp.zeros((R,), jnp.float32).at[dest].set(sw)
    block_exp = jnp.minimum(jnp.searchsorted(pad_ends, jnp.arange(n_blocks) * ROW_BLOCK, side='right'),
                            N_EXPERTS - 1)
    x_pad = jnp.concatenate([x, jnp.zeros((1, d), x.dtype)], axis=0)

    def run_block(args):
        toks, e = args
        xb = x_pad[toks]
        hb = jax.nn.silu(xb @ w_gate[e]) * (xb @ w_up[e])
        return hb @ w_down[e]

    y_rows = lax.map(run_block, (row_tok.reshape(n_blocks, ROW_BLOCK), block_exp))
    y_rows = y_rows.reshape(R, d) * row_w[:, None].astype(y_rows.dtype)
    y = jax.ops.segment_sum(y_rows, row_tok, num_segments=T + 1)[:T]
    return y.reshape(bsz, L, d)


def setup_inputs(seed: int = 0) -> dict:
    key = jax.random.key(seed)
    ks = iter(jax.random.split(key, 40))
    nrm = lambda shape, std: jax.random.normal(next(ks), shape, jnp.float32) * std
    Dp = DEPTH
    n_idx = jnp.arange(SSM_STATE, dtype=jnp.float32)
    a_im0 = jnp.broadcast_to(math.pi * n_idx, (Dp, SSM_GROUPS, SSM_STATE))
    return {
        "x": nrm((BATCH, SEQ, D_MODEL), 1.0),
        "meta_tokens": nrm((N_META, D_MODEL), 1.0),
        "ln_in_g": 1.0 + nrm((D_MODEL,), 0.02),
        "ln_in_b": nrm((D_MODEL,), 0.02),
        "w_in": nrm((Dp, D_MODEL, IN_COLS), D_MODEL ** -0.5),
        "ssm_a_re": -0.5 + nrm((Dp, SSM_GROUPS, SSM_STATE), 0.01),
        "ssm_a_im": a_im0 + nrm((Dp, SSM_GROUPS, SSM_STATE), 0.01),
        "ssm_log_dt": jax.random.uniform(next(ks), (Dp, SSM_GROUPS), jnp.float32,
                                         math.log(DT_MIN), math.log(DT_MAX)),
        "ssm_b_re": nrm((Dp, SSM_GROUPS, SSM_STATE, SSM_GROUP), SSM_GROUP ** -0.5),
        "ssm_b_im": nrm((Dp, SSM_GROUPS, SSM_STATE, SSM_GROUP), SSM_GROUP ** -0.5),
        "ssm_c_re": nrm((Dp, SSM_GROUPS, SSM_GROUP, SSM_STATE), SSM_STATE ** -0.5),
        "ssm_c_im": nrm((Dp, SSM_GROUPS, SSM_GROUP, SSM_STATE), SSM_STATE ** -0.5),
        "ssm_d": nrm((Dp, SSM_GROUPS, SSM_GROUP), 1.0),
        "ssm_w_glu": nrm((Dp, SSM_WIDTH, SSM_WIDTH), SSM_WIDTH ** -0.5),
        "attn_lambda_q1": nrm((Dp, ATTN_HEAD_DIM), 0.1),
        "attn_lambda_k1": nrm((Dp, ATTN_HEAD_DIM), 0.1),
        "attn_lambda_q2": nrm((Dp, ATTN_HEAD_DIM), 0.1),
        "attn_lambda_k2": nrm((Dp, ATTN_HEAD_DIM), 0.1),
        "attn_subln_g": 1.0 + nrm((Dp, ATTN_VDIM), 0.02),
        "w_br_ssm": nrm((Dp, SSM_WIDTH, D_MODEL), SSM_WIDTH ** -0.5 * DEEPNORM_BETA),
        "w_br_attn": nrm((Dp, ATTN_WIDTH, D_MODEL), ATTN_WIDTH ** -0.5 * DEEPNORM_BETA),
        "w_o": nrm((Dp, D_MODEL, D_MODEL), D_MODEL ** -0.5 * DEEPNORM_BETA),
        "ln1_g": 1.0 + nrm((Dp, D_MODEL), 0.02),
        "ln1_b": nrm((Dp, D_MODEL), 0.02),
        "router_g_w": nrm((Dp, D_MODEL, N_EXPERT_GROUPS), D_MODEL ** -0.5),
        "router_g_b": nrm((Dp, N_EXPERT_GROUPS), 0.01),
        "router_e_w": nrm((Dp, D_MODEL, N_EXPERTS), D_MODEL ** -0.5),
        "router_e_b": nrm((Dp, N_EXPERTS), 0.01),
        "exp_w_gate": nrm((Dp, N_EXPERTS, D_MODEL, D_FF_EXPERT), D_MODEL ** -0.5),
        "exp_w_up": nrm((Dp, N_EXPERTS, D_MODEL, D_FF_EXPERT), D_MODEL ** -0.5),
        "exp_w_down": nrm((Dp, N_EXPERTS, D_FF_EXPERT, D_MODEL), D_FF_EXPERT ** -0.5 * DEEPNORM_BETA),
        "ln2_g": 1.0 + nrm((Dp, D_MODEL), 0.02),
        "ln2_b": nrm((Dp, D_MODEL), 0.02),
    }


def reference(x, meta_tokens, ln_in_g, ln_in_b, w_in, ssm_a_re, ssm_a_im, ssm_log_dt,
              ssm_b_re, ssm_b_im, ssm_c_re, ssm_c_im, ssm_d, ssm_w_glu,
              attn_lambda_q1, attn_lambda_k1, attn_lambda_q2, attn_lambda_k2, attn_subln_g,
              w_br_ssm, w_br_attn, w_o, ln1_g, ln1_b,
              router_g_w, router_g_b, router_e_w, router_e_b,
              exp_w_gate, exp_w_up, exp_w_down, ln2_g, ln2_b):
    bsz = x.shape[0]
    meta = jnp.broadcast_to(meta_tokens[None].astype(x.dtype), (bsz, N_META, D_MODEL))
    h = jnp.concatenate([meta, x], axis=1)
    L = h.shape[1]
    h = layer_norm(h, ln_in_g, ln_in_b)
    splits = np.cumsum([SSM_WIDTH, ATTN_WIDTH, ATTN_WIDTH, ATTN_WIDTH, D_MODEL]).tolist()
    for l in range(DEPTH):
        lambda_init = 0.8 - 0.6 * math.exp(-0.3 * l)
        proj = h @ w_in[l]
        u_ssm, q, k, v, g_ssm, g_attn = jnp.split(proj, splits, axis=-1)
        y_ssm = s5_branch(u_ssm, ssm_a_re[l], ssm_a_im[l], ssm_log_dt[l], ssm_b_re[l], ssm_b_im[l],
                          ssm_c_re[l], ssm_c_im[l], ssm_d[l], ssm_w_glu[l])
        q = q.reshape(bsz, L, ATTN_HEADS, 2, ATTN_HEAD_DIM)
        k = k.reshape(bsz, L, ATTN_HEADS, 2, ATTN_HEAD_DIM)
        v = v.reshape(bsz, L, ATTN_HEADS, ATTN_VDIM)
        lam = (jnp.exp(jnp.sum(attn_lambda_q1[l].astype(jnp.float32) * attn_lambda_k1[l].astype(jnp.float32)))
               - jnp.exp(jnp.sum(attn_lambda_q2[l].astype(jnp.float32) * attn_lambda_k2[l].astype(jnp.float32)))
               + lambda_init)
        y_attn = diff_attention(q, k, v, lam, lambda_init, attn_subln_g[l])
        merged = (jax.nn.sigmoid(g_ssm) * (y_ssm @ w_br_ssm[l])
                  + jax.nn.sigmoid(g_attn) * (y_attn @ w_br_attn[l]))
        mix = merged @ w_o[l]
        h = layer_norm(DEEPNORM_ALPHA * h + mix, ln1_g[l], ln1_b[l])
        ffn = hier_moe(h, router_g_w[l], router_g_b[l], router_e_w[l], router_e_b[l],
                       exp_w_gate[l], exp_w_up[l], exp_w_down[l])
        h = layer_norm(DEEPNORM_ALPHA * h + ffn, ln2_g[l], ln2_b[l])
    return h[:, N_META:]
```

```cpp
#include <hip/hip_runtime.h>
#include <stdint.h>
#include <stdio.h>

#ifndef MK_PER_PHASE
#define MK_PER_PHASE 0
#endif

#define GAS __attribute__((address_space(1)))
#define LAS __attribute__((address_space(3)))
typedef unsigned short bf16_t;
typedef short bf16x8 __attribute__((ext_vector_type(8)));
typedef short s16x4 __attribute__((ext_vector_type(4)));
typedef float f32x2 __attribute__((ext_vector_type(2)));
typedef float f32x4 __attribute__((ext_vector_type(4)));
typedef float f32x16 __attribute__((ext_vector_type(16)));
typedef unsigned u32x2 __attribute__((ext_vector_type(2)));
typedef unsigned u32x4 __attribute__((ext_vector_type(4)));

constexpr int NB_ = 16, SEQ = 2048, DM = 2048, T = NB_ * SEQ, NMETA = 16;
constexpr int SSMW = 512, AW = 1024, INC = 7680, NGRP = 32, NST = 64;
constexpr int NE = 32, DFF = 512, CAP = T;
constexpr float LN_EPS = 1e-5f;
constexpr float ALPHA = 1.189207115002721f;
constexpr float QSCALE = 0.125f * 1.4426950408889634f;

__device__ __forceinline__ unsigned cvt_pk_bf16(float lo, float hi) { unsigned r; asm volatile("v_cvt_pk_bf16_f32 %0, %1, %2" : "=v"(r) : "v"(lo), "v"(hi)); return r; }
__device__ __forceinline__ float bf_lo(unsigned w) { return __uint_as_float(w << 16); }
__device__ __forceinline__ float bf_hi(unsigned w) { return __uint_as_float(w & 0xffff0000u); }
__device__ __forceinline__ float sigmoidf_(float x) { return 1.0f / (1.0f + __expf(-x)); }
__device__ __forceinline__ float wave_sum(float v) {
#pragma unroll
    for (int o = 1; o < 64; o <<= 1) v += __shfl_xor(v, o);
    return v;
}

namespace pg8 {
constexpr int BM = 256, BK = 64, HALF = 128, HTB = HALF * BK * 2, STAGE_BYTES = 8 * HTB, NXCD = 8, WGM = 8;
__host__ __device__ __forceinline__ int lds_byte(int r, int c) { const int st = (r >> 4) * 2 + (c >> 5), rr = r & 15, cc = c & 31, ob = rr * 64 + cc * 2; return st * 1024 + (ob ^ (((ob >> 9) & 1) << 5)); }
__host__ __device__ __forceinline__ void stage_rc(int b, int& R, int& C) { const int st = b / 1024, sb = b % 1024, swz = sb ^ (((sb >> 9) & 1) << 5); R = (st >> 1) * 16 + swz / 64; C = (st & 1) * 32 + (swz % 64) / 2; }
__host__ __device__ __forceinline__ int perm32(int rho) { const int n = rho >> 4, i = rho & 15; return 8 * (i >> 2) + 4 * n + (i & 3); }

struct Unit { int pm, pn, e, s0, cnt; };
struct Gemm { const bf16_t* A; const bf16_t* Bt; int M, N, K; };

struct StaticOrder {
    int nM, nN, nwg, G, c;
    __device__ void init(int M, int N, int G_, int c_) { nM = M / BM; nN = N / BM; nwg = nM * nN; G = G_; c = c_; }
    __device__ bool next(int i, Unit& u) const {
        const long L = (long)i * G + c; if (L >= nwg) return false;
        int wgid = (int)L; { const int q = nwg / NXCD, r = nwg % NXCD, xcd = wgid % NXCD, off = wgid / NXCD; wgid = (xcd < r ? xcd * (q + 1) : r * (q + 1) + (xcd - r) * q) + off; }
        const int nig = WGM * nN, gid = wgid / nig, fm = gid * WGM, gsz = (nM - fm) < WGM ? (nM - fm) : WGM;
        u.pm = fm + ((wgid % nig) % gsz); u.pn = (wgid % nig) / gsz; u.e = 0; u.s0 = 0; u.cnt = 0; return true;
    }
    __device__ __forceinline__ int arow(const Unit&, int) const { return 0; }
};

template <class Epi, class Sched, bool ALIGN_EPI, bool SP2, bool GATHER>
__device__ __forceinline__ void gemm_phase(LAS unsigned char* lds, const Gemm g, const Sched& S, const Epi& E) {
    const int tid = threadIdx.x, wid = __builtin_amdgcn_readfirstlane(tid >> 6), lane = tid & 63, wr = wid >> 2, wc = wid & 3, fr = lane & 15, fq = lane >> 4;
    const int K = g.K, nt = K / BK;
    unsigned voffA[2], voffB[2]; int stR[2], stC[2];
#pragma unroll
    for (int i = 0; i < 2; ++i) { int R, C; stage_rc(tid * 16 + i * 8192, R, C); const int Rb = Epi::PERM ? ((R & ~31) + perm32(R & 31)) : R;
        stR[i] = R; stC[i] = C; voffA[i] = (unsigned)(R * K + C) * 2u; voffB[i] = (unsigned)(Rb * K + C) * 2u; }
    const size_t kstep = (size_t)(BK * 2);
    const size_t hstep = (size_t)HALF * K * 2;
    const size_t tstep = 2 * hstep;
    const unsigned ldsw = (unsigned)wid * 1024u;
    const int aoff = lds_byte(wr * 64 + fr, fq * 8), boff = lds_byte(wc * 32 + fr, fq * 8);
#define PG8_SA(b, h) (((b) * 2 + (h)) * HTB)
#define PG8_SB(b, h) ((4 + (b) * 2 + (h)) * HTB)
#define PG8_STAGE(bufoff, gbase, voff) do { _Pragma("unroll") for (int _i = 0; _i < 2; ++_i) \
        __builtin_amdgcn_global_load_lds((const unsigned*)((const char*)(gbase) + (voff)[_i]), (LAS unsigned*)(lds + (bufoff) + ldsw + _i * 8192), 16, 0, 0); } while (0)
#define PG8_STAGE_A(bufoff, kbase, h, VO) do { if constexpr (GATHER) { PG8_STAGE(bufoff, kbase, VO[h]); } else { PG8_STAGE(bufoff, (kbase) + (h) * hstep, voffA); } } while (0)
#define PG8_LDA(dst, b, h) do { _Pragma("unroll") for (int m = 0; m < 4; ++m) _Pragma("unroll") for (int k = 0; k < 2; ++k) dst[m][k] = *(const LAS bf16x8*)(lds + PG8_SA(b, h) + aoff + m * 2048 + k * 1024); } while (0)
#define PG8_LDB(dst, b, h) do { _Pragma("unroll") for (int n = 0; n < 2; ++n) _Pragma("unroll") for (int k = 0; k < 2; ++k) dst[n][k] = *(const LAS bf16x8*)(lds + PG8_SB(b, h) + boff + n * 2048 + k * 1024); } while (0)
#define PG8_MMA(ai, bj, At, Bt) do { __builtin_amdgcn_s_setprio(1); _Pragma("unroll") for (int m = 0; m < 4; ++m) _Pragma("unroll") for (int n = 0; n < 2; ++n) _Pragma("unroll") for (int k = 0; k < 2; ++k) \
        acc[ai][bj][m][n] = __builtin_amdgcn_mfma_f32_16x16x32_bf16(Bt[n][k], At[m][k], acc[ai][bj][m][n], 0, 0, 0); __builtin_amdgcn_s_setprio(0); } while (0)
#define PG8_WAIT_V(n) asm volatile("s_waitcnt vmcnt(" #n ")" ::: "memory")
#define PG8_WAIT_L(n) asm volatile("s_waitcnt lgkmcnt(" #n ")" ::: "memory")
#define PG8_BAR __builtin_amdgcn_s_barrier()
#define PG8_SCHED __builtin_amdgcn_sched_barrier(0)
#define PG8_GOFF(VO, U) do { _Pragma("unroll") for (int _h = 0; _h < 2; ++_h) _Pragma("unroll") for (int _i = 0; _i < 2; ++_i) \
        VO[_h][_i] = (unsigned)S.arow(U, _h * HALF + stR[_i]) * (unsigned)(K * 2) + (unsigned)(stC[_i] * 2); } while (0)
    Unit cur, nxt; int ui = 0;
    if (!S.next(0, cur)) return;
    f32x4 acc[2][2][4][2];
#pragma unroll
    for (int a = 0; a < 2; ++a)
#pragma unroll
        for (int b = 0; b < 2; ++b)
#pragma unroll
            for (int m = 0; m < 4; ++m)
#pragma unroll
                for (int n = 0; n < 2; ++n) acc[a][b][m][n] = (f32x4){0.f, 0.f, 0.f, 0.f};
    bf16x8 At[4][2], B0[2][2], B1[2][2];
    unsigned cvo[2][2] = {{0u, 0u}, {0u, 0u}}, nvo[2][2] = {{0u, 0u}, {0u, 0u}};
    const char* cA = GATHER ? (const char*)g.A : (const char*)g.A + (size_t)cur.pm * tstep; const char* cB = (const char*)g.Bt + (size_t)cur.pn * tstep;
    if constexpr (GATHER) { PG8_GOFF(cvo, cur); }
    if constexpr (SP2) {
        PG8_STAGE(PG8_SB(0, 0), cB, voffB); PG8_STAGE(PG8_SB(0, 1), cB + hstep, voffB); PG8_STAGE_A(PG8_SA(0, 0), cA, 0, cvo); PG8_STAGE_A(PG8_SA(0, 1), cA, 1, cvo);
        if (wr == 1) PG8_BAR;
        PG8_WAIT_V(2); PG8_BAR;
        PG8_STAGE(PG8_SB(1, 0), cB + kstep, voffB); PG8_STAGE_A(PG8_SA(1, 0), cA + kstep, 0, cvo); PG8_STAGE(PG8_SB(1, 1), cB + hstep + kstep, voffB);
        PG8_WAIT_V(6); PG8_BAR;
    } else {
        PG8_STAGE(PG8_SB(0, 0), cB, voffB); PG8_STAGE_A(PG8_SA(0, 0), cA, 0, cvo); PG8_STAGE(PG8_SB(0, 1), cB + hstep, voffB); PG8_STAGE_A(PG8_SA(0, 1), cA, 1, cvo);
        if (wr == 1) PG8_BAR;
        PG8_WAIT_V(4); PG8_BAR;
        PG8_STAGE(PG8_SB(1, 0), cB + kstep, voffB); PG8_STAGE_A(PG8_SA(1, 0), cA + kstep, 0, cvo); PG8_STAGE(PG8_SB(1, 1), cB + hstep + kstep, voffB);
        PG8_WAIT_V(6); PG8_BAR;
    }
    for (;;) {
        const bool has_next = S.next(ui + 1, nxt);
        const char* nA = GATHER ? cA : (has_next ? (const char*)g.A + (size_t)nxt.pm * tstep : cA); const char* nB = has_next ? (const char*)g.Bt + (size_t)nxt.pn * tstep : cB;
        if constexpr (GATHER) { if (has_next) { PG8_GOFF(nvo, nxt); } else {
#pragma unroll
            for (int h = 0; h < 2; ++h)
#pragma unroll
                for (int i = 0; i < 2; ++i) nvo[h][i] = cvo[h][i]; } }
        for (int t = 0; t < nt; t += 2) {
            const bool last = (t == nt - 2);
            const char* a1 = cA + (size_t)(t + 1) * kstep;
            const char* a2 = last ? nA : cA + (size_t)(t + 2) * kstep; const char* b2 = last ? nB : cB + (size_t)(t + 2) * kstep;
            const char* a3 = a2 + kstep; const char* b3 = b2 + kstep;
            unsigned svo[2][2];
#pragma unroll
            for (int h = 0; h < 2; ++h)
#pragma unroll
                for (int i = 0; i < 2; ++i) svo[h][i] = last ? nvo[h][i] : cvo[h][i];
            if constexpr (SP2) {
            PG8_LDB(B0, 0, 0); PG8_LDB(B1, 0, 1); PG8_SCHED; PG8_LDA(At, 0, 0); PG8_STAGE_A(PG8_SA(1, 1), a1, 1, cvo);
            PG8_WAIT_V(8); PG8_WAIT_L(0); PG8_BAR; PG8_MMA(0, 0, At, B0); PG8_MMA(0, 1, At, B1); PG8_BAR; PG8_SCHED;
            PG8_LDA(At, 0, 1); PG8_STAGE(PG8_SB(0, 0), b2, voffB); PG8_STAGE(PG8_SB(0, 1), b2 + hstep, voffB); PG8_STAGE_A(PG8_SA(0, 0), a2, 0, svo);
            PG8_WAIT_V(8); PG8_WAIT_L(0); PG8_BAR; PG8_MMA(1, 0, At, B0); PG8_MMA(1, 1, At, B1); PG8_BAR; PG8_SCHED;
            PG8_LDB(B0, 1, 0); PG8_LDB(B1, 1, 1); PG8_SCHED; PG8_LDA(At, 1, 0); PG8_STAGE_A(PG8_SA(0, 1), a2, 1, svo);
            PG8_WAIT_V(8); PG8_WAIT_L(0); PG8_BAR; PG8_MMA(0, 0, At, B0); PG8_MMA(0, 1, At, B1); PG8_BAR; PG8_SCHED;
            PG8_LDA(At, 1, 1); PG8_STAGE(PG8_SB(1, 0), b3, voffB); PG8_STAGE(PG8_SB(1, 1), b3 + hstep, voffB); PG8_STAGE_A(PG8_SA(1, 0), a3, 0, svo);
            PG8_WAIT_V(8); PG8_WAIT_L(0); PG8_BAR; PG8_MMA(1, 0, At, B0); PG8_MMA(1, 1, At, B1); PG8_BAR; PG8_SCHED;
            } else {
            PG8_LDB(B0, 0, 0); PG8_SCHED; PG8_LDA(At, 0, 0); PG8_STAGE_A(PG8_SA(1, 1), a1, 1, cvo);
            PG8_WAIT_L(8); PG8_BAR; PG8_WAIT_L(0); PG8_MMA(0, 0, At, B0); PG8_BAR; PG8_SCHED;
            PG8_LDB(B1, 0, 1); PG8_STAGE(PG8_SB(0, 0), b2, voffB);
            PG8_BAR; PG8_WAIT_L(0); PG8_MMA(0, 1, At, B1); PG8_BAR;
            PG8_LDA(At, 0, 1); PG8_STAGE_A(PG8_SA(0, 0), a2, 0, svo);
            PG8_BAR; PG8_WAIT_L(0); PG8_MMA(1, 0, At, B0); PG8_BAR; PG8_SCHED;
            PG8_STAGE(PG8_SB(0, 1), b2 + hstep, voffB);
            PG8_WAIT_V(6); PG8_BAR; PG8_MMA(1, 1, At, B1); PG8_BAR;
            PG8_LDB(B0, 1, 0); PG8_SCHED; PG8_LDA(At, 1, 0); PG8_STAGE_A(PG8_SA(0, 1), a2, 1, svo);
            PG8_WAIT_L(8); PG8_BAR; PG8_WAIT_L(0); PG8_MMA(0, 0, At, B0); PG8_BAR; PG8_SCHED;
            PG8_LDB(B1, 1, 1); PG8_STAGE(PG8_SB(1, 0), b3, voffB);
            PG8_BAR; PG8_WAIT_L(0); PG8_MMA(0, 1, At, B1); PG8_BAR;
            PG8_LDA(At, 1, 1); PG8_STAGE_A(PG8_SA(1, 0), a3, 0, svo);
            PG8_BAR; PG8_WAIT_L(0); PG8_MMA(1, 0, At, B0); PG8_BAR; PG8_SCHED;
            PG8_STAGE(PG8_SB(1, 1), b3 + hstep, voffB);
            PG8_WAIT_V(6); PG8_BAR; PG8_MMA(1, 1, At, B1); PG8_BAR;
            }
        }
        if constexpr (ALIGN_EPI) { if (wr == 0) PG8_BAR; }
        E(acc, cur, wr, wc, fr, fq);
        if (!has_next) break;
#pragma unroll
        for (int a = 0; a < 2; ++a)
#pragma unroll
            for (int b = 0; b < 2; ++b)
#pragma unroll
                for (int m = 0; m < 4; ++m)
#pragma unroll
                    for (int n = 0; n < 2; ++n) acc[a][b][m][n] = (f32x4){0.f, 0.f, 0.f, 0.f};
        cur = nxt; cA = nA; cB = nB; ++ui;
#pragma unroll
        for (int h = 0; h < 2; ++h)
#pragma unroll
            for (int i = 0; i < 2; ++i) cvo[h][i] = nvo[h][i];
        if constexpr (ALIGN_EPI) { if (wr == 1) PG8_BAR; }
    }
    PG8_WAIT_V(0);
    if constexpr (!ALIGN_EPI) { if (wr == 0) PG8_BAR; }
    PG8_BAR;
#undef PG8_SA
#undef PG8_SB
#undef PG8_STAGE
#undef PG8_STAGE_A
#undef PG8_LDA
#undef PG8_LDB
#undef PG8_MMA
#undef PG8_WAIT_V
#undef PG8_WAIT_L
#undef PG8_BAR
#undef PG8_SCHED
#undef PG8_GOFF
}
}

constexpr size_t MiB = 1u << 20;
constexpr size_t WS_CTL = 0, CTL_ZERO_BYTES = 1 * MiB;
constexpr size_t WS_HMETA = 1 * MiB;
constexpr size_t WS_UMETA = WS_HMETA + 128 * 1024;
constexpr size_t WS_KMETA = WS_HMETA + 256 * 1024;
constexpr size_t WS_VMETA = WS_HMETA + 384 * 1024;
constexpr size_t WS_SSMAB = WS_HMETA + 512 * 1024;
constexpr size_t WS_SSMBB = WS_HMETA + 576 * 1024;
constexpr size_t WS_WRT = 2 * MiB;
constexpr size_t WS_WIN = 3 * MiB;
constexpr size_t WS_WGLU = 33 * MiB;
constexpr size_t WS_WBS = 34 * MiB;
constexpr size_t WS_WBA = 36 * MiB;
constexpr size_t WS_WO = 40 * MiB;
constexpr size_t WS_WUP = 48 * MiB;
constexpr size_t WS_WDN = 176 * MiB;
constexpr size_t WS_HBF = 240 * MiB;
constexpr size_t WS_U = 368 * MiB;
constexpr size_t WS_Q = 400 * MiB;
constexpr size_t WS_K = 464 * MiB;
constexpr size_t WS_V = 528 * MiB;
constexpr size_t WS_SGS = 592 * MiB;
constexpr size_t WS_SGA = 720 * MiB;
constexpr size_t WS_YPRE = 848 * MiB;
constexpr size_t WS_YSSM = 880 * MiB;
constexpr size_t WS_YATT = 912 * MiB;
constexpr size_t WS_END = 976 * MiB;
constexpr size_t WS_Z = 368 * MiB;
constexpr size_t WS_H1 = 624 * MiB;
constexpr size_t WS_HB = 752 * MiB;
constexpr size_t WS_YK = 368 * MiB;
constexpr size_t WS_LIST = 848 * MiB;
constexpr size_t WS_WGT = 852 * MiB;
constexpr int CW_ECNT = 64;
constexpr int CW_BAR = 4096;

constexpr int RING_BYTES = 131072;
constexpr int MISC_OFF = RING_BYTES;
constexpr int LDS_BYTES = 139264;

#define XB_TMO      128
#define XB_XCNT(j)  (256  + 64 * (j))
#define XB_XSUB(j)  (1280 + 64 * (j))
#define XB_XGEN(j)  (2304 + 64 * (j))
#define XB_TOP      3328
#define XB_TOPGEN   3392
#define XCD_BAR_WORDS 3456
#define XB_SPIN_CAP (1u << 18)
__device__ __forceinline__ unsigned xb_ld(unsigned* p)              { return __hip_atomic_load(p, __ATOMIC_RELAXED, __HIP_MEMORY_SCOPE_AGENT); }
__device__ __forceinline__ unsigned xb_add(unsigned* p, unsigned v) { return __hip_atomic_fetch_add(p, v, __ATOMIC_RELAXED, __HIP_MEMORY_SCOPE_AGENT); }
__device__ __forceinline__ unsigned xb_xcc_id() { return (unsigned)__builtin_amdgcn_s_getreg((3 << 11) | 20) & 0xFu; }
#define XB_SPIN(cond, bar) do { unsigned _sp = 0; while (cond) { __builtin_amdgcn_s_sleep(1); \
    if ((++_sp & 255u) == 0u) { if (xb_ld(&(bar)[XB_TMO])) break; if (_sp > XB_SPIN_CAP) { atomicAdd(&(bar)[XB_TMO], 1u); break; } } } } while (0)
struct XcdBarrier { unsigned* bar; unsigned x; volatile LAS unsigned* st; };
__device__ __forceinline__ XcdBarrier xcd_barrier_post(unsigned* bar, volatile LAS unsigned* st) {
    XcdBarrier b; b.bar = bar; b.x = xb_xcc_id(); b.st = st;
    if (threadIdx.x == 0) (void)xb_add(&bar[XB_XCNT(b.x)], 1u);
    return b;
}
__device__ __forceinline__ void xcd_barrier_complete(unsigned* bar, unsigned x, unsigned& nloc, unsigned& nx) {
    const unsigned G = gridDim.x * gridDim.y * gridDim.z;
    unsigned sum, cnt, mine, sp = 0u;
    for (;;) {
        sum = 0u; cnt = 0u; mine = 0u;
#pragma unroll
        for (unsigned j = 0; j < 16; ++j) { const unsigned c = xb_ld(&bar[XB_XCNT(j)]); sum += c; cnt += (c > 0u) ? 1u : 0u; mine = (j == x) ? c : mine; }
        if (sum == G) break;
        __builtin_amdgcn_s_sleep(1);
        if ((++sp & 255u) == 0u) { if (xb_ld(&bar[XB_TMO])) break; if (sp > XB_SPIN_CAP) { atomicAdd(&bar[XB_TMO], 1u); break; } }
    }
    nloc = mine > 0u ? mine : 1u; nx = cnt > 0u ? cnt : 1u;
}
__device__ __forceinline__ void xcd_barrier(const XcdBarrier& b) {
    asm volatile("s_waitcnt vmcnt(0)" ::: "memory");
    __syncthreads();
    if (threadIdx.x == 0) {
        unsigned* bar = b.bar;
        __builtin_amdgcn_s_waitcnt(0);
        unsigned nloc = b.st[0], nx = b.st[1];
        if (nloc == 0u) { xcd_barrier_complete(bar, b.x, nloc, nx); b.st[0] = nloc; b.st[1] = nx; }
        const unsigned old = xb_add(&bar[XB_XSUB(b.x)], 1u);
        const unsigned gen = old / nloc;
        if (old + 1u == (gen + 1u) * nloc) {
            __builtin_amdgcn_fence(__ATOMIC_RELEASE, "agent");
            asm volatile("s_waitcnt vmcnt(0)" ::: "memory");
            const unsigned og = xb_add(&bar[XB_TOP], 1u);
            const unsigned tg = og / nx;
            if (og + 1u == (tg + 1u) * nx) xb_add(&bar[XB_TOPGEN], 1u);
            else XB_SPIN(xb_ld(&bar[XB_TOPGEN]) == tg, bar);
            __builtin_amdgcn_fence(__ATOMIC_ACQUIRE, "agent");
            xb_add(&bar[XB_XGEN(b.x)], 1u);
            asm volatile("s_waitcnt vmcnt(0)" ::: "memory");
        } else {
            XB_SPIN(xb_ld(&bar[XB_XGEN(b.x)]) == gen, bar);
            __builtin_amdgcn_fence(__ATOMIC_ACQUIRE, "agent");
            asm volatile("s_waitcnt vmcnt(0)" ::: "memory");
        }
    }
    __syncthreads();
}

using pg8::Unit;
__device__ __forceinline__ u32x4 pack8(const f32x4 v0, const f32x4 v1) { u32x4 w; w.x = cvt_pk_bf16(v0[0], v0[1]); w.y = cvt_pk_bf16(v0[2], v0[3]); w.z = cvt_pk_bf16(v1[0], v1[1]); w.w = cvt_pk_bf16(v1[2], v1[3]); return w; }
__device__ __forceinline__ void unpack8(const u32x4 w, f32x4& v0, f32x4& v1) { v0 = (f32x4){bf_lo(w.x), bf_hi(w.x), bf_lo(w.y), bf_hi(w.y)}; v1 = (f32x4){bf_lo(w.z), bf_hi(w.z), bf_lo(w.w), bf_hi(w.w)}; }

struct EpiProj {
    static constexpr bool PERM = true;
    bf16_t *U, *Q, *K, *V, *SGS, *SGA;
    __device__ __forceinline__ void operator()(const f32x4 (&acc)[2][2][4][2], const Unit& u, int wr, int wc, int fr, int fq) const {
        const int pn = u.pn; bf16_t* base; int ldc, ct, mode;
        if (pn < 2) { base = U; ldc = 512; ct = pn; mode = 0; }
        else if (pn < 6) { base = Q; ldc = 1024; ct = pn - 2; mode = 1; }
        else if (pn < 10) { base = K; ldc = 1024; ct = pn - 6; mode = 0; }
        else if (pn < 14) { base = V; ldc = 1024; ct = pn - 10; mode = 0; }
        else if (pn < 22) { base = SGS; ldc = 2048; ct = pn - 14; mode = 2; }
        else { base = SGA; ldc = 2048; ct = pn - 22; mode = 2; }
        const int row0 = u.pm * 256 + wr * 64 + fr, col0 = ct * 256 + wc * 32 + 8 * fq;
#pragma unroll
        for (int ai = 0; ai < 2; ++ai)
#pragma unroll
            for (int m = 0; m < 4; ++m) { bf16_t* rowp = base + (size_t)(row0 + ai * 128 + m * 16) * ldc + col0;
#pragma unroll
                for (int bj = 0; bj < 2; ++bj) { f32x4 v0 = acc[ai][bj][m][0], v1 = acc[ai][bj][m][1];
                    if (mode == 1) { v0 = v0 * QSCALE; v1 = v1 * QSCALE; }
                    if (mode == 2) {
#pragma unroll
                        for (int j = 0; j < 4; ++j) { v0[j] = sigmoidf_(v0[j]); v1[j] = sigmoidf_(v1[j]); } }
                    *(u32x4*)(rowp + bj * 128) = pack8(v0, v1); } }
    }
};
struct EpiGlu {
    static constexpr bool PERM = true;
    const bf16_t* YPRE; bf16_t* YSSM;
    __device__ __forceinline__ void operator()(const f32x4 (&acc)[2][2][4][2], const Unit& u, int wr, int wc, int fr, int fq) const {
        const int row0 = u.pm * 256 + wr * 64 + fr, col0 = u.pn * 256 + wc * 32 + 8 * fq;
#pragma unroll
        for (int ai = 0; ai < 2; ++ai)
#pragma unroll
            for (int m = 0; m < 4; ++m) { const size_t off = (size_t)(row0 + ai * 128 + m * 16) * SSMW + col0;
#pragma unroll
                for (int bj = 0; bj < 2; ++bj) { const u32x4 yw = *(const u32x4*)(YPRE + off + bj * 128); f32x4 y0, y1; unpack8(yw, y0, y1);
                    f32x4 v0 = acc[ai][bj][m][0], v1 = acc[ai][bj][m][1];
#pragma unroll
                    for (int j = 0; j < 4; ++j) { v0[j] = y0[j] * sigmoidf_(v0[j]); v1[j] = y1[j] * sigmoidf_(v1[j]); }
                    *(u32x4*)(YSSM + off + bj * 128) = pack8(v0, v1); } }
    }
};
template <int SECOND> struct EpiMerge {
    static constexpr bool PERM = true;
    const bf16_t* SG; bf16_t* MG;
    __device__ __forceinline__ void operator()(const f32x4 (&acc)[2][2][4][2], const Unit& u, int wr, int wc, int fr, int fq) const {
        const int row0 = u.pm * 256 + wr * 64 + fr, col0 = u.pn * 256 + wc * 32 + 8 * fq;
#pragma unroll
        for (int ai = 0; ai < 2; ++ai)
#pragma unroll
            for (int m = 0; m < 4; ++m) { const size_t off = (size_t)(row0 + ai * 128 + m * 16) * DM + col0;
#pragma unroll
                for (int bj = 0; bj < 2; ++bj) { const u32x4 gw = *(const u32x4*)(SG + off + bj * 128); f32x4 g0, g1; unpack8(gw, g0, g1);
                    f32x4 v0 = acc[ai][bj][m][0] * g0, v1 = acc[ai][bj][m][1] * g1;
                    if (SECOND) { const u32x4 pw = *(const u32x4*)(MG + off + bj * 128); f32x4 p0, p1; unpack8(pw, p0, p1); v0 = v0 + p0; v1 = v1 + p1; }
                    *(u32x4*)(MG + off + bj * 128) = pack8(v0, v1); } }
    }
};
struct EpiZ {
    static constexpr bool PERM = false;
    const bf16_t* HBF; float* Z;
    __device__ __forceinline__ void operator()(const f32x4 (&acc)[2][2][4][2], const Unit& u, int wr, int wc, int fr, int fq) const {
        const int row0 = u.pm * 256 + wr * 64 + fr, col0 = u.pn * 256 + wc * 32 + 4 * fq;
#pragma unroll
        for (int ai = 0; ai < 2; ++ai)
#pragma unroll
            for (int m = 0; m < 4; ++m) { const size_t off = (size_t)(row0 + ai * 128 + m * 16) * DM + col0;
#pragma unroll
                for (int bj = 0; bj < 2; ++bj)
#pragma unroll
                    for (int n = 0; n < 2; ++n) { const u32x2 hw = *(const u32x2*)(HBF + off + bj * 128 + n * 16);
                        const f32x4 h = (f32x4){bf_lo(hw.x), bf_hi(hw.x), bf_lo(hw.y), bf_hi(hw.y)};
                        *(f32x4*)(Z + off + bj * 128 + n * 16) = acc[ai][bj][m][n] + h * ALPHA; } }
    }
};
struct EpiSwiglu {
    static constexpr bool PERM = true;
    bf16_t* HB;
    __device__ __forceinline__ void operator()(const f32x4 (&acc)[2][2][4][2], const Unit& u, int wr, int wc, int fr, int fq) const {
        const int row0 = u.pm * 256 + wr * 64 + fr, col0 = (u.pn & 3) * 128 + wc * 32 + 8 * fq;
#pragma unroll
        for (int ai = 0; ai < 2; ++ai)
#pragma unroll
            for (int m = 0; m < 4; ++m) { f32x4 v0, v1;
#pragma unroll
                for (int j = 0; j < 4; ++j) { const float g0 = acc[ai][0][m][0][j], g1 = acc[ai][0][m][1][j];
                    v0[j] = g0 * sigmoidf_(g0) * acc[ai][1][m][0][j]; v1[j] = g1 * sigmoidf_(g1) * acc[ai][1][m][1][j]; }
                *(u32x4*)(HB + (size_t)(row0 + ai * 128 + m * 16) * DFF + col0) = pack8(v0, v1); }
    }
};
struct EpiDown {
    static constexpr bool PERM = true;
    const int* LIST; const float* WGT; bf16_t* YK;
    __device__ __forceinline__ void operator()(const f32x4 (&acc)[2][2][4][2], const Unit& u, int wr, int wc, int fr, int fq) const {
        const int r0 = wr * 64 + fr, col0 = (u.pn & 7) * 256 + wc * 32 + 8 * fq;
#pragma unroll
        for (int ai = 0; ai < 2; ++ai)
#pragma unroll
            for (int m = 0; m < 4; ++m) { const int slot = u.s0 + r0 + ai * 128 + m * 16;
                if (slot < u.cnt) { const int entry = LIST[(size_t)u.e * CAP + slot]; const float w = WGT[entry];
                    bf16_t* rowp = YK + (size_t)entry * DM + col0;
#pragma unroll
                    for (int bj = 0; bj < 2; ++bj) *(u32x4*)(rowp + bj * 128) = pack8(acc[ai][bj][m][0] * w, acc[ai][bj][m][1] * w); } }
    }
};
struct MoeOrder {
    int G, c, shift, NB; const LAS int* blkexp; const LAS int* blkstart; const LAS int* cntE; const int* LIST;
    __device__ __forceinline__ bool next(int i, Unit& u) const {
        const long L = (long)i * G + c; if (L >= ((long)NB << shift)) return false;
        const int blk = (int)(L >> shift), tile = (int)(L & ((1 << shift) - 1)), e = blkexp[blk];
        u.pm = blk; u.pn = (e << shift) + tile; u.e = e; u.s0 = (blk - blkstart[e]) * 256; u.cnt = cntE[e]; return true;
    }
    __device__ __forceinline__ int arow(const Unit& u, int r) const { const int slot = u.s0 + r; const int entry = slot < u.cnt ? LIST[(size_t)u.e * CAP + slot] : 0; return entry >> 1; }
};

struct Ctx { LAS unsigned char* lds; int tid, lane, wave, vcu, G; };

__device__ __forceinline__ void transpose_item(const float* W, int K, int N, bf16_t* WT, int kb, int nb, int dst_row0, LAS float* scr, int lane) {
    const int k0 = 64 * kb, n0 = 32 * nb;
#pragma unroll 8
    for (int i = 0; i < 32; ++i) { const int kk = 2 * i + (lane >> 5); scr[kk * 33 + (lane & 31)] = W[(size_t)(k0 + kk) * N + n0 + (lane & 31)]; }
    asm volatile("s_waitcnt lgkmcnt(0)" ::: "memory");
    const int c = lane & 7;
#pragma unroll
    for (int j = 0; j < 4; ++j) { const int n = (lane >> 3) + 8 * j; const LAS float* s = scr + (8 * c) * 33 + n;
        u32x4 o; o.x = cvt_pk_bf16(s[0 * 33], s[1 * 33]); o.y = cvt_pk_bf16(s[2 * 33], s[3 * 33]); o.z = cvt_pk_bf16(s[4 * 33], s[5 * 33]); o.w = cvt_pk_bf16(s[6 * 33], s[7 * 33]);
        *(u32x4*)(WT + (size_t)(dst_row0 + n) * K + k0 + 8 * c) = o; }
    asm volatile("s_waitcnt lgkmcnt(0)" ::: "memory");
}
__device__ __forceinline__ void ln_stats(f32x4 (&v)[8], float& mean, float& rstd) {
    float s = 0.f;
#pragma unroll
    for (int j = 0; j < 8; ++j) s += (v[j].x + v[j].y) + (v[j].z + v[j].w);
    mean = wave_sum(s) * (1.f / DM); float s2 = 0.f;
#pragma unroll
    for (int j = 0; j < 8; ++j) { const f32x4 d = v[j] - mean; s2 += (d.x * d.x + d.y * d.y) + (d.z * d.z + d.w * d.w); }
    rstd = 1.f / sqrtf(wave_sum(s2) * (1.f / DM) + LN_EPS);
}

__device__ __forceinline__ void p0_prologue(const Ctx& C, const float* const* in, unsigned char* ws) {
    LAS float* scr = (LAS float*)(C.lds + C.wave * 16384);
    const int gw = C.vcu * 8 + C.wave, NGW = C.G * 8;
    bf16_t* WinT = (bf16_t*)(ws + WS_WIN); bf16_t* WgluT = (bf16_t*)(ws + WS_WGLU); bf16_t* WbsT = (bf16_t*)(ws + WS_WBS); bf16_t* WbaT = (bf16_t*)(ws + WS_WBA);
    bf16_t* WoT = (bf16_t*)(ws + WS_WO); bf16_t* WupT = (bf16_t*)(ws + WS_WUP); bf16_t* WdnT = (bf16_t*)(ws + WS_WDN);
    constexpr int I_WIN = (DM / 64) * (INC / 32), I_GLU = (SSMW / 64) * (SSMW / 32), I_BS = (SSMW / 64) * (DM / 32), I_BA = (AW / 64) * (DM / 32), I_WO = (DM / 64) * (DM / 32);
    constexpr int I_EXP = NE * 512;
    constexpr int NITEMS = I_WIN + I_GLU + I_BS + I_BA + I_WO + 3 * I_EXP;
    for (int it = gw; it < NITEMS; it += NGW) {
        int r = it;
        if (r < I_WIN) { const int nblk = INC / 32; transpose_item(in[4], DM, INC, WinT, r / nblk, r % nblk, 32 * (r % nblk), scr, C.lane); continue; } r -= I_WIN;
        if (r < I_GLU) { const int nblk = SSMW / 32; transpose_item(in[13], SSMW, SSMW, WgluT, r / nblk, r % nblk, 32 * (r % nblk), scr, C.lane); continue; } r -= I_GLU;
        if (r < I_BS) { const int nblk = DM / 32; transpose_item(in[19], SSMW, DM, WbsT, r / nblk, r % nblk, 32 * (r % nblk), scr, C.lane); continue; } r -= I_BS;
        if (r < I_BA) { const int nblk = DM / 32; transpose_item(in[20], AW, DM, WbaT, r / nblk, r % nblk, 32 * (r % nblk), scr, C.lane); continue; } r -= I_BA;
        if (r < I_WO) { const int nblk = DM / 32; transpose_item(in[21], DM, DM, WoT, r / nblk, r % nblk, 32 * (r % nblk), scr, C.lane); continue; } r -= I_WO;
        if (r < 2 * I_EXP) { const int up = r >= I_EXP ? 1 : 0; r -= up * I_EXP; const int e = r >> 9, rr = r & 511, kb = rr >> 4, nb = rr & 15, n0 = 32 * nb;
            transpose_item(in[28 + up] + (size_t)e * DM * DFF, DM, DFF, WupT, kb, nb, e * 1024 + (n0 >> 7) * 256 + up * 128 + (n0 & 127), scr, C.lane); continue; }
        r -= 2 * I_EXP;
        { const int e = r >> 9, rr = r & 511, kb = rr >> 6, nb = rr & 63; transpose_item(in[30] + (size_t)e * DFF * DM, DFF, DM, WdnT, kb, nb, e * 2048 + 32 * nb, scr, C.lane); }
    }
    const int gt = C.vcu * 512 + C.tid, NGT = C.G * 512;
    { float* WrT = (float*)(ws + WS_WRT);
      for (int i = gt; i < 36 * DM; i += NGT) { const int n = i / DM, k = i % DM; WrT[i] = n < 4 ? in[24][k * 4 + n] : in[26][k * 32 + (n - 4)]; } }
    { u32x4* kz = (u32x4*)(ws + WS_KMETA + 16 * 1024 * 2); u32x4* vz = (u32x4*)(ws + WS_VMETA + 16 * 1024 * 2);
      for (int i = gt; i < 48 * 1024 * 2 / 16; i += NGT) { kz[i] = (u32x4){0u, 0u, 0u, 0u}; vz[i] = (u32x4){0u, 0u, 0u, 0u}; } }
    { float* AB = (float*)(ws + WS_SSMAB); float* BB = (float*)(ws + WS_SSMBB);
      for (int i = gt; i < NGRP * NST; i += NGT) { const int g = i >> 6;
        const double lre = fmin((double)in[5][i], -1e-4), lim = (double)in[6][i], dt = exp((double)in[7][g]);
        const double mag = exp(lre * dt), abr = mag * cos(lim * dt), abi = mag * sin(lim * dt), den = lre * lre + lim * lim, nr = abr - 1.0, ni = abi;
        const double zr = (nr * lre + ni * lim) / den, zi = (ni * lre - nr * lim) / den;
        AB[i] = (float)abr; AB[NGRP * NST + i] = (float)abi;
#pragma unroll 4
        for (int c = 0; c < 16; ++c) { const double br = (double)in[8][i * 16 + c], bi = (double)in[9][i * 16 + c];
            BB[i * 16 + c] = (float)(zr * br - zi * bi); BB[NGRP * NST * 16 + i * 16 + c] = (float)(zr * bi + zi * br); } } }
    const float* lg = in[2]; const float* lb = in[3];
    bf16_t* HBF = (bf16_t*)(ws + WS_HBF);
    for (int m = gw; m < T + NMETA; m += NGW) {
        const bool meta = m >= T; const float* xrow = meta ? in[1] + (size_t)(m - T) * DM : in[0] + (size_t)m * DM;
        f32x4 v[8];
#pragma unroll
        for (int j = 0; j < 8; ++j) v[j] = *(const f32x4*)(xrow + 256 * j + 4 * C.lane);
        float mean, rstd; ln_stats(v, mean, rstd);
#pragma unroll
        for (int j = 0; j < 8; ++j) { const f32x4 gg = *(const f32x4*)(lg + 256 * j + 4 * C.lane), bb = *(const f32x4*)(lb + 256 * j + 4 * C.lane);
            const f32x4 o = (v[j] - mean) * rstd * gg + bb;
            if (meta) *(f32x4*)((float*)(ws + WS_HMETA) + (size_t)(m - T) * DM + 256 * j + 4 * C.lane) = o;
            else { u32x2 w; w.x = cvt_pk_bf16(o.x, o.y); w.y = cvt_pk_bf16(o.z, o.w); *(u32x2*)(HBF + (size_t)m * DM + 256 * j + 4 * C.lane) = w; } }
    }
}

__device__ __forceinline__ void p1_meta_proj(const Ctx& C, unsigned char* ws) {
    const bf16_t* WinT = (const bf16_t*)(ws + WS_WIN); const float* HM = (const float*)(ws + WS_HMETA);
    const int gw = C.vcu * 8 + C.wave, NGW = C.G * 8;
    for (int it = gw; it < 640; it += NGW) {
        const int nidx = 4 * it; const int col0 = nidx < 512 ? nidx : (nidx < 1536 ? 1536 + (nidx - 512) : 2560 + (nidx - 1536));
        float acc[16][4];
#pragma unroll
        for (int r = 0; r < 16; ++r)
#pragma unroll
            for (int c = 0; c < 4; ++c) acc[r][c] = 0.f;
#pragma unroll 1
        for (int j = 0; j < 4; ++j) { const int k0 = j * 512 + C.lane * 8;
            f32x4 w0[4], w1[4];
#pragma unroll
            for (int c = 0; c < 4; ++c) { const u32x4 ww = *(const u32x4*)(WinT + (size_t)(col0 + c) * DM + k0); unpack8(ww, w0[c], w1[c]); }
#pragma unroll
            for (int r = 0; r < 16; ++r) { const f32x4 h0 = *(const f32x4*)(HM + r * DM + k0), h1 = *(const f32x4*)(HM + r * DM + k0 + 4);
#pragma unroll
                for (int c = 0; c < 4; ++c) { const f32x4 p = h0 * w0[c] + h1 * w1[c]; acc[r][c] += (p.x + p.y) + (p.z + p.w); } } }
        float mine = 0.f;
#pragma unroll
        for (int r = 0; r < 16; ++r)
#pragma unroll
            for (int c = 0; c < 4; ++c) { const float s = wave_sum(acc[r][c]); mine = (C.lane == r * 4 + c) ? s : mine; }
        const int r = C.lane >> 2, c = C.lane & 3;
        if (nidx < 512) ((float*)(ws + WS_UMETA))[r * SSMW + nidx + c] = mine;
        else if (nidx < 1536) ((bf16_t*)(ws + WS_KMETA))[r * AW + (nidx - 512) + c] = (bf16_t)(cvt_pk_bf16(mine, 0.f) & 0xffffu);
        else ((bf16_t*)(ws + WS_VMETA))[r * AW + (nidx - 1536) + c] = (bf16_t)(cvt_pk_bf16(mine, 0.f) & 0xffffu);
    }
}

__device__ __forceinline__ float gelu_tanh(float x) { const float u = 1.5957691216057308f * (x + 0.044715f * x * x * x); return x / (1.0f + __expf(-u)); }
#define SC_HANDOFF(Q) do { _Pragma("unroll") for (int st_ = 0; st_ < 2; ++st_) { \
        auto rr_ = __builtin_amdgcn_permlane32_swap(__float_as_uint(sre[st_]), __float_as_uint(sre[st_]), false, false); sre[st_] = __uint_as_float(rr_[(Q) & 1]); \
        auto ri_ = __builtin_amdgcn_permlane32_swap(__float_as_uint(sim[st_]), __float_as_uint(sim[st_]), false, false); sim[st_] = __uint_as_float(ri_[(Q) & 1]); } } while (0)
template <bool STORE> __device__ __forceinline__ void scan_block(f32x16 (&buv)[4], float (&sre)[2], float (&sim)[2], const float (&are)[2], const float (&aim)[2], int hi) {
    float bu[4][16];
#pragma unroll
    for (int t = 0; t < 4; ++t)
#pragma unroll
        for (int r = 0; r < 16; ++r) bu[t][r] = buv[t][r];
#pragma unroll
    for (int q = 0; q < 8; ++q) {
        const bool act = (hi == (q & 1));
#pragma unroll
        for (int i = 0; i < 4; ++i) { const int reg = 4 * (q >> 1) + i;
#pragma unroll
            for (int st = 0; st < 2; ++st) {
                const float nre = are[st] * sre[st] - aim[st] * sim[st] + bu[st][reg];
                const float nim = are[st] * sim[st] + aim[st] * sre[st] + bu[2 + st][reg];
                sre[st] = nre; sim[st] = nim;
                if (STORE) { bu[st][reg] = act ? nre : bu[st][reg]; bu[2 + st][reg] = act ? nim : bu[2 + st][reg]; } } }
        SC_HANDOFF(q);
    }
    if (STORE) {
#pragma unroll
        for (int t = 0; t < 4; ++t)
#pragma unroll
            for (int r = 0; r < 16; ++r) buv[t][r] = bu[t][r];
    }
}
__device__ __forceinline__ void p2_scan(const Ctx& C, const float* const* in, unsigned char* ws) {
    const int lane = C.lane, wave = C.wave, r32 = lane & 31, hi = lane >> 5, fr = lane & 15, fq = lane >> 4;
    const bf16_t* U = (const bf16_t*)(ws + WS_U); const float* UM = (const float*)(ws + WS_UMETA); bf16_t* YPRE = (bf16_t*)(ws + WS_YPRE);
    const float* AB = (const float*)(ws + WS_SSMAB); const float* BB = (const float*)(ws + WS_SSMBB);
    LAS unsigned char* Sl = C.lds + wave * 8704;
    LAS float* E = (LAS float*)(C.lds + 69632);
    for (int item = C.vcu; item < NB_ * NGRP; item += C.G) {
        const int b = item >> 5, g = item & 31;
        float are[2], aim[2];
#pragma unroll
        for (int st = 0; st < 2; ++st) { are[st] = AB[g * 64 + 32 * st + r32]; aim[st] = AB[NGRP * NST + g * 64 + 32 * st + r32]; }
        bf16x8 Bf[4];
#pragma unroll
        for (int ri = 0; ri < 2; ++ri)
#pragma unroll
            for (int st = 0; st < 2; ++st) { const float* src = BB + ri * (NGRP * NST * 16) + (g * 64 + 32 * st + r32) * 16 + 8 * hi;
                const f32x4 x0 = *(const f32x4*)src, x1 = *(const f32x4*)(src + 4); Bf[2 * ri + st] = __builtin_bit_cast(bf16x8, pack8(x0, x1)); }
        bf16x8 Cf[4];
#pragma unroll
        for (int ks = 0; ks < 4; ++ks) { const int k0 = 32 * ks + 8 * fq; const float* src = (ks < 2 ? in[10] : in[11]) + (g * 16 + fr) * 64 + (k0 & 63);
            f32x4 x0 = *(const f32x4*)src, x1 = *(const f32x4*)(src + 4); if (ks >= 2) { x0 = -x0; x1 = -x1; } Cf[ks] = __builtin_bit_cast(bf16x8, pack8(x0, x1)); }
        const float dsk = in[12][g * 16 + fr];
        const bf16_t* Ub = U + ((size_t)b * SEQ + wave * 256) * SSMW + 16 * g;
        float sre[2] = {0.f, 0.f}, sim[2] = {0.f, 0.f}, mre[2] = {0.f, 0.f}, mim[2] = {0.f, 0.f};
        if (wave == 0) {
            f32x4 x0 = (f32x4){0.f, 0.f, 0.f, 0.f}, x1 = x0;
            if (r32 >= 16) { const float* src = UM + (r32 - 16) * SSMW + 16 * g + 8 * hi; x0 = *(const f32x4*)src; x1 = *(const f32x4*)(src + 4); }
            const bf16x8 uf = __builtin_bit_cast(bf16x8, pack8(x0, x1));
            f32x16 bu[4];
#pragma unroll
            for (int t = 0; t < 4; ++t) bu[t] = __builtin_amdgcn_mfma_f32_32x32x16_bf16(uf, Bf[t], (f32x16){}, 0, 0, 0);
            scan_block<false>(bu, sre, sim, are, aim, hi);
            mre[0] = sre[0]; mre[1] = sre[1]; mim[0] = sim[0]; mim[1] = sim[1];
        }
#pragma unroll 1
        for (int blk = 0; blk < 8; ++blk) {
            const bf16x8 uf = *(const bf16x8*)(Ub + (size_t)(32 * blk + r32) * SSMW + 8 * hi);
            f32x16 bu[4];
#pragma unroll
            for (int t = 0; t < 4; ++t) bu[t] = __builtin_amdgcn_mfma_f32_32x32x16_bf16(uf, Bf[t], (f32x16){}, 0, 0, 0);
            scan_block<false>(bu, sre, sim, are, aim, hi);
        }
        if (hi == 0) {
#pragma unroll
            for (int st = 0; st < 2; ++st) { E[wave * 128 + st * 64 + r32] = sre[st]; E[wave * 128 + st * 64 + 32 + r32] = sim[st]; } }
        __syncthreads();
        if (wave == 0) { sre[0] = mre[0]; sre[1] = mre[1]; sim[0] = mim[0]; sim[1] = mim[1]; }
        else {
            float pr[2], pi[2];
#pragma unroll
            for (int st = 0; st < 2; ++st) { pr[st] = are[st]; pi[st] = aim[st];
#pragma unroll
                for (int k = 0; k < 8; ++k) { const float nr = pr[st] * pr[st] - pi[st] * pi[st], ni = 2.f * pr[st] * pi[st]; pr[st] = nr; pi[st] = ni; }
                sre[st] = E[st * 64 + r32]; sim[st] = E[st * 64 + 32 + r32]; }
            for (int j = 1; j < wave; ++j) {
#pragma unroll
                for (int st = 0; st < 2; ++st) { const float er = E[j * 128 + st * 64 + r32], ei = E[j * 128 + st * 64 + 32 + r32];
                    const float nr = pr[st] * sre[st] - pi[st] * sim[st] + er, ni = pr[st] * sim[st] + pi[st] * sre[st] + ei; sre[st] = nr; sim[st] = ni; } }
        }
#pragma unroll 1
        for (int blk = 0; blk < 8; ++blk) {
            const bf16x8 uf = *(const bf16x8*)(Ub + (size_t)(32 * blk + r32) * SSMW + 8 * hi);
            f32x16 bu[4];
#pragma unroll
            for (int t = 0; t < 4; ++t) bu[t] = __builtin_amdgcn_mfma_f32_32x32x16_bf16(uf, Bf[t], (f32x16){}, 0, 0, 0);
            scan_block<true>(bu, sre, sim, are, aim, hi);
#pragma unroll
            for (int reg = 0; reg < 16; ++reg) { const int tok = (reg & 3) + 8 * (reg >> 2) + 4 * hi;
#pragma unroll
                for (int t = 0; t < 4; ++t) *(LAS bf16_t*)(Sl + tok * 272 + (32 * t + r32) * 2) = (bf16_t)(cvt_pk_bf16(bu[t][reg], 0.f) & 0xffffu); }
            f32x4 y[2];
#pragma unroll
            for (int mt = 0; mt < 2; ++mt) { y[mt] = (f32x4){0.f, 0.f, 0.f, 0.f};
#pragma unroll
                for (int ks = 0; ks < 4; ++ks) { const bf16x8 af = *(const LAS bf16x8*)(Sl + (16 * mt + fr) * 272 + (32 * ks + 8 * fq) * 2);
                    y[mt] = __builtin_amdgcn_mfma_f32_16x16x32_bf16(af, Cf[ks], y[mt], 0, 0, 0); } }
#pragma unroll
            for (int mt = 0; mt < 2; ++mt)
#pragma unroll
                for (int reg = 0; reg < 4; ++reg) { const int tok = 32 * blk + 16 * mt + 4 * fq + reg;
                    const float uv = bf_lo((unsigned)Ub[(size_t)tok * SSMW + fr]);
                    const float yy = gelu_tanh(y[mt][reg] + dsk * uv);
                    YPRE[((size_t)b * SEQ + wave * 256 + tok) * SSMW + 16 * g + fr] = (bf16_t)(cvt_pk_bf16(yy, 0.f) & 0xffffu); }
        }
        __syncthreads();
    }
}

__device__ __forceinline__ int crow(int r, int hi) { return (r & 3) + 8 * (r >> 2) + 4 * hi; }
typedef short v4i16_t __attribute__((ext_vector_type(4)));
__device__ __forceinline__ s16x4 vtr(const LAS unsigned char* p) { return __builtin_bit_cast(s16x4, __builtin_amdgcn_ds_read_tr16_b64_v4i16((LAS v4i16_t*)p)); }
__device__ __forceinline__ float half_swap_max(float x) { auto rr = __builtin_amdgcn_permlane32_swap(__float_as_uint(x), __float_as_uint(x), false, false); return fmaxf(__uint_as_float(rr[0]), __uint_as_float(rr[1])); }
__device__ __forceinline__ float half_swap_sum(float x) { auto rr = __builtin_amdgcn_permlane32_swap(__float_as_uint(x), __float_as_uint(x), false, false); return __uint_as_float(rr[0]) + __uint_as_float(rr[1]); }

__device__ __forceinline__ void glds16(const void* gsrc, unsigned lds_dst) { unsigned keep;
    asm volatile("s_mov_b32 %0, m0\n\ts_mov_b32 m0, %2\n\ts_nop 0\n\tglobal_load_lds_dwordx4 %1, off\n\ts_mov_b32 m0, %0" : "=&s"(keep) : "v"(gsrc), "s"(lds_dst) : "memory"); }
__device__ __forceinline__ void attn_unit(const Ctx& C, const bf16_t* Qg, const bf16_t* Kg, const bf16_t* Vg, const bf16_t* KM, const bf16_t* VM, bf16_t* Y,
                                          const float* subg, float lam, int b, int h, int qt) {
    LAS unsigned char* lds = C.lds;
    const int lane = C.lane, wave = C.wave, r32 = lane & 31, hi = lane >> 5, qb = wave >> 1, map = wave & 1;
    const int q0 = qt * 128 + qb * 32;
    const size_t rowb = (size_t)b * SEQ;
    bf16x8 qr[4];
    { const bf16_t* qp = Qg + (rowb + q0 + r32) * AW + h * 128 + map * 64 + hi * 8;
#pragma unroll
      for (int d0 = 0; d0 < 4; ++d0) qr[d0] = *(const bf16x8*)(qp + d0 * 16); }
    const int NT = 2 * qt + 3;
    const bool skip_last = (qb < 2);
    f32x16 o[4];
#pragma unroll
    for (int d = 0; d < 4; ++d) o[d] = (f32x16){};
    float mrun = -__builtin_inff(), lrun = 0.f;
    LAS float* wsf = (LAS float*)(lds + 65536 + wave * 256);
    const bf16_t* Kb = Kg + rowb * AW; const bf16_t* Vb = Vg + rowb * AW;
    const unsigned lds0 = (unsigned)(uintptr_t)lds;
#define ATT_DMA(step, stage) do { const bf16_t* ks_ = (step) == 0 ? KM : Kb; const bf16_t* vs_ = (step) == 0 ? VM : Vb; const int row0_ = (step) == 0 ? 0 : ((step) - 1) * 64; \
    _Pragma("unroll") for (int i_ = 0; i_ < 2; ++i_) { const int p_ = 2 * wave + i_; \
        glds16(ks_ + (size_t)(row0_ + lane) * AW + h * 128 + (p_ >> 3) * 64 + (p_ & 7) * 8, (unsigned)__builtin_amdgcn_readfirstlane(lds0 + (stage) * 32768 + p_ * 1024)); \
        glds16(vs_ + (size_t)(row0_ + 16 * (p_ & 3) + (lane >> 2)) * AW + h * 128 + (p_ >> 2) * 32 + (lane & 3) * 8, (unsigned)__builtin_amdgcn_readfirstlane(lds0 + (stage) * 32768 + 16384 + p_ * 1024)); } } while (0)
    ATT_DMA(0, 0);
    asm volatile("s_waitcnt vmcnt(0)" ::: "memory"); __syncthreads();
#pragma unroll 1
    for (int s = 0; s < NT; ++s) {
        const int stage = s & 1;
        if (s + 1 < NT) ATT_DMA(s + 1, stage ^ 1);
        if (!(skip_last && s == NT - 1)) {
            const LAS unsigned char* kb = lds + stage * 32768 + map * 8192 + hi * 1024 + r32 * 16;
            f32x16 p0 = (f32x16){}, p1 = (f32x16){};
#pragma unroll
            for (int d0 = 0; d0 < 4; ++d0) { const bf16x8 b0 = *(const LAS bf16x8*)(kb + d0 * 2048), b1 = *(const LAS bf16x8*)(kb + d0 * 2048 + 512);
                p0 = __builtin_amdgcn_mfma_f32_32x32x16_bf16(b0, qr[d0], p0, 0, 0, 0); p1 = __builtin_amdgcn_mfma_f32_32x32x16_bf16(b1, qr[d0], p1, 0, 0, 0); }
            if (s == 0) {
#pragma unroll
                for (int r = 0; r < 16; ++r) { if (r >= 8) p0[r] = -__builtin_inff(); p1[r] = -__builtin_inff(); } }
            float rm = fmaxf(p0[0], p1[0]);
#pragma unroll
            for (int r = 1; r < 16; ++r) rm = fmaxf(rm, fmaxf(p0[r], p1[r]));
            rm = half_swap_max(rm);
            const float mnew = fmaxf(mrun, rm);
            if (__any(mnew > mrun)) {
                const float alpha = __builtin_amdgcn_exp2f(mrun - mnew);
                lrun *= alpha; mrun = mnew;
                if (hi == 0) wsf[r32] = alpha;
                f32x4 a4[4];
#pragma unroll
                for (int gq = 0; gq < 4; ++gq) a4[gq] = *(const LAS f32x4*)(wsf + 8 * gq + 4 * hi);
#pragma unroll
                for (int d = 0; d < 4; ++d)
#pragma unroll
                    for (int r = 0; r < 16; ++r) o[d][r] *= a4[r >> 2][r & 3];
            }
            float ps = 0.f;
#pragma unroll
            for (int r = 0; r < 16; ++r) { p0[r] = __builtin_amdgcn_exp2f(p0[r] - mrun); p1[r] = __builtin_amdgcn_exp2f(p1[r] - mrun); ps += p0[r] + p1[r]; }
            lrun += ps;
            bf16x8 pa[4];
            { u32x4 w;
              w = (u32x4){cvt_pk_bf16(p0[0], p0[1]), cvt_pk_bf16(p0[2], p0[3]), cvt_pk_bf16(p0[4], p0[5]), cvt_pk_bf16(p0[6], p0[7])}; pa[0] = __builtin_bit_cast(bf16x8, w);
              w = (u32x4){cvt_pk_bf16(p0[8], p0[9]), cvt_pk_bf16(p0[10], p0[11]), cvt_pk_bf16(p0[12], p0[13]), cvt_pk_bf16(p0[14], p0[15])}; pa[1] = __builtin_bit_cast(bf16x8, w);
              w = (u32x4){cvt_pk_bf16(p1[0], p1[1]), cvt_pk_bf16(p1[2], p1[3]), cvt_pk_bf16(p1[4], p1[5]), cvt_pk_bf16(p1[6], p1[7])}; pa[2] = __builtin_bit_cast(bf16x8, w);
              w = (u32x4){cvt_pk_bf16(p1[8], p1[9]), cvt_pk_bf16(p1[10], p1[11]), cvt_pk_bf16(p1[12], p1[13]), cvt_pk_bf16(p1[14], p1[15])}; pa[3] = __builtin_bit_cast(bf16x8, w); }
            const LAS unsigned char* vp0 = lds + stage * 32768 + 16384 + ((lane >> 4) & 1) * 32 + (lane & 3) * 8 + (4 * hi + ((lane & 15) >> 2)) * 64;
            const unsigned vaddr = (unsigned)(uintptr_t)vp0;
            s16x4 vl[2][4], vh[2][4];
#define ATT_VRD(SET, D) do { _Pragma("unroll") for (int ks_ = 0; ks_ < 4; ++ks_) { \
                asm volatile("ds_read_b64_tr_b16 %0, %1 offset:%2" : "=&v"(vl[SET][ks_]) : "v"(vaddr), "i"((D) * 4096 + ks_ * 1024) : "memory"); \
                asm volatile("ds_read_b64_tr_b16 %0, %1 offset:%2" : "=&v"(vh[SET][ks_]) : "v"(vaddr), "i"((D) * 4096 + ks_ * 1024 + 512) : "memory"); } } while (0)
            __builtin_amdgcn_sched_barrier(0);
            ATT_VRD(0, 0);
#pragma unroll
            for (int d = 0; d < 4; ++d) {
                if (d == 0) { ATT_VRD(1, 1); } else if (d == 1) { ATT_VRD(0, 2); } else if (d == 2) { ATT_VRD(1, 3); }
                if (d < 3) asm volatile("s_waitcnt lgkmcnt(8)" ::: "memory"); else asm volatile("s_waitcnt lgkmcnt(0)" ::: "memory");
                __builtin_amdgcn_sched_barrier(0);
#pragma unroll
                for (int ks = 0; ks < 4; ++ks) { const s16x4 lo = vl[d & 1][ks], hv = vh[d & 1][ks];
                    const bf16x8 vf = (bf16x8){lo[0], lo[1], lo[2], lo[3], hv[0], hv[1], hv[2], hv[3]};
                    o[d] = __builtin_amdgcn_mfma_f32_32x32x16_bf16(pa[ks], vf, o[d], 0, 0, 0); }
                __builtin_amdgcn_sched_barrier(0);
            }
#undef ATT_VRD
        }
        asm volatile("s_waitcnt vmcnt(0)" ::: "memory"); __syncthreads();
    }
#undef ATT_DMA
    { const float ltot = half_swap_sum(lrun); const float inv = (map ? lam : 1.0f) / ltot;
      if (hi == 0) wsf[r32] = inv;
      f32x4 a4[4];
#pragma unroll
      for (int gq = 0; gq < 4; ++gq) a4[gq] = *(const LAS f32x4*)(wsf + 8 * gq + 4 * hi);
#pragma unroll
      for (int d = 0; d < 4; ++d)
#pragma unroll
          for (int r = 0; r < 16; ++r) o[d][r] *= a4[r >> 2][r & 3]; }
    LAS float* X = (LAS float*)(lds + qb * 16384);
    if (map == 1) {
#pragma unroll
        for (int d = 0; d < 4; ++d)
#pragma unroll
            for (int r = 0; r < 16; ++r) X[crow(r, hi) * 128 + 32 * d + r32] = o[d][r];
    }
    __syncthreads();
    if (map == 0) {
        float ssq[16];
#pragma unroll
        for (int r = 0; r < 16; ++r) ssq[r] = 0.f;
#pragma unroll
        for (int d = 0; d < 4; ++d)
#pragma unroll
            for (int r = 0; r < 16; ++r) { const float v = o[d][r] - X[crow(r, hi) * 128 + 32 * d + r32]; o[d][r] = v; ssq[r] += v * v; }
#pragma unroll
        for (int r = 0; r < 16; ++r) {
#pragma unroll
            for (int off = 1; off < 32; off <<= 1) ssq[r] += __shfl_xor(ssq[r], off);
            ssq[r] = 0.8f / sqrtf(ssq[r] * (1.f / 128.f) + LN_EPS); }
#pragma unroll
        for (int d = 0; d < 4; ++d) { const float gg = subg[32 * d + r32];
#pragma unroll
            for (int r = 0; r < 16; ++r) Y[(rowb + q0 + crow(r, hi)) * AW + h * 128 + 32 * d + r32] = (bf16_t)(cvt_pk_bf16(o[d][r] * ssq[r] * gg, 0.f) & 0xffffu); }
    }
    __syncthreads();
}
__device__ __forceinline__ void p3_attention(const Ctx& C, const float* const* in, unsigned char* ws) {
    const bf16_t* Q = (const bf16_t*)(ws + WS_Q); const bf16_t* K = (const bf16_t*)(ws + WS_K); const bf16_t* V = (const bf16_t*)(ws + WS_V);
    const bf16_t* KM = (const bf16_t*)(ws + WS_KMETA); const bf16_t* VM = (const bf16_t*)(ws + WS_VMETA); bf16_t* Y = (bf16_t*)(ws + WS_YATT);
    const float l1 = wave_sum(in[14][C.lane] * in[15][C.lane]), l2 = wave_sum(in[16][C.lane] * in[17][C.lane]);
    const float lam = expf(l1) - expf(l2) + 0.2f;
#ifndef ATT_REP
#define ATT_REP 1
#endif
    for (int vv = C.vcu; vv < 256 * ATT_REP; vv += C.G) { const int v = vv & 255;
        const int bh = v >> 1, sft = v & 1;
#pragma unroll 1
        for (int i = 0; i < 8; ++i) { const int qt = (i & 1) ? (15 - sft - (i & ~1)) : (sft + (i & ~1));
            attn_unit(C, Q, K, V, KM, VM, Y, in[18], lam, bh >> 3, bh & 7, qt); }
    }
}

__device__ __forceinline__ void p6_ln1_router(const Ctx& C, const float* const* in, unsigned char* ws) {
    const int lane = C.lane, wave = C.wave, tid = C.tid;
    const float* Z = (const float*)(ws + WS_Z); bf16_t* H1 = (bf16_t*)(ws + WS_H1); const float* WrT = (const float*)(ws + WS_WRT);
    int* LIST = (int*)(ws + WS_LIST); float* WGT = (float*)(ws + WS_WGT); unsigned* ECNT = (unsigned*)(ws + WS_CTL) + CW_ECNT;
    const float* lg = in[22]; const float* lb = in[23];
    LAS float* WB = (LAS float*)C.lds;
    LAS unsigned char* XB = C.lds + 98304;
    LAS int* RE = (LAS int*)(XB);
    LAS float* RW = (LAS float*)(XB + 1024);
    LAS int* CL = (LAS int*)(XB + 2048);
    LAS int* BS = (LAS int*)(XB + 2048 + 128);
    LAS int* SL = (LAS int*)(XB + 2048 + 256);
    LAS float* LG = (LAS float*)(XB + 4096) + wave * 80;
    for (int rbk = C.vcu; rbk < T / 128; rbk += C.G) {
        if (tid < 32) CL[tid] = 0;
#pragma unroll 1
        for (int step = 0; step < 8; ++step) {
            const int lr0 = step * 16 + 2 * wave; const size_t row0 = (size_t)rbk * 128 + lr0;
            int l4 = 4 * lane; asm volatile("" : "+v"(l4));
            f32x4 v0[8], v1[8];
#pragma unroll
            for (int j = 0; j < 8; ++j) { v0[j] = *(const f32x4*)(Z + row0 * DM + 256 * j + l4); v1[j] = *(const f32x4*)(Z + (row0 + 1) * DM + 256 * j + l4); }
            float mean0, rstd0, mean1, rstd1; ln_stats(v0, mean0, rstd0); ln_stats(v1, mean1, rstd1);
#pragma unroll
            for (int j = 0; j < 8; ++j) { const f32x4 gg = *(const f32x4*)(lg + 256 * j + l4), bb = *(const f32x4*)(lb + 256 * j + l4);
                v0[j] = (v0[j] - mean0) * rstd0 * gg + bb; v1[j] = (v1[j] - mean1) * rstd1 * gg + bb;
                u32x2 w; w.x = cvt_pk_bf16(v0[j].x, v0[j].y); w.y = cvt_pk_bf16(v0[j].z, v0[j].w); *(u32x2*)(H1 + row0 * DM + 256 * j + l4) = w;
                w.x = cvt_pk_bf16(v1[j].x, v1[j].y); w.y = cvt_pk_bf16(v1[j].z, v1[j].w); *(u32x2*)(H1 + (row0 + 1) * DM + 256 * j + l4) = w; }
#pragma unroll 1
            for (int ng = 0; ng < 3; ++ng) {
                __syncthreads();
                int tq = tid; asm volatile("" : "+v"(tq));
#pragma unroll
                for (int i = 0; i < 12; ++i) { const int idx = tq + 512 * i, n = idx >> 9, c4 = idx & 511;
                    *(LAS f32x4*)(WB + n * 2048 + 4 * c4) = *(const f32x4*)(WrT + (size_t)(12 * ng + n) * DM + 4 * c4); }
                __syncthreads();
#pragma unroll 1
                for (int n = 0; n < 12; ++n) { float pa = 0.f, pb = 0.f;
#pragma unroll
                    for (int j = 0; j < 8; ++j) { const f32x4 w4 = *(const LAS f32x4*)(WB + n * 2048 + 256 * j + l4);
                        const f32x4 a = v0[j] * w4, bq = v1[j] * w4; pa += (a.x + a.y) + (a.z + a.w); pb += (bq.x + bq.y) + (bq.z + bq.w); }
                    const float sa = wave_sum(pa), sb = wave_sum(pb); if (lane == 0) { LG[12 * ng + n] = sa; LG[40 + 12 * ng + n] = sb; } }
            }
            if (lane < 2) {
                const LAS float* L = LG + 40 * lane;
                int gi = 0; float gm = L[0] + in[25][0];
                for (int n = 1; n < 4; ++n) { const float x = L[n] + in[25][n]; if (x > gm) { gm = x; gi = n; } }
                float gs = 0.f;
                for (int n = 0; n < 4; ++n) gs += __expf(L[n] + in[25][n] - gm);
                const float gval = 1.0f / gs;
                int i1 = 0; float m1 = L[4 + gi * 8] + in[27][gi * 8];
                for (int j = 1; j < 8; ++j) { const float x = L[4 + gi * 8 + j] + in[27][gi * 8 + j]; if (x > m1) { m1 = x; i1 = j; } }
                int i2 = -1; float m2 = -__builtin_inff();
                for (int j = 0; j < 8; ++j) { const float x = L[4 + gi * 8 + j] + in[27][gi * 8 + j]; if (j != i1 && x > m2) { m2 = x; i2 = j; } }
                const float tt = __expf(m2 - m1), w1 = gval / (1.f + tt), w2 = gval * tt / (1.f + tt);
                const int lr = lr0 + lane; RE[lr * 2] = gi * 8 + i1; RE[lr * 2 + 1] = gi * 8 + i2; RW[lr * 2] = w1; RW[lr * 2 + 1] = w2;
            }
        }
        __syncthreads();
        int e = 0;
        if (tid < 256) { e = RE[tid]; SL[tid] = __hip_atomic_fetch_add(&CL[e], 1, __ATOMIC_RELAXED, __HIP_MEMORY_SCOPE_WORKGROUP); }
        __syncthreads();
        if (tid < 32) BS[tid] = (int)__hip_atomic_fetch_add(&ECNT[tid], (unsigned)CL[tid], __ATOMIC_RELAXED, __HIP_MEMORY_SCOPE_AGENT);
        __syncthreads();
        if (tid < 256) { const int entry = (rbk * 128 + (tid >> 1)) * 2 + (tid & 1); LIST[(size_t)e * CAP + BS[e] + SL[tid]] = entry; WGT[entry] = RW[tid]; }
        __syncthreads();
    }
}

__device__ __forceinline__ void p9_ln2(const Ctx& C, const float* const* in, unsigned char* ws, float* out) {
    const bf16_t* H1 = (const bf16_t*)(ws + WS_H1); const bf16_t* YK = (const bf16_t*)(ws + WS_YK);
    const float* lg = in[31]; const float* lb = in[32];
    const int gw = C.vcu * 8 + C.wave, NGW = C.G * 8, lane = C.lane;
    for (int m = gw; m < T; m += NGW) {
        f32x4 v[8];
#pragma unroll
        for (int j = 0; j < 8; ++j) { const size_t c = 256 * j + 4 * lane;
            const u32x2 hw = *(const u32x2*)(H1 + (size_t)m * DM + c), y0 = *(const u32x2*)(YK + (size_t)(2 * m) * DM + c), y1 = *(const u32x2*)(YK + (size_t)(2 * m + 1) * DM + c);
            v[j] = (f32x4){bf_lo(hw.x), bf_hi(hw.x), bf_lo(hw.y), bf_hi(hw.y)} * ALPHA + (f32x4){bf_lo(y0.x), bf_hi(y0.x), bf_lo(y0.y), bf_hi(y0.y)} + (f32x4){bf_lo(y1.x), bf_hi(y1.x), bf_lo(y1.y), bf_hi(y1.y)}; }
        float mean, rstd; ln_stats(v, mean, rstd);
#pragma unroll
        for (int j = 0; j < 8; ++j) { const f32x4 gg = *(const f32x4*)(lg + 256 * j + 4 * lane), bb = *(const f32x4*)(lb + 256 * j + 4 * lane);
            *(f32x4*)(out + (size_t)m * DM + 256 * j + 4 * lane) = (v[j] - mean) * rstd * gg + bb; }
    }
}

__device__ __forceinline__ int build_moe_tables(const Ctx& C, unsigned char* ws) {
    LAS int* blkstart = (LAS int*)(C.lds + MISC_OFF + 64); LAS int* cntE = (LAS int*)(C.lds + MISC_OFF + 320); LAS int* blkexp = (LAS int*)(C.lds + MISC_OFF + 512);
    unsigned* ECNT = (unsigned*)(ws + WS_CTL) + CW_ECNT;
    __syncthreads();
    if (C.tid < 32) cntE[C.tid] = (int)__hip_atomic_load(&ECNT[C.tid], __ATOMIC_RELAXED, __HIP_MEMORY_SCOPE_AGENT);
    __syncthreads();
    if (C.tid == 0) { int s = 0; for (int e = 0; e < NE; ++e) { blkstart[e] = s; s += (cntE[e] + 255) >> 8; } blkstart[NE] = s; }
    __syncthreads();
    const int NBLK = blkstart[NE];
    if (C.tid < NBLK && C.tid < 320) { int e = 0; for (int j = 1; j < NE; ++j) if (blkstart[j] <= C.tid) e = j; blkexp[C.tid] = e; }
    __syncthreads();
    return NBLK < 320 ? NBLK : 320;
}

constexpr int NPHASE = 10;
struct Args { const float* in[33]; float* out; unsigned char* ws; int ph_lo, ph_hi; };
__global__ void __launch_bounds__(512, 2) mk_fwd(Args args) {
    extern __shared__ __attribute__((aligned(16))) unsigned char lds_raw[];
    Ctx C; C.lds = (LAS unsigned char*)lds_raw; C.tid = threadIdx.x; C.lane = C.tid & 63; C.wave = __builtin_amdgcn_readfirstlane(C.tid >> 6);
    C.G = gridDim.x; { const int bx = blockIdx.x; C.vcu = (C.G % 8 == 0) ? (bx % 8) * (C.G / 8) + bx / 8 : bx; }
    unsigned char* ws = args.ws; const float* const* in = args.in;
    volatile LAS unsigned* MISC = (volatile LAS unsigned*)(C.lds + MISC_OFF);
    if (C.tid < 16) MISC[C.tid] = 0u;
    __syncthreads();
    unsigned* barw = (unsigned*)(ws + WS_CTL) + CW_BAR;
    XcdBarrier bar; bar.bar = barw; bar.x = 0; bar.st = nullptr;
    const int lo = args.ph_lo, hi = args.ph_hi;
    if (hi - lo > 1) bar = xcd_barrier_post(barw, MISC);
#ifndef PH_MASK
#define PH_MASK 0x3ff
#endif
#define IN(k) (((PH_MASK >> (k)) & 1) && lo <= (k) && (k) < hi)
#define SEAM(k) do { if (IN(k) && IN((k) + 1)) xcd_barrier(bar); } while (0)
#ifndef GEMM_SP2
#define GEMM_SP2 true
#endif
#ifndef GEMM_ALIGN
#define GEMM_ALIGN true
#endif
#ifndef PROBE_MASK
#define PROBE_MASK 0
#endif
#define REPS(k) (((PROBE_MASK >> (k)) & 1) ? 2 : 1)
#define REPSEAM(k, rep) do { if ((rep) + 1 < REPS(k)) xcd_barrier(bar); } while (0)
    LAS unsigned char* lds = C.lds;
    bf16_t* MG = (bf16_t*)args.out;

    if (IN(0)) { _Pragma("unroll") for (int rep = 0; rep < REPS(0); ++rep) { p0_prologue(C, in, ws); REPSEAM(0, rep); } } SEAM(0);

    if (IN(1)) { _Pragma("unroll") for (int rep = 0; rep < REPS(1); ++rep) {
        pg8::Gemm g{(const bf16_t*)(ws + WS_HBF), (const bf16_t*)(ws + WS_WIN), T, INC, DM}; pg8::StaticOrder S; S.init(T, INC, C.G, (int)blockIdx.x);
        EpiProj E{(bf16_t*)(ws + WS_U), (bf16_t*)(ws + WS_Q), (bf16_t*)(ws + WS_K), (bf16_t*)(ws + WS_V), (bf16_t*)(ws + WS_SGS), (bf16_t*)(ws + WS_SGA)};
        pg8::gemm_phase<EpiProj, pg8::StaticOrder, GEMM_ALIGN, GEMM_SP2, false>(lds, g, S, E);
        p1_meta_proj(C, ws);
        REPSEAM(1, rep);
    } } SEAM(1);

    if (IN(2)) { _Pragma("unroll") for (int rep = 0; rep < REPS(2); ++rep) { p2_scan(C, in, ws); REPSEAM(2, rep); } } SEAM(2);

    if (IN(3)) { _Pragma("unroll") for (int rep = 0; rep < REPS(3); ++rep) {
        { pg8::Gemm g{(const bf16_t*)(ws + WS_YPRE), (const bf16_t*)(ws + WS_WGLU), T, SSMW, SSMW}; pg8::StaticOrder S; S.init(T, SSMW, C.G, (int)blockIdx.x);
          EpiGlu E{(const bf16_t*)(ws + WS_YPRE), (bf16_t*)(ws + WS_YSSM)};
          pg8::gemm_phase<EpiGlu, pg8::StaticOrder, GEMM_ALIGN, GEMM_SP2, false>(lds, g, S, E); }
        p3_attention(C, in, ws);
        REPSEAM(3, rep);
    } } SEAM(3);

    if (IN(4)) { _Pragma("unroll") for (int rep = 0; rep < REPS(4); ++rep) {
        { pg8::Gemm g{(const bf16_t*)(ws + WS_YSSM), (const bf16_t*)(ws + WS_WBS), T, DM, SSMW}; pg8::StaticOrder S; S.init(T, DM, C.G, (int)blockIdx.x);
          EpiMerge<0> E{(const bf16_t*)(ws + WS_SGS), MG};
          pg8::gemm_phase<EpiMerge<0>, pg8::StaticOrder, GEMM_ALIGN, GEMM_SP2, false>(lds, g, S, E); }
        { pg8::Gemm g{(const bf16_t*)(ws + WS_YATT), (const bf16_t*)(ws + WS_WBA), T, DM, AW}; pg8::StaticOrder S; S.init(T, DM, C.G, (int)blockIdx.x);
          EpiMerge<1> E{(const bf16_t*)(ws + WS_SGA), MG};
          pg8::gemm_phase<EpiMerge<1>, pg8::StaticOrder, GEMM_ALIGN, GEMM_SP2, false>(lds, g, S, E); }
        REPSEAM(4, rep);
    } } SEAM(4);

    if (IN(5)) { _Pragma("unroll") for (int rep = 0; rep < REPS(5); ++rep) {
        pg8::Gemm g{MG, (const bf16_t*)(ws + WS_WO), T, DM, DM}; pg8::StaticOrder S; S.init(T, DM, C.G, (int)blockIdx.x);
        EpiZ E{(const bf16_t*)(ws + WS_HBF), (float*)(ws + WS_Z)};
        pg8::gemm_phase<EpiZ, pg8::StaticOrder, GEMM_ALIGN, GEMM_SP2, false>(lds, g, S, E);
        REPSEAM(5, rep);
    } } SEAM(5);

    if (IN(6)) { p6_ln1_router(C, in, ws); } SEAM(6);

    if (IN(7)) { _Pragma("unroll") for (int rep = 0; rep < REPS(7); ++rep) {
        const int NBLK = build_moe_tables(C, ws);
        MoeOrder S{C.G, C.vcu, 2, NBLK, (const LAS int*)(lds + MISC_OFF + 512), (const LAS int*)(lds + MISC_OFF + 64), (const LAS int*)(lds + MISC_OFF + 320), (const int*)(ws + WS_LIST)};
        pg8::Gemm g{(const bf16_t*)(ws + WS_H1), (const bf16_t*)(ws + WS_WUP), T, NE * 1024, DM};
        EpiSwiglu E{(bf16_t*)(ws + WS_HB)};
        pg8::gemm_phase<EpiSwiglu, MoeOrder, GEMM_ALIGN, GEMM_SP2, true>(lds, g, S, E);
        REPSEAM(7, rep);
    } } SEAM(7);

    if (IN(8)) { _Pragma("unroll") for (int rep = 0; rep < REPS(8); ++rep) {
        const int NBLK = build_moe_tables(C, ws);
        MoeOrder S{C.G, C.vcu, 3, NBLK, (const LAS int*)(lds + MISC_OFF + 512), (const LAS int*)(lds + MISC_OFF + 64), (const LAS int*)(lds + MISC_OFF + 320), (const int*)(ws + WS_LIST)};
        pg8::Gemm g{(const bf16_t*)(ws + WS_HB), (const bf16_t*)(ws + WS_WDN), NBLK * 256, NE * DM, DFF};
        EpiDown E{(const int*)(ws + WS_LIST), (const float*)(ws + WS_WGT), (bf16_t*)(ws + WS_YK)};
        pg8::gemm_phase<EpiDown, MoeOrder, GEMM_ALIGN, GEMM_SP2, false>(lds, g, S, E);
        REPSEAM(8, rep);
    } } SEAM(8);

    if (IN(9)) { _Pragma("unroll") for (int rep = 0; rep < REPS(9); ++rep) { p9_ln2(C, in, ws, args.out); REPSEAM(9, rep); } }
#undef IN
#undef SEAM
}

extern "C" void kernel_launch(void* const* d_in, const int* in_sizes, int n_in, void* d_out, int out_size, void* d_ws, size_t ws_size, hipStream_t stream) {
    static int grid = 0;
    if (grid == 0) {
        if (n_in != 33 || in_sizes[0] != T * DM || out_size != T * DM || ws_size < WS_END) { fprintf(stderr, "kernel_launch: unexpected shapes (n_in %d, in0 %d, out %d, ws %zu)\n", n_in, n_in > 0 ? in_sizes[0] : -1, out_size, ws_size); grid = -1; return; }
        int dev = 0, cus = 0, per_cu = 0;
        if (hipGetDevice(&dev) != hipSuccess || hipDeviceGetAttribute(&cus, hipDeviceAttributeMultiprocessorCount, dev) != hipSuccess) { grid = -1; return; }
        if (hipFuncSetAttribute((const void*)mk_fwd, hipFuncAttributeMaxDynamicSharedMemorySize, LDS_BYTES) != hipSuccess) { fprintf(stderr, "kernel_launch: hipFuncSetAttribute failed\n"); grid = -1; return; }
        if (hipOccupancyMaxActiveBlocksPerMultiprocessor(&per_cu, (const void*)mk_fwd, 512, LDS_BYTES) != hipSuccess || per_cu < 1) { fprintf(stderr, "kernel_launch: occupancy query reports %d blocks per CU\n", per_cu); }
        (void)hipGetLastError();
        grid = cus;
    }
    if (grid < 0) return;
    (void)hipMemsetAsync((char*)d_ws + WS_CTL, 0, CTL_ZERO_BYTES, stream);
    Args a{};
    for (int i = 0; i < 33; ++i) a.in[i] = (const float*)d_in[i];
    a.out = (float*)d_out; a.ws = (unsigned char*)d_ws;
#if MK_PER_PHASE
    for (int p = 0; p < NPHASE; ++p) { a.ph_lo = p; a.ph_hi = p + 1; hipLaunchKernelGGL(mk_fwd, dim3(grid), dim3(512), LDS_BYTES, stream, a); }
#else
    a.ph_lo = 0; a.ph_hi = NPHASE; hipLaunchKernelGGL(mk_fwd, dim3(grid), dim3(512), LDS_BYTES, stream, a);
#endif
}
```

```cpp
#include <hip/hip_runtime.h>
#include <stdint.h>
#include <stdio.h>

#ifndef ATT_PROBE
#define ATT_PROBE 0
#endif
#ifndef MK_PER_PHASE
#define MK_PER_PHASE 0
#endif

#define GAS __attribute__((address_space(1)))
#define LAS __attribute__((address_space(3)))
typedef unsigned short bf16_t;
typedef short bf16x8 __attribute__((ext_vector_type(8)));
typedef short s16x4 __attribute__((ext_vector_type(4)));
typedef float f32x2 __attribute__((ext_vector_type(2)));
typedef float f32x4 __attribute__((ext_vector_type(4)));
typedef float f32x16 __attribute__((ext_vector_type(16)));
typedef unsigned u32x2 __attribute__((ext_vector_type(2)));
typedef unsigned u32x4 __attribute__((ext_vector_type(4)));

constexpr int NB_ = 16, SEQ = 2048, DM = 2048, T = NB_ * SEQ, NMETA = 16;
constexpr int SSMW = 512, AW = 1024, INC = 7680, NGRP = 32, NST = 64;
constexpr int NE = 32, DFF = 512, CAP = T;
constexpr float LN_EPS = 1e-5f;
constexpr float ALPHA = 1.189207115002721f;
constexpr float QSCALE = 0.125f * 1.4426950408889634f;

__device__ __forceinline__ unsigned cvt_pk_bf16(float lo, float hi) { unsigned r; asm volatile("v_cvt_pk_bf16_f32 %0, %1, %2" : "=v"(r) : "v"(lo), "v"(hi)); return r; }
__device__ __forceinline__ float bf_lo(unsigned w) { return __uint_as_float(w << 16); }
__device__ __forceinline__ float bf_hi(unsigned w) { return __uint_as_float(w & 0xffff0000u); }
__device__ __forceinline__ float sigmoidf_(float x) { return 1.0f / (1.0f + __expf(-x)); }
__device__ __forceinline__ float wave_sum(float v) {
#pragma unroll
    for (int o = 1; o < 64; o <<= 1) v += __shfl_xor(v, o);
    return v;
}

namespace pg8 {
constexpr int BM = 256, BK = 64, HALF = 128, HTB = HALF * BK * 2, STAGE_BYTES = 8 * HTB, NXCD = 8, WGM = 8;
__host__ __device__ __forceinline__ int lds_byte(int r, int c) { const int st = (r >> 4) * 2 + (c >> 5), rr = r & 15, cc = c & 31, ob = rr * 64 + cc * 2; return st * 1024 + (ob ^ (((ob >> 9) & 1) << 5)); }
__host__ __device__ __forceinline__ void stage_rc(int b, int& R, int& C) { const int st = b / 1024, sb = b % 1024, swz = sb ^ (((sb >> 9) & 1) << 5); R = (st >> 1) * 16 + swz / 64; C = (st & 1) * 32 + (swz % 64) / 2; }
__host__ __device__ __forceinline__ int perm32(int rho) { const int n = rho >> 4, i = rho & 15; return 8 * (i >> 2) + 4 * n + (i & 3); }

struct Unit { int pm, pn, e, s0, cnt; };
struct Gemm { const bf16_t* A; const bf16_t* Bt; int M, N, K; const bf16_t* A2; const bf16_t* Bt2; int K2; };

struct StaticOrder {
    int nM, nN, nwg, G, c;
    __device__ void init(int M, int N, int G_, int c_) { nM = M / BM; nN = N / BM; nwg = nM * nN; G = G_; c = c_; }
    __device__ bool next(int i, Unit& u) const {
        const long L = (long)i * G + c; if (L >= nwg) return false;
        int wgid = (int)L; { const int q = nwg / NXCD, r = nwg % NXCD, xcd = wgid % NXCD, off = wgid / NXCD; wgid = (xcd < r ? xcd * (q + 1) : r * (q + 1) + (xcd - r) * q) + off; }
        const int nig = WGM * nN, gid = wgid / nig, fm = gid * WGM, gsz = (nM - fm) < WGM ? (nM - fm) : WGM;
        u.pm = fm + ((wgid % nig) % gsz); u.pn = (wgid % nig) / gsz; u.e = 0; u.s0 = 0; u.cnt = 0; return true;
    }
    __device__ __forceinline__ int arow(const Unit&, int) const { return 0; }
};

template <class Epi, class Sched, bool ALIGN_EPI, bool SP2, bool GATHER, bool DUAL = false>
__device__ __forceinline__ void gemm_phase(LAS unsigned char* lds, const Gemm g, const Sched& S, const Epi& E) {
    const int tid = threadIdx.x, wid = __builtin_amdgcn_readfirstlane(tid >> 6), lane = tid & 63, wr = wid >> 2, wc = wid & 3, fr = lane & 15, fq = lane >> 4;
    const int K = g.K, K2 = DUAL ? g.K2 : 0, nt1 = K / BK, nt = (K + K2) / BK;
    unsigned voffA[2], voffB[2], voffA2[2] = {0u, 0u}, voffB2[2] = {0u, 0u}; int stR[2], stC[2];
#pragma unroll
    for (int i = 0; i < 2; ++i) { int R, C; stage_rc(tid * 16 + i * 8192, R, C); const int Rb = Epi::PERM ? ((R & ~31) + perm32(R & 31)) : R;
        stR[i] = R; stC[i] = C; voffA[i] = (unsigned)(R * K + C) * 2u; voffB[i] = (unsigned)(Rb * K + C) * 2u;
        if constexpr (DUAL) { voffA2[i] = (unsigned)(R * K2 + C) * 2u; voffB2[i] = (unsigned)(Rb * K2 + C) * 2u; } }
    const size_t kstep = (size_t)(BK * 2);
    const size_t hstep = (size_t)HALF * K * 2;
    const size_t tstep = 2 * hstep;
    const size_t hstep2 = (size_t)HALF * K2 * 2, tstep2 = 2 * hstep2;
    const unsigned ldsw = (unsigned)wid * 1024u;
    const int aoff = lds_byte(wr * 64 + fr, fq * 8), boff = lds_byte(wc * 32 + fr, fq * 8);
#define PG8_SA(b, h) (((b) * 2 + (h)) * HTB)
#define PG8_SB(b, h) ((4 + (b) * 2 + (h)) * HTB)
#define PG8_STAGE(bufoff, gbase, voff) do { _Pragma("unroll") for (int _i = 0; _i < 2; ++_i) \
        __builtin_amdgcn_global_load_lds((const unsigned*)((const char*)(gbase) + (voff)[_i]), (LAS unsigned*)(lds + (bufoff) + ldsw + _i * 8192), 16, 0, 0); } while (0)
#define PG8_STAGE_A(bufoff, kbase, h, VO) do { if constexpr (GATHER) { PG8_STAGE(bufoff, kbase, VO[h]); } else { PG8_STAGE(bufoff, (kbase) + (h) * hstep, voffA); } } while (0)
#define PG8_STAGE_AX(bufoff, kbase, h, VO, HS, VA) do { if constexpr (GATHER) { PG8_STAGE(bufoff, kbase, VO[h]); } else { PG8_STAGE(bufoff, (kbase) + (h) * (HS), VA); } } while (0)
#define PG8_LDA(dst, b, h) do { _Pragma("unroll") for (int m = 0; m < 4; ++m) _Pragma("unroll") for (int k = 0; k < 2; ++k) dst[m][k] = *(const LAS bf16x8*)(lds + PG8_SA(b, h) + aoff + m * 2048 + k * 1024); } while (0)
#define PG8_LDB(dst, b, h) do { _Pragma("unroll") for (int n = 0; n < 2; ++n) _Pragma("unroll") for (int k = 0; k < 2; ++k) dst[n][k] = *(const LAS bf16x8*)(lds + PG8_SB(b, h) + boff + n * 2048 + k * 1024); } while (0)
#define PG8_MMA(ai, bj, At, Bt) do { __builtin_amdgcn_s_setprio(1); _Pragma("unroll") for (int m = 0; m < 4; ++m) _Pragma("unroll") for (int n = 0; n < 2; ++n) _Pragma("unroll") for (int k = 0; k < 2; ++k) \
        acc[ai][bj][m][n] = __builtin_amdgcn_mfma_f32_16x16x32_bf16(Bt[n][k], At[m][k], acc[ai][bj][m][n], 0, 0, 0); __builtin_amdgcn_s_setprio(0); } while (0)
#define PG8_WAIT_V(n) asm volatile("s_waitcnt vmcnt(" #n ")" ::: "memory")
#define PG8_WAIT_L(n) asm volatile("s_waitcnt lgkmcnt(" #n ")" ::: "memory")
#define PG8_BAR __builtin_amdgcn_s_barrier()
#define PG8_SCHED __builtin_amdgcn_sched_barrier(0)
#define PG8_GOFF(VO, U) do { _Pragma("unroll") for (int _h = 0; _h < 2; ++_h) _Pragma("unroll") for (int _i = 0; _i < 2; ++_i) \
        VO[_h][_i] = (unsigned)S.arow(U, _h * HALF + stR[_i]) * (unsigned)(K * 2) + (unsigned)(stC[_i] * 2); } while (0)
    Unit cur, nxt; int ui = 0;
    if (!S.next(0, cur)) return;
    f32x4 acc[2][2][4][2];
#pragma unroll
    for (int a = 0; a < 2; ++a)
#pragma unroll
        for (int b = 0; b < 2; ++b)
#pragma unroll
            for (int m = 0; m < 4; ++m)
#pragma unroll
                for (int n = 0; n < 2; ++n) acc[a][b][m][n] = (f32x4){0.f, 0.f, 0.f, 0.f};
    bf16x8 At[4][2], B0[2][2], B1[2][2];
    unsigned cvo[2][2] = {{0u, 0u}, {0u, 0u}}, nvo[2][2] = {{0u, 0u}, {0u, 0u}};
    const char* cA = GATHER ? (const char*)g.A : (const char*)g.A + (size_t)cur.pm * tstep; const char* cB = (const char*)g.Bt + (size_t)cur.pn * tstep;
    if constexpr (GATHER) { PG8_GOFF(cvo, cur); }
    if constexpr (SP2) {
        PG8_STAGE(PG8_SB(0, 0), cB, voffB); PG8_STAGE(PG8_SB(0, 1), cB + hstep, voffB); PG8_STAGE_A(PG8_SA(0, 0), cA, 0, cvo); PG8_STAGE_A(PG8_SA(0, 1), cA, 1, cvo);
        if (wr == 1) PG8_BAR;
        PG8_WAIT_V(2); PG8_BAR;
        PG8_STAGE(PG8_SB(1, 0), cB + kstep, voffB); PG8_STAGE_A(PG8_SA(1, 0), cA + kstep, 0, cvo); PG8_STAGE(PG8_SB(1, 1), cB + hstep + kstep, voffB);
        PG8_WAIT_V(6); PG8_BAR;
    } else {
        PG8_STAGE(PG8_SB(0, 0), cB, voffB); PG8_STAGE_A(PG8_SA(0, 0), cA, 0, cvo); PG8_STAGE(PG8_SB(0, 1), cB + hstep, voffB); PG8_STAGE_A(PG8_SA(0, 1), cA, 1, cvo);
        if (wr == 1) PG8_BAR;
        PG8_WAIT_V(4); PG8_BAR;
        PG8_STAGE(PG8_SB(1, 0), cB + kstep, voffB); PG8_STAGE_A(PG8_SA(1, 0), cA + kstep, 0, cvo); PG8_STAGE(PG8_SB(1, 1), cB + hstep + kstep, voffB);
        PG8_WAIT_V(6); PG8_BAR;
    }
    for (;;) {
        const bool has_next = S.next(ui + 1, nxt);
        const char* nA = GATHER ? cA : (has_next ? (const char*)g.A + (size_t)nxt.pm * tstep : cA); const char* nB = has_next ? (const char*)g.Bt + (size_t)nxt.pn * tstep : cB;
        if constexpr (GATHER) { if (has_next) { PG8_GOFF(nvo, nxt); } else {
#pragma unroll
            for (int h = 0; h < 2; ++h)
#pragma unroll
                for (int i = 0; i < 2; ++i) nvo[h][i] = cvo[h][i]; } }
        const char* cA2 = DUAL ? (const char*)g.A2 + (size_t)cur.pm * tstep2 : cA; const char* cB2 = DUAL ? (const char*)g.Bt2 + (size_t)cur.pn * tstep2 : cB;
        for (int t = 0; t < nt; t += 2) {
            const bool last = (t == nt - 2);
            const bool s1 = DUAL && (t + 1 >= nt1), s2 = DUAL && !last && (t + 2 >= nt1);
            const char* a1 = s1 ? cA2 + (size_t)(t + 1 - nt1) * kstep : cA + (size_t)(t + 1) * kstep;
            const char* a2 = last ? nA : (s2 ? cA2 + (size_t)(t + 2 - nt1) * kstep : cA + (size_t)(t + 2) * kstep);
            const char* b2 = last ? nB : (s2 ? cB2 + (size_t)(t + 2 - nt1) * kstep : cB + (size_t)(t + 2) * kstep);
            const char* a3 = a2 + kstep; const char* b3 = b2 + kstep;
            const size_t hs1 = s1 ? hstep2 : hstep, hs2 = s2 ? hstep2 : hstep;
            unsigned vA1[2], vA2[2], vB2[2];
#pragma unroll
            for (int i = 0; i < 2; ++i) { vA1[i] = s1 ? voffA2[i] : voffA[i]; vA2[i] = s2 ? voffA2[i] : voffA[i]; vB2[i] = s2 ? voffB2[i] : voffB[i]; }
            unsigned svo[2][2];
#pragma unroll
            for (int h = 0; h < 2; ++h)
#pragma unroll
                for (int i = 0; i < 2; ++i) svo[h][i] = last ? nvo[h][i] : cvo[h][i];
            if constexpr (SP2) {
            PG8_LDB(B0, 0, 0); PG8_LDB(B1, 0, 1); PG8_SCHED; PG8_LDA(At, 0, 0); PG8_STAGE_AX(PG8_SA(1, 1), a1, 1, cvo, hs1, vA1);
            PG8_WAIT_V(8); PG8_WAIT_L(0); PG8_BAR; PG8_MMA(0, 0, At, B0); PG8_MMA(0, 1, At, B1); PG8_BAR; PG8_SCHED;
            PG8_LDA(At, 0, 1); PG8_STAGE(PG8_SB(0, 0), b2, vB2); PG8_STAGE(PG8_SB(0, 1), b2 + hs2, vB2); PG8_STAGE_AX(PG8_SA(0, 0), a2, 0, svo, hs2, vA2);
            PG8_WAIT_V(8); PG8_WAIT_L(0); PG8_BAR; PG8_MMA(1, 0, At, B0); PG8_MMA(1, 1, At, B1); PG8_BAR; PG8_SCHED;
            PG8_LDB(B0, 1, 0); PG8_LDB(B1, 1, 1); PG8_SCHED; PG8_LDA(At, 1, 0); PG8_STAGE_AX(PG8_SA(0, 1), a2, 1, svo, hs2, vA2);
            PG8_WAIT_V(8); PG8_WAIT_L(0); PG8_BAR; PG8_MMA(0, 0, At, B0); PG8_MMA(0, 1, At, B1); PG8_BAR; PG8_SCHED;
            PG8_LDA(At, 1, 1); PG8_STAGE(PG8_SB(1, 0), b3, vB2); PG8_STAGE(PG8_SB(1, 1), b3 + hs2, vB2); PG8_STAGE_AX(PG8_SA(1, 0), a3, 0, svo, hs2, vA2);
            PG8_WAIT_V(8); PG8_WAIT_L(0); PG8_BAR; PG8_MMA(1, 0, At, B0); PG8_MMA(1, 1, At, B1); PG8_BAR; PG8_SCHED;
            } else {
            PG8_LDB(B0, 0, 0); PG8_SCHED; PG8_LDA(At, 0, 0); PG8_STAGE_AX(PG8_SA(1, 1), a1, 1, cvo, hs1, vA1);
            PG8_WAIT_L(8); PG8_BAR; PG8_WAIT_L(0); PG8_MMA(0, 0, At, B0); PG8_BAR; PG8_SCHED;
            PG8_LDB(B1, 0, 1); PG8_STAGE(PG8_SB(0, 0), b2, vB2);
            PG8_BAR; PG8_WAIT_L(0); PG8_MMA(0, 1, At, B1); PG8_BAR;
            PG8_LDA(At, 0, 1); PG8_STAGE_AX(PG8_SA(0, 0), a2, 0, svo, hs2, vA2);
            PG8_BAR; PG8_WAIT_L(0); PG8_MMA(1, 0, At, B0); PG8_BAR; PG8_SCHED;
            PG8_STAGE(PG8_SB(0, 1), b2 + hs2, vB2);
            PG8_WAIT_V(6); PG8_BAR; PG8_MMA(1, 1, At, B1); PG8_BAR;
            PG8_LDB(B0, 1, 0); PG8_SCHED; PG8_LDA(At, 1, 0); PG8_STAGE_AX(PG8_SA(0, 1), a2, 1, svo, hs2, vA2);
            PG8_WAIT_L(8); PG8_BAR; PG8_WAIT_L(0); PG8_MMA(0, 0, At, B0); PG8_BAR; PG8_SCHED;
            PG8_LDB(B1, 1, 1); PG8_STAGE(PG8_SB(1, 0), b3, vB2);
            PG8_BAR; PG8_WAIT_L(0); PG8_MMA(0, 1, At, B1); PG8_BAR;
            PG8_LDA(At, 1, 1); PG8_STAGE_AX(PG8_SA(1, 0), a3, 0, svo, hs2, vA2);
            PG8_BAR; PG8_WAIT_L(0); PG8_MMA(1, 0, At, B0); PG8_BAR; PG8_SCHED;
            PG8_STAGE(PG8_SB(1, 1), b3 + hs2, vB2);
            PG8_WAIT_V(6); PG8_BAR; PG8_MMA(1, 1, At, B1); PG8_BAR;
            }
            if constexpr (DUAL) { if (t + 2 == nt1) E.mid(acc, cur, wr, wc, fr, fq); }
        }
        if constexpr (ALIGN_EPI) { if (wr == 0) PG8_BAR; }
        E(acc, cur, wr, wc, fr, fq);
        if (!has_next) break;
#pragma unroll
        for (int a = 0; a < 2; ++a)
#pragma unroll
            for (int b = 0; b < 2; ++b)
#pragma unroll
                for (int m = 0; m < 4; ++m)
#pragma unroll
                    for (int n = 0; n < 2; ++n) acc[a][b][m][n] = (f32x4){0.f, 0.f, 0.f, 0.f};
        cur = nxt; cA = nA; cB = nB; ++ui;
#pragma unroll
        for (int h = 0; h < 2; ++h)
#pragma unroll
            for (int i = 0; i < 2; ++i) cvo[h][i] = nvo[h][i];
        if constexpr (ALIGN_EPI) { if (wr == 1) PG8_BAR; }
    }
    PG8_WAIT_V(0);
    if constexpr (!ALIGN_EPI) { if (wr == 0) PG8_BAR; }
    PG8_BAR;
#undef PG8_SA
#undef PG8_SB
#undef PG8_STAGE
#undef PG8_STAGE_A
#undef PG8_STAGE_AX
#undef PG8_LDA
#undef PG8_LDB
#undef PG8_MMA
#undef PG8_WAIT_V
#undef PG8_WAIT_L
#undef PG8_BAR
#undef PG8_SCHED
#undef PG8_GOFF
}
}

constexpr size_t MiB = 1u << 20;
constexpr size_t WS_CTL = 0, CTL_ZERO_BYTES = 1 * MiB;
constexpr size_t WS_HMETA = 1 * MiB;
constexpr size_t WS_UMETA = WS_HMETA + 128 * 1024;
constexpr size_t WS_KMETA = WS_HMETA + 256 * 1024;
constexpr size_t WS_VMETA = WS_HMETA + 384 * 1024;
constexpr size_t WS_SSMAB = WS_HMETA + 512 * 1024;
constexpr size_t WS_SSMBB = WS_HMETA + 576 * 1024;
constexpr size_t WS_WRT = 2 * MiB;
constexpr size_t WS_WIN = 3 * MiB;
constexpr size_t WS_WGLU = 33 * MiB;
constexpr size_t WS_WBS = 34 * MiB;
constexpr size_t WS_WBA = 36 * MiB;
constexpr size_t WS_WO = 40 * MiB;
constexpr size_t WS_WUP = 48 * MiB;
constexpr size_t WS_WDN = 176 * MiB;
constexpr size_t WS_HBF = 240 * MiB;
constexpr size_t WS_U = 368 * MiB;
constexpr size_t WS_Q = 400 * MiB;
constexpr size_t WS_K = 464 * MiB;
constexpr size_t WS_V = 528 * MiB;
constexpr size_t WS_SGS = 592 * MiB;
constexpr size_t WS_SGA = 720 * MiB;
constexpr size_t WS_YPRE = 848 * MiB;
constexpr size_t WS_YSSM = 880 * MiB;
constexpr size_t WS_YATT = 912 * MiB;
constexpr size_t WS_END = 976 * MiB;
constexpr size_t WS_Z = 368 * MiB;
constexpr size_t WS_H1 = 624 * MiB;
constexpr size_t WS_HB = 752 * MiB;
constexpr size_t WS_YK = 368 * MiB;
constexpr size_t WS_LIST = 848 * MiB;
constexpr size_t WS_WGT = 852 * MiB;
constexpr size_t WS_POSE = 853 * MiB;
constexpr size_t WS_POSW = 854 * MiB;
constexpr int CW_ECNT = 64;
constexpr int CW_BAR = 4096;

constexpr int RING_BYTES = 131072;
constexpr int MISC_OFF = RING_BYTES;
constexpr int LDS_BYTES = 139264;

#define XB_TMO      128
#define XB_XCNT(j)  (256  + 64 * (j))
#define XB_XSUB(j)  (1280 + 64 * (j))
#define XB_XGEN(j)  (2304 + 64 * (j))
#define XB_TOP      3328
#define XB_TOPGEN   3392
#define XCD_BAR_WORDS 3456
#define XB_SPIN_CAP (1u << 18)
__device__ __forceinline__ unsigned xb_ld(unsigned* p)              { return __hip_atomic_load(p, __ATOMIC_RELAXED, __HIP_MEMORY_SCOPE_AGENT); }
__device__ __forceinline__ unsigned xb_add(unsigned* p, unsigned v) { return __hip_atomic_fetch_add(p, v, __ATOMIC_RELAXED, __HIP_MEMORY_SCOPE_AGENT); }
__device__ __forceinline__ unsigned xb_xcc_id() { return (unsigned)__builtin_amdgcn_s_getreg((3 << 11) | 20) & 0xFu; }
#define XB_SPIN(cond, bar) do { unsigned _sp = 0; while (cond) { __builtin_amdgcn_s_sleep(1); \
    if ((++_sp & 255u) == 0u) { if (xb_ld(&(bar)[XB_TMO])) break; if (_sp > XB_SPIN_CAP) { atomicAdd(&(bar)[XB_TMO], 1u); break; } } } } while (0)
struct XcdBarrier { unsigned* bar; unsigned x; volatile LAS unsigned* st; };
__device__ __forceinline__ XcdBarrier xcd_barrier_post(unsigned* bar, volatile LAS unsigned* st) {
    XcdBarrier b; b.bar = bar; b.x = xb_xcc_id(); b.st = st;
    if (threadIdx.x == 0) (void)xb_add(&bar[XB_XCNT(b.x)], 1u);
    return b;
}
__device__ __forceinline__ void xcd_barrier_complete(unsigned* bar, unsigned x, unsigned& nloc, unsigned& nx) {
    const unsigned G = gridDim.x * gridDim.y * gridDim.z;
    unsigned sum, cnt, mine, sp = 0u;
    for (;;) {
        sum = 0u; cnt = 0u; mine = 0u;
#pragma unroll
        for (unsigned j = 0; j < 16; ++j) { const unsigned c = xb_ld(&bar[XB_XCNT(j)]); sum += c; cnt += (c > 0u) ? 1u : 0u; mine = (j == x) ? c : mine; }
        if (sum == G) break;
        __builtin_amdgcn_s_sleep(1);
        if ((++sp & 255u) == 0u) { if (xb_ld(&bar[XB_TMO])) break; if (sp > XB_SPIN_CAP) { atomicAdd(&bar[XB_TMO], 1u); break; } }
    }
    nloc = mine > 0u ? mine : 1u; nx = cnt > 0u ? cnt : 1u;
}
__device__ __forceinline__ void xcd_barrier(const XcdBarrier& b) {
    asm volatile("s_waitcnt vmcnt(0)" ::: "memory");
    __syncthreads();
    if (threadIdx.x == 0) {
        unsigned* bar = b.bar;
        __builtin_amdgcn_s_waitcnt(0);
        unsigned nloc = b.st[0], nx = b.st[1];
        if (nloc == 0u) { xcd_barrier_complete(bar, b.x, nloc, nx); b.st[0] = nloc; b.st[1] = nx; }
        const unsigned old = xb_add(&bar[XB_XSUB(b.x)], 1u);
        const unsigned gen = old / nloc;
        if (old + 1u == (gen + 1u) * nloc) {
            __builtin_amdgcn_fence(__ATOMIC_RELEASE, "agent");
            asm volatile("s_waitcnt vmcnt(0)" ::: "memory");
            const unsigned og = xb_add(&bar[XB_TOP], 1u);
            const unsigned tg = og / nx;
            if (og + 1u == (tg + 1u) * nx) xb_add(&bar[XB_TOPGEN], 1u);
            else XB_SPIN(xb_ld(&bar[XB_TOPGEN]) == tg, bar);
            __builtin_amdgcn_fence(__ATOMIC_ACQUIRE, "agent");
            xb_add(&bar[XB_XGEN(b.x)], 1u);
            asm volatile("s_waitcnt vmcnt(0)" ::: "memory");
        } else {
            XB_SPIN(xb_ld(&bar[XB_XGEN(b.x)]) == gen, bar);
            __builtin_amdgcn_fence(__ATOMIC_ACQUIRE, "agent");
            asm volatile("s_waitcnt vmcnt(0)" ::: "memory");
        }
    }
    __syncthreads();
}

using pg8::Unit;
__device__ __forceinline__ u32x4 pack8(const f32x4 v0, const f32x4 v1) { u32x4 w; w.x = cvt_pk_bf16(v0[0], v0[1]); w.y = cvt_pk_bf16(v0[2], v0[3]); w.z = cvt_pk_bf16(v1[0], v1[1]); w.w = cvt_pk_bf16(v1[2], v1[3]); return w; }
__device__ __forceinline__ void unpack8(const u32x4 w, f32x4& v0, f32x4& v1) { v0 = (f32x4){bf_lo(w.x), bf_hi(w.x), bf_lo(w.y), bf_hi(w.y)}; v1 = (f32x4){bf_lo(w.z), bf_hi(w.z), bf_lo(w.w), bf_hi(w.w)}; }

struct EpiProj {
    static constexpr bool PERM = true;
    bf16_t *U, *Q, *K, *V, *RHO, *SGA;
    __device__ __forceinline__ void operator()(const f32x4 (&acc)[2][2][4][2], const Unit& u, int wr, int wc, int fr, int fq) const {
        const int pn = u.pn;
        if (pn >= 14) {
            const int row0 = u.pm * 256 + wr * 64 + fr, col0 = (pn - 14) * 128 + wc * 32 + 8 * fq;
#pragma unroll
            for (int ai = 0; ai < 2; ++ai)
#pragma unroll
                for (int m = 0; m < 4; ++m) { const size_t off = (size_t)(row0 + ai * 128 + m * 16) * DM + col0; f32x4 r0, r1, a0, a1;
#pragma unroll
                    for (int j = 0; j < 4; ++j) { const float es0 = __expf(-acc[ai][0][m][0][j]), es1 = __expf(-acc[ai][0][m][1][j]), ea0 = __expf(-acc[ai][1][m][0][j]), ea1 = __expf(-acc[ai][1][m][1][j]);
                        a0[j] = __builtin_amdgcn_rcpf(1.f + ea0); a1[j] = __builtin_amdgcn_rcpf(1.f + ea1);
                        r0[j] = (1.f + ea0) * __builtin_amdgcn_rcpf(1.f + es0); r1[j] = (1.f + ea1) * __builtin_amdgcn_rcpf(1.f + es1); }
                    *(u32x4*)(RHO + off) = pack8(r0, r1); *(u32x4*)(SGA + off) = pack8(a0, a1); }
            return;
        }
        bf16_t* base; int ldc, ct, mode;
        if (pn < 2) { base = U; ldc = 512; ct = pn; mode = 0; }
        else if (pn < 6) { base = Q; ldc = 1024; ct = pn - 2; mode = 1; }
        else if (pn < 10) { base = K; ldc = 1024; ct = pn - 6; mode = 0; }
        else { base = V; ldc = 1024; ct = pn - 10; mode = 0; }
        const int row0 = u.pm * 256 + wr * 64 + fr, col0 = ct * 256 + wc * 32 + 8 * fq;
#pragma unroll
        for (int ai = 0; ai < 2; ++ai)
#pragma unroll
            for (int m = 0; m < 4; ++m) { bf16_t* rowp = base + (size_t)(row0 + ai * 128 + m * 16) * ldc + col0;
#pragma unroll
                for (int bj = 0; bj < 2; ++bj) { f32x4 v0 = acc[ai][bj][m][0], v1 = acc[ai][bj][m][1];
                    if (mode == 1) { v0 = v0 * QSCALE; v1 = v1 * QSCALE; }
                    *(u32x4*)(rowp + bj * 128) = pack8(v0, v1); } }
    }
};
struct EpiGlu {
    static constexpr bool PERM = true;
    const bf16_t* YPRE; bf16_t* YSSM;
    __device__ __forceinline__ void operator()(const f32x4 (&acc)[2][2][4][2], const Unit& u, int wr, int wc, int fr, int fq) const {
        const int row0 = u.pm * 256 + wr * 64 + fr, col0 = u.pn * 256 + wc * 32 + 8 * fq;
#pragma unroll
        for (int ai = 0; ai < 2; ++ai)
#pragma unroll
            for (int m = 0; m < 4; ++m) { const size_t off = (size_t)(row0 + ai * 128 + m * 16) * SSMW + col0;
#pragma unroll
                for (int bj = 0; bj < 2; ++bj) { const u32x4 yw = *(const u32x4*)(YPRE + off + bj * 128); f32x4 y0, y1; unpack8(yw, y0, y1);
                    f32x4 v0 = acc[ai][bj][m][0], v1 = acc[ai][bj][m][1];
#pragma unroll
                    for (int j = 0; j < 4; ++j) { v0[j] = y0[j] * sigmoidf_(v0[j]); v1[j] = y1[j] * sigmoidf_(v1[j]); }
                    *(u32x4*)(YSSM + off + bj * 128) = pack8(v0, v1); } }
    }
};
template <int SECOND> struct EpiMerge {
    static constexpr bool PERM = true;
    const bf16_t* SG; bf16_t* MG;
    __device__ __forceinline__ void operator()(const f32x4 (&acc)[2][2][4][2], const Unit& u, int wr, int wc, int fr, int fq) const {
        const int row0 = u.pm * 256 + wr * 64 + fr, col0 = u.pn * 256 + wc * 32 + 8 * fq;
#pragma unroll
        for (int ai = 0; ai < 2; ++ai)
#pragma unroll
            for (int m = 0; m < 4; ++m) { const size_t off = (size_t)(row0 + ai * 128 + m * 16) * DM + col0;
#pragma unroll
                for (int bj = 0; bj < 2; ++bj) { const u32x4 gw = *(const u32x4*)(SG + off + bj * 128); f32x4 g0, g1; unpack8(gw, g0, g1);
                    f32x4 v0 = acc[ai][bj][m][0] * g0, v1 = acc[ai][bj][m][1] * g1;
                    if (SECOND) { const u32x4 pw = *(const u32x4*)(MG + off + bj * 128); f32x4 p0, p1; unpack8(pw, p0, p1); v0 = v0 + p0; v1 = v1 + p1; }
                    *(u32x4*)(MG + off + bj * 128) = pack8(v0, v1); } }
    }
};
struct EpiMergeF {
    static constexpr bool PERM = true;
    const bf16_t* SGS; const bf16_t* SGA; bf16_t* MG;
    __device__ __forceinline__ void mid(f32x4 (&acc)[2][2][4][2], const Unit& u, int wr, int wc, int fr, int fq) const {
        asm volatile("" : "+v"(fr), "+v"(fq));
        const int row0 = u.pm * 256 + wr * 64 + fr, col0 = u.pn * 256 + wc * 32 + 8 * fq;
#pragma unroll
        for (int ai = 0; ai < 2; ++ai)
#pragma unroll
            for (int m = 0; m < 4; ++m) { const size_t off = (size_t)(row0 + ai * 128 + m * 16) * DM + col0;
#pragma unroll
                for (int bj = 0; bj < 2; ++bj) { const u32x4 sw = *(const u32x4*)(SGS + off + bj * 128);
                    f32x4 s0, s1; unpack8(sw, s0, s1);
                    acc[ai][bj][m][0] = acc[ai][bj][m][0] * s0; acc[ai][bj][m][1] = acc[ai][bj][m][1] * s1; }
                asm volatile("" ::: "memory"); }
    }
    __device__ __forceinline__ void operator()(const f32x4 (&acc)[2][2][4][2], const Unit& u, int wr, int wc, int fr, int fq) const {
        const int row0 = u.pm * 256 + wr * 64 + fr, col0 = u.pn * 256 + wc * 32 + 8 * fq;
#pragma unroll
        for (int ai = 0; ai < 2; ++ai)
#pragma unroll
            for (int m = 0; m < 4; ++m) { const size_t off = (size_t)(row0 + ai * 128 + m * 16) * DM + col0;
#pragma unroll
                for (int bj = 0; bj < 2; ++bj) { const u32x4 gw = *(const u32x4*)(SGA + off + bj * 128); f32x4 g0, g1; unpack8(gw, g0, g1);
                    *(u32x4*)(MG + off + bj * 128) = pack8(acc[ai][bj][m][0] * g0, acc[ai][bj][m][1] * g1); } }
    }
};
struct EpiZ {
    static constexpr bool PERM = true;
    const bf16_t* HBF; bf16_t* Z;
    __device__ __forceinline__ void operator()(const f32x4 (&acc)[2][2][4][2], const Unit& u, int wr, int wc, int fr, int fq) const {
        const int row0 = u.pm * 256 + wr * 64 + fr, col0 = u.pn * 256 + wc * 32 + 8 * fq;
#pragma unroll
        for (int ai = 0; ai < 2; ++ai)
#pragma unroll
            for (int m = 0; m < 4; ++m) { const size_t off = (size_t)(row0 + ai * 128 + m * 16) * DM + col0;
#pragma unroll
                for (int bj = 0; bj < 2; ++bj) { const u32x4 hw = *(const u32x4*)(HBF + off + bj * 128); f32x4 h0, h1; unpack8(hw, h0, h1);
                    *(u32x4*)(Z + off + bj * 128) = pack8(acc[ai][bj][m][0] + h0 * ALPHA, acc[ai][bj][m][1] + h1 * ALPHA); } }
    }
};
struct EpiSwiglu {
    static constexpr bool PERM = true;
    bf16_t* HB; const int* LIST; const float* WGT; int* POSE; float* POSW;
    __device__ __forceinline__ void operator()(const f32x4 (&acc)[2][2][4][2], const Unit& u, int wr, int wc, int fr, int fq) const {
        const int row0 = u.pm * 256 + wr * 64 + fr, col0 = (u.pn & 3) * 128 + wc * 32 + 8 * fq;
#pragma unroll
        for (int ai = 0; ai < 2; ++ai)
#pragma unroll
            for (int m = 0; m < 4; ++m) { f32x4 v0, v1;
#pragma unroll
                for (int j = 0; j < 4; ++j) { const float g0 = acc[ai][0][m][0][j], g1 = acc[ai][0][m][1][j];
                    v0[j] = g0 * sigmoidf_(g0) * acc[ai][1][m][0][j]; v1[j] = g1 * sigmoidf_(g1) * acc[ai][1][m][1][j]; }
                *(u32x4*)(HB + (size_t)(row0 + ai * 128 + m * 16) * DFF + col0) = pack8(v0, v1); }
        if ((u.pn & 3) == 0 && wc == 0 && fq == 0) {
#pragma unroll
            for (int ai = 0; ai < 2; ++ai)
#pragma unroll
                for (int m = 0; m < 4; ++m) { const int r = wr * 64 + fr + ai * 128 + m * 16, slot = u.s0 + r; int entry = -1; float w = 0.f;
                    if (slot < u.cnt) { entry = LIST[(size_t)u.e * CAP + slot]; w = WGT[entry]; }
                    POSE[u.pm * 256 + r] = entry; POSW[u.pm * 256 + r] = w; }
        }
    }
};
struct EpiDown {
    static constexpr bool PERM = true;
    const int* POSE; const float* POSW; bf16_t* YK;
    __device__ __forceinline__ void operator()(const f32x4 (&acc)[2][2][4][2], const Unit& u, int wr, int wc, int fr, int fq) const {
        const int r0 = u.pm * 256 + wr * 64 + fr, col0 = (u.pn & 7) * 256 + wc * 32 + 8 * fq;
        int en[2][4]; float ww[2][4];
#pragma unroll
        for (int ai = 0; ai < 2; ++ai)
#pragma unroll
            for (int m = 0; m < 4; ++m) { en[ai][m] = POSE[r0 + ai * 128 + m * 16]; ww[ai][m] = POSW[r0 + ai * 128 + m * 16]; }
#pragma unroll
        for (int ai = 0; ai < 2; ++ai)
#pragma unroll
            for (int m = 0; m < 4; ++m) {
                if (en[ai][m] >= 0) { const float w = ww[ai][m]; bf16_t* rowp = YK + (size_t)en[ai][m] * DM + col0;
#pragma unroll
                    for (int bj = 0; bj < 2; ++bj) *(u32x4*)(rowp + bj * 128) = pack8(acc[ai][bj][m][0] * w, acc[ai][bj][m][1] * w); } }
    }
};
struct MoeOrder {
    int G, c, shift, NB; const LAS int* blkexp; const LAS int* blkstart; const LAS int* cntE; const int* LIST;
    __device__ __forceinline__ bool next(int i, Unit& u) const {
        const long L = (long)i * G + c; if (L >= ((long)NB << shift)) return false;
        const int blk = (int)(L >> shift), tile = (int)(L & ((1 << shift) - 1)), e = blkexp[blk];
        u.pm = blk; u.pn = (e << shift) + tile; u.e = e; u.s0 = (blk - blkstart[e]) * 256; u.cnt = cntE[e]; return true;
    }
    __device__ __forceinline__ int arow(const Unit& u, int r) const { const int slot = u.s0 + r; const int entry = slot < u.cnt ? LIST[(size_t)u.e * CAP + slot] : 0; return entry >> 1; }
};

struct Ctx { LAS unsigned char* lds; int tid, lane, wave, vcu, G; };

__device__ __forceinline__ void transpose_item(const float* W, int K, int N, bf16_t* WT, int kb, int nb, int dst_row0, LAS float* scr, int lane) {
    const int k0 = 64 * kb, n0 = 32 * nb;
#pragma unroll 8
    for (int i = 0; i < 32; ++i) { const int kk = 2 * i + (lane >> 5); scr[kk * 33 + (lane & 31)] = W[(size_t)(k0 + kk) * N + n0 + (lane & 31)]; }
    asm volatile("s_waitcnt lgkmcnt(0)" ::: "memory");
    const int c = lane & 7;
#pragma unroll
    for (int j = 0; j < 4; ++j) { const int n = (lane >> 3) + 8 * j; const LAS float* s = scr + (8 * c) * 33 + n;
        u32x4 o; o.x = cvt_pk_bf16(s[0 * 33], s[1 * 33]); o.y = cvt_pk_bf16(s[2 * 33], s[3 * 33]); o.z = cvt_pk_bf16(s[4 * 33], s[5 * 33]); o.w = cvt_pk_bf16(s[6 * 33], s[7 * 33]);
        *(u32x4*)(WT + (size_t)(dst_row0 + n) * K + k0 + 8 * c) = o; }
    asm volatile("s_waitcnt lgkmcnt(0)" ::: "memory");
}
__device__ __forceinline__ void ln_stats(f32x4 (&v)[8], float& mean, float& rstd) {
    float s = 0.f;
#pragma unroll
    for (int j = 0; j < 8; ++j) s += (v[j].x + v[j].y) + (v[j].z + v[j].w);
    mean = wave_sum(s) * (1.f / DM); float s2 = 0.f;
#pragma unroll
    for (int j = 0; j < 8; ++j) { const f32x4 d = v[j] - mean; s2 += (d.x * d.x + d.y * d.y) + (d.z * d.z + d.w * d.w); }
    rstd = 1.f / sqrtf(wave_sum(s2) * (1.f / DM) + LN_EPS);
}

__device__ __forceinline__ void p0_prologue(const Ctx& C, const float* const* in, unsigned char* ws) {
    LAS float* scr = (LAS float*)(C.lds + C.wave * 16384);
    const int gw = C.vcu * 8 + C.wave, NGW = C.G * 8;
    bf16_t* WinT = (bf16_t*)(ws + WS_WIN); bf16_t* WgluT = (bf16_t*)(ws + WS_WGLU); bf16_t* WbsT = (bf16_t*)(ws + WS_WBS); bf16_t* WbaT = (bf16_t*)(ws + WS_WBA);
    bf16_t* WoT = (bf16_t*)(ws + WS_WO); bf16_t* WupT = (bf16_t*)(ws + WS_WUP); bf16_t* WdnT = (bf16_t*)(ws + WS_WDN);
    constexpr int I_WIN = (DM / 64) * (INC / 32), I_GLU = (SSMW / 64) * (SSMW / 32), I_BS = (SSMW / 64) * (DM / 32), I_BA = (AW / 64) * (DM / 32), I_WO = (DM / 64) * (DM / 32);
    constexpr int I_EXP = NE * 512;
    constexpr int NITEMS = I_WIN + I_GLU + I_BS + I_BA + I_WO + 3 * I_EXP;
    for (int it = gw; it < NITEMS; it += NGW) {
        int r = it;
        if (r < I_WIN) { const int nblk = INC / 32, nb = r % nblk, n0 = 32 * nb;
            const int drow = n0 < 3584 ? n0 : (n0 < 5632 ? 3584 + ((n0 - 3584) >> 7) * 256 + ((n0 - 3584) & 127) : 3584 + ((n0 - 5632) >> 7) * 256 + 128 + ((n0 - 5632) & 127));
            transpose_item(in[4], DM, INC, WinT, r / nblk, nb, drow, scr, C.lane); continue; } r -= I_WIN;
        if (r < I_GLU) { const int nblk = SSMW / 32; transpose_item(in[13], SSMW, SSMW, WgluT, r / nblk, r % nblk, 32 * (r % nblk), scr, C.lane); continue; } r -= I_GLU;
        if (r < I_BS) { const int nblk = DM / 32; transpose_item(in[19], SSMW, DM, WbsT, r / nblk, r % nblk, 32 * (r % nblk), scr, C.lane); continue; } r -= I_BS;
        if (r < I_BA) { const int nblk = DM / 32; transpose_item(in[20], AW, DM, WbaT, r / nblk, r % nblk, 32 * (r % nblk), scr, C.lane); continue; } r -= I_BA;
        if (r < I_WO) { const int nblk = DM / 32; transpose_item(in[21], DM, DM, WoT, r / nblk, r % nblk, 32 * (r % nblk), scr, C.lane); continue; } r -= I_WO;
        if (r < 2 * I_EXP) { const int up = r >= I_EXP ? 1 : 0; r -= up * I_EXP; const int e = r >> 9, rr = r & 511, kb = rr >> 4, nb = rr & 15, n0 = 32 * nb;
            transpose_item(in[28 + up] + (size_t)e * DM * DFF, DM, DFF, WupT, kb, nb, e * 1024 + (n0 >> 7) * 256 + up * 128 + (n0 & 127), scr, C.lane); continue; }
        r -= 2 * I_EXP;
        { const int e = r >> 9, rr = r & 511, kb = rr >> 6, nb = rr & 63; transpose_item(in[30] + (size_t)e * DFF * DM, DFF, DM, WdnT, kb, nb, e * 2048 + 32 * nb, scr, C.lane); }
    }
    const int gt = C.vcu * 512 + C.tid, NGT = C.G * 512;
    { float* WrT = (float*)(ws + WS_WRT);
      for (int i = gt; i < 36 * DM; i += NGT) { const int n = i / DM, k = i % DM; WrT[i] = n < 4 ? in[24][k * 4 + n] : in[26][k * 32 + (n - 4)]; } }
    { u32x4* kz = (u32x4*)(ws + WS_KMETA + 16 * 1024 * 2); u32x4* vz = (u32x4*)(ws + WS_VMETA + 16 * 1024 * 2);
      for (int i = gt; i < 48 * 1024 * 2 / 16; i += NGT) { kz[i] = (u32x4){0u, 0u, 0u, 0u}; vz[i] = (u32x4){0u, 0u, 0u, 0u}; } }
    { float* AB = (float*)(ws + WS_SSMAB); float* BB = (float*)(ws + WS_SSMBB);
      for (int i = gt; i < NGRP * NST; i += NGT) { const int g = i >> 6;
        const double lre = fmin((double)in[5][i], -1e-4), lim = (double)in[6][i], dt = exp((double)in[7][g]);
        const double mag = exp(lre * dt), abr = mag * cos(lim * dt), abi = mag * sin(lim * dt), den = lre * lre + lim * lim, nr = abr - 1.0, ni = abi;
        const double zr = (nr * lre + ni * lim) / den, zi = (ni * lre - nr * lim) / den;
        AB[i] = (float)abr; AB[NGRP * NST + i] = (float)abi;
#pragma unroll 4
        for (int c = 0; c < 16; ++c) { const double br = (double)in[8][i * 16 + c], bi = (double)in[9][i * 16 + c];
            BB[i * 16 + c] = (float)(zr * br - zi * bi); BB[NGRP * NST * 16 + i * 16 + c] = (float)(zr * bi + zi * br); } } }
    const float* lg = in[2]; const float* lb = in[3];
    bf16_t* HBF = (bf16_t*)(ws + WS_HBF);
    for (int m = gw; m < T + NMETA; m += NGW) {
        const bool meta = m >= T; const float* xrow = meta ? in[1] + (size_t)(m - T) * DM : in[0] + (size_t)m * DM;
        f32x4 v[8];
#pragma unroll
        for (int j = 0; j < 8; ++j) v[j] = *(const f32x4*)(xrow + 256 * j + 4 * C.lane);
        float mean, rstd; ln_stats(v, mean, rstd);
#pragma unroll
        for (int j = 0; j < 8; ++j) { const f32x4 gg = *(const f32x4*)(lg + 256 * j + 4 * C.lane), bb = *(const f32x4*)(lb + 256 * j + 4 * C.lane);
            const f32x4 o = (v[j] - mean) * rstd * gg + bb;
            if (meta) *(f32x4*)((float*)(ws + WS_HMETA) + (size_t)(m - T) * DM + 256 * j + 4 * C.lane) = o;
            else { u32x2 w; w.x = cvt_pk_bf16(o.x, o.y); w.y = cvt_pk_bf16(o.z, o.w); *(u32x2*)(HBF + (size_t)m * DM + 256 * j + 4 * C.lane) = w; } }
    }
}

__device__ __forceinline__ void p1_meta_proj(const Ctx& C, unsigned char* ws) {
    const bf16_t* WinT = (const bf16_t*)(ws + WS_WIN); const float* HM = (const float*)(ws + WS_HMETA);
    const int gw = C.vcu * 8 + C.wave, NGW = C.G * 8;
    for (int it = gw; it < 640; it += NGW) {
        const int nidx = 4 * it; const int col0 = nidx < 512 ? nidx : (nidx < 1536 ? 1536 + (nidx - 512) : 2560 + (nidx - 1536));
        float acc[16][4];
#pragma unroll
        for (int r = 0; r < 16; ++r)
#pragma unroll
            for (int c = 0; c < 4; ++c) acc[r][c] = 0.f;
#pragma unroll 1
        for (int j = 0; j < 4; ++j) { const int k0 = j * 512 + C.lane * 8;
            f32x4 w0[4], w1[4];
#pragma unroll
            for (int c = 0; c < 4; ++c) { const u32x4 ww = *(const u32x4*)(WinT + (size_t)(col0 + c) * DM + k0); unpack8(ww, w0[c], w1[c]); }
#pragma unroll
            for (int r = 0; r < 16; ++r) { const f32x4 h0 = *(const f32x4*)(HM + r * DM + k0), h1 = *(const f32x4*)(HM + r * DM + k0 + 4);
#pragma unroll
                for (int c = 0; c < 4; ++c) { const f32x4 p = h0 * w0[c] + h1 * w1[c]; acc[r][c] += (p.x + p.y) + (p.z + p.w); } } }
        float mine = 0.f;
#pragma unroll
        for (int r = 0; r < 16; ++r)
#pragma unroll
            for (int c = 0; c < 4; ++c) { const float s = wave_sum(acc[r][c]); mine = (C.lane == r * 4 + c) ? s : mine; }
        const int r = C.lane >> 2, c = C.lane & 3;
        if (nidx < 512) ((float*)(ws + WS_UMETA))[r * SSMW + nidx + c] = mine;
        else if (nidx < 1536) ((bf16_t*)(ws + WS_KMETA))[r * AW + (nidx - 512) + c] = (bf16_t)(cvt_pk_bf16(mine, 0.f) & 0xffffu);
        else ((bf16_t*)(ws + WS_VMETA))[r * AW + (nidx - 1536) + c] = (bf16_t)(cvt_pk_bf16(mine, 0.f) & 0xffffu);
    }
}

__device__ __forceinline__ float gelu_tanh(float x) { const float u = 1.5957691216057308f * (x + 0.044715f * x * x * x); return x / (1.0f + __expf(-u)); }
#define SC_HANDOFF(Q) do { _Pragma("unroll") for (int st_ = 0; st_ < 2; ++st_) { \
        auto rr_ = __builtin_amdgcn_permlane32_swap(__float_as_uint(sre[st_]), __float_as_uint(sre[st_]), false, false); sre[st_] = __uint_as_float(rr_[(Q) & 1]); \
        auto ri_ = __builtin_amdgcn_permlane32_swap(__float_as_uint(sim[st_]), __float_as_uint(sim[st_]), false, false); sim[st_] = __uint_as_float(ri_[(Q) & 1]); } } while (0)
template <bool STORE> __device__ __forceinline__ void scan_block(f32x16 (&buv)[4], float (&sre)[2], float (&sim)[2], const float (&are)[2], const float (&aim)[2], int hi) {
    float bu[4][16];
#pragma unroll
    for (int t = 0; t < 4; ++t)
#pragma unroll
        for (int r = 0; r < 16; ++r) bu[t][r] = buv[t][r];
#pragma unroll
    for (int q = 0; q < 8; ++q) {
        const bool act = (hi == (q & 1));
#pragma unroll
        for (int i = 0; i < 4; ++i) { const int reg = 4 * (q >> 1) + i;
#pragma unroll
            for (int st = 0; st < 2; ++st) {
                const float nre = are[st] * sre[st] - aim[st] * sim[st] + bu[st][reg];
                const float nim = are[st] * sim[st] + aim[st] * sre[st] + bu[2 + st][reg];
                sre[st] = nre; sim[st] = nim;
                if (STORE) { bu[st][reg] = act ? nre : bu[st][reg]; bu[2 + st][reg] = act ? nim : bu[2 + st][reg]; } } }
        SC_HANDOFF(q);
    }
    if (STORE) {
#pragma unroll
        for (int t = 0; t < 4; ++t)
#pragma unroll
            for (int r = 0; r < 16; ++r) buv[t][r] = bu[t][r];
    }
}
__device__ __forceinline__ void p2_scan(const Ctx& C, const float* const* in, unsigned char* ws) {
    const int lane = C.lane, wave = C.wave, r32 = lane & 31, hi = lane >> 5, fr = lane & 15, fq = lane >> 4;
    const bf16_t* U = (const bf16_t*)(ws + WS_U); const float* UM = (const float*)(ws + WS_UMETA); bf16_t* YPRE = (bf16_t*)(ws + WS_YPRE);
    const float* AB = (const float*)(ws + WS_SSMAB); const float* BB = (const float*)(ws + WS_SSMBB);
    LAS unsigned char* Sl = C.lds + wave * 8704;
    LAS float* E = (LAS float*)(C.lds + 69632);
    for (int item = C.vcu; item < NB_ * NGRP; item += C.G) {
        const int b = item >> 5, g = item & 31;
        float are[2], aim[2];
#pragma unroll
        for (int st = 0; st < 2; ++st) { are[st] = AB[g * 64 + 32 * st + r32]; aim[st] = AB[NGRP * NST + g * 64 + 32 * st + r32]; }
        bf16x8 Bf[4];
#pragma unroll
        for (int ri = 0; ri < 2; ++ri)
#pragma unroll
            for (int st = 0; st < 2; ++st) { const float* src = BB + ri * (NGRP * NST * 16) + (g * 64 + 32 * st + r32) * 16 + 8 * hi;
                const f32x4 x0 = *(const f32x4*)src, x1 = *(const f32x4*)(src + 4); Bf[2 * ri + st] = __builtin_bit_cast(bf16x8, pack8(x0, x1)); }
        bf16x8 Cf[4];
#pragma unroll
        for (int ks = 0; ks < 4; ++ks) { const int k0 = 32 * ks + 8 * fq; const float* src = (ks < 2 ? in[10] : in[11]) + (g * 16 + fr) * 64 + (k0 & 63);
            f32x4 x0 = *(const f32x4*)src, x1 = *(const f32x4*)(src + 4); if (ks >= 2) { x0 = -x0; x1 = -x1; } Cf[ks] = __builtin_bit_cast(bf16x8, pack8(x0, x1)); }
        const float dsk = in[12][g * 16 + fr];
        const bf16_t* Ub = U + ((size_t)b * SEQ + wave * 256) * SSMW + 16 * g;
        float sre[2] = {0.f, 0.f}, sim[2] = {0.f, 0.f}, mre[2] = {0.f, 0.f}, mim[2] = {0.f, 0.f};
        if (wave == 0) {
            f32x4 x0 = (f32x4){0.f, 0.f, 0.f, 0.f}, x1 = x0;
            if (r32 >= 16) { const float* src = UM + (r32 - 16) * SSMW + 16 * g + 8 * hi; x0 = *(const f32x4*)src; x1 = *(const f32x4*)(src + 4); }
            const bf16x8 uf = __builtin_bit_cast(bf16x8, pack8(x0, x1));
            f32x16 bu[4];
#pragma unroll
            for (int t = 0; t < 4; ++t) bu[t] = __builtin_amdgcn_mfma_f32_32x32x16_bf16(uf, Bf[t], (f32x16){}, 0, 0, 0);
            scan_block<false>(bu, sre, sim, are, aim, hi);
            mre[0] = sre[0]; mre[1] = sre[1]; mim[0] = sim[0]; mim[1] = sim[1];
        }
#pragma unroll 1
        for (int blk = 0; blk < 8; ++blk) {
            const bf16x8 uf = *(const bf16x8*)(Ub + (size_t)(32 * blk + r32) * SSMW + 8 * hi);
            f32x16 bu[4];
#pragma unroll
            for (int t = 0; t < 4; ++t) bu[t] = __builtin_amdgcn_mfma_f32_32x32x16_bf16(uf, Bf[t], (f32x16){}, 0, 0, 0);
            scan_block<false>(bu, sre, sim, are, aim, hi);
        }
        if (hi == 0) {
#pragma unroll
            for (int st = 0; st < 2; ++st) { E[wave * 128 + st * 64 + r32] = sre[st]; E[wave * 128 + st * 64 + 32 + r32] = sim[st]; } }
        __syncthreads();
        if (wave == 0) { sre[0] = mre[0]; sre[1] = mre[1]; sim[0] = mim[0]; sim[1] = mim[1]; }
        else {
            float pr[2], pi[2];
#pragma unroll
            for (int st = 0; st < 2; ++st) { pr[st] = are[st]; pi[st] = aim[st];
#pragma unroll
                for (int k = 0; k < 8; ++k) { const float nr = pr[st] * pr[st] - pi[st] * pi[st], ni = 2.f * pr[st] * pi[st]; pr[st] = nr; pi[st] = ni; }
                sre[st] = E[st * 64 + r32]; sim[st] = E[st * 64 + 32 + r32]; }
            for (int j = 1; j < wave; ++j) {
#pragma unroll
                for (int st = 0; st < 2; ++st) { const float er = E[j * 128 + st * 64 + r32], ei = E[j * 128 + st * 64 + 32 + r32];
                    const float nr = pr[st] * sre[st] - pi[st] * sim[st] + er, ni = pr[st] * sim[st] + pi[st] * sre[st] + ei; sre[st] = nr; sim[st] = ni; } }
        }
#pragma unroll 1
        for (int blk = 0; blk < 8; ++blk) {
            const bf16x8 uf = *(const bf16x8*)(Ub + (size_t)(32 * blk + r32) * SSMW + 8 * hi);
            f32x16 bu[4];
#pragma unroll
            for (int t = 0; t < 4; ++t) bu[t] = __builtin_amdgcn_mfma_f32_32x32x16_bf16(uf, Bf[t], (f32x16){}, 0, 0, 0);
            scan_block<true>(bu, sre, sim, are, aim, hi);
#pragma unroll
            for (int reg = 0; reg < 16; ++reg) { const int tok = (reg & 3) + 8 * (reg >> 2) + 4 * hi;
#pragma unroll
                for (int t = 0; t < 4; ++t) *(LAS bf16_t*)(Sl + tok * 272 + (32 * t + r32) * 2) = (bf16_t)(cvt_pk_bf16(bu[t][reg], 0.f) & 0xffffu); }
            f32x4 y[2];
#pragma unroll
            for (int mt = 0; mt < 2; ++mt) { y[mt] = (f32x4){0.f, 0.f, 0.f, 0.f};
#pragma unroll
                for (int ks = 0; ks < 4; ++ks) { const bf16x8 af = *(const LAS bf16x8*)(Sl + (16 * mt + fr) * 272 + (32 * ks + 8 * fq) * 2);
                    y[mt] = __builtin_amdgcn_mfma_f32_16x16x32_bf16(af, Cf[ks], y[mt], 0, 0, 0); } }
#pragma unroll
            for (int mt = 0; mt < 2; ++mt)
#pragma unroll
                for (int reg = 0; reg < 4; ++reg) { const int tok = 32 * blk + 16 * mt + 4 * fq + reg;
                    const float uv = bf_lo((unsigned)Ub[(size_t)tok * SSMW + fr]);
                    const float yy = gelu_tanh(y[mt][reg] + dsk * uv);
                    YPRE[((size_t)b * SEQ + wave * 256 + tok) * SSMW + 16 * g + fr] = (bf16_t)(cvt_pk_bf16(yy, 0.f) & 0xffffu); }
        }
        __syncthreads();
    }
}

__device__ __forceinline__ int crow(int r, int hi) { return (r & 3) + 8 * (r >> 2) + 4 * hi; }
typedef short v4i16_t __attribute__((ext_vector_type(4)));
__device__ __forceinline__ s16x4 vtr(const LAS unsigned char* p) { return __builtin_bit_cast(s16x4, __builtin_amdgcn_ds_read_tr16_b64_v4i16((LAS v4i16_t*)p)); }
__device__ __forceinline__ float half_swap_max(float x) { auto rr = __builtin_amdgcn_permlane32_swap(__float_as_uint(x), __float_as_uint(x), false, false); return fmaxf(__uint_as_float(rr[0]), __uint_as_float(rr[1])); }
__device__ __forceinline__ float half_swap_sum(float x) { auto rr = __builtin_amdgcn_permlane32_swap(__float_as_uint(x), __float_as_uint(x), false, false); return __uint_as_float(rr[0]) + __uint_as_float(rr[1]); }

__device__ __forceinline__ void attn_unit(const Ctx& C, const bf16_t* Qg, const bf16_t* Kg, const bf16_t* Vg, const bf16_t* KM, const bf16_t* VM, bf16_t* Y,
                                          const float* subg, float lam, int b, int h, int qt) {
    LAS unsigned char* lds = C.lds;
    const int lane = C.lane, wave = C.wave, r32 = lane & 31, hi = lane >> 5, qb = wave >> 1, map = wave & 1;
    const int q0 = qt * 128 + qb * 32;
    const size_t rowb = (size_t)b * SEQ;
    bf16x8 qr[4];
    { const bf16_t* qp = Qg + (rowb + q0 + r32) * AW + h * 128 + map * 64 + hi * 8;
#pragma unroll
      for (int d0 = 0; d0 < 4; ++d0) qr[d0] = *(const bf16x8*)(qp + d0 * 16); }
    const int NT = 2 * qt + 3;
    const bool skip_last = (qb < 2);
    f32x16 o[4];
#pragma unroll
    for (int d = 0; d < 4; ++d) o[d] = (f32x16){};
    float mrun = -__builtin_inff(), lrun = 0.f;
    LAS float* wsf = (LAS float*)(lds + 65536 + wave * 256);
    const bf16_t* Kb = Kg + rowb * AW; const bf16_t* Vb = Vg + rowb * AW;
#define ATT_DMA(step, stage) do { const bf16_t* ks_ = (step) == 0 ? KM : Kb; const bf16_t* vs_ = (step) == 0 ? VM : Vb; const int row0_ = (step) == 0 ? 0 : ((step) - 1) * 64; \
    _Pragma("unroll") for (int i_ = 0; i_ < 2; ++i_) { const int p_ = 2 * wave + i_; \
        __builtin_amdgcn_global_load_lds((const unsigned*)(ks_ + (size_t)(row0_ + lane) * AW + h * 128 + (p_ >> 3) * 64 + (p_ & 7) * 8), (LAS unsigned*)(lds + (stage) * 32768 + p_ * 1024), 16, 0, 0); \
        __builtin_amdgcn_global_load_lds((const unsigned*)(vs_ + (size_t)(row0_ + 16 * (p_ & 3) + (lane >> 2)) * AW + h * 128 + (p_ >> 2) * 32 + (lane & 3) * 8), (LAS unsigned*)(lds + (stage) * 32768 + 16384 + p_ * 1024), 16, 0, 0); } } while (0)
    ATT_DMA(0, 0);
    asm volatile("s_waitcnt vmcnt(0)" ::: "memory"); __syncthreads();
#pragma unroll 1
    for (int s = 0; s < NT; ++s) {
        const int stage = s & 1;
        if (s + 1 < NT) ATT_DMA(s + 1, stage ^ 1);
        if (!(skip_last && s == NT - 1)) {
            const LAS unsigned char* kb = lds + stage * 32768 + map * 8192 + hi * 1024 + r32 * 16;
            f32x16 p0 = (f32x16){}, p1 = (f32x16){};
#pragma unroll
            for (int d0 = 0; d0 < 4; ++d0) { const bf16x8 b0 = *(const LAS bf16x8*)(kb + d0 * 2048), b1 = *(const LAS bf16x8*)(kb + d0 * 2048 + 512);
                p0 = __builtin_amdgcn_mfma_f32_32x32x16_bf16(b0, qr[d0], p0, 0, 0, 0); p1 = __builtin_amdgcn_mfma_f32_32x32x16_bf16(b1, qr[d0], p1, 0, 0, 0); }
            if (s == 0) {
                asm volatile("" ::: "memory");
#pragma unroll
                for (int r = 0; r < 16; ++r) { if (r >= 8) p0[r] = -__builtin_inff(); p1[r] = -__builtin_inff(); } }
            float rmA = fmaxf(p0[0], p0[1]), rmB = fmaxf(p0[2], p0[3]), rmC = fmaxf(p1[0], p1[1]), rmD = fmaxf(p1[2], p1[3]);
#pragma unroll
            for (int r = 4; r < 16; r += 4) { rmA = fmaxf(rmA, fmaxf(p0[r], p0[r + 1])); rmB = fmaxf(rmB, fmaxf(p0[r + 2], p0[r + 3])); rmC = fmaxf(rmC, fmaxf(p1[r], p1[r + 1])); rmD = fmaxf(rmD, fmaxf(p1[r + 2], p1[r + 3])); }
            const float rm = half_swap_max(fmaxf(fmaxf(rmA, rmB), fmaxf(rmC, rmD)));
            if (s == 0) mrun = rm;
            else if (__any(rm > mrun + 8.0f)) {
                const float mnew = fmaxf(mrun, rm), alpha = __builtin_amdgcn_exp2f(mrun - mnew);
                lrun *= alpha; mrun = mnew;
                if (hi == 0) wsf[r32] = alpha;
                f32x4 a4[4];
#pragma unroll
                for (int gq = 0; gq < 4; ++gq) a4[gq] = *(const LAS f32x4*)(wsf + 8 * gq + 4 * hi);
#pragma unroll
                for (int d = 0; d < 4; ++d)
#pragma unroll
                    for (int r = 0; r < 16; ++r) o[d][r] *= a4[r >> 2][r & 3];
            }
            float psA = 0.f, psB = 0.f, psC = 0.f, psD = 0.f;
#pragma unroll
            for (int r = 0; r < 16; r += 2) { p0[r] = __builtin_amdgcn_exp2f(p0[r] - mrun); p0[r + 1] = __builtin_amdgcn_exp2f(p0[r + 1] - mrun); p1[r] = __builtin_amdgcn_exp2f(p1[r] - mrun); p1[r + 1] = __builtin_amdgcn_exp2f(p1[r + 1] - mrun);
                psA += p0[r]; psB += p0[r + 1]; psC += p1[r]; psD += p1[r + 1]; }
            lrun += (psA + psB) + (psC + psD);
            bf16x8 pa[4];
            { u32x4 w;
              w = (u32x4){cvt_pk_bf16(p0[0], p0[1]), cvt_pk_bf16(p0[2], p0[3]), cvt_pk_bf16(p0[4], p0[5]), cvt_pk_bf16(p0[6], p0[7])}; pa[0] = __builtin_bit_cast(bf16x8, w);
              w = (u32x4){cvt_pk_bf16(p0[8], p0[9]), cvt_pk_bf16(p0[10], p0[11]), cvt_pk_bf16(p0[12], p0[13]), cvt_pk_bf16(p0[14], p0[15])}; pa[1] = __builtin_bit_cast(bf16x8, w);
              w = (u32x4){cvt_pk_bf16(p1[0], p1[1]), cvt_pk_bf16(p1[2], p1[3]), cvt_pk_bf16(p1[4], p1[5]), cvt_pk_bf16(p1[6], p1[7])}; pa[2] = __builtin_bit_cast(bf16x8, w);
              w = (u32x4){cvt_pk_bf16(p1[8], p1[9]), cvt_pk_bf16(p1[10], p1[11]), cvt_pk_bf16(p1[12], p1[13]), cvt_pk_bf16(p1[14], p1[15])}; pa[3] = __builtin_bit_cast(bf16x8, w); }
            const LAS unsigned char* vp0 = lds + stage * 32768 + 16384 + ((lane >> 4) & 1) * 32 + (lane & 3) * 8 + (4 * hi + ((lane & 15) >> 2)) * 64;
#pragma unroll
            for (int d = 0; d < 4; ++d)
#pragma unroll
                for (int ks = 0; ks < 4; ++ks) { const s16x4 lo = vtr(vp0 + d * 4096 + ks * 1024), hv = vtr(vp0 + d * 4096 + ks * 1024 + 512);
                    const bf16x8 vf = (bf16x8){lo[0], lo[1], lo[2], lo[3], hv[0], hv[1], hv[2], hv[3]};
                    o[d] = __builtin_amdgcn_mfma_f32_32x32x16_bf16(pa[ks], vf, o[d], 0, 0, 0); }
        }
        asm volatile("s_waitcnt vmcnt(0)" ::: "memory"); __syncthreads();
    }
#undef ATT_DMA
    { const float ltot = half_swap_sum(lrun); const float inv = (map ? lam : 1.0f) / ltot;
      if (hi == 0) wsf[r32] = inv;
      f32x4 a4[4];
#pragma unroll
      for (int gq = 0; gq < 4; ++gq) a4[gq] = *(const LAS f32x4*)(wsf + 8 * gq + 4 * hi);
#pragma unroll
      for (int d = 0; d < 4; ++d)
#pragma unroll
          for (int r = 0; r < 16; ++r) o[d][r] *= a4[r >> 2][r & 3]; }
    LAS float* X = (LAS float*)(lds + qb * 16384);
    if (map == 1) {
#pragma unroll
        for (int d = 0; d < 4; ++d)
#pragma unroll
            for (int r = 0; r < 16; ++r) X[crow(r, hi) * 128 + 32 * d + r32] = o[d][r];
    }
    __syncthreads();
    if (map == 0) {
        float ssq[16];
#pragma unroll
        for (int r = 0; r < 16; ++r) ssq[r] = 0.f;
#pragma unroll
        for (int d = 0; d < 4; ++d)
#pragma unroll
            for (int r = 0; r < 16; ++r) { const float v = o[d][r] - X[crow(r, hi) * 128 + 32 * d + r32]; o[d][r] = v; ssq[r] += v * v; }
#pragma unroll
        for (int r = 0; r < 16; ++r) {
#pragma unroll
            for (int off = 1; off < 32; off <<= 1) ssq[r] += __shfl_xor(ssq[r], off);
            ssq[r] = 0.8f / sqrtf(ssq[r] * (1.f / 128.f) + LN_EPS); }
#pragma unroll
        for (int d = 0; d < 4; ++d) { const float gg = subg[32 * d + r32];
#pragma unroll
            for (int r = 0; r < 16; ++r) Y[(rowb + q0 + crow(r, hi)) * AW + h * 128 + 32 * d + r32] = (bf16_t)(cvt_pk_bf16(o[d][r] * ssq[r] * gg, 0.f) & 0xffffu); }
    }
    __syncthreads();
}
__device__ __forceinline__ void p3_attention(const Ctx& C, const float* const* in, unsigned char* ws) {
    const bf16_t* Q = (const bf16_t*)(ws + WS_Q); const bf16_t* K = (const bf16_t*)(ws + WS_K); const bf16_t* V = (const bf16_t*)(ws + WS_V);
    const bf16_t* KM = (const bf16_t*)(ws + WS_KMETA); const bf16_t* VM = (const bf16_t*)(ws + WS_VMETA); bf16_t* Y = (bf16_t*)(ws + WS_YATT);
    const float l1 = wave_sum(in[14][C.lane] * in[15][C.lane]), l2 = wave_sum(in[16][C.lane] * in[17][C.lane]);
    const float lam = expf(l1) - expf(l2) + 0.2f;
#ifndef ATT_REP
#define ATT_REP 1
#endif
    for (int vv = C.vcu; vv < 256 * ATT_REP; vv += C.G) { const int v = vv & 255;
        const int bh = v >> 1, sft = v & 1;
#pragma unroll 1
        for (int i = 0; i < 8; ++i) { const int qt = (i & 1) ? (15 - sft - (i & ~1)) : (sft + (i & ~1));
            attn_unit(C, Q, K, V, KM, VM, Y, in[18], lam, bh >> 3, bh & 7, qt); }
    }
}

__device__ __forceinline__ void p6_ln1_router(const Ctx& C, const float* const* in, unsigned char* ws) {
    const int lane = C.lane, wave = C.wave, tid = C.tid;
    const bf16_t* Z = (const bf16_t*)(ws + WS_Z); bf16_t* H1 = (bf16_t*)(ws + WS_H1); const float* WrT = (const float*)(ws + WS_WRT);
    int* LIST = (int*)(ws + WS_LIST); float* WGT = (float*)(ws + WS_WGT); unsigned* ECNT = (unsigned*)(ws + WS_CTL) + CW_ECNT;
    const float* lg = in[22]; const float* lb = in[23];
    LAS float* WB = (LAS float*)C.lds;
    LAS unsigned char* XB = C.lds + 98304;
    LAS int* RE = (LAS int*)(XB);
    LAS float* RW = (LAS float*)(XB + 1024);
    LAS int* CL = (LAS int*)(XB + 2048);
    LAS int* BS = (LAS int*)(XB + 2048 + 128);
    LAS int* SL = (LAS int*)(XB + 2048 + 256);
    LAS float* LG = (LAS float*)(XB + 4096) + wave * 80;
    for (int rbk = C.vcu; rbk < T / 128; rbk += C.G) {
        if (tid < 32) CL[tid] = 0;
#pragma unroll 1
        for (int step = 0; step < 8; ++step) {
            const int lr0 = step * 16 + 2 * wave; const size_t row0 = (size_t)rbk * 128 + lr0;
            int l4 = 4 * lane; asm volatile("" : "+v"(l4));
            f32x4 v0[8], v1[8];
#pragma unroll
            for (int j = 0; j < 8; ++j) { const u32x2 z0 = *(const u32x2*)(Z + row0 * DM + 256 * j + l4), z1 = *(const u32x2*)(Z + (row0 + 1) * DM + 256 * j + l4);
                v0[j] = (f32x4){bf_lo(z0.x), bf_hi(z0.x), bf_lo(z0.y), bf_hi(z0.y)}; v1[j] = (f32x4){bf_lo(z1.x), bf_hi(z1.x), bf_lo(z1.y), bf_hi(z1.y)}; }
            float mean0, rstd0, mean1, rstd1; ln_stats(v0, mean0, rstd0); ln_stats(v1, mean1, rstd1);
#pragma unroll
            for (int j = 0; j < 8; ++j) { const f32x4 gg = *(const f32x4*)(lg + 256 * j + l4), bb = *(const f32x4*)(lb + 256 * j + l4);
                v0[j] = (v0[j] - mean0) * rstd0 * gg + bb; v1[j] = (v1[j] - mean1) * rstd1 * gg + bb;
                u32x2 w; w.x = cvt_pk_bf16(v0[j].x, v0[j].y); w.y = cvt_pk_bf16(v0[j].z, v0[j].w); *(u32x2*)(H1 + row0 * DM + 256 * j + l4) = w;
                w.x = cvt_pk_bf16(v1[j].x, v1[j].y); w.y = cvt_pk_bf16(v1[j].z, v1[j].w); *(u32x2*)(H1 + (row0 + 1) * DM + 256 * j + l4) = w; }
#pragma unroll 1
            for (int ng = 0; ng < 3; ++ng) {
                __syncthreads();
                int tq = tid; asm volatile("" : "+v"(tq));
#pragma unroll
                for (int i = 0; i < 12; ++i) { const int idx = tq + 512 * i, n = idx >> 9, c4 = idx & 511;
                    *(LAS f32x4*)(WB + n * 2048 + 4 * c4) = *(const f32x4*)(WrT + (size_t)(12 * ng + n) * DM + 4 * c4); }
                __syncthreads();
#pragma unroll 1
                for (int n = 0; n < 12; ++n) { float pa = 0.f, pb = 0.f;
#pragma unroll
                    for (int j = 0; j < 8; ++j) { const f32x4 w4 = *(const LAS f32x4*)(WB + n * 2048 + 256 * j + l4);
                        const f32x4 a = v0[j] * w4, bq = v1[j] * w4; pa += (a.x + a.y) + (a.z + a.w); pb += (bq.x + bq.y) + (bq.z + bq.w); }
                    const float sa = wave_sum(pa), sb = wave_sum(pb); if (lane == 0) { LG[12 * ng + n] = sa; LG[40 + 12 * ng + n] = sb; } }
            }
            if (lane < 2) {
                const LAS float* L = LG + 40 * lane;
                int gi = 0; float gm = L[0] + in[25][0];
                for (int n = 1; n < 4; ++n) { const float x = L[n] + in[25][n]; if (x > gm) { gm = x; gi = n; } }
                float gs = 0.f;
                for (int n = 0; n < 4; ++n) gs += __expf(L[n] + in[25][n] - gm);
                const float gval = 1.0f / gs;
                int i1 = 0; float m1 = L[4 + gi * 8] + in[27][gi * 8];
                for (int j = 1; j < 8; ++j) { const float x = L[4 + gi * 8 + j] + in[27][gi * 8 + j]; if (x > m1) { m1 = x; i1 = j; } }
                int i2 = -1; float m2 = -__builtin_inff();
                for (int j = 0; j < 8; ++j) { const float x = L[4 + gi * 8 + j] + in[27][gi * 8 + j]; if (j != i1 && x > m2) { m2 = x; i2 = j; } }
                const float tt = __expf(m2 - m1), w1 = gval / (1.f + tt), w2 = gval * tt / (1.f + tt);
                const int lr = lr0 + lane; RE[lr * 2] = gi * 8 + i1; RE[lr * 2 + 1] = gi * 8 + i2; RW[lr * 2] = w1; RW[lr * 2 + 1] = w2;
            }
        }
        __syncthreads();
        int e = 0;
        if (tid < 256) { e = RE[tid]; SL[tid] = __hip_atomic_fetch_add(&CL[e], 1, __ATOMIC_RELAXED, __HIP_MEMORY_SCOPE_WORKGROUP); }
        __syncthreads();
        if (tid < 32) BS[tid] = (int)__hip_atomic_fetch_add(&ECNT[tid], (unsigned)CL[tid], __ATOMIC_RELAXED, __HIP_MEMORY_SCOPE_AGENT);
        __syncthreads();
        if (tid < 256) { const int entry = (rbk * 128 + (tid >> 1)) * 2 + (tid & 1); LIST[(size_t)e * CAP + BS[e] + SL[tid]] = entry; WGT[entry] = RW[tid]; }
        __syncthreads();
    }
}

__device__ __forceinline__ void p9_ln2(const Ctx& C, const float* const* in, unsigned char* ws, float* out) {
    const bf16_t* H1 = (const bf16_t*)(ws + WS_H1); const bf16_t* YK = (const bf16_t*)(ws + WS_YK);
    const float* lg = in[31]; const float* lb = in[32];
    const int gw = C.vcu * 8 + C.wave, NGW = C.G * 8, lane = C.lane;
    for (int m = gw; m < T; m += NGW) {
        f32x4 v[8];
#pragma unroll
        for (int j = 0; j < 8; ++j) { const size_t c = 256 * j + 4 * lane;
            const u32x2 hw = *(const u32x2*)(H1 + (size_t)m * DM + c), y0 = *(const u32x2*)(YK + (size_t)(2 * m) * DM + c), y1 = *(const u32x2*)(YK + (size_t)(2 * m + 1) * DM + c);
            v[j] = (f32x4){bf_lo(hw.x), bf_hi(hw.x), bf_lo(hw.y), bf_hi(hw.y)} * ALPHA + (f32x4){bf_lo(y0.x), bf_hi(y0.x), bf_lo(y0.y), bf_hi(y0.y)} + (f32x4){bf_lo(y1.x), bf_hi(y1.x), bf_lo(y1.y), bf_hi(y1.y)}; }
        float mean, rstd; ln_stats(v, mean, rstd);
#pragma unroll
        for (int j = 0; j < 8; ++j) { const f32x4 gg = *(const f32x4*)(lg + 256 * j + 4 * lane), bb = *(const f32x4*)(lb + 256 * j + 4 * lane);
            *(f32x4*)(out + (size_t)m * DM + 256 * j + 4 * lane) = (v[j] - mean) * rstd * gg + bb; }
    }
}

__device__ __forceinline__ int build_moe_tables(const Ctx& C, unsigned char* ws) {
    LAS int* blkstart = (LAS int*)(C.lds + MISC_OFF + 64); LAS int* cntE = (LAS int*)(C.lds + MISC_OFF + 320); LAS int* blkexp = (LAS int*)(C.lds + MISC_OFF + 512);
    unsigned* ECNT = (unsigned*)(ws + WS_CTL) + CW_ECNT;
    __syncthreads();
    if (C.tid < 32) cntE[C.tid] = (int)__hip_atomic_load(&ECNT[C.tid], __ATOMIC_RELAXED, __HIP_MEMORY_SCOPE_AGENT);
    __syncthreads();
    if (C.tid == 0) { int s = 0; for (int e = 0; e < NE; ++e) { blkstart[e] = s; s += (cntE[e] + 255) >> 8; } blkstart[NE] = s; }
    __syncthreads();
    const int NBLK = blkstart[NE];
    if (C.tid < NBLK && C.tid < 320) { int e = 0; for (int j = 1; j < NE; ++j) if (blkstart[j] <= C.tid) e = j; blkexp[C.tid] = e; }
    __syncthreads();
    return NBLK < 320 ? NBLK : 320;
}

constexpr int NPHASE = 10;
struct Args { const float* in[33]; float* out; unsigned char* ws; int ph_lo, ph_hi; };
__global__ void __launch_bounds__(512, 2) mk_fwd(Args args) {
    extern __shared__ __attribute__((aligned(16))) unsigned char lds_raw[];
    Ctx C; C.lds = (LAS unsigned char*)lds_raw; C.tid = threadIdx.x; C.lane = C.tid & 63; C.wave = __builtin_amdgcn_readfirstlane(C.tid >> 6);
    C.G = gridDim.x; { const int bx = blockIdx.x; C.vcu = (C.G % 8 == 0) ? (bx % 8) * (C.G / 8) + bx / 8 : bx; }
    unsigned char* ws = args.ws; const float* const* in = args.in;
    volatile LAS unsigned* MISC = (volatile LAS unsigned*)(C.lds + MISC_OFF);
    if (C.tid < 16) MISC[C.tid] = 0u;
    __syncthreads();
    unsigned* barw = (unsigned*)(ws + WS_CTL) + CW_BAR;
    XcdBarrier bar; bar.bar = barw; bar.x = 0; bar.st = nullptr;
    const int lo = args.ph_lo, hi = args.ph_hi;
    if (hi - lo > 1) bar = xcd_barrier_post(barw, MISC);
#ifndef PH_MASK
#define PH_MASK 0x3ff
#endif
#define IN(k) (((PH_MASK >> (k)) & 1) && lo <= (k) && (k) < hi)
#define SEAM(k) do { if (IN(k) && IN((k) + 1)) xcd_barrier(bar); } while (0)
#ifndef GEMM_SP2
#define GEMM_SP2 true
#endif
#ifndef GEMM_ALIGN
#define GEMM_ALIGN true
#endif
#ifndef PROBE_MASK
#define PROBE_MASK 0
#endif
#define REPS(k) (((PROBE_MASK >> (k)) & 1) ? 2 : 1)
#define REPSEAM(k, rep) do { if ((rep) + 1 < REPS(k)) xcd_barrier(bar); } while (0)
    LAS unsigned char* lds = C.lds;
    bf16_t* MG = (bf16_t*)args.out;

    if (IN(0)) { _Pragma("unroll") for (int rep = 0; rep < REPS(0); ++rep) { p0_prologue(C, in, ws); REPSEAM(0, rep); } } SEAM(0);

    if (IN(1)) { _Pragma("unroll") for (int rep = 0; rep < REPS(1); ++rep) {
        pg8::Gemm g{(const bf16_t*)(ws + WS_HBF), (const bf16_t*)(ws + WS_WIN), T, INC, DM, nullptr, nullptr, 0}; pg8::StaticOrder S; S.init(T, INC, C.G, (int)blockIdx.x);
        EpiProj E{(bf16_t*)(ws + WS_U), (bf16_t*)(ws + WS_Q), (bf16_t*)(ws + WS_K), (bf16_t*)(ws + WS_V), (bf16_t*)(ws + WS_SGS), (bf16_t*)(ws + WS_SGA)};
        pg8::gemm_phase<EpiProj, pg8::StaticOrder, GEMM_ALIGN, GEMM_SP2, false>(lds, g, S, E);
        p1_meta_proj(C, ws);
        REPSEAM(1, rep);
    } } SEAM(1);

    if (IN(2)) { _Pragma("unroll") for (int rep = 0; rep < REPS(2); ++rep) { p2_scan(C, in, ws); REPSEAM(2, rep); } } SEAM(2);

    if (IN(3)) { _Pragma("unroll") for (int rep = 0; rep < REPS(3); ++rep) {
        { pg8::Gemm g{(const bf16_t*)(ws + WS_YPRE), (const bf16_t*)(ws + WS_WGLU), T, SSMW, SSMW, nullptr, nullptr, 0}; pg8::StaticOrder S; S.init(T, SSMW, C.G, (int)blockIdx.x);
          EpiGlu E{(const bf16_t*)(ws + WS_YPRE), (bf16_t*)(ws + WS_YSSM)};
          pg8::gemm_phase<EpiGlu, pg8::StaticOrder, GEMM_ALIGN, GEMM_SP2, false>(lds, g, S, E); }
        p3_attention(C, in, ws);
        REPSEAM(3, rep);
    } } SEAM(3);

    if (IN(4)) { _Pragma("unroll") for (int rep = 0; rep < REPS(4); ++rep) {
        { pg8::Gemm g{(const bf16_t*)(ws + WS_YSSM), (const bf16_t*)(ws + WS_WBS), T, DM, SSMW, (const bf16_t*)(ws + WS_YATT), (const bf16_t*)(ws + WS_WBA), AW}; pg8::StaticOrder S; S.init(T, DM, C.G, (int)blockIdx.x);
          EpiMergeF E{(const bf16_t*)(ws + WS_SGS), (const bf16_t*)(ws + WS_SGA), MG};
          pg8::gemm_phase<EpiMergeF, pg8::StaticOrder, GEMM_ALIGN, GEMM_SP2, false, true>(lds, g, S, E); }
        REPSEAM(4, rep);
    } } SEAM(4);

    if (IN(5)) { _Pragma("unroll") for (int rep = 0; rep < REPS(5); ++rep) {
        pg8::Gemm g{MG, (const bf16_t*)(ws + WS_WO), T, DM, DM, nullptr, nullptr, 0}; pg8::StaticOrder S; S.init(T, DM, C.G, (int)blockIdx.x);
        EpiZ E{(const bf16_t*)(ws + WS_HBF), (bf16_t*)(ws + WS_Z)};
        pg8::gemm_phase<EpiZ, pg8::StaticOrder, GEMM_ALIGN, GEMM_SP2, false>(lds, g, S, E);
        REPSEAM(5, rep);
    } } SEAM(5);

    if (IN(6)) { p6_ln1_router(C, in, ws); } SEAM(6);

    if (IN(7)) { _Pragma("unroll") for (int rep = 0; rep < REPS(7); ++rep) {
        const int NBLK = build_moe_tables(C, ws);
        MoeOrder S{C.G, C.vcu, 2, NBLK, (const LAS int*)(lds + MISC_OFF + 512), (const LAS int*)(lds + MISC_OFF + 64), (const LAS int*)(lds + MISC_OFF + 320), (const int*)(ws + WS_LIST)};
        pg8::Gemm g{(const bf16_t*)(ws + WS_H1), (const bf16_t*)(ws + WS_WUP), T, NE * 1024, DM, nullptr, nullptr, 0};
        EpiSwiglu E{(bf16_t*)(ws + WS_HB), (const int*)(ws + WS_LIST), (const float*)(ws + WS_WGT), (int*)(ws + WS_POSE), (float*)(ws + WS_POSW)};
        pg8::gemm_phase<EpiSwiglu, MoeOrder, GEMM_ALIGN, GEMM_SP2, true>(lds, g, S, E);
        REPSEAM(7, rep);
    } } SEAM(7);

    if (IN(8)) { _Pragma("unroll") for (int rep = 0; rep < REPS(8); ++rep) {
        const int NBLK = build_moe_tables(C, ws);
        MoeOrder S{C.G, C.vcu, 3, NBLK, (const LAS int*)(lds + MISC_OFF + 512), (const LAS int*)(lds + MISC_OFF + 64), (const LAS int*)(lds + MISC_OFF + 320), (const int*)(ws + WS_LIST)};
        pg8::Gemm g{(const bf16_t*)(ws + WS_HB), (const bf16_t*)(ws + WS_WDN), NBLK * 256, NE * DM, DFF, nullptr, nullptr, 0};
        EpiDown E{(const int*)(ws + WS_POSE), (const float*)(ws + WS_POSW), (bf16_t*)(ws + WS_YK)};
        pg8::gemm_phase<EpiDown, MoeOrder, GEMM_ALIGN, GEMM_SP2, false>(lds, g, S, E);
        REPSEAM(8, rep);
    } } SEAM(8);

    if (IN(9)) { _Pragma("unroll") for (int rep = 0; rep < REPS(9); ++rep) { p9_ln2(C, in, ws, args.out); REPSEAM(9, rep); } }
#undef IN
#undef SEAM
}

extern "C" void kernel_launch(void* const* d_in, const int* in_sizes, int n_in, void* d_out, int out_size, void* d_ws, size_t ws_size, hipStream_t stream) {
    static int grid = 0;
    if (grid == 0) {
        if (n_in != 33 || in_sizes[0] != T * DM || out_size != T * DM || ws_size < WS_END) { fprintf(stderr, "kernel_launch: unexpected shapes (n_in %d, in0 %d, out %d, ws %zu)\n", n_in, n_in > 0 ? in_sizes[0] : -1, out_size, ws_size); grid = -1; return; }
        int dev = 0, cus = 0, per_cu = 0;
        if (hipGetDevice(&dev) != hipSuccess || hipDeviceGetAttribute(&cus, hipDeviceAttributeMultiprocessorCount, dev) != hipSuccess) { grid = -1; return; }
        if (hipFuncSetAttribute((const void*)mk_fwd, hipFuncAttributeMaxDynamicSharedMemorySize, LDS_BYTES) != hipSuccess) { fprintf(stderr, "kernel_launch: hipFuncSetAttribute failed\n"); grid = -1; return; }
        if (hipOccupancyMaxActiveBlocksPerMultiprocessor(&per_cu, (const void*)mk_fwd, 512, LDS_BYTES) != hipSuccess || per_cu < 1) { fprintf(stderr, "kernel_launch: occupancy query reports %d blocks per CU\n", per_cu); }
        (void)hipGetLastError();
        grid = cus;
    }
    if (grid < 0) return;
    (void)hipMemsetAsync((char*)d_ws + WS_CTL, 0, CTL_ZERO_BYTES, stream);
    Args a{};
    for (int i = 0; i < 33; ++i) a.in[i] = (const float*)d_in[i];
    a.out = (float*)d_out; a.ws = (unsigned char*)d_ws;
#if MK_PER_PHASE
    for (int p = 0; p < NPHASE; ++p) { a.ph_lo = p; a.ph_hi = p + 1; hipLaunchKernelGGL(mk_fwd, dim3(grid), dim3(512), LDS_BYTES, stream, a); }
#else
    a.ph_lo = 0; a.ph_hi = NPHASE; hipLaunchKernelGGL(mk_fwd, dim3(grid), dim3(512), LDS_BYTES, stream, a);
#endif
}
```

```cpp
#include <hip/hip_runtime.h>
#include <stdint.h>
#include <stdio.h>

#ifndef ATT_PROBE
#define ATT_PROBE 0
#endif
#ifndef MK_PER_PHASE
#define MK_PER_PHASE 0
#endif

#define GAS __attribute__((address_space(1)))
#define LAS __attribute__((address_space(3)))
typedef unsigned short bf16_t;
typedef short bf16x8 __attribute__((ext_vector_type(8)));
typedef short s16x4 __attribute__((ext_vector_type(4)));
typedef float f32x2 __attribute__((ext_vector_type(2)));
typedef float f32x4 __attribute__((ext_vector_type(4)));
typedef float f32x16 __attribute__((ext_vector_type(16)));
typedef unsigned u32x2 __attribute__((ext_vector_type(2)));
typedef unsigned u32x4 __attribute__((ext_vector_type(4)));

constexpr int NB_ = 16, SEQ = 2048, DM = 2048, T = NB_ * SEQ, NMETA = 16;
constexpr int SSMW = 512, AW = 1024, INC = 7680, NGRP = 32, NST = 64;
constexpr int NE = 32, DFF = 512, CAP = T;
constexpr float LN_EPS = 1e-5f;
constexpr float ALPHA = 1.189207115002721f;
constexpr float QSCALE = 0.125f * 1.4426950408889634f;

__device__ __forceinline__ unsigned cvt_pk_bf16(float lo, float hi) { unsigned r; asm volatile("v_cvt_pk_bf16_f32 %0, %1, %2" : "=v"(r) : "v"(lo), "v"(hi)); return r; }
__device__ __forceinline__ float bf_lo(unsigned w) { return __uint_as_float(w << 16); }
__device__ __forceinline__ float bf_hi(unsigned w) { return __uint_as_float(w & 0xffff0000u); }
__device__ __forceinline__ float sigmoidf_(float x) { return 1.0f / (1.0f + __expf(-x)); }
__device__ __forceinline__ float wave_sum(float v) {
#pragma unroll
    for (int o = 1; o < 64; o <<= 1) v += __shfl_xor(v, o);
    return v;
}

namespace pg8 {
constexpr int BM = 256, BK = 64, HALF = 128, HTB = HALF * BK * 2, STAGE_BYTES = 8 * HTB, NXCD = 8, WGM = 4;
__host__ __device__ __forceinline__ int lds_byte(int r, int c) { const int st = (r >> 4) * 2 + (c >> 5), rr = r & 15, cc = c & 31, ob = rr * 64 + cc * 2; return st * 1024 + (ob ^ (((ob >> 9) & 1) << 5)); }
__host__ __device__ __forceinline__ void stage_rc(int b, int& R, int& C) { const int st = b / 1024, sb = b % 1024, swz = sb ^ (((sb >> 9) & 1) << 5); R = (st >> 1) * 16 + swz / 64; C = (st & 1) * 32 + (swz % 64) / 2; }
__host__ __device__ __forceinline__ int perm32(int rho) { const int n = rho >> 4, i = rho & 15; return 8 * (i >> 2) + 4 * n + (i & 3); }

struct Unit { int pm, pn, e, s0, cnt; };
struct Gemm { const bf16_t* A; const bf16_t* Bt; int M, N, K; const bf16_t* A2; const bf16_t* Bt2; int K2; };

struct StaticOrder {
    int nM, nN, nwg, G, c, wgm;
    __device__ void init(int M, int N, int G_, int c_, int wgm_ = WGM) { nM = M / BM; nN = N / BM; nwg = nM * nN; G = G_; c = c_; wgm = wgm_; }
    __device__ bool next(int i, Unit& u) const {
        const long L = (long)i * G + c; if (L >= nwg) return false;
        int wgid = (int)L; { const int q = nwg / NXCD, r = nwg % NXCD, xcd = wgid % NXCD, off = wgid / NXCD; wgid = (xcd < r ? xcd * (q + 1) : r * (q + 1) + (xcd - r) * q) + off; }
        const int nig = wgm * nN, gid = wgid / nig, fm = gid * wgm, gsz = (nM - fm) < wgm ? (nM - fm) : wgm;
        u.pm = fm + ((wgid % nig) % gsz); u.pn = (wgid % nig) / gsz; u.e = 0; u.s0 = 0; u.cnt = 0; return true;
    }
    __device__ __forceinline__ int arow(const Unit&, int) const { return 0; }
};

template <class Epi, class Sched, bool ALIGN_EPI, bool SP2, bool GATHER, bool DUAL = false>
__device__ __forceinline__ void gemm_phase(LAS unsigned char* lds, const Gemm g, const Sched& S, const Epi& E) {
    const int tid = threadIdx.x, wid = __builtin_amdgcn_readfirstlane(tid >> 6), lane = tid & 63, wr = wid >> 2, wc = wid & 3, fr = lane & 15, fq = lane >> 4;
    const int K = g.K, K2 = DUAL ? g.K2 : 0, nt1 = K / BK, nt = (K + K2) / BK;
    unsigned voffA[2], voffB[2], voffA2[2] = {0u, 0u}, voffB2[2] = {0u, 0u}; int stR[2], stC[2];
#pragma unroll
    for (int i = 0; i < 2; ++i) { int R, C; stage_rc(tid * 16 + i * 8192, R, C); const int Rb = Epi::PERM ? ((R & ~31) + perm32(R & 31)) : R;
        stR[i] = R; stC[i] = C; voffA[i] = (unsigned)(R * K + C) * 2u; voffB[i] = (unsigned)(Rb * K + C) * 2u;
        if constexpr (DUAL) { voffA2[i] = (unsigned)(R * K2 + C) * 2u; voffB2[i] = (unsigned)(Rb * K2 + C) * 2u; } }
    const size_t kstep = (size_t)(BK * 2);
    const size_t hstep = (size_t)HALF * K * 2;
    const size_t tstep = 2 * hstep;
    const size_t hstep2 = (size_t)HALF * K2 * 2, tstep2 = 2 * hstep2;
    const unsigned ldsw = (unsigned)wid * 1024u;
    const int aoff = lds_byte(wr * 64 + fr, fq * 8), boff = lds_byte(wc * 32 + fr, fq * 8);
#define PG8_SA(b, h) (((b) * 2 + (h)) * HTB)
#define PG8_SB(b, h) ((4 + (b) * 2 + (h)) * HTB)
#define PG8_STAGE(bufoff, gbase, voff) do { _Pragma("unroll") for (int _i = 0; _i < 2; ++_i) \
        __builtin_amdgcn_global_load_lds((const unsigned*)((const char*)(gbase) + (voff)[_i]), (LAS unsigned*)(lds + (bufoff) + ldsw + _i * 8192), 16, 0, 0); } while (0)
#define PG8_STAGE_A(bufoff, kbase, h, VO) do { if constexpr (GATHER) { PG8_STAGE(bufoff, kbase, VO[h]); } else { PG8_STAGE(bufoff, (kbase) + (h) * hstep, voffA); } } while (0)
#define PG8_STAGE_AX(bufoff, kbase, h, VO, HS, VA) do { if constexpr (GATHER) { PG8_STAGE(bufoff, kbase, VO[h]); } else { PG8_STAGE(bufoff, (kbase) + (h) * (HS), VA); } } while (0)
#define PG8_LDA(dst, b, h) do { _Pragma("unroll") for (int m = 0; m < 4; ++m) _Pragma("unroll") for (int k = 0; k < 2; ++k) dst[m][k] = *(const LAS bf16x8*)(lds + PG8_SA(b, h) + aoff + m * 2048 + k * 1024); } while (0)
#define PG8_LDB(dst, b, h) do { _Pragma("unroll") for (int n = 0; n < 2; ++n) _Pragma("unroll") for (int k = 0; k < 2; ++k) dst[n][k] = *(const LAS bf16x8*)(lds + PG8_SB(b, h) + boff + n * 2048 + k * 1024); } while (0)
#define PG8_MMA(ai, bj, At, Bt) do { __builtin_amdgcn_s_setprio(1); _Pragma("unroll") for (int m = 0; m < 4; ++m) _Pragma("unroll") for (int n = 0; n < 2; ++n) _Pragma("unroll") for (int k = 0; k < 2; ++k) \
        acc[ai][bj][m][n] = __builtin_amdgcn_mfma_f32_16x16x32_bf16(Bt[n][k], At[m][k], acc[ai][bj][m][n], 0, 0, 0); __builtin_amdgcn_s_setprio(0); } while (0)
#define PG8_WAIT_V(n) asm volatile("s_waitcnt vmcnt(" #n ")" ::: "memory")
#define PG8_WAIT_L(n) asm volatile("s_waitcnt lgkmcnt(" #n ")" ::: "memory")
#define PG8_BAR __builtin_amdgcn_s_barrier()
#define PG8_SCHED __builtin_amdgcn_sched_barrier(0)
#define PG8_GOFF(VO, U) do { _Pragma("unroll") for (int _h = 0; _h < 2; ++_h) _Pragma("unroll") for (int _i = 0; _i < 2; ++_i) \
        VO[_h][_i] = (unsigned)S.arow(U, _h * HALF + stR[_i]) * (unsigned)(K * 2) + (unsigned)(stC[_i] * 2); } while (0)
    Unit cur, nxt; int ui = 0;
    if (!S.next(0, cur)) return;
    f32x4 acc[2][2][4][2];
#pragma unroll
    for (int a = 0; a < 2; ++a)
#pragma unroll
        for (int b = 0; b < 2; ++b)
#pragma unroll
            for (int m = 0; m < 4; ++m)
#pragma unroll
                for (int n = 0; n < 2; ++n) acc[a][b][m][n] = (f32x4){0.f, 0.f, 0.f, 0.f};
    bf16x8 At[4][2], B0[2][2], B1[2][2];
    unsigned cvo[2][2] = {{0u, 0u}, {0u, 0u}}, nvo[2][2] = {{0u, 0u}, {0u, 0u}};
    const char* cA = GATHER ? (const char*)g.A : (const char*)g.A + (size_t)cur.pm * tstep; const char* cB = (const char*)g.Bt + (size_t)cur.pn * tstep;
    if constexpr (GATHER) { PG8_GOFF(cvo, cur); }
    if constexpr (SP2) {
        PG8_STAGE(PG8_SB(0, 0), cB, voffB); PG8_STAGE(PG8_SB(0, 1), cB + hstep, voffB); PG8_STAGE_A(PG8_SA(0, 0), cA, 0, cvo); PG8_STAGE_A(PG8_SA(0, 1), cA, 1, cvo);
        if (wr == 1) PG8_BAR;
        PG8_WAIT_V(2); PG8_BAR;
        PG8_STAGE(PG8_SB(1, 0), cB + kstep, voffB); PG8_STAGE_A(PG8_SA(1, 0), cA + kstep, 0, cvo); PG8_STAGE(PG8_SB(1, 1), cB + hstep + kstep, voffB);
        PG8_WAIT_V(6); PG8_BAR;
    } else {
        PG8_STAGE(PG8_SB(0, 0), cB, voffB); PG8_STAGE_A(PG8_SA(0, 0), cA, 0, cvo); PG8_STAGE(PG8_SB(0, 1), cB + hstep, voffB); PG8_STAGE_A(PG8_SA(0, 1), cA, 1, cvo);
        if (wr == 1) PG8_BAR;
        PG8_WAIT_V(4); PG8_BAR;
        PG8_STAGE(PG8_SB(1, 0), cB + kstep, voffB); PG8_STAGE_A(PG8_SA(1, 0), cA + kstep, 0, cvo); PG8_STAGE(PG8_SB(1, 1), cB + hstep + kstep, voffB);
        PG8_WAIT_V(6); PG8_BAR;
    }
    for (;;) {
        const bool has_next = S.next(ui + 1, nxt);
        const char* nA = GATHER ? cA : (has_next ? (const char*)g.A + (size_t)nxt.pm * tstep : cA); const char* nB = has_next ? (const char*)g.Bt + (size_t)nxt.pn * tstep : cB;
        if constexpr (GATHER) { if (has_next) { PG8_GOFF(nvo, nxt); } else {
#pragma unroll
            for (int h = 0; h < 2; ++h)
#pragma unroll
                for (int i = 0; i < 2; ++i) nvo[h][i] = cvo[h][i]; } }
        const char* cA2 = DUAL ? (const char*)g.A2 + (size_t)cur.pm * tstep2 : cA; const char* cB2 = DUAL ? (const char*)g.Bt2 + (size_t)cur.pn * tstep2 : cB;
        for (int t = 0; t < nt; t += 2) {
            const bool last = (t == nt - 2);
            const bool s1 = DUAL && (t + 1 >= nt1), s2 = DUAL && !last && (t + 2 >= nt1);
            const char* a1 = s1 ? cA2 + (size_t)(t + 1 - nt1) * kstep : cA + (size_t)(t + 1) * kstep;
            const char* a2 = last ? nA : (s2 ? cA2 + (size_t)(t + 2 - nt1) * kstep : cA + (size_t)(t + 2) * kstep);
            const char* b2 = last ? nB : (s2 ? cB2 + (size_t)(t + 2 - nt1) * kstep : cB + (size_t)(t + 2) * kstep);
            const char* a3 = a2 + kstep; const char* b3 = b2 + kstep;
            const size_t hs1 = s1 ? hstep2 : hstep, hs2 = s2 ? hstep2 : hstep;
            unsigned vA1[2], vA2[2], vB2[2];
#pragma unroll
            for (int i = 0; i < 2; ++i) { vA1[i] = s1 ? voffA2[i] : voffA[i]; vA2[i] = s2 ? voffA2[i] : voffA[i]; vB2[i] = s2 ? voffB2[i] : voffB[i]; }
            unsigned svo[2][2];
#pragma unroll
            for (int h = 0; h < 2; ++h)
#pragma unroll
                for (int i = 0; i < 2; ++i) svo[h][i] = last ? nvo[h][i] : cvo[h][i];
            if constexpr (SP2) {
            PG8_LDB(B0, 0, 0); PG8_LDB(B1, 0, 1); PG8_SCHED; PG8_LDA(At, 0, 0); PG8_STAGE_AX(PG8_SA(1, 1), a1, 1, cvo, hs1, vA1);
            PG8_WAIT_V(8); PG8_WAIT_L(0); PG8_BAR; PG8_MMA(0, 0, At, B0); PG8_MMA(0, 1, At, B1); PG8_BAR; PG8_SCHED;
            PG8_LDA(At, 0, 1); PG8_STAGE(PG8_SB(0, 0), b2, vB2); PG8_STAGE(PG8_SB(0, 1), b2 + hs2, vB2); PG8_STAGE_AX(PG8_SA(0, 0), a2, 0, svo, hs2, vA2);
            PG8_WAIT_V(8); PG8_WAIT_L(0); PG8_BAR; PG8_MMA(1, 0, At, B0); PG8_MMA(1, 1, At, B1); PG8_BAR; PG8_SCHED;
            PG8_LDB(B0, 1, 0); PG8_LDB(B1, 1, 1); PG8_SCHED; PG8_LDA(At, 1, 0); PG8_STAGE_AX(PG8_SA(0, 1), a2, 1, svo, hs2, vA2);
            PG8_WAIT_V(8); PG8_WAIT_L(0); PG8_BAR; PG8_MMA(0, 0, At, B0); PG8_MMA(0, 1, At, B1); PG8_BAR; PG8_SCHED;
            PG8_LDA(At, 1, 1); PG8_STAGE(PG8_SB(1, 0), b3, vB2); PG8_STAGE(PG8_SB(1, 1), b3 + hs2, vB2); PG8_STAGE_AX(PG8_SA(1, 0), a3, 0, svo, hs2, vA2);
            PG8_WAIT_V(8); PG8_WAIT_L(0); PG8_BAR; PG8_MMA(1, 0, At, B0); PG8_MMA(1, 1, At, B1); PG8_BAR; PG8_SCHED;
            } else {
            PG8_LDB(B0, 0, 0); PG8_SCHED; PG8_LDA(At, 0, 0); PG8_STAGE_AX(PG8_SA(1, 1), a1, 1, cvo, hs1, vA1);
            PG8_WAIT_L(8); PG8_BAR; PG8_WAIT_L(0); PG8_MMA(0, 0, At, B0); PG8_BAR; PG8_SCHED;
            PG8_LDB(B1, 0, 1); PG8_STAGE(PG8_SB(0, 0), b2, vB2);
            PG8_BAR; PG8_WAIT_L(0); PG8_MMA(0, 1, At, B1); PG8_BAR;
            PG8_LDA(At, 0, 1); PG8_STAGE_AX(PG8_SA(0, 0), a2, 0, svo, hs2, vA2);
            PG8_BAR; PG8_WAIT_L(0); PG8_MMA(1, 0, At, B0); PG8_BAR; PG8_SCHED;
            PG8_STAGE(PG8_SB(0, 1), b2 + hs2, vB2);
            PG8_WAIT_V(6); PG8_BAR; PG8_MMA(1, 1, At, B1); PG8_BAR;
            PG8_LDB(B0, 1, 0); PG8_SCHED; PG8_LDA(At, 1, 0); PG8_STAGE_AX(PG8_SA(0, 1), a2, 1, svo, hs2, vA2);
            PG8_WAIT_L(8); PG8_BAR; PG8_WAIT_L(0); PG8_MMA(0, 0, At, B0); PG8_BAR; PG8_SCHED;
            PG8_LDB(B1, 1, 1); PG8_STAGE(PG8_SB(1, 0), b3, vB2);
            PG8_BAR; PG8_WAIT_L(0); PG8_MMA(0, 1, At, B1); PG8_BAR;
            PG8_LDA(At, 1, 1); PG8_STAGE_AX(PG8_SA(1, 0), a3, 0, svo, hs2, vA2);
            PG8_BAR; PG8_WAIT_L(0); PG8_MMA(1, 0, At, B0); PG8_BAR; PG8_SCHED;
            PG8_STAGE(PG8_SB(1, 1), b3 + hs2, vB2);
            PG8_WAIT_V(6); PG8_BAR; PG8_MMA(1, 1, At, B1); PG8_BAR;
            }
            if constexpr (DUAL) { if (t + 2 == nt1) E.mid(acc, cur, wr, wc, fr, fq); }
        }
        if constexpr (ALIGN_EPI) { if (wr == 0) PG8_BAR; }
        E(acc, cur, wr, wc, fr, fq);
        if (!has_next) break;
#pragma unroll
        for (int a = 0; a < 2; ++a)
#pragma unroll
            for (int b = 0; b < 2; ++b)
#pragma unroll
                for (int m = 0; m < 4; ++m)
#pragma unroll
                    for (int n = 0; n < 2; ++n) acc[a][b][m][n] = (f32x4){0.f, 0.f, 0.f, 0.f};
        cur = nxt; cA = nA; cB = nB; ++ui;
#pragma unroll
        for (int h = 0; h < 2; ++h)
#pragma unroll
            for (int i = 0; i < 2; ++i) cvo[h][i] = nvo[h][i];
        if constexpr (ALIGN_EPI) { if (wr == 1) PG8_BAR; }
    }
    PG8_WAIT_V(0);
    if constexpr (!ALIGN_EPI) { if (wr == 0) PG8_BAR; }
    PG8_BAR;
#undef PG8_SA
#undef PG8_SB
#undef PG8_STAGE
#undef PG8_STAGE_A
#undef PG8_STAGE_AX
#undef PG8_LDA
#undef PG8_LDB
#undef PG8_MMA
#undef PG8_WAIT_V
#undef PG8_WAIT_L
#undef PG8_BAR
#undef PG8_SCHED
#undef PG8_GOFF
}
}

constexpr size_t MiB = 1u << 20;
constexpr size_t WS_CTL = 0, CTL_ZERO_BYTES = 1 * MiB;
constexpr size_t WS_HMETA = 1 * MiB;
constexpr size_t WS_UMETA = WS_HMETA + 128 * 1024;
constexpr size_t WS_KMETA = WS_HMETA + 256 * 1024;
constexpr size_t WS_VMETA = WS_HMETA + 384 * 1024;
constexpr size_t WS_SSMAB = WS_HMETA + 512 * 1024;
constexpr size_t WS_SSMBB = WS_HMETA + 576 * 1024;
constexpr size_t WS_WRT = 2 * MiB;
constexpr size_t WS_WIN = 3 * MiB;
constexpr size_t WS_WGLU = 33 * MiB;
constexpr size_t WS_WBS = 34 * MiB;
constexpr size_t WS_WBA = 36 * MiB;
constexpr size_t WS_WO = 40 * MiB;
constexpr size_t WS_WUP = 48 * MiB;
constexpr size_t WS_WDN = 176 * MiB;
constexpr size_t WS_HBF = 240 * MiB;
constexpr size_t WS_U = 368 * MiB;
constexpr size_t WS_Q = 400 * MiB;
constexpr size_t WS_K = 464 * MiB;
constexpr size_t WS_V = 528 * MiB;
constexpr size_t WS_SGS = 592 * MiB;
constexpr size_t WS_SGA = 720 * MiB;
constexpr size_t WS_YPRE = 848 * MiB;
constexpr size_t WS_YSSM = 880 * MiB;
constexpr size_t WS_YATT = 912 * MiB;
constexpr size_t WS_END = 976 * MiB;
constexpr size_t WS_Z = 368 * MiB;
constexpr size_t WS_H1 = 624 * MiB;
constexpr size_t WS_HB = 752 * MiB;
constexpr size_t WS_YK = 368 * MiB;
constexpr size_t WS_LIST = 848 * MiB;
constexpr size_t WS_WGT = 852 * MiB;
constexpr size_t WS_POSE = 853 * MiB;
constexpr size_t WS_POSW = 854 * MiB;
constexpr int CW_ECNT = 64;
constexpr int CW_BAR = 4096;

constexpr int RING_BYTES = 131072;
constexpr int MISC_OFF = RING_BYTES;
constexpr int LDS_BYTES = 139264;

#define XB_TMO      128
#define XB_XCNT(j)  (256  + 64 * (j))
#define XB_XSUB(j)  (1280 + 64 * (j))
#define XB_XGEN(j)  (2304 + 64 * (j))
#define XB_TOP      3328
#define XB_TOPGEN   3392
#define XCD_BAR_WORDS 3456
#define XB_SPIN_CAP (1u << 18)
__device__ __forceinline__ unsigned xb_ld(unsigned* p)              { return __hip_atomic_load(p, __ATOMIC_RELAXED, __HIP_MEMORY_SCOPE_AGENT); }
__device__ __forceinline__ unsigned xb_add(unsigned* p, unsigned v) { return __hip_atomic_fetch_add(p, v, __ATOMIC_RELAXED, __HIP_MEMORY_SCOPE_AGENT); }
__device__ __forceinline__ unsigned xb_xcc_id() { return (unsigned)__builtin_amdgcn_s_getreg((3 << 11) | 20) & 0xFu; }
#define XB_SPIN(cond, bar) do { unsigned _sp = 0; while (cond) { __builtin_amdgcn_s_sleep(1); \
    if ((++_sp & 255u) == 0u) { if (xb_ld(&(bar)[XB_TMO])) break; if (_sp > XB_SPIN_CAP) { atomicAdd(&(bar)[XB_TMO], 1u); break; } } } } while (0)
struct XcdBarrier { unsigned* bar; unsigned x; volatile LAS unsigned* st; };
__device__ __forceinline__ XcdBarrier xcd_barrier_post(unsigned* bar, volatile LAS unsigned* st) {
    XcdBarrier b; b.bar = bar; b.x = xb_xcc_id(); b.st = st;
    if (threadIdx.x == 0) (void)xb_add(&bar[XB_XCNT(b.x)], 1u);
    return b;
}
__device__ __forceinline__ void xcd_barrier_complete(unsigned* bar, unsigned x, unsigned& nloc, unsigned& nx) {
    const unsigned G = gridDim.x * gridDim.y * gridDim.z;
    unsigned sum, cnt, mine, sp = 0u;
    for (;;) {
        sum = 0u; cnt = 0u; mine = 0u;
#pragma unroll
        for (unsigned j = 0; j < 16; ++j) { const unsigned c = xb_ld(&bar[XB_XCNT(j)]); sum += c; cnt += (c > 0u) ? 1u : 0u; mine = (j == x) ? c : mine; }
        if (sum == G) break;
        __builtin_amdgcn_s_sleep(1);
        if ((++sp & 255u) == 0u) { if (xb_ld(&bar[XB_TMO])) break; if (sp > XB_SPIN_CAP) { atomicAdd(&bar[XB_TMO], 1u); break; } }
    }
    nloc = mine > 0u ? mine : 1u; nx = cnt > 0u ? cnt : 1u;
}
__device__ __forceinline__ void xcd_barrier(const XcdBarrier& b) {
    asm volatile("s_waitcnt vmcnt(0)" ::: "memory");
    __syncthreads();
    if (threadIdx.x == 0) {
        unsigned* bar = b.bar;
        __builtin_amdgcn_s_waitcnt(0);
        unsigned nloc = b.st[0], nx = b.st[1];
        if (nloc == 0u) { xcd_barrier_complete(bar, b.x, nloc, nx); b.st[0] = nloc; b.st[1] = nx; }
        const unsigned old = xb_add(&bar[XB_XSUB(b.x)], 1u);
        const unsigned gen = old / nloc;
        if (old + 1u == (gen + 1u) * nloc) {
            __builtin_amdgcn_fence(__ATOMIC_RELEASE, "agent");
            asm volatile("s_waitcnt vmcnt(0)" ::: "memory");
            const unsigned og = xb_add(&bar[XB_TOP], 1u);
            const unsigned tg = og / nx;
            if (og + 1u == (tg + 1u) * nx) xb_add(&bar[XB_TOPGEN], 1u);
            else XB_SPIN(xb_ld(&bar[XB_TOPGEN]) == tg, bar);
            __builtin_amdgcn_fence(__ATOMIC_ACQUIRE, "agent");
            xb_add(&bar[XB_XGEN(b.x)], 1u);
            asm volatile("s_waitcnt vmcnt(0)" ::: "memory");
        } else {
            XB_SPIN(xb_ld(&bar[XB_XGEN(b.x)]) == gen, bar);
            __builtin_amdgcn_fence(__ATOMIC_ACQUIRE, "agent");
            asm volatile("s_waitcnt vmcnt(0)" ::: "memory");
        }
    }
    __syncthreads();
}

using pg8::Unit;
__device__ __forceinline__ u32x4 pack8(const f32x4 v0, const f32x4 v1) { u32x4 w; w.x = cvt_pk_bf16(v0[0], v0[1]); w.y = cvt_pk_bf16(v0[2], v0[3]); w.z = cvt_pk_bf16(v1[0], v1[1]); w.w = cvt_pk_bf16(v1[2], v1[3]); return w; }
__device__ __forceinline__ void unpack8(const u32x4 w, f32x4& v0, f32x4& v1) { v0 = (f32x4){bf_lo(w.x), bf_hi(w.x), bf_lo(w.y), bf_hi(w.y)}; v1 = (f32x4){bf_lo(w.z), bf_hi(w.z), bf_lo(w.w), bf_hi(w.w)}; }

struct EpiProj {
    static constexpr bool PERM = true;
    bf16_t *U, *Q, *K, *V, *RHO, *SGA;
    __device__ __forceinline__ void operator()(const f32x4 (&acc)[2][2][4][2], const Unit& u, int wr, int wc, int fr, int fq) const {
        const int pn = u.pn;
        if (pn >= 14) {
            const int row0 = u.pm * 256 + wr * 64 + fr, col0 = (pn - 14) * 128 + wc * 32 + 8 * fq;
#pragma unroll
            for (int ai = 0; ai < 2; ++ai)
#pragma unroll
                for (int m = 0; m < 4; ++m) { const size_t off = (size_t)(row0 + ai * 128 + m * 16) * DM + col0; f32x4 r0, r1, a0, a1;
#pragma unroll
                    for (int j = 0; j < 4; ++j) { const float es0 = __expf(-acc[ai][0][m][0][j]), es1 = __expf(-acc[ai][0][m][1][j]), ea0 = __expf(-acc[ai][1][m][0][j]), ea1 = __expf(-acc[ai][1][m][1][j]);
                        a0[j] = __builtin_amdgcn_rcpf(1.f + ea0); a1[j] = __builtin_amdgcn_rcpf(1.f + ea1);
                        r0[j] = (1.f + ea0) * __builtin_amdgcn_rcpf(1.f + es0); r1[j] = (1.f + ea1) * __builtin_amdgcn_rcpf(1.f + es1); }
                    *(u32x4*)(RHO + off) = pack8(r0, r1); *(u32x4*)(SGA + off) = pack8(a0, a1); }
            return;
        }
        bf16_t* base; int ldc, ct, mode;
        if (pn < 2) { base = U; ldc = 512; ct = pn; mode = 0; }
        else if (pn < 6) { base = Q; ldc = 1024; ct = pn - 2; mode = 1; }
        else if (pn < 10) { base = K; ldc = 1024; ct = pn - 6; mode = 0; }
        else { base = V; ldc = 1024; ct = pn - 10; mode = 0; }
        const int row0 = u.pm * 256 + wr * 64 + fr, col0 = ct * 256 + wc * 32 + 8 * fq;
#pragma unroll
        for (int ai = 0; ai < 2; ++ai)
#pragma unroll
            for (int m = 0; m < 4; ++m) { bf16_t* rowp = base + (size_t)(row0 + ai * 128 + m * 16) * ldc + col0;
#pragma unroll
                for (int bj = 0; bj < 2; ++bj) { f32x4 v0 = acc[ai][bj][m][0], v1 = acc[ai][bj][m][1];
                    if (mode == 1) { v0 = v0 * QSCALE; v1 = v1 * QSCALE; }
                    *(u32x4*)(rowp + bj * 128) = pack8(v0, v1); } }
    }
};
struct EpiGlu {
    static constexpr bool PERM = true;
    const bf16_t* YPRE; bf16_t* YSSM;
    __device__ __forceinline__ void operator()(const f32x4 (&acc)[2][2][4][2], const Unit& u, int wr, int wc, int fr, int fq) const {
        const int row0 = u.pm * 256 + wr * 64 + fr, col0 = u.pn * 256 + wc * 32 + 8 * fq;
#pragma unroll
        for (int ai = 0; ai < 2; ++ai)
#pragma unroll
            for (int m = 0; m < 4; ++m) { const size_t off = (size_t)(row0 + ai * 128 + m * 16) * SSMW + col0;
#pragma unroll
                for (int bj = 0; bj < 2; ++bj) { const u32x4 yw = *(const u32x4*)(YPRE + off + bj * 128); f32x4 y0, y1; unpack8(yw, y0, y1);
                    f32x4 v0 = acc[ai][bj][m][0], v1 = acc[ai][bj][m][1];
#pragma unroll
                    for (int j = 0; j < 4; ++j) { v0[j] = y0[j] * sigmoidf_(v0[j]); v1[j] = y1[j] * sigmoidf_(v1[j]); }
                    *(u32x4*)(YSSM + off + bj * 128) = pack8(v0, v1); } }
    }
};
template <int SECOND> struct EpiMerge {
    static constexpr bool PERM = true;
    const bf16_t* SG; bf16_t* MG;
    __device__ __forceinline__ void operator()(const f32x4 (&acc)[2][2][4][2], const Unit& u, int wr, int wc, int fr, int fq) const {
        const int row0 = u.pm * 256 + wr * 64 + fr, col0 = u.pn * 256 + wc * 32 + 8 * fq;
#pragma unroll
        for (int ai = 0; ai < 2; ++ai)
#pragma unroll
            for (int m = 0; m < 4; ++m) { const size_t off = (size_t)(row0 + ai * 128 + m * 16) * DM + col0;
#pragma unroll
                for (int bj = 0; bj < 2; ++bj) { const u32x4 gw = *(const u32x4*)(SG + off + bj * 128); f32x4 g0, g1; unpack8(gw, g0, g1);
                    f32x4 v0 = acc[ai][bj][m][0] * g0, v1 = acc[ai][bj][m][1] * g1;
                    if (SECOND) { const u32x4 pw = *(const u32x4*)(MG + off + bj * 128); f32x4 p0, p1; unpack8(pw, p0, p1); v0 = v0 + p0; v1 = v1 + p1; }
                    *(u32x4*)(MG + off + bj * 128) = pack8(v0, v1); } }
    }
};
struct EpiMergeF {
    static constexpr bool PERM = true;
    const bf16_t* SGS; const bf16_t* SGA; bf16_t* MG;
    __device__ __forceinline__ void mid(f32x4 (&acc)[2][2][4][2], const Unit& u, int wr, int wc, int fr, int fq) const {
        asm volatile("" : "+v"(fr), "+v"(fq));
        const int row0 = u.pm * 256 + wr * 64 + fr, col0 = u.pn * 256 + wc * 32 + 8 * fq;
#pragma unroll
        for (int ai = 0; ai < 2; ++ai)
#pragma unroll
            for (int m = 0; m < 4; ++m) { const size_t off = (size_t)(row0 + ai * 128 + m * 16) * DM + col0;
#pragma unroll
                for (int bj = 0; bj < 2; ++bj) { const u32x4 sw = *(const u32x4*)(SGS + off + bj * 128);
                    f32x4 s0, s1; unpack8(sw, s0, s1);
                    acc[ai][bj][m][0] = acc[ai][bj][m][0] * s0; acc[ai][bj][m][1] = acc[ai][bj][m][1] * s1; }
                asm volatile("" ::: "memory"); }
    }
    __device__ __forceinline__ void operator()(const f32x4 (&acc)[2][2][4][2], const Unit& u, int wr, int wc, int fr, int fq) const {
        const int row0 = u.pm * 256 + wr * 64 + fr, col0 = u.pn * 256 + wc * 32 + 8 * fq;
#pragma unroll
        for (int ai = 0; ai < 2; ++ai)
#pragma unroll
            for (int m = 0; m < 4; ++m) { const size_t off = (size_t)(row0 + ai * 128 + m * 16) * DM + col0;
#pragma unroll
                for (int bj = 0; bj < 2; ++bj) { const u32x4 gw = *(const u32x4*)(SGA + off + bj * 128); f32x4 g0, g1; unpack8(gw, g0, g1);
                    *(u32x4*)(MG + off + bj * 128) = pack8(acc[ai][bj][m][0] * g0, acc[ai][bj][m][1] * g1); } }
    }
};
struct EpiZ {
    static constexpr bool PERM = true;
    const bf16_t* HBF; bf16_t* Z;
    __device__ __forceinline__ void operator()(const f32x4 (&acc)[2][2][4][2], const Unit& u, int wr, int wc, int fr, int fq) const {
        const int row0 = u.pm * 256 + wr * 64 + fr, col0 = u.pn * 256 + wc * 32 + 8 * fq;
#pragma unroll
        for (int ai = 0; ai < 2; ++ai)
#pragma unroll
            for (int m = 0; m < 4; ++m) { const size_t off = (size_t)(row0 + ai * 128 + m * 16) * DM + col0;
#pragma unroll
                for (int bj = 0; bj < 2; ++bj) { const u32x4 hw = *(const u32x4*)(HBF + off + bj * 128); f32x4 h0, h1; unpack8(hw, h0, h1);
                    *(u32x4*)(Z + off + bj * 128) = pack8(acc[ai][bj][m][0] + h0 * ALPHA, acc[ai][bj][m][1] + h1 * ALPHA); } }
    }
};
struct EpiSwiglu {
    static constexpr bool PERM = true;
    bf16_t* HB; const int* LIST; const float* WGT; int* POSE; float* POSW;
    __device__ __forceinline__ void operator()(const f32x4 (&acc)[2][2][4][2], const Unit& u, int wr, int wc, int fr, int fq) const {
        const int row0 = u.pm * 256 + wr * 64 + fr, col0 = (u.pn & 3) * 128 + wc * 32 + 8 * fq;
#pragma unroll
        for (int ai = 0; ai < 2; ++ai)
#pragma unroll
            for (int m = 0; m < 4; ++m) { f32x4 v0, v1;
#pragma unroll
                for (int j = 0; j < 4; ++j) { const float g0 = acc[ai][0][m][0][j], g1 = acc[ai][0][m][1][j];
                    v0[j] = g0 * sigmoidf_(g0) * acc[ai][1][m][0][j]; v1[j] = g1 * sigmoidf_(g1) * acc[ai][1][m][1][j]; }
                *(u32x4*)(HB + (size_t)(row0 + ai * 128 + m * 16) * DFF + col0) = pack8(v0, v1); }
        if ((u.pn & 3) == 0 && wc == 0 && fq == 0) {
#pragma unroll
            for (int ai = 0; ai < 2; ++ai)
#pragma unroll
                for (int m = 0; m < 4; ++m) { const int r = wr * 64 + fr + ai * 128 + m * 16, slot = u.s0 + r; int entry = -1; float w = 0.f;
                    if (slot < u.cnt) { entry = LIST[(size_t)u.e * CAP + slot]; w = WGT[entry]; }
                    POSE[u.pm * 256 + r] = entry; POSW[u.pm * 256 + r] = w; }
        }
    }
};
struct EpiDown {
    static constexpr bool PERM = true;
    const int* POSE; const float* POSW; bf16_t* YK;
    __device__ __forceinline__ void operator()(const f32x4 (&acc)[2][2][4][2], const Unit& u, int wr, int wc, int fr, int fq) const {
        const int r0 = u.pm * 256 + wr * 64 + fr, col0 = (u.pn & 7) * 256 + wc * 32 + 8 * fq;
        int en[2][4]; float ww[2][4];
#pragma unroll
        for (int ai = 0; ai < 2; ++ai)
#pragma unroll
            for (int m = 0; m < 4; ++m) { en[ai][m] = POSE[r0 + ai * 128 + m * 16]; ww[ai][m] = POSW[r0 + ai * 128 + m * 16]; }
#pragma unroll
        for (int ai = 0; ai < 2; ++ai)
#pragma unroll
            for (int m = 0; m < 4; ++m) {
                if (en[ai][m] >= 0) { const float w = ww[ai][m]; bf16_t* rowp = YK + (size_t)en[ai][m] * DM + col0;
#pragma unroll
                    for (int bj = 0; bj < 2; ++bj) *(u32x4*)(rowp + bj * 128) = pack8(acc[ai][bj][m][0] * w, acc[ai][bj][m][1] * w); } }
    }
};
struct MoeOrder {
    int G, c, shift, NB; const LAS int* blkexp; const LAS int* blkstart; const LAS int* cntE; const int* LIST;
    __device__ __forceinline__ bool next(int i, Unit& u) const {
        const long L = (long)i * G + c; if (L >= ((long)NB << shift)) return false;
        const int blk = (int)(L >> shift), tile = (int)(L & ((1 << shift) - 1)), e = blkexp[blk];
        u.pm = blk; u.pn = (e << shift) + tile; u.e = e; u.s0 = (blk - blkstart[e]) * 256; u.cnt = cntE[e]; return true;
    }
    __device__ __forceinline__ int arow(const Unit& u, int r) const { const int slot = u.s0 + r; const int entry = slot < u.cnt ? LIST[(size_t)u.e * CAP + slot] : 0; return entry >> 1; }
};

struct Ctx { LAS unsigned char* lds; int tid, lane, wave, vcu, G; };

__device__ __forceinline__ void transpose_item(const float* W, int K, int N, bf16_t* WT, int kb, int nb, int dst_row0, LAS float* scr, int lane) {
    const int k0 = 64 * kb, n0 = 32 * nb;
    float tv[32];
#pragma unroll
    for (int i = 0; i < 32; ++i) tv[i] = W[(size_t)(k0 + 2 * i + (lane >> 5)) * N + n0 + (lane & 31)];
#pragma unroll
    for (int i = 0; i < 32; ++i) scr[(2 * i + (lane >> 5)) * 33 + (lane & 31)] = tv[i];
    asm volatile("s_waitcnt lgkmcnt(0)" ::: "memory");
    const int c = lane & 7;
#pragma unroll
    for (int j = 0; j < 4; ++j) { const int n = (lane >> 3) + 8 * j; const LAS float* s = scr + (8 * c) * 33 + n;
        u32x4 o; o.x = cvt_pk_bf16(s[0 * 33], s[1 * 33]); o.y = cvt_pk_bf16(s[2 * 33], s[3 * 33]); o.z = cvt_pk_bf16(s[4 * 33], s[5 * 33]); o.w = cvt_pk_bf16(s[6 * 33], s[7 * 33]);
        *(u32x4*)(WT + (size_t)(dst_row0 + n) * K + k0 + 8 * c) = o; }
    asm volatile("s_waitcnt lgkmcnt(0)" ::: "memory");
}
__device__ __forceinline__ void ln_stats(f32x4 (&v)[8], float& mean, float& rstd) {
    float s = 0.f;
#pragma unroll
    for (int j = 0; j < 8; ++j) s += (v[j].x + v[j].y) + (v[j].z + v[j].w);
    mean = wave_sum(s) * (1.f / DM); float s2 = 0.f;
#pragma unroll
    for (int j = 0; j < 8; ++j) { const f32x4 d = v[j] - mean; s2 += (d.x * d.x + d.y * d.y) + (d.z * d.z + d.w * d.w); }
    rstd = 1.f / sqrtf(wave_sum(s2) * (1.f / DM) + LN_EPS);
}

__device__ __forceinline__ void p0_prologue(const Ctx& C, const float* const* in, unsigned char* ws) {
    LAS float* scr = (LAS float*)(C.lds + C.wave * 16384);
    const int gw = C.vcu * 8 + C.wave, NGW = C.G * 8;
    bf16_t* WinT = (bf16_t*)(ws + WS_WIN); bf16_t* WgluT = (bf16_t*)(ws + WS_WGLU); bf16_t* WbsT = (bf16_t*)(ws + WS_WBS); bf16_t* WbaT = (bf16_t*)(ws + WS_WBA);
    bf16_t* WoT = (bf16_t*)(ws + WS_WO); bf16_t* WupT = (bf16_t*)(ws + WS_WUP); bf16_t* WdnT = (bf16_t*)(ws + WS_WDN);
    constexpr int I_WIN = (DM / 64) * (INC / 32), I_GLU = (SSMW / 64) * (SSMW / 32), I_BS = (SSMW / 64) * (DM / 32), I_BA = (AW / 64) * (DM / 32), I_WO = (DM / 64) * (DM / 32);
    constexpr int I_EXP = NE * 512;
    constexpr int NITEMS = I_WIN + I_GLU + I_BS + I_BA + I_WO + 3 * I_EXP;
    for (int it = gw; it < NITEMS; it += NGW) {
        int r = it;
        if (r < I_WIN) { const int nblk = INC / 32, nb = r % nblk, n0 = 32 * nb;
            const int drow = n0 < 3584 ? n0 : (n0 < 5632 ? 3584 + ((n0 - 3584) >> 7) * 256 + ((n0 - 3584) & 127) : 3584 + ((n0 - 5632) >> 7) * 256 + 128 + ((n0 - 5632) & 127));
            transpose_item(in[4], DM, INC, WinT, r / nblk, nb, drow, scr, C.lane); continue; } r -= I_WIN;
        if (r < I_GLU) { const int nblk = SSMW / 32; transpose_item(in[13], SSMW, SSMW, WgluT, r / nblk, r % nblk, 32 * (r % nblk), scr, C.lane); continue; } r -= I_GLU;
        if (r < I_BS) { const int nblk = DM / 32; transpose_item(in[19], SSMW, DM, WbsT, r / nblk, r % nblk, 32 * (r % nblk), scr, C.lane); continue; } r -= I_BS;
        if (r < I_BA) { const int nblk = DM / 32; transpose_item(in[20], AW, DM, WbaT, r / nblk, r % nblk, 32 * (r % nblk), scr, C.lane); continue; } r -= I_BA;
        if (r < I_WO) { const int nblk = DM / 32; transpose_item(in[21], DM, DM, WoT, r / nblk, r % nblk, 32 * (r % nblk), scr, C.lane); continue; } r -= I_WO;
        if (r < 2 * I_EXP) { const int up = r >= I_EXP ? 1 : 0; r -= up * I_EXP; const int e = r >> 9, rr = r & 511, kb = rr >> 4, nb = rr & 15, n0 = 32 * nb;
            transpose_item(in[28 + up] + (size_t)e * DM * DFF, DM, DFF, WupT, kb, nb, e * 1024 + (n0 >> 7) * 256 + up * 128 + (n0 & 127), scr, C.lane); continue; }
        r -= 2 * I_EXP;
        { const int e = r >> 9, rr = r & 511, kb = rr >> 6, nb = rr & 63; transpose_item(in[30] + (size_t)e * DFF * DM, DFF, DM, WdnT, kb, nb, e * 2048 + 32 * nb, scr, C.lane); }
    }
    const int gt = C.vcu * 512 + C.tid, NGT = C.G * 512;
    { float* WrT = (float*)(ws + WS_WRT);
      for (int i = gt; i < 36 * DM; i += NGT) { const int n = i / DM, k = i % DM; WrT[i] = n < 4 ? in[24][k * 4 + n] : in[26][k * 32 + (n - 4)]; } }
    { u32x4* kz = (u32x4*)(ws + WS_KMETA + 16 * 1024 * 2); u32x4* vz = (u32x4*)(ws + WS_VMETA + 16 * 1024 * 2);
      for (int i = gt; i < 48 * 1024 * 2 / 16; i += NGT) { kz[i] = (u32x4){0u, 0u, 0u, 0u}; vz[i] = (u32x4){0u, 0u, 0u, 0u}; } }
    { float* AB = (float*)(ws + WS_SSMAB); float* BB = (float*)(ws + WS_SSMBB);
      for (int i = gt; i < NGRP * NST; i += NGT) { const int g = i >> 6;
        const double lre = fmin((double)in[5][i], -1e-4), lim = (double)in[6][i], dt = exp((double)in[7][g]);
        const double mag = exp(lre * dt), abr = mag * cos(lim * dt), abi = mag * sin(lim * dt), den = lre * lre + lim * lim, nr = abr - 1.0, ni = abi;
        const double zr = (nr * lre + ni * lim) / den, zi = (ni * lre - nr * lim) / den;
        AB[i] = (float)abr; AB[NGRP * NST + i] = (float)abi;
#pragma unroll 4
        for (int c = 0; c < 16; ++c) { const double br = (double)in[8][i * 16 + c], bi = (double)in[9][i * 16 + c];
            BB[i * 16 + c] = (float)(zr * br - zi * bi); BB[NGRP * NST * 16 + i * 16 + c] = (float)(zr * bi + zi * br); } } }
    const float* lg = in[2]; const float* lb = in[3];
    bf16_t* HBF = (bf16_t*)(ws + WS_HBF);
    for (int m = gw; m < T + NMETA; m += 2 * NGW) {
        const int m2 = (m + NGW < T + NMETA) ? m + NGW : m;
        const float* xa = m >= T ? in[1] + (size_t)(m - T) * DM : in[0] + (size_t)m * DM; const float* xb = m2 >= T ? in[1] + (size_t)(m2 - T) * DM : in[0] + (size_t)m2 * DM;
        f32x4 va[8], vb[8];
#pragma unroll
        for (int j = 0; j < 8; ++j) { va[j] = *(const f32x4*)(xa + 256 * j + 4 * C.lane); vb[j] = *(const f32x4*)(xb + 256 * j + 4 * C.lane); }
        float meana, rstda, meanb, rstdb; ln_stats(va, meana, rstda); ln_stats(vb, meanb, rstdb);
#pragma unroll
        for (int rr = 0; rr < 2; ++rr) { const int mm = rr ? m2 : m; if (rr == 1 && m2 == m) break; const bool meta = mm >= T;
#pragma unroll
            for (int j = 0; j < 8; ++j) { const f32x4 gg = *(const f32x4*)(lg + 256 * j + 4 * C.lane), bb = *(const f32x4*)(lb + 256 * j + 4 * C.lane);
                const f32x4 o = rr ? (vb[j] - meanb) * rstdb * gg + bb : (va[j] - meana) * rstda * gg + bb;
                if (meta) *(f32x4*)((float*)(ws + WS_HMETA) + (size_t)(mm - T) * DM + 256 * j + 4 * C.lane) = o;
                else { u32x2 w; w.x = cvt_pk_bf16(o.x, o.y); w.y = cvt_pk_bf16(o.z, o.w); *(u32x2*)(HBF + (size_t)mm * DM + 256 * j + 4 * C.lane) = w; } } }
    }
}

__device__ __forceinline__ void p1_meta_proj(const Ctx& C, unsigned char* ws) {
    const bf16_t* WinT = (const bf16_t*)(ws + WS_WIN); const float* HM = (const float*)(ws + WS_HMETA);
    const int gw = C.vcu * 8 + C.wave, NGW = C.G * 8;
    for (int it = gw; it < 640; it += NGW) {
        const int nidx = 4 * it; const int col0 = nidx < 512 ? nidx : (nidx < 1536 ? 1536 + (nidx - 512) : 2560 + (nidx - 1536));
        float acc[16][4];
#pragma unroll
        for (int r = 0; r < 16; ++r)
#pragma unroll
            for (int c = 0; c < 4; ++c) acc[r][c] = 0.f;
#pragma unroll 1
        for (int j = 0; j < 4; ++j) { const int k0 = j * 512 + C.lane * 8;
            f32x4 w0[4], w1[4];
#pragma unroll
            for (int c = 0; c < 4; ++c) { const u32x4 ww = *(const u32x4*)(WinT + (size_t)(col0 + c) * DM + k0); unpack8(ww, w0[c], w1[c]); }
#pragma unroll
            for (int r = 0; r < 16; ++r) { const f32x4 h0 = *(const f32x4*)(HM + r * DM + k0), h1 = *(const f32x4*)(HM + r * DM + k0 + 4);
#pragma unroll
                for (int c = 0; c < 4; ++c) { const f32x4 p = h0 * w0[c] + h1 * w1[c]; acc[r][c] += (p.x + p.y) + (p.z + p.w); } } }
        float mine = 0.f;
#pragma unroll
        for (int r = 0; r < 16; ++r)
#pragma unroll
            for (int c = 0; c < 4; ++c) { const float s = wave_sum(acc[r][c]); mine = (C.lane == r * 4 + c) ? s : mine; }
        const int r = C.lane >> 2, c = C.lane & 3;
        if (nidx < 512) ((float*)(ws + WS_UMETA))[r * SSMW + nidx + c] = mine;
        else if (nidx < 1536) ((bf16_t*)(ws + WS_KMETA))[r * AW + (nidx - 512) + c] = (bf16_t)(cvt_pk_bf16(mine, 0.f) & 0xffffu);
        else ((bf16_t*)(ws + WS_VMETA))[r * AW + (nidx - 1536) + c] = (bf16_t)(cvt_pk_bf16(mine, 0.f) & 0xffffu);
    }
}

__device__ __forceinline__ float gelu_tanh(float x) { const float u = 1.5957691216057308f * (x + 0.044715f * x * x * x); return x / (1.0f + __expf(-u)); }
#define SC_HANDOFF(Q) do { _Pragma("unroll") for (int st_ = 0; st_ < 2; ++st_) { \
        auto rr_ = __builtin_amdgcn_permlane32_swap(__float_as_uint(sre[st_]), __float_as_uint(sre[st_]), false, false); sre[st_] = __uint_as_float(rr_[(Q) & 1]); \
        auto ri_ = __builtin_amdgcn_permlane32_swap(__float_as_uint(sim[st_]), __float_as_uint(sim[st_]), false, false); sim[st_] = __uint_as_float(ri_[(Q) & 1]); } } while (0)
template <bool STORE> __device__ __forceinline__ void scan_block(f32x16 (&buv)[4], float (&sre)[2], float (&sim)[2], const float (&are)[2], const float (&aim)[2], int hi) {
    float bu[4][16];
#pragma unroll
    for (int t = 0; t < 4; ++t)
#pragma unroll
        for (int r = 0; r < 16; ++r) bu[t][r] = buv[t][r];
#pragma unroll
    for (int q = 0; q < 8; ++q) {
        const bool act = (hi == (q & 1));
#pragma unroll
        for (int i = 0; i < 4; ++i) { const int reg = 4 * (q >> 1) + i;
#pragma unroll
            for (int st = 0; st < 2; ++st) {
                const float nre = are[st] * sre[st] - aim[st] * sim[st] + bu[st][reg];
                const float nim = are[st] * sim[st] + aim[st] * sre[st] + bu[2 + st][reg];
                sre[st] = nre; sim[st] = nim;
                if (STORE) { bu[st][reg] = act ? nre : bu[st][reg]; bu[2 + st][reg] = act ? nim : bu[2 + st][reg]; } } }
        SC_HANDOFF(q);
    }
    if (STORE) {
#pragma unroll
        for (int t = 0; t < 4; ++t)
#pragma unroll
            for (int r = 0; r < 16; ++r) buv[t][r] = bu[t][r];
    }
}
__device__ __forceinline__ void p2_scan(const Ctx& C, const float* const* in, unsigned char* ws) {
    const int lane = C.lane, wave = C.wave, r32 = lane & 31, hi = lane >> 5, fr = lane & 15, fq = lane >> 4;
    const bf16_t* U = (const bf16_t*)(ws + WS_U); const float* UM = (const float*)(ws + WS_UMETA); bf16_t* YPRE = (bf16_t*)(ws + WS_YPRE);
    const float* AB = (const float*)(ws + WS_SSMAB); const float* BB = (const float*)(ws + WS_SSMBB);
    LAS unsigned char* Sl = C.lds + wave * 10752;
    LAS unsigned char* Yl = Sl + 9728;
    LAS float* E = (LAS float*)(C.lds + 86016);
    for (int item = C.vcu; item < NB_ * NGRP; item += C.G) {
        const int b = item >> 5, g = item & 31;
        const bf16_t* Ub = U + ((size_t)b * SEQ + wave * 256) * SSMW + 16 * g;
        bf16x8 ufa[8];
#pragma unroll
        for (int blk = 0; blk < 8; ++blk) ufa[blk] = *(const bf16x8*)(Ub + (size_t)(32 * blk + r32) * SSMW + 8 * hi);
        float are[2], aim[2];
#pragma unroll
        for (int st = 0; st < 2; ++st) { are[st] = AB[g * 64 + 32 * st + r32]; aim[st] = AB[NGRP * NST + g * 64 + 32 * st + r32]; }
        bf16x8 Bf[4];
#pragma unroll
        for (int ri = 0; ri < 2; ++ri)
#pragma unroll
            for (int st = 0; st < 2; ++st) { const float* src = BB + ri * (NGRP * NST * 16) + (g * 64 + 32 * st + r32) * 16 + 8 * hi;
                const f32x4 x0 = *(const f32x4*)src, x1 = *(const f32x4*)(src + 4); Bf[2 * ri + st] = __builtin_bit_cast(bf16x8, pack8(x0, x1)); }
        bf16x8 Cf[5];
#pragma unroll
        for (int ks = 0; ks < 4; ++ks) { const int k0 = 32 * ks + 8 * fq; const float* src = (ks < 2 ? in[10] : in[11]) + (g * 16 + fr) * 64 + (k0 & 63);
            f32x4 x0 = *(const f32x4*)src, x1 = *(const f32x4*)(src + 4); if (ks >= 2) { x0 = -x0; x1 = -x1; } Cf[ks] = __builtin_bit_cast(bf16x8, pack8(x0, x1)); }
        { const float dsk = in[12][g * 16 + fr]; f32x4 x0, x1;
#pragma unroll
          for (int j = 0; j < 4; ++j) { x0[j] = (fq < 2 && 8 * fq + j == fr) ? dsk : 0.f; x1[j] = (fq < 2 && 8 * fq + 4 + j == fr) ? dsk : 0.f; }
          Cf[4] = __builtin_bit_cast(bf16x8, pack8(x0, x1)); }
        float sre[2] = {0.f, 0.f}, sim[2] = {0.f, 0.f}, mre[2] = {0.f, 0.f}, mim[2] = {0.f, 0.f};
        if (wave == 0) {
            f32x4 x0 = (f32x4){0.f, 0.f, 0.f, 0.f}, x1 = x0;
            if (r32 >= 16) { const float* src = UM + (r32 - 16) * SSMW + 16 * g + 8 * hi; x0 = *(const f32x4*)src; x1 = *(const f32x4*)(src + 4); }
            const bf16x8 uf = __builtin_bit_cast(bf16x8, pack8(x0, x1));
            f32x16 bu[4];
#pragma unroll
            for (int t = 0; t < 4; ++t) bu[t] = __builtin_amdgcn_mfma_f32_32x32x16_bf16(uf, Bf[t], (f32x16){}, 0, 0, 0);
            scan_block<false>(bu, sre, sim, are, aim, hi);
            mre[0] = sre[0]; mre[1] = sre[1]; mim[0] = sim[0]; mim[1] = sim[1];
        }
#pragma unroll
        for (int blk = 0; blk < 8; ++blk) {
            f32x16 bu[4];
#pragma unroll
            for (int t = 0; t < 4; ++t) bu[t] = __builtin_amdgcn_mfma_f32_32x32x16_bf16(ufa[blk], Bf[t], (f32x16){}, 0, 0, 0);
            scan_block<false>(bu, sre, sim, are, aim, hi);
        }
        if (hi == 0) {
#pragma unroll
            for (int st = 0; st < 2; ++st) { E[wave * 128 + st * 64 + r32] = sre[st]; E[wave * 128 + st * 64 + 32 + r32] = sim[st]; } }
        __syncthreads();
        if (wave == 0) { sre[0] = mre[0]; sre[1] = mre[1]; sim[0] = mim[0]; sim[1] = mim[1]; }
        else {
            float pr[2], pi[2];
#pragma unroll
            for (int st = 0; st < 2; ++st) { pr[st] = are[st]; pi[st] = aim[st];
#pragma unroll
                for (int k = 0; k < 8; ++k) { const float nr = pr[st] * pr[st] - pi[st] * pi[st], ni = 2.f * pr[st] * pi[st]; pr[st] = nr; pi[st] = ni; }
                sre[st] = E[st * 64 + r32]; sim[st] = E[st * 64 + 32 + r32]; }
            for (int j = 1; j < wave; ++j) {
#pragma unroll
                for (int st = 0; st < 2; ++st) { const float er = E[j * 128 + st * 64 + r32], ei = E[j * 128 + st * 64 + 32 + r32];
                    const float nr = pr[st] * sre[st] - pi[st] * sim[st] + er, ni = pr[st] * sim[st] + pi[st] * sre[st] + ei; sre[st] = nr; sim[st] = ni; } }
        }
#pragma unroll
        for (int blk = 0; blk < 8; ++blk) {
            f32x16 bu[4];
#pragma unroll
            for (int t = 0; t < 4; ++t) bu[t] = __builtin_amdgcn_mfma_f32_32x32x16_bf16(ufa[blk], Bf[t], (f32x16){}, 0, 0, 0);
            scan_block<true>(bu, sre, sim, are, aim, hi);
#pragma unroll
            for (int reg = 0; reg < 16; ++reg) { const int tok = (reg & 3) + 8 * (reg >> 2) + 4 * hi;
#pragma unroll
                for (int t = 0; t < 4; ++t) *(LAS bf16_t*)(Sl + tok * 304 + (32 * t + r32) * 2) = (bf16_t)(cvt_pk_bf16(bu[t][reg], 0.f) & 0xffffu); }
            *(LAS bf16x8*)(Sl + r32 * 304 + (128 + 8 * hi) * 2) = ufa[blk];
            f32x4 y[2];
#pragma unroll
            for (int mt = 0; mt < 2; ++mt) { y[mt] = (f32x4){0.f, 0.f, 0.f, 0.f};
#pragma unroll
                for (int ks = 0; ks < 4; ++ks) { const bf16x8 af = *(const LAS bf16x8*)(Sl + (16 * mt + fr) * 304 + (32 * ks + 8 * fq) * 2);
                    y[mt] = __builtin_amdgcn_mfma_f32_16x16x32_bf16(af, Cf[ks], y[mt], 0, 0, 0); }
                bf16x8 au = *(const LAS bf16x8*)(Sl + (16 * mt + fr) * 304 + (128 + 8 * (fq & 1)) * 2); if (fq >= 2) au = (bf16x8){};
                y[mt] = __builtin_amdgcn_mfma_f32_16x16x32_bf16(au, Cf[4], y[mt], 0, 0, 0); }
#pragma unroll
            for (int mt = 0; mt < 2; ++mt)
#pragma unroll
                for (int reg = 0; reg < 4; ++reg) *(LAS bf16_t*)(Yl + (16 * mt + 4 * fq + reg) * 32 + fr * 2) = (bf16_t)(cvt_pk_bf16(gelu_tanh(y[mt][reg]), 0.f) & 0xffffu);
            const u32x4 yo = *(const LAS u32x4*)(Yl + (lane >> 1) * 32 + (lane & 1) * 16);
            *(u32x4*)(YPRE + ((size_t)b * SEQ + wave * 256 + 32 * blk + (lane >> 1)) * SSMW + 16 * g + 8 * (lane & 1)) = yo;
        }
        __syncthreads();
    }
}

__device__ __forceinline__ int crow(int r, int hi) { return (r & 3) + 8 * (r >> 2) + 4 * hi; }
typedef short v4i16_t __attribute__((ext_vector_type(4)));
__device__ __forceinline__ s16x4 vtr(const LAS unsigned char* p) { return __builtin_bit_cast(s16x4, __builtin_amdgcn_ds_read_tr16_b64_v4i16((LAS v4i16_t*)p)); }
__device__ __forceinline__ float half_swap_max(float x) { auto rr = __builtin_amdgcn_permlane32_swap(__float_as_uint(x), __float_as_uint(x), false, false); return fmaxf(__uint_as_float(rr[0]), __uint_as_float(rr[1])); }
__device__ __forceinline__ float half_swap_sum(float x) { auto rr = __builtin_amdgcn_permlane32_swap(__float_as_uint(x), __float_as_uint(x), false, false); return __uint_as_float(rr[0]) + __uint_as_float(rr[1]); }

__device__ __forceinline__ void attn_unit(const Ctx& C, const bf16_t* Qg, const bf16_t* Kg, const bf16_t* Vg, const bf16_t* KM, const bf16_t* VM, bf16_t* Y,
                                          const float* subg, float lam, int b, int h, int qt) {
    LAS unsigned char* lds = C.lds;
    const int lane = C.lane, wave = C.wave, r32 = lane & 31, hi = lane >> 5, qb = wave >> 1, map = wave & 1;
    const int q0 = qt * 128 + qb * 32;
    const size_t rowb = (size_t)b * SEQ;
    bf16x8 qr[4];
    { const bf16_t* qp = Qg + (rowb + q0 + r32) * AW + h * 128 + map * 64 + hi * 8;
#pragma unroll
      for (int d0 = 0; d0 < 4; ++d0) qr[d0] = *(const bf16x8*)(qp + d0 * 16); }
    const int NT = 2 * qt + 3;
    const bool skip_last = (qb < 2);
    f32x16 o[4];
#pragma unroll
    for (int d = 0; d < 4; ++d) o[d] = (f32x16){};
    float mrun = -__builtin_inff(), lrun = 0.f;
    LAS float* wsf = (LAS float*)(lds + 65536 + wave * 256);
    const bf16_t* Kb = Kg + rowb * AW; const bf16_t* Vb = Vg + rowb * AW;
#define ATT_DMA(step, stage) do { const bf16_t* ks_ = (step) == 0 ? KM : Kb; const bf16_t* vs_ = (step) == 0 ? VM : Vb; const int row0_ = (step) == 0 ? 0 : ((step) - 1) * 64; \
    _Pragma("unroll") for (int i_ = 0; i_ < 2; ++i_) { const int p_ = 2 * wave + i_; \
        __builtin_amdgcn_global_load_lds((const unsigned*)(ks_ + (size_t)(row0_ + lane) * AW + h * 128 + (p_ >> 3) * 64 + (p_ & 7) * 8), (LAS unsigned*)(lds + (stage) * 32768 + p_ * 1024), 16, 0, 0); \
        __builtin_amdgcn_global_load_lds((const unsigned*)(vs_ + (size_t)(row0_ + 16 * (p_ & 3) + (lane >> 2)) * AW + h * 128 + (p_ >> 2) * 32 + (lane & 3) * 8), (LAS unsigned*)(lds + (stage) * 32768 + 16384 + p_ * 1024), 16, 0, 0); } } while (0)
    ATT_DMA(0, 0);
    asm volatile("s_waitcnt vmcnt(0)" ::: "memory"); __syncthreads();
#pragma unroll 1
    for (int s = 0; s < NT; ++s) {
        const int stage = s & 1;
        if (s + 1 < NT) ATT_DMA(s + 1, stage ^ 1);
        if (!(skip_last && s == NT - 1)) {
            const LAS unsigned char* kb = lds + stage * 32768 + map * 8192 + hi * 1024 + r32 * 16;
            f32x16 p0 = (f32x16){}, p1 = (f32x16){};
#pragma unroll
            for (int d0 = 0; d0 < 4; ++d0) { const bf16x8 b0 = *(const LAS bf16x8*)(kb + d0 * 2048), b1 = *(const LAS bf16x8*)(kb + d0 * 2048 + 512);
                p0 = __builtin_amdgcn_mfma_f32_32x32x16_bf16(b0, qr[d0], p0, 0, 0, 0); p1 = __builtin_amdgcn_mfma_f32_32x32x16_bf16(b1, qr[d0], p1, 0, 0, 0); }
            if (s == 0) {
                asm volatile("" ::: "memory");
#pragma unroll
                for (int r = 0; r < 16; ++r) { if (r >= 8) p0[r] = -__builtin_inff(); p1[r] = -__builtin_inff(); } }
            float rmA = fmaxf(p0[0], p0[1]), rmB = fmaxf(p0[2], p0[3]), rmC = fmaxf(p1[0], p1[1]), rmD = fmaxf(p1[2], p1[3]);
#pragma unroll
            for (int r = 4; r < 16; r += 4) { rmA = fmaxf(rmA, fmaxf(p0[r], p0[r + 1])); rmB = fmaxf(rmB, fmaxf(p0[r + 2], p0[r + 3])); rmC = fmaxf(rmC, fmaxf(p1[r], p1[r + 1])); rmD = fmaxf(rmD, fmaxf(p1[r + 2], p1[r + 3])); }
            const float rm = half_swap_max(fmaxf(fmaxf(rmA, rmB), fmaxf(rmC, rmD)));
            if (s == 0) mrun = rm;
            else if (__any(rm > mrun + 8.0f)) {
                const float mnew = fmaxf(mrun, rm), alpha = __builtin_amdgcn_exp2f(mrun - mnew);
                lrun *= alpha; mrun = mnew;
                if (hi == 0) wsf[r32] = alpha;
                f32x4 a4[4];
#pragma unroll
                for (int gq = 0; gq < 4; ++gq) a4[gq] = *(const LAS f32x4*)(wsf + 8 * gq + 4 * hi);
#pragma unroll
                for (int d = 0; d < 4; ++d)
#pragma unroll
                    for (int r = 0; r < 16; ++r) o[d][r] *= a4[r >> 2][r & 3];
            }
            float psA = 0.f, psB = 0.f, psC = 0.f, psD = 0.f;
#pragma unroll
            for (int r = 0; r < 16; r += 2) { p0[r] = __builtin_amdgcn_exp2f(p0[r] - mrun); p0[r + 1] = __builtin_amdgcn_exp2f(p0[r + 1] - mrun); p1[r] = __builtin_amdgcn_exp2f(p1[r] - mrun); p1[r + 1] = __builtin_amdgcn_exp2f(p1[r + 1] - mrun);
                psA += p0[r]; psB += p0[r + 1]; psC += p1[r]; psD += p1[r + 1]; }
            lrun += (psA + psB) + (psC + psD);
            bf16x8 pa[4];
            { u32x4 w;
              w = (u32x4){cvt_pk_bf16(p0[0], p0[1]), cvt_pk_bf16(p0[2], p0[3]), cvt_pk_bf16(p0[4], p0[5]), cvt_pk_bf16(p0[6], p0[7])}; pa[0] = __builtin_bit_cast(bf16x8, w);
              w = (u32x4){cvt_pk_bf16(p0[8], p0[9]), cvt_pk_bf16(p0[10], p0[11]), cvt_pk_bf16(p0[12], p0[13]), cvt_pk_bf16(p0[14], p0[15])}; pa[1] = __builtin_bit_cast(bf16x8, w);
              w = (u32x4){cvt_pk_bf16(p1[0], p1[1]), cvt_pk_bf16(p1[2], p1[3]), cvt_pk_bf16(p1[4], p1[5]), cvt_pk_bf16(p1[6], p1[7])}; pa[2] = __builtin_bit_cast(bf16x8, w);
              w = (u32x4){cvt_pk_bf16(p1[8], p1[9]), cvt_pk_bf16(p1[10], p1[11]), cvt_pk_bf16(p1[12], p1[13]), cvt_pk_bf16(p1[14], p1[15])}; pa[3] = __builtin_bit_cast(bf16x8, w); }
            const LAS unsigned char* vp0 = lds + stage * 32768 + 16384 + ((lane >> 4) & 1) * 32 + (lane & 3) * 8 + (4 * hi + ((lane & 15) >> 2)) * 64;
#pragma unroll
            for (int d = 0; d < 4; ++d)
#pragma unroll
                for (int ks = 0; ks < 4; ++ks) { const s16x4 lo = vtr(vp0 + d * 4096 + ks * 1024), hv = vtr(vp0 + d * 4096 + ks * 1024 + 512);
                    const bf16x8 vf = (bf16x8){lo[0], lo[1], lo[2], lo[3], hv[0], hv[1], hv[2], hv[3]};
                    o[d] = __builtin_amdgcn_mfma_f32_32x32x16_bf16(pa[ks], vf, o[d], 0, 0, 0); }
        }
        asm volatile("s_waitcnt vmcnt(0)" ::: "memory"); __syncthreads();
    }
#undef ATT_DMA
    { const float ltot = half_swap_sum(lrun); const float inv = (map ? lam : 1.0f) / ltot;
      if (hi == 0) wsf[r32] = inv;
      f32x4 a4[4];
#pragma unroll
      for (int gq = 0; gq < 4; ++gq) a4[gq] = *(const LAS f32x4*)(wsf + 8 * gq + 4 * hi);
#pragma unroll
      for (int d = 0; d < 4; ++d)
#pragma unroll
          for (int r = 0; r < 16; ++r) o[d][r] *= a4[r >> 2][r & 3]; }
    LAS float* X = (LAS float*)(lds + qb * 16384);
    if (map == 1) {
#pragma unroll
        for (int d = 0; d < 4; ++d)
#pragma unroll
            for (int r = 0; r < 16; ++r) X[crow(r, hi) * 128 + 32 * d + r32] = o[d][r];
    }
    __syncthreads();
    if (map == 0) {
        float ssq[16];
#pragma unroll
        for (int r = 0; r < 16; ++r) ssq[r] = 0.f;
#pragma unroll
        for (int d = 0; d < 4; ++d)
#pragma unroll
            for (int r = 0; r < 16; ++r) { const float v = o[d][r] - X[crow(r, hi) * 128 + 32 * d + r32]; o[d][r] = v; ssq[r] += v * v; }
#pragma unroll
        for (int r = 0; r < 16; ++r) {
#pragma unroll
            for (int off = 1; off < 32; off <<= 1) ssq[r] += __shfl_xor(ssq[r], off);
            ssq[r] = 0.8f / sqrtf(ssq[r] * (1.f / 128.f) + LN_EPS); }
#pragma unroll
        for (int d = 0; d < 4; ++d) { const float gg = subg[32 * d + r32];
#pragma unroll
            for (int r = 0; r < 16; ++r) Y[(rowb + q0 + crow(r, hi)) * AW + h * 128 + 32 * d + r32] = (bf16_t)(cvt_pk_bf16(o[d][r] * ssq[r] * gg, 0.f) & 0xffffu); }
    }
    __syncthreads();
}
__device__ __forceinline__ void p3_attention(const Ctx& C, const float* const* in, unsigned char* ws) {
    const bf16_t* Q = (const bf16_t*)(ws + WS_Q); const bf16_t* K = (const bf16_t*)(ws + WS_K); const bf16_t* V = (const bf16_t*)(ws + WS_V);
    const bf16_t* KM = (const bf16_t*)(ws + WS_KMETA); const bf16_t* VM = (const bf16_t*)(ws + WS_VMETA); bf16_t* Y = (bf16_t*)(ws + WS_YATT);
    const float l1 = wave_sum(in[14][C.lane] * in[15][C.lane]), l2 = wave_sum(in[16][C.lane] * in[17][C.lane]);
    const float lam = expf(l1) - expf(l2) + 0.2f;
#ifndef ATT_REP
#define ATT_REP 1
#endif
    for (int vv = C.vcu; vv < 256 * ATT_REP; vv += C.G) { const int v = vv & 255;
        const int bh = v >> 1, sft = v & 1;
#pragma unroll 1
        for (int i = 0; i < 8; ++i) { const int qt = (i & 1) ? (15 - sft - (i & ~1)) : (sft + (i & ~1));
            attn_unit(C, Q, K, V, KM, VM, Y, in[18], lam, bh >> 3, bh & 7, qt); }
    }
}

__device__ __forceinline__ void p6_ln1_router(const Ctx& C, const float* const* in, unsigned char* ws) {
    const int lane = C.lane, wave = C.wave, tid = C.tid;
    const bf16_t* Z = (const bf16_t*)(ws + WS_Z); bf16_t* H1 = (bf16_t*)(ws + WS_H1); const float* WrT = (const float*)(ws + WS_WRT);
    int* LIST = (int*)(ws + WS_LIST); float* WGT = (float*)(ws + WS_WGT); unsigned* ECNT = (unsigned*)(ws + WS_CTL) + CW_ECNT;
    const float* lg = in[22]; const float* lb = in[23];
    LAS float* WB = (LAS float*)C.lds;
    LAS unsigned char* XB = C.lds + 98304;
    LAS int* RE = (LAS int*)(XB);
    LAS float* RW = (LAS float*)(XB + 1024);
    LAS int* CL = (LAS int*)(XB + 2048);
    LAS int* BS = (LAS int*)(XB + 2048 + 128);
    LAS int* SL = (LAS int*)(XB + 2048 + 256);
    LAS float* LG = (LAS float*)(XB + 4096) + wave * 80;
    for (int rbk = C.vcu; rbk < T / 128; rbk += C.G) {
        if (tid < 32) CL[tid] = 0;
#pragma unroll 1
        for (int step = 0; step < 8; ++step) {
            const int lr0 = step * 16 + 2 * wave; const size_t row0 = (size_t)rbk * 128 + lr0;
            int l4 = 4 * lane; asm volatile("" : "+v"(l4));
            f32x4 v0[8], v1[8];
#pragma unroll
            for (int j = 0; j < 8; ++j) { const u32x2 z0 = *(const u32x2*)(Z + row0 * DM + 256 * j + l4), z1 = *(const u32x2*)(Z + (row0 + 1) * DM + 256 * j + l4);
                v0[j] = (f32x4){bf_lo(z0.x), bf_hi(z0.x), bf_lo(z0.y), bf_hi(z0.y)}; v1[j] = (f32x4){bf_lo(z1.x), bf_hi(z1.x), bf_lo(z1.y), bf_hi(z1.y)}; }
            float mean0, rstd0, mean1, rstd1; ln_stats(v0, mean0, rstd0); ln_stats(v1, mean1, rstd1);
#pragma unroll
            for (int j = 0; j < 8; ++j) { const f32x4 gg = *(const f32x4*)(lg + 256 * j + l4), bb = *(const f32x4*)(lb + 256 * j + l4);
                v0[j] = (v0[j] - mean0) * rstd0 * gg + bb; v1[j] = (v1[j] - mean1) * rstd1 * gg + bb;
                u32x2 w; w.x = cvt_pk_bf16(v0[j].x, v0[j].y); w.y = cvt_pk_bf16(v0[j].z, v0[j].w); *(u32x2*)(H1 + row0 * DM + 256 * j + l4) = w;
                w.x = cvt_pk_bf16(v1[j].x, v1[j].y); w.y = cvt_pk_bf16(v1[j].z, v1[j].w); *(u32x2*)(H1 + (row0 + 1) * DM + 256 * j + l4) = w; }
#pragma unroll 1
            for (int ng = 0; ng < 3; ++ng) {
                __syncthreads();
                int tq = tid; asm volatile("" : "+v"(tq));
#pragma unroll
                for (int i = 0; i < 12; ++i) { const int idx = tq + 512 * i, n = idx >> 9, c4 = idx & 511;
                    *(LAS f32x4*)(WB + n * 2048 + 4 * c4) = *(const f32x4*)(WrT + (size_t)(12 * ng + n) * DM + 4 * c4); }
                __syncthreads();
#pragma unroll 1
                for (int n = 0; n < 12; ++n) { float pa = 0.f, pb = 0.f;
#pragma unroll
                    for (int j = 0; j < 8; ++j) { const f32x4 w4 = *(const LAS f32x4*)(WB + n * 2048 + 256 * j + l4);
                        const f32x4 a = v0[j] * w4, bq = v1[j] * w4; pa += (a.x + a.y) + (a.z + a.w); pb += (bq.x + bq.y) + (bq.z + bq.w); }
                    const float sa = wave_sum(pa), sb = wave_sum(pb); if (lane == 0) { LG[12 * ng + n] = sa; LG[40 + 12 * ng + n] = sb; } }
            }
            if (lane < 2) {
                const LAS float* L = LG + 40 * lane;
                int gi = 0; float gm = L[0] + in[25][0];
                for (int n = 1; n < 4; ++n) { const float x = L[n] + in[25][n]; if (x > gm) { gm = x; gi = n; } }
                float gs = 0.f;
                for (int n = 0; n < 4; ++n) gs += __expf(L[n] + in[25][n] - gm);
                const float gval = 1.0f / gs;
                int i1 = 0; float m1 = L[4 + gi * 8] + in[27][gi * 8];
                for (int j = 1; j < 8; ++j) { const float x = L[4 + gi * 8 + j] + in[27][gi * 8 + j]; if (x > m1) { m1 = x; i1 = j; } }
                int i2 = -1; float m2 = -__builtin_inff();
                for (int j = 0; j < 8; ++j) { const float x = L[4 + gi * 8 + j] + in[27][gi * 8 + j]; if (j != i1 && x > m2) { m2 = x; i2 = j; } }
                const float tt = __expf(m2 - m1), w1 = gval / (1.f + tt), w2 = gval * tt / (1.f + tt);
                const int lr = lr0 + lane; RE[lr * 2] = gi * 8 + i1; RE[lr * 2 + 1] = gi * 8 + i2; RW[lr * 2] = w1; RW[lr * 2 + 1] = w2;
            }
        }
        __syncthreads();
        int e = 0;
        if (tid < 256) { e = RE[tid]; SL[tid] = __hip_atomic_fetch_add(&CL[e], 1, __ATOMIC_RELAXED, __HIP_MEMORY_SCOPE_WORKGROUP); }
        __syncthreads();
        if (tid < 32) BS[tid] = (int)__hip_atomic_fetch_add(&ECNT[tid], (unsigned)CL[tid], __ATOMIC_RELAXED, __HIP_MEMORY_SCOPE_AGENT);
        __syncthreads();
        if (tid < 256) { const int entry = (rbk * 128 + (tid >> 1)) * 2 + (tid & 1); LIST[(size_t)e * CAP + BS[e] + SL[tid]] = entry; WGT[entry] = RW[tid]; }
        __syncthreads();
    }
}

__device__ __forceinline__ void p9_ln2(const Ctx& C, const float* const* in, unsigned char* ws, float* out) {
    const bf16_t* H1 = (const bf16_t*)(ws + WS_H1); const bf16_t* YK = (const bf16_t*)(ws + WS_YK);
    const float* lg = in[31]; const float* lb = in[32];
    const int gw = C.vcu * 8 + C.wave, NGW = C.G * 8, lane = C.lane;
    for (int m = gw; m < T; m += 2 * NGW) {
        const int m2 = (m + NGW < T) ? m + NGW : m;
        u32x2 ha[8], ya0[8], ya1[8], hb[8], yb0[8], yb1[8];
#pragma unroll
        for (int j = 0; j < 8; ++j) { const size_t c = 256 * j + 4 * lane;
            ha[j] = *(const u32x2*)(H1 + (size_t)m * DM + c); ya0[j] = *(const u32x2*)(YK + (size_t)(2 * m) * DM + c); ya1[j] = *(const u32x2*)(YK + (size_t)(2 * m + 1) * DM + c);
            hb[j] = *(const u32x2*)(H1 + (size_t)m2 * DM + c); yb0[j] = *(const u32x2*)(YK + (size_t)(2 * m2) * DM + c); yb1[j] = *(const u32x2*)(YK + (size_t)(2 * m2 + 1) * DM + c); }
#pragma unroll
        for (int rr = 0; rr < 2; ++rr) {
            f32x4 v[8];
#pragma unroll
            for (int j = 0; j < 8; ++j) { const u32x2 hw = rr ? hb[j] : ha[j], y0 = rr ? yb0[j] : ya0[j], y1 = rr ? yb1[j] : ya1[j];
                v[j] = (f32x4){bf_lo(hw.x), bf_hi(hw.x), bf_lo(hw.y), bf_hi(hw.y)} * ALPHA + (f32x4){bf_lo(y0.x), bf_hi(y0.x), bf_lo(y0.y), bf_hi(y0.y)} + (f32x4){bf_lo(y1.x), bf_hi(y1.x), bf_lo(y1.y), bf_hi(y1.y)}; }
            float mean, rstd; ln_stats(v, mean, rstd);
            const int mm = rr ? m2 : m;
            if (rr == 0 || m2 != m) {
#pragma unroll
                for (int j = 0; j < 8; ++j) { const f32x4 gg = *(const f32x4*)(lg + 256 * j + 4 * lane), bb = *(const f32x4*)(lb + 256 * j + 4 * lane);
                    *(f32x4*)(out + (size_t)mm * DM + 256 * j + 4 * lane) = (v[j] - mean) * rstd * gg + bb; } }
        }
    }
}

__device__ __forceinline__ int build_moe_tables(const Ctx& C, unsigned char* ws) {
    LAS int* blkstart = (LAS int*)(C.lds + MISC_OFF + 64); LAS int* cntE = (LAS int*)(C.lds + MISC_OFF + 320); LAS int* blkexp = (LAS int*)(C.lds + MISC_OFF + 512);
    unsigned* ECNT = (unsigned*)(ws + WS_CTL) + CW_ECNT;
    __syncthreads();
    if (C.tid < 32) cntE[C.tid] = (int)__hip_atomic_load(&ECNT[C.tid], __ATOMIC_RELAXED, __HIP_MEMORY_SCOPE_AGENT);
    __syncthreads();
    if (C.tid == 0) { int s = 0; for (int e = 0; e < NE; ++e) { blkstart[e] = s; s += (cntE[e] + 255) >> 8; } blkstart[NE] = s; }
    __syncthreads();
    const int NBLK = blkstart[NE];
    if (C.tid < NBLK && C.tid < 320) { int e = 0; for (int j = 1; j < NE; ++j) if (blkstart[j] <= C.tid) e = j; blkexp[C.tid] = e; }
    __syncthreads();
    return NBLK < 320 ? NBLK : 320;
}

constexpr int NPHASE = 10;
struct Args { const float* in[33]; float* out; unsigned char* ws; int ph_lo, ph_hi; };
__global__ void __launch_bounds__(512, 2) mk_fwd(Args args) {
    extern __shared__ __attribute__((aligned(16))) unsigned char lds_raw[];
    Ctx C; C.lds = (LAS unsigned char*)lds_raw; C.tid = threadIdx.x; C.lane = C.tid & 63; C.wave = __builtin_amdgcn_readfirstlane(C.tid >> 6);
    C.G = gridDim.x; { const int bx = blockIdx.x; C.vcu = (C.G % 8 == 0) ? (bx % 8) * (C.G / 8) + bx / 8 : bx; }
    unsigned char* ws = args.ws; const float* const* in = args.in;
    volatile LAS unsigned* MISC = (volatile LAS unsigned*)(C.lds + MISC_OFF);
    if (C.tid < 16) MISC[C.tid] = 0u;
    __syncthreads();
    unsigned* barw = (unsigned*)(ws + WS_CTL) + CW_BAR;
    XcdBarrier bar; bar.bar = barw; bar.x = 0; bar.st = nullptr;
    const int lo = args.ph_lo, hi = args.ph_hi;
    if (hi - lo > 1) bar = xcd_barrier_post(barw, MISC);
#ifndef PH_MASK
#define PH_MASK 0x3ff
#endif
#define IN(k) (((PH_MASK >> (k)) & 1) && lo <= (k) && (k) < hi)
#define SEAM(k) do { if (IN(k) && IN((k) + 1)) xcd_barrier(bar); } while (0)
#ifndef WGM_PROJ
#define WGM_PROJ 4
#endif
#ifndef WGM_N2K
#define WGM_N2K 2
#endif
#ifndef GEMM_SP2
#define GEMM_SP2 true
#endif
#ifndef GEMM_ALIGN
#define GEMM_ALIGN true
#endif
#ifndef PROBE_MASK
#define PROBE_MASK 0
#endif
#define REPS(k) (((PROBE_MASK >> (k)) & 1) ? 2 : 1)
#define REPSEAM(k, rep) do { if ((rep) + 1 < REPS(k)) xcd_barrier(bar); } while (0)
    LAS unsigned char* lds = C.lds;
    bf16_t* MG = (bf16_t*)args.out;

    if (IN(0)) { _Pragma("unroll") for (int rep = 0; rep < REPS(0); ++rep) { p0_prologue(C, in, ws); REPSEAM(0, rep); } } SEAM(0);

    if (IN(1)) { _Pragma("unroll") for (int rep = 0; rep < REPS(1); ++rep) {
        pg8::Gemm g{(const bf16_t*)(ws + WS_HBF), (const bf16_t*)(ws + WS_WIN), T, INC, DM, nullptr, nullptr, 0}; pg8::StaticOrder S; S.init(T, INC, C.G, (int)blockIdx.x, WGM_PROJ);
        EpiProj E{(bf16_t*)(ws + WS_U), (bf16_t*)(ws + WS_Q), (bf16_t*)(ws + WS_K), (bf16_t*)(ws + WS_V), (bf16_t*)(ws + WS_SGS), (bf16_t*)(ws + WS_SGA)};
        pg8::gemm_phase<EpiProj, pg8::StaticOrder, GEMM_ALIGN, GEMM_SP2, false>(lds, g, S, E);
        p1_meta_proj(C, ws);
        REPSEAM(1, rep);
    } } SEAM(1);

    if (IN(2)) { _Pragma("unroll") for (int rep = 0; rep < REPS(2); ++rep) { p2_scan(C, in, ws); REPSEAM(2, rep); } } SEAM(2);

    if (IN(3)) { _Pragma("unroll") for (int rep = 0; rep < REPS(3); ++rep) {
        { pg8::Gemm g{(const bf16_t*)(ws + WS_YPRE), (const bf16_t*)(ws + WS_WGLU), T, SSMW, SSMW, nullptr, nullptr, 0}; pg8::StaticOrder S; S.init(T, SSMW, C.G, (int)blockIdx.x);
          EpiGlu E{(const bf16_t*)(ws + WS_YPRE), (bf16_t*)(ws + WS_YSSM)};
          pg8::gemm_phase<EpiGlu, pg8::StaticOrder, GEMM_ALIGN, GEMM_SP2, false>(lds, g, S, E); }
        p3_attention(C, in, ws);
        REPSEAM(3, rep);
    } } SEAM(3);

    if (IN(4)) { _Pragma("unroll") for (int rep = 0; rep < REPS(4); ++rep) {
        { pg8::Gemm g{(const bf16_t*)(ws + WS_YSSM), (const bf16_t*)(ws + WS_WBS), T, DM, SSMW, (const bf16_t*)(ws + WS_YATT), (const bf16_t*)(ws + WS_WBA), AW}; pg8::StaticOrder S; S.init(T, DM, C.G, (int)blockIdx.x, WGM_N2K);
          EpiMergeF E{(const bf16_t*)(ws + WS_SGS), (const bf16_t*)(ws + WS_SGA), MG};
          pg8::gemm_phase<EpiMergeF, pg8::StaticOrder, GEMM_ALIGN, GEMM_SP2, false, true>(lds, g, S, E); }
        REPSEAM(4, rep);
    } } SEAM(4);

    if (IN(5)) { _Pragma("unroll") for (int rep = 0; rep < REPS(5); ++rep) {
        pg8::Gemm g{MG, (const bf16_t*)(ws + WS_WO), T, DM, DM, nullptr, nullptr, 0}; pg8::StaticOrder S; S.init(T, DM, C.G, (int)blockIdx.x, WGM_N2K);
        EpiZ E{(const bf16_t*)(ws + WS_HBF), (bf16_t*)(ws + WS_Z)};
        pg8::gemm_phase<EpiZ, pg8::StaticOrder, GEMM_ALIGN, GEMM_SP2, false>(lds, g, S, E);
        REPSEAM(5, rep);
    } } SEAM(5);

    if (IN(6)) { p6_ln1_router(C, in, ws); } SEAM(6);

    if (IN(7)) { _Pragma("unroll") for (int rep = 0; rep < REPS(7); ++rep) {
        const int NBLK = build_moe_tables(C, ws);
        MoeOrder S{C.G, C.vcu, 2, NBLK, (const LAS int*)(lds + MISC_OFF + 512), (const LAS int*)(lds + MISC_OFF + 64), (const LAS int*)(lds + MISC_OFF + 320), (const int*)(ws + WS_LIST)};
        pg8::Gemm g{(const bf16_t*)(ws + WS_H1), (const bf16_t*)(ws + WS_WUP), T, NE * 1024, DM, nullptr, nullptr, 0};
        EpiSwiglu E{(bf16_t*)(ws + WS_HB), (const int*)(ws + WS_LIST), (const float*)(ws + WS_WGT), (int*)(ws + WS_POSE), (float*)(ws + WS_POSW)};
        pg8::gemm_phase<EpiSwiglu, MoeOrder, GEMM_ALIGN, GEMM_SP2, true>(lds, g, S, E);
        REPSEAM(7, rep);
    } } SEAM(7);

    if (IN(8)) { _Pragma("unroll") for (int rep = 0; rep < REPS(8); ++rep) {
        const int NBLK = build_moe_tables(C, ws);
        MoeOrder S{C.G, C.vcu, 3, NBLK, (const LAS int*)(lds + MISC_OFF + 512), (const LAS int*)(lds + MISC_OFF + 64), (const LAS int*)(lds + MISC_OFF + 320), (const int*)(ws + WS_LIST)};
        pg8::Gemm g{(const bf16_t*)(ws + WS_HB), (const bf16_t*)(ws + WS_WDN), NBLK * 256, NE * DM, DFF, nullptr, nullptr, 0};
        EpiDown E{(const int*)(ws + WS_POSE), (const float*)(ws + WS_POSW), (bf16_t*)(ws + WS_YK)};
        pg8::gemm_phase<EpiDown, MoeOrder, GEMM_ALIGN, GEMM_SP2, false>(lds, g, S, E);
        REPSEAM(8, rep);
    } } SEAM(8);

    if (IN(9)) { _Pragma("unroll") for (int rep = 0; rep < REPS(9); ++rep) { p9_ln2(C, in, ws, args.out); REPSEAM(9, rep); } }
#undef IN
#undef SEAM
}

extern "C" void kernel_launch(void* const* d_in, const int* in_sizes, int n_in, void* d_out, int out_size, void* d_ws, size_t ws_size, hipStream_t stream) {
    static int grid = 0;
    if (grid == 0) {
        if (n_in != 33 || in_sizes[0] != T * DM || out_size != T * DM || ws_size < WS_END) { fprintf(stderr, "kernel_launch: unexpected shapes (n_in %d, in0 %d, out %d, ws %zu)\n", n_in, n_in > 0 ? in_sizes[0] : -1, out_size, ws_size); grid = -1; return; }
        int dev = 0, cus = 0, per_cu = 0;
        if (hipGetDevice(&dev) != hipSuccess || hipDeviceGetAttribute(&cus, hipDeviceAttributeMultiprocessorCount, dev) != hipSuccess) { grid = -1; return; }
        if (hipFuncSetAttribute((const void*)mk_fwd, hipFuncAttributeMaxDynamicSharedMemorySize, LDS_BYTES) != hipSuccess) { fprintf(stderr, "kernel_launch: hipFuncSetAttribute failed\n"); grid = -1; return; }
        if (hipOccupancyMaxActiveBlocksPerMultiprocessor(&per_cu, (const void*)mk_fwd, 512, LDS_BYTES) != hipSuccess || per_cu < 1) { fprintf(stderr, "kernel_launch: occupancy query reports %d blocks per CU\n", per_cu); }
        (void)hipGetLastError();
        grid = cus;
    }
    if (grid < 0) return;
    (void)hipMemsetAsync((char*)d_ws + WS_CTL, 0, CTL_ZERO_BYTES, stream);
    Args a{};
    for (int i = 0; i < 33; ++i) a.in[i] = (const float*)d_in[i];
    a.out = (float*)d_out; a.ws = (unsigned char*)d_ws;
#if MK_PER_PHASE
    for (int p = 0; p < NPHASE; ++p) { a.ph_lo = p; a.ph_hi = p + 1; hipLaunchKernelGGL(mk_fwd, dim3(grid), dim3(512), LDS_BYTES, stream, a); }
#else
    a.ph_lo = 0; a.ph_hi = NPHASE; hipLaunchKernelGGL(mk_fwd, dim3(grid), dim3(512), LDS_BYTES, stream, a);
#endif
}
```

```cpp
#include <hip/hip_runtime.h>
#include <stdint.h>
#include <stdio.h>

#ifndef ATT_PROBE
#define ATT_PROBE 0
#endif
#ifndef MK_PER_PHASE
#define MK_PER_PHASE 0
#endif

#define GAS __attribute__((address_space(1)))
#define LAS __attribute__((address_space(3)))
typedef unsigned short bf16_t;
typedef short bf16x8 __attribute__((ext_vector_type(8)));
typedef short s16x4 __attribute__((ext_vector_type(4)));
typedef float f32x2 __attribute__((ext_vector_type(2)));
typedef float f32x4 __attribute__((ext_vector_type(4)));
typedef float f32x16 __attribute__((ext_vector_type(16)));
typedef unsigned u32x2 __attribute__((ext_vector_type(2)));
typedef unsigned u32x4 __attribute__((ext_vector_type(4)));

constexpr int NB_ = 16, SEQ = 2048, DM = 2048, T = NB_ * SEQ, NMETA = 16;
constexpr int SSMW = 512, AW = 1024, INC = 7680, NGRP = 32, NST = 64;
constexpr int NE = 32, DFF = 512, CAP = T;
constexpr float LN_EPS = 1e-5f;
constexpr float ALPHA = 1.189207115002721f;
constexpr float QSCALE = 0.125f * 1.4426950408889634f;

__device__ __forceinline__ unsigned cvt_pk_bf16(float lo, float hi) { unsigned r; asm volatile("v_cvt_pk_bf16_f32 %0, %1, %2" : "=v"(r) : "v"(lo), "v"(hi)); return r; }
__device__ __forceinline__ float bf_lo(unsigned w) { return __uint_as_float(w << 16); }
__device__ __forceinline__ float bf_hi(unsigned w) { return __uint_as_float(w & 0xffff0000u); }
__device__ __forceinline__ float sigmoidf_(float x) { return 1.0f / (1.0f + __expf(-x)); }
__device__ __forceinline__ float wave_sum(float v) {
#pragma unroll
    for (int o = 1; o < 64; o <<= 1) v += __shfl_xor(v, o);
    return v;
}

namespace pg8 {
constexpr int BM = 256, BK = 64, HALF = 128, HTB = HALF * BK * 2, STAGE_BYTES = 8 * HTB, NXCD = 8, WGM = 4;
__host__ __device__ __forceinline__ int lds_byte(int r, int c) { const int st = (r >> 4) * 2 + (c >> 5), rr = r & 15, cc = c & 31, ob = rr * 64 + cc * 2; return st * 1024 + (ob ^ (((ob >> 9) & 1) << 5)); }
__host__ __device__ __forceinline__ void stage_rc(int b, int& R, int& C) { const int st = b / 1024, sb = b % 1024, swz = sb ^ (((sb >> 9) & 1) << 5); R = (st >> 1) * 16 + swz / 64; C = (st & 1) * 32 + (swz % 64) / 2; }
__host__ __device__ __forceinline__ int perm32(int rho) { const int n = rho >> 4, i = rho & 15; return 8 * (i >> 2) + 4 * n + (i & 3); }

struct Unit { int pm, pn, e, s0, cnt; };
struct Gemm { const bf16_t* A; const bf16_t* Bt; int M, N, K; const bf16_t* A2; const bf16_t* Bt2; int K2; };

struct StaticOrder {
    int nM, nN, nwg, G, c, wgm;
    __device__ void init(int M, int N, int G_, int c_, int wgm_ = WGM) { nM = M / BM; nN = N / BM; nwg = nM * nN; G = G_; c = c_; wgm = wgm_; }
    __device__ bool next(int i, Unit& u) const {
        const long L = (long)i * G + c; if (L >= nwg) return false;
        int wgid = (int)L; { const int q = nwg / NXCD, r = nwg % NXCD, xcd = wgid % NXCD, off = wgid / NXCD; wgid = (xcd < r ? xcd * (q + 1) : r * (q + 1) + (xcd - r) * q) + off; }
        const int nig = wgm * nN, gid = wgid / nig, fm = gid * wgm, gsz = (nM - fm) < wgm ? (nM - fm) : wgm;
        u.pm = fm + ((wgid % nig) % gsz); u.pn = (wgid % nig) / gsz; u.e = 0; u.s0 = 0; u.cnt = 0; return true;
    }
    __device__ __forceinline__ int arow(const Unit&, int) const { return 0; }
};

template <class Epi, class Sched, bool ALIGN_EPI, bool SP2, bool GATHER, bool DUAL = false>
__device__ __forceinline__ void gemm_phase(LAS unsigned char* lds, const Gemm g, const Sched& S, const Epi& E) {
    const int tid = threadIdx.x, wid = __builtin_amdgcn_readfirstlane(tid >> 6), lane = tid & 63, wr = wid >> 2, wc = wid & 3, fr = lane & 15, fq = lane >> 4;
    const int K = g.K, K2 = DUAL ? g.K2 : 0, nt1 = K / BK, nt = (K + K2) / BK;
    unsigned voffA[2], voffB[2], voffA2[2] = {0u, 0u}, voffB2[2] = {0u, 0u}; int stR[2], stC[2];
#pragma unroll
    for (int i = 0; i < 2; ++i) { int R, C; stage_rc(tid * 16 + i * 8192, R, C); const int Rb = Epi::PERM ? ((R & ~31) + perm32(R & 31)) : R;
        stR[i] = R; stC[i] = C; voffA[i] = (unsigned)(R * K + C) * 2u; voffB[i] = (unsigned)(Rb * K + C) * 2u;
        if constexpr (DUAL) { voffA2[i] = (unsigned)(R * K2 + C) * 2u; voffB2[i] = (unsigned)(Rb * K2 + C) * 2u; } }
    const size_t kstep = (size_t)(BK * 2);
    const size_t hstep = (size_t)HALF * K * 2;
    const size_t tstep = 2 * hstep;
    const size_t hstep2 = (size_t)HALF * K2 * 2, tstep2 = 2 * hstep2;
    const unsigned ldsw = (unsigned)wid * 1024u;
    const int aoff = lds_byte(wr * 64 + fr, fq * 8), boff = lds_byte(wc * 32 + fr, fq * 8);
#define PG8_SA(b, h) (((b) * 2 + (h)) * HTB)
#define PG8_SB(b, h) ((4 + (b) * 2 + (h)) * HTB)
#define PG8_STAGE(bufoff, gbase, voff) do { _Pragma("unroll") for (int _i = 0; _i < 2; ++_i) \
        __builtin_amdgcn_global_load_lds((const unsigned*)((const char*)(gbase) + (voff)[_i]), (LAS unsigned*)(lds + (bufoff) + ldsw + _i * 8192), 16, 0, 0); } while (0)
#define PG8_STAGE_A(bufoff, kbase, h, VO) do { if constexpr (GATHER) { PG8_STAGE(bufoff, kbase, VO[h]); } else { PG8_STAGE(bufoff, (kbase) + (h) * hstep, voffA); } } while (0)
#define PG8_STAGE_AX(bufoff, kbase, h, VO, HS, VA) do { if constexpr (GATHER) { PG8_STAGE(bufoff, kbase, VO[h]); } else { PG8_STAGE(bufoff, (kbase) + (h) * (HS), VA); } } while (0)
#define PG8_LDA(dst, b, h) do { _Pragma("unroll") for (int m = 0; m < 4; ++m) _Pragma("unroll") for (int k = 0; k < 2; ++k) dst[m][k] = *(const LAS bf16x8*)(lds + PG8_SA(b, h) + aoff + m * 2048 + k * 1024); } while (0)
#define PG8_LDB(dst, b, h) do { _Pragma("unroll") for (int n = 0; n < 2; ++n) _Pragma("unroll") for (int k = 0; k < 2; ++k) dst[n][k] = *(const LAS bf16x8*)(lds + PG8_SB(b, h) + boff + n * 2048 + k * 1024); } while (0)
#define PG8_MMA(ai, bj, At, Bt) do { __builtin_amdgcn_s_setprio(1); _Pragma("unroll") for (int m = 0; m < 4; ++m) _Pragma("unroll") for (int n = 0; n < 2; ++n) _Pragma("unroll") for (int k = 0; k < 2; ++k) \
        acc[ai][bj][m][n] = __builtin_amdgcn_mfma_f32_16x16x32_bf16(Bt[n][k], At[m][k], acc[ai][bj][m][n], 0, 0, 0); __builtin_amdgcn_s_setprio(0); } while (0)
#define PG8_WAIT_V(n) asm volatile("s_waitcnt vmcnt(" #n ")" ::: "memory")
#define PG8_WAIT_L(n) asm volatile("s_waitcnt lgkmcnt(" #n ")" ::: "memory")
#define PG8_BAR __builtin_amdgcn_s_barrier()
#define PG8_SCHED __builtin_amdgcn_sched_barrier(0)
#define PG8_GOFF(VO, U) do { _Pragma("unroll") for (int _h = 0; _h < 2; ++_h) _Pragma("unroll") for (int _i = 0; _i < 2; ++_i) \
        VO[_h][_i] = (unsigned)S.arow(U, _h * HALF + stR[_i]) * (unsigned)(K * 2) + (unsigned)(stC[_i] * 2); } while (0)
    Unit cur, nxt; int ui = 0;
    if (!S.next(0, cur)) return;
    f32x4 acc[2][2][4][2];
#pragma unroll
    for (int a = 0; a < 2; ++a)
#pragma unroll
        for (int b = 0; b < 2; ++b)
#pragma unroll
            for (int m = 0; m < 4; ++m)
#pragma unroll
                for (int n = 0; n < 2; ++n) acc[a][b][m][n] = (f32x4){0.f, 0.f, 0.f, 0.f};
    bf16x8 At[4][2], B0[2][2], B1[2][2];
    unsigned cvo[2][2] = {{0u, 0u}, {0u, 0u}}, nvo[2][2] = {{0u, 0u}, {0u, 0u}};
    const char* cA = GATHER ? (const char*)g.A : (const char*)g.A + (size_t)cur.pm * tstep; const char* cB = (const char*)g.Bt + (size_t)cur.pn * tstep;
    if constexpr (GATHER) { PG8_GOFF(cvo, cur); }
    if constexpr (SP2) {
        PG8_STAGE(PG8_SB(0, 0), cB, voffB); PG8_STAGE(PG8_SB(0, 1), cB + hstep, voffB); PG8_STAGE_A(PG8_SA(0, 0), cA, 0, cvo); PG8_STAGE_A(PG8_SA(0, 1), cA, 1, cvo);
        if (wr == 1) PG8_BAR;
        PG8_WAIT_V(2); PG8_BAR;
        PG8_STAGE(PG8_SB(1, 0), cB + kstep, voffB); PG8_STAGE_A(PG8_SA(1, 0), cA + kstep, 0, cvo); PG8_STAGE(PG8_SB(1, 1), cB + hstep + kstep, voffB);
        PG8_WAIT_V(6); PG8_BAR;
    } else {
        PG8_STAGE(PG8_SB(0, 0), cB, voffB); PG8_STAGE_A(PG8_SA(0, 0), cA, 0, cvo); PG8_STAGE(PG8_SB(0, 1), cB + hstep, voffB); PG8_STAGE_A(PG8_SA(0, 1), cA, 1, cvo);
        if (wr == 1) PG8_BAR;
        PG8_WAIT_V(4); PG8_BAR;
        PG8_STAGE(PG8_SB(1, 0), cB + kstep, voffB); PG8_STAGE_A(PG8_SA(1, 0), cA + kstep, 0, cvo); PG8_STAGE(PG8_SB(1, 1), cB + hstep + kstep, voffB);
        PG8_WAIT_V(6); PG8_BAR;
    }
    for (;;) {
        const bool has_next = S.next(ui + 1, nxt);
        const char* nA = GATHER ? cA : (has_next ? (const char*)g.A + (size_t)nxt.pm * tstep : cA); const char* nB = has_next ? (const char*)g.Bt + (size_t)nxt.pn * tstep : cB;
        if constexpr (GATHER) { if (has_next) { PG8_GOFF(nvo, nxt); } else {
#pragma unroll
            for (int h = 0; h < 2; ++h)
#pragma unroll
                for (int i = 0; i < 2; ++i) nvo[h][i] = cvo[h][i]; } }
        const char* cA2 = DUAL ? (const char*)g.A2 + (size_t)cur.pm * tstep2 : cA; const char* cB2 = DUAL ? (const char*)g.Bt2 + (size_t)cur.pn * tstep2 : cB;
        for (int t = 0; t < nt; t += 2) {
            const bool last = (t == nt - 2);
            const bool s1 = DUAL && (t + 1 >= nt1), s2 = DUAL && !last && (t + 2 >= nt1);
            const char* a1 = s1 ? cA2 + (size_t)(t + 1 - nt1) * kstep : cA + (size_t)(t + 1) * kstep;
            const char* a2 = last ? nA : (s2 ? cA2 + (size_t)(t + 2 - nt1) * kstep : cA + (size_t)(t + 2) * kstep);
            const char* b2 = last ? nB : (s2 ? cB2 + (size_t)(t + 2 - nt1) * kstep : cB + (size_t)(t + 2) * kstep);
            const char* a3 = a2 + kstep; const char* b3 = b2 + kstep;
            const size_t hs1 = s1 ? hstep2 : hstep, hs2 = s2 ? hstep2 : hstep;
            unsigned vA1[2], vA2[2], vB2[2];
#pragma unroll
            for (int i = 0; i < 2; ++i) { vA1[i] = s1 ? voffA2[i] : voffA[i]; vA2[i] = s2 ? voffA2[i] : voffA[i]; vB2[i] = s2 ? voffB2[i] : voffB[i]; }
            unsigned svo[2][2];
#pragma unroll
            for (int h = 0; h < 2; ++h)
#pragma unroll
                for (int i = 0; i < 2; ++i) svo[h][i] = last ? nvo[h][i] : cvo[h][i];
            if constexpr (SP2) {
            PG8_LDB(B0, 0, 0); PG8_LDB(B1, 0, 1); PG8_SCHED; PG8_LDA(At, 0, 0); PG8_STAGE_AX(PG8_SA(1, 1), a1, 1, cvo, hs1, vA1);
            PG8_WAIT_V(8); PG8_WAIT_L(0); PG8_BAR; PG8_MMA(0, 0, At, B0); PG8_MMA(0, 1, At, B1); PG8_BAR; PG8_SCHED;
            PG8_LDA(At, 0, 1); PG8_STAGE(PG8_SB(0, 0), b2, vB2); PG8_STAGE(PG8_SB(0, 1), b2 + hs2, vB2); PG8_STAGE_AX(PG8_SA(0, 0), a2, 0, svo, hs2, vA2);
            PG8_WAIT_V(8); PG8_WAIT_L(0); PG8_BAR; PG8_MMA(1, 0, At, B0); PG8_MMA(1, 1, At, B1); PG8_BAR; PG8_SCHED;
            PG8_LDB(B0, 1, 0); PG8_LDB(B1, 1, 1); PG8_SCHED; PG8_LDA(At, 1, 0); PG8_STAGE_AX(PG8_SA(0, 1), a2, 1, svo, hs2, vA2);
            PG8_WAIT_V(8); PG8_WAIT_L(0); PG8_BAR; PG8_MMA(0, 0, At, B0); PG8_MMA(0, 1, At, B1); PG8_BAR; PG8_SCHED;
            PG8_LDA(At, 1, 1); PG8_STAGE(PG8_SB(1, 0), b3, vB2); PG8_STAGE(PG8_SB(1, 1), b3 + hs2, vB2); PG8_STAGE_AX(PG8_SA(1, 0), a3, 0, svo, hs2, vA2);
            PG8_WAIT_V(8); PG8_WAIT_L(0); PG8_BAR; PG8_MMA(1, 0, At, B0); PG8_MMA(1, 1, At, B1); PG8_BAR; PG8_SCHED;
            } else {
            PG8_LDB(B0, 0, 0); PG8_SCHED; PG8_LDA(At, 0, 0); PG8_STAGE_AX(PG8_SA(1, 1), a1, 1, cvo, hs1, vA1);
            PG8_WAIT_L(8); PG8_BAR; PG8_WAIT_L(0); PG8_MMA(0, 0, At, B0); PG8_BAR; PG8_SCHED;
            PG8_LDB(B1, 0, 1); PG8_STAGE(PG8_SB(0, 0), b2, vB2);
            PG8_BAR; PG8_WAIT_L(0); PG8_MMA(0, 1, At, B1); PG8_BAR;
            PG8_LDA(At, 0, 1); PG8_STAGE_AX(PG8_SA(0, 0), a2, 0, svo, hs2, vA2);
            PG8_BAR; PG8_WAIT_L(0); PG8_MMA(1, 0, At, B0); PG8_BAR; PG8_SCHED;
            PG8_STAGE(PG8_SB(0, 1), b2 + hs2, vB2);
            PG8_WAIT_V(6); PG8_BAR; PG8_MMA(1, 1, At, B1); PG8_BAR;
            PG8_LDB(B0, 1, 0); PG8_SCHED; PG8_LDA(At, 1, 0); PG8_STAGE_AX(PG8_SA(0, 1), a2, 1, svo, hs2, vA2);
            PG8_WAIT_L(8); PG8_BAR; PG8_WAIT_L(0); PG8_MMA(0, 0, At, B0); PG8_BAR; PG8_SCHED;
            PG8_LDB(B1, 1, 1); PG8_STAGE(PG8_SB(1, 0), b3, vB2);
            PG8_BAR; PG8_WAIT_L(0); PG8_MMA(0, 1, At, B1); PG8_BAR;
            PG8_LDA(At, 1, 1); PG8_STAGE_AX(PG8_SA(1, 0), a3, 0, svo, hs2, vA2);
            PG8_BAR; PG8_WAIT_L(0); PG8_MMA(1, 0, At, B0); PG8_BAR; PG8_SCHED;
            PG8_STAGE(PG8_SB(1, 1), b3 + hs2, vB2);
            PG8_WAIT_V(6); PG8_BAR; PG8_MMA(1, 1, At, B1); PG8_BAR;
            }
            if constexpr (DUAL) { if (t + 2 == nt1) E.mid(acc, cur, wr, wc, fr, fq); }
        }
        if constexpr (ALIGN_EPI) { if (wr == 0) PG8_BAR; }
        E(acc, cur, wr, wc, fr, fq);
        if (!has_next) break;
#pragma unroll
        for (int a = 0; a < 2; ++a)
#pragma unroll
            for (int b = 0; b < 2; ++b)
#pragma unroll
                for (int m = 0; m < 4; ++m)
#pragma unroll
                    for (int n = 0; n < 2; ++n) acc[a][b][m][n] = (f32x4){0.f, 0.f, 0.f, 0.f};
        cur = nxt; cA = nA; cB = nB; ++ui;
#pragma unroll
        for (int h = 0; h < 2; ++h)
#pragma unroll
            for (int i = 0; i < 2; ++i) cvo[h][i] = nvo[h][i];
        if constexpr (ALIGN_EPI) { if (wr == 1) PG8_BAR; }
    }
    PG8_WAIT_V(0);
    if constexpr (!ALIGN_EPI) { if (wr == 0) PG8_BAR; }
    PG8_BAR;
#undef PG8_SA
#undef PG8_SB
#undef PG8_STAGE
#undef PG8_STAGE_A
#undef PG8_STAGE_AX
#undef PG8_LDA
#undef PG8_LDB
#undef PG8_MMA
#undef PG8_WAIT_V
#undef PG8_WAIT_L
#undef PG8_BAR
#undef PG8_SCHED
#undef PG8_GOFF
}
}

constexpr size_t MiB = 1u << 20;
constexpr size_t WS_CTL = 0, CTL_ZERO_BYTES = 1 * MiB;
constexpr size_t WS_HMETA = 1 * MiB;
constexpr size_t WS_UMETA = WS_HMETA + 128 * 1024;
constexpr size_t WS_KMETA = WS_HMETA + 256 * 1024;
constexpr size_t WS_VMETA = WS_HMETA + 384 * 1024;
constexpr size_t WS_SSMAB = WS_HMETA + 512 * 1024;
constexpr size_t WS_SSMBB = WS_HMETA + 576 * 1024;
constexpr size_t WS_WRT = 2 * MiB;
constexpr size_t WS_WIN = 3 * MiB;
constexpr size_t WS_WGLU = 33 * MiB;
constexpr size_t WS_WBS = 34 * MiB;
constexpr size_t WS_WBA = 36 * MiB;
constexpr size_t WS_WO = 40 * MiB;
constexpr size_t WS_WUP = 48 * MiB;
constexpr size_t WS_WDN = 176 * MiB;
constexpr size_t WS_HBF = 240 * MiB;
constexpr size_t WS_U = 368 * MiB;
constexpr size_t WS_Q = 400 * MiB;
constexpr size_t WS_K = 464 * MiB;
constexpr size_t WS_V = 528 * MiB;
constexpr size_t WS_SGS = 592 * MiB;
constexpr size_t WS_SGA = 720 * MiB;
constexpr size_t WS_YPRE = 848 * MiB;
constexpr size_t WS_YSSM = 880 * MiB;
constexpr size_t WS_YATT = 912 * MiB;
constexpr size_t WS_END = 976 * MiB;
constexpr size_t WS_Z = 368 * MiB;
constexpr size_t WS_H1 = 624 * MiB;
constexpr size_t WS_HB = 752 * MiB;
constexpr size_t WS_YK = 368 * MiB;
constexpr size_t WS_LIST = 848 * MiB;
constexpr size_t WS_WGT = 852 * MiB;
constexpr size_t WS_POSE = 853 * MiB;
constexpr size_t WS_POSW = 854 * MiB;
constexpr int CW_ECNT = 64;
constexpr int CW_BAR = 4096;

constexpr int RING_BYTES = 131072;
constexpr int MISC_OFF = RING_BYTES;
constexpr int LDS_BYTES = 139264;

#define XB_TMO      128
#define XB_XCNT(j)  (256  + 64 * (j))
#define XB_XSUB(j)  (1280 + 64 * (j))
#define XB_XGEN(j)  (2304 + 64 * (j))
#define XB_TOP      3328
#define XB_TOPGEN   3392
#define XCD_BAR_WORDS 3456
#define XB_SPIN_CAP (1u << 18)
__device__ __forceinline__ unsigned xb_ld(unsigned* p)              { return __hip_atomic_load(p, __ATOMIC_RELAXED, __HIP_MEMORY_SCOPE_AGENT); }
__device__ __forceinline__ unsigned xb_add(unsigned* p, unsigned v) { return __hip_atomic_fetch_add(p, v, __ATOMIC_RELAXED, __HIP_MEMORY_SCOPE_AGENT); }
__device__ __forceinline__ unsigned xb_xcc_id() { return (unsigned)__builtin_amdgcn_s_getreg((3 << 11) | 20) & 0xFu; }
#define XB_SPIN(cond, bar) do { unsigned _sp = 0; while (cond) { __builtin_amdgcn_s_sleep(1); \
    if ((++_sp & 255u) == 0u) { if (xb_ld(&(bar)[XB_TMO])) break; if (_sp > XB_SPIN_CAP) { atomicAdd(&(bar)[XB_TMO], 1u); break; } } } } while (0)
struct XcdBarrier { unsigned* bar; unsigned x; volatile LAS unsigned* st; };
__device__ __forceinline__ XcdBarrier xcd_barrier_post(unsigned* bar, volatile LAS unsigned* st) {
    XcdBarrier b; b.bar = bar; b.x = xb_xcc_id(); b.st = st;
    if (threadIdx.x == 0) (void)xb_add(&bar[XB_XCNT(b.x)], 1u);
    return b;
}
__device__ __forceinline__ void xcd_barrier_complete(unsigned* bar, unsigned x, unsigned& nloc, unsigned& nx) {
    const unsigned G = gridDim.x * gridDim.y * gridDim.z;
    unsigned sum, cnt, mine, sp = 0u;
    for (;;) {
        sum = 0u; cnt = 0u; mine = 0u;
#pragma unroll
        for (unsigned j = 0; j < 16; ++j) { const unsigned c = xb_ld(&bar[XB_XCNT(j)]); sum += c; cnt += (c > 0u) ? 1u : 0u; mine = (j == x) ? c : mine; }
        if (sum == G) break;
        __builtin_amdgcn_s_sleep(1);
        if ((++sp & 255u) == 0u) { if (xb_ld(&bar[XB_TMO])) break; if (sp > XB_SPIN_CAP) { atomicAdd(&bar[XB_TMO], 1u); break; } }
    }
    nloc = mine > 0u ? mine : 1u; nx = cnt > 0u ? cnt : 1u;
}
__device__ __forceinline__ void xcd_barrier(const XcdBarrier& b) {
    asm volatile("s_waitcnt vmcnt(0)" ::: "memory");
    __syncthreads();
    if (threadIdx.x == 0) {
        unsigned* bar = b.bar;
        __builtin_amdgcn_s_waitcnt(0);
        unsigned nloc = b.st[0], nx = b.st[1];
        if (nloc == 0u) { xcd_barrier_complete(bar, b.x, nloc, nx); b.st[0] = nloc; b.st[1] = nx; }
        const unsigned old = xb_add(&bar[XB_XSUB(b.x)], 1u);
        const unsigned gen = old / nloc;
        if (old + 1u == (gen + 1u) * nloc) {
            __builtin_amdgcn_fence(__ATOMIC_RELEASE, "agent");
            asm volatile("s_waitcnt vmcnt(0)" ::: "memory");
            const unsigned og = xb_add(&bar[XB_TOP], 1u);
            const unsigned tg = og / nx;
            if (og + 1u == (tg + 1u) * nx) xb_add(&bar[XB_TOPGEN], 1u);
            else XB_SPIN(xb_ld(&bar[XB_TOPGEN]) == tg, bar);
            __builtin_amdgcn_fence(__ATOMIC_ACQUIRE, "agent");
            xb_add(&bar[XB_XGEN(b.x)], 1u);
            asm volatile("s_waitcnt vmcnt(0)" ::: "memory");
        } else {
            XB_SPIN(xb_ld(&bar[XB_XGEN(b.x)]) == gen, bar);
            __builtin_amdgcn_fence(__ATOMIC_ACQUIRE, "agent");
            asm volatile("s_waitcnt vmcnt(0)" ::: "memory");
        }
    }
    __syncthreads();
}

using pg8::Unit;
__device__ __forceinline__ u32x4 pack8(const f32x4 v0, const f32x4 v1) { u32x4 w; w.x = cvt_pk_bf16(v0[0], v0[1]); w.y = cvt_pk_bf16(v0[2], v0[3]); w.z = cvt_pk_bf16(v1[0], v1[1]); w.w = cvt_pk_bf16(v1[2], v1[3]); return w; }
__device__ __forceinline__ void unpack8(const u32x4 w, f32x4& v0, f32x4& v1) { v0 = (f32x4){bf_lo(w.x), bf_hi(w.x), bf_lo(w.y), bf_hi(w.y)}; v1 = (f32x4){bf_lo(w.z), bf_hi(w.z), bf_lo(w.w), bf_hi(w.w)}; }

struct EpiProj {
    static constexpr bool PERM = true;
    bf16_t *U, *Q, *K, *V, *RHO, *SGA;
    __device__ __forceinline__ void operator()(const f32x4 (&acc)[2][2][4][2], const Unit& u, int wr, int wc, int fr, int fq) const {
        const int pn = u.pn;
        if (pn >= 14) {
            const int row0 = u.pm * 256 + wr * 64 + fr, col0 = (pn - 14) * 128 + wc * 32 + 8 * fq;
#pragma unroll
            for (int ai = 0; ai < 2; ++ai)
#pragma unroll
                for (int m = 0; m < 4; ++m) { const size_t off = (size_t)(row0 + ai * 128 + m * 16) * DM + col0; f32x4 r0, r1, a0, a1;
#pragma unroll
                    for (int j = 0; j < 4; ++j) { const float es0 = __expf(-acc[ai][0][m][0][j]), es1 = __expf(-acc[ai][0][m][1][j]), ea0 = __expf(-acc[ai][1][m][0][j]), ea1 = __expf(-acc[ai][1][m][1][j]);
                        a0[j] = __builtin_amdgcn_rcpf(1.f + ea0); a1[j] = __builtin_amdgcn_rcpf(1.f + ea1);
                        r0[j] = (1.f + ea0) * __builtin_amdgcn_rcpf(1.f + es0); r1[j] = (1.f + ea1) * __builtin_amdgcn_rcpf(1.f + es1); }
                    *(u32x4*)(RHO + off) = pack8(r0, r1); *(u32x4*)(SGA + off) = pack8(a0, a1); }
            return;
        }
        bf16_t* base; int ldc, ct, mode;
        if (pn < 2) { base = U; ldc = 512; ct = pn; mode = 0; }
        else if (pn < 6) { base = Q; ldc = 1024; ct = pn - 2; mode = 1; }
        else if (pn < 10) { base = K; ldc = 1024; ct = pn - 6; mode = 0; }
        else { base = V; ldc = 1024; ct = pn - 10; mode = 0; }
        const int row0 = u.pm * 256 + wr * 64 + fr, col0 = ct * 256 + wc * 32 + 8 * fq;
#pragma unroll
        for (int ai = 0; ai < 2; ++ai)
#pragma unroll
            for (int m = 0; m < 4; ++m) { bf16_t* rowp = base + (size_t)(row0 + ai * 128 + m * 16) * ldc + col0;
#pragma unroll
                for (int bj = 0; bj < 2; ++bj) { f32x4 v0 = acc[ai][bj][m][0], v1 = acc[ai][bj][m][1];
                    if (mode == 1) { v0 = v0 * QSCALE; v1 = v1 * QSCALE; }
                    *(u32x4*)(rowp + bj * 128) = pack8(v0, v1); } }
    }
};
struct EpiGlu {
    static constexpr bool PERM = true;
    const bf16_t* YPRE; bf16_t* YSSM;
    __device__ __forceinline__ void operator()(const f32x4 (&acc)[2][2][4][2], const Unit& u, int wr, int wc, int fr, int fq) const {
        const int row0 = u.pm * 256 + wr * 64 + fr, col0 = u.pn * 256 + wc * 32 + 8 * fq;
#pragma unroll
        for (int ai = 0; ai < 2; ++ai)
#pragma unroll
            for (int m = 0; m < 4; ++m) { const size_t off = (size_t)(row0 + ai * 128 + m * 16) * SSMW + col0;
#pragma unroll
                for (int bj = 0; bj < 2; ++bj) { const u32x4 yw = *(const u32x4*)(YPRE + off + bj * 128); f32x4 y0, y1; unpack8(yw, y0, y1);
                    f32x4 v0 = acc[ai][bj][m][0], v1 = acc[ai][bj][m][1];
#pragma unroll
                    for (int j = 0; j < 4; ++j) { v0[j] = y0[j] * sigmoidf_(v0[j]); v1[j] = y1[j] * sigmoidf_(v1[j]); }
                    *(u32x4*)(YSSM + off + bj * 128) = pack8(v0, v1); } }
    }
};
template <int SECOND> struct EpiMerge {
    static constexpr bool PERM = true;
    const bf16_t* SG; bf16_t* MG;
    __device__ __forceinline__ void operator()(const f32x4 (&acc)[2][2][4][2], const Unit& u, int wr, int wc, int fr, int fq) const {
        const int row0 = u.pm * 256 + wr * 64 + fr, col0 = u.pn * 256 + wc * 32 + 8 * fq;
#pragma unroll
        for (int ai = 0; ai < 2; ++ai)
#pragma unroll
            for (int m = 0; m < 4; ++m) { const size_t off = (size_t)(row0 + ai * 128 + m * 16) * DM + col0;
#pragma unroll
                for (int bj = 0; bj < 2; ++bj) { const u32x4 gw = *(const u32x4*)(SG + off + bj * 128); f32x4 g0, g1; unpack8(gw, g0, g1);
                    f32x4 v0 = acc[ai][bj][m][0] * g0, v1 = acc[ai][bj][m][1] * g1;
                    if (SECOND) { const u32x4 pw = *(const u32x4*)(MG + off + bj * 128); f32x4 p0, p1; unpack8(pw, p0, p1); v0 = v0 + p0; v1 = v1 + p1; }
                    *(u32x4*)(MG + off + bj * 128) = pack8(v0, v1); } }
    }
};
struct EpiMergeF {
    static constexpr bool PERM = true;
    const bf16_t* SGS; const bf16_t* SGA; bf16_t* MG;
    __device__ __forceinline__ void mid(f32x4 (&acc)[2][2][4][2], const Unit& u, int wr, int wc, int fr, int fq) const {
        asm volatile("" : "+v"(fr), "+v"(fq));
        const int row0 = u.pm * 256 + wr * 64 + fr, col0 = u.pn * 256 + wc * 32 + 8 * fq;
#pragma unroll
        for (int ai = 0; ai < 2; ++ai)
#pragma unroll
            for (int m = 0; m < 4; ++m) { const size_t off = (size_t)(row0 + ai * 128 + m * 16) * DM + col0;
#pragma unroll
                for (int bj = 0; bj < 2; ++bj) { const u32x4 sw = *(const u32x4*)(SGS + off + bj * 128);
                    f32x4 s0, s1; unpack8(sw, s0, s1);
                    acc[ai][bj][m][0] = acc[ai][bj][m][0] * s0; acc[ai][bj][m][1] = acc[ai][bj][m][1] * s1; }
                asm volatile("" ::: "memory"); }
    }
    __device__ __forceinline__ void operator()(const f32x4 (&acc)[2][2][4][2], const Unit& u, int wr, int wc, int fr, int fq) const {
        const int row0 = u.pm * 256 + wr * 64 + fr, col0 = u.pn * 256 + wc * 32 + 8 * fq;
#pragma unroll
        for (int ai = 0; ai < 2; ++ai)
#pragma unroll
            for (int m = 0; m < 4; ++m) { const size_t off = (size_t)(row0 + ai * 128 + m * 16) * DM + col0;
#pragma unroll
                for (int bj = 0; bj < 2; ++bj) { const u32x4 gw = *(const u32x4*)(SGA + off + bj * 128); f32x4 g0, g1; unpack8(gw, g0, g1);
                    *(u32x4*)(MG + off + bj * 128) = pack8(acc[ai][bj][m][0] * g0, acc[ai][bj][m][1] * g1); } }
    }
};
struct EpiZ {
    static constexpr bool PERM = true;
    const bf16_t* HBF; bf16_t* Z;
    __device__ __forceinline__ void operator()(const f32x4 (&acc)[2][2][4][2], const Unit& u, int wr, int wc, int fr, int fq) const {
        const int row0 = u.pm * 256 + wr * 64 + fr, col0 = u.pn * 256 + wc * 32 + 8 * fq;
#pragma unroll
        for (int ai = 0; ai < 2; ++ai)
#pragma unroll
            for (int m = 0; m < 4; ++m) { const size_t off = (size_t)(row0 + ai * 128 + m * 16) * DM + col0;
#pragma unroll
                for (int bj = 0; bj < 2; ++bj) { const u32x4 hw = *(const u32x4*)(HBF + off + bj * 128); f32x4 h0, h1; unpack8(hw, h0, h1);
                    *(u32x4*)(Z + off + bj * 128) = pack8(acc[ai][bj][m][0] + h0 * ALPHA, acc[ai][bj][m][1] + h1 * ALPHA); } }
    }
};
struct EpiSwiglu {
    static constexpr bool PERM = true;
    bf16_t* HB; const int* LIST; const float* WGT; int* POSE; float* POSW;
    __device__ __forceinline__ void operator()(const f32x4 (&acc)[2][2][4][2], const Unit& u, int wr, int wc, int fr, int fq) const {
        const int row0 = u.pm * 256 + wr * 64 + fr, col0 = (u.pn & 3) * 128 + wc * 32 + 8 * fq;
#pragma unroll
        for (int ai = 0; ai < 2; ++ai)
#pragma unroll
            for (int m = 0; m < 4; ++m) { f32x4 v0, v1;
#pragma unroll
                for (int j = 0; j < 4; ++j) { const float g0 = acc[ai][0][m][0][j], g1 = acc[ai][0][m][1][j];
                    v0[j] = g0 * sigmoidf_(g0) * acc[ai][1][m][0][j]; v1[j] = g1 * sigmoidf_(g1) * acc[ai][1][m][1][j]; }
                *(u32x4*)(HB + (size_t)(row0 + ai * 128 + m * 16) * DFF + col0) = pack8(v0, v1); }
        if ((u.pn & 3) == 0 && wc == 0 && fq == 0) {
#pragma unroll
            for (int ai = 0; ai < 2; ++ai)
#pragma unroll
                for (int m = 0; m < 4; ++m) { const int r = wr * 64 + fr + ai * 128 + m * 16, slot = u.s0 + r; int entry = -1; float w = 0.f;
                    if (slot < u.cnt) { entry = LIST[(size_t)u.e * CAP + slot]; w = WGT[entry]; }
                    POSE[u.pm * 256 + r] = entry; POSW[u.pm * 256 + r] = w; }
        }
    }
};
struct EpiDown {
    static constexpr bool PERM = true;
    const int* POSE; const float* POSW; bf16_t* YK;
    __device__ __forceinline__ void operator()(const f32x4 (&acc)[2][2][4][2], const Unit& u, int wr, int wc, int fr, int fq) const {
        const int r0 = u.pm * 256 + wr * 64 + fr, col0 = (u.pn & 7) * 256 + wc * 32 + 8 * fq;
        int en[2][4]; float ww[2][4];
#pragma unroll
        for (int ai = 0; ai < 2; ++ai)
#pragma unroll
            for (int m = 0; m < 4; ++m) { en[ai][m] = POSE[r0 + ai * 128 + m * 16]; ww[ai][m] = POSW[r0 + ai * 128 + m * 16]; }
#pragma unroll
        for (int ai = 0; ai < 2; ++ai)
#pragma unroll
            for (int m = 0; m < 4; ++m) {
                if (en[ai][m] >= 0) { const float w = ww[ai][m]; bf16_t* rowp = YK + (size_t)en[ai][m] * DM + col0;
#pragma unroll
                    for (int bj = 0; bj < 2; ++bj) *(u32x4*)(rowp + bj * 128) = pack8(acc[ai][bj][m][0] * w, acc[ai][bj][m][1] * w); } }
    }
};
struct MoeOrder {
    int G, c, shift, NB; const LAS int* blkexp; const LAS int* blkstart; const LAS int* cntE; const int* LIST;
    __device__ __forceinline__ bool next(int i, Unit& u) const {
        const long L = (long)i * G + c; if (L >= ((long)NB << shift)) return false;
        const int blk = (int)(L >> shift), tile = (int)(L & ((1 << shift) - 1)), e = blkexp[blk];
        u.pm = blk; u.pn = (e << shift) + tile; u.e = e; u.s0 = (blk - blkstart[e]) * 256; u.cnt = cntE[e]; return true;
    }
    __device__ __forceinline__ int arow(const Unit& u, int r) const { const int slot = u.s0 + r; const int entry = slot < u.cnt ? LIST[(size_t)u.e * CAP + slot] : 0; return entry >> 1; }
};

struct Ctx { LAS unsigned char* lds; int tid, lane, wave, vcu, G; };

__device__ __forceinline__ void transpose_item(const float* W, int K, int N, bf16_t* WT, int kb, int nb, int dst_row0, LAS float* scr, int lane) {
    const int k0 = 64 * kb, n0 = 32 * nb;
    float tv[32];
#pragma unroll
    for (int i = 0; i < 32; ++i) tv[i] = W[(size_t)(k0 + 2 * i + (lane >> 5)) * N + n0 + (lane & 31)];
#pragma unroll
    for (int i = 0; i < 32; ++i) scr[(2 * i + (lane >> 5)) * 33 + (lane & 31)] = tv[i];
    asm volatile("s_waitcnt lgkmcnt(0)" ::: "memory");
    const int c = lane & 7;
#pragma unroll
    for (int j = 0; j < 4; ++j) { const int n = (lane >> 3) + 8 * j; const LAS float* s = scr + (8 * c) * 33 + n;
        u32x4 o; o.x = cvt_pk_bf16(s[0 * 33], s[1 * 33]); o.y = cvt_pk_bf16(s[2 * 33], s[3 * 33]); o.z = cvt_pk_bf16(s[4 * 33], s[5 * 33]); o.w = cvt_pk_bf16(s[6 * 33], s[7 * 33]);
        *(u32x4*)(WT + (size_t)(dst_row0 + n) * K + k0 + 8 * c) = o; }
    asm volatile("s_waitcnt lgkmcnt(0)" ::: "memory");
}
__device__ __forceinline__ void ln_stats(f32x4 (&v)[8], float& mean, float& rstd) {
    float s = 0.f;
#pragma unroll
    for (int j = 0; j < 8; ++j) s += (v[j].x + v[j].y) + (v[j].z + v[j].w);
    mean = wave_sum(s) * (1.f / DM); float s2 = 0.f;
#pragma unroll
    for (int j = 0; j < 8; ++j) { const f32x4 d = v[j] - mean; s2 += (d.x * d.x + d.y * d.y) + (d.z * d.z + d.w * d.w); }
    rstd = 1.f / sqrtf(wave_sum(s2) * (1.f / DM) + LN_EPS);
}

__device__ __forceinline__ void p0_prologue(const Ctx& C, const float* const* in, unsigned char* ws) {
    LAS float* scr = (LAS float*)(C.lds + C.wave * 16384);
    const int gw = C.vcu * 8 + C.wave, NGW = C.G * 8;
    bf16_t* WinT = (bf16_t*)(ws + WS_WIN); bf16_t* WgluT = (bf16_t*)(ws + WS_WGLU); bf16_t* WbsT = (bf16_t*)(ws + WS_WBS); bf16_t* WbaT = (bf16_t*)(ws + WS_WBA);
    bf16_t* WoT = (bf16_t*)(ws + WS_WO); bf16_t* WupT = (bf16_t*)(ws + WS_WUP); bf16_t* WdnT = (bf16_t*)(ws + WS_WDN);
    constexpr int I_WIN = (DM / 64) * (INC / 32), I_GLU = (SSMW / 64) * (SSMW / 32), I_BS = (SSMW / 64) * (DM / 32), I_BA = (AW / 64) * (DM / 32), I_WO = (DM / 64) * (DM / 32);
    constexpr int I_EXP = NE * 512;
    constexpr int NITEMS = I_WIN + I_GLU + I_BS + I_BA + I_WO + 3 * I_EXP;
    for (int it = gw; it < NITEMS; it += NGW) {
        int r = it;
        if (r < I_WIN) { const int nblk = INC / 32, nb = r % nblk, n0 = 32 * nb;
            const int drow = n0 < 3584 ? n0 : (n0 < 5632 ? 3584 + ((n0 - 3584) >> 7) * 256 + ((n0 - 3584) & 127) : 3584 + ((n0 - 5632) >> 7) * 256 + 128 + ((n0 - 5632) & 127));
            transpose_item(in[4], DM, INC, WinT, r / nblk, nb, drow, scr, C.lane); continue; } r -= I_WIN;
        if (r < I_GLU) { const int nblk = SSMW / 32; transpose_item(in[13], SSMW, SSMW, WgluT, r / nblk, r % nblk, 32 * (r % nblk), scr, C.lane); continue; } r -= I_GLU;
        if (r < I_BS) { const int nblk = DM / 32; transpose_item(in[19], SSMW, DM, WbsT, r / nblk, r % nblk, 32 * (r % nblk), scr, C.lane); continue; } r -= I_BS;
        if (r < I_BA) { const int nblk = DM / 32; transpose_item(in[20], AW, DM, WbaT, r / nblk, r % nblk, 32 * (r % nblk), scr, C.lane); continue; } r -= I_BA;
        if (r < I_WO) { const int nblk = DM / 32; transpose_item(in[21], DM, DM, WoT, r / nblk, r % nblk, 32 * (r % nblk), scr, C.lane); continue; } r -= I_WO;
        if (r < 2 * I_EXP) { const int up = r >= I_EXP ? 1 : 0; r -= up * I_EXP; const int e = r >> 9, rr = r & 511, kb = rr >> 4, nb = rr & 15, n0 = 32 * nb;
            transpose_item(in[28 + up] + (size_t)e * DM * DFF, DM, DFF, WupT, kb, nb, e * 1024 + (n0 >> 7) * 256 + up * 128 + (n0 & 127), scr, C.lane); continue; }
        r -= 2 * I_EXP;
        { const int e = r >> 9, rr = r & 511, kb = rr >> 6, nb = rr & 63; transpose_item(in[30] + (size_t)e * DFF * DM, DFF, DM, WdnT, kb, nb, e * 2048 + 32 * nb, scr, C.lane); }
    }
    const int gt = C.vcu * 512 + C.tid, NGT = C.G * 512;
    { float* WrT = (float*)(ws + WS_WRT);
      for (int i = gt; i < 36 * DM; i += NGT) { const int n = i / DM, k = i % DM; WrT[i] = n < 4 ? in[24][k * 4 + n] : in[26][k * 32 + (n - 4)]; } }
    { u32x4* kz = (u32x4*)(ws + WS_KMETA + 16 * 1024 * 2); u32x4* vz = (u32x4*)(ws + WS_VMETA + 16 * 1024 * 2);
      for (int i = gt; i < 48 * 1024 * 2 / 16; i += NGT) { kz[i] = (u32x4){0u, 0u, 0u, 0u}; vz[i] = (u32x4){0u, 0u, 0u, 0u}; } }
    { float* AB = (float*)(ws + WS_SSMAB); float* BB = (float*)(ws + WS_SSMBB);
      for (int i = gt; i < NGRP * NST; i += NGT) { const int g = i >> 6;
        const double lre = fmin((double)in[5][i], -1e-4), lim = (double)in[6][i], dt = exp((double)in[7][g]);
        const double mag = exp(lre * dt), abr = mag * cos(lim * dt), abi = mag * sin(lim * dt), den = lre * lre + lim * lim, nr = abr - 1.0, ni = abi;
        const double zr = (nr * lre + ni * lim) / den, zi = (ni * lre - nr * lim) / den;
        AB[i] = (float)abr; AB[NGRP * NST + i] = (float)abi;
#pragma unroll 4
        for (int c = 0; c < 16; ++c) { const double br = (double)in[8][i * 16 + c], bi = (double)in[9][i * 16 + c];
            BB[i * 16 + c] = (float)(zr * br - zi * bi); BB[NGRP * NST * 16 + i * 16 + c] = (float)(zr * bi + zi * br); } } }
    const float* lg = in[2]; const float* lb = in[3];
    bf16_t* HBF = (bf16_t*)(ws + WS_HBF);
    for (int m = gw; m < T + NMETA; m += 2 * NGW) {
        const int m2 = (m + NGW < T + NMETA) ? m + NGW : m;
        const float* xa = m >= T ? in[1] + (size_t)(m - T) * DM : in[0] + (size_t)m * DM; const float* xb = m2 >= T ? in[1] + (size_t)(m2 - T) * DM : in[0] + (size_t)m2 * DM;
        f32x4 va[8], vb[8];
#pragma unroll
        for (int j = 0; j < 8; ++j) { va[j] = *(const f32x4*)(xa + 256 * j + 4 * C.lane); vb[j] = *(const f32x4*)(xb + 256 * j + 4 * C.lane); }
        float meana, rstda, meanb, rstdb; ln_stats(va, meana, rstda); ln_stats(vb, meanb, rstdb);
#pragma unroll
        for (int rr = 0; rr < 2; ++rr) { const int mm = rr ? m2 : m; if (rr == 1 && m2 == m) break; const bool meta = mm >= T;
#pragma unroll
            for (int j = 0; j < 8; ++j) { const f32x4 gg = *(const f32x4*)(lg + 256 * j + 4 * C.lane), bb = *(const f32x4*)(lb + 256 * j + 4 * C.lane);
                const f32x4 o = rr ? (vb[j] - meanb) * rstdb * gg + bb : (va[j] - meana) * rstda * gg + bb;
                if (meta) *(f32x4*)((float*)(ws + WS_HMETA) + (size_t)(mm - T) * DM + 256 * j + 4 * C.lane) = o;
                else { u32x2 w; w.x = cvt_pk_bf16(o.x, o.y); w.y = cvt_pk_bf16(o.z, o.w); *(u32x2*)(HBF + (size_t)mm * DM + 256 * j + 4 * C.lane) = w; } } }
    }
}

__device__ __forceinline__ void p1_meta_proj(const Ctx& C, unsigned char* ws) {
    const bf16_t* WinT = (const bf16_t*)(ws + WS_WIN); const float* HM = (const float*)(ws + WS_HMETA);
    const int gw = C.vcu * 8 + C.wave, NGW = C.G * 8;
    for (int it = gw; it < 640; it += NGW) {
        const int nidx = 4 * it; const int col0 = nidx < 512 ? nidx : (nidx < 1536 ? 1536 + (nidx - 512) : 2560 + (nidx - 1536));
        float acc[16][4];
#pragma unroll
        for (int r = 0; r < 16; ++r)
#pragma unroll
            for (int c = 0; c < 4; ++c) acc[r][c] = 0.f;
#pragma unroll 1
        for (int j = 0; j < 4; ++j) { const int k0 = j * 512 + C.lane * 8;
            f32x4 w0[4], w1[4];
#pragma unroll
            for (int c = 0; c < 4; ++c) { const u32x4 ww = *(const u32x4*)(WinT + (size_t)(col0 + c) * DM + k0); unpack8(ww, w0[c], w1[c]); }
#pragma unroll
            for (int r = 0; r < 16; ++r) { const f32x4 h0 = *(const f32x4*)(HM + r * DM + k0), h1 = *(const f32x4*)(HM + r * DM + k0 + 4);
#pragma unroll
                for (int c = 0; c < 4; ++c) { const f32x4 p = h0 * w0[c] + h1 * w1[c]; acc[r][c] += (p.x + p.y) + (p.z + p.w); } } }
        float mine = 0.f;
#pragma unroll
        for (int r = 0; r < 16; ++r)
#pragma unroll
            for (int c = 0; c < 4; ++c) { const float s = wave_sum(acc[r][c]); mine = (C.lane == r * 4 + c) ? s : mine; }
        const int r = C.lane >> 2, c = C.lane & 3;
        if (nidx < 512) ((float*)(ws + WS_UMETA))[r * SSMW + nidx + c] = mine;
        else if (nidx < 1536) ((bf16_t*)(ws + WS_KMETA))[r * AW + (nidx - 512) + c] = (bf16_t)(cvt_pk_bf16(mine, 0.f) & 0xffffu);
        else ((bf16_t*)(ws + WS_VMETA))[r * AW + (nidx - 1536) + c] = (bf16_t)(cvt_pk_bf16(mine, 0.f) & 0xffffu);
    }
}

__device__ __forceinline__ float gelu_tanh(float x) { const float u = 1.5957691216057308f * (x + 0.044715f * x * x * x); return x / (1.0f + __expf(-u)); }
#define SC_HANDOFF(Q) do { _Pragma("unroll") for (int st_ = 0; st_ < 2; ++st_) { \
        auto rr_ = __builtin_amdgcn_permlane32_swap(__float_as_uint(sre[st_]), __float_as_uint(sre[st_]), false, false); sre[st_] = __uint_as_float(rr_[(Q) & 1]); \
        auto ri_ = __builtin_amdgcn_permlane32_swap(__float_as_uint(sim[st_]), __float_as_uint(sim[st_]), false, false); sim[st_] = __uint_as_float(ri_[(Q) & 1]); } } while (0)
template <bool STORE> __device__ __forceinline__ void scan_block(f32x16 (&buv)[4], float (&sre)[2], float (&sim)[2], const float (&are)[2], const float (&aim)[2], int hi) {
    float bu[4][16];
#pragma unroll
    for (int t = 0; t < 4; ++t)
#pragma unroll
        for (int r = 0; r < 16; ++r) bu[t][r] = buv[t][r];
#pragma unroll
    for (int q = 0; q < 8; ++q) {
        const bool act = (hi == (q & 1));
#pragma unroll
        for (int i = 0; i < 4; ++i) { const int reg = 4 * (q >> 1) + i;
#pragma unroll
            for (int st = 0; st < 2; ++st) {
                const float nre = are[st] * sre[st] - aim[st] * sim[st] + bu[st][reg];
                const float nim = are[st] * sim[st] + aim[st] * sre[st] + bu[2 + st][reg];
                sre[st] = nre; sim[st] = nim;
                if (STORE) { bu[st][reg] = act ? nre : bu[st][reg]; bu[2 + st][reg] = act ? nim : bu[2 + st][reg]; } } }
        SC_HANDOFF(q);
    }
    if (STORE) {
#pragma unroll
        for (int t = 0; t < 4; ++t)
#pragma unroll
            for (int r = 0; r < 16; ++r) buv[t][r] = bu[t][r];
    }
}
__device__ __forceinline__ void p2_scan(const Ctx& C, const float* const* in, unsigned char* ws) {
    const int lane = C.lane, wave = C.wave, r32 = lane & 31, hi = lane >> 5, fr = lane & 15, fq = lane >> 4;
    const bf16_t* U = (const bf16_t*)(ws + WS_U); const float* UM = (const float*)(ws + WS_UMETA); bf16_t* YPRE = (bf16_t*)(ws + WS_YPRE);
    const float* AB = (const float*)(ws + WS_SSMAB); const float* BB = (const float*)(ws + WS_SSMBB);
    LAS unsigned char* Sl = C.lds + wave * 10752;
    LAS unsigned char* Yl = Sl + 9728;
    LAS float* E = (LAS float*)(C.lds + 86016);
    for (int item = C.vcu; item < NB_ * NGRP; item += C.G) {
        const int b = item >> 5, g = item & 31;
        const bf16_t* Ub = U + ((size_t)b * SEQ + wave * 256) * SSMW + 16 * g;
        bf16x8 ufa[8];
#pragma unroll
        for (int blk = 0; blk < 8; ++blk) ufa[blk] = *(const bf16x8*)(Ub + (size_t)(32 * blk + r32) * SSMW + 8 * hi);
        float are[2], aim[2];
#pragma unroll
        for (int st = 0; st < 2; ++st) { are[st] = AB[g * 64 + 32 * st + r32]; aim[st] = AB[NGRP * NST + g * 64 + 32 * st + r32]; }
        bf16x8 Bf[4];
#pragma unroll
        for (int ri = 0; ri < 2; ++ri)
#pragma unroll
            for (int st = 0; st < 2; ++st) { const float* src = BB + ri * (NGRP * NST * 16) + (g * 64 + 32 * st + r32) * 16 + 8 * hi;
                const f32x4 x0 = *(const f32x4*)src, x1 = *(const f32x4*)(src + 4); Bf[2 * ri + st] = __builtin_bit_cast(bf16x8, pack8(x0, x1)); }
        bf16x8 Cf[5];
#pragma unroll
        for (int ks = 0; ks < 4; ++ks) { const int k0 = 32 * ks + 8 * fq; const float* src = (ks < 2 ? in[10] : in[11]) + (g * 16 + fr) * 64 + (k0 & 63);
            f32x4 x0 = *(const f32x4*)src, x1 = *(const f32x4*)(src + 4); if (ks >= 2) { x0 = -x0; x1 = -x1; } Cf[ks] = __builtin_bit_cast(bf16x8, pack8(x0, x1)); }
        { const float dsk = in[12][g * 16 + fr]; f32x4 x0, x1;
#pragma unroll
          for (int j = 0; j < 4; ++j) { x0[j] = (fq < 2 && 8 * fq + j == fr) ? dsk : 0.f; x1[j] = (fq < 2 && 8 * fq + 4 + j == fr) ? dsk : 0.f; }
          Cf[4] = __builtin_bit_cast(bf16x8, pack8(x0, x1)); }
        float sre[2] = {0.f, 0.f}, sim[2] = {0.f, 0.f}, mre[2] = {0.f, 0.f}, mim[2] = {0.f, 0.f};
        if (wave == 0) {
            f32x4 x0 = (f32x4){0.f, 0.f, 0.f, 0.f}, x1 = x0;
            if (r32 >= 16) { const float* src = UM + (r32 - 16) * SSMW + 16 * g + 8 * hi; x0 = *(const f32x4*)src; x1 = *(const f32x4*)(src + 4); }
            const bf16x8 uf = __builtin_bit_cast(bf16x8, pack8(x0, x1));
            f32x16 bu[4];
#pragma unroll
            for (int t = 0; t < 4; ++t) bu[t] = __builtin_amdgcn_mfma_f32_32x32x16_bf16(uf, Bf[t], (f32x16){}, 0, 0, 0);
            scan_block<false>(bu, sre, sim, are, aim, hi);
            mre[0] = sre[0]; mre[1] = sre[1]; mim[0] = sim[0]; mim[1] = sim[1];
        }
#pragma unroll
        for (int blk = 0; blk < 8; ++blk) {
            f32x16 bu[4];
#pragma unroll
            for (int t = 0; t < 4; ++t) bu[t] = __builtin_amdgcn_mfma_f32_32x32x16_bf16(ufa[blk], Bf[t], (f32x16){}, 0, 0, 0);
            scan_block<false>(bu, sre, sim, are, aim, hi);
        }
        if (hi == 0) {
#pragma unroll
            for (int st = 0; st < 2; ++st) { E[wave * 128 + st * 64 + r32] = sre[st]; E[wave * 128 + st * 64 + 32 + r32] = sim[st]; } }
        __syncthreads();
        if (wave == 0) { sre[0] = mre[0]; sre[1] = mre[1]; sim[0] = mim[0]; sim[1] = mim[1]; }
        else {
            float pr[2], pi[2];
#pragma unroll
            for (int st = 0; st < 2; ++st) { pr[st] = are[st]; pi[st] = aim[st];
#pragma unroll
                for (int k = 0; k < 8; ++k) { const float nr = pr[st] * pr[st] - pi[st] * pi[st], ni = 2.f * pr[st] * pi[st]; pr[st] = nr; pi[st] = ni; }
                sre[st] = E[st * 64 + r32]; sim[st] = E[st * 64 + 32 + r32]; }
            for (int j = 1; j < wave; ++j) {
#pragma unroll
                for (int st = 0; st < 2; ++st) { const float er = E[j * 128 + st * 64 + r32], ei = E[j * 128 + st * 64 + 32 + r32];
                    const float nr = pr[st] * sre[st] - pi[st] * sim[st] + er, ni = pr[st] * sim[st] + pi[st] * sre[st] + ei; sre[st] = nr; sim[st] = ni; } }
        }
#pragma unroll
        for (int blk = 0; blk < 8; ++blk) {
            f32x16 bu[4];
#pragma unroll
            for (int t = 0; t < 4; ++t) bu[t] = __builtin_amdgcn_mfma_f32_32x32x16_bf16(ufa[blk], Bf[t], (f32x16){}, 0, 0, 0);
            scan_block<true>(bu, sre, sim, are, aim, hi);
#pragma unroll
            for (int reg = 0; reg < 16; ++reg) { const int tok = (reg & 3) + 8 * (reg >> 2) + 4 * hi;
#pragma unroll
                for (int t = 0; t < 4; ++t) *(LAS bf16_t*)(Sl + tok * 304 + (32 * t + r32) * 2) = (bf16_t)(cvt_pk_bf16(bu[t][reg], 0.f) & 0xffffu); }
            *(LAS bf16x8*)(Sl + r32 * 304 + (128 + 8 * hi) * 2) = ufa[blk];
            f32x4 y[2];
#pragma unroll
            for (int mt = 0; mt < 2; ++mt) { y[mt] = (f32x4){0.f, 0.f, 0.f, 0.f};
#pragma unroll
                for (int ks = 0; ks < 4; ++ks) { const bf16x8 af = *(const LAS bf16x8*)(Sl + (16 * mt + fr) * 304 + (32 * ks + 8 * fq) * 2);
                    y[mt] = __builtin_amdgcn_mfma_f32_16x16x32_bf16(af, Cf[ks], y[mt], 0, 0, 0); }
                bf16x8 au = *(const LAS bf16x8*)(Sl + (16 * mt + fr) * 304 + (128 + 8 * (fq & 1)) * 2); if (fq >= 2) au = (bf16x8){};
                y[mt] = __builtin_amdgcn_mfma_f32_16x16x32_bf16(au, Cf[4], y[mt], 0, 0, 0); }
#pragma unroll
            for (int mt = 0; mt < 2; ++mt)
#pragma unroll
                for (int reg = 0; reg < 4; ++reg) *(LAS bf16_t*)(Yl + (16 * mt + 4 * fq + reg) * 32 + fr * 2) = (bf16_t)(cvt_pk_bf16(gelu_tanh(y[mt][reg]), 0.f) & 0xffffu);
            const u32x4 yo = *(const LAS u32x4*)(Yl + (lane >> 1) * 32 + (lane & 1) * 16);
            *(u32x4*)(YPRE + ((size_t)b * SEQ + wave * 256 + 32 * blk + (lane >> 1)) * SSMW + 16 * g + 8 * (lane & 1)) = yo;
        }
        __syncthreads();
    }
}

__device__ __forceinline__ int crow(int r, int hi) { return (r & 3) + 8 * (r >> 2) + 4 * hi; }
typedef short v4i16_t __attribute__((ext_vector_type(4)));
__device__ __forceinline__ s16x4 vtr(const LAS unsigned char* p) { return __builtin_bit_cast(s16x4, __builtin_amdgcn_ds_read_tr16_b64_v4i16((LAS v4i16_t*)p)); }
__device__ __forceinline__ float half_swap_max(float x) { auto rr = __builtin_amdgcn_permlane32_swap(__float_as_uint(x), __float_as_uint(x), false, false); return fmaxf(__uint_as_float(rr[0]), __uint_as_float(rr[1])); }
__device__ __forceinline__ float half_swap_sum(float x) { auto rr = __builtin_amdgcn_permlane32_swap(__float_as_uint(x), __float_as_uint(x), false, false); return __uint_as_float(rr[0]) + __uint_as_float(rr[1]); }

__device__ __forceinline__ void glds16(const void* gsrc, unsigned lds_dst) { unsigned keep;
    asm volatile("s_mov_b32 %0, m0\n\ts_mov_b32 m0, %2\n\ts_nop 0\n\tglobal_load_lds_dwordx4 %1, off\n\ts_mov_b32 m0, %0" : "=&s"(keep) : "v"(gsrc), "s"(lds_dst) : "memory"); }
__device__ __forceinline__ void attn_unit(const Ctx& C, const bf16_t* Qg, const bf16_t* Kg, const bf16_t* Vg, const bf16_t* KM, const bf16_t* VM, bf16_t* Y,
                                          const float* subg, float lam, int b, int h, int qt, bool prefetched, int nqt, bf16x8 (&qr)[4]) {
    LAS unsigned char* lds = C.lds;
    const int lane = C.lane, wave = C.wave, r32 = lane & 31, hi = lane >> 5, qb = wave >> 1, map = wave & 1;
    const int q0 = qt * 128 + qb * 32;
    const size_t rowb = (size_t)b * SEQ;
    if (!prefetched) { const bf16_t* qp = Qg + (rowb + q0 + r32) * AW + h * 128 + map * 64 + hi * 8;
#pragma unroll
      for (int d0 = 0; d0 < 4; ++d0) qr[d0] = *(const bf16x8*)(qp + d0 * 16); }
    const int NT = 2 * qt + 3;
    const bool skip_last = (qb < 2);
    f32x16 o[4];
#pragma unroll
    for (int d = 0; d < 4; ++d) o[d] = (f32x16){};
    float mrun = -__builtin_inff(), lrun = 0.f;
    LAS float* wsf = (LAS float*)(lds + MISC_OFF + 4096 + wave * 256);
    const bf16_t* Kb = Kg + rowb * AW; const bf16_t* Vb = Vg + rowb * AW;
#define ATT_DMA(step, stage) do { const bf16_t* ks_ = (step) == 0 ? KM : Kb; const bf16_t* vs_ = (step) == 0 ? VM : Vb; const int row0_ = (step) == 0 ? 0 : ((step) - 1) * 64; \
    _Pragma("unroll") for (int i_ = 0; i_ < 2; ++i_) { const int p_ = 2 * wave + i_; \
        __builtin_amdgcn_global_load_lds((const unsigned*)(ks_ + (size_t)(row0_ + lane) * AW + h * 128 + (p_ >> 3) * 64 + (p_ & 7) * 8), (LAS unsigned*)(lds + (stage) * 32768 + p_ * 1024), 16, 0, 0); \
        __builtin_amdgcn_global_load_lds((const unsigned*)(vs_ + (size_t)(row0_ + 16 * (p_ & 3) + (lane >> 2)) * AW + h * 128 + (p_ >> 2) * 32 + (lane & 3) * 8), (LAS unsigned*)(lds + (stage) * 32768 + 16384 + p_ * 1024), 16, 0, 0); } } while (0)
    if (!prefetched) ATT_DMA(0, 0);
    asm volatile("s_waitcnt vmcnt(0)" ::: "memory"); __syncthreads();
#pragma unroll 1
    for (int s = 0; s < NT; ++s) {
        const int stage = s & 1;
        if (s + 1 < NT) ATT_DMA(s + 1, stage ^ 1);
        if (!(skip_last && s == NT - 1)) {
            const LAS unsigned char* kb = lds + stage * 32768 + map * 8192 + hi * 1024 + r32 * 16;
            f32x16 p0 = (f32x16){}, p1 = (f32x16){};
#pragma unroll
            for (int d0 = 0; d0 < 4; ++d0) { const bf16x8 b0 = *(const LAS bf16x8*)(kb + d0 * 2048), b1 = *(const LAS bf16x8*)(kb + d0 * 2048 + 512);
                p0 = __builtin_amdgcn_mfma_f32_32x32x16_bf16(b0, qr[d0], p0, 0, 0, 0); p1 = __builtin_amdgcn_mfma_f32_32x32x16_bf16(b1, qr[d0], p1, 0, 0, 0); }
            if (s == 0) {
                asm volatile("" ::: "memory");
#pragma unroll
                for (int r = 0; r < 16; ++r) { if (r >= 8) p0[r] = -__builtin_inff(); p1[r] = -__builtin_inff(); } }
            float rmA = fmaxf(p0[0], p0[1]), rmB = fmaxf(p0[2], p0[3]), rmC = fmaxf(p1[0], p1[1]), rmD = fmaxf(p1[2], p1[3]);
#pragma unroll
            for (int r = 4; r < 16; r += 4) { rmA = fmaxf(rmA, fmaxf(p0[r], p0[r + 1])); rmB = fmaxf(rmB, fmaxf(p0[r + 2], p0[r + 3])); rmC = fmaxf(rmC, fmaxf(p1[r], p1[r + 1])); rmD = fmaxf(rmD, fmaxf(p1[r + 2], p1[r + 3])); }
            const float rm = half_swap_max(fmaxf(fmaxf(rmA, rmB), fmaxf(rmC, rmD)));
            if (s == 0) mrun = rm;
            else if (__any(rm > mrun + 8.0f)) {
                const float mnew = fmaxf(mrun, rm), alpha = __builtin_amdgcn_exp2f(mrun - mnew);
                lrun *= alpha; mrun = mnew;
                if (hi == 0) wsf[r32] = alpha;
                f32x4 a4[4];
#pragma unroll
                for (int gq = 0; gq < 4; ++gq) a4[gq] = *(const LAS f32x4*)(wsf + 8 * gq + 4 * hi);
#pragma unroll
                for (int d = 0; d < 4; ++d)
#pragma unroll
                    for (int r = 0; r < 16; ++r) o[d][r] *= a4[r >> 2][r & 3];
            }
            float psA = 0.f, psB = 0.f, psC = 0.f, psD = 0.f;
#pragma unroll
            for (int r = 0; r < 16; r += 2) { p0[r] = __builtin_amdgcn_exp2f(p0[r] - mrun); p0[r + 1] = __builtin_amdgcn_exp2f(p0[r + 1] - mrun); p1[r] = __builtin_amdgcn_exp2f(p1[r] - mrun); p1[r + 1] = __builtin_amdgcn_exp2f(p1[r + 1] - mrun);
                psA += p0[r]; psB += p0[r + 1]; psC += p1[r]; psD += p1[r + 1]; }
            lrun += (psA + psB) + (psC + psD);
            bf16x8 pa[4];
            { u32x4 w;
              w = (u32x4){cvt_pk_bf16(p0[0], p0[1]), cvt_pk_bf16(p0[2], p0[3]), cvt_pk_bf16(p0[4], p0[5]), cvt_pk_bf16(p0[6], p0[7])}; pa[0] = __builtin_bit_cast(bf16x8, w);
              w = (u32x4){cvt_pk_bf16(p0[8], p0[9]), cvt_pk_bf16(p0[10], p0[11]), cvt_pk_bf16(p0[12], p0[13]), cvt_pk_bf16(p0[14], p0[15])}; pa[1] = __builtin_bit_cast(bf16x8, w);
              w = (u32x4){cvt_pk_bf16(p1[0], p1[1]), cvt_pk_bf16(p1[2], p1[3]), cvt_pk_bf16(p1[4], p1[5]), cvt_pk_bf16(p1[6], p1[7])}; pa[2] = __builtin_bit_cast(bf16x8, w);
              w = (u32x4){cvt_pk_bf16(p1[8], p1[9]), cvt_pk_bf16(p1[10], p1[11]), cvt_pk_bf16(p1[12], p1[13]), cvt_pk_bf16(p1[14], p1[15])}; pa[3] = __builtin_bit_cast(bf16x8, w); }
            const LAS unsigned char* vp0 = lds + stage * 32768 + 16384 + ((lane >> 4) & 1) * 32 + (lane & 3) * 8 + (4 * hi + ((lane & 15) >> 2)) * 64;
            const unsigned vaddr = (unsigned)(uintptr_t)vp0;
            s16x4 vl[2][4], vh[2][4];
#define ATT_VRD(SET, D) do { _Pragma("unroll") for (int ks_ = 0; ks_ < 4; ++ks_) { \
                asm volatile("ds_read_b64_tr_b16 %0, %1 offset:%2" : "=&v"(vl[SET][ks_]) : "v"(vaddr), "i"((D) * 4096 + ks_ * 1024) : "memory"); \
                asm volatile("ds_read_b64_tr_b16 %0, %1 offset:%2" : "=&v"(vh[SET][ks_]) : "v"(vaddr), "i"((D) * 4096 + ks_ * 1024 + 512) : "memory"); } } while (0)
            __builtin_amdgcn_sched_barrier(0);
            ATT_VRD(0, 0);
#pragma unroll
            for (int d = 0; d < 4; ++d) {
                if (d == 0) { ATT_VRD(1, 1); } else if (d == 1) { ATT_VRD(0, 2); } else if (d == 2) { ATT_VRD(1, 3); }
                if (d < 3) asm volatile("s_waitcnt lgkmcnt(8)" ::: "memory"); else asm volatile("s_waitcnt lgkmcnt(0)" ::: "memory");
                __builtin_amdgcn_sched_barrier(0);
#pragma unroll
                for (int ks = 0; ks < 4; ++ks) { const s16x4 lo = vl[d & 1][ks], hv = vh[d & 1][ks];
                    const bf16x8 vf = (bf16x8){lo[0], lo[1], lo[2], lo[3], hv[0], hv[1], hv[2], hv[3]};
                    o[d] = __builtin_amdgcn_mfma_f32_32x32x16_bf16(pa[ks], vf, o[d], 0, 0, 0); }
                __builtin_amdgcn_sched_barrier(0);
            }
#undef ATT_VRD
        }
        asm volatile("s_waitcnt vmcnt(0)" ::: "memory"); __syncthreads();
    }
#undef ATT_DMA
    bf16x8 qn[4];
#pragma unroll
    for (int d0 = 0; d0 < 4; ++d0) qn[d0] = qr[d0];
    if (nqt >= 0) {
        const unsigned lds0 = (unsigned)(uintptr_t)lds;
#pragma unroll
        for (int i = 0; i < 2; ++i) { const int p = 2 * wave + i;
            glds16(KM + (size_t)lane * AW + h * 128 + (p >> 3) * 64 + (p & 7) * 8, (unsigned)__builtin_amdgcn_readfirstlane(lds0 + p * 1024));
            glds16(VM + (size_t)(16 * (p & 3) + (lane >> 2)) * AW + h * 128 + (p >> 2) * 32 + (lane & 3) * 8, (unsigned)__builtin_amdgcn_readfirstlane(lds0 + 16384 + p * 1024)); }
        const bf16_t* qp = Qg + (rowb + nqt * 128 + qb * 32 + r32) * AW + h * 128 + map * 64 + hi * 8;
#pragma unroll
        for (int d0 = 0; d0 < 4; ++d0) qn[d0] = *(const bf16x8*)(qp + d0 * 16);
    }
    { const float ltot = half_swap_sum(lrun); const float inv = (map ? lam : 1.0f) / ltot;
      if (hi == 0) wsf[r32] = inv;
      f32x4 a4[4];
#pragma unroll
      for (int gq = 0; gq < 4; ++gq) a4[gq] = *(const LAS f32x4*)(wsf + 8 * gq + 4 * hi);
#pragma unroll
      for (int d = 0; d < 4; ++d)
#pragma unroll
          for (int r = 0; r < 16; ++r) o[d][r] *= a4[r >> 2][r & 3]; }
    LAS float* X = (LAS float*)(lds + 65536 + qb * 16384);
    if (map == 1) {
#pragma unroll
        for (int d = 0; d < 4; ++d)
#pragma unroll
            for (int r = 0; r < 16; ++r) X[crow(r, hi) * 128 + 32 * d + r32] = o[d][r];
    }
    __syncthreads();
    if (map == 0) {
        float ssq[16];
#pragma unroll
        for (int r = 0; r < 16; ++r) ssq[r] = 0.f;
#pragma unroll
        for (int d = 0; d < 4; ++d)
#pragma unroll
            for (int r = 0; r < 16; ++r) { const float v = o[d][r] - X[crow(r, hi) * 128 + 32 * d + r32]; o[d][r] = v; ssq[r] += v * v; }
#pragma unroll
        for (int r = 0; r < 16; ++r) {
#pragma unroll
            for (int off = 1; off < 32; off <<= 1) ssq[r] += __shfl_xor(ssq[r], off);
            ssq[r] = 0.8f / sqrtf(ssq[r] * (1.f / 128.f) + LN_EPS); }
        LAS bf16_t* Yt = (LAS bf16_t*)X;
#pragma unroll
        for (int d = 0; d < 4; ++d) { const float gg = subg[32 * d + r32];
#pragma unroll
            for (int r = 0; r < 16; ++r) Yt[crow(r, hi) * 128 + 32 * d + r32] = (bf16_t)(cvt_pk_bf16(o[d][r] * ssq[r] * gg, 0.f) & 0xffffu); }
#pragma unroll
        for (int i = 0; i < 8; ++i) { const int id = i * 64 + lane, row = id >> 4, ch = id & 15;
            *(u32x4*)(Y + (rowb + q0 + row) * AW + h * 128 + ch * 8) = *(const LAS u32x4*)(Yt + row * 128 + ch * 8); }
    }
#pragma unroll
    for (int d0 = 0; d0 < 4; ++d0) qr[d0] = qn[d0];
    __syncthreads();
}
__device__ __forceinline__ void p3_attention(const Ctx& C, const float* const* in, unsigned char* ws) {
    const bf16_t* Q = (const bf16_t*)(ws + WS_Q); const bf16_t* K = (const bf16_t*)(ws + WS_K); const bf16_t* V = (const bf16_t*)(ws + WS_V);
    const bf16_t* KM = (const bf16_t*)(ws + WS_KMETA); const bf16_t* VM = (const bf16_t*)(ws + WS_VMETA); bf16_t* Y = (bf16_t*)(ws + WS_YATT);
    const float l1 = wave_sum(in[14][C.lane] * in[15][C.lane]), l2 = wave_sum(in[16][C.lane] * in[17][C.lane]);
    const float lam = expf(l1) - expf(l2) + 0.2f;
#ifndef ATT_REP
#define ATT_REP 1
#endif
    for (int vv = C.vcu; vv < 256 * ATT_REP; vv += C.G) { const int v = vv & 255;
        const int bh = v >> 1, sft = v & 1;
        bf16x8 qr[4];
#pragma unroll
        for (int d0 = 0; d0 < 4; ++d0) qr[d0] = (bf16x8){};
#pragma unroll 1
        for (int i = 0; i < 8; ++i) { const int qt = (i & 1) ? (15 - sft - (i & ~1)) : (sft + (i & ~1)); const int i1 = i + 1;
            const int nqt = i1 < 8 ? ((i1 & 1) ? (15 - sft - (i1 & ~1)) : (sft + (i1 & ~1))) : -1;
            attn_unit(C, Q, K, V, KM, VM, Y, in[18], lam, bh >> 3, bh & 7, qt, i > 0, nqt, qr); }
    }
}

__device__ __forceinline__ void p6_ln1_router(const Ctx& C, const float* const* in, unsigned char* ws) {
    const int lane = C.lane, wave = C.wave, tid = C.tid;
    const bf16_t* Z = (const bf16_t*)(ws + WS_Z); bf16_t* H1 = (bf16_t*)(ws + WS_H1); const float* WrT = (const float*)(ws + WS_WRT);
    int* LIST = (int*)(ws + WS_LIST); float* WGT = (float*)(ws + WS_WGT); unsigned* ECNT = (unsigned*)(ws + WS_CTL) + CW_ECNT;
    const float* lg = in[22]; const float* lb = in[23];
    LAS float* WB = (LAS float*)C.lds;
    LAS unsigned char* XB = C.lds + 98304;
    LAS int* RE = (LAS int*)(XB);
    LAS float* RW = (LAS float*)(XB + 1024);
    LAS int* CL = (LAS int*)(XB + 2048);
    LAS int* BS = (LAS int*)(XB + 2048 + 128);
    LAS int* SL = (LAS int*)(XB + 2048 + 256);
    LAS float* LG = (LAS float*)(XB + 4096) + wave * 80;
    for (int rbk = C.vcu; rbk < T / 128; rbk += C.G) {
        if (tid < 32) CL[tid] = 0;
#pragma unroll 1
        for (int step = 0; step < 8; ++step) {
            const int lr0 = step * 16 + 2 * wave; const size_t row0 = (size_t)rbk * 128 + lr0;
            int l4 = 4 * lane; asm volatile("" : "+v"(l4));
            f32x4 v0[8], v1[8];
#pragma unroll
            for (int j = 0; j < 8; ++j) { const u32x2 z0 = *(const u32x2*)(Z + row0 * DM + 256 * j + l4), z1 = *(const u32x2*)(Z + (row0 + 1) * DM + 256 * j + l4);
                v0[j] = (f32x4){bf_lo(z0.x), bf_hi(z0.x), bf_lo(z0.y), bf_hi(z0.y)}; v1[j] = (f32x4){bf_lo(z1.x), bf_hi(z1.x), bf_lo(z1.y), bf_hi(z1.y)}; }
            float mean0, rstd0, mean1, rstd1; ln_stats(v0, mean0, rstd0); ln_stats(v1, mean1, rstd1);
#pragma unroll
            for (int j = 0; j < 8; ++j) { const f32x4 gg = *(const f32x4*)(lg + 256 * j + l4), bb = *(const f32x4*)(lb + 256 * j + l4);
                v0[j] = (v0[j] - mean0) * rstd0 * gg + bb; v1[j] = (v1[j] - mean1) * rstd1 * gg + bb;
                u32x2 w; w.x = cvt_pk_bf16(v0[j].x, v0[j].y); w.y = cvt_pk_bf16(v0[j].z, v0[j].w); *(u32x2*)(H1 + row0 * DM + 256 * j + l4) = w;
                w.x = cvt_pk_bf16(v1[j].x, v1[j].y); w.y = cvt_pk_bf16(v1[j].z, v1[j].w); *(u32x2*)(H1 + (row0 + 1) * DM + 256 * j + l4) = w; }
#pragma unroll 1
            for (int ng = 0; ng < 3; ++ng) {
                __syncthreads();
                int tq = tid; asm volatile("" : "+v"(tq));
#pragma unroll
                for (int i = 0; i < 12; ++i) { const int idx = tq + 512 * i, n = idx >> 9, c4 = idx & 511;
                    *(LAS f32x4*)(WB + n * 2048 + 4 * c4) = *(const f32x4*)(WrT + (size_t)(12 * ng + n) * DM + 4 * c4); }
                __syncthreads();
#pragma unroll 1
                for (int n = 0; n < 12; ++n) { float pa = 0.f, pb = 0.f;
#pragma unroll
                    for (int j = 0; j < 8; ++j) { const f32x4 w4 = *(const LAS f32x4*)(WB + n * 2048 + 256 * j + l4);
                        const f32x4 a = v0[j] * w4, bq = v1[j] * w4; pa += (a.x + a.y) + (a.z + a.w); pb += (bq.x + bq.y) + (bq.z + bq.w); }
                    const float sa = wave_sum(pa), sb = wave_sum(pb); if (lane == 0) { LG[12 * ng + n] = sa; LG[40 + 12 * ng + n] = sb; } }
            }
            if (lane < 2) {
                const LAS float* L = LG + 40 * lane;
                int gi = 0; float gm = L[0] + in[25][0];
                for (int n = 1; n < 4; ++n) { const float x = L[n] + in[25][n]; if (x > gm) { gm = x; gi = n; } }
                float gs = 0.f;
                for (int n = 0; n < 4; ++n) gs += __expf(L[n] + in[25][n] - gm);
                const float gval = 1.0f / gs;
                int i1 = 0; float m1 = L[4 + gi * 8] + in[27][gi * 8];
                for (int j = 1; j < 8; ++j) { const float x = L[4 + gi * 8 + j] + in[27][gi * 8 + j]; if (x > m1) { m1 = x; i1 = j; } }
                int i2 = -1; float m2 = -__builtin_inff();
                for (int j = 0; j < 8; ++j) { const float x = L[4 + gi * 8 + j] + in[27][gi * 8 + j]; if (j != i1 && x > m2) { m2 = x; i2 = j; } }
                const float tt = __expf(m2 - m1), w1 = gval / (1.f + tt), w2 = gval * tt / (1.f + tt);
                const int lr = lr0 + lane; RE[lr * 2] = gi * 8 + i1; RE[lr * 2 + 1] = gi * 8 + i2; RW[lr * 2] = w1; RW[lr * 2 + 1] = w2;
            }
        }
        __syncthreads();
        int e = 0;
        if (tid < 256) { e = RE[tid]; SL[tid] = __hip_atomic_fetch_add(&CL[e], 1, __ATOMIC_RELAXED, __HIP_MEMORY_SCOPE_WORKGROUP); }
        __syncthreads();
        if (tid < 32) BS[tid] = (int)__hip_atomic_fetch_add(&ECNT[tid], (unsigned)CL[tid], __ATOMIC_RELAXED, __HIP_MEMORY_SCOPE_AGENT);
        __syncthreads();
        if (tid < 256) { const int entry = (rbk * 128 + (tid >> 1)) * 2 + (tid & 1); LIST[(size_t)e * CAP + BS[e] + SL[tid]] = entry; WGT[entry] = RW[tid]; }
        __syncthreads();
    }
}

__device__ __forceinline__ void p9_ln2(const Ctx& C, const float* const* in, unsigned char* ws, float* out) {
    const bf16_t* H1 = (const bf16_t*)(ws + WS_H1); const bf16_t* YK = (const bf16_t*)(ws + WS_YK);
    const float* lg = in[31]; const float* lb = in[32];
    const int gw = C.vcu * 8 + C.wave, NGW = C.G * 8, lane = C.lane;
    for (int m = gw; m < T; m += 2 * NGW) {
        const int m2 = (m + NGW < T) ? m + NGW : m;
        u32x2 ha[8], ya0[8], ya1[8], hb[8], yb0[8], yb1[8];
#pragma unroll
        for (int j = 0; j < 8; ++j) { const size_t c = 256 * j + 4 * lane;
            ha[j] = *(const u32x2*)(H1 + (size_t)m * DM + c); ya0[j] = *(const u32x2*)(YK + (size_t)(2 * m) * DM + c); ya1[j] = *(const u32x2*)(YK + (size_t)(2 * m + 1) * DM + c);
            hb[j] = *(const u32x2*)(H1 + (size_t)m2 * DM + c); yb0[j] = *(const u32x2*)(YK + (size_t)(2 * m2) * DM + c); yb1[j] = *(const u32x2*)(YK + (size_t)(2 * m2 + 1) * DM + c); }
#pragma unroll
        for (int rr = 0; rr < 2; ++rr) {
            f32x4 v[8];
#pragma unroll
            for (int j = 0; j < 8; ++j) { const u32x2 hw = rr ? hb[j] : ha[j], y0 = rr ? yb0[j] : ya0[j], y1 = rr ? yb1[j] : ya1[j];
                v[j] = (f32x4){bf_lo(hw.x), bf_hi(hw.x), bf_lo(hw.y), bf_hi(hw.y)} * ALPHA + (f32x4){bf_lo(y0.x), bf_hi(y0.x), bf_lo(y0.y), bf_hi(y0.y)} + (f32x4){bf_lo(y1.x), bf_hi(y1.x), bf_lo(y1.y), bf_hi(y1.y)}; }
            float mean, rstd; ln_stats(v, mean, rstd);
            const int mm = rr ? m2 : m;
            if (rr == 0 || m2 != m) {
#pragma unroll
                for (int j = 0; j < 8; ++j) { const f32x4 gg = *(const f32x4*)(lg + 256 * j + 4 * lane), bb = *(const f32x4*)(lb + 256 * j + 4 * lane);
                    *(f32x4*)(out + (size_t)mm * DM + 256 * j + 4 * lane) = (v[j] - mean) * rstd * gg + bb; } }
        }
    }
}

__device__ __forceinline__ int build_moe_tables(const Ctx& C, unsigned char* ws) {
    LAS int* blkstart = (LAS int*)(C.lds + MISC_OFF + 64); LAS int* cntE = (LAS int*)(C.lds + MISC_OFF + 320); LAS int* blkexp = (LAS int*)(C.lds + MISC_OFF + 512);
    unsigned* ECNT = (unsigned*)(ws + WS_CTL) + CW_ECNT;
    __syncthreads();
    if (C.tid < 32) cntE[C.tid] = (int)__hip_atomic_load(&ECNT[C.tid], __ATOMIC_RELAXED, __HIP_MEMORY_SCOPE_AGENT);
    __syncthreads();
    if (C.tid == 0) { int s = 0; for (int e = 0; e < NE; ++e) { blkstart[e] = s; s += (cntE[e] + 255) >> 8; } blkstart[NE] = s; }
    __syncthreads();
    const int NBLK = blkstart[NE];
    if (C.tid < NBLK && C.tid < 320) { int e = 0; for (int j = 1; j < NE; ++j) if (blkstart[j] <= C.tid) e = j; blkexp[C.tid] = e; }
    __syncthreads();
    return NBLK < 320 ? NBLK : 320;
}

constexpr int NPHASE = 10;
struct Args { const float* in[33]; float* out; unsigned char* ws; int ph_lo, ph_hi; };
__global__ void __launch_bounds__(512, 2) mk_fwd(Args args) {
    extern __shared__ __attribute__((aligned(16))) unsigned char lds_raw[];
    Ctx C; C.lds = (LAS unsigned char*)lds_raw; C.tid = threadIdx.x; C.lane = C.tid & 63; C.wave = __builtin_amdgcn_readfirstlane(C.tid >> 6);
    C.G = gridDim.x; { const int bx = blockIdx.x; C.vcu = (C.G % 8 == 0) ? (bx % 8) * (C.G / 8) + bx / 8 : bx; }
    unsigned char* ws = args.ws; const float* const* in = args.in;
    volatile LAS unsigned* MISC = (volatile LAS unsigned*)(C.lds + MISC_OFF);
    if (C.tid < 16) MISC[C.tid] = 0u;
    __syncthreads();
    unsigned* barw = (unsigned*)(ws + WS_CTL) + CW_BAR;
    XcdBarrier bar; bar.bar = barw; bar.x = 0; bar.st = nullptr;
    const int lo = args.ph_lo, hi = args.ph_hi;
    if (hi - lo > 1) bar = xcd_barrier_post(barw, MISC);
#ifndef PH_MASK
#define PH_MASK 0x3ff
#endif
#define IN(k) (((PH_MASK >> (k)) & 1) && lo <= (k) && (k) < hi)
#define SEAM(k) do { if (IN(k) && IN((k) + 1)) xcd_barrier(bar); } while (0)
#ifndef WGM_PROJ
#define WGM_PROJ 4
#endif
#ifndef WGM_N2K
#define WGM_N2K 2
#endif
#ifndef GEMM_SP2
#define GEMM_SP2 true
#endif
#ifndef GEMM_ALIGN
#define GEMM_ALIGN true
#endif
#ifndef PROBE_MASK
#define PROBE_MASK 0
#endif
#define REPS(k) (((PROBE_MASK >> (k)) & 1) ? 2 : 1)
#define REPSEAM(k, rep) do { if ((rep) + 1 < REPS(k)) xcd_barrier(bar); } while (0)
    LAS unsigned char* lds = C.lds;
    bf16_t* MG = (bf16_t*)args.out;

    if (IN(0)) { _Pragma("unroll") for (int rep = 0; rep < REPS(0); ++rep) { p0_prologue(C, in, ws); REPSEAM(0, rep); } } SEAM(0);

    if (IN(1)) { _Pragma("unroll") for (int rep = 0; rep < REPS(1); ++rep) {
        pg8::Gemm g{(const bf16_t*)(ws + WS_HBF), (const bf16_t*)(ws + WS_WIN), T, INC, DM, nullptr, nullptr, 0}; pg8::StaticOrder S; S.init(T, INC, C.G, (int)blockIdx.x, WGM_PROJ);
        EpiProj E{(bf16_t*)(ws + WS_U), (bf16_t*)(ws + WS_Q), (bf16_t*)(ws + WS_K), (bf16_t*)(ws + WS_V), (bf16_t*)(ws + WS_SGS), (bf16_t*)(ws + WS_SGA)};
        pg8::gemm_phase<EpiProj, pg8::StaticOrder, GEMM_ALIGN, GEMM_SP2, false>(lds, g, S, E);
        p1_meta_proj(C, ws);
        REPSEAM(1, rep);
    } } SEAM(1);

    if (IN(2)) { _Pragma("unroll") for (int rep = 0; rep < REPS(2); ++rep) { p2_scan(C, in, ws); REPSEAM(2, rep); } } SEAM(2);

    if (IN(3)) { _Pragma("unroll") for (int rep = 0; rep < REPS(3); ++rep) {
        { pg8::Gemm g{(const bf16_t*)(ws + WS_YPRE), (const bf16_t*)(ws + WS_WGLU), T, SSMW, SSMW, nullptr, nullptr, 0}; pg8::StaticOrder S; S.init(T, SSMW, C.G, (int)blockIdx.x);
          EpiGlu E{(const bf16_t*)(ws + WS_YPRE), (bf16_t*)(ws + WS_YSSM)};
          pg8::gemm_phase<EpiGlu, pg8::StaticOrder, GEMM_ALIGN, GEMM_SP2, false>(lds, g, S, E); }
        p3_attention(C, in, ws);
        REPSEAM(3, rep);
    } } SEAM(3);

    if (IN(4)) { _Pragma("unroll") for (int rep = 0; rep < REPS(4); ++rep) {
        { pg8::Gemm g{(const bf16_t*)(ws + WS_YSSM), (const bf16_t*)(ws + WS_WBS), T, DM, SSMW, (const bf16_t*)(ws + WS_YATT), (const bf16_t*)(ws + WS_WBA), AW}; pg8::StaticOrder S; S.init(T, DM, C.G, (int)blockIdx.x, WGM_N2K);
          EpiMergeF E{(const bf16_t*)(ws + WS_SGS), (const bf16_t*)(ws + WS_SGA), MG};
          pg8::gemm_phase<EpiMergeF, pg8::StaticOrder, GEMM_ALIGN, GEMM_SP2, false, true>(lds, g, S, E); }
        REPSEAM(4, rep);
    } } SEAM(4);

    if (IN(5)) { _Pragma("unroll") for (int rep = 0; rep < REPS(5); ++rep) {
        pg8::Gemm g{MG, (const bf16_t*)(ws + WS_WO), T, DM, DM, nullptr, nullptr, 0}; pg8::StaticOrder S; S.init(T, DM, C.G, (int)blockIdx.x, WGM_N2K);
        EpiZ E{(const bf16_t*)(ws + WS_HBF), (bf16_t*)(ws + WS_Z)};
        pg8::gemm_phase<EpiZ, pg8::StaticOrder, GEMM_ALIGN, GEMM_SP2, false>(lds, g, S, E);
        REPSEAM(5, rep);
    } } SEAM(5);

    if (IN(6)) { p6_ln1_router(C, in, ws); } SEAM(6);

    if (IN(7)) { _Pragma("unroll") for (int rep = 0; rep < REPS(7); ++rep) {
        const int NBLK = build_moe_tables(C, ws);
        MoeOrder S{C.G, C.vcu, 2, NBLK, (const LAS int*)(lds + MISC_OFF + 512), (const LAS int*)(lds + MISC_OFF + 64), (const LAS int*)(lds + MISC_OFF + 320), (const int*)(ws + WS_LIST)};
        pg8::Gemm g{(const bf16_t*)(ws + WS_H1), (const bf16_t*)(ws + WS_WUP), T, NE * 1024, DM, nullptr, nullptr, 0};
        EpiSwiglu E{(bf16_t*)(ws + WS_HB), (const int*)(ws + WS_LIST), (const float*)(ws + WS_WGT), (int*)(ws + WS_POSE), (float*)(ws + WS_POSW)};
        pg8::gemm_phase<EpiSwiglu, MoeOrder, GEMM_ALIGN, GEMM_SP2, true>(lds, g, S, E);
        REPSEAM(7, rep);
    } } SEAM(7);

    if (IN(8)) { _Pragma("unroll") for (int rep = 0; rep < REPS(8); ++rep) {
        const int NBLK = build_moe_tables(C, ws);
        MoeOrder S{C.G, C.vcu, 3, NBLK, (const LAS int*)(lds + MISC_OFF + 512), (const LAS int*)(lds + MISC_OFF + 64), (const LAS int*)(lds + MISC_OFF + 320), (const int*)(ws + WS_LIST)};
        pg8::Gemm g{(const bf16_t*)(ws + WS_HB), (const bf16_t*)(ws + WS_WDN), NBLK * 256, NE * DM, DFF, nullptr, nullptr, 0};
        EpiDown E{(const int*)(ws + WS_POSE), (const float*)(ws + WS_POSW), (bf16_t*)(ws + WS_YK)};
        pg8::gemm_phase<EpiDown, MoeOrder, GEMM_ALIGN, GEMM_SP2, false>(lds, g, S, E);
        REPSEAM(8, rep);
    } } SEAM(8);

    if (IN(9)) { _Pragma("unroll") for (int rep = 0; rep < REPS(9); ++rep) { p9_ln2(C, in, ws, args.out); REPSEAM(9, rep); } }
#undef IN
#undef SEAM
}

extern "C" void kernel_launch(void* const* d_in, const int* in_sizes, int n_in, void* d_out, int out_size, void* d_ws, size_t ws_size, hipStream_t stream) {
    static int grid = 0;
    if (grid == 0) {
        if (n_in != 33 || in_sizes[0] != T * DM || out_size != T * DM || ws_size < WS_END) { fprintf(stderr, "kernel_launch: unexpected shapes (n_in %d, in0 %d, out %d, ws %zu)\n", n_in, n_in > 0 ? in_sizes[0] : -1, out_size, ws_size); grid = -1; return; }
        int dev = 0, cus = 0, per_cu = 0;
        if (hipGetDevice(&dev) != hipSuccess || hipDeviceGetAttribute(&cus, hipDeviceAttributeMultiprocessorCount, dev) != hipSuccess) { grid = -1; return; }
        if (hipFuncSetAttribute((const void*)mk_fwd, hipFuncAttributeMaxDynamicSharedMemorySize, LDS_BYTES) != hipSuccess) { fprintf(stderr, "kernel_launch: hipFuncSetAttribute failed\n"); grid = -1; return; }
        if (hipOccupancyMaxActiveBlocksPerMultiprocessor(&per_cu, (const void*)mk_fwd, 512, LDS_BYTES) != hipSuccess || per_cu < 1) { fprintf(stderr, "kernel_launch: occupancy query reports %d blocks per CU\n", per_cu); }
        (void)hipGetLastError();
        grid = cus;
    }
    if (grid < 0) return;
    (void)hipMemsetAsync((char*)d_ws + WS_CTL, 0, CTL_ZERO_BYTES, stream);
    Args a{};
    for (int i = 0; i < 33; ++i) a.in[i] = (const float*)d_in[i];
    a.out = (float*)d_out; a.ws = (unsigned char*)d_ws;
#if MK_PER_PHASE
    for (int p = 0; p < NPHASE; ++p) { a.ph_lo = p; a.ph_hi = p + 1; hipLaunchKernelGGL(mk_fwd, dim3(grid), dim3(512), LDS_BYTES, stream, a); }
#else
    a.ph_lo = 0; a.ph_hi = NPHASE; hipLaunchKernelGGL(mk_fwd, dim3(grid), dim3(512), LDS_BYTES, stream, a);
#endif
}
```

```cpp
#include <hip/hip_runtime.h>
#include <stdint.h>
#include <stdio.h>

#ifndef ATT_PROBE
#define ATT_PROBE 0
#endif
#ifndef MK_PER_PHASE
#define MK_PER_PHASE 0
#endif

#define GAS __attribute__((address_space(1)))
#define LAS __attribute__((address_space(3)))
typedef unsigned short bf16_t;
typedef short bf16x8 __attribute__((ext_vector_type(8)));
typedef short s16x4 __attribute__((ext_vector_type(4)));
typedef float f32x2 __attribute__((ext_vector_type(2)));
typedef float f32x4 __attribute__((ext_vector_type(4)));
typedef float f32x16 __attribute__((ext_vector_type(16)));
typedef unsigned u32x2 __attribute__((ext_vector_type(2)));
typedef unsigned u32x4 __attribute__((ext_vector_type(4)));

constexpr int NB_ = 16, SEQ = 2048, DM = 2048, T = NB_ * SEQ, NMETA = 16;
constexpr int SSMW = 512, AW = 1024, INC = 7680, NGRP = 32, NST = 64;
constexpr int NE = 32, DFF = 512, CAP = T;
constexpr float LN_EPS = 1e-5f;
constexpr float ALPHA = 1.189207115002721f;
constexpr float QSCALE = 0.125f * 1.4426950408889634f;

__device__ __forceinline__ unsigned cvt_pk_bf16(float lo, float hi) { unsigned r; asm volatile("v_cvt_pk_bf16_f32 %0, %1, %2" : "=v"(r) : "v"(lo), "v"(hi)); return r; }
__device__ __forceinline__ float bf_lo(unsigned w) { return __uint_as_float(w << 16); }
__device__ __forceinline__ float bf_hi(unsigned w) { return __uint_as_float(w & 0xffff0000u); }
__device__ __forceinline__ float sigmoidf_(float x) { return 1.0f / (1.0f + __expf(-x)); }
__device__ __forceinline__ float wave_sum(float v) {
#pragma unroll
    for (int o = 1; o < 64; o <<= 1) v += __shfl_xor(v, o);
    return v;
}

namespace pg8 {
constexpr int BM = 256, BK = 64, HALF = 128, HTB = HALF * BK * 2, STAGE_BYTES = 8 * HTB, NXCD = 8, WGM = 4;
__host__ __device__ __forceinline__ int lds_byte(int r, int c) { const int st = (r >> 4) * 2 + (c >> 5), rr = r & 15, cc = c & 31, ob = rr * 64 + cc * 2; return st * 1024 + (ob ^ (((ob >> 9) & 1) << 5)); }
__host__ __device__ __forceinline__ void stage_rc(int b, int& R, int& C) { const int st = b / 1024, sb = b % 1024, swz = sb ^ (((sb >> 9) & 1) << 5); R = (st >> 1) * 16 + swz / 64; C = (st & 1) * 32 + (swz % 64) / 2; }
__host__ __device__ __forceinline__ int perm32(int rho) { const int n = rho >> 4, i = rho & 15; return 8 * (i >> 2) + 4 * n + (i & 3); }

struct Unit { int pm, pn, e, s0, cnt; };
struct Gemm { const bf16_t* A; const bf16_t* Bt; int M, N, K; const bf16_t* A2; const bf16_t* Bt2; int K2; };

struct StaticOrder {
    int nM, nN, nwg, G, c, wgm;
    __device__ void init(int M, int N, int G_, int c_, int wgm_ = WGM) { nM = M / BM; nN = N / BM; nwg = nM * nN; G = G_; c = c_; wgm = wgm_; }
    __device__ bool next(int i, Unit& u) const {
        const long L = (long)i * G + c; if (L >= nwg) return false;
        int wgid = (int)L; { const int q = nwg / NXCD, r = nwg % NXCD, xcd = wgid % NXCD, off = wgid / NXCD; wgid = (xcd < r ? xcd * (q + 1) : r * (q + 1) + (xcd - r) * q) + off; }
        const int nig = wgm * nN, gid = wgid / nig, fm = gid * wgm, gsz = (nM - fm) < wgm ? (nM - fm) : wgm;
        u.pm = fm + ((wgid % nig) % gsz); u.pn = (wgid % nig) / gsz; u.e = 0; u.s0 = 0; u.cnt = 0; return true;
    }
    __device__ __forceinline__ int arow(const Unit&, int) const { return 0; }
};

template <class Epi, class Sched, bool ALIGN_EPI, bool SP2, bool GATHER, bool DUAL = false>
__device__ __forceinline__ void gemm_phase(LAS unsigned char* lds, const Gemm g, const Sched& S, const Epi& E) {
    const int tid = threadIdx.x, wid = __builtin_amdgcn_readfirstlane(tid >> 6), lane = tid & 63, wr = wid >> 2, wc = wid & 3, fr = lane & 15, fq = lane >> 4;
    const int K = g.K, K2 = DUAL ? g.K2 : 0, nt1 = K / BK, nt = (K + K2) / BK;
    unsigned voffA[2], voffB[2], voffA2[2] = {0u, 0u}, voffB2[2] = {0u, 0u}; int stR[2], stC[2];
#pragma unroll
    for (int i = 0; i < 2; ++i) { int R, C; stage_rc(tid * 16 + i * 8192, R, C); const int Rb = Epi::PERM ? ((R & ~31) + perm32(R & 31)) : R;
        stR[i] = R; stC[i] = C; voffA[i] = (unsigned)(R * K + C) * 2u; voffB[i] = (unsigned)(Rb * K + C) * 2u;
        if constexpr (DUAL) { voffA2[i] = (unsigned)(R * K2 + C) * 2u; voffB2[i] = (unsigned)(Rb * K2 + C) * 2u; } }
    const size_t kstep = (size_t)(BK * 2);
    const size_t hstep = (size_t)HALF * K * 2;
    const size_t tstep = 2 * hstep;
    const size_t hstep2 = (size_t)HALF * K2 * 2, tstep2 = 2 * hstep2;
    const unsigned ldsw = (unsigned)wid * 1024u;
    const int aoff = lds_byte(wr * 64 + fr, fq * 8), boff = lds_byte(wc * 32 + fr, fq * 8);
#define PG8_SA(b, h) (((b) * 2 + (h)) * HTB)
#define PG8_SB(b, h) ((4 + (b) * 2 + (h)) * HTB)
#define PG8_STAGE(bufoff, gbase, voff) do { _Pragma("unroll") for (int _i = 0; _i < 2; ++_i) \
        __builtin_amdgcn_global_load_lds((const unsigned*)((const char*)(gbase) + (voff)[_i]), (LAS unsigned*)(lds + (bufoff) + ldsw + _i * 8192), 16, 0, 0); } while (0)
#define PG8_STAGE_A(bufoff, kbase, h, VO) do { if constexpr (GATHER) { PG8_STAGE(bufoff, kbase, VO[h]); } else { PG8_STAGE(bufoff, (kbase) + (h) * hstep, voffA); } } while (0)
#define PG8_STAGE_AX(bufoff, kbase, h, VO, HS, VA) do { if constexpr (GATHER) { PG8_STAGE(bufoff, kbase, VO[h]); } else { PG8_STAGE(bufoff, (kbase) + (h) * (HS), VA); } } while (0)
#define PG8_LDA(dst, b, h) do { _Pragma("unroll") for (int m = 0; m < 4; ++m) _Pragma("unroll") for (int k = 0; k < 2; ++k) dst[m][k] = *(const LAS bf16x8*)(lds + PG8_SA(b, h) + aoff + m * 2048 + k * 1024); } while (0)
#define PG8_LDB(dst, b, h) do { _Pragma("unroll") for (int n = 0; n < 2; ++n) _Pragma("unroll") for (int k = 0; k < 2; ++k) dst[n][k] = *(const LAS bf16x8*)(lds + PG8_SB(b, h) + boff + n * 2048 + k * 1024); } while (0)
#define PG8_MMA(ai, bj, At, Bt) do { __builtin_amdgcn_s_setprio(1); _Pragma("unroll") for (int m = 0; m < 4; ++m) _Pragma("unroll") for (int n = 0; n < 2; ++n) _Pragma("unroll") for (int k = 0; k < 2; ++k) \
        acc[ai][bj][m][n] = __builtin_amdgcn_mfma_f32_16x16x32_bf16(Bt[n][k], At[m][k], acc[ai][bj][m][n], 0, 0, 0); __builtin_amdgcn_s_setprio(0); } while (0)
#define PG8_WAIT_V(n) asm volatile("s_waitcnt vmcnt(" #n ")" ::: "memory")
#define PG8_WAIT_L(n) asm volatile("s_waitcnt lgkmcnt(" #n ")" ::: "memory")
#define PG8_BAR __builtin_amdgcn_s_barrier()
#define PG8_SCHED __builtin_amdgcn_sched_barrier(0)
#define PG8_GOFF(VO, U) do { _Pragma("unroll") for (int _h = 0; _h < 2; ++_h) _Pragma("unroll") for (int _i = 0; _i < 2; ++_i) \
        VO[_h][_i] = (unsigned)S.arow(U, _h * HALF + stR[_i]) * (unsigned)(K * 2) + (unsigned)(stC[_i] * 2); } while (0)
    Unit cur, nxt; int ui = 0;
    if (!S.next(0, cur)) return;
    f32x4 acc[2][2][4][2];
#pragma unroll
    for (int a = 0; a < 2; ++a)
#pragma unroll
        for (int b = 0; b < 2; ++b)
#pragma unroll
            for (int m = 0; m < 4; ++m)
#pragma unroll
                for (int n = 0; n < 2; ++n) acc[a][b][m][n] = (f32x4){0.f, 0.f, 0.f, 0.f};
    bf16x8 At[4][2], B0[2][2], B1[2][2];
    unsigned cvo[2][2] = {{0u, 0u}, {0u, 0u}}, nvo[2][2] = {{0u, 0u}, {0u, 0u}};
    const char* cA = GATHER ? (const char*)g.A : (const char*)g.A + (size_t)cur.pm * tstep; const char* cB = (const char*)g.Bt + (size_t)cur.pn * tstep;
    if constexpr (GATHER) { PG8_GOFF(cvo, cur); }
    if constexpr (SP2) {
        PG8_STAGE(PG8_SB(0, 0), cB, voffB); PG8_STAGE(PG8_SB(0, 1), cB + hstep, voffB); PG8_STAGE_A(PG8_SA(0, 0), cA, 0, cvo); PG8_STAGE_A(PG8_SA(0, 1), cA, 1, cvo);
        if (wr == 1) PG8_BAR;
        PG8_WAIT_V(2); PG8_BAR;
        PG8_STAGE(PG8_SB(1, 0), cB + kstep, voffB); PG8_STAGE_A(PG8_SA(1, 0), cA + kstep, 0, cvo); PG8_STAGE(PG8_SB(1, 1), cB + hstep + kstep, voffB);
        PG8_WAIT_V(6); PG8_BAR;
    } else {
        PG8_STAGE(PG8_SB(0, 0), cB, voffB); PG8_STAGE_A(PG8_SA(0, 0), cA, 0, cvo); PG8_STAGE(PG8_SB(0, 1), cB + hstep, voffB); PG8_STAGE_A(PG8_SA(0, 1), cA, 1, cvo);
        if (wr == 1) PG8_BAR;
        PG8_WAIT_V(4); PG8_BAR;
        PG8_STAGE(PG8_SB(1, 0), cB + kstep, voffB); PG8_STAGE_A(PG8_SA(1, 0), cA + kstep, 0, cvo); PG8_STAGE(PG8_SB(1, 1), cB + hstep + kstep, voffB);
        PG8_WAIT_V(6); PG8_BAR;
    }
    for (;;) {
        const bool has_next = S.next(ui + 1, nxt);
        const char* nA = GATHER ? cA : (has_next ? (const char*)g.A + (size_t)nxt.pm * tstep : cA); const char* nB = has_next ? (const char*)g.Bt + (size_t)nxt.pn * tstep : cB;
        if constexpr (GATHER) { if (has_next) { PG8_GOFF(nvo, nxt); } else {
#pragma unroll
            for (int h = 0; h < 2; ++h)
#pragma unroll
                for (int i = 0; i < 2; ++i) nvo[h][i] = cvo[h][i]; } }
        const char* cA2 = DUAL ? (const char*)g.A2 + (size_t)cur.pm * tstep2 : cA; const char* cB2 = DUAL ? (const char*)g.Bt2 + (size_t)cur.pn * tstep2 : cB;
        for (int t = 0; t < nt; t += 2) {
            const bool last = (t == nt - 2);
            const bool s1 = DUAL && (t + 1 >= nt1), s2 = DUAL && !last && (t + 2 >= nt1);
            const char* a1 = s1 ? cA2 + (size_t)(t + 1 - nt1) * kstep : cA + (size_t)(t + 1) * kstep;
            const char* a2 = last ? nA : (s2 ? cA2 + (size_t)(t + 2 - nt1) * kstep : cA + (size_t)(t + 2) * kstep);
            const char* b2 = last ? nB : (s2 ? cB2 + (size_t)(t + 2 - nt1) * kstep : cB + (size_t)(t + 2) * kstep);
            const char* a3 = a2 + kstep; const char* b3 = b2 + kstep;
            const size_t hs1 = s1 ? hstep2 : hstep, hs2 = s2 ? hstep2 : hstep;
            unsigned vA1[2], vA2[2], vB2[2];
#pragma unroll
            for (int i = 0; i < 2; ++i) { vA1[i] = s1 ? voffA2[i] : voffA[i]; vA2[i] = s2 ? voffA2[i] : voffA[i]; vB2[i] = s2 ? voffB2[i] : voffB[i]; }
            unsigned svo[2][2];
#pragma unroll
            for (int h = 0; h < 2; ++h)
#pragma unroll
                for (int i = 0; i < 2; ++i) svo[h][i] = last ? nvo[h][i] : cvo[h][i];
            if constexpr (SP2) {
            PG8_LDB(B0, 0, 0); PG8_LDB(B1, 0, 1); PG8_SCHED; PG8_LDA(At, 0, 0); PG8_STAGE_AX(PG8_SA(1, 1), a1, 1, cvo, hs1, vA1);
            PG8_WAIT_V(8); PG8_WAIT_L(0); PG8_BAR; PG8_MMA(0, 0, At, B0); PG8_MMA(0, 1, At, B1); PG8_BAR; PG8_SCHED;
            PG8_LDA(At, 0, 1); PG8_STAGE(PG8_SB(0, 0), b2, vB2); PG8_STAGE(PG8_SB(0, 1), b2 + hs2, vB2); PG8_STAGE_AX(PG8_SA(0, 0), a2, 0, svo, hs2, vA2);
            PG8_WAIT_V(8); PG8_WAIT_L(0); PG8_BAR; PG8_MMA(1, 0, At, B0); PG8_MMA(1, 1, At, B1); PG8_BAR; PG8_SCHED;
            PG8_LDB(B0, 1, 0); PG8_LDB(B1, 1, 1); PG8_SCHED; PG8_LDA(At, 1, 0); PG8_STAGE_AX(PG8_SA(0, 1), a2, 1, svo, hs2, vA2);
            PG8_WAIT_V(8); PG8_WAIT_L(0); PG8_BAR; PG8_MMA(0, 0, At, B0); PG8_MMA(0, 1, At, B1); PG8_BAR; PG8_SCHED;
            PG8_LDA(At, 1, 1); PG8_STAGE(PG8_SB(1, 0), b3, vB2); PG8_STAGE(PG8_SB(1, 1), b3 + hs2, vB2); PG8_STAGE_AX(PG8_SA(1, 0), a3, 0, svo, hs2, vA2);
            PG8_WAIT_V(8); PG8_WAIT_L(0); PG8_BAR; PG8_MMA(1, 0, At, B0); PG8_MMA(1, 1, At, B1); PG8_BAR; PG8_SCHED;
            } else {
            PG8_LDB(B0, 0, 0); PG8_SCHED; PG8_LDA(At, 0, 0); PG8_STAGE_AX(PG8_SA(1, 1), a1, 1, cvo, hs1, vA1);
            PG8_WAIT_L(8); PG8_BAR; PG8_WAIT_L(0); PG8_MMA(0, 0, At, B0); PG8_BAR; PG8_SCHED;
            PG8_LDB(B1, 0, 1); PG8_STAGE(PG8_SB(0, 0), b2, vB2);
            PG8_BAR; PG8_WAIT_L(0); PG8_MMA(0, 1, At, B1); PG8_BAR;
            PG8_LDA(At, 0, 1); PG8_STAGE_AX(PG8_SA(0, 0), a2, 0, svo, hs2, vA2);
            PG8_BAR; PG8_WAIT_L(0); PG8_MMA(1, 0, At, B0); PG8_BAR; PG8_SCHED;
            PG8_STAGE(PG8_SB(0, 1), b2 + hs2, vB2);
            PG8_WAIT_V(6); PG8_BAR; PG8_MMA(1, 1, At, B1); PG8_BAR;
            PG8_LDB(B0, 1, 0); PG8_SCHED; PG8_LDA(At, 1, 0); PG8_STAGE_AX(PG8_SA(0, 1), a2, 1, svo, hs2, vA2);
            PG8_WAIT_L(8); PG8_BAR; PG8_WAIT_L(0); PG8_MMA(0, 0, At, B0); PG8_BAR; PG8_SCHED;
            PG8_LDB(B1, 1, 1); PG8_STAGE(PG8_SB(1, 0), b3, vB2);
            PG8_BAR; PG8_WAIT_L(0); PG8_MMA(0, 1, At, B1); PG8_BAR;
            PG8_LDA(At, 1, 1); PG8_STAGE_AX(PG8_SA(1, 0), a3, 0, svo, hs2, vA2);
            PG8_BAR; PG8_WAIT_L(0); PG8_MMA(1, 0, At, B0); PG8_BAR; PG8_SCHED;
            PG8_STAGE(PG8_SB(1, 1), b3 + hs2, vB2);
            PG8_WAIT_V(6); PG8_BAR; PG8_MMA(1, 1, At, B1); PG8_BAR;
            }
            if constexpr (DUAL) { if (t + 2 == nt1) E.mid(acc, cur, wr, wc, fr, fq); }
        }
        if constexpr (ALIGN_EPI) { if (wr == 0) PG8_BAR; }
        E(acc, cur, wr, wc, fr, fq);
        if (!has_next) break;
#pragma unroll
        for (int a = 0; a < 2; ++a)
#pragma unroll
            for (int b = 0; b < 2; ++b)
#pragma unroll
                for (int m = 0; m < 4; ++m)
#pragma unroll
                    for (int n = 0; n < 2; ++n) acc[a][b][m][n] = (f32x4){0.f, 0.f, 0.f, 0.f};
        cur = nxt; cA = nA; cB = nB; ++ui;
#pragma unroll
        for (int h = 0; h < 2; ++h)
#pragma unroll
            for (int i = 0; i < 2; ++i) cvo[h][i] = nvo[h][i];
        if constexpr (ALIGN_EPI) { if (wr == 1) PG8_BAR; }
    }
    PG8_WAIT_V(0);
    if constexpr (!ALIGN_EPI) { if (wr == 0) PG8_BAR; }
    PG8_BAR;
#undef PG8_SA
#undef PG8_SB
#undef PG8_STAGE
#undef PG8_STAGE_A
#undef PG8_STAGE_AX
#undef PG8_LDA
#undef PG8_LDB
#undef PG8_MMA
#undef PG8_WAIT_V
#undef PG8_WAIT_L
#undef PG8_BAR
#undef PG8_SCHED
#undef PG8_GOFF
}
}

constexpr size_t MiB = 1u << 20;
constexpr size_t WS_CTL = 0, CTL_ZERO_BYTES = 1 * MiB;
constexpr size_t WS_HMETA = 1 * MiB;
constexpr size_t WS_UMETA = WS_HMETA + 128 * 1024;
constexpr size_t WS_KMETA = WS_HMETA + 256 * 1024;
constexpr size_t WS_VMETA = WS_HMETA + 384 * 1024;
constexpr size_t WS_SSMAB = WS_HMETA + 512 * 1024;
constexpr size_t WS_SSMBB = WS_HMETA + 576 * 1024;
constexpr size_t WS_WRT = 2 * MiB;
constexpr size_t WS_WIN = 3 * MiB;
constexpr size_t WS_WGLU = 33 * MiB;
constexpr size_t WS_WBS = 34 * MiB;
constexpr size_t WS_WBA = 36 * MiB;
constexpr size_t WS_WO = 40 * MiB;
constexpr size_t WS_WUP = 48 * MiB;
constexpr size_t WS_WDN = 176 * MiB;
constexpr size_t WS_HBF = 240 * MiB;
constexpr size_t WS_U = 368 * MiB;
constexpr size_t WS_Q = 400 * MiB;
constexpr size_t WS_K = 464 * MiB;
constexpr size_t WS_V = 528 * MiB;
constexpr size_t WS_SGS = 592 * MiB;
constexpr size_t WS_SGA = 720 * MiB;
constexpr size_t WS_YPRE = 848 * MiB;
constexpr size_t WS_YSSM = 880 * MiB;
constexpr size_t WS_YATT = 912 * MiB;
constexpr size_t WS_END = 976 * MiB;
constexpr size_t WS_Z = 368 * MiB;
constexpr size_t WS_H1 = 624 * MiB;
constexpr size_t WS_HB = 752 * MiB;
constexpr size_t WS_YK = 368 * MiB;
constexpr size_t WS_LIST = 848 * MiB;
constexpr size_t WS_WGT = 852 * MiB;
constexpr size_t WS_POSE = 853 * MiB;
constexpr size_t WS_POSW = 854 * MiB;
constexpr int CW_ECNT = 64;
constexpr int CW_CONV = 192;
constexpr int CW_BAR = 4096;

constexpr int RING_BYTES = 131072;
constexpr int MISC_OFF = RING_BYTES;
constexpr int LDS_BYTES = 139264;

#define XB_TMO      128
#define XB_XCNT(j)  (256  + 64 * (j))
#define XB_XSUB(j)  (1280 + 64 * (j))
#define XB_XGEN(j)  (2304 + 64 * (j))
#define XB_TOP      3328
#define XB_TOPGEN   3392
#define XCD_BAR_WORDS 3456
#define XB_SPIN_CAP (1u << 18)
__device__ __forceinline__ unsigned xb_ld(unsigned* p)              { return __hip_atomic_load(p, __ATOMIC_RELAXED, __HIP_MEMORY_SCOPE_AGENT); }
__device__ __forceinline__ unsigned xb_add(unsigned* p, unsigned v) { return __hip_atomic_fetch_add(p, v, __ATOMIC_RELAXED, __HIP_MEMORY_SCOPE_AGENT); }
__device__ __forceinline__ unsigned xb_xcc_id() { return (unsigned)__builtin_amdgcn_s_getreg((3 << 11) | 20) & 0xFu; }
#define XB_SPIN(cond, bar) do { unsigned _sp = 0; while (cond) { __builtin_amdgcn_s_sleep(1); \
    if ((++_sp & 255u) == 0u) { if (xb_ld(&(bar)[XB_TMO])) break; if (_sp > XB_SPIN_CAP) { atomicAdd(&(bar)[XB_TMO], 1u); break; } } } } while (0)
struct XcdBarrier { unsigned* bar; unsigned x; volatile LAS unsigned* st; };
__device__ __forceinline__ XcdBarrier xcd_barrier_post(unsigned* bar, volatile LAS unsigned* st) {
    XcdBarrier b; b.bar = bar; b.x = xb_xcc_id(); b.st = st;
    if (threadIdx.x == 0) (void)xb_add(&bar[XB_XCNT(b.x)], 1u);
    return b;
}
__device__ __forceinline__ void xcd_barrier_complete(unsigned* bar, unsigned x, unsigned& nloc, unsigned& nx) {
    const unsigned G = gridDim.x * gridDim.y * gridDim.z;
    unsigned sum, cnt, mine, sp = 0u;
    for (;;) {
        sum = 0u; cnt = 0u; mine = 0u;
#pragma unroll
        for (unsigned j = 0; j < 16; ++j) { const unsigned c = xb_ld(&bar[XB_XCNT(j)]); sum += c; cnt += (c > 0u) ? 1u : 0u; mine = (j == x) ? c : mine; }
        if (sum == G) break;
        __builtin_amdgcn_s_sleep(1);
        if ((++sp & 255u) == 0u) { if (xb_ld(&bar[XB_TMO])) break; if (sp > XB_SPIN_CAP) { atomicAdd(&bar[XB_TMO], 1u); break; } }
    }
    nloc = mine > 0u ? mine : 1u; nx = cnt > 0u ? cnt : 1u;
}
__device__ __forceinline__ void xcd_barrier(const XcdBarrier& b) {
    asm volatile("s_waitcnt vmcnt(0)" ::: "memory");
    __syncthreads();
    if (threadIdx.x == 0) {
        unsigned* bar = b.bar;
        __builtin_amdgcn_s_waitcnt(0);
        unsigned nloc = b.st[0], nx = b.st[1];
        if (nloc == 0u) { xcd_barrier_complete(bar, b.x, nloc, nx); b.st[0] = nloc; b.st[1] = nx; }
        const unsigned old = xb_add(&bar[XB_XSUB(b.x)], 1u);
        const unsigned gen = old / nloc;
        if (old + 1u == (gen + 1u) * nloc) {
            __builtin_amdgcn_fence(__ATOMIC_RELEASE, "agent");
            asm volatile("s_waitcnt vmcnt(0)" ::: "memory");
            const unsigned og = xb_add(&bar[XB_TOP], 1u);
            const unsigned tg = og / nx;
            if (og + 1u == (tg + 1u) * nx) xb_add(&bar[XB_TOPGEN], 1u);
            else XB_SPIN(xb_ld(&bar[XB_TOPGEN]) == tg, bar);
            __builtin_amdgcn_fence(__ATOMIC_ACQUIRE, "agent");
            xb_add(&bar[XB_XGEN(b.x)], 1u);
            asm volatile("s_waitcnt vmcnt(0)" ::: "memory");
        } else {
            XB_SPIN(xb_ld(&bar[XB_XGEN(b.x)]) == gen, bar);
            __builtin_amdgcn_fence(__ATOMIC_ACQUIRE, "agent");
            asm volatile("s_waitcnt vmcnt(0)" ::: "memory");
        }
    }
    __syncthreads();
}

using pg8::Unit;
__device__ __forceinline__ u32x4 pack8(const f32x4 v0, const f32x4 v1) { u32x4 w; w.x = cvt_pk_bf16(v0[0], v0[1]); w.y = cvt_pk_bf16(v0[2], v0[3]); w.z = cvt_pk_bf16(v1[0], v1[1]); w.w = cvt_pk_bf16(v1[2], v1[3]); return w; }
__device__ __forceinline__ void unpack8(const u32x4 w, f32x4& v0, f32x4& v1) { v0 = (f32x4){bf_lo(w.x), bf_hi(w.x), bf_lo(w.y), bf_hi(w.y)}; v1 = (f32x4){bf_lo(w.z), bf_hi(w.z), bf_lo(w.w), bf_hi(w.w)}; }

struct EpiProj {
    static constexpr bool PERM = true;
    bf16_t *U, *Q, *K, *V, *RHO, *SGA;
    __device__ __forceinline__ void operator()(const f32x4 (&acc)[2][2][4][2], const Unit& u, int wr, int wc, int fr, int fq) const {
        const int pn = u.pn;
        if (pn >= 14) {
            const int row0 = u.pm * 256 + wr * 64 + fr, col0 = (pn - 14) * 128 + wc * 32 + 8 * fq;
#pragma unroll
            for (int ai = 0; ai < 2; ++ai)
#pragma unroll
                for (int m = 0; m < 4; ++m) { const size_t off = (size_t)(row0 + ai * 128 + m * 16) * DM + col0; f32x4 r0, r1, a0, a1;
#pragma unroll
                    for (int j = 0; j < 4; ++j) { const float es0 = __expf(-acc[ai][0][m][0][j]), es1 = __expf(-acc[ai][0][m][1][j]), ea0 = __expf(-acc[ai][1][m][0][j]), ea1 = __expf(-acc[ai][1][m][1][j]);
                        a0[j] = __builtin_amdgcn_rcpf(1.f + ea0); a1[j] = __builtin_amdgcn_rcpf(1.f + ea1);
                        r0[j] = (1.f + ea0) * __builtin_amdgcn_rcpf(1.f + es0); r1[j] = (1.f + ea1) * __builtin_amdgcn_rcpf(1.f + es1); }
                    *(u32x4*)(RHO + off) = pack8(r0, r1); *(u32x4*)(SGA + off) = pack8(a0, a1); }
            return;
        }
        bf16_t* base; int ldc, ct, mode;
        if (pn < 2) { base = U; ldc = 512; ct = pn; mode = 0; }
        else if (pn < 6) { base = Q; ldc = 1024; ct = pn - 2; mode = 1; }
        else if (pn < 10) { base = K; ldc = 1024; ct = pn - 6; mode = 0; }
        else { base = V; ldc = 1024; ct = pn - 10; mode = 0; }
        const int row0 = u.pm * 256 + wr * 64 + fr, col0 = ct * 256 + wc * 32 + 8 * fq;
#pragma unroll
        for (int ai = 0; ai < 2; ++ai)
#pragma unroll
            for (int m = 0; m < 4; ++m) { bf16_t* rowp = base + (size_t)(row0 + ai * 128 + m * 16) * ldc + col0;
#pragma unroll
                for (int bj = 0; bj < 2; ++bj) { f32x4 v0 = acc[ai][bj][m][0], v1 = acc[ai][bj][m][1];
                    if (mode == 1) { v0 = v0 * QSCALE; v1 = v1 * QSCALE; }
                    *(u32x4*)(rowp + bj * 128) = pack8(v0, v1); } }
    }
};
struct EpiGlu {
    static constexpr bool PERM = true;
    const bf16_t* YPRE; bf16_t* YSSM;
    __device__ __forceinline__ void operator()(const f32x4 (&acc)[2][2][4][2], const Unit& u, int wr, int wc, int fr, int fq) const {
        const int row0 = u.pm * 256 + wr * 64 + fr, col0 = u.pn * 256 + wc * 32 + 8 * fq;
#pragma unroll
        for (int ai = 0; ai < 2; ++ai)
#pragma unroll
            for (int m = 0; m < 4; ++m) { const size_t off = (size_t)(row0 + ai * 128 + m * 16) * SSMW + col0;
#pragma unroll
                for (int bj = 0; bj < 2; ++bj) { const u32x4 yw = *(const u32x4*)(YPRE + off + bj * 128); f32x4 y0, y1; unpack8(yw, y0, y1);
                    f32x4 v0 = acc[ai][bj][m][0], v1 = acc[ai][bj][m][1];
#pragma unroll
                    for (int j = 0; j < 4; ++j) { v0[j] = y0[j] * sigmoidf_(v0[j]); v1[j] = y1[j] * sigmoidf_(v1[j]); }
                    *(u32x4*)(YSSM + off + bj * 128) = pack8(v0, v1); } }
    }
};
template <int SECOND> struct EpiMerge {
    static constexpr bool PERM = true;
    const bf16_t* SG; bf16_t* MG;
    __device__ __forceinline__ void operator()(const f32x4 (&acc)[2][2][4][2], const Unit& u, int wr, int wc, int fr, int fq) const {
        const int row0 = u.pm * 256 + wr * 64 + fr, col0 = u.pn * 256 + wc * 32 + 8 * fq;
#pragma unroll
        for (int ai = 0; ai < 2; ++ai)
#pragma unroll
            for (int m = 0; m < 4; ++m) { const size_t off = (size_t)(row0 + ai * 128 + m * 16) * DM + col0;
#pragma unroll
                for (int bj = 0; bj < 2; ++bj) { const u32x4 gw = *(const u32x4*)(SG + off + bj * 128); f32x4 g0, g1; unpack8(gw, g0, g1);
                    f32x4 v0 = acc[ai][bj][m][0] * g0, v1 = acc[ai][bj][m][1] * g1;
                    if (SECOND) { const u32x4 pw = *(const u32x4*)(MG + off + bj * 128); f32x4 p0, p1; unpack8(pw, p0, p1); v0 = v0 + p0; v1 = v1 + p1; }
                    *(u32x4*)(MG + off + bj * 128) = pack8(v0, v1); } }
    }
};
struct EpiMergeF {
    static constexpr bool PERM = true;
    const bf16_t* SGS; const bf16_t* SGA; bf16_t* MG;
    __device__ __forceinline__ void mid(f32x4 (&acc)[2][2][4][2], const Unit& u, int wr, int wc, int fr, int fq) const {
        asm volatile("" : "+v"(fr), "+v"(fq));
        const int row0 = u.pm * 256 + wr * 64 + fr, col0 = u.pn * 256 + wc * 32 + 8 * fq;
#pragma unroll
        for (int ai = 0; ai < 2; ++ai)
#pragma unroll
            for (int m = 0; m < 4; ++m) { const size_t off = (size_t)(row0 + ai * 128 + m * 16) * DM + col0;
#pragma unroll
                for (int bj = 0; bj < 2; ++bj) { const u32x4 sw = *(const u32x4*)(SGS + off + bj * 128);
                    f32x4 s0, s1; unpack8(sw, s0, s1);
                    acc[ai][bj][m][0] = acc[ai][bj][m][0] * s0; acc[ai][bj][m][1] = acc[ai][bj][m][1] * s1; }
                asm volatile("" ::: "memory"); }
    }
    __device__ __forceinline__ void operator()(const f32x4 (&acc)[2][2][4][2], const Unit& u, int wr, int wc, int fr, int fq) const {
        const int row0 = u.pm * 256 + wr * 64 + fr, col0 = u.pn * 256 + wc * 32 + 8 * fq;
#pragma unroll
        for (int ai = 0; ai < 2; ++ai)
#pragma unroll
            for (int m = 0; m < 4; ++m) { const size_t off = (size_t)(row0 + ai * 128 + m * 16) * DM + col0;
#pragma unroll
                for (int bj = 0; bj < 2; ++bj) { const u32x4 gw = *(const u32x4*)(SGA + off + bj * 128); f32x4 g0, g1; unpack8(gw, g0, g1);
                    *(u32x4*)(MG + off + bj * 128) = pack8(acc[ai][bj][m][0] * g0, acc[ai][bj][m][1] * g1); } }
    }
};
struct EpiZ {
    static constexpr bool PERM = true;
    const bf16_t* HBF; bf16_t* Z;
    __device__ __forceinline__ void operator()(const f32x4 (&acc)[2][2][4][2], const Unit& u, int wr, int wc, int fr, int fq) const {
        const int row0 = u.pm * 256 + wr * 64 + fr, col0 = u.pn * 256 + wc * 32 + 8 * fq;
#pragma unroll
        for (int ai = 0; ai < 2; ++ai)
#pragma unroll
            for (int m = 0; m < 4; ++m) { const size_t off = (size_t)(row0 + ai * 128 + m * 16) * DM + col0;
#pragma unroll
                for (int bj = 0; bj < 2; ++bj) { const u32x4 hw = *(const u32x4*)(HBF + off + bj * 128); f32x4 h0, h1; unpack8(hw, h0, h1);
                    *(u32x4*)(Z + off + bj * 128) = pack8(acc[ai][bj][m][0] + h0 * ALPHA, acc[ai][bj][m][1] + h1 * ALPHA); } }
    }
};
struct EpiSwiglu {
    static constexpr bool PERM = true;
    bf16_t* HB; const int* LIST; const float* WGT; int* POSE; float* POSW;
    __device__ __forceinline__ void operator()(const f32x4 (&acc)[2][2][4][2], const Unit& u, int wr, int wc, int fr, int fq) const {
        const int row0 = u.pm * 256 + wr * 64 + fr, col0 = (u.pn & 3) * 128 + wc * 32 + 8 * fq;
#pragma unroll
        for (int ai = 0; ai < 2; ++ai)
#pragma unroll
            for (int m = 0; m < 4; ++m) { f32x4 v0, v1;
#pragma unroll
                for (int j = 0; j < 4; ++j) { const float g0 = acc[ai][0][m][0][j], g1 = acc[ai][0][m][1][j];
                    v0[j] = g0 * sigmoidf_(g0) * acc[ai][1][m][0][j]; v1[j] = g1 * sigmoidf_(g1) * acc[ai][1][m][1][j]; }
                *(u32x4*)(HB + (size_t)(row0 + ai * 128 + m * 16) * DFF + col0) = pack8(v0, v1); }
        if ((u.pn & 3) == 0 && wc == 0 && fq == 0) {
#pragma unroll
            for (int ai = 0; ai < 2; ++ai)
#pragma unroll
                for (int m = 0; m < 4; ++m) { const int r = wr * 64 + fr + ai * 128 + m * 16, slot = u.s0 + r; int entry = -1; float w = 0.f;
                    if (slot < u.cnt) { entry = LIST[(size_t)u.e * CAP + slot]; w = WGT[entry]; }
                    POSE[u.pm * 256 + r] = entry; POSW[u.pm * 256 + r] = w; }
        }
    }
};
struct EpiDown {
    static constexpr bool PERM = true;
    const int* POSE; const float* POSW; bf16_t* YK;
    __device__ __forceinline__ void operator()(const f32x4 (&acc)[2][2][4][2], const Unit& u, int wr, int wc, int fr, int fq) const {
        const int r0 = u.pm * 256 + wr * 64 + fr, col0 = (u.pn & 7) * 256 + wc * 32 + 8 * fq;
        int en[2][4]; float ww[2][4];
#pragma unroll
        for (int ai = 0; ai < 2; ++ai)
#pragma unroll
            for (int m = 0; m < 4; ++m) { en[ai][m] = POSE[r0 + ai * 128 + m * 16]; ww[ai][m] = POSW[r0 + ai * 128 + m * 16]; }
#pragma unroll
        for (int ai = 0; ai < 2; ++ai)
#pragma unroll
            for (int m = 0; m < 4; ++m) {
                if (en[ai][m] >= 0) { const float w = ww[ai][m]; bf16_t* rowp = YK + (size_t)en[ai][m] * DM + col0;
#pragma unroll
                    for (int bj = 0; bj < 2; ++bj) *(u32x4*)(rowp + bj * 128) = pack8(acc[ai][bj][m][0] * w, acc[ai][bj][m][1] * w); } }
    }
};
struct MoeOrder {
    int G, c, shift, NB; const LAS int* blkexp; const LAS int* blkstart; const LAS int* cntE; const int* LIST;
    __device__ __forceinline__ bool next(int i, Unit& u) const {
        const long L = (long)i * G + c; if (L >= ((long)NB << shift)) return false;
        const int blk = (int)(L >> shift), tile = (int)(L & ((1 << shift) - 1)), e = blkexp[blk];
        u.pm = blk; u.pn = (e << shift) + tile; u.e = e; u.s0 = (blk - blkstart[e]) * 256; u.cnt = cntE[e]; return true;
    }
    __device__ __forceinline__ int arow(const Unit& u, int r) const { const int slot = u.s0 + r; const int entry = slot < u.cnt ? LIST[(size_t)u.e * CAP + slot] : 0; return entry >> 1; }
};

struct Ctx { LAS unsigned char* lds; int tid, lane, wave, vcu, G; };

__device__ __forceinline__ void transpose_item(const float* W, int K, int N, bf16_t* WT, int kb, int nb, int dst_row0, LAS float* scr, int lane) {
    const int k0 = 64 * kb, n0 = 32 * nb;
    float tv[32];
#pragma unroll
    for (int i = 0; i < 32; ++i) tv[i] = W[(size_t)(k0 + 2 * i + (lane >> 5)) * N + n0 + (lane & 31)];
#pragma unroll
    for (int i = 0; i < 32; ++i) scr[(2 * i + (lane >> 5)) * 33 + (lane & 31)] = tv[i];
    asm volatile("s_waitcnt lgkmcnt(0)" ::: "memory");
    const int c = lane & 7;
#pragma unroll
    for (int j = 0; j < 4; ++j) { const int n = (lane >> 3) + 8 * j; const LAS float* s = scr + (8 * c) * 33 + n;
        u32x4 o; o.x = cvt_pk_bf16(s[0 * 33], s[1 * 33]); o.y = cvt_pk_bf16(s[2 * 33], s[3 * 33]); o.z = cvt_pk_bf16(s[4 * 33], s[5 * 33]); o.w = cvt_pk_bf16(s[6 * 33], s[7 * 33]);
        *(u32x4*)(WT + (size_t)(dst_row0 + n) * K + k0 + 8 * c) = o; }
    asm volatile("s_waitcnt lgkmcnt(0)" ::: "memory");
}
__device__ __forceinline__ void ln_stats(f32x4 (&v)[8], float& mean, float& rstd) {
    float s = 0.f;
#pragma unroll
    for (int j = 0; j < 8; ++j) s += (v[j].x + v[j].y) + (v[j].z + v[j].w);
    mean = wave_sum(s) * (1.f / DM); float s2 = 0.f;
#pragma unroll
    for (int j = 0; j < 8; ++j) { const f32x4 d = v[j] - mean; s2 += (d.x * d.x + d.y * d.y) + (d.z * d.z + d.w * d.w); }
    rstd = 1.f / sqrtf(wave_sum(s2) * (1.f / DM) + LN_EPS);
}

__device__ __forceinline__ void p0_prologue(const Ctx& C, const float* const* in, unsigned char* ws) {
    LAS float* scr = (LAS float*)(C.lds + C.wave * 16384);
    const int gw = C.vcu * 8 + C.wave, NGW = C.G * 8;
    bf16_t* WinT = (bf16_t*)(ws + WS_WIN); bf16_t* WgluT = (bf16_t*)(ws + WS_WGLU); bf16_t* WbsT = (bf16_t*)(ws + WS_WBS); bf16_t* WbaT = (bf16_t*)(ws + WS_WBA);
    bf16_t* WoT = (bf16_t*)(ws + WS_WO); bf16_t* WupT = (bf16_t*)(ws + WS_WUP);
    constexpr int I_WIN = (DM / 64) * (INC / 32), I_GLU = (SSMW / 64) * (SSMW / 32), I_BS = (SSMW / 64) * (DM / 32), I_BA = (AW / 64) * (DM / 32), I_WO = (DM / 64) * (DM / 32);
    constexpr int I_EXP = NE * 512;
    constexpr int NITEMS = I_WIN + I_GLU + I_BS + I_BA + I_WO + 2 * I_EXP;
    for (int it = gw; it < NITEMS; it += NGW) {
        int r = it;
        if (r < I_WIN) { const int nblk = INC / 32, nb = r % nblk, n0 = 32 * nb;
            const int drow = n0 < 3584 ? n0 : (n0 < 5632 ? 3584 + ((n0 - 3584) >> 7) * 256 + ((n0 - 3584) & 127) : 3584 + ((n0 - 5632) >> 7) * 256 + 128 + ((n0 - 5632) & 127));
            transpose_item(in[4], DM, INC, WinT, r / nblk, nb, drow, scr, C.lane); continue; } r -= I_WIN;
        if (r < I_GLU) { const int nblk = SSMW / 32; transpose_item(in[13], SSMW, SSMW, WgluT, r / nblk, r % nblk, 32 * (r % nblk), scr, C.lane); continue; } r -= I_GLU;
        if (r < I_BS) { const int nblk = DM / 32; transpose_item(in[19], SSMW, DM, WbsT, r / nblk, r % nblk, 32 * (r % nblk), scr, C.lane); continue; } r -= I_BS;
        if (r < I_BA) { const int nblk = DM / 32; transpose_item(in[20], AW, DM, WbaT, r / nblk, r % nblk, 32 * (r % nblk), scr, C.lane); continue; } r -= I_BA;
        if (r < I_WO) { const int nblk = DM / 32; transpose_item(in[21], DM, DM, WoT, r / nblk, r % nblk, 32 * (r % nblk), scr, C.lane); continue; } r -= I_WO;
        if (r < 2 * I_EXP) { const int up = r >= I_EXP ? 1 : 0; r -= up * I_EXP; const int e = r >> 9, rr = r & 511, kb = rr >> 4, nb = rr & 15, n0 = 32 * nb;
            transpose_item(in[28 + up] + (size_t)e * DM * DFF, DM, DFF, WupT, kb, nb, e * 1024 + (n0 >> 7) * 256 + up * 128 + (n0 & 127), scr, C.lane); continue; }
    }
    const int gt = C.vcu * 512 + C.tid, NGT = C.G * 512;
    { float* WrT = (float*)(ws + WS_WRT);
      for (int i = gt; i < 36 * DM; i += NGT) { const int n = i / DM, k = i % DM; WrT[i] = n < 4 ? in[24][k * 4 + n] : in[26][k * 32 + (n - 4)]; } }
    { u32x4* kz = (u32x4*)(ws + WS_KMETA + 16 * 1024 * 2); u32x4* vz = (u32x4*)(ws + WS_VMETA + 16 * 1024 * 2);
      for (int i = gt; i < 48 * 1024 * 2 / 16; i += NGT) { kz[i] = (u32x4){0u, 0u, 0u, 0u}; vz[i] = (u32x4){0u, 0u, 0u, 0u}; } }
    { float* AB = (float*)(ws + WS_SSMAB); float* BB = (float*)(ws + WS_SSMBB);
      for (int i = gt; i < NGRP * NST; i += NGT) { const int g = i >> 6;
        const double lre = fmin((double)in[5][i], -1e-4), lim = (double)in[6][i], dt = exp((double)in[7][g]);
        const double mag = exp(lre * dt), abr = mag * cos(lim * dt), abi = mag * sin(lim * dt), den = lre * lre + lim * lim, nr = abr - 1.0, ni = abi;
        const double zr = (nr * lre + ni * lim) / den, zi = (ni * lre - nr * lim) / den;
        AB[i] = (float)abr; AB[NGRP * NST + i] = (float)abi;
#pragma unroll 4
        for (int c = 0; c < 16; ++c) { const double br = (double)in[8][i * 16 + c], bi = (double)in[9][i * 16 + c];
            BB[i * 16 + c] = (float)(zr * br - zi * bi); BB[NGRP * NST * 16 + i * 16 + c] = (float)(zr * bi + zi * br); } } }
    const float* lg = in[2]; const float* lb = in[3];
    bf16_t* HBF = (bf16_t*)(ws + WS_HBF);
    for (int m = gw; m < T + NMETA; m += 2 * NGW) {
        const int m2 = (m + NGW < T + NMETA) ? m + NGW : m;
        const float* xa = m >= T ? in[1] + (size_t)(m - T) * DM : in[0] + (size_t)m * DM; const float* xb = m2 >= T ? in[1] + (size_t)(m2 - T) * DM : in[0] + (size_t)m2 * DM;
        f32x4 va[8], vb[8];
#pragma unroll
        for (int j = 0; j < 8; ++j) { va[j] = *(const f32x4*)(xa + 256 * j + 4 * C.lane); vb[j] = *(const f32x4*)(xb + 256 * j + 4 * C.lane); }
        float meana, rstda, meanb, rstdb; ln_stats(va, meana, rstda); ln_stats(vb, meanb, rstdb);
#pragma unroll
        for (int rr = 0; rr < 2; ++rr) { const int mm = rr ? m2 : m; if (rr == 1 && m2 == m) break; const bool meta = mm >= T;
#pragma unroll
            for (int j = 0; j < 8; ++j) { const f32x4 gg = *(const f32x4*)(lg + 256 * j + 4 * C.lane), bb = *(const f32x4*)(lb + 256 * j + 4 * C.lane);
                const f32x4 o = rr ? (vb[j] - meanb) * rstdb * gg + bb : (va[j] - meana) * rstda * gg + bb;
                if (meta) *(f32x4*)((float*)(ws + WS_HMETA) + (size_t)(mm - T) * DM + 256 * j + 4 * C.lane) = o;
                else { u32x2 w; w.x = cvt_pk_bf16(o.x, o.y); w.y = cvt_pk_bf16(o.z, o.w); *(u32x2*)(HBF + (size_t)mm * DM + 256 * j + 4 * C.lane) = w; } } }
    }
}

__device__ __forceinline__ void p1_meta_proj(const Ctx& C, unsigned char* ws) {
    const bf16_t* WinT = (const bf16_t*)(ws + WS_WIN); const float* HM = (const float*)(ws + WS_HMETA);
    const int gw = C.vcu * 8 + C.wave, NGW = C.G * 8;
    for (int it = gw; it < 640; it += NGW) {
        const int nidx = 4 * it; const int col0 = nidx < 512 ? nidx : (nidx < 1536 ? 1536 + (nidx - 512) : 2560 + (nidx - 1536));
        float acc[16][4];
#pragma unroll
        for (int r = 0; r < 16; ++r)
#pragma unroll
            for (int c = 0; c < 4; ++c) acc[r][c] = 0.f;
#pragma unroll 1
        for (int j = 0; j < 4; ++j) { const int k0 = j * 512 + C.lane * 8;
            f32x4 w0[4], w1[4];
#pragma unroll
            for (int c = 0; c < 4; ++c) { const u32x4 ww = *(const u32x4*)(WinT + (size_t)(col0 + c) * DM + k0); unpack8(ww, w0[c], w1[c]); }
#pragma unroll
            for (int r = 0; r < 16; ++r) { const f32x4 h0 = *(const f32x4*)(HM + r * DM + k0), h1 = *(const f32x4*)(HM + r * DM + k0 + 4);
#pragma unroll
                for (int c = 0; c < 4; ++c) { const f32x4 p = h0 * w0[c] + h1 * w1[c]; acc[r][c] += (p.x + p.y) + (p.z + p.w); } } }
        float mine = 0.f;
#pragma unroll
        for (int r = 0; r < 16; ++r)
#pragma unroll
            for (int c = 0; c < 4; ++c) { const float s = wave_sum(acc[r][c]); mine = (C.lane == r * 4 + c) ? s : mine; }
        const int r = C.lane >> 2, c = C.lane & 3;
        if (nidx < 512) ((float*)(ws + WS_UMETA))[r * SSMW + nidx + c] = mine;
        else if (nidx < 1536) ((bf16_t*)(ws + WS_KMETA))[r * AW + (nidx - 512) + c] = (bf16_t)(cvt_pk_bf16(mine, 0.f) & 0xffffu);
        else ((bf16_t*)(ws + WS_VMETA))[r * AW + (nidx - 1536) + c] = (bf16_t)(cvt_pk_bf16(mine, 0.f) & 0xffffu);
    }
}

__device__ __forceinline__ float gelu_tanh(float x) { const float u = 1.5957691216057308f * (x + 0.044715f * x * x * x); return x / (1.0f + __expf(-u)); }
#define SC_HANDOFF(Q) do { _Pragma("unroll") for (int st_ = 0; st_ < 2; ++st_) { \
        auto rr_ = __builtin_amdgcn_permlane32_swap(__float_as_uint(sre[st_]), __float_as_uint(sre[st_]), false, false); sre[st_] = __uint_as_float(rr_[(Q) & 1]); \
        auto ri_ = __builtin_amdgcn_permlane32_swap(__float_as_uint(sim[st_]), __float_as_uint(sim[st_]), false, false); sim[st_] = __uint_as_float(ri_[(Q) & 1]); } } while (0)
template <bool STORE> __device__ __forceinline__ void scan_block(f32x16 (&buv)[4], float (&sre)[2], float (&sim)[2], const float (&are)[2], const float (&aim)[2], int hi) {
    float bu[4][16];
#pragma unroll
    for (int t = 0; t < 4; ++t)
#pragma unroll
        for (int r = 0; r < 16; ++r) bu[t][r] = buv[t][r];
#pragma unroll
    for (int q = 0; q < 8; ++q) {
        const bool act = (hi == (q & 1));
#pragma unroll
        for (int i = 0; i < 4; ++i) { const int reg = 4 * (q >> 1) + i;
#pragma unroll
            for (int st = 0; st < 2; ++st) {
                const float nre = are[st] * sre[st] - aim[st] * sim[st] + bu[st][reg];
                const float nim = are[st] * sim[st] + aim[st] * sre[st] + bu[2 + st][reg];
                sre[st] = nre; sim[st] = nim;
                if (STORE) { bu[st][reg] = act ? nre : bu[st][reg]; bu[2 + st][reg] = act ? nim : bu[2 + st][reg]; } } }
        SC_HANDOFF(q);
    }
    if (STORE) {
#pragma unroll
        for (int t = 0; t < 4; ++t)
#pragma unroll
            for (int r = 0; r < 16; ++r) buv[t][r] = bu[t][r];
    }
}
__device__ __forceinline__ void p2_scan(const Ctx& C, const float* const* in, unsigned char* ws) {
    const int lane = C.lane, wave = C.wave, r32 = lane & 31, hi = lane >> 5, fr = lane & 15, fq = lane >> 4;
    const bf16_t* U = (const bf16_t*)(ws + WS_U); const float* UM = (const float*)(ws + WS_UMETA); bf16_t* YPRE = (bf16_t*)(ws + WS_YPRE);
    const float* AB = (const float*)(ws + WS_SSMAB); const float* BB = (const float*)(ws + WS_SSMBB);
    LAS unsigned char* Sl = C.lds + wave * 10752;
    LAS unsigned char* Yl = Sl + 9728;
    LAS float* E = (LAS float*)(C.lds + 86016);
    for (int item = C.vcu; item < NB_ * NGRP; item += C.G) {
        const int b = item >> 5, g = item & 31;
        const bf16_t* Ub = U + ((size_t)b * SEQ + wave * 256) * SSMW + 16 * g;
        bf16x8 ufa[8];
#pragma unroll
        for (int blk = 0; blk < 8; ++blk) ufa[blk] = *(const bf16x8*)(Ub + (size_t)(32 * blk + r32) * SSMW + 8 * hi);
        float are[2], aim[2];
#pragma unroll
        for (int st = 0; st < 2; ++st) { are[st] = AB[g * 64 + 32 * st + r32]; aim[st] = AB[NGRP * NST + g * 64 + 32 * st + r32]; }
        bf16x8 Bf[4];
#pragma unroll
        for (int ri = 0; ri < 2; ++ri)
#pragma unroll
            for (int st = 0; st < 2; ++st) { const float* src = BB + ri * (NGRP * NST * 16) + (g * 64 + 32 * st + r32) * 16 + 8 * hi;
                const f32x4 x0 = *(const f32x4*)src, x1 = *(const f32x4*)(src + 4); Bf[2 * ri + st] = __builtin_bit_cast(bf16x8, pack8(x0, x1)); }
        bf16x8 Cf[5];
#pragma unroll
        for (int ks = 0; ks < 4; ++ks) { const int k0 = 32 * ks + 8 * fq; const float* src = (ks < 2 ? in[10] : in[11]) + (g * 16 + fr) * 64 + (k0 & 63);
            f32x4 x0 = *(const f32x4*)src, x1 = *(const f32x4*)(src + 4); if (ks >= 2) { x0 = -x0; x1 = -x1; } Cf[ks] = __builtin_bit_cast(bf16x8, pack8(x0, x1)); }
        { const float dsk = in[12][g * 16 + fr]; f32x4 x0, x1;
#pragma unroll
          for (int j = 0; j < 4; ++j) { x0[j] = (fq < 2 && 8 * fq + j == fr) ? dsk : 0.f; x1[j] = (fq < 2 && 8 * fq + 4 + j == fr) ? dsk : 0.f; }
          Cf[4] = __builtin_bit_cast(bf16x8, pack8(x0, x1)); }
        float sre[2] = {0.f, 0.f}, sim[2] = {0.f, 0.f}, mre[2] = {0.f, 0.f}, mim[2] = {0.f, 0.f};
        if (wave == 0) {
            f32x4 x0 = (f32x4){0.f, 0.f, 0.f, 0.f}, x1 = x0;
            if (r32 >= 16) { const float* src = UM + (r32 - 16) * SSMW + 16 * g + 8 * hi; x0 = *(const f32x4*)src; x1 = *(const f32x4*)(src + 4); }
            const bf16x8 uf = __builtin_bit_cast(bf16x8, pack8(x0, x1));
            f32x16 bu[4];
#pragma unroll
            for (int t = 0; t < 4; ++t) bu[t] = __builtin_amdgcn_mfma_f32_32x32x16_bf16(uf, Bf[t], (f32x16){}, 0, 0, 0);
            scan_block<false>(bu, sre, sim, are, aim, hi);
            mre[0] = sre[0]; mre[1] = sre[1]; mim[0] = sim[0]; mim[1] = sim[1];
        }
#pragma unroll
        for (int blk = 0; blk < 8; ++blk) {
            f32x16 bu[4];
#pragma unroll
            for (int t = 0; t < 4; ++t) bu[t] = __builtin_amdgcn_mfma_f32_32x32x16_bf16(ufa[blk], Bf[t], (f32x16){}, 0, 0, 0);
            scan_block<false>(bu, sre, sim, are, aim, hi);
        }
        if (hi == 0) {
#pragma unroll
            for (int st = 0; st < 2; ++st) { E[wave * 128 + st * 64 + r32] = sre[st]; E[wave * 128 + st * 64 + 32 + r32] = sim[st]; } }
        __syncthreads();
        if (wave == 0) { sre[0] = mre[0]; sre[1] = mre[1]; sim[0] = mim[0]; sim[1] = mim[1]; }
        else {
            float pr[2], pi[2];
#pragma unroll
            for (int st = 0; st < 2; ++st) { pr[st] = are[st]; pi[st] = aim[st];
#pragma unroll
                for (int k = 0; k < 8; ++k) { const float nr = pr[st] * pr[st] - pi[st] * pi[st], ni = 2.f * pr[st] * pi[st]; pr[st] = nr; pi[st] = ni; }
                sre[st] = E[st * 64 + r32]; sim[st] = E[st * 64 + 32 + r32]; }
            for (int j = 1; j < wave; ++j) {
#pragma unroll
                for (int st = 0; st < 2; ++st) { const float er = E[j * 128 + st * 64 + r32], ei = E[j * 128 + st * 64 + 32 + r32];
                    const float nr = pr[st] * sre[st] - pi[st] * sim[st] + er, ni = pr[st] * sim[st] + pi[st] * sre[st] + ei; sre[st] = nr; sim[st] = ni; } }
        }
#pragma unroll
        for (int blk = 0; blk < 8; ++blk) {
            f32x16 bu[4];
#pragma unroll
            for (int t = 0; t < 4; ++t) bu[t] = __builtin_amdgcn_mfma_f32_32x32x16_bf16(ufa[blk], Bf[t], (f32x16){}, 0, 0, 0);
            scan_block<true>(bu, sre, sim, are, aim, hi);
#pragma unroll
            for (int reg = 0; reg < 16; ++reg) { const int tok = (reg & 3) + 8 * (reg >> 2) + 4 * hi;
#pragma unroll
                for (int t = 0; t < 4; ++t) *(LAS bf16_t*)(Sl + tok * 304 + (32 * t + r32) * 2) = (bf16_t)(cvt_pk_bf16(bu[t][reg], 0.f) & 0xffffu); }
            *(LAS bf16x8*)(Sl + r32 * 304 + (128 + 8 * hi) * 2) = ufa[blk];
            f32x4 y[2];
#pragma unroll
            for (int mt = 0; mt < 2; ++mt) { y[mt] = (f32x4){0.f, 0.f, 0.f, 0.f};
#pragma unroll
                for (int ks = 0; ks < 4; ++ks) { const bf16x8 af = *(const LAS bf16x8*)(Sl + (16 * mt + fr) * 304 + (32 * ks + 8 * fq) * 2);
                    y[mt] = __builtin_amdgcn_mfma_f32_16x16x32_bf16(af, Cf[ks], y[mt], 0, 0, 0); }
                bf16x8 au = *(const LAS bf16x8*)(Sl + (16 * mt + fr) * 304 + (128 + 8 * (fq & 1)) * 2); if (fq >= 2) au = (bf16x8){};
                y[mt] = __builtin_amdgcn_mfma_f32_16x16x32_bf16(au, Cf[4], y[mt], 0, 0, 0); }
#pragma unroll
            for (int mt = 0; mt < 2; ++mt)
#pragma unroll
                for (int reg = 0; reg < 4; ++reg) *(LAS bf16_t*)(Yl + (16 * mt + 4 * fq + reg) * 32 + fr * 2) = (bf16_t)(cvt_pk_bf16(gelu_tanh(y[mt][reg]), 0.f) & 0xffffu);
            const u32x4 yo = *(const LAS u32x4*)(Yl + (lane >> 1) * 32 + (lane & 1) * 16);
            *(u32x4*)(YPRE + ((size_t)b * SEQ + wave * 256 + 32 * blk + (lane >> 1)) * SSMW + 16 * g + 8 * (lane & 1)) = yo;
        }
        __syncthreads();
    }
}

__device__ __forceinline__ int crow(int r, int hi) { return (r & 3) + 8 * (r >> 2) + 4 * hi; }
typedef short v4i16_t __attribute__((ext_vector_type(4)));
__device__ __forceinline__ s16x4 vtr(const LAS unsigned char* p) { return __builtin_bit_cast(s16x4, __builtin_amdgcn_ds_read_tr16_b64_v4i16((LAS v4i16_t*)p)); }
__device__ __forceinline__ float half_swap_max(float x) { auto rr = __builtin_amdgcn_permlane32_swap(__float_as_uint(x), __float_as_uint(x), false, false); return fmaxf(__uint_as_float(rr[0]), __uint_as_float(rr[1])); }
__device__ __forceinline__ float half_swap_sum(float x) { auto rr = __builtin_amdgcn_permlane32_swap(__float_as_uint(x), __float_as_uint(x), false, false); return __uint_as_float(rr[0]) + __uint_as_float(rr[1]); }

__device__ __forceinline__ void glds16(const void* gsrc, unsigned lds_dst) { unsigned keep;
    asm volatile("s_mov_b32 %0, m0\n\ts_mov_b32 m0, %2\n\ts_nop 0\n\tglobal_load_lds_dwordx4 %1, off\n\ts_mov_b32 m0, %0" : "=&s"(keep) : "v"(gsrc), "s"(lds_dst) : "memory"); }
__device__ __forceinline__ void attn_unit(const Ctx& C, const bf16_t* Qg, const bf16_t* Kg, const bf16_t* Vg, const bf16_t* KM, const bf16_t* VM, bf16_t* Y,
                                          const float* subg, float lam, int b, int h, int qt, bool prefetched, int nqt, bf16x8 (&qr)[4]) {
    LAS unsigned char* lds = C.lds;
    const int lane = C.lane, wave = C.wave, r32 = lane & 31, hi = lane >> 5, qb = wave >> 1, map = wave & 1;
    const int q0 = qt * 128 + qb * 32;
    const size_t rowb = (size_t)b * SEQ;
    if (!prefetched) { const bf16_t* qp = Qg + (rowb + q0 + r32) * AW + h * 128 + map * 64 + hi * 8;
#pragma unroll
      for (int d0 = 0; d0 < 4; ++d0) qr[d0] = *(const bf16x8*)(qp + d0 * 16); }
    const int NT = 2 * qt + 3;
    const bool skip_last = (qb < 2);
    f32x16 o[4];
#pragma unroll
    for (int d = 0; d < 4; ++d) o[d] = (f32x16){};
    float mrun = -__builtin_inff(), lrun = 0.f;
    LAS float* wsf = (LAS float*)(lds + MISC_OFF + 4096 + wave * 256);
    const bf16_t* Kb = Kg + rowb * AW; const bf16_t* Vb = Vg + rowb * AW;
#define ATT_DMA(step, stage) do { const bf16_t* ks_ = (step) == 0 ? KM : Kb; const bf16_t* vs_ = (step) == 0 ? VM : Vb; const int row0_ = (step) == 0 ? 0 : ((step) - 1) * 64; \
    _Pragma("unroll") for (int i_ = 0; i_ < 2; ++i_) { const int p_ = 2 * wave + i_; \
        __builtin_amdgcn_global_load_lds((const unsigned*)(ks_ + (size_t)(row0_ + lane) * AW + h * 128 + (p_ >> 3) * 64 + (p_ & 7) * 8), (LAS unsigned*)(lds + (stage) * 32768 + p_ * 1024), 16, 0, 0); \
        __builtin_amdgcn_global_load_lds((const unsigned*)(vs_ + (size_t)(row0_ + 16 * (p_ & 3) + (lane >> 2)) * AW + h * 128 + (p_ >> 2) * 32 + (lane & 3) * 8), (LAS unsigned*)(lds + (stage) * 32768 + 16384 + p_ * 1024), 16, 0, 0); } } while (0)
    if (!prefetched) ATT_DMA(0, 0);
    asm volatile("s_waitcnt vmcnt(0)" ::: "memory"); __syncthreads();
#pragma unroll 1
    for (int s = 0; s < NT; ++s) {
        const int stage = s & 1;
        if (s + 1 < NT) ATT_DMA(s + 1, stage ^ 1);
        if (!(skip_last && s == NT - 1)) {
            const LAS unsigned char* kb = lds + stage * 32768 + map * 8192 + hi * 1024 + r32 * 16;
            f32x16 p0 = (f32x16){}, p1 = (f32x16){};
#pragma unroll
            for (int d0 = 0; d0 < 4; ++d0) { const bf16x8 b0 = *(const LAS bf16x8*)(kb + d0 * 2048), b1 = *(const LAS bf16x8*)(kb + d0 * 2048 + 512);
                p0 = __builtin_amdgcn_mfma_f32_32x32x16_bf16(b0, qr[d0], p0, 0, 0, 0); p1 = __builtin_amdgcn_mfma_f32_32x32x16_bf16(b1, qr[d0], p1, 0, 0, 0); }
            if (s == 0) {
                asm volatile("" ::: "memory");
#pragma unroll
                for (int r = 0; r < 16; ++r) { if (r >= 8) p0[r] = -__builtin_inff(); p1[r] = -__builtin_inff(); } }
            float rmA = fmaxf(p0[0], p0[1]), rmB = fmaxf(p0[2], p0[3]), rmC = fmaxf(p1[0], p1[1]), rmD = fmaxf(p1[2], p1[3]);
#pragma unroll
            for (int r = 4; r < 16; r += 4) { rmA = fmaxf(rmA, fmaxf(p0[r], p0[r + 1])); rmB = fmaxf(rmB, fmaxf(p0[r + 2], p0[r + 3])); rmC = fmaxf(rmC, fmaxf(p1[r], p1[r + 1])); rmD = fmaxf(rmD, fmaxf(p1[r + 2], p1[r + 3])); }
            const float rm = half_swap_max(fmaxf(fmaxf(rmA, rmB), fmaxf(rmC, rmD)));
            if (s == 0) mrun = rm;
            else if (__any(rm > mrun + 8.0f)) {
                const float mnew = fmaxf(mrun, rm), alpha = __builtin_amdgcn_exp2f(mrun - mnew);
                lrun *= alpha; mrun = mnew;
                if (hi == 0) wsf[r32] = alpha;
                f32x4 a4[4];
#pragma unroll
                for (int gq = 0; gq < 4; ++gq) a4[gq] = *(const LAS f32x4*)(wsf + 8 * gq + 4 * hi);
#pragma unroll
                for (int d = 0; d < 4; ++d)
#pragma unroll
                    for (int r = 0; r < 16; ++r) o[d][r] *= a4[r >> 2][r & 3];
            }
            float psA = 0.f, psB = 0.f, psC = 0.f, psD = 0.f;
#pragma unroll
            for (int r = 0; r < 16; r += 2) { p0[r] = __builtin_amdgcn_exp2f(p0[r] - mrun); p0[r + 1] = __builtin_amdgcn_exp2f(p0[r + 1] - mrun); p1[r] = __builtin_amdgcn_exp2f(p1[r] - mrun); p1[r + 1] = __builtin_amdgcn_exp2f(p1[r + 1] - mrun);
                psA += p0[r]; psB += p0[r + 1]; psC += p1[r]; psD += p1[r + 1]; }
            lrun += (psA + psB) + (psC + psD);
            bf16x8 pa[4];
            { u32x4 w;
              w = (u32x4){cvt_pk_bf16(p0[0], p0[1]), cvt_pk_bf16(p0[2], p0[3]), cvt_pk_bf16(p0[4], p0[5]), cvt_pk_bf16(p0[6], p0[7])}; pa[0] = __builtin_bit_cast(bf16x8, w);
              w = (u32x4){cvt_pk_bf16(p0[8], p0[9]), cvt_pk_bf16(p0[10], p0[11]), cvt_pk_bf16(p0[12], p0[13]), cvt_pk_bf16(p0[14], p0[15])}; pa[1] = __builtin_bit_cast(bf16x8, w);
              w = (u32x4){cvt_pk_bf16(p1[0], p1[1]), cvt_pk_bf16(p1[2], p1[3]), cvt_pk_bf16(p1[4], p1[5]), cvt_pk_bf16(p1[6], p1[7])}; pa[2] = __builtin_bit_cast(bf16x8, w);
              w = (u32x4){cvt_pk_bf16(p1[8], p1[9]), cvt_pk_bf16(p1[10], p1[11]), cvt_pk_bf16(p1[12], p1[13]), cvt_pk_bf16(p1[14], p1[15])}; pa[3] = __builtin_bit_cast(bf16x8, w); }
            const LAS unsigned char* vp0 = lds + stage * 32768 + 16384 + ((lane >> 4) & 1) * 32 + (lane & 3) * 8 + (4 * hi + ((lane & 15) >> 2)) * 64;
            const unsigned vaddr = (unsigned)(uintptr_t)vp0;
            s16x4 vl[2][4], vh[2][4];
#define ATT_VRD(SET, D) do { _Pragma("unroll") for (int ks_ = 0; ks_ < 4; ++ks_) { \
                asm volatile("ds_read_b64_tr_b16 %0, %1 offset:%2" : "=&v"(vl[SET][ks_]) : "v"(vaddr), "i"((D) * 4096 + ks_ * 1024) : "memory"); \
                asm volatile("ds_read_b64_tr_b16 %0, %1 offset:%2" : "=&v"(vh[SET][ks_]) : "v"(vaddr), "i"((D) * 4096 + ks_ * 1024 + 512) : "memory"); } } while (0)
            __builtin_amdgcn_sched_barrier(0);
            ATT_VRD(0, 0);
#pragma unroll
            for (int d = 0; d < 4; ++d) {
                if (d == 0) { ATT_VRD(1, 1); } else if (d == 1) { ATT_VRD(0, 2); } else if (d == 2) { ATT_VRD(1, 3); }
                if (d < 3) asm volatile("s_waitcnt lgkmcnt(8)" ::: "memory"); else asm volatile("s_waitcnt lgkmcnt(0)" ::: "memory");
                __builtin_amdgcn_sched_barrier(0);
#pragma unroll
                for (int ks = 0; ks < 4; ++ks) { const s16x4 lo = vl[d & 1][ks], hv = vh[d & 1][ks];
                    const bf16x8 vf = (bf16x8){lo[0], lo[1], lo[2], lo[3], hv[0], hv[1], hv[2], hv[3]};
                    o[d] = __builtin_amdgcn_mfma_f32_32x32x16_bf16(pa[ks], vf, o[d], 0, 0, 0); }
                __builtin_amdgcn_sched_barrier(0);
            }
#undef ATT_VRD
        }
        asm volatile("s_waitcnt vmcnt(0)" ::: "memory"); __syncthreads();
    }
#undef ATT_DMA
    bf16x8 qn[4];
#pragma unroll
    for (int d0 = 0; d0 < 4; ++d0) qn[d0] = qr[d0];
    if (nqt >= 0) {
        const unsigned lds0 = (unsigned)(uintptr_t)lds;
#pragma unroll
        for (int i = 0; i < 2; ++i) { const int p = 2 * wave + i;
            glds16(KM + (size_t)lane * AW + h * 128 + (p >> 3) * 64 + (p & 7) * 8, (unsigned)__builtin_amdgcn_readfirstlane(lds0 + p * 1024));
            glds16(VM + (size_t)(16 * (p & 3) + (lane >> 2)) * AW + h * 128 + (p >> 2) * 32 + (lane & 3) * 8, (unsigned)__builtin_amdgcn_readfirstlane(lds0 + 16384 + p * 1024)); }
        const bf16_t* qp = Qg + (rowb + nqt * 128 + qb * 32 + r32) * AW + h * 128 + map * 64 + hi * 8;
#pragma unroll
        for (int d0 = 0; d0 < 4; ++d0) qn[d0] = *(const bf16x8*)(qp + d0 * 16);
    }
    { const float ltot = half_swap_sum(lrun); const float inv = (map ? lam : 1.0f) / ltot;
      if (hi == 0) wsf[r32] = inv;
      f32x4 a4[4];
#pragma unroll
      for (int gq = 0; gq < 4; ++gq) a4[gq] = *(const LAS f32x4*)(wsf + 8 * gq + 4 * hi);
#pragma unroll
      for (int d = 0; d < 4; ++d)
#pragma unroll
          for (int r = 0; r < 16; ++r) o[d][r] *= a4[r >> 2][r & 3]; }
    LAS float* X = (LAS float*)(lds + 65536 + qb * 16384);
    if (map == 1) {
#pragma unroll
        for (int d = 0; d < 4; ++d)
#pragma unroll
            for (int r = 0; r < 16; ++r) X[crow(r, hi) * 128 + 32 * d + r32] = o[d][r];
    }
    __syncthreads();
    if (map == 0) {
        float ssq[16];
#pragma unroll
        for (int r = 0; r < 16; ++r) ssq[r] = 0.f;
#pragma unroll
        for (int d = 0; d < 4; ++d)
#pragma unroll
            for (int r = 0; r < 16; ++r) { const float v = o[d][r] - X[crow(r, hi) * 128 + 32 * d + r32]; o[d][r] = v; ssq[r] += v * v; }
#pragma unroll
        for (int r = 0; r < 16; ++r) {
#pragma unroll
            for (int off = 1; off < 32; off <<= 1) ssq[r] += __shfl_xor(ssq[r], off);
            ssq[r] = 0.8f / sqrtf(ssq[r] * (1.f / 128.f) + LN_EPS); }
        LAS bf16_t* Yt = (LAS bf16_t*)X;
#pragma unroll
        for (int d = 0; d < 4; ++d) { const float gg = subg[32 * d + r32];
#pragma unroll
            for (int r = 0; r < 16; ++r) Yt[crow(r, hi) * 128 + 32 * d + r32] = (bf16_t)(cvt_pk_bf16(o[d][r] * ssq[r] * gg, 0.f) & 0xffffu); }
#pragma unroll
        for (int i = 0; i < 8; ++i) { const int id = i * 64 + lane, row = id >> 4, ch = id & 15;
            *(u32x4*)(Y + (rowb + q0 + row) * AW + h * 128 + ch * 8) = *(const LAS u32x4*)(Yt + row * 128 + ch * 8); }
    }
#pragma unroll
    for (int d0 = 0; d0 < 4; ++d0) qr[d0] = qn[d0];
    __syncthreads();
}
__device__ __forceinline__ void p3_attention(const Ctx& C, const float* const* in, unsigned char* ws) {
    const bf16_t* Q = (const bf16_t*)(ws + WS_Q); const bf16_t* K = (const bf16_t*)(ws + WS_K); const bf16_t* V = (const bf16_t*)(ws + WS_V);
    const bf16_t* KM = (const bf16_t*)(ws + WS_KMETA); const bf16_t* VM = (const bf16_t*)(ws + WS_VMETA); bf16_t* Y = (bf16_t*)(ws + WS_YATT);
    const float l1 = wave_sum(in[14][C.lane] * in[15][C.lane]), l2 = wave_sum(in[16][C.lane] * in[17][C.lane]);
    const float lam = expf(l1) - expf(l2) + 0.2f;
#ifndef ATT_REP
#define ATT_REP 1
#endif
    for (int vv = C.vcu; vv < 256 * ATT_REP; vv += C.G) { const int v = vv & 255;
        const int bh = v >> 1, sft = v & 1;
        bf16x8 qr[4];
#pragma unroll
        for (int d0 = 0; d0 < 4; ++d0) qr[d0] = (bf16x8){};
#pragma unroll 1
        for (int i = 0; i < 8; ++i) { const int qt = (i & 1) ? (15 - sft - (i & ~1)) : (sft + (i & ~1)); const int i1 = i + 1;
            const int nqt = i1 < 8 ? ((i1 & 1) ? (15 - sft - (i1 & ~1)) : (sft + (i1 & ~1))) : -1;
            attn_unit(C, Q, K, V, KM, VM, Y, in[18], lam, bh >> 3, bh & 7, qt, i > 0, nqt, qr); }
    }
}

__device__ __forceinline__ void p6_ln1_router(const Ctx& C, const float* const* in, unsigned char* ws) {
    const int lane = C.lane, wave = C.wave, tid = C.tid;
    const bf16_t* Z = (const bf16_t*)(ws + WS_Z); bf16_t* H1 = (bf16_t*)(ws + WS_H1); const float* WrT = (const float*)(ws + WS_WRT);
    int* LIST = (int*)(ws + WS_LIST); float* WGT = (float*)(ws + WS_WGT); unsigned* ECNT = (unsigned*)(ws + WS_CTL) + CW_ECNT;
    const float* lg = in[22]; const float* lb = in[23];
    LAS float* WB = (LAS float*)C.lds;
    LAS unsigned char* XB = C.lds + 98304;
    LAS int* RE = (LAS int*)(XB);
    LAS float* RW = (LAS float*)(XB + 1024);
    LAS int* CL = (LAS int*)(XB + 2048);
    LAS int* BS = (LAS int*)(XB + 2048 + 128);
    LAS int* SL = (LAS int*)(XB + 2048 + 256);
    LAS float* LG = (LAS float*)(XB + 4096) + wave * 80;
    for (int rbk = C.vcu; rbk < T / 128; rbk += C.G) {
        if (tid < 32) CL[tid] = 0;
#pragma unroll 1
        for (int step = 0; step < 8; ++step) {
            const int lr0 = step * 16 + 2 * wave; const size_t row0 = (size_t)rbk * 128 + lr0;
            int l4 = 4 * lane; asm volatile("" : "+v"(l4));
            f32x4 v0[8], v1[8];
#pragma unroll
            for (int j = 0; j < 8; ++j) { const u32x2 z0 = *(const u32x2*)(Z + row0 * DM + 256 * j + l4), z1 = *(const u32x2*)(Z + (row0 + 1) * DM + 256 * j + l4);
                v0[j] = (f32x4){bf_lo(z0.x), bf_hi(z0.x), bf_lo(z0.y), bf_hi(z0.y)}; v1[j] = (f32x4){bf_lo(z1.x), bf_hi(z1.x), bf_lo(z1.y), bf_hi(z1.y)}; }
            float mean0, rstd0, mean1, rstd1; ln_stats(v0, mean0, rstd0); ln_stats(v1, mean1, rstd1);
#pragma unroll
            for (int j = 0; j < 8; ++j) { const f32x4 gg = *(const f32x4*)(lg + 256 * j + l4), bb = *(const f32x4*)(lb + 256 * j + l4);
                v0[j] = (v0[j] - mean0) * rstd0 * gg + bb; v1[j] = (v1[j] - mean1) * rstd1 * gg + bb;
                u32x2 w; w.x = cvt_pk_bf16(v0[j].x, v0[j].y); w.y = cvt_pk_bf16(v0[j].z, v0[j].w); *(u32x2*)(H1 + row0 * DM + 256 * j + l4) = w;
                w.x = cvt_pk_bf16(v1[j].x, v1[j].y); w.y = cvt_pk_bf16(v1[j].z, v1[j].w); *(u32x2*)(H1 + (row0 + 1) * DM + 256 * j + l4) = w; }
#pragma unroll 1
            for (int ng = 0; ng < 3; ++ng) {
                __syncthreads();
                int tq = tid; asm volatile("" : "+v"(tq));
#pragma unroll
                for (int i = 0; i < 12; ++i) { const int idx = tq + 512 * i, n = idx >> 9, c4 = idx & 511;
                    *(LAS f32x4*)(WB + n * 2048 + 4 * c4) = *(const f32x4*)(WrT + (size_t)(12 * ng + n) * DM + 4 * c4); }
                __syncthreads();
#pragma unroll 1
                for (int n = 0; n < 12; ++n) { float pa = 0.f, pb = 0.f;
#pragma unroll
                    for (int j = 0; j < 8; ++j) { const f32x4 w4 = *(const LAS f32x4*)(WB + n * 2048 + 256 * j + l4);
                        const f32x4 a = v0[j] * w4, bq = v1[j] * w4; pa += (a.x + a.y) + (a.z + a.w); pb += (bq.x + bq.y) + (bq.z + bq.w); }
                    const float sa = wave_sum(pa), sb = wave_sum(pb); if (lane == 0) { LG[12 * ng + n] = sa; LG[40 + 12 * ng + n] = sb; } }
            }
            if (lane < 2) {
                const LAS float* L = LG + 40 * lane;
                int gi = 0; float gm = L[0] + in[25][0];
                for (int n = 1; n < 4; ++n) { const float x = L[n] + in[25][n]; if (x > gm) { gm = x; gi = n; } }
                float gs = 0.f;
                for (int n = 0; n < 4; ++n) gs += __expf(L[n] + in[25][n] - gm);
                const float gval = 1.0f / gs;
                int i1 = 0; float m1 = L[4 + gi * 8] + in[27][gi * 8];
                for (int j = 1; j < 8; ++j) { const float x = L[4 + gi * 8 + j] + in[27][gi * 8 + j]; if (x > m1) { m1 = x; i1 = j; } }
                int i2 = -1; float m2 = -__builtin_inff();
                for (int j = 0; j < 8; ++j) { const float x = L[4 + gi * 8 + j] + in[27][gi * 8 + j]; if (j != i1 && x > m2) { m2 = x; i2 = j; } }
                const float tt = __expf(m2 - m1), w1 = gval / (1.f + tt), w2 = gval * tt / (1.f + tt);
                const int lr = lr0 + lane; RE[lr * 2] = gi * 8 + i1; RE[lr * 2 + 1] = gi * 8 + i2; RW[lr * 2] = w1; RW[lr * 2 + 1] = w2;
            }
        }
        __syncthreads();
        int e = 0;
        if (tid < 256) { e = RE[tid]; SL[tid] = __hip_atomic_fetch_add(&CL[e], 1, __ATOMIC_RELAXED, __HIP_MEMORY_SCOPE_WORKGROUP); }
        __syncthreads();
        if (tid < 32) BS[tid] = (int)__hip_atomic_fetch_add(&ECNT[tid], (unsigned)CL[tid], __ATOMIC_RELAXED, __HIP_MEMORY_SCOPE_AGENT);
        __syncthreads();
        if (tid < 256) { const int entry = (rbk * 128 + (tid >> 1)) * 2 + (tid & 1); LIST[(size_t)e * CAP + BS[e] + SL[tid]] = entry; WGT[entry] = RW[tid]; }
        __syncthreads();
    }
}

__device__ __forceinline__ void p9_ln2(const Ctx& C, const float* const* in, unsigned char* ws, float* out) {
    const bf16_t* H1 = (const bf16_t*)(ws + WS_H1); const bf16_t* YK = (const bf16_t*)(ws + WS_YK);
    const float* lg = in[31]; const float* lb = in[32];
    const int gw = C.vcu * 8 + C.wave, NGW = C.G * 8, lane = C.lane;
    for (int m = gw; m < T; m += 2 * NGW) {
        const int m2 = (m + NGW < T) ? m + NGW : m;
        u32x2 ha[8], ya0[8], ya1[8], hb[8], yb0[8], yb1[8];
#pragma unroll
        for (int j = 0; j < 8; ++j) { const size_t c = 256 * j + 4 * lane;
            ha[j] = *(const u32x2*)(H1 + (size_t)m * DM + c); ya0[j] = *(const u32x2*)(YK + (size_t)(2 * m) * DM + c); ya1[j] = *(const u32x2*)(YK + (size_t)(2 * m + 1) * DM + c);
            hb[j] = *(const u32x2*)(H1 + (size_t)m2 * DM + c); yb0[j] = *(const u32x2*)(YK + (size_t)(2 * m2) * DM + c); yb1[j] = *(const u32x2*)(YK + (size_t)(2 * m2 + 1) * DM + c); }
#pragma unroll
        for (int rr = 0; rr < 2; ++rr) {
            f32x4 v[8];
#pragma unroll
            for (int j = 0; j < 8; ++j) { const u32x2 hw = rr ? hb[j] : ha[j], y0 = rr ? yb0[j] : ya0[j], y1 = rr ? yb1[j] : ya1[j];
                v[j] = (f32x4){bf_lo(hw.x), bf_hi(hw.x), bf_lo(hw.y), bf_hi(hw.y)} * ALPHA + (f32x4){bf_lo(y0.x), bf_hi(y0.x), bf_lo(y0.y), bf_hi(y0.y)} + (f32x4){bf_lo(y1.x), bf_hi(y1.x), bf_lo(y1.y), bf_hi(y1.y)}; }
            float mean, rstd; ln_stats(v, mean, rstd);
            const int mm = rr ? m2 : m;
            if (rr == 0 || m2 != m) {
#pragma unroll
                for (int j = 0; j < 8; ++j) { const f32x4 gg = *(const f32x4*)(lg + 256 * j + 4 * lane), bb = *(const f32x4*)(lb + 256 * j + 4 * lane);
                    *(f32x4*)(out + (size_t)mm * DM + 256 * j + 4 * lane) = (v[j] - mean) * rstd * gg + bb; } }
        }
    }
}

__device__ __forceinline__ int build_moe_tables(const Ctx& C, unsigned char* ws) {
    LAS int* blkstart = (LAS int*)(C.lds + MISC_OFF + 64); LAS int* cntE = (LAS int*)(C.lds + MISC_OFF + 320); LAS int* blkexp = (LAS int*)(C.lds + MISC_OFF + 512);
    unsigned* ECNT = (unsigned*)(ws + WS_CTL) + CW_ECNT;
    __syncthreads();
    if (C.tid < 32) cntE[C.tid] = (int)__hip_atomic_load(&ECNT[C.tid], __ATOMIC_RELAXED, __HIP_MEMORY_SCOPE_AGENT);
    __syncthreads();
    if (C.tid == 0) { int s = 0; for (int e = 0; e < NE; ++e) { blkstart[e] = s; s += (cntE[e] + 255) >> 8; } blkstart[NE] = s; }
    __syncthreads();
    const int NBLK = blkstart[NE];
    if (C.tid < NBLK && C.tid < 320) { int e = 0; for (int j = 1; j < NE; ++j) if (blkstart[j] <= C.tid) e = j; blkexp[C.tid] = e; }
    __syncthreads();
    return NBLK < 320 ? NBLK : 320;
}

__device__ __forceinline__ void p7_convert_down(const Ctx& C, const float* const* in, unsigned char* ws) {
    LAS float* scr = (LAS float*)(C.lds + C.wave * 16384);
    unsigned* ctr = (unsigned*)(ws + WS_CTL) + CW_CONV; bf16_t* WdnT = (bf16_t*)(ws + WS_WDN);
    constexpr int NCH = NE * 512 / 16;
    for (;;) {
        unsigned ch = 0; if (C.lane == 0) ch = __hip_atomic_fetch_add(ctr, 1u, __ATOMIC_RELAXED, __HIP_MEMORY_SCOPE_AGENT);
        ch = (unsigned)__builtin_amdgcn_readfirstlane((int)ch);
        if (ch >= (unsigned)NCH) break;
#pragma unroll 1
        for (int q = 0; q < 16; ++q) { const int r = (int)ch * 16 + q, e = r >> 9, rr = r & 511, kb = rr >> 6, nb = rr & 63;
            transpose_item(in[30] + (size_t)e * DFF * DM, DFF, DM, WdnT, kb, nb, e * 2048 + 32 * nb, scr, C.lane); }
    }
}

constexpr int NPHASE = 10;
struct Args { const float* in[33]; float* out; unsigned char* ws; int ph_lo, ph_hi; };
__global__ void __launch_bounds__(512, 2) mk_fwd(Args args) {
    extern __shared__ __attribute__((aligned(16))) unsigned char lds_raw[];
    Ctx C; C.lds = (LAS unsigned char*)lds_raw; C.tid = threadIdx.x; C.lane = C.tid & 63; C.wave = __builtin_amdgcn_readfirstlane(C.tid >> 6);
    C.G = gridDim.x; { const int bx = blockIdx.x; C.vcu = (C.G % 8 == 0) ? (bx % 8) * (C.G / 8) + bx / 8 : bx; }
    unsigned char* ws = args.ws; const float* const* in = args.in;
    volatile LAS unsigned* MISC = (volatile LAS unsigned*)(C.lds + MISC_OFF);
    if (C.tid < 16) MISC[C.tid] = 0u;
    __syncthreads();
    unsigned* barw = (unsigned*)(ws + WS_CTL) + CW_BAR;
    XcdBarrier bar; bar.bar = barw; bar.x = 0; bar.st = nullptr;
    const int lo = args.ph_lo, hi = args.ph_hi;
    if (hi - lo > 1) bar = xcd_barrier_post(barw, MISC);
#ifndef PH_MASK
#define PH_MASK 0x3ff
#endif
#define IN(k) (((PH_MASK >> (k)) & 1) && lo <= (k) && (k) < hi)
#define SEAM(k) do { if (IN(k) && IN((k) + 1)) xcd_barrier(bar); } while (0)
#ifndef WGM_PROJ
#define WGM_PROJ 4
#endif
#ifndef WGM_N2K
#define WGM_N2K 2
#endif
#ifndef GEMM_SP2
#define GEMM_SP2 true
#endif
#ifndef GEMM_ALIGN
#define GEMM_ALIGN true
#endif
#ifndef PROBE_MASK
#define PROBE_MASK 0
#endif
#define REPS(k) (((PROBE_MASK >> (k)) & 1) ? 2 : 1)
#define REPSEAM(k, rep) do { if ((rep) + 1 < REPS(k)) xcd_barrier(bar); } while (0)
    LAS unsigned char* lds = C.lds;
    bf16_t* MG = (bf16_t*)args.out;

    if (IN(0)) { _Pragma("unroll") for (int rep = 0; rep < REPS(0); ++rep) { p0_prologue(C, in, ws); REPSEAM(0, rep); } } SEAM(0);

    if (IN(1)) { _Pragma("unroll") for (int rep = 0; rep < REPS(1); ++rep) {
        pg8::Gemm g{(const bf16_t*)(ws + WS_HBF), (const bf16_t*)(ws + WS_WIN), T, INC, DM, nullptr, nullptr, 0}; pg8::StaticOrder S; S.init(T, INC, C.G, (int)blockIdx.x, WGM_PROJ);
        EpiProj E{(bf16_t*)(ws + WS_U), (bf16_t*)(ws + WS_Q), (bf16_t*)(ws + WS_K), (bf16_t*)(ws + WS_V), (bf16_t*)(ws + WS_SGS), (bf16_t*)(ws + WS_SGA)};
        pg8::gemm_phase<EpiProj, pg8::StaticOrder, GEMM_ALIGN, GEMM_SP2, false>(lds, g, S, E);
        p1_meta_proj(C, ws);
        REPSEAM(1, rep);
    } } SEAM(1);

    if (IN(2)) { _Pragma("unroll") for (int rep = 0; rep < REPS(2); ++rep) { p2_scan(C, in, ws); REPSEAM(2, rep); } } SEAM(2);

    if (IN(3)) { _Pragma("unroll") for (int rep = 0; rep < REPS(3); ++rep) {
        { pg8::Gemm g{(const bf16_t*)(ws + WS_YPRE), (const bf16_t*)(ws + WS_WGLU), T, SSMW, SSMW, nullptr, nullptr, 0}; pg8::StaticOrder S; S.init(T, SSMW, C.G, (int)blockIdx.x);
          EpiGlu E{(const bf16_t*)(ws + WS_YPRE), (bf16_t*)(ws + WS_YSSM)};
          pg8::gemm_phase<EpiGlu, pg8::StaticOrder, GEMM_ALIGN, GEMM_SP2, false>(lds, g, S, E); }
        p3_attention(C, in, ws);
        REPSEAM(3, rep);
    } } SEAM(3);

    if (IN(4)) { _Pragma("unroll") for (int rep = 0; rep < REPS(4); ++rep) {
        { pg8::Gemm g{(const bf16_t*)(ws + WS_YSSM), (const bf16_t*)(ws + WS_WBS), T, DM, SSMW, (const bf16_t*)(ws + WS_YATT), (const bf16_t*)(ws + WS_WBA), AW}; pg8::StaticOrder S; S.init(T, DM, C.G, (int)blockIdx.x, WGM_N2K);
          EpiMergeF E{(const bf16_t*)(ws + WS_SGS), (const bf16_t*)(ws + WS_SGA), MG};
          pg8::gemm_phase<EpiMergeF, pg8::StaticOrder, GEMM_ALIGN, GEMM_SP2, false, true>(lds, g, S, E); }
        REPSEAM(4, rep);
    } } SEAM(4);

    if (IN(5)) { _Pragma("unroll") for (int rep = 0; rep < REPS(5); ++rep) {
        pg8::Gemm g{MG, (const bf16_t*)(ws + WS_WO), T, DM, DM, nullptr, nullptr, 0}; pg8::StaticOrder S; S.init(T, DM, C.G, (int)blockIdx.x, WGM_N2K);
        EpiZ E{(const bf16_t*)(ws + WS_HBF), (bf16_t*)(ws + WS_Z)};
        pg8::gemm_phase<EpiZ, pg8::StaticOrder, GEMM_ALIGN, GEMM_SP2, false>(lds, g, S, E);
        REPSEAM(5, rep);
    } } SEAM(5);

    if (IN(6)) { p6_ln1_router(C, in, ws); } SEAM(6);

    if (IN(7)) { _Pragma("unroll") for (int rep = 0; rep < REPS(7); ++rep) {
        const int NBLK = build_moe_tables(C, ws);
        MoeOrder S{C.G, C.vcu, 2, NBLK, (const LAS int*)(lds + MISC_OFF + 512), (const LAS int*)(lds + MISC_OFF + 64), (const LAS int*)(lds + MISC_OFF + 320), (const int*)(ws + WS_LIST)};
        pg8::Gemm g{(const bf16_t*)(ws + WS_H1), (const bf16_t*)(ws + WS_WUP), T, NE * 1024, DM, nullptr, nullptr, 0};
        EpiSwiglu E{(bf16_t*)(ws + WS_HB), (const int*)(ws + WS_LIST), (const float*)(ws + WS_WGT), (int*)(ws + WS_POSE), (float*)(ws + WS_POSW)};
        pg8::gemm_phase<EpiSwiglu, MoeOrder, GEMM_ALIGN, GEMM_SP2, true>(lds, g, S, E);
        p7_convert_down(C, in, ws);
        REPSEAM(7, rep);
    } } SEAM(7);

    if (IN(8)) { _Pragma("unroll") for (int rep = 0; rep < REPS(8); ++rep) {
        const int NBLK = build_moe_tables(C, ws);
        MoeOrder S{C.G, C.vcu, 3, NBLK, (const LAS int*)(lds + MISC_OFF + 512), (const LAS int*)(lds + MISC_OFF + 64), (const LAS int*)(lds + MISC_OFF + 320), (const int*)(ws + WS_LIST)};
        pg8::Gemm g{(const bf16_t*)(ws + WS_HB), (const bf16_t*)(ws + WS_WDN), NBLK * 256, NE * DM, DFF, nullptr, nullptr, 0};
        EpiDown E{(const int*)(ws + WS_POSE), (const float*)(ws + WS_POSW), (bf16_t*)(ws + WS_YK)};
        pg8::gemm_phase<EpiDown, MoeOrder, GEMM_ALIGN, GEMM_SP2, false>(lds, g, S, E);
        REPSEAM(8, rep);
    } } SEAM(8);

    if (IN(9)) { _Pragma("unroll") for (int rep = 0; rep < REPS(9); ++rep) { p9_ln2(C, in, ws, args.out); REPSEAM(9, rep); } }
#undef IN
#undef SEAM
}

extern "C" void kernel_launch(void* const* d_in, const int* in_sizes, int n_in, void* d_out, int out_size, void* d_ws, size_t ws_size, hipStream_t stream) {
    static int grid = 0;
    if (grid == 0) {
        if (n_in != 33 || in_sizes[0] != T * DM || out_size != T * DM || ws_size < WS_END) { fprintf(stderr, "kernel_launch: unexpected shapes (n_in %d, in0 %d, out %d, ws %zu)\n", n_in, n_in > 0 ? in_sizes[0] : -1, out_size, ws_size); grid = -1; return; }
        int dev = 0, cus = 0, per_cu = 0;
        if (hipGetDevice(&dev) != hipSuccess || hipDeviceGetAttribute(&cus, hipDeviceAttributeMultiprocessorCount, dev) != hipSuccess) { grid = -1; return; }
        if (hipFuncSetAttribute((const void*)mk_fwd, hipFuncAttributeMaxDynamicSharedMemorySize, LDS_BYTES) != hipSuccess) { fprintf(stderr, "kernel_launch: hipFuncSetAttribute failed\n"); grid = -1; return; }
        if (hipOccupancyMaxActiveBlocksPerMultiprocessor(&per_cu, (const void*)mk_fwd, 512, LDS_BYTES) != hipSuccess || per_cu < 1) { fprintf(stderr, "kernel_launch: occupancy query reports %d blocks per CU\n", per_cu); }
        (void)hipGetLastError();
        grid = cus;
    }
    if (grid < 0) return;
    (void)hipMemsetAsync((char*)d_ws + WS_CTL, 0, CTL_ZERO_BYTES, stream);
    Args a{};
    for (int i = 0; i < 33; ++i) a.in[i] = (const float*)d_in[i];
    a.out = (float*)d_out; a.ws = (unsigned char*)d_ws;
#if MK_PER_PHASE
    for (int p = 0; p < NPHASE; ++p) { a.ph_lo = p; a.ph_hi = p + 1; hipLaunchKernelGGL(mk_fwd, dim3(grid), dim3(512), LDS_BYTES, stream, a); }
#else
    a.ph_lo = 0; a.ph_hi = NPHASE; hipLaunchKernelGGL(mk_fwd, dim3(grid), dim3(512), LDS_BYTES, stream, a);
#endif
}
```

```cpp
#include <hip/hip_runtime.h>
#include <stdint.h>
#include <stdio.h>

#ifndef ATT_PROBE
#define ATT_PROBE 0
#endif
#ifndef MK_PER_PHASE
#define MK_PER_PHASE 0
#endif

#define GAS __attribute__((address_space(1)))
#define LAS __attribute__((address_space(3)))
typedef unsigned short bf16_t;
typedef short bf16x8 __attribute__((ext_vector_type(8)));
typedef short s16x4 __attribute__((ext_vector_type(4)));
typedef float f32x2 __attribute__((ext_vector_type(2)));
typedef float f32x4 __attribute__((ext_vector_type(4)));
typedef float f32x16 __attribute__((ext_vector_type(16)));
typedef unsigned u32x2 __attribute__((ext_vector_type(2)));
typedef unsigned u32x4 __attribute__((ext_vector_type(4)));

constexpr int NB_ = 16, SEQ = 2048, DM = 2048, T = NB_ * SEQ, NMETA = 16;
constexpr int SSMW = 512, AW = 1024, INC = 7680, NGRP = 32, NST = 64;
constexpr int NE = 32, DFF = 512, CAP = T;
constexpr float LN_EPS = 1e-5f;
constexpr float ALPHA = 1.189207115002721f;
constexpr float QSCALE = 0.125f * 1.4426950408889634f;

__device__ __forceinline__ unsigned cvt_pk_bf16(float lo, float hi) { unsigned r; asm volatile("v_cvt_pk_bf16_f32 %0, %1, %2" : "=v"(r) : "v"(lo), "v"(hi)); return r; }
__device__ __forceinline__ float bf_lo(unsigned w) { return __uint_as_float(w << 16); }
__device__ __forceinline__ float bf_hi(unsigned w) { return __uint_as_float(w & 0xffff0000u); }
__device__ __forceinline__ float sigmoidf_(float x) { return 1.0f / (1.0f + __expf(-x)); }
__device__ __forceinline__ float wave_sum(float v) {
#pragma unroll
    for (int o = 1; o < 64; o <<= 1) v += __shfl_xor(v, o);
    return v;
}

namespace pg8 {
constexpr int BM = 256, BK = 64, HALF = 128, HTB = HALF * BK * 2, STAGE_BYTES = 8 * HTB, NXCD = 8, WGM = 4;
__host__ __device__ __forceinline__ int lds_byte(int r, int c) { const int st = (r >> 4) * 2 + (c >> 5), rr = r & 15, cc = c & 31, ob = rr * 64 + cc * 2; return st * 1024 + (ob ^ (((ob >> 9) & 1) << 5)); }
__host__ __device__ __forceinline__ void stage_rc(int b, int& R, int& C) { const int st = b / 1024, sb = b % 1024, swz = sb ^ (((sb >> 9) & 1) << 5); R = (st >> 1) * 16 + swz / 64; C = (st & 1) * 32 + (swz % 64) / 2; }
__host__ __device__ __forceinline__ int perm32(int rho) { const int n = rho >> 4, i = rho & 15; return 8 * (i >> 2) + 4 * n + (i & 3); }

struct Unit { int pm, pn, e, s0, cnt; };
struct Gemm { const bf16_t* A; const bf16_t* Bt; int M, N, K; const bf16_t* A2; const bf16_t* Bt2; int K2; };

struct StaticOrder {
    int nM, nN, nwg, G, c, wgm;
    __device__ void init(int M, int N, int G_, int c_, int wgm_ = WGM) { nM = M / BM; nN = N / BM; nwg = nM * nN; G = G_; c = c_; wgm = wgm_; }
    __device__ bool next(int i, Unit& u) const {
        const long L = (long)i * G + c; if (L >= nwg) return false;
        int wgid = (int)L; { const int q = nwg / NXCD, r = nwg % NXCD, xcd = wgid % NXCD, off = wgid / NXCD; wgid = (xcd < r ? xcd * (q + 1) : r * (q + 1) + (xcd - r) * q) + off; }
        const int nig = wgm * nN, gid = wgid / nig, fm = gid * wgm, gsz = (nM - fm) < wgm ? (nM - fm) : wgm;
        u.pm = fm + ((wgid % nig) % gsz); u.pn = (wgid % nig) / gsz; u.e = 0; u.s0 = 0; u.cnt = 0; return true;
    }
    __device__ __forceinline__ int arow(const Unit&, int) const { return 0; }
};

template <class Epi, class Sched, bool ALIGN_EPI, bool SP2, bool GATHER, bool DUAL = false>
__device__ __forceinline__ void gemm_phase(LAS unsigned char* lds, const Gemm g, const Sched& S, const Epi& E) {
    const int tid = threadIdx.x, wid = __builtin_amdgcn_readfirstlane(tid >> 6), lane = tid & 63, wr = wid >> 2, wc = wid & 3, fr = lane & 15, fq = lane >> 4;
    const int K = g.K, K2 = DUAL ? g.K2 : 0, nt1 = K / BK, nt = (K + K2) / BK;
    unsigned voffA[2], voffB[2], voffA2[2] = {0u, 0u}, voffB2[2] = {0u, 0u}; int stR[2], stC[2];
#pragma unroll
    for (int i = 0; i < 2; ++i) { int R, C; stage_rc(tid * 16 + i * 8192, R, C); const int Rb = Epi::PERM ? ((R & ~31) + perm32(R & 31)) : R;
        stR[i] = R; stC[i] = C; voffA[i] = (unsigned)(R * K + C) * 2u; voffB[i] = (unsigned)(Rb * K + C) * 2u;
        if constexpr (DUAL) { voffA2[i] = (unsigned)(R * K2 + C) * 2u; voffB2[i] = (unsigned)(Rb * K2 + C) * 2u; } }
    const size_t kstep = (size_t)(BK * 2);
    const size_t hstep = (size_t)HALF * K * 2;
    const size_t tstep = 2 * hstep;
    const size_t hstep2 = (size_t)HALF * K2 * 2, tstep2 = 2 * hstep2;
    const unsigned ldsw = (unsigned)wid * 1024u;
    const int aoff = lds_byte(wr * 64 + fr, fq * 8), boff = lds_byte(wc * 32 + fr, fq * 8);
#define PG8_SA(b, h) (((b) * 2 + (h)) * HTB)
#define PG8_SB(b, h) ((4 + (b) * 2 + (h)) * HTB)
#define PG8_STAGE(bufoff, gbase, voff) do { _Pragma("unroll") for (int _i = 0; _i < 2; ++_i) \
        __builtin_amdgcn_global_load_lds((const unsigned*)((const char*)(gbase) + (voff)[_i]), (LAS unsigned*)(lds + (bufoff) + ldsw + _i * 8192), 16, 0, 0); } while (0)
#define PG8_STAGE_A(bufoff, kbase, h, VO) do { if constexpr (GATHER) { PG8_STAGE(bufoff, kbase, VO[h]); } else { PG8_STAGE(bufoff, (kbase) + (h) * hstep, voffA); } } while (0)
#define PG8_STAGE_AX(bufoff, kbase, h, VO, HS, VA) do { if constexpr (GATHER) { PG8_STAGE(bufoff, kbase, VO[h]); } else { PG8_STAGE(bufoff, (kbase) + (h) * (HS), VA); } } while (0)
#define PG8_LDA(dst, b, h) do { _Pragma("unroll") for (int m = 0; m < 4; ++m) _Pragma("unroll") for (int k = 0; k < 2; ++k) dst[m][k] = *(const LAS bf16x8*)(lds + PG8_SA(b, h) + aoff + m * 2048 + k * 1024); } while (0)
#define PG8_LDB(dst, b, h) do { _Pragma("unroll") for (int n = 0; n < 2; ++n) _Pragma("unroll") for (int k = 0; k < 2; ++k) dst[n][k] = *(const LAS bf16x8*)(lds + PG8_SB(b, h) + boff + n * 2048 + k * 1024); } while (0)
#define PG8_MMA(ai, bj, At, Bt) do { __builtin_amdgcn_s_setprio(1); _Pragma("unroll") for (int m = 0; m < 4; ++m) _Pragma("unroll") for (int n = 0; n < 2; ++n) _Pragma("unroll") for (int k = 0; k < 2; ++k) \
        acc[ai][bj][m][n] = __builtin_amdgcn_mfma_f32_16x16x32_bf16(Bt[n][k], At[m][k], acc[ai][bj][m][n], 0, 0, 0); __builtin_amdgcn_s_setprio(0); } while (0)
#define PG8_WAIT_V(n) asm volatile("s_waitcnt vmcnt(" #n ")" ::: "memory")
#define PG8_WAIT_L(n) asm volatile("s_waitcnt lgkmcnt(" #n ")" ::: "memory")
#define PG8_BAR __builtin_amdgcn_s_barrier()
#define PG8_SCHED __builtin_amdgcn_sched_barrier(0)
#define PG8_GOFF(VO, U) do { _Pragma("unroll") for (int _h = 0; _h < 2; ++_h) _Pragma("unroll") for (int _i = 0; _i < 2; ++_i) \
        VO[_h][_i] = (unsigned)S.arow(U, _h * HALF + stR[_i]) * (unsigned)(K * 2) + (unsigned)(stC[_i] * 2); } while (0)
    Unit cur, nxt; int ui = 0;
    if (!S.next(0, cur)) return;
    f32x4 acc[2][2][4][2];
#pragma unroll
    for (int a = 0; a < 2; ++a)
#pragma unroll
        for (int b = 0; b < 2; ++b)
#pragma unroll
            for (int m = 0; m < 4; ++m)
#pragma unroll
                for (int n = 0; n < 2; ++n) acc[a][b][m][n] = (f32x4){0.f, 0.f, 0.f, 0.f};
    bf16x8 At[4][2], B0[2][2], B1[2][2];
    unsigned cvo[2][2] = {{0u, 0u}, {0u, 0u}}, nvo[2][2] = {{0u, 0u}, {0u, 0u}};
    const char* cA = GATHER ? (const char*)g.A : (const char*)g.A + (size_t)cur.pm * tstep; const char* cB = (const char*)g.Bt + (size_t)cur.pn * tstep;
    if constexpr (GATHER) { PG8_GOFF(cvo, cur); }
    if constexpr (SP2) {
        PG8_STAGE(PG8_SB(0, 0), cB, voffB); PG8_STAGE(PG8_SB(0, 1), cB + hstep, voffB); PG8_STAGE_A(PG8_SA(0, 0), cA, 0, cvo); PG8_STAGE_A(PG8_SA(0, 1), cA, 1, cvo);
        if (wr == 1) PG8_BAR;
        PG8_WAIT_V(2); PG8_BAR;
        PG8_STAGE(PG8_SB(1, 0), cB + kstep, voffB); PG8_STAGE_A(PG8_SA(1, 0), cA + kstep, 0, cvo); PG8_STAGE(PG8_SB(1, 1), cB + hstep + kstep, voffB);
        PG8_WAIT_V(6); PG8_BAR;
    } else {
        PG8_STAGE(PG8_SB(0, 0), cB, voffB); PG8_STAGE_A(PG8_SA(0, 0), cA, 0, cvo); PG8_STAGE(PG8_SB(0, 1), cB + hstep, voffB); PG8_STAGE_A(PG8_SA(0, 1), cA, 1, cvo);
        if (wr == 1) PG8_BAR;
        PG8_WAIT_V(4); PG8_BAR;
        PG8_STAGE(PG8_SB(1, 0), cB + kstep, voffB); PG8_STAGE_A(PG8_SA(1, 0), cA + kstep, 0, cvo); PG8_STAGE(PG8_SB(1, 1), cB + hstep + kstep, voffB);
        PG8_WAIT_V(6); PG8_BAR;
    }
    for (;;) {
        const bool has_next = S.next(ui + 1, nxt);
        const char* nA = GATHER ? cA : (has_next ? (const char*)g.A + (size_t)nxt.pm * tstep : cA); const char* nB = has_next ? (const char*)g.Bt + (size_t)nxt.pn * tstep : cB;
        if constexpr (GATHER) { if (has_next) { PG8_GOFF(nvo, nxt); } else {
#pragma unroll
            for (int h = 0; h < 2; ++h)
#pragma unroll
                for (int i = 0; i < 2; ++i) nvo[h][i] = cvo[h][i]; } }
        const char* cA2 = DUAL ? (const char*)g.A2 + (size_t)cur.pm * tstep2 : cA; const char* cB2 = DUAL ? (const char*)g.Bt2 + (size_t)cur.pn * tstep2 : cB;
        for (int t = 0; t < nt; t += 2) {
            const bool last = (t == nt - 2);
            const bool s1 = DUAL && (t + 1 >= nt1), s2 = DUAL && !last && (t + 2 >= nt1);
            const char* a1 = s1 ? cA2 + (size_t)(t + 1 - nt1) * kstep : cA + (size_t)(t + 1) * kstep;
            const char* a2 = last ? nA : (s2 ? cA2 + (size_t)(t + 2 - nt1) * kstep : cA + (size_t)(t + 2) * kstep);
            const char* b2 = last ? nB : (s2 ? cB2 + (size_t)(t + 2 - nt1) * kstep : cB + (size_t)(t + 2) * kstep);
            const char* a3 = a2 + kstep; const char* b3 = b2 + kstep;
            const size_t hs1 = s1 ? hstep2 : hstep, hs2 = s2 ? hstep2 : hstep;
            unsigned vA1[2], vA2[2], vB2[2];
#pragma unroll
            for (int i = 0; i < 2; ++i) { vA1[i] = s1 ? voffA2[i] : voffA[i]; vA2[i] = s2 ? voffA2[i] : voffA[i]; vB2[i] = s2 ? voffB2[i] : voffB[i]; }
            unsigned svo[2][2];
#pragma unroll
            for (int h = 0; h < 2; ++h)
#pragma unroll
                for (int i = 0; i < 2; ++i) svo[h][i] = last ? nvo[h][i] : cvo[h][i];
            if constexpr (SP2) {
            PG8_LDB(B0, 0, 0); PG8_LDB(B1, 0, 1); PG8_SCHED; PG8_LDA(At, 0, 0); PG8_STAGE_AX(PG8_SA(1, 1), a1, 1, cvo, hs1, vA1);
            PG8_WAIT_V(8); PG8_WAIT_L(0); PG8_BAR; PG8_MMA(0, 0, At, B0); PG8_MMA(0, 1, At, B1); PG8_BAR; PG8_SCHED;
            PG8_LDA(At, 0, 1); PG8_STAGE(PG8_SB(0, 0), b2, vB2); PG8_STAGE(PG8_SB(0, 1), b2 + hs2, vB2); PG8_STAGE_AX(PG8_SA(0, 0), a2, 0, svo, hs2, vA2);
            PG8_WAIT_V(8); PG8_WAIT_L(0); PG8_BAR; PG8_MMA(1, 0, At, B0); PG8_MMA(1, 1, At, B1); PG8_BAR; PG8_SCHED;
            PG8_LDB(B0, 1, 0); PG8_LDB(B1, 1, 1); PG8_SCHED; PG8_LDA(At, 1, 0); PG8_STAGE_AX(PG8_SA(0, 1), a2, 1, svo, hs2, vA2);
            PG8_WAIT_V(8); PG8_WAIT_L(0); PG8_BAR; PG8_MMA(0, 0, At, B0); PG8_MMA(0, 1, At, B1); PG8_BAR; PG8_SCHED;
            PG8_LDA(At, 1, 1); PG8_STAGE(PG8_SB(1, 0), b3, vB2); PG8_STAGE(PG8_SB(1, 1), b3 + hs2, vB2); PG8_STAGE_AX(PG8_SA(1, 0), a3, 0, svo, hs2, vA2);
            PG8_WAIT_V(8); PG8_WAIT_L(0); PG8_BAR; PG8_MMA(1, 0, At, B0); PG8_MMA(1, 1, At, B1); PG8_BAR; PG8_SCHED;
            } else {
            PG8_LDB(B0, 0, 0); PG8_SCHED; PG8_LDA(At, 0, 0); PG8_STAGE_AX(PG8_SA(1, 1), a1, 1, cvo, hs1, vA1);
            PG8_WAIT_L(8); PG8_BAR; PG8_WAIT_L(0); PG8_MMA(0, 0, At, B0); PG8_BAR; PG8_SCHED;
            PG8_LDB(B1, 0, 1); PG8_STAGE(PG8_SB(0, 0), b2, vB2);
            PG8_BAR; PG8_WAIT_L(0); PG8_MMA(0, 1, At, B1); PG8_BAR;
            PG8_LDA(At, 0, 1); PG8_STAGE_AX(PG8_SA(0, 0), a2, 0, svo, hs2, vA2);
            PG8_BAR; PG8_WAIT_L(0); PG8_MMA(1, 0, At, B0); PG8_BAR; PG8_SCHED;
            PG8_STAGE(PG8_SB(0, 1), b2 + hs2, vB2);
            PG8_WAIT_V(6); PG8_BAR; PG8_MMA(1, 1, At, B1); PG8_BAR;
            PG8_LDB(B0, 1, 0); PG8_SCHED; PG8_LDA(At, 1, 0); PG8_STAGE_AX(PG8_SA(0, 1), a2, 1, svo, hs2, vA2);
            PG8_WAIT_L(8); PG8_BAR; PG8_WAIT_L(0); PG8_MMA(0, 0, At, B0); PG8_BAR; PG8_SCHED;
            PG8_LDB(B1, 1, 1); PG8_STAGE(PG8_SB(1, 0), b3, vB2);
            PG8_BAR; PG8_WAIT_L(0); PG8_MMA(0, 1, At, B1); PG8_BAR;
            PG8_LDA(At, 1, 1); PG8_STAGE_AX(PG8_SA(1, 0), a3, 0, svo, hs2, vA2);
            PG8_BAR; PG8_WAIT_L(0); PG8_MMA(1, 0, At, B0); PG8_BAR; PG8_SCHED;
            PG8_STAGE(PG8_SB(1, 1), b3 + hs2, vB2);
            PG8_WAIT_V(6); PG8_BAR; PG8_MMA(1, 1, At, B1); PG8_BAR;
            }
            if constexpr (DUAL) { if (t + 2 == nt1) E.mid(acc, cur, wr, wc, fr, fq); }
        }
        if constexpr (ALIGN_EPI) { if (wr == 0) PG8_BAR; }
        E(acc, cur, wr, wc, fr, fq);
        if (!has_next) break;
#pragma unroll
        for (int a = 0; a < 2; ++a)
#pragma unroll
            for (int b = 0; b < 2; ++b)
#pragma unroll
                for (int m = 0; m < 4; ++m)
#pragma unroll
                    for (int n = 0; n < 2; ++n) acc[a][b][m][n] = (f32x4){0.f, 0.f, 0.f, 0.f};
        cur = nxt; cA = nA; cB = nB; ++ui;
#pragma unroll
        for (int h = 0; h < 2; ++h)
#pragma unroll
            for (int i = 0; i < 2; ++i) cvo[h][i] = nvo[h][i];
        if constexpr (ALIGN_EPI) { if (wr == 1) PG8_BAR; }
    }
    PG8_WAIT_V(0);
    if constexpr (!ALIGN_EPI) { if (wr == 0) PG8_BAR; }
    PG8_BAR;
#undef PG8_SA
#undef PG8_SB
#undef PG8_STAGE
#undef PG8_STAGE_A
#undef PG8_STAGE_AX
#undef PG8_LDA
#undef PG8_LDB
#undef PG8_MMA
#undef PG8_WAIT_V
#undef PG8_WAIT_L
#undef PG8_BAR
#undef PG8_SCHED
#undef PG8_GOFF
}
}

constexpr size_t MiB = 1u << 20;
constexpr size_t WS_CTL = 0, CTL_ZERO_BYTES = 1 * MiB;
constexpr size_t WS_HMETA = 1 * MiB;
constexpr size_t WS_UMETA = WS_HMETA + 128 * 1024;
constexpr size_t WS_KMETA = WS_HMETA + 256 * 1024;
constexpr size_t WS_VMETA = WS_HMETA + 384 * 1024;
constexpr size_t WS_SSMAB = WS_HMETA + 512 * 1024;
constexpr size_t WS_SSMBB = WS_HMETA + 576 * 1024;
constexpr size_t WS_WRT = 2 * MiB;
constexpr size_t WS_WIN = 3 * MiB;
constexpr size_t WS_WGLU = 33 * MiB;
constexpr size_t WS_WBS = 34 * MiB;
constexpr size_t WS_WBA = 36 * MiB;
constexpr size_t WS_WO = 40 * MiB;
constexpr size_t WS_WUP = 48 * MiB;
constexpr size_t WS_WDN = 176 * MiB;
constexpr size_t WS_HBF = 240 * MiB;
constexpr size_t WS_U = 368 * MiB;
constexpr size_t WS_Q = 400 * MiB;
constexpr size_t WS_K = 464 * MiB;
constexpr size_t WS_V = 528 * MiB;
constexpr size_t WS_SGS = 592 * MiB;
constexpr size_t WS_SGA = 720 * MiB;
constexpr size_t WS_YPRE = 848 * MiB;
constexpr size_t WS_YSSM = 880 * MiB;
constexpr size_t WS_YATT = 912 * MiB;
constexpr size_t WS_END = 976 * MiB;
constexpr size_t WS_Z = 368 * MiB;
constexpr size_t WS_H1 = 624 * MiB;
constexpr size_t WS_HB = 752 * MiB;
constexpr size_t WS_YK = 368 * MiB;
constexpr size_t WS_LIST = 848 * MiB;
constexpr size_t WS_WGT = 852 * MiB;
constexpr size_t WS_POSE = 853 * MiB;
constexpr size_t WS_POSW = 854 * MiB;
constexpr int CW_ECNT = 64;
constexpr int CW_CONV = 192;
constexpr int CW_BAR = 4096;

constexpr int RING_BYTES = 131072;
constexpr int MISC_OFF = RING_BYTES;
constexpr int LDS_BYTES = 139264;

#define XB_TMO      128
#define XB_XCNT(j)  (256  + 64 * (j))
#define XB_XSUB(j)  (1280 + 64 * (j))
#define XB_XGEN(j)  (2304 + 64 * (j))
#define XB_TOP      3328
#define XB_TOPGEN   3392
#define XCD_BAR_WORDS 3456
#define XB_SPIN_CAP (1u << 18)
__device__ __forceinline__ unsigned xb_ld(unsigned* p)              { return __hip_atomic_load(p, __ATOMIC_RELAXED, __HIP_MEMORY_SCOPE_AGENT); }
__device__ __forceinline__ unsigned xb_add(unsigned* p, unsigned v) { return __hip_atomic_fetch_add(p, v, __ATOMIC_RELAXED, __HIP_MEMORY_SCOPE_AGENT); }
__device__ __forceinline__ unsigned xb_xcc_id() { return (unsigned)__builtin_amdgcn_s_getreg((3 << 11) | 20) & 0xFu; }
#define XB_SPIN(cond, bar) do { unsigned _sp = 0; while (cond) { __builtin_amdgcn_s_sleep(1); \
    if ((++_sp & 255u) == 0u) { if (xb_ld(&(bar)[XB_TMO])) break; if (_sp > XB_SPIN_CAP) { atomicAdd(&(bar)[XB_TMO], 1u); break; } } } } while (0)
struct XcdBarrier { unsigned* bar; unsigned x; volatile LAS unsigned* st; };
__device__ __forceinline__ XcdBarrier xcd_barrier_post(unsigned* bar, volatile LAS unsigned* st) {
    XcdBarrier b; b.bar = bar; b.x = xb_xcc_id(); b.st = st;
    if (threadIdx.x == 0) (void)xb_add(&bar[XB_XCNT(b.x)], 1u);
    return b;
}
__device__ __forceinline__ void xcd_barrier_complete(unsigned* bar, unsigned x, unsigned& nloc, unsigned& nx) {
    const unsigned G = gridDim.x * gridDim.y * gridDim.z;
    unsigned sum, cnt, mine, sp = 0u;
    for (;;) {
        sum = 0u; cnt = 0u; mine = 0u;
#pragma unroll
        for (unsigned j = 0; j < 16; ++j) { const unsigned c = xb_ld(&bar[XB_XCNT(j)]); sum += c; cnt += (c > 0u) ? 1u : 0u; mine = (j == x) ? c : mine; }
        if (sum == G) break;
        __builtin_amdgcn_s_sleep(1);
        if ((++sp & 255u) == 0u) { if (xb_ld(&bar[XB_TMO])) break; if (sp > XB_SPIN_CAP) { atomicAdd(&bar[XB_TMO], 1u); break; } }
    }
    nloc = mine > 0u ? mine : 1u; nx = cnt > 0u ? cnt : 1u;
}
__device__ __forceinline__ void xcd_barrier(const XcdBarrier& b) {
    asm volatile("s_waitcnt vmcnt(0)" ::: "memory");
    __syncthreads();
    if (threadIdx.x == 0) {
        unsigned* bar = b.bar;
        __builtin_amdgcn_s_waitcnt(0);
        unsigned nloc = b.st[0], nx = b.st[1];
        if (nloc == 0u) { xcd_barrier_complete(bar, b.x, nloc, nx); b.st[0] = nloc; b.st[1] = nx; }
        const unsigned old = xb_add(&bar[XB_XSUB(b.x)], 1u);
        const unsigned gen = old / nloc;
        if (old + 1u == (gen + 1u) * nloc) {
            __builtin_amdgcn_fence(__ATOMIC_RELEASE, "agent");
            asm volatile("s_waitcnt vmcnt(0)" ::: "memory");
            const unsigned og = xb_add(&bar[XB_TOP], 1u);
            const unsigned tg = og / nx;
            if (og + 1u == (tg + 1u) * nx) xb_add(&bar[XB_TOPGEN], 1u);
            else XB_SPIN(xb_ld(&bar[XB_TOPGEN]) == tg, bar);
            __builtin_amdgcn_fence(__ATOMIC_ACQUIRE, "agent");
            xb_add(&bar[XB_XGEN(b.x)], 1u);
            asm volatile("s_waitcnt vmcnt(0)" ::: "memory");
        } else {
            XB_SPIN(xb_ld(&bar[XB_XGEN(b.x)]) == gen, bar);
            __builtin_amdgcn_fence(__ATOMIC_ACQUIRE, "agent");
            asm volatile("s_waitcnt vmcnt(0)" ::: "memory");
        }
    }
    __syncthreads();
}

using pg8::Unit;
__device__ __forceinline__ u32x4 pack8(const f32x4 v0, const f32x4 v1) { u32x4 w; w.x = cvt_pk_bf16(v0[0], v0[1]); w.y = cvt_pk_bf16(v0[2], v0[3]); w.z = cvt_pk_bf16(v1[0], v1[1]); w.w = cvt_pk_bf16(v1[2], v1[3]); return w; }
__device__ __forceinline__ void unpack8(const u32x4 w, f32x4& v0, f32x4& v1) { v0 = (f32x4){bf_lo(w.x), bf_hi(w.x), bf_lo(w.y), bf_hi(w.y)}; v1 = (f32x4){bf_lo(w.z), bf_hi(w.z), bf_lo(w.w), bf_hi(w.w)}; }

struct EpiProj {
    static constexpr bool PERM = true;
    bf16_t *U, *Q, *K, *V, *RHO, *SGA;
    __device__ __forceinline__ void operator()(const f32x4 (&acc)[2][2][4][2], const Unit& u, int wr, int wc, int fr, int fq) const {
        const int pn = u.pn;
        if (pn >= 14) {
            const int row0 = u.pm * 256 + wr * 64 + fr, col0 = (pn - 14) * 128 + wc * 32 + 8 * fq;
#pragma unroll
            for (int ai = 0; ai < 2; ++ai)
#pragma unroll
                for (int m = 0; m < 4; ++m) { const size_t off = (size_t)(row0 + ai * 128 + m * 16) * DM + col0; f32x4 r0, r1, a0, a1;
#pragma unroll
                    for (int j = 0; j < 4; ++j) { const float es0 = __expf(-acc[ai][0][m][0][j]), es1 = __expf(-acc[ai][0][m][1][j]), ea0 = __expf(-acc[ai][1][m][0][j]), ea1 = __expf(-acc[ai][1][m][1][j]);
                        a0[j] = __builtin_amdgcn_rcpf(1.f + ea0); a1[j] = __builtin_amdgcn_rcpf(1.f + ea1);
                        r0[j] = (1.f + ea0) * __builtin_amdgcn_rcpf(1.f + es0); r1[j] = (1.f + ea1) * __builtin_amdgcn_rcpf(1.f + es1); }
                    *(u32x4*)(RHO + off) = pack8(r0, r1); *(u32x4*)(SGA + off) = pack8(a0, a1); }
            return;
        }
        bf16_t* base; int ldc, ct, mode;
        if (pn < 2) { base = U; ldc = 512; ct = pn; mode = 0; }
        else if (pn < 6) { base = Q; ldc = 1024; ct = pn - 2; mode = 1; }
        else if (pn < 10) { base = K; ldc = 1024; ct = pn - 6; mode = 0; }
        else { base = V; ldc = 1024; ct = pn - 10; mode = 0; }
        const int row0 = u.pm * 256 + wr * 64 + fr, col0 = ct * 256 + wc * 32 + 8 * fq;
#pragma unroll
        for (int ai = 0; ai < 2; ++ai)
#pragma unroll
            for (int m = 0; m < 4; ++m) { bf16_t* rowp = base + (size_t)(row0 + ai * 128 + m * 16) * ldc + col0;
#pragma unroll
                for (int bj = 0; bj < 2; ++bj) { f32x4 v0 = acc[ai][bj][m][0], v1 = acc[ai][bj][m][1];
                    if (mode == 1) { v0 = v0 * QSCALE; v1 = v1 * QSCALE; }
                    *(u32x4*)(rowp + bj * 128) = pack8(v0, v1); } }
    }
};
struct EpiGlu {
    static constexpr bool PERM = true;
    const bf16_t* YPRE; bf16_t* YSSM;
    __device__ __forceinline__ void operator()(const f32x4 (&acc)[2][2][4][2], const Unit& u, int wr, int wc, int fr, int fq) const {
        const int row0 = u.pm * 256 + wr * 64 + fr, col0 = u.pn * 256 + wc * 32 + 8 * fq;
#pragma unroll
        for (int ai = 0; ai < 2; ++ai)
#pragma unroll
            for (int m = 0; m < 4; ++m) { const size_t off = (size_t)(row0 + ai * 128 + m * 16) * SSMW + col0;
#pragma unroll
                for (int bj = 0; bj < 2; ++bj) { const u32x4 yw = *(const u32x4*)(YPRE + off + bj * 128); f32x4 y0, y1; unpack8(yw, y0, y1);
                    f32x4 v0 = acc[ai][bj][m][0], v1 = acc[ai][bj][m][1];
#pragma unroll
                    for (int j = 0; j < 4; ++j) { v0[j] = y0[j] * sigmoidf_(v0[j]); v1[j] = y1[j] * sigmoidf_(v1[j]); }
                    *(u32x4*)(YSSM + off + bj * 128) = pack8(v0, v1); } }
    }
};
template <int SECOND> struct EpiMerge {
    static constexpr bool PERM = true;
    const bf16_t* SG; bf16_t* MG;
    __device__ __forceinline__ void operator()(const f32x4 (&acc)[2][2][4][2], const Unit& u, int wr, int wc, int fr, int fq) const {
        const int row0 = u.pm * 256 + wr * 64 + fr, col0 = u.pn * 256 + wc * 32 + 8 * fq;
#pragma unroll
        for (int ai = 0; ai < 2; ++ai)
#pragma unroll
            for (int m = 0; m < 4; ++m) { const size_t off = (size_t)(row0 + ai * 128 + m * 16) * DM + col0;
#pragma unroll
                for (int bj = 0; bj < 2; ++bj) { const u32x4 gw = *(const u32x4*)(SG + off + bj * 128); f32x4 g0, g1; unpack8(gw, g0, g1);
                    f32x4 v0 = acc[ai][bj][m][0] * g0, v1 = acc[ai][bj][m][1] * g1;
                    if (SECOND) { const u32x4 pw = *(const u32x4*)(MG + off + bj * 128); f32x4 p0, p1; unpack8(pw, p0, p1); v0 = v0 + p0; v1 = v1 + p1; }
                    *(u32x4*)(MG + off + bj * 128) = pack8(v0, v1); } }
    }
};
struct EpiMergeF {
    static constexpr bool PERM = true;
    const bf16_t* SGS; const bf16_t* SGA; bf16_t* MG;
    __device__ __forceinline__ void mid(f32x4 (&acc)[2][2][4][2], const Unit& u, int wr, int wc, int fr, int fq) const {
        asm volatile("" : "+v"(fr), "+v"(fq));
        const int row0 = u.pm * 256 + wr * 64 + fr, col0 = u.pn * 256 + wc * 32 + 8 * fq;
#pragma unroll
        for (int ai = 0; ai < 2; ++ai)
#pragma unroll
            for (int m = 0; m < 4; ++m) { const size_t off = (size_t)(row0 + ai * 128 + m * 16) * DM + col0;
#pragma unroll
                for (int bj = 0; bj < 2; ++bj) { const u32x4 sw = *(const u32x4*)(SGS + off + bj * 128);
                    f32x4 s0, s1; unpack8(sw, s0, s1);
                    acc[ai][bj][m][0] = acc[ai][bj][m][0] * s0; acc[ai][bj][m][1] = acc[ai][bj][m][1] * s1; }
                asm volatile("" ::: "memory"); }
    }
    __device__ __forceinline__ void operator()(const f32x4 (&acc)[2][2][4][2], const Unit& u, int wr, int wc, int fr, int fq) const {
        const int row0 = u.pm * 256 + wr * 64 + fr, col0 = u.pn * 256 + wc * 32 + 8 * fq;
#pragma unroll
        for (int ai = 0; ai < 2; ++ai)
#pragma unroll
            for (int m = 0; m < 4; ++m) { const size_t off = (size_t)(row0 + ai * 128 + m * 16) * DM + col0;
#pragma unroll
                for (int bj = 0; bj < 2; ++bj) { const u32x4 gw = *(const u32x4*)(SGA + off + bj * 128); f32x4 g0, g1; unpack8(gw, g0, g1);
                    *(u32x4*)(MG + off + bj * 128) = pack8(acc[ai][bj][m][0] * g0, acc[ai][bj][m][1] * g1); } }
    }
};
struct EpiZ {
    static constexpr bool PERM = true;
    const bf16_t* HBF; bf16_t* Z;
    __device__ __forceinline__ void operator()(const f32x4 (&acc)[2][2][4][2], const Unit& u, int wr, int wc, int fr, int fq) const {
        const int row0 = u.pm * 256 + wr * 64 + fr, col0 = u.pn * 256 + wc * 32 + 8 * fq;
#pragma unroll
        for (int ai = 0; ai < 2; ++ai)
#pragma unroll
            for (int m = 0; m < 4; ++m) { const size_t off = (size_t)(row0 + ai * 128 + m * 16) * DM + col0;
#pragma unroll
                for (int bj = 0; bj < 2; ++bj) { const u32x4 hw = *(const u32x4*)(HBF + off + bj * 128); f32x4 h0, h1; unpack8(hw, h0, h1);
                    *(u32x4*)(Z + off + bj * 128) = pack8(acc[ai][bj][m][0] + h0 * ALPHA, acc[ai][bj][m][1] + h1 * ALPHA); } }
    }
};
struct EpiSwiglu {
    static constexpr bool PERM = true;
    bf16_t* HB; const int* LIST; const float* WGT; int* POSE; float* POSW;
    __device__ __forceinline__ void operator()(const f32x4 (&acc)[2][2][4][2], const Unit& u, int wr, int wc, int fr, int fq) const {
        const int row0 = u.pm * 256 + wr * 64 + fr, col0 = (u.pn & 3) * 128 + wc * 32 + 8 * fq;
#pragma unroll
        for (int ai = 0; ai < 2; ++ai)
#pragma unroll
            for (int m = 0; m < 4; ++m) { f32x4 v0, v1;
#pragma unroll
                for (int j = 0; j < 4; ++j) { const float g0 = acc[ai][0][m][0][j], g1 = acc[ai][0][m][1][j];
                    v0[j] = g0 * sigmoidf_(g0) * acc[ai][1][m][0][j]; v1[j] = g1 * sigmoidf_(g1) * acc[ai][1][m][1][j]; }
                *(u32x4*)(HB + (size_t)(row0 + ai * 128 + m * 16) * DFF + col0) = pack8(v0, v1); }
        if ((u.pn & 3) == 0 && wc == 0 && fq == 0) {
#pragma unroll
            for (int ai = 0; ai < 2; ++ai)
#pragma unroll
                for (int m = 0; m < 4; ++m) { const int r = wr * 64 + fr + ai * 128 + m * 16, slot = u.s0 + r; int entry = -1; float w = 0.f;
                    if (slot < u.cnt) { entry = LIST[(size_t)u.e * CAP + slot]; w = WGT[entry]; }
                    POSE[u.pm * 256 + r] = entry; POSW[u.pm * 256 + r] = w; }
        }
    }
};
struct EpiDown {
    static constexpr bool PERM = true;
    const int* POSE; const float* POSW; bf16_t* YK;
    __device__ __forceinline__ void operator()(const f32x4 (&acc)[2][2][4][2], const Unit& u, int wr, int wc, int fr, int fq) const {
        const int r0 = u.pm * 256 + wr * 64 + fr, col0 = (u.pn & 7) * 256 + wc * 32 + 8 * fq;
        int en[2][4]; float ww[2][4];
#pragma unroll
        for (int ai = 0; ai < 2; ++ai)
#pragma unroll
            for (int m = 0; m < 4; ++m) { en[ai][m] = POSE[r0 + ai * 128 + m * 16]; ww[ai][m] = POSW[r0 + ai * 128 + m * 16]; }
#pragma unroll
        for (int ai = 0; ai < 2; ++ai)
#pragma unroll
            for (int m = 0; m < 4; ++m) {
                if (en[ai][m] >= 0) { const float w = ww[ai][m]; bf16_t* rowp = YK + (size_t)en[ai][m] * DM + col0;
#pragma unroll
                    for (int bj = 0; bj < 2; ++bj) *(u32x4*)(rowp + bj * 128) = pack8(acc[ai][bj][m][0] * w, acc[ai][bj][m][1] * w); } }
    }
};
struct MoeOrder {
    int G, c, shift, NB; const LAS int* blkexp; const LAS int* blkstart; const LAS int* cntE; const int* LIST;
    __device__ __forceinline__ bool next(int i, Unit& u) const {
        const long L = (long)i * G + c; if (L >= ((long)NB << shift)) return false;
        const int blk = (int)(L >> shift), tile = (int)(L & ((1 << shift) - 1)), e = blkexp[blk];
        u.pm = blk; u.pn = (e << shift) + tile; u.e = e; u.s0 = (blk - blkstart[e]) * 256; u.cnt = cntE[e]; return true;
    }
    __device__ __forceinline__ int arow(const Unit& u, int r) const { const int slot = u.s0 + r; const int entry = slot < u.cnt ? LIST[(size_t)u.e * CAP + slot] : 0; return entry >> 1; }
};

struct Ctx { LAS unsigned char* lds; int tid, lane, wave, vcu, G; };

__device__ __forceinline__ void transpose_item(const float* W, int K, int N, bf16_t* WT, int kb, int nb, int dst_row0, LAS float* scr, int lane) {
    const int k0 = 64 * kb, n0 = 32 * nb;
    float tv[32];
#pragma unroll
    for (int i = 0; i < 32; ++i) tv[i] = W[(size_t)(k0 + 2 * i + (lane >> 5)) * N + n0 + (lane & 31)];
#pragma unroll
    for (int i = 0; i < 32; ++i) scr[(2 * i + (lane >> 5)) * 33 + (lane & 31)] = tv[i];
    asm volatile("s_waitcnt lgkmcnt(0)" ::: "memory");
    const int c = lane & 7;
#pragma unroll
    for (int j = 0; j < 4; ++j) { const int n = (lane >> 3) + 8 * j; const LAS float* s = scr + (8 * c) * 33 + n;
        u32x4 o; o.x = cvt_pk_bf16(s[0 * 33], s[1 * 33]); o.y = cvt_pk_bf16(s[2 * 33], s[3 * 33]); o.z = cvt_pk_bf16(s[4 * 33], s[5 * 33]); o.w = cvt_pk_bf16(s[6 * 33], s[7 * 33]);
        *(u32x4*)(WT + (size_t)(dst_row0 + n) * K + k0 + 8 * c) = o; }
    asm volatile("s_waitcnt lgkmcnt(0)" ::: "memory");
}
__device__ __forceinline__ void ln_stats(f32x4 (&v)[8], float& mean, float& rstd) {
    float s = 0.f;
#pragma unroll
    for (int j = 0; j < 8; ++j) s += (v[j].x + v[j].y) + (v[j].z + v[j].w);
    mean = wave_sum(s) * (1.f / DM); float s2 = 0.f;
#pragma unroll
    for (int j = 0; j < 8; ++j) { const f32x4 d = v[j] - mean; s2 += (d.x * d.x + d.y * d.y) + (d.z * d.z + d.w * d.w); }
    rstd = 1.f / sqrtf(wave_sum(s2) * (1.f / DM) + LN_EPS);
}

__device__ __forceinline__ void p0_prologue(const Ctx& C, const float* const* in, unsigned char* ws) {
    LAS float* scr = (LAS float*)(C.lds + C.wave * 16384);
    const int gw = C.vcu * 8 + C.wave, NGW = C.G * 8;
    bf16_t* WinT = (bf16_t*)(ws + WS_WIN); bf16_t* WgluT = (bf16_t*)(ws + WS_WGLU); bf16_t* WbsT = (bf16_t*)(ws + WS_WBS); bf16_t* WbaT = (bf16_t*)(ws + WS_WBA);
    bf16_t* WoT = (bf16_t*)(ws + WS_WO); bf16_t* WupT = (bf16_t*)(ws + WS_WUP);
    constexpr int I_WIN = (DM / 64) * (INC / 32), I_GLU = (SSMW / 64) * (SSMW / 32), I_BS = (SSMW / 64) * (DM / 32), I_BA = (AW / 64) * (DM / 32), I_WO = (DM / 64) * (DM / 32);
    constexpr int I_EXP = NE * 512;
    constexpr int NITEMS = I_WIN + I_GLU + I_BS + I_BA + I_WO + 2 * I_EXP;
    for (int it = gw; it < NITEMS; it += NGW) {
        int r = it;
        if (r < I_WIN) { const int nblk = INC / 32, nb = r % nblk, n0 = 32 * nb;
            const int drow = n0 < 3584 ? n0 : (n0 < 5632 ? 3584 + ((n0 - 3584) >> 7) * 256 + ((n0 - 3584) & 127) : 3584 + ((n0 - 5632) >> 7) * 256 + 128 + ((n0 - 5632) & 127));
            transpose_item(in[4], DM, INC, WinT, r / nblk, nb, drow, scr, C.lane); continue; } r -= I_WIN;
        if (r < I_GLU) { const int nblk = SSMW / 32; transpose_item(in[13], SSMW, SSMW, WgluT, r / nblk, r % nblk, 32 * (r % nblk), scr, C.lane); continue; } r -= I_GLU;
        if (r < I_BS) { const int nblk = DM / 32; transpose_item(in[19], SSMW, DM, WbsT, r / nblk, r % nblk, 32 * (r % nblk), scr, C.lane); continue; } r -= I_BS;
        if (r < I_BA) { const int nblk = DM / 32; transpose_item(in[20], AW, DM, WbaT, r / nblk, r % nblk, 32 * (r % nblk), scr, C.lane); continue; } r -= I_BA;
        if (r < I_WO) { const int nblk = DM / 32; transpose_item(in[21], DM, DM, WoT, r / nblk, r % nblk, 32 * (r % nblk), scr, C.lane); continue; } r -= I_WO;
        if (r < 2 * I_EXP) { const int up = r >= I_EXP ? 1 : 0; r -= up * I_EXP; const int e = r >> 9, rr = r & 511, kb = rr >> 4, nb = rr & 15, n0 = 32 * nb;
            transpose_item(in[28 + up] + (size_t)e * DM * DFF, DM, DFF, WupT, kb, nb, e * 1024 + (n0 >> 7) * 256 + up * 128 + (n0 & 127), scr, C.lane); continue; }
    }
    const int gt = C.vcu * 512 + C.tid, NGT = C.G * 512;
    { float* WrT = (float*)(ws + WS_WRT);
      for (int i = gt; i < 36 * DM; i += NGT) { const int n = i / DM, k = i % DM; WrT[i] = n < 4 ? in[24][k * 4 + n] : in[26][k * 32 + (n - 4)]; } }
    { u32x4* kz = (u32x4*)(ws + WS_KMETA + 16 * 1024 * 2); u32x4* vz = (u32x4*)(ws + WS_VMETA + 16 * 1024 * 2);
      for (int i = gt; i < 48 * 1024 * 2 / 16; i += NGT) { kz[i] = (u32x4){0u, 0u, 0u, 0u}; vz[i] = (u32x4){0u, 0u, 0u, 0u}; } }
    { float* AB = (float*)(ws + WS_SSMAB); float* BB = (float*)(ws + WS_SSMBB);
      for (int i = gt; i < NGRP * NST; i += NGT) { const int g = i >> 6;
        const double lre = fmin((double)in[5][i], -1e-4), lim = (double)in[6][i], dt = exp((double)in[7][g]);
        const double mag = exp(lre * dt), abr = mag * cos(lim * dt), abi = mag * sin(lim * dt), den = lre * lre + lim * lim, nr = abr - 1.0, ni = abi;
        const double zr = (nr * lre + ni * lim) / den, zi = (ni * lre - nr * lim) / den;
        AB[i] = (float)abr; AB[NGRP * NST + i] = (float)abi;
#pragma unroll 4
        for (int c = 0; c < 16; ++c) { const double br = (double)in[8][i * 16 + c], bi = (double)in[9][i * 16 + c];
            BB[i * 16 + c] = (float)(zr * br - zi * bi); BB[NGRP * NST * 16 + i * 16 + c] = (float)(zr * bi + zi * br); } } }
    const float* lg = in[2]; const float* lb = in[3];
    bf16_t* HBF = (bf16_t*)(ws + WS_HBF);
    for (int m = gw; m < T + NMETA; m += 2 * NGW) {
        const int m2 = (m + NGW < T + NMETA) ? m + NGW : m;
        const float* xa = m >= T ? in[1] + (size_t)(m - T) * DM : in[0] + (size_t)m * DM; const float* xb = m2 >= T ? in[1] + (size_t)(m2 - T) * DM : in[0] + (size_t)m2 * DM;
        f32x4 va[8], vb[8];
#pragma unroll
        for (int j = 0; j < 8; ++j) { va[j] = *(const f32x4*)(xa + 256 * j + 4 * C.lane); vb[j] = *(const f32x4*)(xb + 256 * j + 4 * C.lane); }
        float meana, rstda, meanb, rstdb; ln_stats(va, meana, rstda); ln_stats(vb, meanb, rstdb);
#pragma unroll
        for (int rr = 0; rr < 2; ++rr) { const int mm = rr ? m2 : m; if (rr == 1 && m2 == m) break; const bool meta = mm >= T;
#pragma unroll
            for (int j = 0; j < 8; ++j) { const f32x4 gg = *(const f32x4*)(lg + 256 * j + 4 * C.lane), bb = *(const f32x4*)(lb + 256 * j + 4 * C.lane);
                const f32x4 o = rr ? (vb[j] - meanb) * rstdb * gg + bb : (va[j] - meana) * rstda * gg + bb;
                if (meta) *(f32x4*)((float*)(ws + WS_HMETA) + (size_t)(mm - T) * DM + 256 * j + 4 * C.lane) = o;
                else { u32x2 w; w.x = cvt_pk_bf16(o.x, o.y); w.y = cvt_pk_bf16(o.z, o.w); *(u32x2*)(HBF + (size_t)mm * DM + 256 * j + 4 * C.lane) = w; } } }
    }
}

__device__ __forceinline__ void p1_meta_proj(const Ctx& C, unsigned char* ws) {
    const bf16_t* WinT = (const bf16_t*)(ws + WS_WIN); const float* HM = (const float*)(ws + WS_HMETA);
    const int gw = C.vcu * 8 + C.wave, NGW = C.G * 8;
    for (int it = gw; it < 640; it += NGW) {
        const int nidx = 4 * it; const int col0 = nidx < 512 ? nidx : (nidx < 1536 ? 1536 + (nidx - 512) : 2560 + (nidx - 1536));
        float acc[16][4];
#pragma unroll
        for (int r = 0; r < 16; ++r)
#pragma unroll
            for (int c = 0; c < 4; ++c) acc[r][c] = 0.f;
#pragma unroll 1
        for (int j = 0; j < 4; ++j) { const int k0 = j * 512 + C.lane * 8;
            f32x4 w0[4], w1[4];
#pragma unroll
            for (int c = 0; c < 4; ++c) { const u32x4 ww = *(const u32x4*)(WinT + (size_t)(col0 + c) * DM + k0); unpack8(ww, w0[c], w1[c]); }
#pragma unroll
            for (int r = 0; r < 16; ++r) { const f32x4 h0 = *(const f32x4*)(HM + r * DM + k0), h1 = *(const f32x4*)(HM + r * DM + k0 + 4);
#pragma unroll
                for (int c = 0; c < 4; ++c) { const f32x4 p = h0 * w0[c] + h1 * w1[c]; acc[r][c] += (p.x + p.y) + (p.z + p.w); } } }
        float mine = 0.f;
#pragma unroll
        for (int r = 0; r < 16; ++r)
#pragma unroll
            for (int c = 0; c < 4; ++c) { const float s = wave_sum(acc[r][c]); mine = (C.lane == r * 4 + c) ? s : mine; }
        const int r = C.lane >> 2, c = C.lane & 3;
        if (nidx < 512) ((float*)(ws + WS_UMETA))[r * SSMW + nidx + c] = mine;
        else if (nidx < 1536) ((bf16_t*)(ws + WS_KMETA))[r * AW + (nidx - 512) + c] = (bf16_t)(cvt_pk_bf16(mine, 0.f) & 0xffffu);
        else ((bf16_t*)(ws + WS_VMETA))[r * AW + (nidx - 1536) + c] = (bf16_t)(cvt_pk_bf16(mine, 0.f) & 0xffffu);
    }
}

__device__ __forceinline__ float gelu_tanh(float x) { const float u = 1.5957691216057308f * (x + 0.044715f * x * x * x); return x / (1.0f + __expf(-u)); }
#define SC_HANDOFF(Q) do { _Pragma("unroll") for (int st_ = 0; st_ < 2; ++st_) { \
        auto rr_ = __builtin_amdgcn_permlane32_swap(__float_as_uint(sre[st_]), __float_as_uint(sre[st_]), false, false); sre[st_] = __uint_as_float(rr_[(Q) & 1]); \
        auto ri_ = __builtin_amdgcn_permlane32_swap(__float_as_uint(sim[st_]), __float_as_uint(sim[st_]), false, false); sim[st_] = __uint_as_float(ri_[(Q) & 1]); } } while (0)
template <bool STORE> __device__ __forceinline__ void scan_block(f32x16 (&buv)[4], float (&sre)[2], float (&sim)[2], const float (&are)[2], const float (&aim)[2], int hi) {
    float bu[4][16];
#pragma unroll
    for (int t = 0; t < 4; ++t)
#pragma unroll
        for (int r = 0; r < 16; ++r) bu[t][r] = buv[t][r];
#pragma unroll
    for (int q = 0; q < 8; ++q) {
        const bool act = (hi == (q & 1));
#pragma unroll
        for (int i = 0; i < 4; ++i) { const int reg = 4 * (q >> 1) + i;
#pragma unroll
            for (int st = 0; st < 2; ++st) {
                const float nre = are[st] * sre[st] - aim[st] * sim[st] + bu[st][reg];
                const float nim = are[st] * sim[st] + aim[st] * sre[st] + bu[2 + st][reg];
                sre[st] = nre; sim[st] = nim;
                if (STORE) { bu[st][reg] = act ? nre : bu[st][reg]; bu[2 + st][reg] = act ? nim : bu[2 + st][reg]; } } }
        SC_HANDOFF(q);
    }
    if (STORE) {
#pragma unroll
        for (int t = 0; t < 4; ++t)
#pragma unroll
            for (int r = 0; r < 16; ++r) buv[t][r] = bu[t][r];
    }
}
__device__ __forceinline__ void p2_scan(const Ctx& C, const float* const* in, unsigned char* ws) {
    const int lane = C.lane, wave = C.wave, r32 = lane & 31, hi = lane >> 5, fr = lane & 15, fq = lane >> 4;
    const bf16_t* U = (const bf16_t*)(ws + WS_U); const float* UM = (const float*)(ws + WS_UMETA); bf16_t* YPRE = (bf16_t*)(ws + WS_YPRE);
    const float* AB = (const float*)(ws + WS_SSMAB); const float* BB = (const float*)(ws + WS_SSMBB);
    LAS unsigned char* Sl = C.lds + wave * 10752;
    LAS unsigned char* Yl = Sl + 9728;
    LAS float* E = (LAS float*)(C.lds + 86016);
    for (int item = C.vcu; item < NB_ * NGRP; item += C.G) {
        const int b = item >> 5, g = item & 31;
        const bf16_t* Ub = U + ((size_t)b * SEQ + wave * 256) * SSMW + 16 * g;
        bf16x8 ufa[8];
#pragma unroll
        for (int blk = 0; blk < 8; ++blk) ufa[blk] = *(const bf16x8*)(Ub + (size_t)(32 * blk + r32) * SSMW + 8 * hi);
        float are[2], aim[2];
#pragma unroll
        for (int st = 0; st < 2; ++st) { are[st] = AB[g * 64 + 32 * st + r32]; aim[st] = AB[NGRP * NST + g * 64 + 32 * st + r32]; }
        bf16x8 Bf[4];
#pragma unroll
        for (int ri = 0; ri < 2; ++ri)
#pragma unroll
            for (int st = 0; st < 2; ++st) { const float* src = BB + ri * (NGRP * NST * 16) + (g * 64 + 32 * st + r32) * 16 + 8 * hi;
                const f32x4 x0 = *(const f32x4*)src, x1 = *(const f32x4*)(src + 4); Bf[2 * ri + st] = __builtin_bit_cast(bf16x8, pack8(x0, x1)); }
        bf16x8 Cf[5];
#pragma unroll
        for (int ks = 0; ks < 4; ++ks) { const int k0 = 32 * ks + 8 * fq; const float* src = (ks < 2 ? in[10] : in[11]) + (g * 16 + fr) * 64 + (k0 & 63);
            f32x4 x0 = *(const f32x4*)src, x1 = *(const f32x4*)(src + 4); if (ks >= 2) { x0 = -x0; x1 = -x1; } Cf[ks] = __builtin_bit_cast(bf16x8, pack8(x0, x1)); }
        { const float dsk = in[12][g * 16 + fr]; f32x4 x0, x1;
#pragma unroll
          for (int j = 0; j < 4; ++j) { x0[j] = (fq < 2 && 8 * fq + j == fr) ? dsk : 0.f; x1[j] = (fq < 2 && 8 * fq + 4 + j == fr) ? dsk : 0.f; }
          Cf[4] = __builtin_bit_cast(bf16x8, pack8(x0, x1)); }
        float sre[2] = {0.f, 0.f}, sim[2] = {0.f, 0.f}, mre[2] = {0.f, 0.f}, mim[2] = {0.f, 0.f};
        if (wave == 0) {
            f32x4 x0 = (f32x4){0.f, 0.f, 0.f, 0.f}, x1 = x0;
            if (r32 >= 16) { const float* src = UM + (r32 - 16) * SSMW + 16 * g + 8 * hi; x0 = *(const f32x4*)src; x1 = *(const f32x4*)(src + 4); }
            const bf16x8 uf = __builtin_bit_cast(bf16x8, pack8(x0, x1));
            f32x16 bu[4];
#pragma unroll
            for (int t = 0; t < 4; ++t) bu[t] = __builtin_amdgcn_mfma_f32_32x32x16_bf16(uf, Bf[t], (f32x16){}, 0, 0, 0);
            scan_block<false>(bu, sre, sim, are, aim, hi);
            mre[0] = sre[0]; mre[1] = sre[1]; mim[0] = sim[0]; mim[1] = sim[1];
        }
#pragma unroll
        for (int blk = 0; blk < 8; ++blk) {
            f32x16 bu[4];
#pragma unroll
            for (int t = 0; t < 4; ++t) bu[t] = __builtin_amdgcn_mfma_f32_32x32x16_bf16(ufa[blk], Bf[t], (f32x16){}, 0, 0, 0);
            scan_block<false>(bu, sre, sim, are, aim, hi);
        }
        if (hi == 0) {
#pragma unroll
            for (int st = 0; st < 2; ++st) { E[wave * 128 + st * 64 + r32] = sre[st]; E[wave * 128 + st * 64 + 32 + r32] = sim[st]; } }
        __syncthreads();
        if (wave == 0) { sre[0] = mre[0]; sre[1] = mre[1]; sim[0] = mim[0]; sim[1] = mim[1]; }
        else {
            float pr[2], pi[2];
#pragma unroll
            for (int st = 0; st < 2; ++st) { pr[st] = are[st]; pi[st] = aim[st];
#pragma unroll
                for (int k = 0; k < 8; ++k) { const float nr = pr[st] * pr[st] - pi[st] * pi[st], ni = 2.f * pr[st] * pi[st]; pr[st] = nr; pi[st] = ni; }
                sre[st] = E[st * 64 + r32]; sim[st] = E[st * 64 + 32 + r32]; }
            for (int j = 1; j < wave; ++j) {
#pragma unroll
                for (int st = 0; st < 2; ++st) { const float er = E[j * 128 + st * 64 + r32], ei = E[j * 128 + st * 64 + 32 + r32];
                    const float nr = pr[st] * sre[st] - pi[st] * sim[st] + er, ni = pr[st] * sim[st] + pi[st] * sre[st] + ei; sre[st] = nr; sim[st] = ni; } }
        }
#pragma unroll
        for (int blk = 0; blk < 8; ++blk) {
            f32x16 bu[4];
#pragma unroll
            for (int t = 0; t < 4; ++t) bu[t] = __builtin_amdgcn_mfma_f32_32x32x16_bf16(ufa[blk], Bf[t], (f32x16){}, 0, 0, 0);
            scan_block<true>(bu, sre, sim, are, aim, hi);
#pragma unroll
            for (int reg = 0; reg < 16; ++reg) { const int tok = (reg & 3) + 8 * (reg >> 2) + 4 * hi;
#pragma unroll
                for (int t = 0; t < 4; ++t) *(LAS bf16_t*)(Sl + tok * 304 + (32 * t + r32) * 2) = (bf16_t)(cvt_pk_bf16(bu[t][reg], 0.f) & 0xffffu); }
            *(LAS bf16x8*)(Sl + r32 * 304 + (128 + 8 * hi) * 2) = ufa[blk];
            f32x4 y[2];
#pragma unroll
            for (int mt = 0; mt < 2; ++mt) { y[mt] = (f32x4){0.f, 0.f, 0.f, 0.f};
#pragma unroll
                for (int ks = 0; ks < 4; ++ks) { const bf16x8 af = *(const LAS bf16x8*)(Sl + (16 * mt + fr) * 304 + (32 * ks + 8 * fq) * 2);
                    y[mt] = __builtin_amdgcn_mfma_f32_16x16x32_bf16(af, Cf[ks], y[mt], 0, 0, 0); }
                bf16x8 au = *(const LAS bf16x8*)(Sl + (16 * mt + fr) * 304 + (128 + 8 * (fq & 1)) * 2); if (fq >= 2) au = (bf16x8){};
                y[mt] = __builtin_amdgcn_mfma_f32_16x16x32_bf16(au, Cf[4], y[mt], 0, 0, 0); }
#pragma unroll
            for (int mt = 0; mt < 2; ++mt)
#pragma unroll
                for (int reg = 0; reg < 4; ++reg) *(LAS bf16_t*)(Yl + (16 * mt + 4 * fq + reg) * 32 + fr * 2) = (bf16_t)(cvt_pk_bf16(gelu_tanh(y[mt][reg]), 0.f) & 0xffffu);
            const u32x4 yo = *(const LAS u32x4*)(Yl + (lane >> 1) * 32 + (lane & 1) * 16);
            *(u32x4*)(YPRE + ((size_t)b * SEQ + wave * 256 + 32 * blk + (lane >> 1)) * SSMW + 16 * g + 8 * (lane & 1)) = yo;
        }
        __syncthreads();
    }
}

__device__ __forceinline__ int crow(int r, int hi) { return (r & 3) + 8 * (r >> 2) + 4 * hi; }
typedef short v4i16_t __attribute__((ext_vector_type(4)));
__device__ __forceinline__ s16x4 vtr(const LAS unsigned char* p) { return __builtin_bit_cast(s16x4, __builtin_amdgcn_ds_read_tr16_b64_v4i16((LAS v4i16_t*)p)); }
__device__ __forceinline__ float half_swap_max(float x) { auto rr = __builtin_amdgcn_permlane32_swap(__float_as_uint(x), __float_as_uint(x), false, false); return fmaxf(__uint_as_float(rr[0]), __uint_as_float(rr[1])); }
__device__ __forceinline__ float half_swap_sum(float x) { auto rr = __builtin_amdgcn_permlane32_swap(__float_as_uint(x), __float_as_uint(x), false, false); return __uint_as_float(rr[0]) + __uint_as_float(rr[1]); }

__device__ __forceinline__ void attn_pv(f32x16 (&o)[4], const bf16x8 (&pa)[4], unsigned vaddr) {
    s16x4 vl[2][4], vh[2][4];
#define ATT_VRD(SET, D) do { _Pragma("unroll") for (int ks_ = 0; ks_ < 4; ++ks_) { \
        asm volatile("ds_read_b64_tr_b16 %0, %1 offset:%2" : "=&v"(vl[SET][ks_]) : "v"(vaddr), "i"((D) * 4096 + ks_ * 1024) : "memory"); \
        asm volatile("ds_read_b64_tr_b16 %0, %1 offset:%2" : "=&v"(vh[SET][ks_]) : "v"(vaddr), "i"((D) * 4096 + ks_ * 1024 + 512) : "memory"); } } while (0)
    __builtin_amdgcn_sched_barrier(0);
    ATT_VRD(0, 0);
#pragma unroll
    for (int d = 0; d < 4; ++d) {
        if (d == 0) { ATT_VRD(1, 1); } else if (d == 1) { ATT_VRD(0, 2); } else if (d == 2) { ATT_VRD(1, 3); }
        if (d < 3) asm volatile("s_waitcnt lgkmcnt(8)" ::: "memory"); else asm volatile("s_waitcnt lgkmcnt(0)" ::: "memory");
        __builtin_amdgcn_sched_barrier(0);
#pragma unroll
        for (int ks = 0; ks < 4; ++ks) { const s16x4 lo = vl[d & 1][ks], hv = vh[d & 1][ks];
            const bf16x8 vf = (bf16x8){lo[0], lo[1], lo[2], lo[3], hv[0], hv[1], hv[2], hv[3]};
            o[d] = __builtin_amdgcn_mfma_f32_32x32x16_bf16(pa[ks], vf, o[d], 0, 0, 0); }
        __builtin_amdgcn_sched_barrier(0);
    }
#undef ATT_VRD
}
__device__ __forceinline__ void attn_qk(f32x16& p0, f32x16& p1, const LAS unsigned char* kb, const bf16x8 (&qr)[4]) {
    p0 = (f32x16){}; p1 = (f32x16){};
#pragma unroll
    for (int d0 = 0; d0 < 4; ++d0) { const bf16x8 b0 = *(const LAS bf16x8*)(kb + d0 * 2048), b1 = *(const LAS bf16x8*)(kb + d0 * 2048 + 512);
        p0 = __builtin_amdgcn_mfma_f32_32x32x16_bf16(b0, qr[d0], p0, 0, 0, 0); p1 = __builtin_amdgcn_mfma_f32_32x32x16_bf16(b1, qr[d0], p1, 0, 0, 0); }
}
__device__ __forceinline__ void attn_softmax(const bool FIRST, f32x16& p0, f32x16& p1, f32x16 (&o)[4], float& mrun, float& lrun, bf16x8 (&pa)[4], LAS float* wsf, int r32, int hi) {
    if (FIRST) {
        asm volatile("" ::: "memory");
#pragma unroll
        for (int r = 0; r < 16; ++r) { if (r >= 8) p0[r] = -__builtin_inff(); p1[r] = -__builtin_inff(); } }
    float rmA = fmaxf(p0[0], p0[1]), rmB = fmaxf(p0[2], p0[3]), rmC = fmaxf(p1[0], p1[1]), rmD = fmaxf(p1[2], p1[3]);
#pragma unroll
    for (int r = 4; r < 16; r += 4) { rmA = fmaxf(rmA, fmaxf(p0[r], p0[r + 1])); rmB = fmaxf(rmB, fmaxf(p0[r + 2], p0[r + 3])); rmC = fmaxf(rmC, fmaxf(p1[r], p1[r + 1])); rmD = fmaxf(rmD, fmaxf(p1[r + 2], p1[r + 3])); }
    const float rm = half_swap_max(fmaxf(fmaxf(rmA, rmB), fmaxf(rmC, rmD)));
    if (FIRST) mrun = rm;
    else if (__any(rm > mrun + 8.0f)) {
        const float mnew = fmaxf(mrun, rm), alpha = __builtin_amdgcn_exp2f(mrun - mnew);
        lrun *= alpha; mrun = mnew;
        if (hi == 0) wsf[r32] = alpha;
        f32x4 a4[4];
#pragma unroll
        for (int gq = 0; gq < 4; ++gq) a4[gq] = *(const LAS f32x4*)(wsf + 8 * gq + 4 * hi);
#pragma unroll
        for (int d = 0; d < 4; ++d)
#pragma unroll
            for (int r = 0; r < 16; ++r) o[d][r] *= a4[r >> 2][r & 3];
    }
    float psA = 0.f, psB = 0.f, psC = 0.f, psD = 0.f;
#pragma unroll
    for (int r = 0; r < 16; r += 2) { p0[r] = __builtin_amdgcn_exp2f(p0[r] - mrun); p0[r + 1] = __builtin_amdgcn_exp2f(p0[r + 1] - mrun); p1[r] = __builtin_amdgcn_exp2f(p1[r] - mrun); p1[r + 1] = __builtin_amdgcn_exp2f(p1[r + 1] - mrun);
        psA += p0[r]; psB += p0[r + 1]; psC += p1[r]; psD += p1[r + 1]; }
    lrun += (psA + psB) + (psC + psD);
    u32x4 w;
    w = (u32x4){cvt_pk_bf16(p0[0], p0[1]), cvt_pk_bf16(p0[2], p0[3]), cvt_pk_bf16(p0[4], p0[5]), cvt_pk_bf16(p0[6], p0[7])}; pa[0] = __builtin_bit_cast(bf16x8, w);
    w = (u32x4){cvt_pk_bf16(p0[8], p0[9]), cvt_pk_bf16(p0[10], p0[11]), cvt_pk_bf16(p0[12], p0[13]), cvt_pk_bf16(p0[14], p0[15])}; pa[1] = __builtin_bit_cast(bf16x8, w);
    w = (u32x4){cvt_pk_bf16(p1[0], p1[1]), cvt_pk_bf16(p1[2], p1[3]), cvt_pk_bf16(p1[4], p1[5]), cvt_pk_bf16(p1[6], p1[7])}; pa[2] = __builtin_bit_cast(bf16x8, w);
    w = (u32x4){cvt_pk_bf16(p1[8], p1[9]), cvt_pk_bf16(p1[10], p1[11]), cvt_pk_bf16(p1[12], p1[13]), cvt_pk_bf16(p1[14], p1[15])}; pa[3] = __builtin_bit_cast(bf16x8, w);
}
__device__ __forceinline__ void glds16(const void* gsrc, unsigned lds_dst) { unsigned keep;
    asm volatile("s_mov_b32 %0, m0\n\ts_mov_b32 m0, %2\n\ts_nop 0\n\tglobal_load_lds_dwordx4 %1, off\n\ts_mov_b32 m0, %0" : "=&s"(keep) : "v"(gsrc), "s"(lds_dst) : "memory"); }
__device__ __forceinline__ void attn_unit(const Ctx& C, const bf16_t* Qg, const bf16_t* Kg, const bf16_t* Vg, const bf16_t* KM, const bf16_t* VM, bf16_t* Y,
                                          const float* subg, float lam, int b, int h, int qt, bool prefetched, int nqt, bf16x8 (&qr)[4], bool rb) {
    LAS unsigned char* lds = C.lds;
    const int lane = C.lane, wave = C.wave, r32 = lane & 31, hi = lane >> 5, qb = wave >> 1, map = wave & 1;
    const int q0 = qt * 128 + qb * 32;
    const size_t rowb = (size_t)b * SEQ;
    if (!prefetched) { const bf16_t* qp = Qg + (rowb + q0 + r32) * AW + h * 128 + map * 64 + hi * 8;
#pragma unroll
      for (int d0 = 0; d0 < 4; ++d0) qr[d0] = *(const bf16x8*)(qp + d0 * 16); }
    const int NT = 2 * qt + 3;
    const bool skip_last = (qb < 2);
    f32x16 o[4];
#pragma unroll
    for (int d = 0; d < 4; ++d) o[d] = (f32x16){};
    float mrun = -__builtin_inff(), lrun = 0.f;
    LAS float* wsf = (LAS float*)(lds + MISC_OFF + 4096 + wave * 256);
    const bf16_t* Kb = Kg + rowb * AW; const bf16_t* Vb = Vg + rowb * AW;
#define ATT_DMA(step, stage) do { const bf16_t* ks_ = (step) == 0 ? KM : Kb; const bf16_t* vs_ = (step) == 0 ? VM : Vb; const int row0_ = (step) == 0 ? 0 : ((step) - 1) * 64; \
    _Pragma("unroll") for (int i_ = 0; i_ < 2; ++i_) { const int p_ = 2 * wave + i_; \
        __builtin_amdgcn_global_load_lds((const unsigned*)(ks_ + (size_t)(row0_ + lane) * AW + h * 128 + (p_ >> 3) * 64 + (p_ & 7) * 8), (LAS unsigned*)(lds + (stage) * 32768 + p_ * 1024), 16, 0, 0); \
        __builtin_amdgcn_global_load_lds((const unsigned*)(vs_ + (size_t)(row0_ + 16 * (p_ & 3) + (lane >> 2)) * AW + h * 128 + (p_ >> 2) * 32 + (lane & 3) * 8), (LAS unsigned*)(lds + (stage) * 32768 + 16384 + p_ * 1024), 16, 0, 0); } } while (0)
    const int myNT = skip_last ? NT - 1 : NT;
    bf16x8 pa[4];
#pragma unroll
    for (int k = 0; k < 4; ++k) pa[k] = (bf16x8){};
    if (!prefetched) ATT_DMA(0, 0);
    asm volatile("s_waitcnt vmcnt(0)" ::: "memory"); __syncthreads();
    int stage = 0;
#pragma unroll 1
    for (int s = 0; s <= NT; ++s) {
        const int stn = stage == 2 ? 0 : stage + 1, stp = stage == 0 ? 2 : stage - 1;
        if (s + 1 < NT) ATT_DMA(s + 1, stn);
        if (rb && s >= 1 && s <= myNT) attn_pv(o, pa, (unsigned)(uintptr_t)(lds + stp * 32768 + 16384 + ((lane >> 4) & 1) * 32 + (lane & 3) * 8 + (4 * hi + ((lane & 15) >> 2)) * 64));
        if (s < myNT) {
            f32x16 p0, p1; attn_qk(p0, p1, lds + stage * 32768 + map * 8192 + hi * 1024 + r32 * 16, qr);
            attn_softmax(s == 0, p0, p1, o, mrun, lrun, pa, wsf, r32, hi);
            if (!rb) attn_pv(o, pa, (unsigned)(uintptr_t)(lds + stage * 32768 + 16384 + ((lane >> 4) & 1) * 32 + (lane & 3) * 8 + (4 * hi + ((lane & 15) >> 2)) * 64));
        }
        asm volatile("s_waitcnt vmcnt(0)" ::: "memory"); __syncthreads();
        stage = stn;
    }
#undef ATT_DMA
    bf16x8 qn[4];
#pragma unroll
    for (int d0 = 0; d0 < 4; ++d0) qn[d0] = qr[d0];
    if (nqt >= 0) {
        const unsigned lds0 = (unsigned)(uintptr_t)lds;
#pragma unroll
        for (int i = 0; i < 2; ++i) { const int p = 2 * wave + i;
            glds16(KM + (size_t)lane * AW + h * 128 + (p >> 3) * 64 + (p & 7) * 8, (unsigned)__builtin_amdgcn_readfirstlane(lds0 + p * 1024));
            glds16(VM + (size_t)(16 * (p & 3) + (lane >> 2)) * AW + h * 128 + (p >> 2) * 32 + (lane & 3) * 8, (unsigned)__builtin_amdgcn_readfirstlane(lds0 + 16384 + p * 1024)); }
        const bf16_t* qp = Qg + (rowb + nqt * 128 + qb * 32 + r32) * AW + h * 128 + map * 64 + hi * 8;
#pragma unroll
        for (int d0 = 0; d0 < 4; ++d0) qn[d0] = *(const bf16x8*)(qp + d0 * 16);
    }
    { const float ltot = half_swap_sum(lrun); const float inv = (map ? lam : 1.0f) / ltot;
      if (hi == 0) wsf[r32] = inv;
      f32x4 a4[4];
#pragma unroll
      for (int gq = 0; gq < 4; ++gq) a4[gq] = *(const LAS f32x4*)(wsf + 8 * gq + 4 * hi);
#pragma unroll
      for (int d = 0; d < 4; ++d)
#pragma unroll
          for (int r = 0; r < 16; ++r) o[d][r] *= a4[r >> 2][r & 3]; }
    LAS float* X = (LAS float*)(lds + 32768 + qb * 16384);
    if (map == 1) {
#pragma unroll
        for (int d = 0; d < 4; ++d)
#pragma unroll
            for (int r = 0; r < 16; ++r) X[crow(r, hi) * 128 + 32 * d + r32] = o[d][r];
    }
    __syncthreads();
    if (map == 0) {
        float ssq[16];
#pragma unroll
        for (int r = 0; r < 16; ++r) ssq[r] = 0.f;
#pragma unroll
        for (int d = 0; d < 4; ++d)
#pragma unroll
            for (int r = 0; r < 16; ++r) { const float v = o[d][r] - X[crow(r, hi) * 128 + 32 * d + r32]; o[d][r] = v; ssq[r] += v * v; }
#pragma unroll
        for (int r = 0; r < 16; ++r) {
#pragma unroll
            for (int off = 1; off < 32; off <<= 1) ssq[r] += __shfl_xor(ssq[r], off);
            ssq[r] = 0.8f / sqrtf(ssq[r] * (1.f / 128.f) + LN_EPS); }
        LAS bf16_t* Yt = (LAS bf16_t*)X;
#pragma unroll
        for (int d = 0; d < 4; ++d) { const float gg = subg[32 * d + r32];
#pragma unroll
            for (int r = 0; r < 16; ++r) Yt[crow(r, hi) * 128 + 32 * d + r32] = (bf16_t)(cvt_pk_bf16(o[d][r] * ssq[r] * gg, 0.f) & 0xffffu); }
#pragma unroll
        for (int i = 0; i < 8; ++i) { const int id = i * 64 + lane, row = id >> 4, ch = id & 15;
            *(u32x4*)(Y + (rowb + q0 + row) * AW + h * 128 + ch * 8) = *(const LAS u32x4*)(Yt + row * 128 + ch * 8); }
    }
#pragma unroll
    for (int d0 = 0; d0 < 4; ++d0) qr[d0] = qn[d0];
    __syncthreads();
}
__device__ __forceinline__ void p3_attention(const Ctx& C, const float* const* in, unsigned char* ws) {
    const bf16_t* Q = (const bf16_t*)(ws + WS_Q); const bf16_t* K = (const bf16_t*)(ws + WS_K); const bf16_t* V = (const bf16_t*)(ws + WS_V);
    const bf16_t* KM = (const bf16_t*)(ws + WS_KMETA); const bf16_t* VM = (const bf16_t*)(ws + WS_VMETA); bf16_t* Y = (bf16_t*)(ws + WS_YATT);
    const float l1 = wave_sum(in[14][C.lane] * in[15][C.lane]), l2 = wave_sum(in[16][C.lane] * in[17][C.lane]);
    const float lam = expf(l1) - expf(l2) + 0.2f;
    LAS unsigned* rc = (LAS unsigned*)(C.lds + MISC_OFF + 6144);
    if (C.tid < 4) rc[C.tid] = 0;
    __syncthreads();
    bool rb;
    { const unsigned simd = (unsigned)__builtin_amdgcn_s_getreg(2308) & 3u;
      unsigned r = 0; if (C.lane == 0) r = __hip_atomic_fetch_add(rc + simd, 1u, __ATOMIC_RELAXED, __HIP_MEMORY_SCOPE_WORKGROUP);
      rb = (__builtin_amdgcn_readfirstlane((int)r) & 1) != 0; }
#ifndef ATT_REP
#define ATT_REP 1
#endif
    for (int vv = C.vcu; vv < 256 * ATT_REP; vv += C.G) { const int v = vv & 255;
        const int bh = v >> 1, sft = v & 1;
        bf16x8 qr[4];
#pragma unroll
        for (int d0 = 0; d0 < 4; ++d0) qr[d0] = (bf16x8){};
#pragma unroll 1
        for (int i = 0; i < 8; ++i) { const int qt = (i & 1) ? (15 - sft - (i & ~1)) : (sft + (i & ~1)); const int i1 = i + 1;
            const int nqt = i1 < 8 ? ((i1 & 1) ? (15 - sft - (i1 & ~1)) : (sft + (i1 & ~1))) : -1;
            attn_unit(C, Q, K, V, KM, VM, Y, in[18], lam, bh >> 3, bh & 7, qt, i > 0, nqt, qr, rb); }
    }
}

__device__ __forceinline__ void p6_ln1_router(const Ctx& C, const float* const* in, unsigned char* ws) {
    const int lane = C.lane, wave = C.wave, tid = C.tid;
    const bf16_t* Z = (const bf16_t*)(ws + WS_Z); bf16_t* H1 = (bf16_t*)(ws + WS_H1); const float* WrT = (const float*)(ws + WS_WRT);
    int* LIST = (int*)(ws + WS_LIST); float* WGT = (float*)(ws + WS_WGT); unsigned* ECNT = (unsigned*)(ws + WS_CTL) + CW_ECNT;
    const float* lg = in[22]; const float* lb = in[23];
    LAS float* WB = (LAS float*)C.lds;
    LAS unsigned char* XB = C.lds + 98304;
    LAS int* RE = (LAS int*)(XB);
    LAS float* RW = (LAS float*)(XB + 1024);
    LAS int* CL = (LAS int*)(XB + 2048);
    LAS int* BS = (LAS int*)(XB + 2048 + 128);
    LAS int* SL = (LAS int*)(XB + 2048 + 256);
    LAS float* LG = (LAS float*)(XB + 4096) + wave * 80;
    for (int rbk = C.vcu; rbk < T / 128; rbk += C.G) {
        if (tid < 32) CL[tid] = 0;
#pragma unroll 1
        for (int step = 0; step < 8; ++step) {
            const int lr0 = step * 16 + 2 * wave; const size_t row0 = (size_t)rbk * 128 + lr0;
            int l4 = 4 * lane; asm volatile("" : "+v"(l4));
            f32x4 v0[8], v1[8];
#pragma unroll
            for (int j = 0; j < 8; ++j) { const u32x2 z0 = *(const u32x2*)(Z + row0 * DM + 256 * j + l4), z1 = *(const u32x2*)(Z + (row0 + 1) * DM + 256 * j + l4);
                v0[j] = (f32x4){bf_lo(z0.x), bf_hi(z0.x), bf_lo(z0.y), bf_hi(z0.y)}; v1[j] = (f32x4){bf_lo(z1.x), bf_hi(z1.x), bf_lo(z1.y), bf_hi(z1.y)}; }
            float mean0, rstd0, mean1, rstd1; ln_stats(v0, mean0, rstd0); ln_stats(v1, mean1, rstd1);
#pragma unroll
            for (int j = 0; j < 8; ++j) { const f32x4 gg = *(const f32x4*)(lg + 256 * j + l4), bb = *(const f32x4*)(lb + 256 * j + l4);
                v0[j] = (v0[j] - mean0) * rstd0 * gg + bb; v1[j] = (v1[j] - mean1) * rstd1 * gg + bb;
                u32x2 w; w.x = cvt_pk_bf16(v0[j].x, v0[j].y); w.y = cvt_pk_bf16(v0[j].z, v0[j].w); *(u32x2*)(H1 + row0 * DM + 256 * j + l4) = w;
                w.x = cvt_pk_bf16(v1[j].x, v1[j].y); w.y = cvt_pk_bf16(v1[j].z, v1[j].w); *(u32x2*)(H1 + (row0 + 1) * DM + 256 * j + l4) = w; }
#pragma unroll 1
            for (int ng = 0; ng < 3; ++ng) {
                __syncthreads();
                int tq = tid; asm volatile("" : "+v"(tq));
#pragma unroll
                for (int i = 0; i < 12; ++i) { const int idx = tq + 512 * i, n = idx >> 9, c4 = idx & 511;
                    *(LAS f32x4*)(WB + n * 2048 + 4 * c4) = *(const f32x4*)(WrT + (size_t)(12 * ng + n) * DM + 4 * c4); }
                __syncthreads();
#pragma unroll 1
                for (int n = 0; n < 12; ++n) { float pa = 0.f, pb = 0.f;
#pragma unroll
                    for (int j = 0; j < 8; ++j) { const f32x4 w4 = *(const LAS f32x4*)(WB + n * 2048 + 256 * j + l4);
                        const f32x4 a = v0[j] * w4, bq = v1[j] * w4; pa += (a.x + a.y) + (a.z + a.w); pb += (bq.x + bq.y) + (bq.z + bq.w); }
                    const float sa = wave_sum(pa), sb = wave_sum(pb); if (lane == 0) { LG[12 * ng + n] = sa; LG[40 + 12 * ng + n] = sb; } }
            }
            if (lane < 2) {
                const LAS float* L = LG + 40 * lane;
                int gi = 0; float gm = L[0] + in[25][0];
                for (int n = 1; n < 4; ++n) { const float x = L[n] + in[25][n]; if (x > gm) { gm = x; gi = n; } }
                float gs = 0.f;
                for (int n = 0; n < 4; ++n) gs += __expf(L[n] + in[25][n] - gm);
                const float gval = 1.0f / gs;
                int i1 = 0; float m1 = L[4 + gi * 8] + in[27][gi * 8];
                for (int j = 1; j < 8; ++j) { const float x = L[4 + gi * 8 + j] + in[27][gi * 8 + j]; if (x > m1) { m1 = x; i1 = j; } }
                int i2 = -1; float m2 = -__builtin_inff();
                for (int j = 0; j < 8; ++j) { const float x = L[4 + gi * 8 + j] + in[27][gi * 8 + j]; if (j != i1 && x > m2) { m2 = x; i2 = j; } }
                const float tt = __expf(m2 - m1), w1 = gval / (1.f + tt), w2 = gval * tt / (1.f + tt);
                const int lr = lr0 + lane; RE[lr * 2] = gi * 8 + i1; RE[lr * 2 + 1] = gi * 8 + i2; RW[lr * 2] = w1; RW[lr * 2 + 1] = w2;
            }
        }
        __syncthreads();
        int e = 0;
        if (tid < 256) { e = RE[tid]; SL[tid] = __hip_atomic_fetch_add(&CL[e], 1, __ATOMIC_RELAXED, __HIP_MEMORY_SCOPE_WORKGROUP); }
        __syncthreads();
        if (tid < 32) BS[tid] = (int)__hip_atomic_fetch_add(&ECNT[tid], (unsigned)CL[tid], __ATOMIC_RELAXED, __HIP_MEMORY_SCOPE_AGENT);
        __syncthreads();
        if (tid < 256) { const int entry = (rbk * 128 + (tid >> 1)) * 2 + (tid & 1); LIST[(size_t)e * CAP + BS[e] + SL[tid]] = entry; WGT[entry] = RW[tid]; }
        __syncthreads();
    }
}

__device__ __forceinline__ void p9_ln2(const Ctx& C, const float* const* in, unsigned char* ws, float* out) {
    const bf16_t* H1 = (const bf16_t*)(ws + WS_H1); const bf16_t* YK = (const bf16_t*)(ws + WS_YK);
    const float* lg = in[31]; const float* lb = in[32];
    const int gw = C.vcu * 8 + C.wave, NGW = C.G * 8, lane = C.lane;
    for (int m = gw; m < T; m += 2 * NGW) {
        const int m2 = (m + NGW < T) ? m + NGW : m;
        u32x2 ha[8], ya0[8], ya1[8], hb[8], yb0[8], yb1[8];
#pragma unroll
        for (int j = 0; j < 8; ++j) { const size_t c = 256 * j + 4 * lane;
            ha[j] = *(const u32x2*)(H1 + (size_t)m * DM + c); ya0[j] = *(const u32x2*)(YK + (size_t)(2 * m) * DM + c); ya1[j] = *(const u32x2*)(YK + (size_t)(2 * m + 1) * DM + c);
            hb[j] = *(const u32x2*)(H1 + (size_t)m2 * DM + c); yb0[j] = *(const u32x2*)(YK + (size_t)(2 * m2) * DM + c); yb1[j] = *(const u32x2*)(YK + (size_t)(2 * m2 + 1) * DM + c); }
#pragma unroll
        for (int rr = 0; rr < 2; ++rr) {
            f32x4 v[8];
#pragma unroll
            for (int j = 0; j < 8; ++j) { const u32x2 hw = rr ? hb[j] : ha[j], y0 = rr ? yb0[j] : ya0[j], y1 = rr ? yb1[j] : ya1[j];
                v[j] = (f32x4){bf_lo(hw.x), bf_hi(hw.x), bf_lo(hw.y), bf_hi(hw.y)} * ALPHA + (f32x4){bf_lo(y0.x), bf_hi(y0.x), bf_lo(y0.y), bf_hi(y0.y)} + (f32x4){bf_lo(y1.x), bf_hi(y1.x), bf_lo(y1.y), bf_hi(y1.y)}; }
            float mean, rstd; ln_stats(v, mean, rstd);
            const int mm = rr ? m2 : m;
            if (rr == 0 || m2 != m) {
#pragma unroll
                for (int j = 0; j < 8; ++j) { const f32x4 gg = *(const f32x4*)(lg + 256 * j + 4 * lane), bb = *(const f32x4*)(lb + 256 * j + 4 * lane);
                    *(f32x4*)(out + (size_t)mm * DM + 256 * j + 4 * lane) = (v[j] - mean) * rstd * gg + bb; } }
        }
    }
}

__device__ __forceinline__ int build_moe_tables(const Ctx& C, unsigned char* ws) {
    LAS int* blkstart = (LAS int*)(C.lds + MISC_OFF + 64); LAS int* cntE = (LAS int*)(C.lds + MISC_OFF + 320); LAS int* blkexp = (LAS int*)(C.lds + MISC_OFF + 512);
    unsigned* ECNT = (unsigned*)(ws + WS_CTL) + CW_ECNT;
    __syncthreads();
    if (C.tid < 32) cntE[C.tid] = (int)__hip_atomic_load(&ECNT[C.tid], __ATOMIC_RELAXED, __HIP_MEMORY_SCOPE_AGENT);
    __syncthreads();
    if (C.tid == 0) { int s = 0; for (int e = 0; e < NE; ++e) { blkstart[e] = s; s += (cntE[e] + 255) >> 8; } blkstart[NE] = s; }
    __syncthreads();
    const int NBLK = blkstart[NE];
    if (C.tid < NBLK && C.tid < 320) { int e = 0; for (int j = 1; j < NE; ++j) if (blkstart[j] <= C.tid) e = j; blkexp[C.tid] = e; }
    __syncthreads();
    return NBLK < 320 ? NBLK : 320;
}

__device__ __forceinline__ void p7_convert_down(const Ctx& C, const float* const* in, unsigned char* ws) {
    LAS float* scr = (LAS float*)(C.lds + C.wave * 16384);
    unsigned* ctr = (unsigned*)(ws + WS_CTL) + CW_CONV; bf16_t* WdnT = (bf16_t*)(ws + WS_WDN);
    constexpr int NCH = NE * 512 / 16;
    for (;;) {
        unsigned ch = 0; if (C.lane == 0) ch = __hip_atomic_fetch_add(ctr, 1u, __ATOMIC_RELAXED, __HIP_MEMORY_SCOPE_AGENT);
        ch = (unsigned)__builtin_amdgcn_readfirstlane((int)ch);
        if (ch >= (unsigned)NCH) break;
#pragma unroll 1
        for (int q = 0; q < 16; ++q) { const int r = (int)ch * 16 + q, e = r >> 9, rr = r & 511, kb = rr >> 6, nb = rr & 63;
            transpose_item(in[30] + (size_t)e * DFF * DM, DFF, DM, WdnT, kb, nb, e * 2048 + 32 * nb, scr, C.lane); }
    }
}

constexpr int NPHASE = 10;
struct Args { const float* in[33]; float* out; unsigned char* ws; int ph_lo, ph_hi; };
__global__ void __launch_bounds__(512, 2) mk_fwd(Args args) {
    extern __shared__ __attribute__((aligned(16))) unsigned char lds_raw[];
    Ctx C; C.lds = (LAS unsigned char*)lds_raw; C.tid = threadIdx.x; C.lane = C.tid & 63; C.wave = __builtin_amdgcn_readfirstlane(C.tid >> 6);
    C.G = gridDim.x; { const int bx = blockIdx.x; C.vcu = (C.G % 8 == 0) ? (bx % 8) * (C.G / 8) + bx / 8 : bx; }
    unsigned char* ws = args.ws; const float* const* in = args.in;
    volatile LAS unsigned* MISC = (volatile LAS unsigned*)(C.lds + MISC_OFF);
    if (C.tid < 16) MISC[C.tid] = 0u;
    __syncthreads();
    unsigned* barw = (unsigned*)(ws + WS_CTL) + CW_BAR;
    XcdBarrier bar; bar.bar = barw; bar.x = 0; bar.st = nullptr;
    const int lo = args.ph_lo, hi = args.ph_hi;
    if (hi - lo > 1) bar = xcd_barrier_post(barw, MISC);
#ifndef PH_MASK
#define PH_MASK 0x3ff
#endif
#define IN(k) (((PH_MASK >> (k)) & 1) && lo <= (k) && (k) < hi)
#define SEAM(k) do { if (IN(k) && IN((k) + 1)) xcd_barrier(bar); } while (0)
#ifndef WGM_PROJ
#define WGM_PROJ 4
#endif
#ifndef WGM_N2K
#define WGM_N2K 2
#endif
#ifndef GEMM_SP2
#define GEMM_SP2 true
#endif
#ifndef GEMM_ALIGN
#define GEMM_ALIGN true
#endif
#ifndef PROBE_MASK
#define PROBE_MASK 0
#endif
#define REPS(k) (((PROBE_MASK >> (k)) & 1) ? 2 : 1)
#define REPSEAM(k, rep) do { if ((rep) + 1 < REPS(k)) xcd_barrier(bar); } while (0)
    LAS unsigned char* lds = C.lds;
    bf16_t* MG = (bf16_t*)args.out;

    if (IN(0)) { _Pragma("unroll") for (int rep = 0; rep < REPS(0); ++rep) { p0_prologue(C, in, ws); REPSEAM(0, rep); } } SEAM(0);

    if (IN(1)) { _Pragma("unroll") for (int rep = 0; rep < REPS(1); ++rep) {
        pg8::Gemm g{(const bf16_t*)(ws + WS_HBF), (const bf16_t*)(ws + WS_WIN), T, INC, DM, nullptr, nullptr, 0}; pg8::StaticOrder S; S.init(T, INC, C.G, (int)blockIdx.x, WGM_PROJ);
        EpiProj E{(bf16_t*)(ws + WS_U), (bf16_t*)(ws + WS_Q), (bf16_t*)(ws + WS_K), (bf16_t*)(ws + WS_V), (bf16_t*)(ws + WS_SGS), (bf16_t*)(ws + WS_SGA)};
        pg8::gemm_phase<EpiProj, pg8::StaticOrder, GEMM_ALIGN, GEMM_SP2, false>(lds, g, S, E);
        p1_meta_proj(C, ws);
        REPSEAM(1, rep);
    } } SEAM(1);

    if (IN(2)) { _Pragma("unroll") for (int rep = 0; rep < REPS(2); ++rep) { p2_scan(C, in, ws); REPSEAM(2, rep); } } SEAM(2);

    if (IN(3)) { _Pragma("unroll") for (int rep = 0; rep < REPS(3); ++rep) {
        { pg8::Gemm g{(const bf16_t*)(ws + WS_YPRE), (const bf16_t*)(ws + WS_WGLU), T, SSMW, SSMW, nullptr, nullptr, 0}; pg8::StaticOrder S; S.init(T, SSMW, C.G, (int)blockIdx.x);
          EpiGlu E{(const bf16_t*)(ws + WS_YPRE), (bf16_t*)(ws + WS_YSSM)};
          pg8::gemm_phase<EpiGlu, pg8::StaticOrder, GEMM_ALIGN, GEMM_SP2, false>(lds, g, S, E); }
        p3_attention(C, in, ws);
        REPSEAM(3, rep);
    } } SEAM(3);

    if (IN(4)) { _Pragma("unroll") for (int rep = 0; rep < REPS(4); ++rep) {
        { pg8::Gemm g{(const bf16_t*)(ws + WS_YSSM), (const bf16_t*)(ws + WS_WBS), T, DM, SSMW, (const bf16_t*)(ws + WS_YATT), (const bf16_t*)(ws + WS_WBA), AW}; pg8::StaticOrder S; S.init(T, DM, C.G, (int)blockIdx.x, WGM_N2K);
          EpiMergeF E{(const bf16_t*)(ws + WS_SGS), (const bf16_t*)(ws + WS_SGA), MG};
          pg8::gemm_phase<EpiMergeF, pg8::StaticOrder, GEMM_ALIGN, GEMM_SP2, false, true>(lds, g, S, E); }
        REPSEAM(4, rep);
    } } SEAM(4);

    if (IN(5)) { _Pragma("unroll") for (int rep = 0; rep < REPS(5); ++rep) {
        pg8::Gemm g{MG, (const bf16_t*)(ws + WS_WO), T, DM, DM, nullptr, nullptr, 0}; pg8::StaticOrder S; S.init(T, DM, C.G, (int)blockIdx.x, WGM_N2K);
        EpiZ E{(const bf16_t*)(ws + WS_HBF), (bf16_t*)(ws + WS_Z)};
        pg8::gemm_phase<EpiZ, pg8::StaticOrder, GEMM_ALIGN, GEMM_SP2, false>(lds, g, S, E);
        REPSEAM(5, rep);
    } } SEAM(5);

    if (IN(6)) { p6_ln1_router(C, in, ws); } SEAM(6);

    if (IN(7)) { _Pragma("unroll") for (int rep = 0; rep < REPS(7); ++rep) {
        const int NBLK = build_moe_tables(C, ws);
        MoeOrder S{C.G, C.vcu, 2, NBLK, (const LAS int*)(lds + MISC_OFF + 512), (const LAS int*)(lds + MISC_OFF + 64), (const LAS int*)(lds + MISC_OFF + 320), (const int*)(ws + WS_LIST)};
        pg8::Gemm g{(const bf16_t*)(ws + WS_H1), (const bf16_t*)(ws + WS_WUP), T, NE * 1024, DM, nullptr, nullptr, 0};
        EpiSwiglu E{(bf16_t*)(ws + WS_HB), (const int*)(ws + WS_LIST), (const float*)(ws + WS_WGT), (int*)(ws + WS_POSE), (float*)(ws + WS_POSW)};
        pg8::gemm_phase<EpiSwiglu, MoeOrder, GEMM_ALIGN, GEMM_SP2, true>(lds, g, S, E);
        p7_convert_down(C, in, ws);
        REPSEAM(7, rep);
    } } SEAM(7);

    if (IN(8)) { _Pragma("unroll") for (int rep = 0; rep < REPS(8); ++rep) {
        const int NBLK = build_moe_tables(C, ws);
        MoeOrder S{C.G, C.vcu, 3, NBLK, (const LAS int*)(lds + MISC_OFF + 512), (const LAS int*)(lds + MISC_OFF + 64), (const LAS int*)(lds + MISC_OFF + 320), (const int*)(ws + WS_LIST)};
        pg8::Gemm g{(const bf16_t*)(ws + WS_HB), (const bf16_t*)(ws + WS_WDN), NBLK * 256, NE * DM, DFF, nullptr, nullptr, 0};
        EpiDown E{(const int*)(ws + WS_POSE), (const float*)(ws + WS_POSW), (bf16_t*)(ws + WS_YK)};
        pg8::gemm_phase<EpiDown, MoeOrder, GEMM_ALIGN, GEMM_SP2, false>(lds, g, S, E);
        REPSEAM(8, rep);
    } } SEAM(8);

    if (IN(9)) { _Pragma("unroll") for (int rep = 0; rep < REPS(9); ++rep) { p9_ln2(C, in, ws, args.out); REPSEAM(9, rep); } }
#undef IN
#undef SEAM
}

extern "C" void kernel_launch(void* const* d_in, const int* in_sizes, int n_in, void* d_out, int out_size, void* d_ws, size_t ws_size, hipStream_t stream) {
    static int grid = 0;
    if (grid == 0) {
        if (n_in != 33 || in_sizes[0] != T * DM || out_size != T * DM || ws_size < WS_END) { fprintf(stderr, "kernel_launch: unexpected shapes (n_in %d, in0 %d, out %d, ws %zu)\n", n_in, n_in > 0 ? in_sizes[0] : -1, out_size, ws_size); grid = -1; return; }
        int dev = 0, cus = 0, per_cu = 0;
        if (hipGetDevice(&dev) != hipSuccess || hipDeviceGetAttribute(&cus, hipDeviceAttributeMultiprocessorCount, dev) != hipSuccess) { grid = -1; return; }
        if (hipFuncSetAttribute((const void*)mk_fwd, hipFuncAttributeMaxDynamicSharedMemorySize, LDS_BYTES) != hipSuccess) { fprintf(stderr, "kernel_launch: hipFuncSetAttribute failed\n"); grid = -1; return; }
        if (hipOccupancyMaxActiveBlocksPerMultiprocessor(&per_cu, (const void*)mk_fwd, 512, LDS_BYTES) != hipSuccess || per_cu < 1) { fprintf(stderr, "kernel_launch: occupancy query reports %d blocks per CU\n", per_cu); }
        (void)hipGetLastError();
        grid = cus;
    }
    if (grid < 0) return;
    (void)hipMemsetAsync((char*)d_ws + WS_CTL, 0, CTL_ZERO_BYTES, stream);
    Args a{};
    for (int i = 0; i < 33; ++i) a.in[i] = (const float*)d_in[i];
    a.out = (float*)d_out; a.ws = (unsigned char*)d_ws;
#if MK_PER_PHASE
    for (int p = 0; p < NPHASE; ++p) { a.ph_lo = p; a.ph_hi = p + 1; hipLaunchKernelGGL(mk_fwd, dim3(grid), dim3(512), LDS_BYTES, stream, a); }
#else
    a.ph_lo = 0; a.ph_hi = NPHASE; hipLaunchKernelGGL(mk_fwd, dim3(grid), dim3(512), LDS_BYTES, stream, a);
#endif
}
```

```cpp
#include <hip/hip_runtime.h>
#include <stdint.h>
#include <stdio.h>

#ifndef ATT_PROBE
#define ATT_PROBE 0
#endif
#ifndef MK_PER_PHASE
#define MK_PER_PHASE 0
#endif

#define GAS __attribute__((address_space(1)))
#define LAS __attribute__((address_space(3)))
typedef unsigned short bf16_t;
typedef short bf16x8 __attribute__((ext_vector_type(8)));
typedef short s16x4 __attribute__((ext_vector_type(4)));
typedef float f32x2 __attribute__((ext_vector_type(2)));
typedef float f32x4 __attribute__((ext_vector_type(4)));
typedef float f32x16 __attribute__((ext_vector_type(16)));
typedef unsigned u32x2 __attribute__((ext_vector_type(2)));
typedef unsigned u32x4 __attribute__((ext_vector_type(4)));

constexpr int NB_ = 16, SEQ = 2048, DM = 2048, T = NB_ * SEQ, NMETA = 16;
constexpr int SSMW = 512, AW = 1024, INC = 7680, NGRP = 32, NST = 64;
constexpr int NE = 32, DFF = 512, CAP = T;
constexpr float LN_EPS = 1e-5f;
constexpr float ALPHA = 1.189207115002721f;
constexpr float QSCALE = 0.125f * 1.4426950408889634f;

__device__ __forceinline__ unsigned cvt_pk_bf16(float lo, float hi) { unsigned r; asm volatile("v_cvt_pk_bf16_f32 %0, %1, %2" : "=v"(r) : "v"(lo), "v"(hi)); return r; }
__device__ __forceinline__ float bf_lo(unsigned w) { return __uint_as_float(w << 16); }
__device__ __forceinline__ float bf_hi(unsigned w) { return __uint_as_float(w & 0xffff0000u); }
__device__ __forceinline__ float sigmoidf_(float x) { return 1.0f / (1.0f + __expf(-x)); }
__device__ __forceinline__ float wave_sum(float v) {
#pragma unroll
    for (int o = 1; o < 64; o <<= 1) v += __shfl_xor(v, o);
    return v;
}

namespace pg8 {
constexpr int BM = 256, BK = 64, HALF = 128, HTB = HALF * BK * 2, STAGE_BYTES = 8 * HTB, NXCD = 8, WGM = 4;
__host__ __device__ __forceinline__ int lds_byte(int r, int c) { const int st = (r >> 4) * 2 + (c >> 5), rr = r & 15, cc = c & 31, ob = rr * 64 + cc * 2; return st * 1024 + (ob ^ (((ob >> 9) & 1) << 5)); }
__host__ __device__ __forceinline__ void stage_rc(int b, int& R, int& C) { const int st = b / 1024, sb = b % 1024, swz = sb ^ (((sb >> 9) & 1) << 5); R = (st >> 1) * 16 + swz / 64; C = (st & 1) * 32 + (swz % 64) / 2; }
__host__ __device__ __forceinline__ int perm32(int rho) { const int n = rho >> 4, i = rho & 15; return 8 * (i >> 2) + 4 * n + (i & 3); }

struct Unit { int pm, pn, e, s0, cnt; };
struct Gemm { const bf16_t* A; const bf16_t* Bt; int M, N, K; const bf16_t* A2; const bf16_t* Bt2; int K2; };

struct StaticOrder {
    int nM, nN, nwg, G, c, wgm;
    __device__ void init(int M, int N, int G_, int c_, int wgm_ = WGM) { nM = M / BM; nN = N / BM; nwg = nM * nN; G = G_; c = c_; wgm = wgm_; }
    __device__ bool next(int i, Unit& u) const {
        const long L = (long)i * G + c; if (L >= nwg) return false;
        int wgid = (int)L; { const int q = nwg / NXCD, r = nwg % NXCD, xcd = wgid % NXCD, off = wgid / NXCD; wgid = (xcd < r ? xcd * (q + 1) : r * (q + 1) + (xcd - r) * q) + off; }
        const int nig = wgm * nN, gid = wgid / nig, fm = gid * wgm, gsz = (nM - fm) < wgm ? (nM - fm) : wgm;
        u.pm = fm + ((wgid % nig) % gsz); u.pn = (wgid % nig) / gsz; u.e = 0; u.s0 = 0; u.cnt = 0; return true;
    }
    __device__ __forceinline__ int arow(const Unit&, int) const { return 0; }
};

template <class Epi, class Sched, bool ALIGN_EPI, bool SP2, bool GATHER, bool DUAL = false>
__device__ __forceinline__ void gemm_phase(LAS unsigned char* lds, const Gemm g, const Sched& S, const Epi& E) {
    const int tid = threadIdx.x, wid = __builtin_amdgcn_readfirstlane(tid >> 6), lane = tid & 63, wr = wid >> 2, wc = wid & 3, fr = lane & 15, fq = lane >> 4;
    const int K = g.K, K2 = DUAL ? g.K2 : 0, nt1 = K / BK, nt = (K + K2) / BK;
    unsigned voffA[2], voffB[2], voffA2[2] = {0u, 0u}, voffB2[2] = {0u, 0u}; int stR[2], stC[2];
#pragma unroll
    for (int i = 0; i < 2; ++i) { int R, C; stage_rc(tid * 16 + i * 8192, R, C); const int Rb = Epi::PERM ? ((R & ~31) + perm32(R & 31)) : R;
        stR[i] = R; stC[i] = C; voffA[i] = (unsigned)(R * K + C) * 2u; voffB[i] = (unsigned)(Rb * K + C) * 2u;
        if constexpr (DUAL) { voffA2[i] = (unsigned)(R * K2 + C) * 2u; voffB2[i] = (unsigned)(Rb * K2 + C) * 2u; } }
    const size_t kstep = (size_t)(BK * 2);
    const size_t hstep = (size_t)HALF * K * 2;
    const size_t tstep = 2 * hstep;
    const size_t hstep2 = (size_t)HALF * K2 * 2, tstep2 = 2 * hstep2;
    const unsigned ldsw = (unsigned)wid * 1024u;
    const int aoff = lds_byte(wr * 64 + fr, fq * 8), boff = lds_byte(wc * 32 + fr, fq * 8);
#define PG8_SA(b, h) (((b) * 2 + (h)) * HTB)
#define PG8_SB(b, h) ((4 + (b) * 2 + (h)) * HTB)
#define PG8_STAGE(bufoff, gbase, voff) do { _Pragma("unroll") for (int _i = 0; _i < 2; ++_i) \
        __builtin_amdgcn_global_load_lds((const unsigned*)((const char*)(gbase) + (voff)[_i]), (LAS unsigned*)(lds + (bufoff) + ldsw + _i * 8192), 16, 0, 0); } while (0)
#define PG8_STAGE_A(bufoff, kbase, h, VO) do { if constexpr (GATHER) { PG8_STAGE(bufoff, kbase, VO[h]); } else { PG8_STAGE(bufoff, (kbase) + (h) * hstep, voffA); } } while (0)
#define PG8_STAGE_AX(bufoff, kbase, h, VO, HS, VA) do { if constexpr (GATHER) { PG8_STAGE(bufoff, kbase, VO[h]); } else { PG8_STAGE(bufoff, (kbase) + (h) * (HS), VA); } } while (0)
#define PG8_LDA(dst, b, h) do { _Pragma("unroll") for (int m = 0; m < 4; ++m) _Pragma("unroll") for (int k = 0; k < 2; ++k) dst[m][k] = *(const LAS bf16x8*)(lds + PG8_SA(b, h) + aoff + m * 2048 + k * 1024); } while (0)
#define PG8_LDB(dst, b, h) do { _Pragma("unroll") for (int n = 0; n < 2; ++n) _Pragma("unroll") for (int k = 0; k < 2; ++k) dst[n][k] = *(const LAS bf16x8*)(lds + PG8_SB(b, h) + boff + n * 2048 + k * 1024); } while (0)
#define PG8_MMA(ai, bj, At, Bt) do { __builtin_amdgcn_s_setprio(1); _Pragma("unroll") for (int m = 0; m < 4; ++m) _Pragma("unroll") for (int n = 0; n < 2; ++n) _Pragma("unroll") for (int k = 0; k < 2; ++k) \
        acc[ai][bj][m][n] = __builtin_amdgcn_mfma_f32_16x16x32_bf16(Bt[n][k], At[m][k], acc[ai][bj][m][n], 0, 0, 0); __builtin_amdgcn_s_setprio(0); } while (0)
#define PG8_WAIT_V(n) asm volatile("s_waitcnt vmcnt(" #n ")" ::: "memory")
#define PG8_WAIT_L(n) asm volatile("s_waitcnt lgkmcnt(" #n ")" ::: "memory")
#define PG8_BAR __builtin_amdgcn_s_barrier()
#define PG8_SCHED __builtin_amdgcn_sched_barrier(0)
#define PG8_GOFF(VO, U) do { _Pragma("unroll") for (int _h = 0; _h < 2; ++_h) _Pragma("unroll") for (int _i = 0; _i < 2; ++_i) \
        VO[_h][_i] = (unsigned)S.arow(U, _h * HALF + stR[_i]) * (unsigned)(K * 2) + (unsigned)(stC[_i] * 2); } while (0)
    Unit cur, nxt; int ui = 0;
    if (!S.next(0, cur)) return;
    f32x4 acc[2][2][4][2];
#pragma unroll
    for (int a = 0; a < 2; ++a)
#pragma unroll
        for (int b = 0; b < 2; ++b)
#pragma unroll
            for (int m = 0; m < 4; ++m)
#pragma unroll
                for (int n = 0; n < 2; ++n) acc[a][b][m][n] = (f32x4){0.f, 0.f, 0.f, 0.f};
    bf16x8 At[4][2], B0[2][2], B1[2][2];
    unsigned cvo[2][2] = {{0u, 0u}, {0u, 0u}}, nvo[2][2] = {{0u, 0u}, {0u, 0u}};
    const char* cA = GATHER ? (const char*)g.A : (const char*)g.A + (size_t)cur.pm * tstep; const char* cB = (const char*)g.Bt + (size_t)cur.pn * tstep;
    if constexpr (GATHER) { PG8_GOFF(cvo, cur); }
    if constexpr (SP2) {
        PG8_STAGE(PG8_SB(0, 0), cB, voffB); PG8_STAGE(PG8_SB(0, 1), cB + hstep, voffB); PG8_STAGE_A(PG8_SA(0, 0), cA, 0, cvo); PG8_STAGE_A(PG8_SA(0, 1), cA, 1, cvo);
        if (wr == 1) PG8_BAR;
        PG8_WAIT_V(2); PG8_BAR;
        PG8_STAGE(PG8_SB(1, 0), cB + kstep, voffB); PG8_STAGE_A(PG8_SA(1, 0), cA + kstep, 0, cvo); PG8_STAGE(PG8_SB(1, 1), cB + hstep + kstep, voffB);
        PG8_WAIT_V(6); PG8_BAR;
    } else {
        PG8_STAGE(PG8_SB(0, 0), cB, voffB); PG8_STAGE_A(PG8_SA(0, 0), cA, 0, cvo); PG8_STAGE(PG8_SB(0, 1), cB + hstep, voffB); PG8_STAGE_A(PG8_SA(0, 1), cA, 1, cvo);
        if (wr == 1) PG8_BAR;
        PG8_WAIT_V(4); PG8_BAR;
        PG8_STAGE(PG8_SB(1, 0), cB + kstep, voffB); PG8_STAGE_A(PG8_SA(1, 0), cA + kstep, 0, cvo); PG8_STAGE(PG8_SB(1, 1), cB + hstep + kstep, voffB);
        PG8_WAIT_V(6); PG8_BAR;
    }
    for (;;) {
        const bool has_next = S.next(ui + 1, nxt);
        const char* nA = GATHER ? cA : (has_next ? (const char*)g.A + (size_t)nxt.pm * tstep : cA); const char* nB = has_next ? (const char*)g.Bt + (size_t)nxt.pn * tstep : cB;
        if constexpr (GATHER) { if (has_next) { PG8_GOFF(nvo, nxt); } else {
#pragma unroll
            for (int h = 0; h < 2; ++h)
#pragma unroll
                for (int i = 0; i < 2; ++i) nvo[h][i] = cvo[h][i]; } }
        const char* cA2 = DUAL ? (const char*)g.A2 + (size_t)cur.pm * tstep2 : cA; const char* cB2 = DUAL ? (const char*)g.Bt2 + (size_t)cur.pn * tstep2 : cB;
        for (int t = 0; t < nt; t += 2) {
            const bool last = (t == nt - 2);
            const bool s1 = DUAL && (t + 1 >= nt1), s2 = DUAL && !last && (t + 2 >= nt1);
            const char* a1 = s1 ? cA2 + (size_t)(t + 1 - nt1) * kstep : cA + (size_t)(t + 1) * kstep;
            const char* a2 = last ? nA : (s2 ? cA2 + (size_t)(t + 2 - nt1) * kstep : cA + (size_t)(t + 2) * kstep);
            const char* b2 = last ? nB : (s2 ? cB2 + (size_t)(t + 2 - nt1) * kstep : cB + (size_t)(t + 2) * kstep);
            const char* a3 = a2 + kstep; const char* b3 = b2 + kstep;
            const size_t hs1 = s1 ? hstep2 : hstep, hs2 = s2 ? hstep2 : hstep;
            unsigned vA1[2], vA2[2], vB2[2];
#pragma unroll
            for (int i = 0; i < 2; ++i) { vA1[i] = s1 ? voffA2[i] : voffA[i]; vA2[i] = s2 ? voffA2[i] : voffA[i]; vB2[i] = s2 ? voffB2[i] : voffB[i]; }
            unsigned svo[2][2];
#pragma unroll
            for (int h = 0; h < 2; ++h)
#pragma unroll
                for (int i = 0; i < 2; ++i) svo[h][i] = last ? nvo[h][i] : cvo[h][i];
            if constexpr (SP2) {
            PG8_LDB(B0, 0, 0); PG8_LDB(B1, 0, 1); PG8_SCHED; PG8_LDA(At, 0, 0); PG8_STAGE_AX(PG8_SA(1, 1), a1, 1, cvo, hs1, vA1);
            PG8_WAIT_V(8); PG8_WAIT_L(0); PG8_BAR; PG8_MMA(0, 0, At, B0); PG8_MMA(0, 1, At, B1); PG8_BAR; PG8_SCHED;
            PG8_LDA(At, 0, 1); PG8_STAGE(PG8_SB(0, 0), b2, vB2); PG8_STAGE(PG8_SB(0, 1), b2 + hs2, vB2); PG8_STAGE_AX(PG8_SA(0, 0), a2, 0, svo, hs2, vA2);
            PG8_WAIT_V(8); PG8_WAIT_L(0); PG8_BAR; PG8_MMA(1, 0, At, B0); PG8_MMA(1, 1, At, B1); PG8_BAR; PG8_SCHED;
            PG8_LDB(B0, 1, 0); PG8_LDB(B1, 1, 1); PG8_SCHED; PG8_LDA(At, 1, 0); PG8_STAGE_AX(PG8_SA(0, 1), a2, 1, svo, hs2, vA2);
            PG8_WAIT_V(8); PG8_WAIT_L(0); PG8_BAR; PG8_MMA(0, 0, At, B0); PG8_MMA(0, 1, At, B1); PG8_BAR; PG8_SCHED;
            PG8_LDA(At, 1, 1); PG8_STAGE(PG8_SB(1, 0), b3, vB2); PG8_STAGE(PG8_SB(1, 1), b3 + hs2, vB2); PG8_STAGE_AX(PG8_SA(1, 0), a3, 0, svo, hs2, vA2);
            PG8_WAIT_V(8); PG8_WAIT_L(0); PG8_BAR; PG8_MMA(1, 0, At, B0); PG8_MMA(1, 1, At, B1); PG8_BAR; PG8_SCHED;
            } else {
            PG8_LDB(B0, 0, 0); PG8_SCHED; PG8_LDA(At, 0, 0); PG8_STAGE_AX(PG8_SA(1, 1), a1, 1, cvo, hs1, vA1);
            PG8_WAIT_L(8); PG8_BAR; PG8_WAIT_L(0); PG8_MMA(0, 0, At, B0); PG8_BAR; PG8_SCHED;
            PG8_LDB(B1, 0, 1); PG8_STAGE(PG8_SB(0, 0), b2, vB2);
            PG8_BAR; PG8_WAIT_L(0); PG8_MMA(0, 1, At, B1); PG8_BAR;
            PG8_LDA(At, 0, 1); PG8_STAGE_AX(PG8_SA(0, 0), a2, 0, svo, hs2, vA2);
            PG8_BAR; PG8_WAIT_L(0); PG8_MMA(1, 0, At, B0); PG8_BAR; PG8_SCHED;
            PG8_STAGE(PG8_SB(0, 1), b2 + hs2, vB2);
            PG8_WAIT_V(6); PG8_BAR; PG8_MMA(1, 1, At, B1); PG8_BAR;
            PG8_LDB(B0, 1, 0); PG8_SCHED; PG8_LDA(At, 1, 0); PG8_STAGE_AX(PG8_SA(0, 1), a2, 1, svo, hs2, vA2);
            PG8_WAIT_L(8); PG8_BAR; PG8_WAIT_L(0); PG8_MMA(0, 0, At, B0); PG8_BAR; PG8_SCHED;
            PG8_LDB(B1, 1, 1); PG8_STAGE(PG8_SB(1, 0), b3, vB2);
            PG8_BAR; PG8_WAIT_L(0); PG8_MMA(0, 1, At, B1); PG8_BAR;
            PG8_LDA(At, 1, 1); PG8_STAGE_AX(PG8_SA(1, 0), a3, 0, svo, hs2, vA2);
            PG8_BAR; PG8_WAIT_L(0); PG8_MMA(1, 0, At, B0); PG8_BAR; PG8_SCHED;
            PG8_STAGE(PG8_SB(1, 1), b3 + hs2, vB2);
            PG8_WAIT_V(6); PG8_BAR; PG8_MMA(1, 1, At, B1); PG8_BAR;
            }
            if constexpr (DUAL) { if (t + 2 == nt1) E.mid(acc, cur, wr, wc, fr, fq); }
        }
        if constexpr (ALIGN_EPI) { if (wr == 0) PG8_BAR; }
        E(acc, cur, wr, wc, fr, fq);
        if (!has_next) break;
#pragma unroll
        for (int a = 0; a < 2; ++a)
#pragma unroll
            for (int b = 0; b < 2; ++b)
#pragma unroll
                for (int m = 0; m < 4; ++m)
#pragma unroll
                    for (int n = 0; n < 2; ++n) acc[a][b][m][n] = (f32x4){0.f, 0.f, 0.f, 0.f};
        cur = nxt; cA = nA; cB = nB; ++ui;
#pragma unroll
        for (int h = 0; h < 2; ++h)
#pragma unroll
            for (int i = 0; i < 2; ++i) cvo[h][i] = nvo[h][i];
        if constexpr (ALIGN_EPI) { if (wr == 1) PG8_BAR; }
    }
    PG8_WAIT_V(0);
    if constexpr (!ALIGN_EPI) { if (wr == 0) PG8_BAR; }
    PG8_BAR;
#undef PG8_SA
#undef PG8_SB
#undef PG8_STAGE
#undef PG8_STAGE_A
#undef PG8_STAGE_AX
#undef PG8_LDA
#undef PG8_LDB
#undef PG8_MMA
#undef PG8_WAIT_V
#undef PG8_WAIT_L
#undef PG8_BAR
#undef PG8_SCHED
#undef PG8_GOFF
}
}

constexpr size_t MiB = 1u << 20;
constexpr size_t WS_CTL = 0, CTL_ZERO_BYTES = 1 * MiB;
constexpr size_t WS_HMETA = 1 * MiB;
constexpr size_t WS_UMETA = WS_HMETA + 128 * 1024;
constexpr size_t WS_KMETA = WS_HMETA + 256 * 1024;
constexpr size_t WS_VMETA = WS_HMETA + 384 * 1024;
constexpr size_t WS_SSMAB = WS_HMETA + 512 * 1024;
constexpr size_t WS_SSMBB = WS_HMETA + 576 * 1024;
constexpr size_t WS_WRT = 2 * MiB;
constexpr size_t WS_WIN = 3 * MiB;
constexpr size_t WS_WGLU = 33 * MiB;
constexpr size_t WS_WBS = 34 * MiB;
constexpr size_t WS_WBA = 36 * MiB;
constexpr size_t WS_WO = 40 * MiB;
constexpr size_t WS_WUP = 48 * MiB;
constexpr size_t WS_WDN = 176 * MiB;
constexpr size_t WS_HBF = 240 * MiB;
constexpr size_t WS_U = 368 * MiB;
constexpr size_t WS_Q = 400 * MiB;
constexpr size_t WS_K = 464 * MiB;
constexpr size_t WS_V = 528 * MiB;
constexpr size_t WS_SGS = 592 * MiB;
constexpr size_t WS_SGA = 720 * MiB;
constexpr size_t WS_YPRE = 848 * MiB;
constexpr size_t WS_YSSM = 880 * MiB;
constexpr size_t WS_YATT = 912 * MiB;
constexpr size_t WS_END = 976 * MiB;
constexpr size_t WS_Z = 368 * MiB;
constexpr size_t WS_H1 = 624 * MiB;
constexpr size_t WS_HB = 752 * MiB;
constexpr size_t WS_YK = 368 * MiB;
constexpr size_t WS_LIST = 848 * MiB;
constexpr size_t WS_WGT = 852 * MiB;
constexpr size_t WS_POSE = 853 * MiB;
constexpr size_t WS_POSW = 854 * MiB;
constexpr int CW_ECNT = 64;
constexpr int CW_CONV = 192;
constexpr int CW_BAR = 4096;

constexpr int RING_BYTES = 131072;
constexpr int MISC_OFF = RING_BYTES;
constexpr int LDS_BYTES = 139264;

#define XB_TMO      128
#define XB_XCNT(j)  (256  + 64 * (j))
#define XB_XSUB(j)  (1280 + 64 * (j))
#define XB_XGEN(j)  (2304 + 64 * (j))
#define XB_TOP      3328
#define XB_TOPGEN   3392
#define XCD_BAR_WORDS 3456
#define XB_SPIN_CAP (1u << 18)
__device__ __forceinline__ unsigned xb_ld(unsigned* p)              { return __hip_atomic_load(p, __ATOMIC_RELAXED, __HIP_MEMORY_SCOPE_AGENT); }
__device__ __forceinline__ unsigned xb_add(unsigned* p, unsigned v) { return __hip_atomic_fetch_add(p, v, __ATOMIC_RELAXED, __HIP_MEMORY_SCOPE_AGENT); }
__device__ __forceinline__ unsigned xb_xcc_id() { return (unsigned)__builtin_amdgcn_s_getreg((3 << 11) | 20) & 0xFu; }
#define XB_SPIN(cond, bar) do { unsigned _sp = 0; while (cond) { __builtin_amdgcn_s_sleep(1); \
    if ((++_sp & 255u) == 0u) { if (xb_ld(&(bar)[XB_TMO])) break; if (_sp > XB_SPIN_CAP) { atomicAdd(&(bar)[XB_TMO], 1u); break; } } } } while (0)
struct XcdBarrier { unsigned* bar; unsigned x; volatile LAS unsigned* st; };
__device__ __forceinline__ XcdBarrier xcd_barrier_post(unsigned* bar, volatile LAS unsigned* st) {
    XcdBarrier b; b.bar = bar; b.x = xb_xcc_id(); b.st = st;
    if (threadIdx.x == 0) (void)xb_add(&bar[XB_XCNT(b.x)], 1u);
    return b;
}
__device__ __forceinline__ void xcd_barrier_complete(unsigned* bar, unsigned x, unsigned& nloc, unsigned& nx) {
    const unsigned G = gridDim.x * gridDim.y * gridDim.z;
    unsigned sum, cnt, mine, sp = 0u;
    for (;;) {
        sum = 0u; cnt = 0u; mine = 0u;
#pragma unroll
        for (unsigned j = 0; j < 16; ++j) { const unsigned c = xb_ld(&bar[XB_XCNT(j)]); sum += c; cnt += (c > 0u) ? 1u : 0u; mine = (j == x) ? c : mine; }
        if (sum == G) break;
        __builtin_amdgcn_s_sleep(1);
        if ((++sp & 255u) == 0u) { if (xb_ld(&bar[XB_TMO])) break; if (sp > XB_SPIN_CAP) { atomicAdd(&bar[XB_TMO], 1u); break; } }
    }
    nloc = mine > 0u ? mine : 1u; nx = cnt > 0u ? cnt : 1u;
}
__device__ __forceinline__ void xcd_barrier(const XcdBarrier& b) {
    asm volatile("s_waitcnt vmcnt(0)" ::: "memory");
    __syncthreads();
    if (threadIdx.x == 0) {
        unsigned* bar = b.bar;
        __builtin_amdgcn_s_waitcnt(0);
        unsigned nloc = b.st[0], nx = b.st[1];
        if (nloc == 0u) { xcd_barrier_complete(bar, b.x, nloc, nx); b.st[0] = nloc; b.st[1] = nx; }
        const unsigned old = xb_add(&bar[XB_XSUB(b.x)], 1u);
        const unsigned gen = old / nloc;
        if (old + 1u == (gen + 1u) * nloc) {
            __builtin_amdgcn_fence(__ATOMIC_RELEASE, "agent");
            asm volatile("s_waitcnt vmcnt(0)" ::: "memory");
            const unsigned og = xb_add(&bar[XB_TOP], 1u);
            const unsigned tg = og / nx;
            if (og + 1u == (tg + 1u) * nx) xb_add(&bar[XB_TOPGEN], 1u);
            else XB_SPIN(xb_ld(&bar[XB_TOPGEN]) == tg, bar);
            __builtin_amdgcn_fence(__ATOMIC_ACQUIRE, "agent");
            xb_add(&bar[XB_XGEN(b.x)], 1u);
            asm volatile("s_waitcnt vmcnt(0)" ::: "memory");
        } else {
            XB_SPIN(xb_ld(&bar[XB_XGEN(b.x)]) == gen, bar);
            __builtin_amdgcn_fence(__ATOMIC_ACQUIRE, "agent");
            asm volatile("s_waitcnt vmcnt(0)" ::: "memory");
        }
    }
    __syncthreads();
}

using pg8::Unit;
__device__ __forceinline__ u32x4 pack8(const f32x4 v0, const f32x4 v1) { u32x4 w; w.x = cvt_pk_bf16(v0[0], v0[1]); w.y = cvt_pk_bf16(v0[2], v0[3]); w.z = cvt_pk_bf16(v1[0], v1[1]); w.w = cvt_pk_bf16(v1[2], v1[3]); return w; }
__device__ __forceinline__ void unpack8(const u32x4 w, f32x4& v0, f32x4& v1) { v0 = (f32x4){bf_lo(w.x), bf_hi(w.x), bf_lo(w.y), bf_hi(w.y)}; v1 = (f32x4){bf_lo(w.z), bf_hi(w.z), bf_lo(w.w), bf_hi(w.w)}; }

struct EpiProj {
    static constexpr bool PERM = true;
    bf16_t *U, *Q, *K, *V, *RHO, *SGA;
    __device__ __forceinline__ void operator()(const f32x4 (&acc)[2][2][4][2], const Unit& u, int wr, int wc, int fr, int fq) const {
        const int pn = u.pn;
        if (pn >= 14) {
            const int row0 = u.pm * 256 + wr * 64 + fr, col0 = (pn - 14) * 128 + wc * 32 + 8 * fq;
#pragma unroll
            for (int ai = 0; ai < 2; ++ai)
#pragma unroll
                for (int m = 0; m < 4; ++m) { const size_t off = (size_t)(row0 + ai * 128 + m * 16) * DM + col0; f32x4 r0, r1, a0, a1;
#pragma unroll
                    for (int j = 0; j < 4; ++j) { const float es0 = __expf(-acc[ai][0][m][0][j]), es1 = __expf(-acc[ai][0][m][1][j]), ea0 = __expf(-acc[ai][1][m][0][j]), ea1 = __expf(-acc[ai][1][m][1][j]);
                        a0[j] = __builtin_amdgcn_rcpf(1.f + ea0); a1[j] = __builtin_amdgcn_rcpf(1.f + ea1);
                        r0[j] = (1.f + ea0) * __builtin_amdgcn_rcpf(1.f + es0); r1[j] = (1.f + ea1) * __builtin_amdgcn_rcpf(1.f + es1); }
                    *(u32x4*)(RHO + off) = pack8(r0, r1); *(u32x4*)(SGA + off) = pack8(a0, a1); }
            return;
        }
        bf16_t* base; int ldc, ct, mode;
        if (pn < 2) { base = U; ldc = 512; ct = pn; mode = 0; }
        else if (pn < 6) { base = Q; ldc = 1024; ct = pn - 2; mode = 1; }
        else if (pn < 10) { base = K; ldc = 1024; ct = pn - 6; mode = 0; }
        else { base = V; ldc = 1024; ct = pn - 10; mode = 0; }
        const int row0 = u.pm * 256 + wr * 64 + fr, col0 = ct * 256 + wc * 32 + 8 * fq;
#pragma unroll
        for (int ai = 0; ai < 2; ++ai)
#pragma unroll
            for (int m = 0; m < 4; ++m) { bf16_t* rowp = base + (size_t)(row0 + ai * 128 + m * 16) * ldc + col0;
#pragma unroll
                for (int bj = 0; bj < 2; ++bj) { f32x4 v0 = acc[ai][bj][m][0], v1 = acc[ai][bj][m][1];
                    if (mode == 1) { v0 = v0 * QSCALE; v1 = v1 * QSCALE; }
                    *(u32x4*)(rowp + bj * 128) = pack8(v0, v1); } }
    }
};
struct EpiGlu {
    static constexpr bool PERM = true;
    const bf16_t* YPRE; bf16_t* YSSM;
    __device__ __forceinline__ void operator()(const f32x4 (&acc)[2][2][4][2], const Unit& u, int wr, int wc, int fr, int fq) const {
        const int row0 = u.pm * 256 + wr * 64 + fr, col0 = u.pn * 256 + wc * 32 + 8 * fq;
#pragma unroll
        for (int ai = 0; ai < 2; ++ai)
#pragma unroll
            for (int m = 0; m < 4; ++m) { const size_t off = (size_t)(row0 + ai * 128 + m * 16) * SSMW + col0;
#pragma unroll
                for (int bj = 0; bj < 2; ++bj) { const u32x4 yw = *(const u32x4*)(YPRE + off + bj * 128); f32x4 y0, y1; unpack8(yw, y0, y1);
                    f32x4 v0 = acc[ai][bj][m][0], v1 = acc[ai][bj][m][1];
#pragma unroll
                    for (int j = 0; j < 4; ++j) { v0[j] = y0[j] * sigmoidf_(v0[j]); v1[j] = y1[j] * sigmoidf_(v1[j]); }
                    *(u32x4*)(YSSM + off + bj * 128) = pack8(v0, v1); } }
    }
};
template <int SECOND> struct EpiMerge {
    static constexpr bool PERM = true;
    const bf16_t* SG; bf16_t* MG;
    __device__ __forceinline__ void operator()(const f32x4 (&acc)[2][2][4][2], const Unit& u, int wr, int wc, int fr, int fq) const {
        const int row0 = u.pm * 256 + wr * 64 + fr, col0 = u.pn * 256 + wc * 32 + 8 * fq;
#pragma unroll
        for (int ai = 0; ai < 2; ++ai)
#pragma unroll
            for (int m = 0; m < 4; ++m) { const size_t off = (size_t)(row0 + ai * 128 + m * 16) * DM + col0;
#pragma unroll
                for (int bj = 0; bj < 2; ++bj) { const u32x4 gw = *(const u32x4*)(SG + off + bj * 128); f32x4 g0, g1; unpack8(gw, g0, g1);
                    f32x4 v0 = acc[ai][bj][m][0] * g0, v1 = acc[ai][bj][m][1] * g1;
                    if (SECOND) { const u32x4 pw = *(const u32x4*)(MG + off + bj * 128); f32x4 p0, p1; unpack8(pw, p0, p1); v0 = v0 + p0; v1 = v1 + p1; }
                    *(u32x4*)(MG + off + bj * 128) = pack8(v0, v1); } }
    }
};
struct EpiMergeF {
    static constexpr bool PERM = true;
    const bf16_t* SGS; const bf16_t* SGA; bf16_t* MG;
    __device__ __forceinline__ void mid(f32x4 (&acc)[2][2][4][2], const Unit& u, int wr, int wc, int fr, int fq) const {
        asm volatile("" : "+v"(fr), "+v"(fq));
        const int row0 = u.pm * 256 + wr * 64 + fr, col0 = u.pn * 256 + wc * 32 + 8 * fq;
        const bf16_t* sp = SGS + (size_t)row0 * DM + col0;
        u32x4 sw[2][2];
        sw[0][0] = *(const u32x4*)(sp); sw[0][1] = *(const u32x4*)(sp + 128);
#pragma unroll
        for (int g = 0; g < 8; ++g) { const int ai = g >> 2, m = g & 3;
            if (g < 7) { const int g1 = g + 1; const bf16_t* sq = sp + (size_t)((g1 >> 2) * 128 + (g1 & 3) * 16) * DM;
                sw[g1 & 1][0] = *(const u32x4*)(sq); sw[g1 & 1][1] = *(const u32x4*)(sq + 128); }
            asm volatile("" ::: "memory");
#pragma unroll
            for (int bj = 0; bj < 2; ++bj) { f32x4 s0, s1; unpack8(sw[g & 1][bj], s0, s1);
                acc[ai][bj][m][0] = acc[ai][bj][m][0] * s0; acc[ai][bj][m][1] = acc[ai][bj][m][1] * s1; }
        }
    }
    __device__ __forceinline__ void operator()(const f32x4 (&acc)[2][2][4][2], const Unit& u, int wr, int wc, int fr, int fq) const {
        const int row0 = u.pm * 256 + wr * 64 + fr, col0 = u.pn * 256 + wc * 32 + 8 * fq;
#pragma unroll
        for (int ai = 0; ai < 2; ++ai)
#pragma unroll
            for (int m = 0; m < 4; ++m) { const size_t off = (size_t)(row0 + ai * 128 + m * 16) * DM + col0;
#pragma unroll
                for (int bj = 0; bj < 2; ++bj) { const u32x4 gw = *(const u32x4*)(SGA + off + bj * 128); f32x4 g0, g1; unpack8(gw, g0, g1);
                    *(u32x4*)(MG + off + bj * 128) = pack8(acc[ai][bj][m][0] * g0, acc[ai][bj][m][1] * g1); } }
    }
};
struct EpiZ {
    static constexpr bool PERM = true;
    const bf16_t* HBF; bf16_t* Z;
    __device__ __forceinline__ void operator()(const f32x4 (&acc)[2][2][4][2], const Unit& u, int wr, int wc, int fr, int fq) const {
        const int row0 = u.pm * 256 + wr * 64 + fr, col0 = u.pn * 256 + wc * 32 + 8 * fq;
#pragma unroll
        for (int ai = 0; ai < 2; ++ai)
#pragma unroll
            for (int m = 0; m < 4; ++m) { const size_t off = (size_t)(row0 + ai * 128 + m * 16) * DM + col0;
#pragma unroll
                for (int bj = 0; bj < 2; ++bj) { const u32x4 hw = *(const u32x4*)(HBF + off + bj * 128); f32x4 h0, h1; unpack8(hw, h0, h1);
                    *(u32x4*)(Z + off + bj * 128) = pack8(acc[ai][bj][m][0] + h0 * ALPHA, acc[ai][bj][m][1] + h1 * ALPHA); } }
    }
};
struct EpiSwiglu {
    static constexpr bool PERM = true;
    bf16_t* HB; const int* LIST; const float* WGT; int* POSE; float* POSW;
    __device__ __forceinline__ void operator()(const f32x4 (&acc)[2][2][4][2], const Unit& u, int wr, int wc, int fr, int fq) const {
        const int row0 = u.pm * 256 + wr * 64 + fr, col0 = (u.pn & 3) * 128 + wc * 32 + 8 * fq;
#pragma unroll
        for (int ai = 0; ai < 2; ++ai)
#pragma unroll
            for (int m = 0; m < 4; ++m) { f32x4 v0, v1;
#pragma unroll
                for (int j = 0; j < 4; ++j) { const float g0 = acc[ai][0][m][0][j], g1 = acc[ai][0][m][1][j];
                    v0[j] = g0 * sigmoidf_(g0) * acc[ai][1][m][0][j]; v1[j] = g1 * sigmoidf_(g1) * acc[ai][1][m][1][j]; }
                *(u32x4*)(HB + (size_t)(row0 + ai * 128 + m * 16) * DFF + col0) = pack8(v0, v1); }
        if ((u.pn & 3) == 0 && wc == 0 && fq == 0) {
#pragma unroll
            for (int ai = 0; ai < 2; ++ai)
#pragma unroll
                for (int m = 0; m < 4; ++m) { const int r = wr * 64 + fr + ai * 128 + m * 16, slot = u.s0 + r; int entry = -1; float w = 0.f;
                    if (slot < u.cnt) { entry = LIST[(size_t)u.e * CAP + slot]; w = WGT[entry]; }
                    POSE[u.pm * 256 + r] = entry; POSW[u.pm * 256 + r] = w; }
        }
    }
};
struct EpiDown {
    static constexpr bool PERM = true;
    const int* POSE; const float* POSW; bf16_t* YK;
    __device__ __forceinline__ void operator()(const f32x4 (&acc)[2][2][4][2], const Unit& u, int wr, int wc, int fr, int fq) const {
        const int r0 = u.pm * 256 + wr * 64 + fr, col0 = (u.pn & 7) * 256 + wc * 32 + 8 * fq;
        int en[2][4]; float ww[2][4];
#pragma unroll
        for (int ai = 0; ai < 2; ++ai)
#pragma unroll
            for (int m = 0; m < 4; ++m) { en[ai][m] = POSE[r0 + ai * 128 + m * 16]; ww[ai][m] = POSW[r0 + ai * 128 + m * 16]; }
#pragma unroll
        for (int ai = 0; ai < 2; ++ai)
#pragma unroll
            for (int m = 0; m < 4; ++m) {
                if (en[ai][m] >= 0) { const float w = ww[ai][m]; bf16_t* rowp = YK + (size_t)en[ai][m] * DM + col0;
#pragma unroll
                    for (int bj = 0; bj < 2; ++bj) *(u32x4*)(rowp + bj * 128) = pack8(acc[ai][bj][m][0] * w, acc[ai][bj][m][1] * w); } }
    }
};
struct MoeOrder {
    int G, c, shift, NB; const LAS int* blkexp; const LAS int* blkstart; const LAS int* cntE; const int* LIST;
    __device__ __forceinline__ bool next(int i, Unit& u) const {
        const long L = (long)i * G + c; if (L >= ((long)NB << shift)) return false;
        const int blk = (int)(L >> shift), tile = (int)(L & ((1 << shift) - 1)), e = blkexp[blk];
        u.pm = blk; u.pn = (e << shift) + tile; u.e = e; u.s0 = (blk - blkstart[e]) * 256; u.cnt = cntE[e]; return true;
    }
    __device__ __forceinline__ int arow(const Unit& u, int r) const { const int slot = u.s0 + r; const int entry = slot < u.cnt ? LIST[(size_t)u.e * CAP + slot] : 0; return entry >> 1; }
};

struct Ctx { LAS unsigned char* lds; int tid, lane, wave, vcu, G; };

__device__ __forceinline__ void transpose_item(const float* W, int K, int N, bf16_t* WT, int kb, int nb, int dst_row0, LAS float* scr, int lane) {
    const int k0 = 64 * kb, n0 = 32 * nb;
    float tv[32];
#pragma unroll
    for (int i = 0; i < 32; ++i) tv[i] = W[(size_t)(k0 + 2 * i + (lane >> 5)) * N + n0 + (lane & 31)];
#pragma unroll
    for (int i = 0; i < 32; ++i) scr[(2 * i + (lane >> 5)) * 33 + (lane & 31)] = tv[i];
    asm volatile("s_waitcnt lgkmcnt(0)" ::: "memory");
    const int c = lane & 7;
#pragma unroll
    for (int j = 0; j < 4; ++j) { const int n = (lane >> 3) + 8 * j; const LAS float* s = scr + (8 * c) * 33 + n;
        u32x4 o; o.x = cvt_pk_bf16(s[0 * 33], s[1 * 33]); o.y = cvt_pk_bf16(s[2 * 33], s[3 * 33]); o.z = cvt_pk_bf16(s[4 * 33], s[5 * 33]); o.w = cvt_pk_bf16(s[6 * 33], s[7 * 33]);
        *(u32x4*)(WT + (size_t)(dst_row0 + n) * K + k0 + 8 * c) = o; }
    asm volatile("s_waitcnt lgkmcnt(0)" ::: "memory");
}
__device__ __forceinline__ void ln_stats(f32x4 (&v)[8], float& mean, float& rstd) {
    float s = 0.f;
#pragma unroll
    for (int j = 0; j < 8; ++j) s += (v[j].x + v[j].y) + (v[j].z + v[j].w);
    mean = wave_sum(s) * (1.f / DM); float s2 = 0.f;
#pragma unroll
    for (int j = 0; j < 8; ++j) { const f32x4 d = v[j] - mean; s2 += (d.x * d.x + d.y * d.y) + (d.z * d.z + d.w * d.w); }
    rstd = 1.f / sqrtf(wave_sum(s2) * (1.f / DM) + LN_EPS);
}

__device__ __forceinline__ void p0_prologue(const Ctx& C, const float* const* in, unsigned char* ws) {
    LAS float* scr = (LAS float*)(C.lds + C.wave * 16384);
    const int gw = C.vcu * 8 + C.wave, NGW = C.G * 8;
    bf16_t* WinT = (bf16_t*)(ws + WS_WIN); bf16_t* WgluT = (bf16_t*)(ws + WS_WGLU); bf16_t* WbsT = (bf16_t*)(ws + WS_WBS); bf16_t* WbaT = (bf16_t*)(ws + WS_WBA);
    bf16_t* WoT = (bf16_t*)(ws + WS_WO); bf16_t* WupT = (bf16_t*)(ws + WS_WUP);
    constexpr int I_WIN = (DM / 64) * (INC / 32), I_GLU = (SSMW / 64) * (SSMW / 32), I_BS = (SSMW / 64) * (DM / 32), I_BA = (AW / 64) * (DM / 32), I_WO = (DM / 64) * (DM / 32);
    constexpr int I_EXP = NE * 512;
    constexpr int NITEMS = I_WIN + I_GLU + I_BS + I_BA + I_WO + 2 * I_EXP;
    for (int it = gw; it < NITEMS; it += NGW) {
        int r = it;
        if (r < I_WIN) { const int nblk = INC / 32, nb = r % nblk, n0 = 32 * nb;
            const int drow = n0 < 3584 ? n0 : (n0 < 5632 ? 3584 + ((n0 - 3584) >> 7) * 256 + ((n0 - 3584) & 127) : 3584 + ((n0 - 5632) >> 7) * 256 + 128 + ((n0 - 5632) & 127));
            transpose_item(in[4], DM, INC, WinT, r / nblk, nb, drow, scr, C.lane); continue; } r -= I_WIN;
        if (r < I_GLU) { const int nblk = SSMW / 32; transpose_item(in[13], SSMW, SSMW, WgluT, r / nblk, r % nblk, 32 * (r % nblk), scr, C.lane); continue; } r -= I_GLU;
        if (r < I_BS) { const int nblk = DM / 32; transpose_item(in[19], SSMW, DM, WbsT, r / nblk, r % nblk, 32 * (r % nblk), scr, C.lane); continue; } r -= I_BS;
        if (r < I_BA) { const int nblk = DM / 32; transpose_item(in[20], AW, DM, WbaT, r / nblk, r % nblk, 32 * (r % nblk), scr, C.lane); continue; } r -= I_BA;
        if (r < I_WO) { const int nblk = DM / 32; transpose_item(in[21], DM, DM, WoT, r / nblk, r % nblk, 32 * (r % nblk), scr, C.lane); continue; } r -= I_WO;
        if (r < 2 * I_EXP) { const int up = r >= I_EXP ? 1 : 0; r -= up * I_EXP; const int e = r >> 9, rr = r & 511, kb = rr >> 4, nb = rr & 15, n0 = 32 * nb;
            transpose_item(in[28 + up] + (size_t)e * DM * DFF, DM, DFF, WupT, kb, nb, e * 1024 + (n0 >> 7) * 256 + up * 128 + (n0 & 127), scr, C.lane); continue; }
    }
    const int gt = C.vcu * 512 + C.tid, NGT = C.G * 512;
    { float* WrT = (float*)(ws + WS_WRT);
      for (int i = gt; i < 36 * DM; i += NGT) { const int n = i / DM, k = i % DM; WrT[i] = n < 4 ? in[24][k * 4 + n] : in[26][k * 32 + (n - 4)]; } }
    { u32x4* kz = (u32x4*)(ws + WS_KMETA + 16 * 1024 * 2); u32x4* vz = (u32x4*)(ws + WS_VMETA + 16 * 1024 * 2);
      for (int i = gt; i < 48 * 1024 * 2 / 16; i += NGT) { kz[i] = (u32x4){0u, 0u, 0u, 0u}; vz[i] = (u32x4){0u, 0u, 0u, 0u}; } }
    { float* AB = (float*)(ws + WS_SSMAB); float* BB = (float*)(ws + WS_SSMBB);
      for (int i = gt; i < NGRP * NST; i += NGT) { const int g = i >> 6;
        const double lre = fmin((double)in[5][i], -1e-4), lim = (double)in[6][i], dt = exp((double)in[7][g]);
        const double mag = exp(lre * dt), abr = mag * cos(lim * dt), abi = mag * sin(lim * dt), den = lre * lre + lim * lim, nr = abr - 1.0, ni = abi;
        const double zr = (nr * lre + ni * lim) / den, zi = (ni * lre - nr * lim) / den;
        AB[i] = (float)abr; AB[NGRP * NST + i] = (float)abi;
#pragma unroll 4
        for (int c = 0; c < 16; ++c) { const double br = (double)in[8][i * 16 + c], bi = (double)in[9][i * 16 + c];
            BB[i * 16 + c] = (float)(zr * br - zi * bi); BB[NGRP * NST * 16 + i * 16 + c] = (float)(zr * bi + zi * br); } } }
    const float* lg = in[2]; const float* lb = in[3];
    bf16_t* HBF = (bf16_t*)(ws + WS_HBF);
    for (int m = gw; m < T + NMETA; m += 2 * NGW) {
        const int m2 = (m + NGW < T + NMETA) ? m + NGW : m;
        const float* xa = m >= T ? in[1] + (size_t)(m - T) * DM : in[0] + (size_t)m * DM; const float* xb = m2 >= T ? in[1] + (size_t)(m2 - T) * DM : in[0] + (size_t)m2 * DM;
        f32x4 va[8], vb[8];
#pragma unroll
        for (int j = 0; j < 8; ++j) { va[j] = *(const f32x4*)(xa + 256 * j + 4 * C.lane); vb[j] = *(const f32x4*)(xb + 256 * j + 4 * C.lane); }
        float meana, rstda, meanb, rstdb; ln_stats(va, meana, rstda); ln_stats(vb, meanb, rstdb);
#pragma unroll
        for (int rr = 0; rr < 2; ++rr) { const int mm = rr ? m2 : m; if (rr == 1 && m2 == m) break; const bool meta = mm >= T;
#pragma unroll
            for (int j = 0; j < 8; ++j) { const f32x4 gg = *(const f32x4*)(lg + 256 * j + 4 * C.lane), bb = *(const f32x4*)(lb + 256 * j + 4 * C.lane);
                const f32x4 o = rr ? (vb[j] - meanb) * rstdb * gg + bb : (va[j] - meana) * rstda * gg + bb;
                if (meta) *(f32x4*)((float*)(ws + WS_HMETA) + (size_t)(mm - T) * DM + 256 * j + 4 * C.lane) = o;
                else { u32x2 w; w.x = cvt_pk_bf16(o.x, o.y); w.y = cvt_pk_bf16(o.z, o.w); *(u32x2*)(HBF + (size_t)mm * DM + 256 * j + 4 * C.lane) = w; } } }
    }
}

__device__ __forceinline__ void p1_meta_proj(const Ctx& C, unsigned char* ws) {
    const bf16_t* WinT = (const bf16_t*)(ws + WS_WIN); const float* HM = (const float*)(ws + WS_HMETA);
    const int gw = C.vcu * 8 + C.wave, NGW = C.G * 8;
    for (int it = gw; it < 640; it += NGW) {
        const int nidx = 4 * it; const int col0 = nidx < 512 ? nidx : (nidx < 1536 ? 1536 + (nidx - 512) : 2560 + (nidx - 1536));
        float acc[16][4];
#pragma unroll
        for (int r = 0; r < 16; ++r)
#pragma unroll
            for (int c = 0; c < 4; ++c) acc[r][c] = 0.f;
#pragma unroll 1
        for (int j = 0; j < 4; ++j) { const int k0 = j * 512 + C.lane * 8;
            f32x4 w0[4], w1[4];
#pragma unroll
            for (int c = 0; c < 4; ++c) { const u32x4 ww = *(const u32x4*)(WinT + (size_t)(col0 + c) * DM + k0); unpack8(ww, w0[c], w1[c]); }
#pragma unroll
            for (int r = 0; r < 16; ++r) { const f32x4 h0 = *(const f32x4*)(HM + r * DM + k0), h1 = *(const f32x4*)(HM + r * DM + k0 + 4);
#pragma unroll
                for (int c = 0; c < 4; ++c) { const f32x4 p = h0 * w0[c] + h1 * w1[c]; acc[r][c] += (p.x + p.y) + (p.z + p.w); } } }
        float mine = 0.f;
#pragma unroll
        for (int r = 0; r < 16; ++r)
#pragma unroll
            for (int c = 0; c < 4; ++c) { const float s = wave_sum(acc[r][c]); mine = (C.lane == r * 4 + c) ? s : mine; }
        const int r = C.lane >> 2, c = C.lane & 3;
        if (nidx < 512) ((float*)(ws + WS_UMETA))[r * SSMW + nidx + c] = mine;
        else if (nidx < 1536) ((bf16_t*)(ws + WS_KMETA))[r * AW + (nidx - 512) + c] = (bf16_t)(cvt_pk_bf16(mine, 0.f) & 0xffffu);
        else ((bf16_t*)(ws + WS_VMETA))[r * AW + (nidx - 1536) + c] = (bf16_t)(cvt_pk_bf16(mine, 0.f) & 0xffffu);
    }
}

__device__ __forceinline__ float gelu_tanh(float x) { const float u = 1.5957691216057308f * (x + 0.044715f * x * x * x); return x / (1.0f + __expf(-u)); }
#define SC_HANDOFF(Q) do { _Pragma("unroll") for (int st_ = 0; st_ < 2; ++st_) { \
        auto rr_ = __builtin_amdgcn_permlane32_swap(__float_as_uint(sre[st_]), __float_as_uint(sre[st_]), false, false); sre[st_] = __uint_as_float(rr_[(Q) & 1]); \
        auto ri_ = __builtin_amdgcn_permlane32_swap(__float_as_uint(sim[st_]), __float_as_uint(sim[st_]), false, false); sim[st_] = __uint_as_float(ri_[(Q) & 1]); } } while (0)
template <bool STORE> __device__ __forceinline__ void scan_block(f32x16 (&buv)[4], float (&sre)[2], float (&sim)[2], const float (&are)[2], const float (&aim)[2], int hi) {
    float bu[4][16];
#pragma unroll
    for (int t = 0; t < 4; ++t)
#pragma unroll
        for (int r = 0; r < 16; ++r) bu[t][r] = buv[t][r];
#pragma unroll
    for (int q = 0; q < 8; ++q) {
        const bool act = (hi == (q & 1));
#pragma unroll
        for (int i = 0; i < 4; ++i) { const int reg = 4 * (q >> 1) + i;
#pragma unroll
            for (int st = 0; st < 2; ++st) {
                const float nre = are[st] * sre[st] - aim[st] * sim[st] + bu[st][reg];
                const float nim = are[st] * sim[st] + aim[st] * sre[st] + bu[2 + st][reg];
                sre[st] = nre; sim[st] = nim;
                if (STORE) { bu[st][reg] = act ? nre : bu[st][reg]; bu[2 + st][reg] = act ? nim : bu[2 + st][reg]; } } }
        SC_HANDOFF(q);
    }
    if (STORE) {
#pragma unroll
        for (int t = 0; t < 4; ++t)
#pragma unroll
            for (int r = 0; r < 16; ++r) buv[t][r] = bu[t][r];
    }
}
__device__ __forceinline__ void p2_scan(const Ctx& C, const float* const* in, unsigned char* ws) {
    const int lane = C.lane, wave = C.wave, r32 = lane & 31, hi = lane >> 5, fr = lane & 15, fq = lane >> 4;
    const bf16_t* U = (const bf16_t*)(ws + WS_U); const float* UM = (const float*)(ws + WS_UMETA); bf16_t* YPRE = (bf16_t*)(ws + WS_YPRE);
    const float* AB = (const float*)(ws + WS_SSMAB); const float* BB = (const float*)(ws + WS_SSMBB);
    LAS unsigned char* Sl = C.lds + wave * 10752;
    LAS unsigned char* Yl = Sl + 9728;
    LAS float* E = (LAS float*)(C.lds + 86016);
    for (int item = C.vcu; item < NB_ * NGRP; item += C.G) {
        const int b = item >> 5, g = item & 31;
        const bf16_t* Ub = U + ((size_t)b * SEQ + wave * 256) * SSMW + 16 * g;
        bf16x8 ufa[8];
#pragma unroll
        for (int blk = 0; blk < 8; ++blk) ufa[blk] = *(const bf16x8*)(Ub + (size_t)(32 * blk + r32) * SSMW + 8 * hi);
        float are[2], aim[2];
#pragma unroll
        for (int st = 0; st < 2; ++st) { are[st] = AB[g * 64 + 32 * st + r32]; aim[st] = AB[NGRP * NST + g * 64 + 32 * st + r32]; }
        bf16x8 Bf[4];
#pragma unroll
        for (int ri = 0; ri < 2; ++ri)
#pragma unroll
            for (int st = 0; st < 2; ++st) { const float* src = BB + ri * (NGRP * NST * 16) + (g * 64 + 32 * st + r32) * 16 + 8 * hi;
                const f32x4 x0 = *(const f32x4*)src, x1 = *(const f32x4*)(src + 4); Bf[2 * ri + st] = __builtin_bit_cast(bf16x8, pack8(x0, x1)); }
        bf16x8 Cf[5];
#pragma unroll
        for (int ks = 0; ks < 4; ++ks) { const int k0 = 32 * ks + 8 * fq; const float* src = (ks < 2 ? in[10] : in[11]) + (g * 16 + fr) * 64 + (k0 & 63);
            f32x4 x0 = *(const f32x4*)src, x1 = *(const f32x4*)(src + 4); if (ks >= 2) { x0 = -x0; x1 = -x1; } Cf[ks] = __builtin_bit_cast(bf16x8, pack8(x0, x1)); }
        { const float dsk = in[12][g * 16 + fr]; f32x4 x0, x1;
#pragma unroll
          for (int j = 0; j < 4; ++j) { x0[j] = (fq < 2 && 8 * fq + j == fr) ? dsk : 0.f; x1[j] = (fq < 2 && 8 * fq + 4 + j == fr) ? dsk : 0.f; }
          Cf[4] = __builtin_bit_cast(bf16x8, pack8(x0, x1)); }
        float sre[2] = {0.f, 0.f}, sim[2] = {0.f, 0.f}, mre[2] = {0.f, 0.f}, mim[2] = {0.f, 0.f};
        if (wave == 0) {
            f32x4 x0 = (f32x4){0.f, 0.f, 0.f, 0.f}, x1 = x0;
            if (r32 >= 16) { const float* src = UM + (r32 - 16) * SSMW + 16 * g + 8 * hi; x0 = *(const f32x4*)src; x1 = *(const f32x4*)(src + 4); }
            const bf16x8 uf = __builtin_bit_cast(bf16x8, pack8(x0, x1));
            f32x16 bu[4];
#pragma unroll
            for (int t = 0; t < 4; ++t) bu[t] = __builtin_amdgcn_mfma_f32_32x32x16_bf16(uf, Bf[t], (f32x16){}, 0, 0, 0);
            scan_block<false>(bu, sre, sim, are, aim, hi);
            mre[0] = sre[0]; mre[1] = sre[1]; mim[0] = sim[0]; mim[1] = sim[1];
        }
#pragma unroll
        for (int blk = 0; blk < 8; ++blk) {
            f32x16 bu[4];
#pragma unroll
            for (int t = 0; t < 4; ++t) bu[t] = __builtin_amdgcn_mfma_f32_32x32x16_bf16(ufa[blk], Bf[t], (f32x16){}, 0, 0, 0);
            scan_block<false>(bu, sre, sim, are, aim, hi);
        }
        if (hi == 0) {
#pragma unroll
            for (int st = 0; st < 2; ++st) { E[wave * 128 + st * 64 + r32] = sre[st]; E[wave * 128 + st * 64 + 32 + r32] = sim[st]; } }
        __syncthreads();
        if (wave == 0) { sre[0] = mre[0]; sre[1] = mre[1]; sim[0] = mim[0]; sim[1] = mim[1]; }
        else {
            float pr[2], pi[2];
#pragma unroll
            for (int st = 0; st < 2; ++st) { pr[st] = are[st]; pi[st] = aim[st];
#pragma unroll
                for (int k = 0; k < 8; ++k) { const float nr = pr[st] * pr[st] - pi[st] * pi[st], ni = 2.f * pr[st] * pi[st]; pr[st] = nr; pi[st] = ni; }
                sre[st] = E[st * 64 + r32]; sim[st] = E[st * 64 + 32 + r32]; }
            for (int j = 1; j < wave; ++j) {
#pragma unroll
                for (int st = 0; st < 2; ++st) { const float er = E[j * 128 + st * 64 + r32], ei = E[j * 128 + st * 64 + 32 + r32];
                    const float nr = pr[st] * sre[st] - pi[st] * sim[st] + er, ni = pr[st] * sim[st] + pi[st] * sre[st] + ei; sre[st] = nr; sim[st] = ni; } }
        }
#pragma unroll
        for (int blk = 0; blk < 8; ++blk) {
            f32x16 bu[4];
#pragma unroll
            for (int t = 0; t < 4; ++t) bu[t] = __builtin_amdgcn_mfma_f32_32x32x16_bf16(ufa[blk], Bf[t], (f32x16){}, 0, 0, 0);
            scan_block<true>(bu, sre, sim, are, aim, hi);
#pragma unroll
            for (int reg = 0; reg < 16; ++reg) { const int tok = (reg & 3) + 8 * (reg >> 2) + 4 * hi;
#pragma unroll
                for (int t = 0; t < 4; ++t) *(LAS bf16_t*)(Sl + tok * 304 + (32 * t + r32) * 2) = (bf16_t)(cvt_pk_bf16(bu[t][reg], 0.f) & 0xffffu); }
            *(LAS bf16x8*)(Sl + r32 * 304 + (128 + 8 * hi) * 2) = ufa[blk];
            f32x4 y[2];
#pragma unroll
            for (int mt = 0; mt < 2; ++mt) { y[mt] = (f32x4){0.f, 0.f, 0.f, 0.f};
#pragma unroll
                for (int ks = 0; ks < 4; ++ks) { const bf16x8 af = *(const LAS bf16x8*)(Sl + (16 * mt + fr) * 304 + (32 * ks + 8 * fq) * 2);
                    y[mt] = __builtin_amdgcn_mfma_f32_16x16x32_bf16(af, Cf[ks], y[mt], 0, 0, 0); }
                bf16x8 au = *(const LAS bf16x8*)(Sl + (16 * mt + fr) * 304 + (128 + 8 * (fq & 1)) * 2); if (fq >= 2) au = (bf16x8){};
                y[mt] = __builtin_amdgcn_mfma_f32_16x16x32_bf16(au, Cf[4], y[mt], 0, 0, 0); }
#pragma unroll
            for (int mt = 0; mt < 2; ++mt)
#pragma unroll
                for (int reg = 0; reg < 4; ++reg) *(LAS bf16_t*)(Yl + (16 * mt + 4 * fq + reg) * 32 + fr * 2) = (bf16_t)(cvt_pk_bf16(gelu_tanh(y[mt][reg]), 0.f) & 0xffffu);
            const u32x4 yo = *(const LAS u32x4*)(Yl + (lane >> 1) * 32 + (lane & 1) * 16);
            *(u32x4*)(YPRE + ((size_t)b * SEQ + wave * 256 + 32 * blk + (lane >> 1)) * SSMW + 16 * g + 8 * (lane & 1)) = yo;
        }
        __syncthreads();
    }
}

__device__ __forceinline__ int crow(int r, int hi) { return (r & 3) + 8 * (r >> 2) + 4 * hi; }
typedef short v4i16_t __attribute__((ext_vector_type(4)));
__device__ __forceinline__ s16x4 vtr(const LAS unsigned char* p) { return __builtin_bit_cast(s16x4, __builtin_amdgcn_ds_read_tr16_b64_v4i16((LAS v4i16_t*)p)); }
__device__ __forceinline__ float half_swap_max(float x) { auto rr = __builtin_amdgcn_permlane32_swap(__float_as_uint(x), __float_as_uint(x), false, false); return fmaxf(__uint_as_float(rr[0]), __uint_as_float(rr[1])); }
__device__ __forceinline__ float half_swap_sum(float x) { auto rr = __builtin_amdgcn_permlane32_swap(__float_as_uint(x), __float_as_uint(x), false, false); return __uint_as_float(rr[0]) + __uint_as_float(rr[1]); }

__device__ __forceinline__ void attn_pv(f32x16 (&o)[4], const bf16x8 (&pa)[4], unsigned vaddr) {
    s16x4 vl[2][4], vh[2][4];
#define ATT_VRD(SET, D) do { _Pragma("unroll") for (int ks_ = 0; ks_ < 4; ++ks_) { \
        asm volatile("ds_read_b64_tr_b16 %0, %1 offset:%2" : "=&v"(vl[SET][ks_]) : "v"(vaddr), "i"((D) * 4096 + ks_ * 1024) : "memory"); \
        asm volatile("ds_read_b64_tr_b16 %0, %1 offset:%2" : "=&v"(vh[SET][ks_]) : "v"(vaddr), "i"((D) * 4096 + ks_ * 1024 + 512) : "memory"); } } while (0)
    __builtin_amdgcn_sched_barrier(0);
    ATT_VRD(0, 0);
#pragma unroll
    for (int d = 0; d < 4; ++d) {
        if (d == 0) { ATT_VRD(1, 1); } else if (d == 1) { ATT_VRD(0, 2); } else if (d == 2) { ATT_VRD(1, 3); }
        if (d < 3) asm volatile("s_waitcnt lgkmcnt(8)" ::: "memory"); else asm volatile("s_waitcnt lgkmcnt(0)" ::: "memory");
        __builtin_amdgcn_sched_barrier(0);
#pragma unroll
        for (int ks = 0; ks < 4; ++ks) { const s16x4 lo = vl[d & 1][ks], hv = vh[d & 1][ks];
            const bf16x8 vf = (bf16x8){lo[0], lo[1], lo[2], lo[3], hv[0], hv[1], hv[2], hv[3]};
            o[d] = __builtin_amdgcn_mfma_f32_32x32x16_bf16(pa[ks], vf, o[d], 0, 0, 0); }
        __builtin_amdgcn_sched_barrier(0);
    }
#undef ATT_VRD
}
__device__ __forceinline__ void attn_qk(f32x16& p0, f32x16& p1, const LAS unsigned char* kb, const bf16x8 (&qr)[4]) {
    p0 = (f32x16){}; p1 = (f32x16){};
#pragma unroll
    for (int d0 = 0; d0 < 4; ++d0) { const bf16x8 b0 = *(const LAS bf16x8*)(kb + d0 * 2048), b1 = *(const LAS bf16x8*)(kb + d0 * 2048 + 512);
        p0 = __builtin_amdgcn_mfma_f32_32x32x16_bf16(b0, qr[d0], p0, 0, 0, 0); p1 = __builtin_amdgcn_mfma_f32_32x32x16_bf16(b1, qr[d0], p1, 0, 0, 0); }
}
__device__ __forceinline__ void attn_softmax(const bool FIRST, f32x16& p0, f32x16& p1, f32x16 (&o)[4], float& mrun, float& lrun, bf16x8 (&pa)[4], LAS float* wsf, int r32, int hi) {
    if (FIRST) {
        asm volatile("" ::: "memory");
#pragma unroll
        for (int r = 0; r < 16; ++r) { if (r >= 8) p0[r] = -__builtin_inff(); p1[r] = -__builtin_inff(); } }
    float rmA = fmaxf(p0[0], p0[1]), rmB = fmaxf(p0[2], p0[3]), rmC = fmaxf(p1[0], p1[1]), rmD = fmaxf(p1[2], p1[3]);
#pragma unroll
    for (int r = 4; r < 16; r += 4) { rmA = fmaxf(rmA, fmaxf(p0[r], p0[r + 1])); rmB = fmaxf(rmB, fmaxf(p0[r + 2], p0[r + 3])); rmC = fmaxf(rmC, fmaxf(p1[r], p1[r + 1])); rmD = fmaxf(rmD, fmaxf(p1[r + 2], p1[r + 3])); }
    const float rm = half_swap_max(fmaxf(fmaxf(rmA, rmB), fmaxf(rmC, rmD)));
    if (FIRST) mrun = rm;
    else if (__any(rm > mrun + 8.0f)) {
        const float mnew = fmaxf(mrun, rm), alpha = __builtin_amdgcn_exp2f(mrun - mnew);
        lrun *= alpha; mrun = mnew;
        if (hi == 0) wsf[r32] = alpha;
        f32x4 a4[4];
#pragma unroll
        for (int gq = 0; gq < 4; ++gq) a4[gq] = *(const LAS f32x4*)(wsf + 8 * gq + 4 * hi);
#pragma unroll
        for (int d = 0; d < 4; ++d)
#pragma unroll
            for (int r = 0; r < 16; ++r) o[d][r] *= a4[r >> 2][r & 3];
    }
    float psA = 0.f, psB = 0.f, psC = 0.f, psD = 0.f;
#pragma unroll
    for (int r = 0; r < 16; r += 2) { p0[r] = __builtin_amdgcn_exp2f(p0[r] - mrun); p0[r + 1] = __builtin_amdgcn_exp2f(p0[r + 1] - mrun); p1[r] = __builtin_amdgcn_exp2f(p1[r] - mrun); p1[r + 1] = __builtin_amdgcn_exp2f(p1[r + 1] - mrun);
        psA += p0[r]; psB += p0[r + 1]; psC += p1[r]; psD += p1[r + 1]; }
    lrun += (psA + psB) + (psC + psD);
    u32x4 w;
    w = (u32x4){cvt_pk_bf16(p0[0], p0[1]), cvt_pk_bf16(p0[2], p0[3]), cvt_pk_bf16(p0[4], p0[5]), cvt_pk_bf16(p0[6], p0[7])}; pa[0] = __builtin_bit_cast(bf16x8, w);
    w = (u32x4){cvt_pk_bf16(p0[8], p0[9]), cvt_pk_bf16(p0[10], p0[11]), cvt_pk_bf16(p0[12], p0[13]), cvt_pk_bf16(p0[14], p0[15])}; pa[1] = __builtin_bit_cast(bf16x8, w);
    w = (u32x4){cvt_pk_bf16(p1[0], p1[1]), cvt_pk_bf16(p1[2], p1[3]), cvt_pk_bf16(p1[4], p1[5]), cvt_pk_bf16(p1[6], p1[7])}; pa[2] = __builtin_bit_cast(bf16x8, w);
    w = (u32x4){cvt_pk_bf16(p1[8], p1[9]), cvt_pk_bf16(p1[10], p1[11]), cvt_pk_bf16(p1[12], p1[13]), cvt_pk_bf16(p1[14], p1[15])}; pa[3] = __builtin_bit_cast(bf16x8, w);
}
__device__ __forceinline__ void glds16(const void* gsrc, unsigned lds_dst) { unsigned keep;
    asm volatile("s_mov_b32 %0, m0\n\ts_mov_b32 m0, %2\n\ts_nop 0\n\tglobal_load_lds_dwordx4 %1, off\n\ts_mov_b32 m0, %0" : "=&s"(keep) : "v"(gsrc), "s"(lds_dst) : "memory"); }
__device__ __forceinline__ void attn_unit(const Ctx& C, const bf16_t* Qg, const bf16_t* Kg, const bf16_t* Vg, const bf16_t* KM, const bf16_t* VM, bf16_t* Y,
                                          const float* subg, float lam, int b, int h, int qt, bool prefetched, int nqt, bf16x8 (&qr)[4], bool rb) {
    LAS unsigned char* lds = C.lds;
    const int lane = C.lane, wave = C.wave, r32 = lane & 31, hi = lane >> 5, qb = wave >> 1, map = wave & 1;
    const int q0 = qt * 128 + qb * 32;
    const size_t rowb = (size_t)b * SEQ;
    if (!prefetched) { const bf16_t* qp = Qg + (rowb + q0 + r32) * AW + h * 128 + map * 64 + hi * 8;
#pragma unroll
      for (int d0 = 0; d0 < 4; ++d0) qr[d0] = *(const bf16x8*)(qp + d0 * 16); }
    const int NT = 2 * qt + 3;
    const bool skip_last = (qb < 2);
    f32x16 o[4];
#pragma unroll
    for (int d = 0; d < 4; ++d) o[d] = (f32x16){};
    float mrun = -__builtin_inff(), lrun = 0.f;
    LAS float* wsf = (LAS float*)(lds + MISC_OFF + 4096 + wave * 256);
    const bf16_t* Kb = Kg + rowb * AW; const bf16_t* Vb = Vg + rowb * AW;
#define ATT_DMA(step, stage) do { const bf16_t* ks_ = (step) == 0 ? KM : Kb; const bf16_t* vs_ = (step) == 0 ? VM : Vb; const int row0_ = (step) == 0 ? 0 : ((step) - 1) * 64; \
    _Pragma("unroll") for (int i_ = 0; i_ < 2; ++i_) { const int p_ = 2 * wave + i_; \
        __builtin_amdgcn_global_load_lds((const unsigned*)(ks_ + (size_t)(row0_ + lane) * AW + h * 128 + (p_ >> 3) * 64 + (p_ & 7) * 8), (LAS unsigned*)(lds + (stage) * 32768 + p_ * 1024), 16, 0, 0); \
        __builtin_amdgcn_global_load_lds((const unsigned*)(vs_ + (size_t)(row0_ + 16 * (p_ & 3) + (lane >> 2)) * AW + h * 128 + (p_ >> 2) * 32 + (lane & 3) * 8), (LAS unsigned*)(lds + (stage) * 32768 + 16384 + p_ * 1024), 16, 0, 0); } } while (0)
    const int myNT = skip_last ? NT - 1 : NT;
    bf16x8 pa[4];
#pragma unroll
    for (int k = 0; k < 4; ++k) pa[k] = (bf16x8){};
    if (!prefetched) ATT_DMA(0, 0);
    asm volatile("s_waitcnt vmcnt(0)" ::: "memory"); __syncthreads();
    int stage = 0;
#pragma unroll 1
    for (int s = 0; s <= NT; ++s) {
        const int stn = stage == 2 ? 0 : stage + 1, stp = stage == 0 ? 2 : stage - 1;
        if (s + 1 < NT) ATT_DMA(s + 1, stn);
        if (rb && s >= 1 && s <= myNT) attn_pv(o, pa, (unsigned)(uintptr_t)(lds + stp * 32768 + 16384 + ((lane >> 4) & 1) * 32 + (lane & 3) * 8 + (4 * hi + ((lane & 15) >> 2)) * 64));
        if (s < myNT) {
            f32x16 p0, p1; attn_qk(p0, p1, lds + stage * 32768 + map * 8192 + hi * 1024 + r32 * 16, qr);
            attn_softmax(s == 0, p0, p1, o, mrun, lrun, pa, wsf, r32, hi);
            if (!rb) attn_pv(o, pa, (unsigned)(uintptr_t)(lds + stage * 32768 + 16384 + ((lane >> 4) & 1) * 32 + (lane & 3) * 8 + (4 * hi + ((lane & 15) >> 2)) * 64));
        }
        asm volatile("s_waitcnt vmcnt(0)" ::: "memory"); __syncthreads();
        stage = stn;
    }
#undef ATT_DMA
    bf16x8 qn[4];
#pragma unroll
    for (int d0 = 0; d0 < 4; ++d0) qn[d0] = qr[d0];
    if (nqt >= 0) {
        const unsigned lds0 = (unsigned)(uintptr_t)lds;
#pragma unroll
        for (int i = 0; i < 2; ++i) { const int p = 2 * wave + i;
            glds16(KM + (size_t)lane * AW + h * 128 + (p >> 3) * 64 + (p & 7) * 8, (unsigned)__builtin_amdgcn_readfirstlane(lds0 + p * 1024));
            glds16(VM + (size_t)(16 * (p & 3) + (lane >> 2)) * AW + h * 128 + (p >> 2) * 32 + (lane & 3) * 8, (unsigned)__builtin_amdgcn_readfirstlane(lds0 + 16384 + p * 1024)); }
        const bf16_t* qp = Qg + (rowb + nqt * 128 + qb * 32 + r32) * AW + h * 128 + map * 64 + hi * 8;
#pragma unroll
        for (int d0 = 0; d0 < 4; ++d0) qn[d0] = *(const bf16x8*)(qp + d0 * 16);
    }
    { const float ltot = half_swap_sum(lrun); const float inv = (map ? lam : 1.0f) / ltot;
      if (hi == 0) wsf[r32] = inv;
      f32x4 a4[4];
#pragma unroll
      for (int gq = 0; gq < 4; ++gq) a4[gq] = *(const LAS f32x4*)(wsf + 8 * gq + 4 * hi);
#pragma unroll
      for (int d = 0; d < 4; ++d)
#pragma unroll
          for (int r = 0; r < 16; ++r) o[d][r] *= a4[r >> 2][r & 3]; }
    LAS float* X = (LAS float*)(lds + 32768 + qb * 16384);
    if (map == 1) {
#pragma unroll
        for (int d = 0; d < 4; ++d)
#pragma unroll
            for (int r = 0; r < 16; ++r) X[crow(r, hi) * 128 + 32 * d + r32] = o[d][r];
    }
    __syncthreads();
    if (map == 0) {
        float ssq[16];
#pragma unroll
        for (int r = 0; r < 16; ++r) ssq[r] = 0.f;
#pragma unroll
        for (int d = 0; d < 4; ++d)
#pragma unroll
            for (int r = 0; r < 16; ++r) { const float v = o[d][r] - X[crow(r, hi) * 128 + 32 * d + r32]; o[d][r] = v; ssq[r] += v * v; }
#pragma unroll
        for (int r = 0; r < 16; ++r) {
#pragma unroll
            for (int off = 1; off < 32; off <<= 1) ssq[r] += __shfl_xor(ssq[r], off);
            ssq[r] = 0.8f / sqrtf(ssq[r] * (1.f / 128.f) + LN_EPS); }
        LAS bf16_t* Yt = (LAS bf16_t*)X;
#pragma unroll
        for (int d = 0; d < 4; ++d) { const float gg = subg[32 * d + r32];
#pragma unroll
            for (int r = 0; r < 16; ++r) Yt[crow(r, hi) * 128 + 32 * d + r32] = (bf16_t)(cvt_pk_bf16(o[d][r] * ssq[r] * gg, 0.f) & 0xffffu); }
#pragma unroll
        for (int i = 0; i < 8; ++i) { const int id = i * 64 + lane, row = id >> 4, ch = id & 15;
            *(u32x4*)(Y + (rowb + q0 + row) * AW + h * 128 + ch * 8) = *(const LAS u32x4*)(Yt + row * 128 + ch * 8); }
    }
#pragma unroll
    for (int d0 = 0; d0 < 4; ++d0) qr[d0] = qn[d0];
    __syncthreads();
}
__device__ __forceinline__ void p3_attention(const Ctx& C, const float* const* in, unsigned char* ws) {
    const bf16_t* Q = (const bf16_t*)(ws + WS_Q); const bf16_t* K = (const bf16_t*)(ws + WS_K); const bf16_t* V = (const bf16_t*)(ws + WS_V);
    const bf16_t* KM = (const bf16_t*)(ws + WS_KMETA); const bf16_t* VM = (const bf16_t*)(ws + WS_VMETA); bf16_t* Y = (bf16_t*)(ws + WS_YATT);
    const float l1 = wave_sum(in[14][C.lane] * in[15][C.lane]), l2 = wave_sum(in[16][C.lane] * in[17][C.lane]);
    const float lam = expf(l1) - expf(l2) + 0.2f;
    LAS unsigned* rc = (LAS unsigned*)(C.lds + MISC_OFF + 6144);
    if (C.tid < 4) rc[C.tid] = 0;
    __syncthreads();
    bool rb;
    { const unsigned simd = (unsigned)__builtin_amdgcn_s_getreg(2308) & 3u;
      unsigned r = 0; if (C.lane == 0) r = __hip_atomic_fetch_add(rc + simd, 1u, __ATOMIC_RELAXED, __HIP_MEMORY_SCOPE_WORKGROUP);
      rb = (__builtin_amdgcn_readfirstlane((int)r) & 1) != 0; }
#ifndef ATT_REP
#define ATT_REP 1
#endif
    for (int vv = C.vcu; vv < 256 * ATT_REP; vv += C.G) { const int v = vv & 255;
        const int bh = v >> 1, sft = v & 1;
        bf16x8 qr[4];
#pragma unroll
        for (int d0 = 0; d0 < 4; ++d0) qr[d0] = (bf16x8){};
#pragma unroll 1
        for (int i = 0; i < 8; ++i) { const int qt = (i & 1) ? (15 - sft - (i & ~1)) : (sft + (i & ~1)); const int i1 = i + 1;
            const int nqt = i1 < 8 ? ((i1 & 1) ? (15 - sft - (i1 & ~1)) : (sft + (i1 & ~1))) : -1;
            attn_unit(C, Q, K, V, KM, VM, Y, in[18], lam, bh >> 3, bh & 7, qt, i > 0, nqt, qr, rb); }
    }
}

__device__ __forceinline__ void p6_ln1_router(const Ctx& C, const float* const* in, unsigned char* ws) {
    const int lane = C.lane, wave = C.wave, tid = C.tid;
    const bf16_t* Z = (const bf16_t*)(ws + WS_Z); bf16_t* H1 = (bf16_t*)(ws + WS_H1); const float* WrT = (const float*)(ws + WS_WRT);
    int* LIST = (int*)(ws + WS_LIST); float* WGT = (float*)(ws + WS_WGT); unsigned* ECNT = (unsigned*)(ws + WS_CTL) + CW_ECNT;
    const float* lg = in[22]; const float* lb = in[23];
    LAS float* WB = (LAS float*)C.lds;
    LAS unsigned char* XB = C.lds + 98304;
    LAS int* RE = (LAS int*)(XB);
    LAS float* RW = (LAS float*)(XB + 1024);
    LAS int* CL = (LAS int*)(XB + 2048);
    LAS int* BS = (LAS int*)(XB + 2048 + 128);
    LAS int* SL = (LAS int*)(XB + 2048 + 256);
    LAS float* LG = (LAS float*)(XB + 4096) + wave * 80;
    for (int rbk = C.vcu; rbk < T / 128; rbk += C.G) {
        if (tid < 32) CL[tid] = 0;
#pragma unroll 1
        for (int step = 0; step < 8; ++step) {
            const int lr0 = step * 16 + 2 * wave; const size_t row0 = (size_t)rbk * 128 + lr0;
            int l4 = 4 * lane; asm volatile("" : "+v"(l4));
            f32x4 v0[8], v1[8];
#pragma unroll
            for (int j = 0; j < 8; ++j) { const u32x2 z0 = *(const u32x2*)(Z + row0 * DM + 256 * j + l4), z1 = *(const u32x2*)(Z + (row0 + 1) * DM + 256 * j + l4);
                v0[j] = (f32x4){bf_lo(z0.x), bf_hi(z0.x), bf_lo(z0.y), bf_hi(z0.y)}; v1[j] = (f32x4){bf_lo(z1.x), bf_hi(z1.x), bf_lo(z1.y), bf_hi(z1.y)}; }
            float mean0, rstd0, mean1, rstd1; ln_stats(v0, mean0, rstd0); ln_stats(v1, mean1, rstd1);
#pragma unroll
            for (int j = 0; j < 8; ++j) { const f32x4 gg = *(const f32x4*)(lg + 256 * j + l4), bb = *(const f32x4*)(lb + 256 * j + l4);
                v0[j] = (v0[j] - mean0) * rstd0 * gg + bb; v1[j] = (v1[j] - mean1) * rstd1 * gg + bb;
                u32x2 w; w.x = cvt_pk_bf16(v0[j].x, v0[j].y); w.y = cvt_pk_bf16(v0[j].z, v0[j].w); *(u32x2*)(H1 + row0 * DM + 256 * j + l4) = w;
                w.x = cvt_pk_bf16(v1[j].x, v1[j].y); w.y = cvt_pk_bf16(v1[j].z, v1[j].w); *(u32x2*)(H1 + (row0 + 1) * DM + 256 * j + l4) = w; }
#pragma unroll 1
            for (int ng = 0; ng < 3; ++ng) {
                __syncthreads();
                int tq = tid; asm volatile("" : "+v"(tq));
#pragma unroll
                for (int i = 0; i < 12; ++i) { const int idx = tq + 512 * i, n = idx >> 9, c4 = idx & 511;
                    *(LAS f32x4*)(WB + n * 2048 + 4 * c4) = *(const f32x4*)(WrT + (size_t)(12 * ng + n) * DM + 4 * c4); }
                __syncthreads();
#pragma unroll 1
                for (int n = 0; n < 12; ++n) { float pa = 0.f, pb = 0.f;
#pragma unroll
                    for (int j = 0; j < 8; ++j) { const f32x4 w4 = *(const LAS f32x4*)(WB + n * 2048 + 256 * j + l4);
                        const f32x4 a = v0[j] * w4, bq = v1[j] * w4; pa += (a.x + a.y) + (a.z + a.w); pb += (bq.x + bq.y) + (bq.z + bq.w); }
                    const float sa = wave_sum(pa), sb = wave_sum(pb); if (lane == 0) { LG[12 * ng + n] = sa; LG[40 + 12 * ng + n] = sb; } }
            }
            if (lane < 2) {
                const LAS float* L = LG + 40 * lane;
                int gi = 0; float gm = L[0] + in[25][0];
                for (int n = 1; n < 4; ++n) { const float x = L[n] + in[25][n]; if (x > gm) { gm = x; gi = n; } }
                float gs = 0.f;
                for (int n = 0; n < 4; ++n) gs += __expf(L[n] + in[25][n] - gm);
                const float gval = 1.0f / gs;
                int i1 = 0; float m1 = L[4 + gi * 8] + in[27][gi * 8];
                for (int j = 1; j < 8; ++j) { const float x = L[4 + gi * 8 + j] + in[27][gi * 8 + j]; if (x > m1) { m1 = x; i1 = j; } }
                int i2 = -1; float m2 = -__builtin_inff();
                for (int j = 0; j < 8; ++j) { const float x = L[4 + gi * 8 + j] + in[27][gi * 8 + j]; if (j != i1 && x > m2) { m2 = x; i2 = j; } }
                const float tt = __expf(m2 - m1), w1 = gval / (1.f + tt), w2 = gval * tt / (1.f + tt);
                const int lr = lr0 + lane; RE[lr * 2] = gi * 8 + i1; RE[lr * 2 + 1] = gi * 8 + i2; RW[lr * 2] = w1; RW[lr * 2 + 1] = w2;
            }
        }
        __syncthreads();
        int e = 0;
        if (tid < 256) { e = RE[tid]; SL[tid] = __hip_atomic_fetch_add(&CL[e], 1, __ATOMIC_RELAXED, __HIP_MEMORY_SCOPE_WORKGROUP); }
        __syncthreads();
        if (tid < 32) BS[tid] = (int)__hip_atomic_fetch_add(&ECNT[tid], (unsigned)CL[tid], __ATOMIC_RELAXED, __HIP_MEMORY_SCOPE_AGENT);
        __syncthreads();
        if (tid < 256) { const int entry = (rbk * 128 + (tid >> 1)) * 2 + (tid & 1); LIST[(size_t)e * CAP + BS[e] + SL[tid]] = entry; WGT[entry] = RW[tid]; }
        __syncthreads();
    }
}

__device__ __forceinline__ void p9_ln2(const Ctx& C, const float* const* in, unsigned char* ws, float* out) {
    const bf16_t* H1 = (const bf16_t*)(ws + WS_H1); const bf16_t* YK = (const bf16_t*)(ws + WS_YK);
    const float* lg = in[31]; const float* lb = in[32];
    const int gw = C.vcu * 8 + C.wave, NGW = C.G * 8, lane = C.lane;
    for (int m = gw; m < T; m += 2 * NGW) {
        const int m2 = (m + NGW < T) ? m + NGW : m;
        u32x2 ha[8], ya0[8], ya1[8], hb[8], yb0[8], yb1[8];
#pragma unroll
        for (int j = 0; j < 8; ++j) { const size_t c = 256 * j + 4 * lane;
            ha[j] = *(const u32x2*)(H1 + (size_t)m * DM + c); ya0[j] = *(const u32x2*)(YK + (size_t)(2 * m) * DM + c); ya1[j] = *(const u32x2*)(YK + (size_t)(2 * m + 1) * DM + c);
            hb[j] = *(const u32x2*)(H1 + (size_t)m2 * DM + c); yb0[j] = *(const u32x2*)(YK + (size_t)(2 * m2) * DM + c); yb1[j] = *(const u32x2*)(YK + (size_t)(2 * m2 + 1) * DM + c); }
#pragma unroll
        for (int rr = 0; rr < 2; ++rr) {
            f32x4 v[8];
#pragma unroll
            for (int j = 0; j < 8; ++j) { const u32x2 hw = rr ? hb[j] : ha[j], y0 = rr ? yb0[j] : ya0[j], y1 = rr ? yb1[j] : ya1[j];
                v[j] = (f32x4){bf_lo(hw.x), bf_hi(hw.x), bf_lo(hw.y), bf_hi(hw.y)} * ALPHA + (f32x4){bf_lo(y0.x), bf_hi(y0.x), bf_lo(y0.y), bf_hi(y0.y)} + (f32x4){bf_lo(y1.x), bf_hi(y1.x), bf_lo(y1.y), bf_hi(y1.y)}; }
            float mean, rstd; ln_stats(v, mean, rstd);
            const int mm = rr ? m2 : m;
            if (rr == 0 || m2 != m) {
#pragma unroll
                for (int j = 0; j < 8; ++j) { const f32x4 gg = *(const f32x4*)(lg + 256 * j + 4 * lane), bb = *(const f32x4*)(lb + 256 * j + 4 * lane);
                    *(f32x4*)(out + (size_t)mm * DM + 256 * j + 4 * lane) = (v[j] - mean) * rstd * gg + bb; } }
        }
    }
}

__device__ __forceinline__ int build_moe_tables(const Ctx& C, unsigned char* ws) {
    LAS int* blkstart = (LAS int*)(C.lds + MISC_OFF + 64); LAS int* cntE = (LAS int*)(C.lds + MISC_OFF + 320); LAS int* blkexp = (LAS int*)(C.lds + MISC_OFF + 512);
    unsigned* ECNT = (unsigned*)(ws + WS_CTL) + CW_ECNT;
    __syncthreads();
    if (C.tid < 32) cntE[C.tid] = (int)__hip_atomic_load(&ECNT[C.tid], __ATOMIC_RELAXED, __HIP_MEMORY_SCOPE_AGENT);
    __syncthreads();
    if (C.tid == 0) { int s = 0; for (int e = 0; e < NE; ++e) { blkstart[e] = s; s += (cntE[e] + 255) >> 8; } blkstart[NE] = s; }
    __syncthreads();
    const int NBLK = blkstart[NE];
    if (C.tid < NBLK && C.tid < 320) { int e = 0; for (int j = 1; j < NE; ++j) if (blkstart[j] <= C.tid) e = j; blkexp[C.tid] = e; }
    __syncthreads();
    return NBLK < 320 ? NBLK : 320;
}

__device__ __forceinline__ void p7_convert_down(const Ctx& C, const float* const* in, unsigned char* ws) {
    LAS float* scr = (LAS float*)(C.lds + C.wave * 16384);
    unsigned* ctr = (unsigned*)(ws + WS_CTL) + CW_CONV; bf16_t* WdnT = (bf16_t*)(ws + WS_WDN);
    constexpr int NCH = NE * 512 / 16;
    for (;;) {
        unsigned ch = 0; if (C.lane == 0) ch = __hip_atomic_fetch_add(ctr, 1u, __ATOMIC_RELAXED, __HIP_MEMORY_SCOPE_AGENT);
        ch = (unsigned)__builtin_amdgcn_readfirstlane((int)ch);
        if (ch >= (unsigned)NCH) break;
#pragma unroll 1
        for (int q = 0; q < 16; ++q) { const int r = (int)ch * 16 + q, e = r >> 9, rr = r & 511, kb = rr >> 6, nb = rr & 63;
            transpose_item(in[30] + (size_t)e * DFF * DM, DFF, DM, WdnT, kb, nb, e * 2048 + 32 * nb, scr, C.lane); }
    }
}

constexpr int NPHASE = 10;
struct Args { const float* in[33]; float* out; unsigned char* ws; int ph_lo, ph_hi; };
__global__ void __launch_bounds__(512, 2) mk_fwd(Args args) {
    extern __shared__ __attribute__((aligned(16))) unsigned char lds_raw[];
    Ctx C; C.lds = (LAS unsigned char*)lds_raw; C.tid = threadIdx.x; C.lane = C.tid & 63; C.wave = __builtin_amdgcn_readfirstlane(C.tid >> 6);
    C.G = gridDim.x; { const int bx = blockIdx.x; C.vcu = (C.G % 8 == 0) ? (bx % 8) * (C.G / 8) + bx / 8 : bx; }
    unsigned char* ws = args.ws; const float* const* in = args.in;
    volatile LAS unsigned* MISC = (volatile LAS unsigned*)(C.lds + MISC_OFF);
    if (C.tid < 16) MISC[C.tid] = 0u;
    __syncthreads();
    unsigned* barw = (unsigned*)(ws + WS_CTL) + CW_BAR;
    XcdBarrier bar; bar.bar = barw; bar.x = 0; bar.st = nullptr;
    const int lo = args.ph_lo, hi = args.ph_hi;
    if (hi - lo > 1) bar = xcd_barrier_post(barw, MISC);
#ifndef PH_MASK
#define PH_MASK 0x3ff
#endif
#define IN(k) (((PH_MASK >> (k)) & 1) && lo <= (k) && (k) < hi)
#define SEAM(k) do { if (IN(k) && IN((k) + 1)) xcd_barrier(bar); } while (0)
#ifndef WGM_PROJ
#define WGM_PROJ 4
#endif
#ifndef WGM_N2K
#define WGM_N2K 2
#endif
#ifndef GEMM_SP2
#define GEMM_SP2 true
#endif
#ifndef GEMM_ALIGN
#define GEMM_ALIGN true
#endif
#ifndef PROBE_MASK
#define PROBE_MASK 0
#endif
#define REPS(k) (((PROBE_MASK >> (k)) & 1) ? 2 : 1)
#define REPSEAM(k, rep) do { if ((rep) + 1 < REPS(k)) xcd_barrier(bar); } while (0)
    LAS unsigned char* lds = C.lds;
    bf16_t* MG = (bf16_t*)args.out;

    if (IN(0)) { _Pragma("unroll") for (int rep = 0; rep < REPS(0); ++rep) { p0_prologue(C, in, ws); REPSEAM(0, rep); } } SEAM(0);

    if (IN(1)) { _Pragma("unroll") for (int rep = 0; rep < REPS(1); ++rep) {
        pg8::Gemm g{(const bf16_t*)(ws + WS_HBF), (const bf16_t*)(ws + WS_WIN), T, INC, DM, nullptr, nullptr, 0}; pg8::StaticOrder S; S.init(T, INC, C.G, (int)blockIdx.x, WGM_PROJ);
        EpiProj E{(bf16_t*)(ws + WS_U), (bf16_t*)(ws + WS_Q), (bf16_t*)(ws + WS_K), (bf16_t*)(ws + WS_V), (bf16_t*)(ws + WS_SGS), (bf16_t*)(ws + WS_SGA)};
        pg8::gemm_phase<EpiProj, pg8::StaticOrder, GEMM_ALIGN, GEMM_SP2, false>(lds, g, S, E);
        p1_meta_proj(C, ws);
        REPSEAM(1, rep);
    } } SEAM(1);

    if (IN(2)) { _Pragma("unroll") for (int rep = 0; rep < REPS(2); ++rep) { p2_scan(C, in, ws); REPSEAM(2, rep); } } SEAM(2);

    if (IN(3)) { _Pragma("unroll") for (int rep = 0; rep < REPS(3); ++rep) {
        { pg8::Gemm g{(const bf16_t*)(ws + WS_YPRE), (const bf16_t*)(ws + WS_WGLU), T, SSMW, SSMW, nullptr, nullptr, 0}; pg8::StaticOrder S; S.init(T, SSMW, C.G, (int)blockIdx.x);
          EpiGlu E{(const bf16_t*)(ws + WS_YPRE), (bf16_t*)(ws + WS_YSSM)};
          pg8::gemm_phase<EpiGlu, pg8::StaticOrder, GEMM_ALIGN, GEMM_SP2, false>(lds, g, S, E); }
        p3_attention(C, in, ws);
        REPSEAM(3, rep);
    } } SEAM(3);

    if (IN(4)) { _Pragma("unroll") for (int rep = 0; rep < REPS(4); ++rep) {
        { pg8::Gemm g{(const bf16_t*)(ws + WS_YSSM), (const bf16_t*)(ws + WS_WBS), T, DM, SSMW, (const bf16_t*)(ws + WS_YATT), (const bf16_t*)(ws + WS_WBA), AW}; pg8::StaticOrder S; S.init(T, DM, C.G, (int)blockIdx.x, WGM_N2K);
          EpiMergeF E{(const bf16_t*)(ws + WS_SGS), (const bf16_t*)(ws + WS_SGA), MG};
          pg8::gemm_phase<EpiMergeF, pg8::StaticOrder, GEMM_ALIGN, GEMM_SP2, false, true>(lds, g, S, E); }
        REPSEAM(4, rep);
    } } SEAM(4);

    if (IN(5)) { _Pragma("unroll") for (int rep = 0; rep < REPS(5); ++rep) {
        pg8::Gemm g{MG, (const bf16_t*)(ws + WS_WO), T, DM, DM, nullptr, nullptr, 0}; pg8::StaticOrder S; S.init(T, DM, C.G, (int)blockIdx.x, WGM_N2K);
        EpiZ E{(const bf16_t*)(ws + WS_HBF), (bf16_t*)(ws + WS_Z)};
        pg8::gemm_phase<EpiZ, pg8::StaticOrder, GEMM_ALIGN, GEMM_SP2, false>(lds, g, S, E);
        REPSEAM(5, rep);
    } } SEAM(5);

    if (IN(6)) { p6_ln1_router(C, in, ws); } SEAM(6);

    if (IN(7)) { _Pragma("unroll") for (int rep = 0; rep < REPS(7); ++rep) {
        const int NBLK = build_moe_tables(C, ws);
        MoeOrder S{C.G, C.vcu, 2, NBLK, (const LAS int*)(lds + MISC_OFF + 512), (const LAS int*)(lds + MISC_OFF + 64), (const LAS int*)(lds + MISC_OFF + 320), (const int*)(ws + WS_LIST)};
        pg8::Gemm g{(const bf16_t*)(ws + WS_H1), (const bf16_t*)(ws + WS_WUP), T, NE * 1024, DM, nullptr, nullptr, 0};
        EpiSwiglu E{(bf16_t*)(ws + WS_HB), (const int*)(ws + WS_LIST), (const float*)(ws + WS_WGT), (int*)(ws + WS_POSE), (float*)(ws + WS_POSW)};
        pg8::gemm_phase<EpiSwiglu, MoeOrder, GEMM_ALIGN, GEMM_SP2, true>(lds, g, S, E);
        p7_convert_down(C, in, ws);
        REPSEAM(7, rep);
    } } SEAM(7);

    if (IN(8)) { _Pragma("unroll") for (int rep = 0; rep < REPS(8); ++rep) {
        const int NBLK = build_moe_tables(C, ws);
        MoeOrder S{C.G, C.vcu, 3, NBLK, (const LAS int*)(lds + MISC_OFF + 512), (const LAS int*)(lds + MISC_OFF + 64), (const LAS int*)(lds + MISC_OFF + 320), (const int*)(ws + WS_LIST)};
        pg8::Gemm g{(const bf16_t*)(ws + WS_HB), (const bf16_t*)(ws + WS_WDN), NBLK * 256, NE * DM, DFF, nullptr, nullptr, 0};
        EpiDown E{(const int*)(ws + WS_POSE), (const float*)(ws + WS_POSW), (bf16_t*)(ws + WS_YK)};
        pg8::gemm_phase<EpiDown, MoeOrder, GEMM_ALIGN, GEMM_SP2, false>(lds, g, S, E);
        REPSEAM(8, rep);
    } } SEAM(8);

    if (IN(9)) { _Pragma("unroll") for (int rep = 0; rep < REPS(9); ++rep) { p9_ln2(C, in, ws, args.out); REPSEAM(9, rep); } }
#undef IN
#undef SEAM
}

extern "C" void kernel_launch(void* const* d_in, const int* in_sizes, int n_in, void* d_out, int out_size, void* d_ws, size_t ws_size, hipStream_t stream) {
    static int grid = 0;
    if (grid == 0) {
        if (n_in != 33 || in_sizes[0] != T * DM || out_size != T * DM || ws_size < WS_END) { fprintf(stderr, "kernel_launch: unexpected shapes (n_in %d, in0 %d, out %d, ws %zu)\n", n_in, n_in > 0 ? in_sizes[0] : -1, out_size, ws_size); grid = -1; return; }
        int dev = 0, cus = 0, per_cu = 0;
        if (hipGetDevice(&dev) != hipSuccess || hipDeviceGetAttribute(&cus, hipDeviceAttributeMultiprocessorCount, dev) != hipSuccess) { grid = -1; return; }
        if (hipFuncSetAttribute((const void*)mk_fwd, hipFuncAttributeMaxDynamicSharedMemorySize, LDS_BYTES) != hipSuccess) { fprintf(stderr, "kernel_launch: hipFuncSetAttribute failed\n"); grid = -1; return; }
        if (hipOccupancyMaxActiveBlocksPerMultiprocessor(&per_cu, (const void*)mk_fwd, 512, LDS_BYTES) != hipSuccess || per_cu < 1) { fprintf(stderr, "kernel_launch: occupancy query reports %d blocks per CU\n", per_cu); }
        (void)hipGetLastError();
        grid = cus;
    }
    if (grid < 0) return;
    (void)hipMemsetAsync((char*)d_ws + WS_CTL, 0, CTL_ZERO_BYTES, stream);
    Args a{};
    for (int i = 0; i < 33; ++i) a.in[i] = (const float*)d_in[i];
    a.out = (float*)d_out; a.ws = (unsigned char*)d_ws;
#if MK_PER_PHASE
    for (int p = 0; p < NPHASE; ++p) { a.ph_lo = p; a.ph_hi = p + 1; hipLaunchKernelGGL(mk_fwd, dim3(grid), dim3(512), LDS_BYTES, stream, a); }
#else
    a.ph_lo = 0; a.ph_hi = NPHASE; hipLaunchKernelGGL(mk_fwd, dim3(grid), dim3(512), LDS_BYTES, stream, a);
#endif
}
```

```cpp
#include <hip/hip_runtime.h>
#include <stdint.h>
#include <stdio.h>

#ifndef ATT_PROBE
#define ATT_PROBE 0
#endif
#ifndef MK_PER_PHASE
#define MK_PER_PHASE 0
#endif

#define GAS __attribute__((address_space(1)))
#define LAS __attribute__((address_space(3)))
typedef unsigned short bf16_t;
typedef short bf16x8 __attribute__((ext_vector_type(8)));
typedef short s16x4 __attribute__((ext_vector_type(4)));
typedef float f32x2 __attribute__((ext_vector_type(2)));
typedef float f32x4 __attribute__((ext_vector_type(4)));
typedef float f32x16 __attribute__((ext_vector_type(16)));
typedef unsigned u32x2 __attribute__((ext_vector_type(2)));
typedef unsigned u32x4 __attribute__((ext_vector_type(4)));

constexpr int NB_ = 16, SEQ = 2048, DM = 2048, T = NB_ * SEQ, NMETA = 16;
constexpr int SSMW = 512, AW = 1024, INC = 7680, NGRP = 32, NST = 64;
constexpr int NE = 32, DFF = 512, CAP = T;
constexpr float LN_EPS = 1e-5f;
constexpr float ALPHA = 1.189207115002721f;
constexpr float QSCALE = 0.125f * 1.4426950408889634f;

__device__ __forceinline__ unsigned cvt_pk_bf16(float lo, float hi) { unsigned r; asm volatile("v_cvt_pk_bf16_f32 %0, %1, %2" : "=v"(r) : "v"(lo), "v"(hi)); return r; }
__device__ __forceinline__ float bf_lo(unsigned w) { return __uint_as_float(w << 16); }
__device__ __forceinline__ float bf_hi(unsigned w) { return __uint_as_float(w & 0xffff0000u); }
__device__ __forceinline__ float sigmoidf_(float x) { return 1.0f / (1.0f + __expf(-x)); }
__device__ __forceinline__ float wave_sum(float v) {
#pragma unroll
    for (int o = 1; o < 64; o <<= 1) v += __shfl_xor(v, o);
    return v;
}

namespace pg8 {
constexpr int BM = 256, BK = 64, HALF = 128, HTB = HALF * BK * 2, STAGE_BYTES = 8 * HTB, NXCD = 8, WGM = 4;
__host__ __device__ __forceinline__ int lds_byte(int r, int c) { const int st = (r >> 4) * 2 + (c >> 5), rr = r & 15, cc = c & 31, ob = rr * 64 + cc * 2; return st * 1024 + (ob ^ (((ob >> 9) & 1) << 5)); }
__host__ __device__ __forceinline__ void stage_rc(int b, int& R, int& C) { const int st = b / 1024, sb = b % 1024, swz = sb ^ (((sb >> 9) & 1) << 5); R = (st >> 1) * 16 + swz / 64; C = (st & 1) * 32 + (swz % 64) / 2; }
__host__ __device__ __forceinline__ int perm32(int rho) { const int n = rho >> 4, i = rho & 15; return 8 * (i >> 2) + 4 * n + (i & 3); }

struct Unit { int pm, pn, e, s0, cnt; };
struct Gemm { const bf16_t* A; const bf16_t* Bt; int M, N, K; const bf16_t* A2; const bf16_t* Bt2; int K2; };

struct StaticOrder {
    int nM, nN, nwg, G, c, wgm;
    __device__ void init(int M, int N, int G_, int c_, int wgm_ = WGM) { nM = M / BM; nN = N / BM; nwg = nM * nN; G = G_; c = c_; wgm = wgm_; }
    __device__ bool next(int i, Unit& u) const {
        const long L = (long)i * G + c; if (L >= nwg) return false;
        int wgid = (int)L; { const int q = nwg / NXCD, r = nwg % NXCD, xcd = wgid % NXCD, off = wgid / NXCD; wgid = (xcd < r ? xcd * (q + 1) : r * (q + 1) + (xcd - r) * q) + off; }
        const int nig = wgm * nN, gid = wgid / nig, fm = gid * wgm, gsz = (nM - fm) < wgm ? (nM - fm) : wgm;
        u.pm = fm + ((wgid % nig) % gsz); u.pn = (wgid % nig) / gsz; u.e = 0; u.s0 = 0; u.cnt = 0; return true;
    }
    __device__ __forceinline__ int arow(const Unit&, int) const { return 0; }
};

template <class Epi, class Sched, bool ALIGN_EPI, bool SP2, bool GATHER, bool DUAL = false>
__device__ __forceinline__ void gemm_phase(LAS unsigned char* lds, const Gemm g, const Sched& S, const Epi& E) {
    const int tid = threadIdx.x, wid = __builtin_amdgcn_readfirstlane(tid >> 6), lane = tid & 63, wr = wid >> 2, wc = wid & 3, fr = lane & 15, fq = lane >> 4;
    const int K = g.K, K2 = DUAL ? g.K2 : 0, nt1 = K / BK, nt = (K + K2) / BK;
    unsigned voffA[2], voffB[2], voffA2[2] = {0u, 0u}, voffB2[2] = {0u, 0u}; int stR[2], stC[2];
#pragma unroll
    for (int i = 0; i < 2; ++i) { int R, C; stage_rc(tid * 16 + i * 8192, R, C); const int Rb = Epi::PERM ? ((R & ~31) + perm32(R & 31)) : R;
        stR[i] = R; stC[i] = C; voffA[i] = (unsigned)(R * K + C) * 2u; voffB[i] = (unsigned)(Rb * K + C) * 2u;
        if constexpr (DUAL) { voffA2[i] = (unsigned)(R * K2 + C) * 2u; voffB2[i] = (unsigned)(Rb * K2 + C) * 2u; } }
    const size_t kstep = (size_t)(BK * 2);
    const size_t hstep = (size_t)HALF * K * 2;
    const size_t tstep = 2 * hstep;
    const size_t hstep2 = (size_t)HALF * K2 * 2, tstep2 = 2 * hstep2;
    const unsigned ldsw = (unsigned)wid * 1024u;
    const int aoff = lds_byte(wr * 64 + fr, fq * 8), boff = lds_byte(wc * 32 + fr, fq * 8);
#define PG8_SA(b, h) (((b) * 2 + (h)) * HTB)
#define PG8_SB(b, h) ((4 + (b) * 2 + (h)) * HTB)
#define PG8_STAGE(bufoff, gbase, voff) do { _Pragma("unroll") for (int _i = 0; _i < 2; ++_i) \
        __builtin_amdgcn_global_load_lds((const unsigned*)((const char*)(gbase) + (voff)[_i]), (LAS unsigned*)(lds + (bufoff) + ldsw + _i * 8192), 16, 0, 0); } while (0)
#define PG8_STAGE_A(bufoff, kbase, h, VO) do { if constexpr (GATHER) { PG8_STAGE(bufoff, kbase, VO[h]); } else { PG8_STAGE(bufoff, (kbase) + (h) * hstep, voffA); } } while (0)
#define PG8_STAGE_AX(bufoff, kbase, h, VO, HS, VA) do { if constexpr (GATHER) { PG8_STAGE(bufoff, kbase, VO[h]); } else { PG8_STAGE(bufoff, (kbase) + (h) * (HS), VA); } } while (0)
#define PG8_LDA(dst, b, h) do { _Pragma("unroll") for (int m = 0; m < 4; ++m) _Pragma("unroll") for (int k = 0; k < 2; ++k) dst[m][k] = *(const LAS bf16x8*)(lds + PG8_SA(b, h) + aoff + m * 2048 + k * 1024); } while (0)
#define PG8_LDB(dst, b, h) do { _Pragma("unroll") for (int n = 0; n < 2; ++n) _Pragma("unroll") for (int k = 0; k < 2; ++k) dst[n][k] = *(const LAS bf16x8*)(lds + PG8_SB(b, h) + boff + n * 2048 + k * 1024); } while (0)
#define PG8_MMA(ai, bj, At, Bt) do { __builtin_amdgcn_s_setprio(1); _Pragma("unroll") for (int m = 0; m < 4; ++m) _Pragma("unroll") for (int n = 0; n < 2; ++n) _Pragma("unroll") for (int k = 0; k < 2; ++k) \
        acc[ai][bj][m][n] = __builtin_amdgcn_mfma_f32_16x16x32_bf16(Bt[n][k], At[m][k], acc[ai][bj][m][n], 0, 0, 0); __builtin_amdgcn_s_setprio(0); } while (0)
#define PG8_WAIT_V(n) asm volatile("s_waitcnt vmcnt(" #n ")" ::: "memory")
#define PG8_WAIT_L(n) asm volatile("s_waitcnt lgkmcnt(" #n ")" ::: "memory")
#define PG8_BAR __builtin_amdgcn_s_barrier()
#define PG8_SCHED __builtin_amdgcn_sched_barrier(0)
#define PG8_GOFF(VO, U) do { _Pragma("unroll") for (int _h = 0; _h < 2; ++_h) _Pragma("unroll") for (int _i = 0; _i < 2; ++_i) \
        VO[_h][_i] = (unsigned)S.arow(U, _h * HALF + stR[_i]) * (unsigned)(K * 2) + (unsigned)(stC[_i] * 2); } while (0)
    Unit cur, nxt; int ui = 0;
    if (!S.next(0, cur)) return;
    f32x4 acc[2][2][4][2];
#pragma unroll
    for (int a = 0; a < 2; ++a)
#pragma unroll
        for (int b = 0; b < 2; ++b)
#pragma unroll
            for (int m = 0; m < 4; ++m)
#pragma unroll
                for (int n = 0; n < 2; ++n) acc[a][b][m][n] = (f32x4){0.f, 0.f, 0.f, 0.f};
    bf16x8 At[4][2], B0[2][2], B1[2][2];
    unsigned cvo[2][2] = {{0u, 0u}, {0u, 0u}}, nvo[2][2] = {{0u, 0u}, {0u, 0u}};
    const char* cA = GATHER ? (const char*)g.A : (const char*)g.A + (size_t)cur.pm * tstep; const char* cB = (const char*)g.Bt + (size_t)cur.pn * tstep;
    if constexpr (GATHER) { PG8_GOFF(cvo, cur); }
    if constexpr (SP2) {
        PG8_STAGE(PG8_SB(0, 0), cB, voffB); PG8_STAGE(PG8_SB(0, 1), cB + hstep, voffB); PG8_STAGE_A(PG8_SA(0, 0), cA, 0, cvo); PG8_STAGE_A(PG8_SA(0, 1), cA, 1, cvo);
        if (wr == 1) PG8_BAR;
        PG8_WAIT_V(2); PG8_BAR;
        PG8_STAGE(PG8_SB(1, 0), cB + kstep, voffB); PG8_STAGE_A(PG8_SA(1, 0), cA + kstep, 0, cvo); PG8_STAGE(PG8_SB(1, 1), cB + hstep + kstep, voffB);
        PG8_WAIT_V(6); PG8_BAR;
    } else {
        PG8_STAGE(PG8_SB(0, 0), cB, voffB); PG8_STAGE_A(PG8_SA(0, 0), cA, 0, cvo); PG8_STAGE(PG8_SB(0, 1), cB + hstep, voffB); PG8_STAGE_A(PG8_SA(0, 1), cA, 1, cvo);
        if (wr == 1) PG8_BAR;
        PG8_WAIT_V(4); PG8_BAR;
        PG8_STAGE(PG8_SB(1, 0), cB + kstep, voffB); PG8_STAGE_A(PG8_SA(1, 0), cA + kstep, 0, cvo); PG8_STAGE(PG8_SB(1, 1), cB + hstep + kstep, voffB);
        PG8_WAIT_V(6); PG8_BAR;
    }
    for (;;) {
        const bool has_next = S.next(ui + 1, nxt);
        const char* nA = GATHER ? cA : (has_next ? (const char*)g.A + (size_t)nxt.pm * tstep : cA); const char* nB = has_next ? (const char*)g.Bt + (size_t)nxt.pn * tstep : cB;
        if constexpr (GATHER) { if (has_next) { PG8_GOFF(nvo, nxt); } else {
#pragma unroll
            for (int h = 0; h < 2; ++h)
#pragma unroll
                for (int i = 0; i < 2; ++i) nvo[h][i] = cvo[h][i]; } }
        const char* cA2 = DUAL ? (const char*)g.A2 + (size_t)cur.pm * tstep2 : cA; const char* cB2 = DUAL ? (const char*)g.Bt2 + (size_t)cur.pn * tstep2 : cB;
        for (int t = 0; t < nt; t += 2) {
            const bool last = (t == nt - 2);
            const bool s1 = DUAL && (t + 1 >= nt1), s2 = DUAL && !last && (t + 2 >= nt1);
            const char* a1 = s1 ? cA2 + (size_t)(t + 1 - nt1) * kstep : cA + (size_t)(t + 1) * kstep;
            const char* a2 = last ? nA : (s2 ? cA2 + (size_t)(t + 2 - nt1) * kstep : cA + (size_t)(t + 2) * kstep);
            const char* b2 = last ? nB : (s2 ? cB2 + (size_t)(t + 2 - nt1) * kstep : cB + (size_t)(t + 2) * kstep);
            const char* a3 = a2 + kstep; const char* b3 = b2 + kstep;
            const size_t hs1 = s1 ? hstep2 : hstep, hs2 = s2 ? hstep2 : hstep;
            unsigned vA1[2], vA2[2], vB2[2];
#pragma unroll
            for (int i = 0; i < 2; ++i) { vA1[i] = s1 ? voffA2[i] : voffA[i]; vA2[i] = s2 ? voffA2[i] : voffA[i]; vB2[i] = s2 ? voffB2[i] : voffB[i]; }
            unsigned svo[2][2];
#pragma unroll
            for (int h = 0; h < 2; ++h)
#pragma unroll
                for (int i = 0; i < 2; ++i) svo[h][i] = last ? nvo[h][i] : cvo[h][i];
            if constexpr (SP2) {
            PG8_LDB(B0, 0, 0); PG8_LDB(B1, 0, 1); PG8_SCHED; PG8_LDA(At, 0, 0); PG8_STAGE_AX(PG8_SA(1, 1), a1, 1, cvo, hs1, vA1);
            PG8_WAIT_V(8); PG8_WAIT_L(0); PG8_BAR; PG8_MMA(0, 0, At, B0); PG8_MMA(0, 1, At, B1); PG8_BAR; PG8_SCHED;
            PG8_LDA(At, 0, 1); PG8_STAGE(PG8_SB(0, 0), b2, vB2); PG8_STAGE(PG8_SB(0, 1), b2 + hs2, vB2); PG8_STAGE_AX(PG8_SA(0, 0), a2, 0, svo, hs2, vA2);
            PG8_WAIT_V(8); PG8_WAIT_L(0); PG8_BAR; PG8_MMA(1, 0, At, B0); PG8_MMA(1, 1, At, B1); PG8_BAR; PG8_SCHED;
            PG8_LDB(B0, 1, 0); PG8_LDB(B1, 1, 1); PG8_SCHED; PG8_LDA(At, 1, 0); PG8_STAGE_AX(PG8_SA(0, 1), a2, 1, svo, hs2, vA2);
            PG8_WAIT_V(8); PG8_WAIT_L(0); PG8_BAR; PG8_MMA(0, 0, At, B0); PG8_MMA(0, 1, At, B1); PG8_BAR; PG8_SCHED;
            PG8_LDA(At, 1, 1); PG8_STAGE(PG8_SB(1, 0), b3, vB2); PG8_STAGE(PG8_SB(1, 1), b3 + hs2, vB2); PG8_STAGE_AX(PG8_SA(1, 0), a3, 0, svo, hs2, vA2);
            PG8_WAIT_V(8); PG8_WAIT_L(0); PG8_BAR; PG8_MMA(1, 0, At, B0); PG8_MMA(1, 1, At, B1); PG8_BAR; PG8_SCHED;
            } else {
            PG8_LDB(B0, 0, 0); PG8_SCHED; PG8_LDA(At, 0, 0); PG8_STAGE_AX(PG8_SA(1, 1), a1, 1, cvo, hs1, vA1);
            PG8_WAIT_L(8); PG8_BAR; PG8_WAIT_L(0); PG8_MMA(0, 0, At, B0); PG8_BAR; PG8_SCHED;
            PG8_LDB(B1, 0, 1); PG8_STAGE(PG8_SB(0, 0), b2, vB2);
            PG8_BAR; PG8_WAIT_L(0); PG8_MMA(0, 1, At, B1); PG8_BAR;
            PG8_LDA(At, 0, 1); PG8_STAGE_AX(PG8_SA(0, 0), a2, 0, svo, hs2, vA2);
            PG8_BAR; PG8_WAIT_L(0); PG8_MMA(1, 0, At, B0); PG8_BAR; PG8_SCHED;
            PG8_STAGE(PG8_SB(0, 1), b2 + hs2, vB2);
            PG8_WAIT_V(6); PG8_BAR; PG8_MMA(1, 1, At, B1); PG8_BAR;
            PG8_LDB(B0, 1, 0); PG8_SCHED; PG8_LDA(At, 1, 0); PG8_STAGE_AX(PG8_SA(0, 1), a2, 1, svo, hs2, vA2);
            PG8_WAIT_L(8); PG8_BAR; PG8_WAIT_L(0); PG8_MMA(0, 0, At, B0); PG8_BAR; PG8_SCHED;
            PG8_LDB(B1, 1, 1); PG8_STAGE(PG8_SB(1, 0), b3, vB2);
            PG8_BAR; PG8_WAIT_L(0); PG8_MMA(0, 1, At, B1); PG8_BAR;
            PG8_LDA(At, 1, 1); PG8_STAGE_AX(PG8_SA(1, 0), a3, 0, svo, hs2, vA2);
            PG8_BAR; PG8_WAIT_L(0); PG8_MMA(1, 0, At, B0); PG8_BAR; PG8_SCHED;
            PG8_STAGE(PG8_SB(1, 1), b3 + hs2, vB2);
            PG8_WAIT_V(6); PG8_BAR; PG8_MMA(1, 1, At, B1); PG8_BAR;
            }
            if constexpr (DUAL) { if (t + 2 == nt1) E.mid(acc, cur, wr, wc, fr, fq); }
        }
        if constexpr (ALIGN_EPI) { if (wr == 0) PG8_BAR; }
        E(acc, cur, wr, wc, fr, fq);
        if (!has_next) break;
#pragma unroll
        for (int a = 0; a < 2; ++a)
#pragma unroll
            for (int b = 0; b < 2; ++b)
#pragma unroll
                for (int m = 0; m < 4; ++m)
#pragma unroll
                    for (int n = 0; n < 2; ++n) acc[a][b][m][n] = (f32x4){0.f, 0.f, 0.f, 0.f};
        cur = nxt; cA = nA; cB = nB; ++ui;
#pragma unroll
        for (int h = 0; h < 2; ++h)
#pragma unroll
            for (int i = 0; i < 2; ++i) cvo[h][i] = nvo[h][i];
        if constexpr (ALIGN_EPI) { if (wr == 1) PG8_BAR; }
    }
    PG8_WAIT_V(0);
    if constexpr (!ALIGN_EPI) { if (wr == 0) PG8_BAR; }
    PG8_BAR;
#undef PG8_SA
#undef PG8_SB
#undef PG8_STAGE
#undef PG8_STAGE_A
#undef PG8_STAGE_AX
#undef PG8_LDA
#undef PG8_LDB
#undef PG8_MMA
#undef PG8_WAIT_V
#undef PG8_WAIT_L
#undef PG8_BAR
#undef PG8_SCHED
#undef PG8_GOFF
}
}

constexpr size_t MiB = 1u << 20;
constexpr size_t WS_CTL = 0, CTL_ZERO_BYTES = 1 * MiB;
constexpr size_t WS_HMETA = 1 * MiB;
constexpr size_t WS_UMETA = WS_HMETA + 128 * 1024;
constexpr size_t WS_KMETA = WS_HMETA + 256 * 1024;
constexpr size_t WS_VMETA = WS_HMETA + 384 * 1024;
constexpr size_t WS_SSMAB = WS_HMETA + 512 * 1024;
constexpr size_t WS_SSMBB = WS_HMETA + 576 * 1024;
constexpr size_t WS_WRT = 2 * MiB;
constexpr size_t WS_WIN = 3 * MiB;
constexpr size_t WS_WGLU = 33 * MiB;
constexpr size_t WS_WBS = 34 * MiB;
constexpr size_t WS_WBA = 36 * MiB;
constexpr size_t WS_WO = 40 * MiB;
constexpr size_t WS_WUP = 48 * MiB;
constexpr size_t WS_WDN = 176 * MiB;
constexpr size_t WS_HBF = 240 * MiB;
constexpr size_t WS_U = 368 * MiB;
constexpr size_t WS_Q = 400 * MiB;
constexpr size_t WS_K = 464 * MiB;
constexpr size_t WS_V = 528 * MiB;
constexpr size_t WS_SGS = 592 * MiB;
constexpr size_t WS_SGA = 720 * MiB;
constexpr size_t WS_YPRE = 848 * MiB;
constexpr size_t WS_YSSM = 880 * MiB;
constexpr size_t WS_YATT = 912 * MiB;
constexpr size_t WS_END = 976 * MiB;
constexpr size_t WS_Z = 368 * MiB;
constexpr size_t WS_H1 = 624 * MiB;
constexpr size_t WS_HB = 752 * MiB;
constexpr size_t WS_YK = 368 * MiB;
constexpr size_t WS_LIST = 848 * MiB;
constexpr size_t WS_WGT = 852 * MiB;
constexpr size_t WS_POSE = 853 * MiB;
constexpr size_t WS_POSW = 854 * MiB;
constexpr int CW_ECNT = 64;
constexpr int CW_CONV = 192;
constexpr int CW_BAR = 4096;

constexpr int RING_BYTES = 131072;
constexpr int MISC_OFF = RING_BYTES;
constexpr int LDS_BYTES = 139264;

#define XB_TMO      128
#define XB_XCNT(j)  (256  + 64 * (j))
#define XB_XSUB(j)  (1280 + 64 * (j))
#define XB_XGEN(j)  (2304 + 64 * (j))
#define XB_TOP      3328
#define XB_TOPGEN   3392
#define XCD_BAR_WORDS 3456
#define XB_SPIN_CAP (1u << 18)
__device__ __forceinline__ unsigned xb_ld(unsigned* p)              { return __hip_atomic_load(p, __ATOMIC_RELAXED, __HIP_MEMORY_SCOPE_AGENT); }
__device__ __forceinline__ unsigned xb_add(unsigned* p, unsigned v) { return __hip_atomic_fetch_add(p, v, __ATOMIC_RELAXED, __HIP_MEMORY_SCOPE_AGENT); }
__device__ __forceinline__ unsigned xb_xcc_id() { return (unsigned)__builtin_amdgcn_s_getreg((3 << 11) | 20) & 0xFu; }
#define XB_SPIN(cond, bar) do { unsigned _sp = 0; while (cond) { __builtin_amdgcn_s_sleep(1); \
    if ((++_sp & 255u) == 0u) { if (xb_ld(&(bar)[XB_TMO])) break; if (_sp > XB_SPIN_CAP) { atomicAdd(&(bar)[XB_TMO], 1u); break; } } } } while (0)
struct XcdBarrier { unsigned* bar; unsigned x; volatile LAS unsigned* st; };
__device__ __forceinline__ XcdBarrier xcd_barrier_post(unsigned* bar, volatile LAS unsigned* st) {
    XcdBarrier b; b.bar = bar; b.x = xb_xcc_id(); b.st = st;
    if (threadIdx.x == 0) (void)xb_add(&bar[XB_XCNT(b.x)], 1u);
    return b;
}
__device__ __forceinline__ void xcd_barrier_complete(unsigned* bar, unsigned x, unsigned& nloc, unsigned& nx) {
    const unsigned G = gridDim.x * gridDim.y * gridDim.z;
    unsigned sum, cnt, mine, sp = 0u;
    for (;;) {
        sum = 0u; cnt = 0u; mine = 0u;
#pragma unroll
        for (unsigned j = 0; j < 16; ++j) { const unsigned c = xb_ld(&bar[XB_XCNT(j)]); sum += c; cnt += (c > 0u) ? 1u : 0u; mine = (j == x) ? c : mine; }
        if (sum == G) break;
        __builtin_amdgcn_s_sleep(1);
        if ((++sp & 255u) == 0u) { if (xb_ld(&bar[XB_TMO])) break; if (sp > XB_SPIN_CAP) { atomicAdd(&bar[XB_TMO], 1u); break; } }
    }
    nloc = mine > 0u ? mine : 1u; nx = cnt > 0u ? cnt : 1u;
}
__device__ __forceinline__ void xcd_barrier(const XcdBarrier& b) {
    asm volatile("s_waitcnt vmcnt(0)" ::: "memory");
    __syncthreads();
    if (threadIdx.x == 0) {
        unsigned* bar = b.bar;
        __builtin_amdgcn_s_waitcnt(0);
        unsigned nloc = b.st[0], nx = b.st[1];
        if (nloc == 0u) { xcd_barrier_complete(bar, b.x, nloc, nx); b.st[0] = nloc; b.st[1] = nx; }
        const unsigned old = xb_add(&bar[XB_XSUB(b.x)], 1u);
        const unsigned gen = old / nloc;
        if (old + 1u == (gen + 1u) * nloc) {
            __builtin_amdgcn_fence(__ATOMIC_RELEASE, "agent");
            asm volatile("s_waitcnt vmcnt(0)" ::: "memory");
            const unsigned og = xb_add(&bar[XB_TOP], 1u);
            const unsigned tg = og / nx;
            if (og + 1u == (tg + 1u) * nx) xb_add(&bar[XB_TOPGEN], 1u);
            else XB_SPIN(xb_ld(&bar[XB_TOPGEN]) == tg, bar);
            __builtin_amdgcn_fence(__ATOMIC_ACQUIRE, "agent");
            xb_add(&bar[XB_XGEN(b.x)], 1u);
            asm volatile("s_waitcnt vmcnt(0)" ::: "memory");
        } else {
            XB_SPIN(xb_ld(&bar[XB_XGEN(b.x)]) == gen, bar);
            __builtin_amdgcn_fence(__ATOMIC_ACQUIRE, "agent");
            asm volatile("s_waitcnt vmcnt(0)" ::: "memory");
        }
    }
    __syncthreads();
}

using pg8::Unit;
__device__ __forceinline__ u32x4 pack8(const f32x4 v0, const f32x4 v1) { u32x4 w; w.x = cvt_pk_bf16(v0[0], v0[1]); w.y = cvt_pk_bf16(v0[2], v0[3]); w.z = cvt_pk_bf16(v1[0], v1[1]); w.w = cvt_pk_bf16(v1[2], v1[3]); return w; }
__device__ __forceinline__ void unpack8(const u32x4 w, f32x4& v0, f32x4& v1) { v0 = (f32x4){bf_lo(w.x), bf_hi(w.x), bf_lo(w.y), bf_hi(w.y)}; v1 = (f32x4){bf_lo(w.z), bf_hi(w.z), bf_lo(w.w), bf_hi(w.w)}; }

struct EpiProj {
    static constexpr bool PERM = true;
    bf16_t *U, *Q, *K, *V, *RHO, *SGA;
    __device__ __forceinline__ void operator()(const f32x4 (&acc)[2][2][4][2], const Unit& u, int wr, int wc, int fr, int fq) const {
        const int pn = u.pn;
        if (pn >= 14) {
            const int row0 = u.pm * 256 + wr * 64 + fr, col0 = (pn - 14) * 128 + wc * 32 + 8 * fq;
#pragma unroll
            for (int ai = 0; ai < 2; ++ai)
#pragma unroll
                for (int m = 0; m < 4; ++m) { const size_t off = (size_t)(row0 + ai * 128 + m * 16) * DM + col0; f32x4 r0, r1, a0, a1;
#pragma unroll
                    for (int j = 0; j < 4; ++j) { const float es0 = __expf(-acc[ai][0][m][0][j]), es1 = __expf(-acc[ai][0][m][1][j]), ea0 = __expf(-acc[ai][1][m][0][j]), ea1 = __expf(-acc[ai][1][m][1][j]);
                        a0[j] = __builtin_amdgcn_rcpf(1.f + ea0); a1[j] = __builtin_amdgcn_rcpf(1.f + ea1);
                        r0[j] = (1.f + ea0) * __builtin_amdgcn_rcpf(1.f + es0); r1[j] = (1.f + ea1) * __builtin_amdgcn_rcpf(1.f + es1); }
                    *(u32x4*)(RHO + off) = pack8(r0, r1); *(u32x4*)(SGA + off) = pack8(a0, a1); }
            return;
        }
        bf16_t* base; int ldc, ct, mode;
        if (pn < 2) { base = U; ldc = 512; ct = pn; mode = 0; }
        else if (pn < 6) { base = Q; ldc = 1024; ct = pn - 2; mode = 1; }
        else if (pn < 10) { base = K; ldc = 1024; ct = pn - 6; mode = 0; }
        else { base = V; ldc = 1024; ct = pn - 10; mode = 0; }
        const int row0 = u.pm * 256 + wr * 64 + fr, col0 = ct * 256 + wc * 32 + 8 * fq;
#pragma unroll
        for (int ai = 0; ai < 2; ++ai)
#pragma unroll
            for (int m = 0; m < 4; ++m) { bf16_t* rowp = base + (size_t)(row0 + ai * 128 + m * 16) * ldc + col0;
#pragma unroll
                for (int bj = 0; bj < 2; ++bj) { f32x4 v0 = acc[ai][bj][m][0], v1 = acc[ai][bj][m][1];
                    if (mode == 1) { v0 = v0 * QSCALE; v1 = v1 * QSCALE; }
                    *(u32x4*)(rowp + bj * 128) = pack8(v0, v1); } }
    }
};
struct EpiGlu {
    static constexpr bool PERM = true;
    const bf16_t* YPRE; bf16_t* YSSM;
    __device__ __forceinline__ void operator()(const f32x4 (&acc)[2][2][4][2], const Unit& u, int wr, int wc, int fr, int fq) const {
        const int row0 = u.pm * 256 + wr * 64 + fr, col0 = u.pn * 256 + wc * 32 + 8 * fq;
#pragma unroll
        for (int ai = 0; ai < 2; ++ai)
#pragma unroll
            for (int m = 0; m < 4; ++m) { const size_t off = (size_t)(row0 + ai * 128 + m * 16) * SSMW + col0;
#pragma unroll
                for (int bj = 0; bj < 2; ++bj) { const u32x4 yw = *(const u32x4*)(YPRE + off + bj * 128); f32x4 y0, y1; unpack8(yw, y0, y1);
                    f32x4 v0 = acc[ai][bj][m][0], v1 = acc[ai][bj][m][1];
#pragma unroll
                    for (int j = 0; j < 4; ++j) { v0[j] = y0[j] * sigmoidf_(v0[j]); v1[j] = y1[j] * sigmoidf_(v1[j]); }
                    *(u32x4*)(YSSM + off + bj * 128) = pack8(v0, v1); } }
    }
};
template <int SECOND> struct EpiMerge {
    static constexpr bool PERM = true;
    const bf16_t* SG; bf16_t* MG;
    __device__ __forceinline__ void operator()(const f32x4 (&acc)[2][2][4][2], const Unit& u, int wr, int wc, int fr, int fq) const {
        const int row0 = u.pm * 256 + wr * 64 + fr, col0 = u.pn * 256 + wc * 32 + 8 * fq;
#pragma unroll
        for (int ai = 0; ai < 2; ++ai)
#pragma unroll
            for (int m = 0; m < 4; ++m) { const size_t off = (size_t)(row0 + ai * 128 + m * 16) * DM + col0;
#pragma unroll
                for (int bj = 0; bj < 2; ++bj) { const u32x4 gw = *(const u32x4*)(SG + off + bj * 128); f32x4 g0, g1; unpack8(gw, g0, g1);
                    f32x4 v0 = acc[ai][bj][m][0] * g0, v1 = acc[ai][bj][m][1] * g1;
                    if (SECOND) { const u32x4 pw = *(const u32x4*)(MG + off + bj * 128); f32x4 p0, p1; unpack8(pw, p0, p1); v0 = v0 + p0; v1 = v1 + p1; }
                    *(u32x4*)(MG + off + bj * 128) = pack8(v0, v1); } }
    }
};
struct EpiMergeF {
    static constexpr bool PERM = true;
    const bf16_t* SGS; const bf16_t* SGA; bf16_t* MG;
    __device__ __forceinline__ void mid(f32x4 (&acc)[2][2][4][2], const Unit& u, int wr, int wc, int fr, int fq) const {
        asm volatile("" : "+v"(fr), "+v"(fq));
        const int row0 = u.pm * 256 + wr * 64 + fr, col0 = u.pn * 256 + wc * 32 + 8 * fq;
        const bf16_t* sp = SGS + (size_t)row0 * DM + col0;
        u32x4 sw[2][2];
        sw[0][0] = *(const u32x4*)(sp); sw[0][1] = *(const u32x4*)(sp + 128);
#pragma unroll
        for (int g = 0; g < 8; ++g) { const int ai = g >> 2, m = g & 3;
            if (g < 7) { const int g1 = g + 1; const bf16_t* sq = sp + (size_t)((g1 >> 2) * 128 + (g1 & 3) * 16) * DM;
                sw[g1 & 1][0] = *(const u32x4*)(sq); sw[g1 & 1][1] = *(const u32x4*)(sq + 128); }
            asm volatile("" ::: "memory");
#pragma unroll
            for (int bj = 0; bj < 2; ++bj) { f32x4 s0, s1; unpack8(sw[g & 1][bj], s0, s1);
                acc[ai][bj][m][0] = acc[ai][bj][m][0] * s0; acc[ai][bj][m][1] = acc[ai][bj][m][1] * s1; }
        }
    }
    __device__ __forceinline__ void operator()(const f32x4 (&acc)[2][2][4][2], const Unit& u, int wr, int wc, int fr, int fq) const {
        const int row0 = u.pm * 256 + wr * 64 + fr, col0 = u.pn * 256 + wc * 32 + 8 * fq;
#pragma unroll
        for (int ai = 0; ai < 2; ++ai)
#pragma unroll
            for (int m = 0; m < 4; ++m) { const size_t off = (size_t)(row0 + ai * 128 + m * 16) * DM + col0;
#pragma unroll
                for (int bj = 0; bj < 2; ++bj) { const u32x4 gw = *(const u32x4*)(SGA + off + bj * 128); f32x4 g0, g1; unpack8(gw, g0, g1);
                    *(u32x4*)(MG + off + bj * 128) = pack8(acc[ai][bj][m][0] * g0, acc[ai][bj][m][1] * g1); } }
    }
};
struct EpiZ {
    static constexpr bool PERM = true;
    const bf16_t* HBF; bf16_t* Z;
    __device__ __forceinline__ void operator()(const f32x4 (&acc)[2][2][4][2], const Unit& u, int wr, int wc, int fr, int fq) const {
        const int row0 = u.pm * 256 + wr * 64 + fr, col0 = u.pn * 256 + wc * 32 + 8 * fq;
#pragma unroll
        for (int ai = 0; ai < 2; ++ai)
#pragma unroll
            for (int m = 0; m < 4; ++m) { const size_t off = (size_t)(row0 + ai * 128 + m * 16) * DM + col0;
#pragma unroll
                for (int bj = 0; bj < 2; ++bj) { const u32x4 hw = *(const u32x4*)(HBF + off + bj * 128); f32x4 h0, h1; unpack8(hw, h0, h1);
                    *(u32x4*)(Z + off + bj * 128) = pack8(acc[ai][bj][m][0] + h0 * ALPHA, acc[ai][bj][m][1] + h1 * ALPHA); } }
    }
};
struct EpiSwiglu {
    static constexpr bool PERM = true;
    bf16_t* HB; const int* LIST; const float* WGT; int* POSE; float* POSW;
    __device__ __forceinline__ void operator()(const f32x4 (&acc)[2][2][4][2], const Unit& u, int wr, int wc, int fr, int fq) const {
        const int row0 = u.pm * 256 + wr * 64 + fr, col0 = (u.pn & 3) * 128 + wc * 32 + 8 * fq;
#pragma unroll
        for (int ai = 0; ai < 2; ++ai)
#pragma unroll
            for (int m = 0; m < 4; ++m) { f32x4 v0, v1;
#pragma unroll
                for (int j = 0; j < 4; ++j) { const float g0 = acc[ai][0][m][0][j], g1 = acc[ai][0][m][1][j];
                    v0[j] = g0 * sigmoidf_(g0) * acc[ai][1][m][0][j]; v1[j] = g1 * sigmoidf_(g1) * acc[ai][1][m][1][j]; }
                *(u32x4*)(HB + (size_t)(row0 + ai * 128 + m * 16) * DFF + col0) = pack8(v0, v1); }
        if ((u.pn & 3) == 0 && wc == 0 && fq == 0) {
#pragma unroll
            for (int ai = 0; ai < 2; ++ai)
#pragma unroll
                for (int m = 0; m < 4; ++m) { const int r = wr * 64 + fr + ai * 128 + m * 16, slot = u.s0 + r; int entry = -1; float w = 0.f;
                    if (slot < u.cnt) { entry = LIST[(size_t)u.e * CAP + slot]; w = WGT[entry]; }
                    POSE[u.pm * 256 + r] = entry; POSW[u.pm * 256 + r] = w; }
        }
    }
};
struct EpiDown {
    static constexpr bool PERM = true;
    const int* POSE; const float* POSW; bf16_t* YK;
    __device__ __forceinline__ void operator()(const f32x4 (&acc)[2][2][4][2], const Unit& u, int wr, int wc, int fr, int fq) const {
        const int r0 = u.pm * 256 + wr * 64 + fr, col0 = (u.pn & 7) * 256 + wc * 32 + 8 * fq;
        int en[2][4]; float ww[2][4];
#pragma unroll
        for (int ai = 0; ai < 2; ++ai)
#pragma unroll
            for (int m = 0; m < 4; ++m) { en[ai][m] = POSE[r0 + ai * 128 + m * 16]; ww[ai][m] = POSW[r0 + ai * 128 + m * 16]; }
#pragma unroll
        for (int ai = 0; ai < 2; ++ai)
#pragma unroll
            for (int m = 0; m < 4; ++m) {
                if (en[ai][m] >= 0) { const float w = ww[ai][m]; bf16_t* rowp = YK + (size_t)en[ai][m] * DM + col0;
#pragma unroll
                    for (int bj = 0; bj < 2; ++bj) *(u32x4*)(rowp + bj * 128) = pack8(acc[ai][bj][m][0] * w, acc[ai][bj][m][1] * w); } }
    }
};
struct MoeOrder {
    int G, c, shift, NB; const LAS int* blkexp; const LAS int* blkstart; const LAS int* cntE; const int* LIST;
    __device__ __forceinline__ bool next(int i, Unit& u) const {
        const long L = (long)i * G + c; if (L >= ((long)NB << shift)) return false;
        const int blk = (int)(L >> shift), tile = (int)(L & ((1 << shift) - 1)), e = blkexp[blk];
        u.pm = blk; u.pn = (e << shift) + tile; u.e = e; u.s0 = (blk - blkstart[e]) * 256; u.cnt = cntE[e]; return true;
    }
    __device__ __forceinline__ int arow(const Unit& u, int r) const { const int slot = u.s0 + r; const int entry = slot < u.cnt ? LIST[(size_t)u.e * CAP + slot] : 0; return entry >> 1; }
};

struct Ctx { LAS unsigned char* lds; int tid, lane, wave, vcu, G; };

__device__ __forceinline__ void transpose_item(const float* W, int K, int N, bf16_t* WT, int kb, int nb, int dst_row0, LAS float* scr, int lane) {
    const int k0 = 64 * kb, n0 = 32 * nb;
    float tv[32];
#pragma unroll
    for (int i = 0; i < 32; ++i) tv[i] = W[(size_t)(k0 + 2 * i + (lane >> 5)) * N + n0 + (lane & 31)];
#pragma unroll
    for (int i = 0; i < 32; ++i) scr[(2 * i + (lane >> 5)) * 33 + (lane & 31)] = tv[i];
    asm volatile("s_waitcnt lgkmcnt(0)" ::: "memory");
    const int c = lane & 7;
#pragma unroll
    for (int j = 0; j < 4; ++j) { const int n = (lane >> 3) + 8 * j; const LAS float* s = scr + (8 * c) * 33 + n;
        u32x4 o; o.x = cvt_pk_bf16(s[0 * 33], s[1 * 33]); o.y = cvt_pk_bf16(s[2 * 33], s[3 * 33]); o.z = cvt_pk_bf16(s[4 * 33], s[5 * 33]); o.w = cvt_pk_bf16(s[6 * 33], s[7 * 33]);
        *(u32x4*)(WT + (size_t)(dst_row0 + n) * K + k0 + 8 * c) = o; }
    asm volatile("s_waitcnt lgkmcnt(0)" ::: "memory");
}
__device__ __forceinline__ void ln_stats(f32x4 (&v)[8], float& mean, float& rstd) {
    float s = 0.f;
#pragma unroll
    for (int j = 0; j < 8; ++j) s += (v[j].x + v[j].y) + (v[j].z + v[j].w);
    mean = wave_sum(s) * (1.f / DM); float s2 = 0.f;
#pragma unroll
    for (int j = 0; j < 8; ++j) { const f32x4 d = v[j] - mean; s2 += (d.x * d.x + d.y * d.y) + (d.z * d.z + d.w * d.w); }
    rstd = 1.f / sqrtf(wave_sum(s2) * (1.f / DM) + LN_EPS);
}

__device__ __forceinline__ void p0_prologue(const Ctx& C, const float* const* in, unsigned char* ws) {
    LAS float* scr = (LAS float*)(C.lds + C.wave * 16384);
    const int gw = C.vcu * 8 + C.wave, NGW = C.G * 8;
    bf16_t* WinT = (bf16_t*)(ws + WS_WIN); bf16_t* WgluT = (bf16_t*)(ws + WS_WGLU); bf16_t* WbsT = (bf16_t*)(ws + WS_WBS); bf16_t* WbaT = (bf16_t*)(ws + WS_WBA);
    bf16_t* WoT = (bf16_t*)(ws + WS_WO); bf16_t* WupT = (bf16_t*)(ws + WS_WUP);
    constexpr int I_WIN = (DM / 64) * (INC / 32), I_GLU = (SSMW / 64) * (SSMW / 32), I_BS = (SSMW / 64) * (DM / 32), I_BA = (AW / 64) * (DM / 32), I_WO = (DM / 64) * (DM / 32);
    constexpr int I_EXP = NE * 512;
    constexpr int NITEMS = I_WIN + I_GLU + I_BS + I_BA + I_WO + 2 * I_EXP;
    for (int it = gw; it < NITEMS; it += NGW) {
        int r = it;
        if (r < I_WIN) { const int nblk = INC / 32, nb = r % nblk, n0 = 32 * nb;
            const int drow = n0 < 3584 ? n0 : (n0 < 5632 ? 3584 + ((n0 - 3584) >> 7) * 256 + ((n0 - 3584) & 127) : 3584 + ((n0 - 5632) >> 7) * 256 + 128 + ((n0 - 5632) & 127));
            transpose_item(in[4], DM, INC, WinT, r / nblk, nb, drow, scr, C.lane); continue; } r -= I_WIN;
        if (r < I_GLU) { const int nblk = SSMW / 32; transpose_item(in[13], SSMW, SSMW, WgluT, r / nblk, r % nblk, 32 * (r % nblk), scr, C.lane); continue; } r -= I_GLU;
        if (r < I_BS) { const int nblk = DM / 32; transpose_item(in[19], SSMW, DM, WbsT, r / nblk, r % nblk, 32 * (r % nblk), scr, C.lane); continue; } r -= I_BS;
        if (r < I_BA) { const int nblk = DM / 32; transpose_item(in[20], AW, DM, WbaT, r / nblk, r % nblk, 32 * (r % nblk), scr, C.lane); continue; } r -= I_BA;
        if (r < I_WO) { const int nblk = DM / 32; transpose_item(in[21], DM, DM, WoT, r / nblk, r % nblk, 32 * (r % nblk), scr, C.lane); continue; } r -= I_WO;
        if (r < 2 * I_EXP) { const int up = r >= I_EXP ? 1 : 0; r -= up * I_EXP; const int e = r >> 9, rr = r & 511, kb = rr >> 4, nb = rr & 15, n0 = 32 * nb;
            transpose_item(in[28 + up] + (size_t)e * DM * DFF, DM, DFF, WupT, kb, nb, e * 1024 + (n0 >> 7) * 256 + up * 128 + (n0 & 127), scr, C.lane); continue; }
    }
    const int gt = C.vcu * 512 + C.tid, NGT = C.G * 512;
    { float* WrT = (float*)(ws + WS_WRT);
      for (int i = gt; i < 36 * DM; i += NGT) { const int n = i / DM, k = i % DM; WrT[i] = n < 4 ? in[24][k * 4 + n] : in[26][k * 32 + (n - 4)]; } }
    { u32x4* kz = (u32x4*)(ws + WS_KMETA + 16 * 1024 * 2); u32x4* vz = (u32x4*)(ws + WS_VMETA + 16 * 1024 * 2);
      for (int i = gt; i < 48 * 1024 * 2 / 16; i += NGT) { kz[i] = (u32x4){0u, 0u, 0u, 0u}; vz[i] = (u32x4){0u, 0u, 0u, 0u}; } }
    { float* AB = (float*)(ws + WS_SSMAB); float* BB = (float*)(ws + WS_SSMBB);
      for (int i = gt; i < NGRP * NST; i += NGT) { const int g = i >> 6;
        const double lre = fmin((double)in[5][i], -1e-4), lim = (double)in[6][i], dt = exp((double)in[7][g]);
        const double mag = exp(lre * dt), abr = mag * cos(lim * dt), abi = mag * sin(lim * dt), den = lre * lre + lim * lim, nr = abr - 1.0, ni = abi;
        const double zr = (nr * lre + ni * lim) / den, zi = (ni * lre - nr * lim) / den;
        AB[i] = (float)abr; AB[NGRP * NST + i] = (float)abi;
#pragma unroll 4
        for (int c = 0; c < 16; ++c) { const double br = (double)in[8][i * 16 + c], bi = (double)in[9][i * 16 + c];
            BB[i * 16 + c] = (float)(zr * br - zi * bi); BB[NGRP * NST * 16 + i * 16 + c] = (float)(zr * bi + zi * br); } } }
    const float* lg = in[2]; const float* lb = in[3];
    bf16_t* HBF = (bf16_t*)(ws + WS_HBF);
    for (int m = gw; m < T + NMETA; m += 2 * NGW) {
        const int m2 = (m + NGW < T + NMETA) ? m + NGW : m;
        const float* xa = m >= T ? in[1] + (size_t)(m - T) * DM : in[0] + (size_t)m * DM; const float* xb = m2 >= T ? in[1] + (size_t)(m2 - T) * DM : in[0] + (size_t)m2 * DM;
        f32x4 va[8], vb[8];
#pragma unroll
        for (int j = 0; j < 8; ++j) { va[j] = *(const f32x4*)(xa + 256 * j + 4 * C.lane); vb[j] = *(const f32x4*)(xb + 256 * j + 4 * C.lane); }
        float meana, rstda, meanb, rstdb; ln_stats(va, meana, rstda); ln_stats(vb, meanb, rstdb);
#pragma unroll
        for (int rr = 0; rr < 2; ++rr) { const int mm = rr ? m2 : m; if (rr == 1 && m2 == m) break; const bool meta = mm >= T;
#pragma unroll
            for (int j = 0; j < 8; ++j) { const f32x4 gg = *(const f32x4*)(lg + 256 * j + 4 * C.lane), bb = *(const f32x4*)(lb + 256 * j + 4 * C.lane);
                const f32x4 o = rr ? (vb[j] - meanb) * rstdb * gg + bb : (va[j] - meana) * rstda * gg + bb;
                if (meta) *(f32x4*)((float*)(ws + WS_HMETA) + (size_t)(mm - T) * DM + 256 * j + 4 * C.lane) = o;
                else { u32x2 w; w.x = cvt_pk_bf16(o.x, o.y); w.y = cvt_pk_bf16(o.z, o.w); *(u32x2*)(HBF + (size_t)mm * DM + 256 * j + 4 * C.lane) = w; } } }
    }
}

__device__ __forceinline__ void p1_meta_proj(const Ctx& C, unsigned char* ws) {
    const bf16_t* WinT = (const bf16_t*)(ws + WS_WIN); const float* HM = (const float*)(ws + WS_HMETA);
    const int gw = C.vcu * 8 + C.wave, NGW = C.G * 8;
    for (int it = gw; it < 640; it += NGW) {
        const int nidx = 4 * it; const int col0 = nidx < 512 ? nidx : (nidx < 1536 ? 1536 + (nidx - 512) : 2560 + (nidx - 1536));
        float acc[16][4];
#pragma unroll
        for (int r = 0; r < 16; ++r)
#pragma unroll
            for (int c = 0; c < 4; ++c) acc[r][c] = 0.f;
#pragma unroll 1
        for (int j = 0; j < 4; ++j) { const int k0 = j * 512 + C.lane * 8;
            f32x4 w0[4], w1[4];
#pragma unroll
            for (int c = 0; c < 4; ++c) { const u32x4 ww = *(const u32x4*)(WinT + (size_t)(col0 + c) * DM + k0); unpack8(ww, w0[c], w1[c]); }
#pragma unroll
            for (int r = 0; r < 16; ++r) { const f32x4 h0 = *(const f32x4*)(HM + r * DM + k0), h1 = *(const f32x4*)(HM + r * DM + k0 + 4);
#pragma unroll
                for (int c = 0; c < 4; ++c) { const f32x4 p = h0 * w0[c] + h1 * w1[c]; acc[r][c] += (p.x + p.y) + (p.z + p.w); } } }
        float mine = 0.f;
#pragma unroll
        for (int r = 0; r < 16; ++r)
#pragma unroll
            for (int c = 0; c < 4; ++c) { const float s = wave_sum(acc[r][c]); mine = (C.lane == r * 4 + c) ? s : mine; }
        const int r = C.lane >> 2, c = C.lane & 3;
        if (nidx < 512) ((float*)(ws + WS_UMETA))[r * SSMW + nidx + c] = mine;
        else if (nidx < 1536) ((bf16_t*)(ws + WS_KMETA))[r * AW + (nidx - 512) + c] = (bf16_t)(cvt_pk_bf16(mine, 0.f) & 0xffffu);
        else ((bf16_t*)(ws + WS_VMETA))[r * AW + (nidx - 1536) + c] = (bf16_t)(cvt_pk_bf16(mine, 0.f) & 0xffffu);
    }
}

__device__ __forceinline__ float gelu_tanh(float x) { const float u = 1.5957691216057308f * (x + 0.044715f * x * x * x); return x / (1.0f + __expf(-u)); }
#define SC_HANDOFF(Q) do { _Pragma("unroll") for (int st_ = 0; st_ < 2; ++st_) { \
        auto rr_ = __builtin_amdgcn_permlane32_swap(__float_as_uint(sre[st_]), __float_as_uint(sre[st_]), false, false); sre[st_] = __uint_as_float(rr_[(Q) & 1]); \
        auto ri_ = __builtin_amdgcn_permlane32_swap(__float_as_uint(sim[st_]), __float_as_uint(sim[st_]), false, false); sim[st_] = __uint_as_float(ri_[(Q) & 1]); } } while (0)
template <bool STORE> __device__ __forceinline__ void scan_block(f32x16 (&buv)[4], float (&sre)[2], float (&sim)[2], const float (&are)[2], const float (&aim)[2], int hi) {
    float bu[4][16];
#pragma unroll
    for (int t = 0; t < 4; ++t)
#pragma unroll
        for (int r = 0; r < 16; ++r) bu[t][r] = buv[t][r];
#pragma unroll
    for (int q = 0; q < 8; ++q) {
        const bool act = (hi == (q & 1));
#pragma unroll
        for (int i = 0; i < 4; ++i) { const int reg = 4 * (q >> 1) + i;
#pragma unroll
            for (int st = 0; st < 2; ++st) {
                const float nre = __builtin_fmaf(are[st], sre[st], __builtin_fmaf(-aim[st], sim[st], bu[st][reg]));
                const float nim = __builtin_fmaf(are[st], sim[st], __builtin_fmaf(aim[st], sre[st], bu[2 + st][reg]));
                sre[st] = nre; sim[st] = nim;
                if (STORE) { bu[st][reg] = act ? nre : bu[st][reg]; bu[2 + st][reg] = act ? nim : bu[2 + st][reg]; } } }
        SC_HANDOFF(q);
    }
    if (STORE) {
#pragma unroll
        for (int t = 0; t < 4; ++t)
#pragma unroll
            for (int r = 0; r < 16; ++r) buv[t][r] = bu[t][r];
    }
}
__device__ __forceinline__ void p2_scan(const Ctx& C, const float* const* in, unsigned char* ws) {
    const int lane = C.lane, wave = C.wave, r32 = lane & 31, hi = lane >> 5, fr = lane & 15, fq = lane >> 4;
    const bf16_t* U = (const bf16_t*)(ws + WS_U); const float* UM = (const float*)(ws + WS_UMETA); bf16_t* YPRE = (bf16_t*)(ws + WS_YPRE);
    const float* AB = (const float*)(ws + WS_SSMAB); const float* BB = (const float*)(ws + WS_SSMBB);
    LAS unsigned char* Sl = C.lds + wave * 10752;
    LAS unsigned char* Yl = Sl + 9728;
    LAS float* E = (LAS float*)(C.lds + 86016);
    for (int item = C.vcu; item < NB_ * NGRP; item += C.G) {
        const int b = item >> 5, g = item & 31;
        const bf16_t* Ub = U + ((size_t)b * SEQ + wave * 256) * SSMW + 16 * g;
        bf16x8 ufa[8];
#pragma unroll
        for (int blk = 0; blk < 8; ++blk) ufa[blk] = *(const bf16x8*)(Ub + (size_t)(32 * blk + r32) * SSMW + 8 * hi);
        float are[2], aim[2];
#pragma unroll
        for (int st = 0; st < 2; ++st) { are[st] = AB[g * 64 + 32 * st + r32]; aim[st] = AB[NGRP * NST + g * 64 + 32 * st + r32]; }
        bf16x8 Bf[4];
#pragma unroll
        for (int ri = 0; ri < 2; ++ri)
#pragma unroll
            for (int st = 0; st < 2; ++st) { const float* src = BB + ri * (NGRP * NST * 16) + (g * 64 + 32 * st + r32) * 16 + 8 * hi;
                const f32x4 x0 = *(const f32x4*)src, x1 = *(const f32x4*)(src + 4); Bf[2 * ri + st] = __builtin_bit_cast(bf16x8, pack8(x0, x1)); }
        bf16x8 Cf[5];
#pragma unroll
        for (int ks = 0; ks < 4; ++ks) { const int k0 = 32 * ks + 8 * fq; const float* src = (ks < 2 ? in[10] : in[11]) + (g * 16 + fr) * 64 + (k0 & 63);
            f32x4 x0 = *(const f32x4*)src, x1 = *(const f32x4*)(src + 4); if (ks >= 2) { x0 = -x0; x1 = -x1; } Cf[ks] = __builtin_bit_cast(bf16x8, pack8(x0, x1)); }
        { const float dsk = in[12][g * 16 + fr]; f32x4 x0, x1;
#pragma unroll
          for (int j = 0; j < 4; ++j) { x0[j] = (fq < 2 && 8 * fq + j == fr) ? dsk : 0.f; x1[j] = (fq < 2 && 8 * fq + 4 + j == fr) ? dsk : 0.f; }
          Cf[4] = __builtin_bit_cast(bf16x8, pack8(x0, x1)); }
        float sre[2] = {0.f, 0.f}, sim[2] = {0.f, 0.f}, mre[2] = {0.f, 0.f}, mim[2] = {0.f, 0.f};
        if (wave == 0) {
            f32x4 x0 = (f32x4){0.f, 0.f, 0.f, 0.f}, x1 = x0;
            if (r32 >= 16) { const float* src = UM + (r32 - 16) * SSMW + 16 * g + 8 * hi; x0 = *(const f32x4*)src; x1 = *(const f32x4*)(src + 4); }
            const bf16x8 uf = __builtin_bit_cast(bf16x8, pack8(x0, x1));
            f32x16 bu[4];
#pragma unroll
            for (int t = 0; t < 4; ++t) bu[t] = __builtin_amdgcn_mfma_f32_32x32x16_bf16(uf, Bf[t], (f32x16){}, 0, 0, 0);
            scan_block<false>(bu, sre, sim, are, aim, hi);
            mre[0] = sre[0]; mre[1] = sre[1]; mim[0] = sim[0]; mim[1] = sim[1];
        }
#pragma unroll
        for (int blk = 0; blk < 8; ++blk) {
            f32x16 bu[4];
#pragma unroll
            for (int t = 0; t < 4; ++t) bu[t] = __builtin_amdgcn_mfma_f32_32x32x16_bf16(ufa[blk], Bf[t], (f32x16){}, 0, 0, 0);
            scan_block<false>(bu, sre, sim, are, aim, hi);
        }
        if (hi == 0) {
#pragma unroll
            for (int st = 0; st < 2; ++st) { E[wave * 128 + st * 64 + r32] = sre[st]; E[wave * 128 + st * 64 + 32 + r32] = sim[st]; } }
        __syncthreads();
        if (wave == 0) { sre[0] = mre[0]; sre[1] = mre[1]; sim[0] = mim[0]; sim[1] = mim[1]; }
        else {
            float pr[2], pi[2];
#pragma unroll
            for (int st = 0; st < 2; ++st) { pr[st] = are[st]; pi[st] = aim[st];
#pragma unroll
                for (int k = 0; k < 8; ++k) { const float nr = pr[st] * pr[st] - pi[st] * pi[st], ni = 2.f * pr[st] * pi[st]; pr[st] = nr; pi[st] = ni; }
                sre[st] = E[st * 64 + r32]; sim[st] = E[st * 64 + 32 + r32]; }
            for (int j = 1; j < wave; ++j) {
#pragma unroll
                for (int st = 0; st < 2; ++st) { const float er = E[j * 128 + st * 64 + r32], ei = E[j * 128 + st * 64 + 32 + r32];
                    const float nr = pr[st] * sre[st] - pi[st] * sim[st] + er, ni = pr[st] * sim[st] + pi[st] * sre[st] + ei; sre[st] = nr; sim[st] = ni; } }
        }
#pragma unroll
        for (int blk = 0; blk < 8; ++blk) {
            f32x16 bu[4];
#pragma unroll
            for (int t = 0; t < 4; ++t) bu[t] = __builtin_amdgcn_mfma_f32_32x32x16_bf16(ufa[blk], Bf[t], (f32x16){}, 0, 0, 0);
            scan_block<true>(bu, sre, sim, are, aim, hi);
#pragma unroll
            for (int reg = 0; reg < 16; ++reg) { const int tok = (reg & 3) + 8 * (reg >> 2) + 4 * hi;
#pragma unroll
                for (int t = 0; t < 4; ++t) *(LAS bf16_t*)(Sl + tok * 304 + (32 * t + r32) * 2) = (bf16_t)(cvt_pk_bf16(bu[t][reg], 0.f) & 0xffffu); }
            *(LAS bf16x8*)(Sl + r32 * 304 + (128 + 8 * hi) * 2) = ufa[blk];
            f32x4 y[2];
#pragma unroll
            for (int mt = 0; mt < 2; ++mt) { y[mt] = (f32x4){0.f, 0.f, 0.f, 0.f};
#pragma unroll
                for (int ks = 0; ks < 4; ++ks) { const bf16x8 af = *(const LAS bf16x8*)(Sl + (16 * mt + fr) * 304 + (32 * ks + 8 * fq) * 2);
                    y[mt] = __builtin_amdgcn_mfma_f32_16x16x32_bf16(af, Cf[ks], y[mt], 0, 0, 0); }
                bf16x8 au = *(const LAS bf16x8*)(Sl + (16 * mt + fr) * 304 + (128 + 8 * (fq & 1)) * 2); if (fq >= 2) au = (bf16x8){};
                y[mt] = __builtin_amdgcn_mfma_f32_16x16x32_bf16(au, Cf[4], y[mt], 0, 0, 0); }
#pragma unroll
            for (int mt = 0; mt < 2; ++mt)
#pragma unroll
                for (int reg = 0; reg < 4; ++reg) *(LAS bf16_t*)(Yl + (16 * mt + 4 * fq + reg) * 32 + fr * 2) = (bf16_t)(cvt_pk_bf16(gelu_tanh(y[mt][reg]), 0.f) & 0xffffu);
            const u32x4 yo = *(const LAS u32x4*)(Yl + (lane >> 1) * 32 + (lane & 1) * 16);
            *(u32x4*)(YPRE + ((size_t)b * SEQ + wave * 256 + 32 * blk + (lane >> 1)) * SSMW + 16 * g + 8 * (lane & 1)) = yo;
        }
        __syncthreads();
    }
}

__device__ __forceinline__ int crow(int r, int hi) { return (r & 3) + 8 * (r >> 2) + 4 * hi; }
typedef short v4i16_t __attribute__((ext_vector_type(4)));
__device__ __forceinline__ s16x4 vtr(const LAS unsigned char* p) { return __builtin_bit_cast(s16x4, __builtin_amdgcn_ds_read_tr16_b64_v4i16((LAS v4i16_t*)p)); }
__device__ __forceinline__ float half_swap_max(float x) { auto rr = __builtin_amdgcn_permlane32_swap(__float_as_uint(x), __float_as_uint(x), false, false); return fmaxf(__uint_as_float(rr[0]), __uint_as_float(rr[1])); }
__device__ __forceinline__ float half_swap_sum(float x) { auto rr = __builtin_amdgcn_permlane32_swap(__float_as_uint(x), __float_as_uint(x), false, false); return __uint_as_float(rr[0]) + __uint_as_float(rr[1]); }

__device__ __forceinline__ void attn_pv(f32x16 (&o)[4], const bf16x8 (&pa)[4], unsigned vaddr) {
    s16x4 vl[2][4], vh[2][4];
#define ATT_VRD(SET, D) do { _Pragma("unroll") for (int ks_ = 0; ks_ < 4; ++ks_) { \
        asm volatile("ds_read_b64_tr_b16 %0, %1 offset:%2" : "=&v"(vl[SET][ks_]) : "v"(vaddr), "i"((D) * 4096 + ks_ * 1024) : "memory"); \
        asm volatile("ds_read_b64_tr_b16 %0, %1 offset:%2" : "=&v"(vh[SET][ks_]) : "v"(vaddr), "i"((D) * 4096 + ks_ * 1024 + 512) : "memory"); } } while (0)
    __builtin_amdgcn_sched_barrier(0);
    ATT_VRD(0, 0);
#pragma unroll
    for (int d = 0; d < 4; ++d) {
        if (d == 0) { ATT_VRD(1, 1); } else if (d == 1) { ATT_VRD(0, 2); } else if (d == 2) { ATT_VRD(1, 3); }
        if (d < 3) asm volatile("s_waitcnt lgkmcnt(8)" ::: "memory"); else asm volatile("s_waitcnt lgkmcnt(0)" ::: "memory");
        __builtin_amdgcn_sched_barrier(0);
#pragma unroll
        for (int ks = 0; ks < 4; ++ks) { const s16x4 lo = vl[d & 1][ks], hv = vh[d & 1][ks];
            const bf16x8 vf = (bf16x8){lo[0], lo[1], lo[2], lo[3], hv[0], hv[1], hv[2], hv[3]};
            o[d] = __builtin_amdgcn_mfma_f32_32x32x16_bf16(pa[ks], vf, o[d], 0, 0, 0); }
        __builtin_amdgcn_sched_barrier(0);
    }
#undef ATT_VRD
}
__device__ __forceinline__ void attn_qk(f32x16& p0, f32x16& p1, const LAS unsigned char* kb, const bf16x8 (&qr)[4]) {
    p0 = (f32x16){}; p1 = (f32x16){};
#pragma unroll
    for (int d0 = 0; d0 < 4; ++d0) { const bf16x8 b0 = *(const LAS bf16x8*)(kb + d0 * 2048), b1 = *(const LAS bf16x8*)(kb + d0 * 2048 + 512);
        p0 = __builtin_amdgcn_mfma_f32_32x32x16_bf16(b0, qr[d0], p0, 0, 0, 0); p1 = __builtin_amdgcn_mfma_f32_32x32x16_bf16(b1, qr[d0], p1, 0, 0, 0); }
}
__device__ __forceinline__ void attn_softmax(const bool FIRST, f32x16& p0, f32x16& p1, f32x16 (&o)[4], float& mrun, float& lrun, bf16x8 (&pa)[4], LAS float* wsf, int r32, int hi) {
    if (FIRST) {
        asm volatile("" ::: "memory");
#pragma unroll
        for (int r = 0; r < 16; ++r) { if (r >= 8) p0[r] = -__builtin_inff(); p1[r] = -__builtin_inff(); } }
    float rmA = fmaxf(p0[0], p0[1]), rmB = fmaxf(p0[2], p0[3]), rmC = fmaxf(p1[0], p1[1]), rmD = fmaxf(p1[2], p1[3]);
#pragma unroll
    for (int r = 4; r < 16; r += 4) { rmA = fmaxf(rmA, fmaxf(p0[r], p0[r + 1])); rmB = fmaxf(rmB, fmaxf(p0[r + 2], p0[r + 3])); rmC = fmaxf(rmC, fmaxf(p1[r], p1[r + 1])); rmD = fmaxf(rmD, fmaxf(p1[r + 2], p1[r + 3])); }
    const float rm = half_swap_max(fmaxf(fmaxf(rmA, rmB), fmaxf(rmC, rmD)));
    if (FIRST) mrun = rm;
    else if (__any(rm > mrun + 8.0f)) {
        const float mnew = fmaxf(mrun, rm), alpha = __builtin_amdgcn_exp2f(mrun - mnew);
        lrun *= alpha; mrun = mnew;
        if (hi == 0) wsf[r32] = alpha;
        f32x4 a4[4];
#pragma unroll
        for (int gq = 0; gq < 4; ++gq) a4[gq] = *(const LAS f32x4*)(wsf + 8 * gq + 4 * hi);
#pragma unroll
        for (int d = 0; d < 4; ++d)
#pragma unroll
            for (int r = 0; r < 16; ++r) o[d][r] *= a4[r >> 2][r & 3];
    }
    float psA = 0.f, psB = 0.f, psC = 0.f, psD = 0.f;
#pragma unroll
    for (int r = 0; r < 16; r += 2) { p0[r] = __builtin_amdgcn_exp2f(p0[r] - mrun); p0[r + 1] = __builtin_amdgcn_exp2f(p0[r + 1] - mrun); p1[r] = __builtin_amdgcn_exp2f(p1[r] - mrun); p1[r + 1] = __builtin_amdgcn_exp2f(p1[r + 1] - mrun);
        psA += p0[r]; psB += p0[r + 1]; psC += p1[r]; psD += p1[r + 1]; }
    lrun += (psA + psB) + (psC + psD);
    u32x4 w;
    w = (u32x4){cvt_pk_bf16(p0[0], p0[1]), cvt_pk_bf16(p0[2], p0[3]), cvt_pk_bf16(p0[4], p0[5]), cvt_pk_bf16(p0[6], p0[7])}; pa[0] = __builtin_bit_cast(bf16x8, w);
    w = (u32x4){cvt_pk_bf16(p0[8], p0[9]), cvt_pk_bf16(p0[10], p0[11]), cvt_pk_bf16(p0[12], p0[13]), cvt_pk_bf16(p0[14], p0[15])}; pa[1] = __builtin_bit_cast(bf16x8, w);
    w = (u32x4){cvt_pk_bf16(p1[0], p1[1]), cvt_pk_bf16(p1[2], p1[3]), cvt_pk_bf16(p1[4], p1[5]), cvt_pk_bf16(p1[6], p1[7])}; pa[2] = __builtin_bit_cast(bf16x8, w);
    w = (u32x4){cvt_pk_bf16(p1[8], p1[9]), cvt_pk_bf16(p1[10], p1[11]), cvt_pk_bf16(p1[12], p1[13]), cvt_pk_bf16(p1[14], p1[15])}; pa[3] = __builtin_bit_cast(bf16x8, w);
}
__device__ __forceinline__ void glds16(const void* gsrc, unsigned lds_dst) { unsigned keep;
    asm volatile("s_mov_b32 %0, m0\n\ts_mov_b32 m0, %2\n\ts_nop 0\n\tglobal_load_lds_dwordx4 %1, off\n\ts_mov_b32 m0, %0" : "=&s"(keep) : "v"(gsrc), "s"(lds_dst) : "memory"); }
__device__ __forceinline__ void attn_unit(const Ctx& C, const bf16_t* Qg, const bf16_t* Kg, const bf16_t* Vg, const bf16_t* KM, const bf16_t* VM, bf16_t* Y,
                                          const float* subg, float lam, int b, int h, int qt, bool prefetched, int nqt, bf16x8 (&qr)[4], bool rb) {
    LAS unsigned char* lds = C.lds;
    const int lane = C.lane, wave = C.wave, r32 = lane & 31, hi = lane >> 5, qb = wave >> 1, map = wave & 1;
    const int q0 = qt * 128 + qb * 32;
    const size_t rowb = (size_t)b * SEQ;
    if (!prefetched) { const bf16_t* qp = Qg + (rowb + q0 + r32) * AW + h * 128 + map * 64 + hi * 8;
#pragma unroll
      for (int d0 = 0; d0 < 4; ++d0) qr[d0] = *(const bf16x8*)(qp + d0 * 16); }
    const int NT = 2 * qt + 3;
    const bool skip_last = (qb < 2);
    f32x16 o[4];
#pragma unroll
    for (int d = 0; d < 4; ++d) o[d] = (f32x16){};
    float mrun = -__builtin_inff(), lrun = 0.f;
    LAS float* wsf = (LAS float*)(lds + MISC_OFF + 4096 + wave * 256);
    const bf16_t* Kb = Kg + rowb * AW; const bf16_t* Vb = Vg + rowb * AW;
#define ATT_DMA(step, stage) do { const bf16_t* ks_ = (step) == 0 ? KM : Kb; const bf16_t* vs_ = (step) == 0 ? VM : Vb; const int row0_ = (step) == 0 ? 0 : ((step) - 1) * 64; \
    _Pragma("unroll") for (int i_ = 0; i_ < 2; ++i_) { const int p_ = 2 * wave + i_; \
        __builtin_amdgcn_global_load_lds((const unsigned*)(ks_ + (size_t)(row0_ + lane) * AW + h * 128 + (p_ >> 3) * 64 + (p_ & 7) * 8), (LAS unsigned*)(lds + (stage) * 32768 + p_ * 1024), 16, 0, 0); \
        __builtin_amdgcn_global_load_lds((const unsigned*)(vs_ + (size_t)(row0_ + 16 * (p_ & 3) + (lane >> 2)) * AW + h * 128 + (p_ >> 2) * 32 + (lane & 3) * 8), (LAS unsigned*)(lds + (stage) * 32768 + 16384 + p_ * 1024), 16, 0, 0); } } while (0)
    const int myNT = skip_last ? NT - 1 : NT;
    bf16x8 pa[4];
#pragma unroll
    for (int k = 0; k < 4; ++k) pa[k] = (bf16x8){};
    if (!prefetched) ATT_DMA(0, 0);
    asm volatile("s_waitcnt vmcnt(0)" ::: "memory"); __syncthreads();
    int stage = 0;
#pragma unroll 1
    for (int s = 0; s <= NT; ++s) {
        const int stn = stage == 2 ? 0 : stage + 1, stp = stage == 0 ? 2 : stage - 1;
        if (s + 1 < NT) ATT_DMA(s + 1, stn);
        if (rb && s >= 1 && s <= myNT) attn_pv(o, pa, (unsigned)(uintptr_t)(lds + stp * 32768 + 16384 + ((lane >> 4) & 1) * 32 + (lane & 3) * 8 + (4 * hi + ((lane & 15) >> 2)) * 64));
        if (s < myNT) {
            f32x16 p0, p1; attn_qk(p0, p1, lds + stage * 32768 + map * 8192 + hi * 1024 + r32 * 16, qr);
            attn_softmax(s == 0, p0, p1, o, mrun, lrun, pa, wsf, r32, hi);
            if (!rb) attn_pv(o, pa, (unsigned)(uintptr_t)(lds + stage * 32768 + 16384 + ((lane >> 4) & 1) * 32 + (lane & 3) * 8 + (4 * hi + ((lane & 15) >> 2)) * 64));
        }
        asm volatile("s_waitcnt vmcnt(0)" ::: "memory"); __syncthreads();
        stage = stn;
    }
#undef ATT_DMA
    bf16x8 qn[4];
#pragma unroll
    for (int d0 = 0; d0 < 4; ++d0) qn[d0] = qr[d0];
    if (nqt >= 0) {
        const unsigned lds0 = (unsigned)(uintptr_t)lds;
#pragma unroll
        for (int i = 0; i < 2; ++i) { const int p = 2 * wave + i;
            glds16(KM + (size_t)lane * AW + h * 128 + (p >> 3) * 64 + (p & 7) * 8, (unsigned)__builtin_amdgcn_readfirstlane(lds0 + p * 1024));
            glds16(VM + (size_t)(16 * (p & 3) + (lane >> 2)) * AW + h * 128 + (p >> 2) * 32 + (lane & 3) * 8, (unsigned)__builtin_amdgcn_readfirstlane(lds0 + 16384 + p * 1024)); }
        const bf16_t* qp = Qg + (rowb + nqt * 128 + qb * 32 + r32) * AW + h * 128 + map * 64 + hi * 8;
#pragma unroll
        for (int d0 = 0; d0 < 4; ++d0) qn[d0] = *(const bf16x8*)(qp + d0 * 16);
    }
    { const float ltot = half_swap_sum(lrun); const float inv = (map ? lam : 1.0f) / ltot;
      if (hi == 0) wsf[r32] = inv;
      f32x4 a4[4];
#pragma unroll
      for (int gq = 0; gq < 4; ++gq) a4[gq] = *(const LAS f32x4*)(wsf + 8 * gq + 4 * hi);
#pragma unroll
      for (int d = 0; d < 4; ++d)
#pragma unroll
          for (int r = 0; r < 16; ++r) o[d][r] *= a4[r >> 2][r & 3]; }
    LAS float* X = (LAS float*)(lds + 32768 + qb * 16384);
    if (map == 1) {
#pragma unroll
        for (int d = 0; d < 4; ++d)
#pragma unroll
            for (int r = 0; r < 16; ++r) X[crow(r, hi) * 128 + 32 * d + r32] = o[d][r];
    }
    __syncthreads();
    if (map == 0) {
        float ssq[16];
#pragma unroll
        for (int r = 0; r < 16; ++r) ssq[r] = 0.f;
#pragma unroll
        for (int d = 0; d < 4; ++d)
#pragma unroll
            for (int r = 0; r < 16; ++r) { const float v = o[d][r] - X[crow(r, hi) * 128 + 32 * d + r32]; o[d][r] = v; ssq[r] += v * v; }
#pragma unroll
        for (int r = 0; r < 16; ++r) {
#pragma unroll
            for (int off = 1; off < 32; off <<= 1) ssq[r] += __shfl_xor(ssq[r], off);
            ssq[r] = 0.8f / sqrtf(ssq[r] * (1.f / 128.f) + LN_EPS); }
        LAS bf16_t* Yt = (LAS bf16_t*)X;
#pragma unroll
        for (int d = 0; d < 4; ++d) { const float gg = subg[32 * d + r32];
#pragma unroll
            for (int r = 0; r < 16; ++r) Yt[crow(r, hi) * 128 + 32 * d + r32] = (bf16_t)(cvt_pk_bf16(o[d][r] * ssq[r] * gg, 0.f) & 0xffffu); }
#pragma unroll
        for (int i = 0; i < 8; ++i) { const int id = i * 64 + lane, row = id >> 4, ch = id & 15;
            *(u32x4*)(Y + (rowb + q0 + row) * AW + h * 128 + ch * 8) = *(const LAS u32x4*)(Yt + row * 128 + ch * 8); }
    }
#pragma unroll
    for (int d0 = 0; d0 < 4; ++d0) qr[d0] = qn[d0];
    __syncthreads();
}
__device__ __forceinline__ void p3_attention(const Ctx& C, const float* const* in, unsigned char* ws) {
    const bf16_t* Q = (const bf16_t*)(ws + WS_Q); const bf16_t* K = (const bf16_t*)(ws + WS_K); const bf16_t* V = (const bf16_t*)(ws + WS_V);
    const bf16_t* KM = (const bf16_t*)(ws + WS_KMETA); const bf16_t* VM = (const bf16_t*)(ws + WS_VMETA); bf16_t* Y = (bf16_t*)(ws + WS_YATT);
    const float l1 = wave_sum(in[14][C.lane] * in[15][C.lane]), l2 = wave_sum(in[16][C.lane] * in[17][C.lane]);
    const float lam = expf(l1) - expf(l2) + 0.2f;
    LAS unsigned* rc = (LAS unsigned*)(C.lds + MISC_OFF + 6144);
    if (C.tid < 4) rc[C.tid] = 0;
    __syncthreads();
    bool rb;
    { const unsigned simd = (unsigned)__builtin_amdgcn_s_getreg(2308) & 3u;
      unsigned r = 0; if (C.lane == 0) r = __hip_atomic_fetch_add(rc + simd, 1u, __ATOMIC_RELAXED, __HIP_MEMORY_SCOPE_WORKGROUP);
      rb = (__builtin_amdgcn_readfirstlane((int)r) & 1) != 0; }
#ifndef ATT_REP
#define ATT_REP 1
#endif
    for (int vv = C.vcu; vv < 256 * ATT_REP; vv += C.G) { const int v = vv & 255;
        const int bh = v >> 1, sft = v & 1;
        bf16x8 qr[4];
#pragma unroll
        for (int d0 = 0; d0 < 4; ++d0) qr[d0] = (bf16x8){};
#pragma unroll 1
        for (int i = 0; i < 8; ++i) { const int qt = (i & 1) ? (15 - sft - (i & ~1)) : (sft + (i & ~1)); const int i1 = i + 1;
            const int nqt = i1 < 8 ? ((i1 & 1) ? (15 - sft - (i1 & ~1)) : (sft + (i1 & ~1))) : -1;
            attn_unit(C, Q, K, V, KM, VM, Y, in[18], lam, bh >> 3, bh & 7, qt, i > 0, nqt, qr, rb); }
    }
}

__device__ __forceinline__ void p6_ln1_router(const Ctx& C, const float* const* in, unsigned char* ws) {
    const int lane = C.lane, wave = C.wave, tid = C.tid;
    const bf16_t* Z = (const bf16_t*)(ws + WS_Z); bf16_t* H1 = (bf16_t*)(ws + WS_H1); const float* WrT = (const float*)(ws + WS_WRT);
    int* LIST = (int*)(ws + WS_LIST); float* WGT = (float*)(ws + WS_WGT); unsigned* ECNT = (unsigned*)(ws + WS_CTL) + CW_ECNT;
    const float* lg = in[22]; const float* lb = in[23];
    LAS float* WB = (LAS float*)C.lds;
    LAS unsigned char* XB = C.lds + 98304;
    LAS int* RE = (LAS int*)(XB);
    LAS float* RW = (LAS float*)(XB + 1024);
    LAS int* CL = (LAS int*)(XB + 2048);
    LAS int* BS = (LAS int*)(XB + 2048 + 128);
    LAS int* SL = (LAS int*)(XB + 2048 + 256);
    LAS float* LG = (LAS float*)(XB + 4096) + wave * 80;
    for (int rbk = C.vcu; rbk < T / 128; rbk += C.G) {
        if (tid < 32) CL[tid] = 0;
#pragma unroll 1
        for (int step = 0; step < 8; ++step) {
            const int lr0 = step * 16 + 2 * wave; const size_t row0 = (size_t)rbk * 128 + lr0;
            int l4 = 4 * lane; asm volatile("" : "+v"(l4));
            f32x4 v0[8], v1[8];
#pragma unroll
            for (int j = 0; j < 8; ++j) { const u32x2 z0 = *(const u32x2*)(Z + row0 * DM + 256 * j + l4), z1 = *(const u32x2*)(Z + (row0 + 1) * DM + 256 * j + l4);
                v0[j] = (f32x4){bf_lo(z0.x), bf_hi(z0.x), bf_lo(z0.y), bf_hi(z0.y)}; v1[j] = (f32x4){bf_lo(z1.x), bf_hi(z1.x), bf_lo(z1.y), bf_hi(z1.y)}; }
            float mean0, rstd0, mean1, rstd1; ln_stats(v0, mean0, rstd0); ln_stats(v1, mean1, rstd1);
#pragma unroll
            for (int j = 0; j < 8; ++j) { const f32x4 gg = *(const f32x4*)(lg + 256 * j + l4), bb = *(const f32x4*)(lb + 256 * j + l4);
                v0[j] = (v0[j] - mean0) * rstd0 * gg + bb; v1[j] = (v1[j] - mean1) * rstd1 * gg + bb;
                u32x2 w; w.x = cvt_pk_bf16(v0[j].x, v0[j].y); w.y = cvt_pk_bf16(v0[j].z, v0[j].w); *(u32x2*)(H1 + row0 * DM + 256 * j + l4) = w;
                w.x = cvt_pk_bf16(v1[j].x, v1[j].y); w.y = cvt_pk_bf16(v1[j].z, v1[j].w); *(u32x2*)(H1 + (row0 + 1) * DM + 256 * j + l4) = w; }
#pragma unroll 1
            for (int ng = 0; ng < 3; ++ng) {
                __syncthreads();
                int tq = tid; asm volatile("" : "+v"(tq));
#pragma unroll
                for (int i = 0; i < 12; ++i) { const int idx = tq + 512 * i, n = idx >> 9, c4 = idx & 511;
                    *(LAS f32x4*)(WB + n * 2048 + 4 * c4) = *(const f32x4*)(WrT + (size_t)(12 * ng + n) * DM + 4 * c4); }
                __syncthreads();
#pragma unroll 1
                for (int n = 0; n < 12; ++n) { float pa = 0.f, pb = 0.f;
#pragma unroll
                    for (int j = 0; j < 8; ++j) { const f32x4 w4 = *(const LAS f32x4*)(WB + n * 2048 + 256 * j + l4);
                        const f32x4 a = v0[j] * w4, bq = v1[j] * w4; pa += (a.x + a.y) + (a.z + a.w); pb += (bq.x + bq.y) + (bq.z + bq.w); }
                    const float sa = wave_sum(pa), sb = wave_sum(pb); if (lane == 0) { LG[12 * ng + n] = sa; LG[40 + 12 * ng + n] = sb; } }
            }
            if (lane < 2) {
                const LAS float* L = LG + 40 * lane;
                int gi = 0; float gm = L[0] + in[25][0];
                for (int n = 1; n < 4; ++n) { const float x = L[n] + in[25][n]; if (x > gm) { gm = x; gi = n; } }
                float gs = 0.f;
                for (int n = 0; n < 4; ++n) gs += __expf(L[n] + in[25][n] - gm);
                const float gval = 1.0f / gs;
                int i1 = 0; float m1 = L[4 + gi * 8] + in[27][gi * 8];
                for (int j = 1; j < 8; ++j) { const float x = L[4 + gi * 8 + j] + in[27][gi * 8 + j]; if (x > m1) { m1 = x; i1 = j; } }
                int i2 = -1; float m2 = -__builtin_inff();
                for (int j = 0; j < 8; ++j) { const float x = L[4 + gi * 8 + j] + in[27][gi * 8 + j]; if (j != i1 && x > m2) { m2 = x; i2 = j; } }
                const float tt = __expf(m2 - m1), w1 = gval / (1.f + tt), w2 = gval * tt / (1.f + tt);
                const int lr = lr0 + lane; RE[lr * 2] = gi * 8 + i1; RE[lr * 2 + 1] = gi * 8 + i2; RW[lr * 2] = w1; RW[lr * 2 + 1] = w2;
            }
        }
        __syncthreads();
        int e = 0;
        if (tid < 256) { e = RE[tid]; SL[tid] = __hip_atomic_fetch_add(&CL[e], 1, __ATOMIC_RELAXED, __HIP_MEMORY_SCOPE_WORKGROUP); }
        __syncthreads();
        if (tid < 32) BS[tid] = (int)__hip_atomic_fetch_add(&ECNT[tid], (unsigned)CL[tid], __ATOMIC_RELAXED, __HIP_MEMORY_SCOPE_AGENT);
        __syncthreads();
        if (tid < 256) { const int entry = (rbk * 128 + (tid >> 1)) * 2 + (tid & 1); LIST[(size_t)e * CAP + BS[e] + SL[tid]] = entry; WGT[entry] = RW[tid]; }
        __syncthreads();
    }
}

__device__ __forceinline__ void p9_ln2(const Ctx& C, const float* const* in, unsigned char* ws, float* out) {
    const bf16_t* H1 = (const bf16_t*)(ws + WS_H1); const bf16_t* YK = (const bf16_t*)(ws + WS_YK);
    const float* lg = in[31]; const float* lb = in[32];
    const int gw = C.vcu * 8 + C.wave, NGW = C.G * 8, lane = C.lane;
    for (int m = gw; m < T; m += 2 * NGW) {
        const int m2 = (m + NGW < T) ? m + NGW : m;
        u32x2 ha[8], ya0[8], ya1[8], hb[8], yb0[8], yb1[8];
#pragma unroll
        for (int j = 0; j < 8; ++j) { const size_t c = 256 * j + 4 * lane;
            ha[j] = *(const u32x2*)(H1 + (size_t)m * DM + c); ya0[j] = *(const u32x2*)(YK + (size_t)(2 * m) * DM + c); ya1[j] = *(const u32x2*)(YK + (size_t)(2 * m + 1) * DM + c);
            hb[j] = *(const u32x2*)(H1 + (size_t)m2 * DM + c); yb0[j] = *(const u32x2*)(YK + (size_t)(2 * m2) * DM + c); yb1[j] = *(const u32x2*)(YK + (size_t)(2 * m2 + 1) * DM + c); }
#pragma unroll
        for (int rr = 0; rr < 2; ++rr) {
            f32x4 v[8];
#pragma unroll
            for (int j = 0; j < 8; ++j) { const u32x2 hw = rr ? hb[j] : ha[j], y0 = rr ? yb0[j] : ya0[j], y1 = rr ? yb1[j] : ya1[j];
                v[j] = (f32x4){bf_lo(hw.x), bf_hi(hw.x), bf_lo(hw.y), bf_hi(hw.y)} * ALPHA + (f32x4){bf_lo(y0.x), bf_hi(y0.x), bf_lo(y0.y), bf_hi(y0.y)} + (f32x4){bf_lo(y1.x), bf_hi(y1.x), bf_lo(y1.y), bf_hi(y1.y)}; }
            float mean, rstd; ln_stats(v, mean, rstd);
            const int mm = rr ? m2 : m;
            if (rr == 0 || m2 != m) {
#pragma unroll
                for (int j = 0; j < 8; ++j) { const f32x4 gg = *(const f32x4*)(lg + 256 * j + 4 * lane), bb = *(const f32x4*)(lb + 256 * j + 4 * lane);
                    *(f32x4*)(out + (size_t)mm * DM + 256 * j + 4 * lane) = (v[j] - mean) * rstd * gg + bb; } }
        }
    }
}

__device__ __forceinline__ int build_moe_tables(const Ctx& C, unsigned char* ws) {
    LAS int* blkstart = (LAS int*)(C.lds + MISC_OFF + 64); LAS int* cntE = (LAS int*)(C.lds + MISC_OFF + 320); LAS int* blkexp = (LAS int*)(C.lds + MISC_OFF + 512);
    unsigned* ECNT = (unsigned*)(ws + WS_CTL) + CW_ECNT;
    __syncthreads();
    if (C.tid < 32) cntE[C.tid] = (int)__hip_atomic_load(&ECNT[C.tid], __ATOMIC_RELAXED, __HIP_MEMORY_SCOPE_AGENT);
    __syncthreads();
    if (C.tid == 0) { int s = 0; for (int e = 0; e < NE; ++e) { blkstart[e] = s; s += (cntE[e] + 255) >> 8; } blkstart[NE] = s; }
    __syncthreads();
    const int NBLK = blkstart[NE];
    if (C.tid < NBLK && C.tid < 320) { int e = 0; for (int j = 1; j < NE; ++j) if (blkstart[j] <= C.tid) e = j; blkexp[C.tid] = e; }
    __syncthreads();
    return NBLK < 320 ? NBLK : 320;
}

__device__ __forceinline__ void p7_convert_down(const Ctx& C, const float* const* in, unsigned char* ws) {
    LAS float* scr = (LAS float*)(C.lds + C.wave * 16384);
    unsigned* ctr = (unsigned*)(ws + WS_CTL) + CW_CONV; bf16_t* WdnT = (bf16_t*)(ws + WS_WDN);
    constexpr int NCH = NE * 512 / 16;
    for (;;) {
        unsigned ch = 0; if (C.lane == 0) ch = __hip_atomic_fetch_add(ctr, 1u, __ATOMIC_RELAXED, __HIP_MEMORY_SCOPE_AGENT);
        ch = (unsigned)__builtin_amdgcn_readfirstlane((int)ch);
        if (ch >= (unsigned)NCH) break;
#pragma unroll 1
        for (int q = 0; q < 16; ++q) { const int r = (int)ch * 16 + q, e = r >> 9, rr = r & 511, kb = rr >> 6, nb = rr & 63;
            transpose_item(in[30] + (size_t)e * DFF * DM, DFF, DM, WdnT, kb, nb, e * 2048 + 32 * nb, scr, C.lane); }
    }
}

constexpr int NPHASE = 10;
struct Args { const float* in[33]; float* out; unsigned char* ws; int ph_lo, ph_hi; };
__global__ void __launch_bounds__(512, 2) mk_fwd(Args args) {
    extern __shared__ __attribute__((aligned(16))) unsigned char lds_raw[];
    Ctx C; C.lds = (LAS unsigned char*)lds_raw; C.tid = threadIdx.x; C.lane = C.tid & 63; C.wave = __builtin_amdgcn_readfirstlane(C.tid >> 6);
    C.G = gridDim.x; { const int bx = blockIdx.x; C.vcu = (C.G % 8 == 0) ? (bx % 8) * (C.G / 8) + bx / 8 : bx; }
    unsigned char* ws = args.ws; const float* const* in = args.in;
    volatile LAS unsigned* MISC = (volatile LAS unsigned*)(C.lds + MISC_OFF);
    if (C.tid < 16) MISC[C.tid] = 0u;
    __syncthreads();
    unsigned* barw = (unsigned*)(ws + WS_CTL) + CW_BAR;
    XcdBarrier bar; bar.bar = barw; bar.x = 0; bar.st = nullptr;
    const int lo = args.ph_lo, hi = args.ph_hi;
    if (hi - lo > 1) bar = xcd_barrier_post(barw, MISC);
#ifndef PH_MASK
#define PH_MASK 0x3ff
#endif
#define IN(k) (((PH_MASK >> (k)) & 1) && lo <= (k) && (k) < hi)
#define SEAM(k) do { if (IN(k) && IN((k) + 1)) xcd_barrier(bar); } while (0)
#ifndef WGM_PROJ
#define WGM_PROJ 4
#endif
#ifndef WGM_N2K
#define WGM_N2K 2
#endif
#ifndef GEMM_SP2
#define GEMM_SP2 true
#endif
#ifndef GEMM_ALIGN
#define GEMM_ALIGN true
#endif
#ifndef PROBE_MASK
#define PROBE_MASK 0
#endif
#define REPS(k) (((PROBE_MASK >> (k)) & 1) ? 2 : 1)
#define REPSEAM(k, rep) do { if ((rep) + 1 < REPS(k)) xcd_barrier(bar); } while (0)
    LAS unsigned char* lds = C.lds;
    bf16_t* MG = (bf16_t*)args.out;

    if (IN(0)) { _Pragma("unroll") for (int rep = 0; rep < REPS(0); ++rep) { p0_prologue(C, in, ws); REPSEAM(0, rep); } } SEAM(0);

    if (IN(1)) { _Pragma("unroll") for (int rep = 0; rep < REPS(1); ++rep) {
        pg8::Gemm g{(const bf16_t*)(ws + WS_HBF), (const bf16_t*)(ws + WS_WIN), T, INC, DM, nullptr, nullptr, 0}; pg8::StaticOrder S; S.init(T, INC, C.G, (int)blockIdx.x, WGM_PROJ);
        EpiProj E{(bf16_t*)(ws + WS_U), (bf16_t*)(ws + WS_Q), (bf16_t*)(ws + WS_K), (bf16_t*)(ws + WS_V), (bf16_t*)(ws + WS_SGS), (bf16_t*)(ws + WS_SGA)};
        pg8::gemm_phase<EpiProj, pg8::StaticOrder, GEMM_ALIGN, GEMM_SP2, false>(lds, g, S, E);
        p1_meta_proj(C, ws);
        REPSEAM(1, rep);
    } } SEAM(1);

    if (IN(2)) { _Pragma("unroll") for (int rep = 0; rep < REPS(2); ++rep) { p2_scan(C, in, ws); REPSEAM(2, rep); } } SEAM(2);

    if (IN(3)) { _Pragma("unroll") for (int rep = 0; rep < REPS(3); ++rep) {
        { pg8::Gemm g{(const bf16_t*)(ws + WS_YPRE), (const bf16_t*)(ws + WS_WGLU), T, SSMW, SSMW, nullptr, nullptr, 0}; pg8::StaticOrder S; S.init(T, SSMW, C.G, (int)blockIdx.x);
          EpiGlu E{(const bf16_t*)(ws + WS_YPRE), (bf16_t*)(ws + WS_YSSM)};
          pg8::gemm_phase<EpiGlu, pg8::StaticOrder, GEMM_ALIGN, GEMM_SP2, false>(lds, g, S, E); }
        p3_attention(C, in, ws);
        REPSEAM(3, rep);
    } } SEAM(3);

    if (IN(4)) { _Pragma("unroll") for (int rep = 0; rep < REPS(4); ++rep) {
        { pg8::Gemm g{(const bf16_t*)(ws + WS_YSSM), (const bf16_t*)(ws + WS_WBS), T, DM, SSMW, (const bf16_t*)(ws + WS_YATT), (const bf16_t*)(ws + WS_WBA), AW}; pg8::StaticOrder S; S.init(T, DM, C.G, (int)blockIdx.x, WGM_N2K);
          EpiMergeF E{(const bf16_t*)(ws + WS_SGS), (const bf16_t*)(ws + WS_SGA), MG};
          pg8::gemm_phase<EpiMergeF, pg8::StaticOrder, GEMM_ALIGN, GEMM_SP2, false, true>(lds, g, S, E); }
        REPSEAM(4, rep);
    } } SEAM(4);

    if (IN(5)) { _Pragma("unroll") for (int rep = 0; rep < REPS(5); ++rep) {
        pg8::Gemm g{MG, (const bf16_t*)(ws + WS_WO), T, DM, DM, nullptr, nullptr, 0}; pg8::StaticOrder S; S.init(T, DM, C.G, (int)blockIdx.x, WGM_N2K);
        EpiZ E{(const bf16_t*)(ws + WS_HBF), (bf16_t*)(ws + WS_Z)};
        pg8::gemm_phase<EpiZ, pg8::StaticOrder, GEMM_ALIGN, GEMM_SP2, false>(lds, g, S, E);
        REPSEAM(5, rep);
    } } SEAM(5);

    if (IN(6)) { p6_ln1_router(C, in, ws); } SEAM(6);

    if (IN(7)) { _Pragma("unroll") for (int rep = 0; rep < REPS(7); ++rep) {
        const int NBLK = build_moe_tables(C, ws);
        MoeOrder S{C.G, C.vcu, 2, NBLK, (const LAS int*)(lds + MISC_OFF + 512), (const LAS int*)(lds + MISC_OFF + 64), (const LAS int*)(lds + MISC_OFF + 320), (const int*)(ws + WS_LIST)};
        pg8::Gemm g{(const bf16_t*)(ws + WS_H1), (const bf16_t*)(ws + WS_WUP), T, NE * 1024, DM, nullptr, nullptr, 0};
        EpiSwiglu E{(bf16_t*)(ws + WS_HB), (const int*)(ws + WS_LIST), (const float*)(ws + WS_WGT), (int*)(ws + WS_POSE), (float*)(ws + WS_POSW)};
        pg8::gemm_phase<EpiSwiglu, MoeOrder, GEMM_ALIGN, GEMM_SP2, true>(lds, g, S, E);
        p7_convert_down(C, in, ws);
        REPSEAM(7, rep);
    } } SEAM(7);

    if (IN(8)) { _Pragma("unroll") for (int rep = 0; rep < REPS(8); ++rep) {
        const int NBLK = build_moe_tables(C, ws);
        MoeOrder S{C.G, C.vcu, 3, NBLK, (const LAS int*)(lds + MISC_OFF + 512), (const LAS int*)(lds + MISC_OFF + 64), (const LAS int*)(lds + MISC_OFF + 320), (const int*)(ws + WS_LIST)};
        pg8::Gemm g{(const bf16_t*)(ws + WS_HB), (const bf16_t*)(ws + WS_WDN), NBLK * 256, NE * DM, DFF, nullptr, nullptr, 0};
        EpiDown E{(const int*)(ws + WS_POSE), (const float*)(ws + WS_POSW), (bf16_t*)(ws + WS_YK)};
        pg8::gemm_phase<EpiDown, MoeOrder, GEMM_ALIGN, GEMM_SP2, false>(lds, g, S, E);
        REPSEAM(8, rep);
    } } SEAM(8);

    if (IN(9)) { _Pragma("unroll") for (int rep = 0; rep < REPS(9); ++rep) { p9_ln2(C, in, ws, args.out); REPSEAM(9, rep); } }
#undef IN
#undef SEAM
}

extern "C" void kernel_launch(void* const* d_in, const int* in_sizes, int n_in, void* d_out, int out_size, void* d_ws, size_t ws_size, hipStream_t stream) {
    static int grid = 0;
    if (grid == 0) {
        if (n_in != 33 || in_sizes[0] != T * DM || out_size != T * DM || ws_size < WS_END) { fprintf(stderr, "kernel_launch: unexpected shapes (n_in %d, in0 %d, out %d, ws %zu)\n", n_in, n_in > 0 ? in_sizes[0] : -1, out_size, ws_size); grid = -1; return; }
        int dev = 0, cus = 0, per_cu = 0;
        if (hipGetDevice(&dev) != hipSuccess || hipDeviceGetAttribute(&cus, hipDeviceAttributeMultiprocessorCount, dev) != hipSuccess) { grid = -1; return; }
        if (hipFuncSetAttribute((const void*)mk_fwd, hipFuncAttributeMaxDynamicSharedMemorySize, LDS_BYTES) != hipSuccess) { fprintf(stderr, "kernel_launch: hipFuncSetAttribute failed\n"); grid = -1; return; }
        if (hipOccupancyMaxActiveBlocksPerMultiprocessor(&per_cu, (const void*)mk_fwd, 512, LDS_BYTES) != hipSuccess || per_cu < 1) { fprintf(stderr, "kernel_launch: occupancy query reports %d blocks per CU\n", per_cu); }
        (void)hipGetLastError();
        grid = cus;
    }
    if (grid < 0) return;
    (void)hipMemsetAsync((char*)d_ws + WS_CTL, 0, CTL_ZERO_BYTES, stream);
    Args a{};
    for (int i = 0; i < 33; ++i) a.in[i] = (const float*)d_in[i];
    a.out = (float*)d_out; a.ws = (unsigned char*)d_ws;
#if MK_PER_PHASE
    for (int p = 0; p < NPHASE; ++p) { a.ph_lo = p; a.ph_hi = p + 1; hipLaunchKernelGGL(mk_fwd, dim3(grid), dim3(512), LDS_BYTES, stream, a); }
#else
    a.ph_lo = 0; a.ph_hi = NPHASE; hipLaunchKernelGGL(mk_fwd, dim3(grid), dim3(512), LDS_BYTES, stream, a);
#endif
}
```

```cpp
#include <hip/hip_runtime.h>
#include <stdint.h>
#include <stdio.h>

#ifndef ATT_PROBE
#define ATT_PROBE 0
#endif
#ifndef MK_PER_PHASE
#define MK_PER_PHASE 0
#endif

#define GAS __attribute__((address_space(1)))
#define LAS __attribute__((address_space(3)))
typedef unsigned short bf16_t;
typedef short bf16x8 __attribute__((ext_vector_type(8)));
typedef short s16x4 __attribute__((ext_vector_type(4)));
typedef float f32x2 __attribute__((ext_vector_type(2)));
typedef float f32x4 __attribute__((ext_vector_type(4)));
typedef float f32x16 __attribute__((ext_vector_type(16)));
typedef unsigned u32x2 __attribute__((ext_vector_type(2)));
typedef unsigned u32x4 __attribute__((ext_vector_type(4)));

constexpr int NB_ = 16, SEQ = 2048, DM = 2048, T = NB_ * SEQ, NMETA = 16;
constexpr int SSMW = 512, AW = 1024, INC = 7680, NGRP = 32, NST = 64;
constexpr int NE = 32, DFF = 512, CAP = T;
constexpr float LN_EPS = 1e-5f;
constexpr float ALPHA = 1.189207115002721f;
constexpr float QSCALE = 0.125f * 1.4426950408889634f;

__device__ __forceinline__ unsigned cvt_pk_bf16(float lo, float hi) { unsigned r; asm volatile("v_cvt_pk_bf16_f32 %0, %1, %2" : "=v"(r) : "v"(lo), "v"(hi)); return r; }
__device__ __forceinline__ float bf_lo(unsigned w) { return __uint_as_float(w << 16); }
__device__ __forceinline__ float bf_hi(unsigned w) { return __uint_as_float(w & 0xffff0000u); }
__device__ __forceinline__ float sigmoidf_(float x) { return 1.0f / (1.0f + __expf(-x)); }
__device__ __forceinline__ float wave_sum(float v) {
#pragma unroll
    for (int o = 1; o < 64; o <<= 1) v += __shfl_xor(v, o);
    return v;
}

namespace pg8 {
constexpr int BM = 256, BK = 64, HALF = 128, HTB = HALF * BK * 2, STAGE_BYTES = 8 * HTB, NXCD = 8, WGM = 4;
__host__ __device__ __forceinline__ int lds_byte(int r, int c) { const int st = (r >> 4) * 2 + (c >> 5), rr = r & 15, cc = c & 31, ob = rr * 64 + cc * 2; return st * 1024 + (ob ^ (((ob >> 9) & 1) << 5)); }
__host__ __device__ __forceinline__ void stage_rc(int b, int& R, int& C) { const int st = b / 1024, sb = b % 1024, swz = sb ^ (((sb >> 9) & 1) << 5); R = (st >> 1) * 16 + swz / 64; C = (st & 1) * 32 + (swz % 64) / 2; }
__host__ __device__ __forceinline__ int perm32(int rho) { const int n = rho >> 4, i = rho & 15; return 8 * (i >> 2) + 4 * n + (i & 3); }

struct Unit { int pm, pn, e, s0, cnt; };
struct Gemm { const bf16_t* A; const bf16_t* Bt; int M, N, K; const bf16_t* A2; const bf16_t* Bt2; int K2; };

struct StaticOrder {
    int nM, nN, nwg, G, c, wgm;
    __device__ void init(int M, int N, int G_, int c_, int wgm_ = WGM) { nM = M / BM; nN = N / BM; nwg = nM * nN; G = G_; c = c_; wgm = wgm_; }
    __device__ bool next(int i, Unit& u) const {
        const long L = (long)i * G + c; if (L >= nwg) return false;
        int wgid = (int)L; { const int q = nwg / NXCD, r = nwg % NXCD, xcd = wgid % NXCD, off = wgid / NXCD; wgid = (xcd < r ? xcd * (q + 1) : r * (q + 1) + (xcd - r) * q) + off; }
        const int nig = wgm * nN, gid = wgid / nig, fm = gid * wgm, gsz = (nM - fm) < wgm ? (nM - fm) : wgm;
        u.pm = fm + ((wgid % nig) % gsz); u.pn = (wgid % nig) / gsz; u.e = 0; u.s0 = 0; u.cnt = 0; return true;
    }
    __device__ __forceinline__ int arow(const Unit&, int) const { return 0; }
};

template <class Epi, class Sched, bool ALIGN_EPI, bool SP2, bool GATHER, bool DUAL = false>
__device__ __forceinline__ void gemm_phase(LAS unsigned char* lds, const Gemm g, const Sched& S, const Epi& E) {
    const int tid = threadIdx.x, wid = __builtin_amdgcn_readfirstlane(tid >> 6), lane = tid & 63, wr = wid >> 2, wc = wid & 3, fr = lane & 15, fq = lane >> 4;
    const int K = g.K, K2 = DUAL ? g.K2 : 0, nt1 = K / BK, nt = (K + K2) / BK;
    unsigned voffA[2], voffB[2], voffA2[2] = {0u, 0u}, voffB2[2] = {0u, 0u}; int stR[2], stC[2];
#pragma unroll
    for (int i = 0; i < 2; ++i) { int R, C; stage_rc(tid * 16 + i * 8192, R, C); const int Rb = Epi::PERM ? ((R & ~31) + perm32(R & 31)) : R;
        stR[i] = R; stC[i] = C; voffA[i] = (unsigned)(R * K + C) * 2u; voffB[i] = (unsigned)(Rb * K + C) * 2u;
        if constexpr (DUAL) { voffA2[i] = (unsigned)(R * K2 + C) * 2u; voffB2[i] = (unsigned)(Rb * K2 + C) * 2u; } }
    const size_t kstep = (size_t)(BK * 2);
    const size_t hstep = (size_t)HALF * K * 2;
    const size_t tstep = 2 * hstep;
    const size_t hstep2 = (size_t)HALF * K2 * 2, tstep2 = 2 * hstep2;
    const unsigned ldsw = (unsigned)wid * 1024u;
    const int aoff = lds_byte(wr * 64 + fr, fq * 8), boff = lds_byte(wc * 32 + fr, fq * 8);
#define PG8_SA(b, h) (((b) * 2 + (h)) * HTB)
#define PG8_SB(b, h) ((4 + (b) * 2 + (h)) * HTB)
#define PG8_STAGE(bufoff, gbase, voff) do { _Pragma("unroll") for (int _i = 0; _i < 2; ++_i) \
        __builtin_amdgcn_global_load_lds((const unsigned*)((const char*)(gbase) + (voff)[_i]), (LAS unsigned*)(lds + (bufoff) + ldsw + _i * 8192), 16, 0, 0); } while (0)
#define PG8_STAGE_A(bufoff, kbase, h, VO) do { if constexpr (GATHER) { PG8_STAGE(bufoff, kbase, VO[h]); } else { PG8_STAGE(bufoff, (kbase) + (h) * hstep, voffA); } } while (0)
#define PG8_STAGE_AX(bufoff, kbase, h, VO, HS, VA) do { if constexpr (GATHER) { PG8_STAGE(bufoff, kbase, VO[h]); } else { PG8_STAGE(bufoff, (kbase) + (h) * (HS), VA); } } while (0)
#define PG8_LDA(dst, b, h) do { _Pragma("unroll") for (int m = 0; m < 4; ++m) _Pragma("unroll") for (int k = 0; k < 2; ++k) dst[m][k] = *(const LAS bf16x8*)(lds + PG8_SA(b, h) + aoff + m * 2048 + k * 1024); } while (0)
#define PG8_LDB(dst, b, h) do { _Pragma("unroll") for (int n = 0; n < 2; ++n) _Pragma("unroll") for (int k = 0; k < 2; ++k) dst[n][k] = *(const LAS bf16x8*)(lds + PG8_SB(b, h) + boff + n * 2048 + k * 1024); } while (0)
#define PG8_MMA(ai, bj, At, Bt) do { __builtin_amdgcn_s_setprio(1); _Pragma("unroll") for (int m = 0; m < 4; ++m) _Pragma("unroll") for (int n = 0; n < 2; ++n) _Pragma("unroll") for (int k = 0; k < 2; ++k) \
        acc[ai][bj][m][n] = __builtin_amdgcn_mfma_f32_16x16x32_bf16(Bt[n][k], At[m][k], acc[ai][bj][m][n], 0, 0, 0); __builtin_amdgcn_s_setprio(0); } while (0)
#define PG8_WAIT_V(n) asm volatile("s_waitcnt vmcnt(" #n ")" ::: "memory")
#define PG8_WAIT_L(n) asm volatile("s_waitcnt lgkmcnt(" #n ")" ::: "memory")
#define PG8_BAR __builtin_amdgcn_s_barrier()
#define PG8_SCHED __builtin_amdgcn_sched_barrier(0)
#define PG8_GOFF(VO, U) do { _Pragma("unroll") for (int _h = 0; _h < 2; ++_h) _Pragma("unroll") for (int _i = 0; _i < 2; ++_i) \
        VO[_h][_i] = (unsigned)S.arow(U, _h * HALF + stR[_i]) * (unsigned)(K * 2) + (unsigned)(stC[_i] * 2); } while (0)
    Unit cur, nxt; int ui = 0;
    if (!S.next(0, cur)) return;
    f32x4 acc[2][2][4][2];
#pragma unroll
    for (int a = 0; a < 2; ++a)
#pragma unroll
        for (int b = 0; b < 2; ++b)
#pragma unroll
            for (int m = 0; m < 4; ++m)
#pragma unroll
                for (int n = 0; n < 2; ++n) acc[a][b][m][n] = (f32x4){0.f, 0.f, 0.f, 0.f};
    bf16x8 At[4][2], B0[2][2], B1[2][2];
    unsigned cvo[2][2] = {{0u, 0u}, {0u, 0u}}, nvo[2][2] = {{0u, 0u}, {0u, 0u}};
    const char* cA = GATHER ? (const char*)g.A : (const char*)g.A + (size_t)cur.pm * tstep; const char* cB = (const char*)g.Bt + (size_t)cur.pn * tstep;
    if constexpr (GATHER) { PG8_GOFF(cvo, cur); }
    if constexpr (SP2) {
        PG8_STAGE(PG8_SB(0, 0), cB, voffB); PG8_STAGE(PG8_SB(0, 1), cB + hstep, voffB); PG8_STAGE_A(PG8_SA(0, 0), cA, 0, cvo); PG8_STAGE_A(PG8_SA(0, 1), cA, 1, cvo);
        if (wr == 1) PG8_BAR;
        PG8_WAIT_V(2); PG8_BAR;
        PG8_STAGE(PG8_SB(1, 0), cB + kstep, voffB); PG8_STAGE_A(PG8_SA(1, 0), cA + kstep, 0, cvo); PG8_STAGE(PG8_SB(1, 1), cB + hstep + kstep, voffB);
        PG8_WAIT_V(6); PG8_BAR;
    } else {
        PG8_STAGE(PG8_SB(0, 0), cB, voffB); PG8_STAGE_A(PG8_SA(0, 0), cA, 0, cvo); PG8_STAGE(PG8_SB(0, 1), cB + hstep, voffB); PG8_STAGE_A(PG8_SA(0, 1), cA, 1, cvo);
        if (wr == 1) PG8_BAR;
        PG8_WAIT_V(4); PG8_BAR;
        PG8_STAGE(PG8_SB(1, 0), cB + kstep, voffB); PG8_STAGE_A(PG8_SA(1, 0), cA + kstep, 0, cvo); PG8_STAGE(PG8_SB(1, 1), cB + hstep + kstep, voffB);
        PG8_WAIT_V(6); PG8_BAR;
    }
    for (;;) {
        const bool has_next = S.next(ui + 1, nxt);
        const char* nA = GATHER ? cA : (has_next ? (const char*)g.A + (size_t)nxt.pm * tstep : cA); const char* nB = has_next ? (const char*)g.Bt + (size_t)nxt.pn * tstep : cB;
        if constexpr (GATHER) { if (has_next) { PG8_GOFF(nvo, nxt); } else {
#pragma unroll
            for (int h = 0; h < 2; ++h)
#pragma unroll
                for (int i = 0; i < 2; ++i) nvo[h][i] = cvo[h][i]; } }
        const char* cA2 = DUAL ? (const char*)g.A2 + (size_t)cur.pm * tstep2 : cA; const char* cB2 = DUAL ? (const char*)g.Bt2 + (size_t)cur.pn * tstep2 : cB;
        for (int t = 0; t < nt; t += 2) {
            const bool last = (t == nt - 2);
            const bool s1 = DUAL && (t + 1 >= nt1), s2 = DUAL && !last && (t + 2 >= nt1);
            const char* a1 = s1 ? cA2 + (size_t)(t + 1 - nt1) * kstep : cA + (size_t)(t + 1) * kstep;
            const char* a2 = last ? nA : (s2 ? cA2 + (size_t)(t + 2 - nt1) * kstep : cA + (size_t)(t + 2) * kstep);
            const char* b2 = last ? nB : (s2 ? cB2 + (size_t)(t + 2 - nt1) * kstep : cB + (size_t)(t + 2) * kstep);
            const char* a3 = a2 + kstep; const char* b3 = b2 + kstep;
            const size_t hs1 = s1 ? hstep2 : hstep, hs2 = s2 ? hstep2 : hstep;
            unsigned vA1[2], vA2[2], vB2[2];
#pragma unroll
            for (int i = 0; i < 2; ++i) { vA1[i] = s1 ? voffA2[i] : voffA[i]; vA2[i] = s2 ? voffA2[i] : voffA[i]; vB2[i] = s2 ? voffB2[i] : voffB[i]; }
            unsigned svo[2][2];
#pragma unroll
            for (int h = 0; h < 2; ++h)
#pragma unroll
                for (int i = 0; i < 2; ++i) svo[h][i] = last ? nvo[h][i] : cvo[h][i];
            if constexpr (SP2) {
            PG8_LDB(B0, 0, 0); PG8_LDB(B1, 0, 1); PG8_SCHED; PG8_LDA(At, 0, 0); PG8_STAGE_AX(PG8_SA(1, 1), a1, 1, cvo, hs1, vA1);
            PG8_WAIT_V(8); PG8_WAIT_L(0); PG8_BAR; PG8_MMA(0, 0, At, B0); PG8_MMA(0, 1, At, B1); PG8_BAR; PG8_SCHED;
            PG8_LDA(At, 0, 1); PG8_STAGE(PG8_SB(0, 0), b2, vB2); PG8_STAGE(PG8_SB(0, 1), b2 + hs2, vB2); PG8_STAGE_AX(PG8_SA(0, 0), a2, 0, svo, hs2, vA2);
            PG8_WAIT_V(8); PG8_WAIT_L(0); PG8_BAR; PG8_MMA(1, 0, At, B0); PG8_MMA(1, 1, At, B1); PG8_BAR; PG8_SCHED;
            PG8_LDB(B0, 1, 0); PG8_LDB(B1, 1, 1); PG8_SCHED; PG8_LDA(At, 1, 0); PG8_STAGE_AX(PG8_SA(0, 1), a2, 1, svo, hs2, vA2);
            PG8_WAIT_V(8); PG8_WAIT_L(0); PG8_BAR; PG8_MMA(0, 0, At, B0); PG8_MMA(0, 1, At, B1); PG8_BAR; PG8_SCHED;
            PG8_LDA(At, 1, 1); PG8_STAGE(PG8_SB(1, 0), b3, vB2); PG8_STAGE(PG8_SB(1, 1), b3 + hs2, vB2); PG8_STAGE_AX(PG8_SA(1, 0), a3, 0, svo, hs2, vA2);
            PG8_WAIT_V(8); PG8_WAIT_L(0); PG8_BAR; PG8_MMA(1, 0, At, B0); PG8_MMA(1, 1, At, B1); PG8_BAR; PG8_SCHED;
            } else {
            PG8_LDB(B0, 0, 0); PG8_SCHED; PG8_LDA(At, 0, 0); PG8_STAGE_AX(PG8_SA(1, 1), a1, 1, cvo, hs1, vA1);
            PG8_WAIT_L(8); PG8_BAR; PG8_WAIT_L(0); PG8_MMA(0, 0, At, B0); PG8_BAR; PG8_SCHED;
            PG8_LDB(B1, 0, 1); PG8_STAGE(PG8_SB(0, 0), b2, vB2);
            PG8_BAR; PG8_WAIT_L(0); PG8_MMA(0, 1, At, B1); PG8_BAR;
            PG8_LDA(At, 0, 1); PG8_STAGE_AX(PG8_SA(0, 0), a2, 0, svo, hs2, vA2);
            PG8_BAR; PG8_WAIT_L(0); PG8_MMA(1, 0, At, B0); PG8_BAR; PG8_SCHED;
            PG8_STAGE(PG8_SB(0, 1), b2 + hs2, vB2);
            PG8_WAIT_V(6); PG8_BAR; PG8_MMA(1, 1, At, B1); PG8_BAR;
            PG8_LDB(B0, 1, 0); PG8_SCHED; PG8_LDA(At, 1, 0); PG8_STAGE_AX(PG8_SA(0, 1), a2, 1, svo, hs2, vA2);
            PG8_WAIT_L(8); PG8_BAR; PG8_WAIT_L(0); PG8_MMA(0, 0, At, B0); PG8_BAR; PG8_SCHED;
            PG8_LDB(B1, 1, 1); PG8_STAGE(PG8_SB(1, 0), b3, vB2);
            PG8_BAR; PG8_WAIT_L(0); PG8_MMA(0, 1, At, B1); PG8_BAR;
            PG8_LDA(At, 1, 1); PG8_STAGE_AX(PG8_SA(1, 0), a3, 0, svo, hs2, vA2);
            PG8_BAR; PG8_WAIT_L(0); PG8_MMA(1, 0, At, B0); PG8_BAR; PG8_SCHED;
            PG8_STAGE(PG8_SB(1, 1), b3 + hs2, vB2);
            PG8_WAIT_V(6); PG8_BAR; PG8_MMA(1, 1, At, B1); PG8_BAR;
            }
            if constexpr (DUAL) { if (t + 2 == nt1) E.mid(acc, cur, wr, wc, fr, fq); }
        }
        if constexpr (ALIGN_EPI) { if (wr == 0) PG8_BAR; }
        E(acc, cur, wr, wc, fr, fq);
        if (!has_next) break;
#pragma unroll
        for (int a = 0; a < 2; ++a)
#pragma unroll
            for (int b = 0; b < 2; ++b)
#pragma unroll
                for (int m = 0; m < 4; ++m)
#pragma unroll
                    for (int n = 0; n < 2; ++n) acc[a][b][m][n] = (f32x4){0.f, 0.f, 0.f, 0.f};
        cur = nxt; cA = nA; cB = nB; ++ui;
#pragma unroll
        for (int h = 0; h < 2; ++h)
#pragma unroll
            for (int i = 0; i < 2; ++i) cvo[h][i] = nvo[h][i];
        if constexpr (ALIGN_EPI) { if (wr == 1) PG8_BAR; }
    }
    PG8_WAIT_V(0);
    if constexpr (!ALIGN_EPI) { if (wr == 0) PG8_BAR; }
    PG8_BAR;
#undef PG8_SA
#undef PG8_SB
#undef PG8_STAGE
#undef PG8_STAGE_A
#undef PG8_STAGE_AX
#undef PG8_LDA
#undef PG8_LDB
#undef PG8_MMA
#undef PG8_WAIT_V
#undef PG8_WAIT_L
#undef PG8_BAR
#undef PG8_SCHED
#undef PG8_GOFF
}
}

constexpr size_t MiB = 1u << 20;
constexpr size_t WS_CTL = 0, CTL_ZERO_BYTES = 1 * MiB;
constexpr size_t WS_HMETA = 1 * MiB;
constexpr size_t WS_UMETA = WS_HMETA + 128 * 1024;
constexpr size_t WS_KMETA = WS_HMETA + 256 * 1024;
constexpr size_t WS_VMETA = WS_HMETA + 384 * 1024;
constexpr size_t WS_SSMAB = WS_HMETA + 512 * 1024;
constexpr size_t WS_SSMBB = WS_HMETA + 576 * 1024;
constexpr size_t WS_WRT = 2 * MiB;
constexpr size_t WS_WIN = 3 * MiB;
constexpr size_t WS_WGLU = 33 * MiB;
constexpr size_t WS_WBS = 34 * MiB;
constexpr size_t WS_WBA = 36 * MiB;
constexpr size_t WS_WO = 40 * MiB;
constexpr size_t WS_WUP = 48 * MiB;
constexpr size_t WS_WDN = 176 * MiB;
constexpr size_t WS_HBF = 240 * MiB;
constexpr size_t WS_U = 368 * MiB;
constexpr size_t WS_Q = 400 * MiB;
constexpr size_t WS_K = 464 * MiB;
constexpr size_t WS_V = 528 * MiB;
constexpr size_t WS_SGS = 592 * MiB;
constexpr size_t WS_SGA = 720 * MiB;
constexpr size_t WS_YPRE = 848 * MiB;
constexpr size_t WS_YSSM = 880 * MiB;
constexpr size_t WS_YATT = 912 * MiB;
constexpr size_t WS_END = 976 * MiB;
constexpr size_t WS_Z = 368 * MiB;
constexpr size_t WS_H1 = 624 * MiB;
constexpr size_t WS_HB = 752 * MiB;
constexpr size_t WS_YK = 368 * MiB;
constexpr size_t WS_LIST = 848 * MiB;
constexpr size_t WS_WGT = 852 * MiB;
constexpr size_t WS_POSE = 853 * MiB;
constexpr size_t WS_POSW = 854 * MiB;
constexpr int CW_ECNT = 64;
constexpr int CW_CONV = 192;
constexpr int CW_BAR = 4096;

constexpr int RING_BYTES = 131072;
constexpr int MISC_OFF = RING_BYTES;
constexpr int LDS_BYTES = 139264;

#define XB_TMO      128
#define XB_XCNT(j)  (256  + 64 * (j))
#define XB_XSUB(j)  (1280 + 64 * (j))
#define XB_XGEN(j)  (2304 + 64 * (j))
#define XB_TOP      3328
#define XB_TOPGEN   3392
#define XCD_BAR_WORDS 3456
#define XB_SPIN_CAP (1u << 18)
__device__ __forceinline__ unsigned xb_ld(unsigned* p)              { return __hip_atomic_load(p, __ATOMIC_RELAXED, __HIP_MEMORY_SCOPE_AGENT); }
__device__ __forceinline__ unsigned xb_add(unsigned* p, unsigned v) { return __hip_atomic_fetch_add(p, v, __ATOMIC_RELAXED, __HIP_MEMORY_SCOPE_AGENT); }
__device__ __forceinline__ unsigned xb_xcc_id() { return (unsigned)__builtin_amdgcn_s_getreg((3 << 11) | 20) & 0xFu; }
#define XB_SPIN(cond, bar) do { unsigned _sp = 0; while (cond) { __builtin_amdgcn_s_sleep(1); \
    if ((++_sp & 255u) == 0u) { if (xb_ld(&(bar)[XB_TMO])) break; if (_sp > XB_SPIN_CAP) { atomicAdd(&(bar)[XB_TMO], 1u); break; } } } } while (0)
struct XcdBarrier { unsigned* bar; unsigned x; volatile LAS unsigned* st; };
__device__ __forceinline__ XcdBarrier xcd_barrier_post(unsigned* bar, volatile LAS unsigned* st) {
    XcdBarrier b; b.bar = bar; b.x = xb_xcc_id(); b.st = st;
    if (threadIdx.x == 0) (void)xb_add(&bar[XB_XCNT(b.x)], 1u);
    return b;
}
__device__ __forceinline__ void xcd_barrier_complete(unsigned* bar, unsigned x, unsigned& nloc, unsigned& nx) {
    const unsigned G = gridDim.x * gridDim.y * gridDim.z;
    unsigned sum, cnt, mine, sp = 0u;
    for (;;) {
        sum = 0u; cnt = 0u; mine = 0u;
#pragma unroll
        for (unsigned j = 0; j < 16; ++j) { const unsigned c = xb_ld(&bar[XB_XCNT(j)]); sum += c; cnt += (c > 0u) ? 1u : 0u; mine = (j == x) ? c : mine; }
        if (sum == G) break;
        __builtin_amdgcn_s_sleep(1);
        if ((++sp & 255u) == 0u) { if (xb_ld(&bar[XB_TMO])) break; if (sp > XB_SPIN_CAP) { atomicAdd(&bar[XB_TMO], 1u); break; } }
    }
    nloc = mine > 0u ? mine : 1u; nx = cnt > 0u ? cnt : 1u;
}
__device__ __forceinline__ void xcd_barrier(const XcdBarrier& b) {
    asm volatile("s_waitcnt vmcnt(0)" ::: "memory");
    __syncthreads();
    if (threadIdx.x == 0) {
        unsigned* bar = b.bar;
        __builtin_amdgcn_s_waitcnt(0);
        unsigned nloc = b.st[0], nx = b.st[1];
        if (nloc == 0u) { xcd_barrier_complete(bar, b.x, nloc, nx); b.st[0] = nloc; b.st[1] = nx; }
        const unsigned old = xb_add(&bar[XB_XSUB(b.x)], 1u);
        const unsigned gen = old / nloc;
        if (old + 1u == (gen + 1u) * nloc) {
            __builtin_amdgcn_fence(__ATOMIC_RELEASE, "agent");
            asm volatile("s_waitcnt vmcnt(0)" ::: "memory");
            const unsigned og = xb_add(&bar[XB_TOP], 1u);
            const unsigned tg = og / nx;
            if (og + 1u == (tg + 1u) * nx) xb_add(&bar[XB_TOPGEN], 1u);
            else XB_SPIN(xb_ld(&bar[XB_TOPGEN]) == tg, bar);
            __builtin_amdgcn_fence(__ATOMIC_ACQUIRE, "agent");
            xb_add(&bar[XB_XGEN(b.x)], 1u);
            asm volatile("s_waitcnt vmcnt(0)" ::: "memory");
        } else {
            XB_SPIN(xb_ld(&bar[XB_XGEN(b.x)]) == gen, bar);
            __builtin_amdgcn_fence(__ATOMIC_ACQUIRE, "agent");
            asm volatile("s_waitcnt vmcnt(0)" ::: "memory");
        }
    }
    __syncthreads();
}

using pg8::Unit;
__device__ __forceinline__ u32x4 pack8(const f32x4 v0, const f32x4 v1) { u32x4 w; w.x = cvt_pk_bf16(v0[0], v0[1]); w.y = cvt_pk_bf16(v0[2], v0[3]); w.z = cvt_pk_bf16(v1[0], v1[1]); w.w = cvt_pk_bf16(v1[2], v1[3]); return w; }
__device__ __forceinline__ void unpack8(const u32x4 w, f32x4& v0, f32x4& v1) { v0 = (f32x4){bf_lo(w.x), bf_hi(w.x), bf_lo(w.y), bf_hi(w.y)}; v1 = (f32x4){bf_lo(w.z), bf_hi(w.z), bf_lo(w.w), bf_hi(w.w)}; }

struct EpiProj {
    static constexpr bool PERM = true;
    bf16_t *U, *Q, *K, *V, *RHO, *SGA;
    __device__ __forceinline__ void operator()(const f32x4 (&acc)[2][2][4][2], const Unit& u, int wr, int wc, int fr, int fq) const {
        const int pn = u.pn;
        if (pn >= 14) {
            const int row0 = u.pm * 256 + wr * 64 + fr, col0 = (pn - 14) * 128 + wc * 32 + 8 * fq;
#pragma unroll
            for (int ai = 0; ai < 2; ++ai)
#pragma unroll
                for (int m = 0; m < 4; ++m) { const size_t off = (size_t)(row0 + ai * 128 + m * 16) * DM + col0; f32x4 r0, r1, a0, a1;
#pragma unroll
                    for (int j = 0; j < 4; ++j) { const float es0 = __expf(-acc[ai][0][m][0][j]), es1 = __expf(-acc[ai][0][m][1][j]), ea0 = __expf(-acc[ai][1][m][0][j]), ea1 = __expf(-acc[ai][1][m][1][j]);
                        a0[j] = __builtin_amdgcn_rcpf(1.f + ea0); a1[j] = __builtin_amdgcn_rcpf(1.f + ea1);
                        r0[j] = (1.f + ea0) * __builtin_amdgcn_rcpf(1.f + es0); r1[j] = (1.f + ea1) * __builtin_amdgcn_rcpf(1.f + es1); }
                    *(u32x4*)(RHO + off) = pack8(r0, r1); *(u32x4*)(SGA + off) = pack8(a0, a1); }
            return;
        }
        bf16_t* base; int ldc, ct, mode;
        if (pn < 2) { base = U; ldc = 512; ct = pn; mode = 0; }
        else if (pn < 6) { base = Q; ldc = 1024; ct = pn - 2; mode = 1; }
        else if (pn < 10) { base = K; ldc = 1024; ct = pn - 6; mode = 0; }
        else { base = V; ldc = 1024; ct = pn - 10; mode = 0; }
        const int row0 = u.pm * 256 + wr * 64 + fr, col0 = ct * 256 + wc * 32 + 8 * fq;
#pragma unroll
        for (int ai = 0; ai < 2; ++ai)
#pragma unroll
            for (int m = 0; m < 4; ++m) { bf16_t* rowp = base + (size_t)(row0 + ai * 128 + m * 16) * ldc + col0;
#pragma unroll
                for (int bj = 0; bj < 2; ++bj) { f32x4 v0 = acc[ai][bj][m][0], v1 = acc[ai][bj][m][1];
                    if (mode == 1) { v0 = v0 * QSCALE; v1 = v1 * QSCALE; }
                    *(u32x4*)(rowp + bj * 128) = pack8(v0, v1); } }
    }
};
struct EpiGlu {
    static constexpr bool PERM = true;
    const bf16_t* YPRE; bf16_t* YSSM;
    __device__ __forceinline__ void operator()(const f32x4 (&acc)[2][2][4][2], const Unit& u, int wr, int wc, int fr, int fq) const {
        const int row0 = u.pm * 256 + wr * 64 + fr, col0 = u.pn * 256 + wc * 32 + 8 * fq;
#pragma unroll
        for (int ai = 0; ai < 2; ++ai)
#pragma unroll
            for (int m = 0; m < 4; ++m) { const size_t off = (size_t)(row0 + ai * 128 + m * 16) * SSMW + col0;
#pragma unroll
                for (int bj = 0; bj < 2; ++bj) { const u32x4 yw = *(const u32x4*)(YPRE + off + bj * 128); f32x4 y0, y1; unpack8(yw, y0, y1);
                    f32x4 v0 = acc[ai][bj][m][0], v1 = acc[ai][bj][m][1];
#pragma unroll
                    for (int j = 0; j < 4; ++j) { v0[j] = y0[j] * sigmoidf_(v0[j]); v1[j] = y1[j] * sigmoidf_(v1[j]); }
                    *(u32x4*)(YSSM + off + bj * 128) = pack8(v0, v1); } }
    }
};
template <int SECOND> struct EpiMerge {
    static constexpr bool PERM = true;
    const bf16_t* SG; bf16_t* MG;
    __device__ __forceinline__ void operator()(const f32x4 (&acc)[2][2][4][2], const Unit& u, int wr, int wc, int fr, int fq) const {
        const int row0 = u.pm * 256 + wr * 64 + fr, col0 = u.pn * 256 + wc * 32 + 8 * fq;
#pragma unroll
        for (int ai = 0; ai < 2; ++ai)
#pragma unroll
            for (int m = 0; m < 4; ++m) { const size_t off = (size_t)(row0 + ai * 128 + m * 16) * DM + col0;
#pragma unroll
                for (int bj = 0; bj < 2; ++bj) { const u32x4 gw = *(const u32x4*)(SG + off + bj * 128); f32x4 g0, g1; unpack8(gw, g0, g1);
                    f32x4 v0 = acc[ai][bj][m][0] * g0, v1 = acc[ai][bj][m][1] * g1;
                    if (SECOND) { const u32x4 pw = *(const u32x4*)(MG + off + bj * 128); f32x4 p0, p1; unpack8(pw, p0, p1); v0 = v0 + p0; v1 = v1 + p1; }
                    *(u32x4*)(MG + off + bj * 128) = pack8(v0, v1); } }
    }
};
struct EpiMergeF {
    static constexpr bool PERM = true;
    const bf16_t* SGS; const bf16_t* SGA; bf16_t* MG;
    __device__ __forceinline__ void mid(f32x4 (&acc)[2][2][4][2], const Unit& u, int wr, int wc, int fr, int fq) const {
        asm volatile("" : "+v"(fr), "+v"(fq));
        const int row0 = u.pm * 256 + wr * 64 + fr, col0 = u.pn * 256 + wc * 32 + 8 * fq;
        const bf16_t* sp = SGS + (size_t)row0 * DM + col0;
        u32x4 sw[2][2];
        sw[0][0] = *(const u32x4*)(sp); sw[0][1] = *(const u32x4*)(sp + 128);
#pragma unroll
        for (int g = 0; g < 8; ++g) { const int ai = g >> 2, m = g & 3;
            if (g < 7) { const int g1 = g + 1; const bf16_t* sq = sp + (size_t)((g1 >> 2) * 128 + (g1 & 3) * 16) * DM;
                sw[g1 & 1][0] = *(const u32x4*)(sq); sw[g1 & 1][1] = *(const u32x4*)(sq + 128); }
            asm volatile("" ::: "memory");
#pragma unroll
            for (int bj = 0; bj < 2; ++bj) { f32x4 s0, s1; unpack8(sw[g & 1][bj], s0, s1);
                acc[ai][bj][m][0] = acc[ai][bj][m][0] * s0; acc[ai][bj][m][1] = acc[ai][bj][m][1] * s1; }
        }
    }
    __device__ __forceinline__ void operator()(const f32x4 (&acc)[2][2][4][2], const Unit& u, int wr, int wc, int fr, int fq) const {
        const int row0 = u.pm * 256 + wr * 64 + fr, col0 = u.pn * 256 + wc * 32 + 8 * fq;
#pragma unroll
        for (int ai = 0; ai < 2; ++ai)
#pragma unroll
            for (int m = 0; m < 4; ++m) { const size_t off = (size_t)(row0 + ai * 128 + m * 16) * DM + col0;
#pragma unroll
                for (int bj = 0; bj < 2; ++bj) { const u32x4 gw = *(const u32x4*)(SGA + off + bj * 128); f32x4 g0, g1; unpack8(gw, g0, g1);
                    *(u32x4*)(MG + off + bj * 128) = pack8(acc[ai][bj][m][0] * g0, acc[ai][bj][m][1] * g1); } }
    }
};
struct EpiZ {
    static constexpr bool PERM = true;
    const bf16_t* HBF; bf16_t* Z;
    __device__ __forceinline__ void operator()(const f32x4 (&acc)[2][2][4][2], const Unit& u, int wr, int wc, int fr, int fq) const {
        const int row0 = u.pm * 256 + wr * 64 + fr, col0 = u.pn * 256 + wc * 32 + 8 * fq;
#pragma unroll
        for (int ai = 0; ai < 2; ++ai)
#pragma unroll
            for (int m = 0; m < 4; ++m) { const size_t off = (size_t)(row0 + ai * 128 + m * 16) * DM + col0;
#pragma unroll
                for (int bj = 0; bj < 2; ++bj) { const u32x4 hw = *(const u32x4*)(HBF + off + bj * 128); f32x4 h0, h1; unpack8(hw, h0, h1);
                    *(u32x4*)(Z + off + bj * 128) = pack8(acc[ai][bj][m][0] + h0 * ALPHA, acc[ai][bj][m][1] + h1 * ALPHA); } }
    }
};
struct EpiSwiglu {
    static constexpr bool PERM = true;
    bf16_t* HB; const int* LIST; const float* WGT; int* POSE; float* POSW;
    __device__ __forceinline__ void operator()(const f32x4 (&acc)[2][2][4][2], const Unit& u, int wr, int wc, int fr, int fq) const {
        const int row0 = u.pm * 256 + wr * 64 + fr, col0 = (u.pn & 3) * 128 + wc * 32 + 8 * fq;
#pragma unroll
        for (int ai = 0; ai < 2; ++ai)
#pragma unroll
            for (int m = 0; m < 4; ++m) { f32x4 v0, v1;
#pragma unroll
                for (int j = 0; j < 4; ++j) { const float g0 = acc[ai][0][m][0][j], g1 = acc[ai][0][m][1][j];
                    v0[j] = g0 * sigmoidf_(g0) * acc[ai][1][m][0][j]; v1[j] = g1 * sigmoidf_(g1) * acc[ai][1][m][1][j]; }
                *(u32x4*)(HB + (size_t)(row0 + ai * 128 + m * 16) * DFF + col0) = pack8(v0, v1); }
        if ((u.pn & 3) == 0 && wc == 0 && fq == 0) {
#pragma unroll
            for (int ai = 0; ai < 2; ++ai)
#pragma unroll
                for (int m = 0; m < 4; ++m) { const int r = wr * 64 + fr + ai * 128 + m * 16, slot = u.s0 + r; int entry = -1; float w = 0.f;
                    if (slot < u.cnt) { entry = LIST[(size_t)u.e * CAP + slot]; w = WGT[entry]; }
                    POSE[u.pm * 256 + r] = entry; POSW[u.pm * 256 + r] = w; }
        }
    }
};
struct EpiDown {
    static constexpr bool PERM = true;
    const int* POSE; const float* POSW; bf16_t* YK;
    __device__ __forceinline__ void operator()(const f32x4 (&acc)[2][2][4][2], const Unit& u, int wr, int wc, int fr, int fq) const {
        const int r0 = u.pm * 256 + wr * 64 + fr, col0 = (u.pn & 7) * 256 + wc * 32 + 8 * fq;
        int en[2][4]; float ww[2][4];
#pragma unroll
        for (int ai = 0; ai < 2; ++ai)
#pragma unroll
            for (int m = 0; m < 4; ++m) { en[ai][m] = POSE[r0 + ai * 128 + m * 16]; ww[ai][m] = POSW[r0 + ai * 128 + m * 16]; }
#pragma unroll
        for (int ai = 0; ai < 2; ++ai)
#pragma unroll
            for (int m = 0; m < 4; ++m) {
                if (en[ai][m] >= 0) { const float w = ww[ai][m]; bf16_t* rowp = YK + (size_t)en[ai][m] * DM + col0;
#pragma unroll
                    for (int bj = 0; bj < 2; ++bj) *(u32x4*)(rowp + bj * 128) = pack8(acc[ai][bj][m][0] * w, acc[ai][bj][m][1] * w); } }
    }
};
struct MoeOrder {
    int G, c, shift, NB; const LAS int* blkexp; const LAS int* blkstart; const LAS int* cntE; const int* LIST;
    __device__ __forceinline__ bool next(int i, Unit& u) const {
        const long L = (long)i * G + c; if (L >= ((long)NB << shift)) return false;
        const int blk = (int)(L >> shift), tile = (int)(L & ((1 << shift) - 1)), e = blkexp[blk];
        u.pm = blk; u.pn = (e << shift) + tile; u.e = e; u.s0 = (blk - blkstart[e]) * 256; u.cnt = cntE[e]; return true;
    }
    __device__ __forceinline__ int arow(const Unit& u, int r) const { const int slot = u.s0 + r; const int entry = slot < u.cnt ? LIST[(size_t)u.e * CAP + slot] : 0; return entry >> 1; }
};

struct Ctx { LAS unsigned char* lds; int tid, lane, wave, vcu, G; };

__device__ __forceinline__ void transpose_item(const float* W, int K, int N, bf16_t* WT, int kb, int nb, int dst_row0, LAS float* scr, int lane) {
    const int k0 = 64 * kb, n0 = 32 * nb;
    float tv[32];
#pragma unroll
    for (int i = 0; i < 32; ++i) tv[i] = W[(size_t)(k0 + 2 * i + (lane >> 5)) * N + n0 + (lane & 31)];
#pragma unroll
    for (int i = 0; i < 32; ++i) scr[(2 * i + (lane >> 5)) * 33 + (lane & 31)] = tv[i];
    asm volatile("s_waitcnt lgkmcnt(0)" ::: "memory");
    const int c = lane & 7;
#pragma unroll
    for (int j = 0; j < 4; ++j) { const int n = (lane >> 3) + 8 * j; const LAS float* s = scr + (8 * c) * 33 + n;
        u32x4 o; o.x = cvt_pk_bf16(s[0 * 33], s[1 * 33]); o.y = cvt_pk_bf16(s[2 * 33], s[3 * 33]); o.z = cvt_pk_bf16(s[4 * 33], s[5 * 33]); o.w = cvt_pk_bf16(s[6 * 33], s[7 * 33]);
        *(u32x4*)(WT + (size_t)(dst_row0 + n) * K + k0 + 8 * c) = o; }
    asm volatile("s_waitcnt lgkmcnt(0)" ::: "memory");
}
__device__ __forceinline__ void ln_stats(f32x4 (&v)[8], float& mean, float& rstd) {
    float s = 0.f;
#pragma unroll
    for (int j = 0; j < 8; ++j) s += (v[j].x + v[j].y) + (v[j].z + v[j].w);
    mean = wave_sum(s) * (1.f / DM); float s2 = 0.f;
#pragma unroll
    for (int j = 0; j < 8; ++j) { const f32x4 d = v[j] - mean; s2 += (d.x * d.x + d.y * d.y) + (d.z * d.z + d.w * d.w); }
    rstd = 1.f / sqrtf(wave_sum(s2) * (1.f / DM) + LN_EPS);
}

__device__ __forceinline__ void p0_prologue(const Ctx& C, const float* const* in, unsigned char* ws) {
    LAS float* scr = (LAS float*)(C.lds + C.wave * 16384);
    const int gw = C.vcu * 8 + C.wave, NGW = C.G * 8;
    bf16_t* WinT = (bf16_t*)(ws + WS_WIN); bf16_t* WgluT = (bf16_t*)(ws + WS_WGLU); bf16_t* WbsT = (bf16_t*)(ws + WS_WBS); bf16_t* WbaT = (bf16_t*)(ws + WS_WBA);
    bf16_t* WoT = (bf16_t*)(ws + WS_WO); bf16_t* WupT = (bf16_t*)(ws + WS_WUP);
    constexpr int I_WIN = (DM / 64) * (INC / 32), I_GLU = (SSMW / 64) * (SSMW / 32), I_BS = (SSMW / 64) * (DM / 32), I_BA = (AW / 64) * (DM / 32), I_WO = (DM / 64) * (DM / 32);
    constexpr int I_EXP = NE * 512;
    constexpr int NITEMS = I_WIN + I_GLU + I_BS + I_BA + I_WO + 2 * I_EXP;
    for (int it = gw; it < NITEMS; it += NGW) {
        int r = it;
        if (r < I_WIN) { const int nblk = INC / 32, nb = r % nblk, n0 = 32 * nb;
            const int drow = n0 < 3584 ? n0 : (n0 < 5632 ? 3584 + ((n0 - 3584) >> 7) * 256 + ((n0 - 3584) & 127) : 3584 + ((n0 - 5632) >> 7) * 256 + 128 + ((n0 - 5632) & 127));
            transpose_item(in[4], DM, INC, WinT, r / nblk, nb, drow, scr, C.lane); continue; } r -= I_WIN;
        if (r < I_GLU) { const int nblk = SSMW / 32; transpose_item(in[13], SSMW, SSMW, WgluT, r / nblk, r % nblk, 32 * (r % nblk), scr, C.lane); continue; } r -= I_GLU;
        if (r < I_BS) { const int nblk = DM / 32; transpose_item(in[19], SSMW, DM, WbsT, r / nblk, r % nblk, 32 * (r % nblk), scr, C.lane); continue; } r -= I_BS;
        if (r < I_BA) { const int nblk = DM / 32; transpose_item(in[20], AW, DM, WbaT, r / nblk, r % nblk, 32 * (r % nblk), scr, C.lane); continue; } r -= I_BA;
        if (r < I_WO) { const int nblk = DM / 32; transpose_item(in[21], DM, DM, WoT, r / nblk, r % nblk, 32 * (r % nblk), scr, C.lane); continue; } r -= I_WO;
        if (r < 2 * I_EXP) { const int up = r >= I_EXP ? 1 : 0; r -= up * I_EXP; const int e = r >> 9, rr = r & 511, kb = rr >> 4, nb = rr & 15, n0 = 32 * nb;
            transpose_item(in[28 + up] + (size_t)e * DM * DFF, DM, DFF, WupT, kb, nb, e * 1024 + (n0 >> 7) * 256 + up * 128 + (n0 & 127), scr, C.lane); continue; }
    }
    const int gt = C.vcu * 512 + C.tid, NGT = C.G * 512;
    { float* WrT = (float*)(ws + WS_WRT);
      for (int i = gt; i < 36 * DM; i += NGT) { const int n = i / DM, k = i % DM; WrT[i] = n < 4 ? in[24][k * 4 + n] : in[26][k * 32 + (n - 4)]; } }
    { u32x4* kz = (u32x4*)(ws + WS_KMETA + 16 * 1024 * 2); u32x4* vz = (u32x4*)(ws + WS_VMETA + 16 * 1024 * 2);
      for (int i = gt; i < 48 * 1024 * 2 / 16; i += NGT) { kz[i] = (u32x4){0u, 0u, 0u, 0u}; vz[i] = (u32x4){0u, 0u, 0u, 0u}; } }
    { float* AB = (float*)(ws + WS_SSMAB); float* BB = (float*)(ws + WS_SSMBB);
      for (int i = gt; i < NGRP * NST; i += NGT) { const int g = i >> 6;
        const double lre = fmin((double)in[5][i], -1e-4), lim = (double)in[6][i], dt = exp((double)in[7][g]);
        const double mag = exp(lre * dt), abr = mag * cos(lim * dt), abi = mag * sin(lim * dt), den = lre * lre + lim * lim, nr = abr - 1.0, ni = abi;
        const double zr = (nr * lre + ni * lim) / den, zi = (ni * lre - nr * lim) / den;
        AB[i] = (float)abr; AB[NGRP * NST + i] = (float)abi;
#pragma unroll 4
        for (int c = 0; c < 16; ++c) { const double br = (double)in[8][i * 16 + c], bi = (double)in[9][i * 16 + c];
            BB[i * 16 + c] = (float)(zr * br - zi * bi); BB[NGRP * NST * 16 + i * 16 + c] = (float)(zr * bi + zi * br); } } }
    const float* lg = in[2]; const float* lb = in[3];
    bf16_t* HBF = (bf16_t*)(ws + WS_HBF);
    for (int m = gw; m < T + NMETA; m += 2 * NGW) {
        const int m2 = (m + NGW < T + NMETA) ? m + NGW : m;
        const float* xa = m >= T ? in[1] + (size_t)(m - T) * DM : in[0] + (size_t)m * DM; const float* xb = m2 >= T ? in[1] + (size_t)(m2 - T) * DM : in[0] + (size_t)m2 * DM;
        f32x4 va[8], vb[8];
#pragma unroll
        for (int j = 0; j < 8; ++j) { va[j] = *(const f32x4*)(xa + 256 * j + 4 * C.lane); vb[j] = *(const f32x4*)(xb + 256 * j + 4 * C.lane); }
        float meana, rstda, meanb, rstdb; ln_stats(va, meana, rstda); ln_stats(vb, meanb, rstdb);
#pragma unroll
        for (int rr = 0; rr < 2; ++rr) { const int mm = rr ? m2 : m; if (rr == 1 && m2 == m) break; const bool meta = mm >= T;
#pragma unroll
            for (int j = 0; j < 8; ++j) { const f32x4 gg = *(const f32x4*)(lg + 256 * j + 4 * C.lane), bb = *(const f32x4*)(lb + 256 * j + 4 * C.lane);
                const f32x4 o = rr ? (vb[j] - meanb) * rstdb * gg + bb : (va[j] - meana) * rstda * gg + bb;
                if (meta) *(f32x4*)((float*)(ws + WS_HMETA) + (size_t)(mm - T) * DM + 256 * j + 4 * C.lane) = o;
                else { u32x2 w; w.x = cvt_pk_bf16(o.x, o.y); w.y = cvt_pk_bf16(o.z, o.w); *(u32x2*)(HBF + (size_t)mm * DM + 256 * j + 4 * C.lane) = w; } } }
    }
}

__device__ __forceinline__ void p1_meta_proj(const Ctx& C, unsigned char* ws) {
    const bf16_t* WinT = (const bf16_t*)(ws + WS_WIN); const float* HM = (const float*)(ws + WS_HMETA);
    const int gw = C.vcu * 8 + C.wave, NGW = C.G * 8;
    for (int it = gw; it < 640; it += NGW) {
        const int nidx = 4 * it; const int col0 = nidx < 512 ? nidx : (nidx < 1536 ? 1536 + (nidx - 512) : 2560 + (nidx - 1536));
        float acc[16][4];
#pragma unroll
        for (int r = 0; r < 16; ++r)
#pragma unroll
            for (int c = 0; c < 4; ++c) acc[r][c] = 0.f;
#pragma unroll 1
        for (int j = 0; j < 4; ++j) { const int k0 = j * 512 + C.lane * 8;
            f32x4 w0[4], w1[4];
#pragma unroll
            for (int c = 0; c < 4; ++c) { const u32x4 ww = *(const u32x4*)(WinT + (size_t)(col0 + c) * DM + k0); unpack8(ww, w0[c], w1[c]); }
#pragma unroll
            for (int r = 0; r < 16; ++r) { const f32x4 h0 = *(const f32x4*)(HM + r * DM + k0), h1 = *(const f32x4*)(HM + r * DM + k0 + 4);
#pragma unroll
                for (int c = 0; c < 4; ++c) { const f32x4 p = h0 * w0[c] + h1 * w1[c]; acc[r][c] += (p.x + p.y) + (p.z + p.w); } } }
        float mine = 0.f;
#pragma unroll
        for (int r = 0; r < 16; ++r)
#pragma unroll
            for (int c = 0; c < 4; ++c) { const float s = wave_sum(acc[r][c]); mine = (C.lane == r * 4 + c) ? s : mine; }
        const int r = C.lane >> 2, c = C.lane & 3;
        if (nidx < 512) ((float*)(ws + WS_UMETA))[r * SSMW + nidx + c] = mine;
        else if (nidx < 1536) ((bf16_t*)(ws + WS_KMETA))[r * AW + (nidx - 512) + c] = (bf16_t)(cvt_pk_bf16(mine, 0.f) & 0xffffu);
        else ((bf16_t*)(ws + WS_VMETA))[r * AW + (nidx - 1536) + c] = (bf16_t)(cvt_pk_bf16(mine, 0.f) & 0xffffu);
    }
}

__device__ __forceinline__ float gelu_tanh(float x) { const float u = 1.5957691216057308f * (x + 0.044715f * x * x * x); return x / (1.0f + __expf(-u)); }
template <bool STORE> __device__ __forceinline__ void scan16(f32x16 (&bu)[4], float (&sre)[2], float (&sim)[2], const float (&are)[2], const float (&aim)[2]) {
#pragma unroll
    for (int reg = 0; reg < 16; ++reg)
#pragma unroll
        for (int st = 0; st < 2; ++st) {
            const float nre = __builtin_fmaf(are[st], sre[st], __builtin_fmaf(-aim[st], sim[st], bu[st][reg]));
            const float nim = __builtin_fmaf(are[st], sim[st], __builtin_fmaf(aim[st], sre[st], bu[2 + st][reg]));
            sre[st] = nre; sim[st] = nim;
            if (STORE) { bu[st][reg] = nre; bu[2 + st][reg] = nim; } }
}
__device__ __forceinline__ void p2_scan(const Ctx& C, const float* const* in, unsigned char* ws) {
    const int lane = C.lane, wave = C.wave, r32 = lane & 31, hi = lane >> 5, fr = lane & 15, fq = lane >> 4;
    const bf16_t* U = (const bf16_t*)(ws + WS_U); const float* UM = (const float*)(ws + WS_UMETA); bf16_t* YPRE = (bf16_t*)(ws + WS_YPRE);
    const float* AB = (const float*)(ws + WS_SSMAB); const float* BB = (const float*)(ws + WS_SSMBB);
    LAS unsigned char* Sl = C.lds + wave * 10752;
    LAS unsigned char* Yl = Sl + 9728;
    LAS float* E = (LAS float*)(C.lds + 86016);
    const int hc = 2 * wave + hi;
    const int urow = ((r32 >> 2) & 1) * 128 + (r32 & 3) + 4 * (r32 >> 3);
    for (int item = C.vcu; item < NB_ * NGRP; item += C.G) {
        const int b = item >> 5, g = item & 31;
        const bf16_t* Ub = U + ((size_t)b * SEQ + wave * 256) * SSMW + 16 * g;
        bf16x8 ufa[8];
#pragma unroll
        for (int blk = 0; blk < 8; ++blk) ufa[blk] = *(const bf16x8*)(Ub + (size_t)(16 * blk + urow) * SSMW + 8 * hi);
        float are[2], aim[2];
#pragma unroll
        for (int st = 0; st < 2; ++st) { are[st] = AB[g * 64 + 32 * st + r32]; aim[st] = AB[NGRP * NST + g * 64 + 32 * st + r32]; }
        bf16x8 Bf[4];
#pragma unroll
        for (int ri = 0; ri < 2; ++ri)
#pragma unroll
            for (int st = 0; st < 2; ++st) { const float* src = BB + ri * (NGRP * NST * 16) + (g * 64 + 32 * st + r32) * 16 + 8 * hi;
                const f32x4 x0 = *(const f32x4*)src, x1 = *(const f32x4*)(src + 4); Bf[2 * ri + st] = __builtin_bit_cast(bf16x8, pack8(x0, x1)); }
        bf16x8 Cf[5];
#pragma unroll
        for (int ks = 0; ks < 4; ++ks) { const int k0 = 32 * ks + 8 * fq; const float* src = (ks < 2 ? in[10] : in[11]) + (g * 16 + fr) * 64 + (k0 & 63);
            f32x4 x0 = *(const f32x4*)src, x1 = *(const f32x4*)(src + 4); if (ks >= 2) { x0 = -x0; x1 = -x1; } Cf[ks] = __builtin_bit_cast(bf16x8, pack8(x0, x1)); }
        { const float dsk = in[12][g * 16 + fr]; f32x4 x0, x1;
#pragma unroll
          for (int j = 0; j < 4; ++j) { x0[j] = (fq < 2 && 8 * fq + j == fr) ? dsk : 0.f; x1[j] = (fq < 2 && 8 * fq + 4 + j == fr) ? dsk : 0.f; }
          Cf[4] = __builtin_bit_cast(bf16x8, pack8(x0, x1)); }
        float sre[2] = {0.f, 0.f}, sim[2] = {0.f, 0.f}, mre[2] = {0.f, 0.f}, mim[2] = {0.f, 0.f};
        if (wave == 0) {
            f32x4 x0 = (f32x4){0.f, 0.f, 0.f, 0.f}, x1 = x0;
            if (((r32 >> 2) & 1) == 0) { const float* src = UM + ((r32 & 3) + 4 * (r32 >> 3)) * SSMW + 16 * g + 8 * hi; x0 = *(const f32x4*)src; x1 = *(const f32x4*)(src + 4); }
            const bf16x8 uf = __builtin_bit_cast(bf16x8, pack8(x0, x1));
            f32x16 bu[4];
#pragma unroll
            for (int t = 0; t < 4; ++t) bu[t] = __builtin_amdgcn_mfma_f32_32x32x16_bf16(uf, Bf[t], (f32x16){}, 0, 0, 0);
            scan16<false>(bu, sre, sim, are, aim);
            mre[0] = sre[0]; mre[1] = sre[1]; mim[0] = sim[0]; mim[1] = sim[1];
        }
#pragma unroll
        for (int blk = 0; blk < 8; ++blk) {
            f32x16 bu[4];
#pragma unroll
            for (int t = 0; t < 4; ++t) bu[t] = __builtin_amdgcn_mfma_f32_32x32x16_bf16(ufa[blk], Bf[t], (f32x16){}, 0, 0, 0);
            scan16<false>(bu, sre, sim, are, aim);
        }
#pragma unroll
        for (int st = 0; st < 2; ++st) { E[hc * 128 + st * 64 + r32] = sre[st]; E[hc * 128 + st * 64 + 32 + r32] = sim[st]; }
        __syncthreads();
        {
            float pr[2], pi[2], cr[2], ci[2];
#pragma unroll
            for (int st = 0; st < 2; ++st) { pr[st] = are[st]; pi[st] = aim[st];
#pragma unroll
                for (int k = 0; k < 7; ++k) { const float nr = pr[st] * pr[st] - pi[st] * pi[st], ni = 2.f * pr[st] * pi[st]; pr[st] = nr; pi[st] = ni; }
                cr[st] = E[st * 64 + r32]; ci[st] = E[st * 64 + 32 + r32]; }
            for (int j = 1; j < 2 * wave + 1; ++j) {
                const bool on = j < hc;
#pragma unroll
                for (int st = 0; st < 2; ++st) { const float er = E[j * 128 + st * 64 + r32], ei = E[j * 128 + st * 64 + 32 + r32];
                    const float nr = pr[st] * cr[st] - pi[st] * ci[st] + er, ni = pr[st] * ci[st] + pi[st] * cr[st] + ei; cr[st] = on ? nr : cr[st]; ci[st] = on ? ni : ci[st]; } }
#pragma unroll
            for (int st = 0; st < 2; ++st) { sre[st] = hc == 0 ? mre[st] : cr[st]; sim[st] = hc == 0 ? mim[st] : ci[st]; }
        }
#pragma unroll
        for (int blk = 0; blk < 8; ++blk) {
            f32x16 bu[4];
#pragma unroll
            for (int t = 0; t < 4; ++t) bu[t] = __builtin_amdgcn_mfma_f32_32x32x16_bf16(ufa[blk], Bf[t], (f32x16){}, 0, 0, 0);
            scan16<true>(bu, sre, sim, are, aim);
#pragma unroll
            for (int reg = 0; reg < 16; ++reg) { const int row = (reg & 3) + 8 * (reg >> 2) + 4 * hi;
#pragma unroll
                for (int t = 0; t < 4; ++t) *(LAS bf16_t*)(Sl + row * 304 + (32 * t + r32) * 2) = (bf16_t)(cvt_pk_bf16(bu[t][reg], 0.f) & 0xffffu); }
            *(LAS bf16x8*)(Sl + r32 * 304 + (128 + 8 * hi) * 2) = ufa[blk];
            f32x4 y[2];
#pragma unroll
            for (int mt = 0; mt < 2; ++mt) { y[mt] = (f32x4){0.f, 0.f, 0.f, 0.f};
#pragma unroll
                for (int ks = 0; ks < 4; ++ks) { const bf16x8 af = *(const LAS bf16x8*)(Sl + (16 * mt + fr) * 304 + (32 * ks + 8 * fq) * 2);
                    y[mt] = __builtin_amdgcn_mfma_f32_16x16x32_bf16(af, Cf[ks], y[mt], 0, 0, 0); }
                bf16x8 au = *(const LAS bf16x8*)(Sl + (16 * mt + fr) * 304 + (128 + 8 * (fq & 1)) * 2); if (fq >= 2) au = (bf16x8){};
                y[mt] = __builtin_amdgcn_mfma_f32_16x16x32_bf16(au, Cf[4], y[mt], 0, 0, 0); }
#pragma unroll
            for (int mt = 0; mt < 2; ++mt)
#pragma unroll
                for (int reg = 0; reg < 4; ++reg) *(LAS bf16_t*)(Yl + (16 * mt + 4 * fq + reg) * 32 + fr * 2) = (bf16_t)(cvt_pk_bf16(gelu_tanh(y[mt][reg]), 0.f) & 0xffffu);
            const u32x4 yo = *(const LAS u32x4*)(Yl + (lane >> 1) * 32 + (lane & 1) * 16);
            { const int row = lane >> 1, tok = ((row >> 2) & 1) * 128 + 16 * blk + (row & 3) + 4 * (row >> 3);
              *(u32x4*)(YPRE + ((size_t)b * SEQ + wave * 256 + tok) * SSMW + 16 * g + 8 * (lane & 1)) = yo; }
        }
        __syncthreads();
    }
}

__device__ __forceinline__ int crow(int r, int hi) { return (r & 3) + 8 * (r >> 2) + 4 * hi; }
typedef short v4i16_t __attribute__((ext_vector_type(4)));
__device__ __forceinline__ s16x4 vtr(const LAS unsigned char* p) { return __builtin_bit_cast(s16x4, __builtin_amdgcn_ds_read_tr16_b64_v4i16((LAS v4i16_t*)p)); }
__device__ __forceinline__ float half_swap_max(float x) { auto rr = __builtin_amdgcn_permlane32_swap(__float_as_uint(x), __float_as_uint(x), false, false); return fmaxf(__uint_as_float(rr[0]), __uint_as_float(rr[1])); }
__device__ __forceinline__ float half_swap_sum(float x) { auto rr = __builtin_amdgcn_permlane32_swap(__float_as_uint(x), __float_as_uint(x), false, false); return __uint_as_float(rr[0]) + __uint_as_float(rr[1]); }

__device__ __forceinline__ void attn_pv(f32x16 (&o)[4], const bf16x8 (&pa)[4], unsigned vaddr) {
    s16x4 vl[2][4], vh[2][4];
#define ATT_VRD(SET, D) do { _Pragma("unroll") for (int ks_ = 0; ks_ < 4; ++ks_) { \
        asm volatile("ds_read_b64_tr_b16 %0, %1 offset:%2" : "=&v"(vl[SET][ks_]) : "v"(vaddr), "i"((D) * 4096 + ks_ * 1024) : "memory"); \
        asm volatile("ds_read_b64_tr_b16 %0, %1 offset:%2" : "=&v"(vh[SET][ks_]) : "v"(vaddr), "i"((D) * 4096 + ks_ * 1024 + 512) : "memory"); } } while (0)
    __builtin_amdgcn_sched_barrier(0);
    ATT_VRD(0, 0);
#pragma unroll
    for (int d = 0; d < 4; ++d) {
        if (d == 0) { ATT_VRD(1, 1); } else if (d == 1) { ATT_VRD(0, 2); } else if (d == 2) { ATT_VRD(1, 3); }
        if (d < 3) asm volatile("s_waitcnt lgkmcnt(8)" ::: "memory"); else asm volatile("s_waitcnt lgkmcnt(0)" ::: "memory");
        __builtin_amdgcn_sched_barrier(0);
#pragma unroll
        for (int ks = 0; ks < 4; ++ks) { const s16x4 lo = vl[d & 1][ks], hv = vh[d & 1][ks];
            const bf16x8 vf = (bf16x8){lo[0], lo[1], lo[2], lo[3], hv[0], hv[1], hv[2], hv[3]};
            o[d] = __builtin_amdgcn_mfma_f32_32x32x16_bf16(pa[ks], vf, o[d], 0, 0, 0); }
        __builtin_amdgcn_sched_barrier(0);
    }
#undef ATT_VRD
}
__device__ __forceinline__ void attn_qk(f32x16& p0, f32x16& p1, const LAS unsigned char* kb, const bf16x8 (&qr)[4]) {
    p0 = (f32x16){}; p1 = (f32x16){};
#pragma unroll
    for (int d0 = 0; d0 < 4; ++d0) { const bf16x8 b0 = *(const LAS bf16x8*)(kb + d0 * 2048), b1 = *(const LAS bf16x8*)(kb + d0 * 2048 + 512);
        p0 = __builtin_amdgcn_mfma_f32_32x32x16_bf16(b0, qr[d0], p0, 0, 0, 0); p1 = __builtin_amdgcn_mfma_f32_32x32x16_bf16(b1, qr[d0], p1, 0, 0, 0); }
}
__device__ __forceinline__ void attn_softmax(const bool FIRST, f32x16& p0, f32x16& p1, f32x16 (&o)[4], float& mrun, float& lrun, bf16x8 (&pa)[4], LAS float* wsf, int r32, int hi) {
    if (FIRST) {
        asm volatile("" ::: "memory");
#pragma unroll
        for (int r = 0; r < 16; ++r) { if (r >= 8) p0[r] = -__builtin_inff(); p1[r] = -__builtin_inff(); } }
    float rmA = fmaxf(p0[0], p0[1]), rmB = fmaxf(p0[2], p0[3]), rmC = fmaxf(p1[0], p1[1]), rmD = fmaxf(p1[2], p1[3]);
#pragma unroll
    for (int r = 4; r < 16; r += 4) { rmA = fmaxf(rmA, fmaxf(p0[r], p0[r + 1])); rmB = fmaxf(rmB, fmaxf(p0[r + 2], p0[r + 3])); rmC = fmaxf(rmC, fmaxf(p1[r], p1[r + 1])); rmD = fmaxf(rmD, fmaxf(p1[r + 2], p1[r + 3])); }
    const float rm = half_swap_max(fmaxf(fmaxf(rmA, rmB), fmaxf(rmC, rmD)));
    if (FIRST) mrun = rm;
    else if (__any(rm > mrun + 8.0f)) {
        const float mnew = fmaxf(mrun, rm), alpha = __builtin_amdgcn_exp2f(mrun - mnew);
        lrun *= alpha; mrun = mnew;
        if (hi == 0) wsf[r32] = alpha;
        f32x4 a4[4];
#pragma unroll
        for (int gq = 0; gq < 4; ++gq) a4[gq] = *(const LAS f32x4*)(wsf + 8 * gq + 4 * hi);
#pragma unroll
        for (int d = 0; d < 4; ++d)
#pragma unroll
            for (int r = 0; r < 16; ++r) o[d][r] *= a4[r >> 2][r & 3];
    }
    float psA = 0.f, psB = 0.f, psC = 0.f, psD = 0.f;
#pragma unroll
    for (int r = 0; r < 16; r += 2) { p0[r] = __builtin_amdgcn_exp2f(p0[r] - mrun); p0[r + 1] = __builtin_amdgcn_exp2f(p0[r + 1] - mrun); p1[r] = __builtin_amdgcn_exp2f(p1[r] - mrun); p1[r + 1] = __builtin_amdgcn_exp2f(p1[r + 1] - mrun);
        psA += p0[r]; psB += p0[r + 1]; psC += p1[r]; psD += p1[r + 1]; }
    lrun += (psA + psB) + (psC + psD);
    u32x4 w;
    w = (u32x4){cvt_pk_bf16(p0[0], p0[1]), cvt_pk_bf16(p0[2], p0[3]), cvt_pk_bf16(p0[4], p0[5]), cvt_pk_bf16(p0[6], p0[7])}; pa[0] = __builtin_bit_cast(bf16x8, w);
    w = (u32x4){cvt_pk_bf16(p0[8], p0[9]), cvt_pk_bf16(p0[10], p0[11]), cvt_pk_bf16(p0[12], p0[13]), cvt_pk_bf16(p0[14], p0[15])}; pa[1] = __builtin_bit_cast(bf16x8, w);
    w = (u32x4){cvt_pk_bf16(p1[0], p1[1]), cvt_pk_bf16(p1[2], p1[3]), cvt_pk_bf16(p1[4], p1[5]), cvt_pk_bf16(p1[6], p1[7])}; pa[2] = __builtin_bit_cast(bf16x8, w);
    w = (u32x4){cvt_pk_bf16(p1[8], p1[9]), cvt_pk_bf16(p1[10], p1[11]), cvt_pk_bf16(p1[12], p1[13]), cvt_pk_bf16(p1[14], p1[15])}; pa[3] = __builtin_bit_cast(bf16x8, w);
}
__device__ __forceinline__ void glds16(const void* gsrc, unsigned lds_dst) { unsigned keep;
    asm volatile("s_mov_b32 %0, m0\n\ts_mov_b32 m0, %2\n\ts_nop 0\n\tglobal_load_lds_dwordx4 %1, off\n\ts_mov_b32 m0, %0" : "=&s"(keep) : "v"(gsrc), "s"(lds_dst) : "memory"); }
__device__ __forceinline__ void attn_unit(const Ctx& C, const bf16_t* Qg, const bf16_t* Kg, const bf16_t* Vg, const bf16_t* KM, const bf16_t* VM, bf16_t* Y,
                                          const float* subg, float lam, int b, int h, int qt, bool prefetched, int nqt, bf16x8 (&qr)[4], bool rb) {
    LAS unsigned char* lds = C.lds;
    const int lane = C.lane, wave = C.wave, r32 = lane & 31, hi = lane >> 5, qb = wave >> 1, map = wave & 1;
    const int q0 = qt * 128 + qb * 32;
    const size_t rowb = (size_t)b * SEQ;
    if (!prefetched) { const bf16_t* qp = Qg + (rowb + q0 + r32) * AW + h * 128 + map * 64 + hi * 8;
#pragma unroll
      for (int d0 = 0; d0 < 4; ++d0) qr[d0] = *(const bf16x8*)(qp + d0 * 16); }
    const int NT = 2 * qt + 3;
    const bool skip_last = (qb < 2);
    f32x16 o[4];
#pragma unroll
    for (int d = 0; d < 4; ++d) o[d] = (f32x16){};
    float mrun = -__builtin_inff(), lrun = 0.f;
    LAS float* wsf = (LAS float*)(lds + MISC_OFF + 4096 + wave * 256);
    const bf16_t* Kb = Kg + rowb * AW; const bf16_t* Vb = Vg + rowb * AW;
#define ATT_DMA(step, stage) do { const bf16_t* ks_ = (step) == 0 ? KM : Kb; const bf16_t* vs_ = (step) == 0 ? VM : Vb; const int row0_ = (step) == 0 ? 0 : ((step) - 1) * 64; \
    _Pragma("unroll") for (int i_ = 0; i_ < 2; ++i_) { const int p_ = 2 * wave + i_; \
        __builtin_amdgcn_global_load_lds((const unsigned*)(ks_ + (size_t)(row0_ + lane) * AW + h * 128 + (p_ >> 3) * 64 + (p_ & 7) * 8), (LAS unsigned*)(lds + (stage) * 32768 + p_ * 1024), 16, 0, 0); \
        __builtin_amdgcn_global_load_lds((const unsigned*)(vs_ + (size_t)(row0_ + 16 * (p_ & 3) + (lane >> 2)) * AW + h * 128 + (p_ >> 2) * 32 + (lane & 3) * 8), (LAS unsigned*)(lds + (stage) * 32768 + 16384 + p_ * 1024), 16, 0, 0); } } while (0)
    const int myNT = skip_last ? NT - 1 : NT;
    bf16x8 pa[4];
#pragma unroll
    for (int k = 0; k < 4; ++k) pa[k] = (bf16x8){};
    if (!prefetched) ATT_DMA(0, 0);
    asm volatile("s_waitcnt vmcnt(0)" ::: "memory"); __syncthreads();
    int stage = 0;
#pragma unroll 1
    for (int s = 0; s <= NT; ++s) {
        const int stn = stage == 2 ? 0 : stage + 1, stp = stage == 0 ? 2 : stage - 1;
        if (s + 1 < NT) ATT_DMA(s + 1, stn);
        if (rb && s >= 1 && s <= myNT) attn_pv(o, pa, (unsigned)(uintptr_t)(lds + stp * 32768 + 16384 + ((lane >> 4) & 1) * 32 + (lane & 3) * 8 + (4 * hi + ((lane & 15) >> 2)) * 64));
        if (s < myNT) {
            f32x16 p0, p1; attn_qk(p0, p1, lds + stage * 32768 + map * 8192 + hi * 1024 + r32 * 16, qr);
            attn_softmax(s == 0, p0, p1, o, mrun, lrun, pa, wsf, r32, hi);
            if (!rb) attn_pv(o, pa, (unsigned)(uintptr_t)(lds + stage * 32768 + 16384 + ((lane >> 4) & 1) * 32 + (lane & 3) * 8 + (4 * hi + ((lane & 15) >> 2)) * 64));
        }
        asm volatile("s_waitcnt vmcnt(0)" ::: "memory"); __syncthreads();
        stage = stn;
    }
#undef ATT_DMA
    bf16x8 qn[4];
#pragma unroll
    for (int d0 = 0; d0 < 4; ++d0) qn[d0] = qr[d0];
    if (nqt >= 0) {
        const unsigned lds0 = (unsigned)(uintptr_t)lds;
#pragma unroll
        for (int i = 0; i < 2; ++i) { const int p = 2 * wave + i;
            glds16(KM + (size_t)lane * AW + h * 128 + (p >> 3) * 64 + (p & 7) * 8, (unsigned)__builtin_amdgcn_readfirstlane(lds0 + p * 1024));
            glds16(VM + (size_t)(16 * (p & 3) + (lane >> 2)) * AW + h * 128 + (p >> 2) * 32 + (lane & 3) * 8, (unsigned)__builtin_amdgcn_readfirstlane(lds0 + 16384 + p * 1024)); }
        const bf16_t* qp = Qg + (rowb + nqt * 128 + qb * 32 + r32) * AW + h * 128 + map * 64 + hi * 8;
#pragma unroll
        for (int d0 = 0; d0 < 4; ++d0) qn[d0] = *(const bf16x8*)(qp + d0 * 16);
    }
    { const float ltot = half_swap_sum(lrun); const float inv = (map ? lam : 1.0f) / ltot;
      if (hi == 0) wsf[r32] = inv;
      f32x4 a4[4];
#pragma unroll
      for (int gq = 0; gq < 4; ++gq) a4[gq] = *(const LAS f32x4*)(wsf + 8 * gq + 4 * hi);
#pragma unroll
      for (int d = 0; d < 4; ++d)
#pragma unroll
          for (int r = 0; r < 16; ++r) o[d][r] *= a4[r >> 2][r & 3]; }
    LAS float* X = (LAS float*)(lds + 32768 + qb * 16384);
    if (map == 1) {
#pragma unroll
        for (int d = 0; d < 4; ++d)
#pragma unroll
            for (int r = 0; r < 16; ++r) X[crow(r, hi) * 128 + 32 * d + r32] = o[d][r];
    }
    __syncthreads();
    if (map == 0) {
        float ssq[16];
#pragma unroll
        for (int r = 0; r < 16; ++r) ssq[r] = 0.f;
#pragma unroll
        for (int d = 0; d < 4; ++d)
#pragma unroll
            for (int r = 0; r < 16; ++r) { const float v = o[d][r] - X[crow(r, hi) * 128 + 32 * d + r32]; o[d][r] = v; ssq[r] += v * v; }
#pragma unroll
        for (int r = 0; r < 16; ++r) {
#pragma unroll
            for (int off = 1; off < 32; off <<= 1) ssq[r] += __shfl_xor(ssq[r], off);
            ssq[r] = 0.8f / sqrtf(ssq[r] * (1.f / 128.f) + LN_EPS); }
        LAS bf16_t* Yt = (LAS bf16_t*)X;
#pragma unroll
        for (int d = 0; d < 4; ++d) { const float gg = subg[32 * d + r32];
#pragma unroll
            for (int r = 0; r < 16; ++r) Yt[crow(r, hi) * 128 + 32 * d + r32] = (bf16_t)(cvt_pk_bf16(o[d][r] * ssq[r] * gg, 0.f) & 0xffffu); }
#pragma unroll
        for (int i = 0; i < 8; ++i) { const int id = i * 64 + lane, row = id >> 4, ch = id & 15;
            *(u32x4*)(Y + (rowb + q0 + row) * AW + h * 128 + ch * 8) = *(const LAS u32x4*)(Yt + row * 128 + ch * 8); }
    }
#pragma unroll
    for (int d0 = 0; d0 < 4; ++d0) qr[d0] = qn[d0];
    __syncthreads();
}
__device__ __forceinline__ void p3_attention(const Ctx& C, const float* const* in, unsigned char* ws) {
    const bf16_t* Q = (const bf16_t*)(ws + WS_Q); const bf16_t* K = (const bf16_t*)(ws + WS_K); const bf16_t* V = (const bf16_t*)(ws + WS_V);
    const bf16_t* KM = (const bf16_t*)(ws + WS_KMETA); const bf16_t* VM = (const bf16_t*)(ws + WS_VMETA); bf16_t* Y = (bf16_t*)(ws + WS_YATT);
    const float l1 = wave_sum(in[14][C.lane] * in[15][C.lane]), l2 = wave_sum(in[16][C.lane] * in[17][C.lane]);
    const float lam = expf(l1) - expf(l2) + 0.2f;
    LAS unsigned* rc = (LAS unsigned*)(C.lds + MISC_OFF + 6144);
    if (C.tid < 4) rc[C.tid] = 0;
    __syncthreads();
    bool rb;
    { const unsigned simd = (unsigned)__builtin_amdgcn_s_getreg(2308) & 3u;
      unsigned r = 0; if (C.lane == 0) r = __hip_atomic_fetch_add(rc + simd, 1u, __ATOMIC_RELAXED, __HIP_MEMORY_SCOPE_WORKGROUP);
      rb = (__builtin_amdgcn_readfirstlane((int)r) & 1) != 0; }
#ifndef ATT_REP
#define ATT_REP 1
#endif
    for (int vv = C.vcu; vv < 256 * ATT_REP; vv += C.G) { const int v = vv & 255;
        const int bh = v >> 1, sft = v & 1;
        bf16x8 qr[4];
#pragma unroll
        for (int d0 = 0; d0 < 4; ++d0) qr[d0] = (bf16x8){};
#pragma unroll 1
        for (int i = 0; i < 8; ++i) { const int qt = (i & 1) ? (15 - sft - (i & ~1)) : (sft + (i & ~1)); const int i1 = i + 1;
            const int nqt = i1 < 8 ? ((i1 & 1) ? (15 - sft - (i1 & ~1)) : (sft + (i1 & ~1))) : -1;
            attn_unit(C, Q, K, V, KM, VM, Y, in[18], lam, bh >> 3, bh & 7, qt, i > 0, nqt, qr, rb); }
    }
}

__device__ __forceinline__ void p6_ln1_router(const Ctx& C, const float* const* in, unsigned char* ws) {
    const int lane = C.lane, wave = C.wave, tid = C.tid;
    const bf16_t* Z = (const bf16_t*)(ws + WS_Z); bf16_t* H1 = (bf16_t*)(ws + WS_H1); const float* WrT = (const float*)(ws + WS_WRT);
    int* LIST = (int*)(ws + WS_LIST); float* WGT = (float*)(ws + WS_WGT); unsigned* ECNT = (unsigned*)(ws + WS_CTL) + CW_ECNT;
    const float* lg = in[22]; const float* lb = in[23];
    LAS float* WB = (LAS float*)C.lds;
    LAS unsigned char* XB = C.lds + 98304;
    LAS int* RE = (LAS int*)(XB);
    LAS float* RW = (LAS float*)(XB + 1024);
    LAS int* CL = (LAS int*)(XB + 2048);
    LAS int* BS = (LAS int*)(XB + 2048 + 128);
    LAS int* SL = (LAS int*)(XB + 2048 + 256);
    LAS float* LG = (LAS float*)(XB + 4096) + wave * 80;
    for (int rbk = C.vcu; rbk < T / 128; rbk += C.G) {
        if (tid < 32) CL[tid] = 0;
#pragma unroll 1
        for (int step = 0; step < 8; ++step) {
            const int lr0 = step * 16 + 2 * wave; const size_t row0 = (size_t)rbk * 128 + lr0;
            int l4 = 4 * lane; asm volatile("" : "+v"(l4));
            f32x4 v0[8], v1[8];
#pragma unroll
            for (int j = 0; j < 8; ++j) { const u32x2 z0 = *(const u32x2*)(Z + row0 * DM + 256 * j + l4), z1 = *(const u32x2*)(Z + (row0 + 1) * DM + 256 * j + l4);
                v0[j] = (f32x4){bf_lo(z0.x), bf_hi(z0.x), bf_lo(z0.y), bf_hi(z0.y)}; v1[j] = (f32x4){bf_lo(z1.x), bf_hi(z1.x), bf_lo(z1.y), bf_hi(z1.y)}; }
            float mean0, rstd0, mean1, rstd1; ln_stats(v0, mean0, rstd0); ln_stats(v1, mean1, rstd1);
#pragma unroll
            for (int j = 0; j < 8; ++j) { const f32x4 gg = *(const f32x4*)(lg + 256 * j + l4), bb = *(const f32x4*)(lb + 256 * j + l4);
                v0[j] = (v0[j] - mean0) * rstd0 * gg + bb; v1[j] = (v1[j] - mean1) * rstd1 * gg + bb;
                u32x2 w; w.x = cvt_pk_bf16(v0[j].x, v0[j].y); w.y = cvt_pk_bf16(v0[j].z, v0[j].w); *(u32x2*)(H1 + row0 * DM + 256 * j + l4) = w;
                w.x = cvt_pk_bf16(v1[j].x, v1[j].y); w.y = cvt_pk_bf16(v1[j].z, v1[j].w); *(u32x2*)(H1 + (row0 + 1) * DM + 256 * j + l4) = w; }
#pragma unroll 1
            for (int ng = 0; ng < 3; ++ng) {
                __syncthreads();
                int tq = tid; asm volatile("" : "+v"(tq));
#pragma unroll
                for (int i = 0; i < 12; ++i) { const int idx = tq + 512 * i, n = idx >> 9, c4 = idx & 511;
                    *(LAS f32x4*)(WB + n * 2048 + 4 * c4) = *(const f32x4*)(WrT + (size_t)(12 * ng + n) * DM + 4 * c4); }
                __syncthreads();
#pragma unroll 1
                for (int n = 0; n < 12; ++n) { float pa = 0.f, pb = 0.f;
#pragma unroll
                    for (int j = 0; j < 8; ++j) { const f32x4 w4 = *(const LAS f32x4*)(WB + n * 2048 + 256 * j + l4);
                        const f32x4 a = v0[j] * w4, bq = v1[j] * w4; pa += (a.x + a.y) + (a.z + a.w); pb += (bq.x + bq.y) + (bq.z + bq.w); }
                    const float sa = wave_sum(pa), sb = wave_sum(pb); if (lane == 0) { LG[12 * ng + n] = sa; LG[40 + 12 * ng + n] = sb; } }
            }
            if (lane < 2) {
                const LAS float* L = LG + 40 * lane;
                int gi = 0; float gm = L[0] + in[25][0];
                for (int n = 1; n < 4; ++n) { const float x = L[n] + in[25][n]; if (x > gm) { gm = x; gi = n; } }
                float gs = 0.f;
                for (int n = 0; n < 4; ++n) gs += __expf(L[n] + in[25][n] - gm);
                const float gval = 1.0f / gs;
                int i1 = 0; float m1 = L[4 + gi * 8] + in[27][gi * 8];
                for (int j = 1; j < 8; ++j) { const float x = L[4 + gi * 8 + j] + in[27][gi * 8 + j]; if (x > m1) { m1 = x; i1 = j; } }
                int i2 = -1; float m2 = -__builtin_inff();
                for (int j = 0; j < 8; ++j) { const float x = L[4 + gi * 8 + j] + in[27][gi * 8 + j]; if (j != i1 && x > m2) { m2 = x; i2 = j; } }
                const float tt = __expf(m2 - m1), w1 = gval / (1.f + tt), w2 = gval * tt / (1.f + tt);
                const int lr = lr0 + lane; RE[lr * 2] = gi * 8 + i1; RE[lr * 2 + 1] = gi * 8 + i2; RW[lr * 2] = w1; RW[lr * 2 + 1] = w2;
            }
        }
        __syncthreads();
        int e = 0;
        if (tid < 256) { e = RE[tid]; SL[tid] = __hip_atomic_fetch_add(&CL[e], 1, __ATOMIC_RELAXED, __HIP_MEMORY_SCOPE_WORKGROUP); }
        __syncthreads();
        if (tid < 32) BS[tid] = (int)__hip_atomic_fetch_add(&ECNT[tid], (unsigned)CL[tid], __ATOMIC_RELAXED, __HIP_MEMORY_SCOPE_AGENT);
        __syncthreads();
        if (tid < 256) { const int entry = (rbk * 128 + (tid >> 1)) * 2 + (tid & 1); LIST[(size_t)e * CAP + BS[e] + SL[tid]] = entry; WGT[entry] = RW[tid]; }
        __syncthreads();
    }
}

__device__ __forceinline__ void p9_ln2(const Ctx& C, const float* const* in, unsigned char* ws, float* out) {
    const bf16_t* H1 = (const bf16_t*)(ws + WS_H1); const bf16_t* YK = (const bf16_t*)(ws + WS_YK);
    const float* lg = in[31]; const float* lb = in[32];
    const int gw = C.vcu * 8 + C.wave, NGW = C.G * 8, lane = C.lane;
    for (int m = gw; m < T; m += 2 * NGW) {
        const int m2 = (m + NGW < T) ? m + NGW : m;
        u32x2 ha[8], ya0[8], ya1[8], hb[8], yb0[8], yb1[8];
#pragma unroll
        for (int j = 0; j < 8; ++j) { const size_t c = 256 * j + 4 * lane;
            ha[j] = *(const u32x2*)(H1 + (size_t)m * DM + c); ya0[j] = *(const u32x2*)(YK + (size_t)(2 * m) * DM + c); ya1[j] = *(const u32x2*)(YK + (size_t)(2 * m + 1) * DM + c);
            hb[j] = *(const u32x2*)(H1 + (size_t)m2 * DM + c); yb0[j] = *(const u32x2*)(YK + (size_t)(2 * m2) * DM + c); yb1[j] = *(const u32x2*)(YK + (size_t)(2 * m2 + 1) * DM + c); }
#pragma unroll
        for (int rr = 0; rr < 2; ++rr) {
            f32x4 v[8];
#pragma unroll
            for (int j = 0; j < 8; ++j) { const u32x2 hw = rr ? hb[j] : ha[j], y0 = rr ? yb0[j] : ya0[j], y1 = rr ? yb1[j] : ya1[j];
                v[j] = (f32x4){bf_lo(hw.x), bf_hi(hw.x), bf_lo(hw.y), bf_hi(hw.y)} * ALPHA + (f32x4){bf_lo(y0.x), bf_hi(y0.x), bf_lo(y0.y), bf_hi(y0.y)} + (f32x4){bf_lo(y1.x), bf_hi(y1.x), bf_lo(y1.y), bf_hi(y1.y)}; }
            float mean, rstd; ln_stats(v, mean, rstd);
            const int mm = rr ? m2 : m;
            if (rr == 0 || m2 != m) {
#pragma unroll
                for (int j = 0; j < 8; ++j) { const f32x4 gg = *(const f32x4*)(lg + 256 * j + 4 * lane), bb = *(const f32x4*)(lb + 256 * j + 4 * lane);
                    *(f32x4*)(out + (size_t)mm * DM + 256 * j + 4 * lane) = (v[j] - mean) * rstd * gg + bb; } }
        }
    }
}

__device__ __forceinline__ int build_moe_tables(const Ctx& C, unsigned char* ws) {
    LAS int* blkstart = (LAS int*)(C.lds + MISC_OFF + 64); LAS int* cntE = (LAS int*)(C.lds + MISC_OFF + 320); LAS int* blkexp = (LAS int*)(C.lds + MISC_OFF + 512);
    unsigned* ECNT = (unsigned*)(ws + WS_CTL) + CW_ECNT;
    __syncthreads();
    if (C.tid < 32) cntE[C.tid] = (int)__hip_atomic_load(&ECNT[C.tid], __ATOMIC_RELAXED, __HIP_MEMORY_SCOPE_AGENT);
    __syncthreads();
    if (C.tid == 0) { int s = 0; for (int e = 0; e < NE; ++e) { blkstart[e] = s; s += (cntE[e] + 255) >> 8; } blkstart[NE] = s; }
    __syncthreads();
    const int NBLK = blkstart[NE];
    if (C.tid < NBLK && C.tid < 320) { int e = 0; for (int j = 1; j < NE; ++j) if (blkstart[j] <= C.tid) e = j; blkexp[C.tid] = e; }
    __syncthreads();
    return NBLK < 320 ? NBLK : 320;
}

__device__ __forceinline__ void p7_convert_down(const Ctx& C, const float* const* in, unsigned char* ws) {
    LAS float* scr = (LAS float*)(C.lds + C.wave * 16384);
    unsigned* ctr = (unsigned*)(ws + WS_CTL) + CW_CONV; bf16_t* WdnT = (bf16_t*)(ws + WS_WDN);
    constexpr int NCH = NE * 512 / 16;
    for (;;) {
        unsigned ch = 0; if (C.lane == 0) ch = __hip_atomic_fetch_add(ctr, 1u, __ATOMIC_RELAXED, __HIP_MEMORY_SCOPE_AGENT);
        ch = (unsigned)__builtin_amdgcn_readfirstlane((int)ch);
        if (ch >= (unsigned)NCH) break;
#pragma unroll 1
        for (int q = 0; q < 16; ++q) { const int r = (int)ch * 16 + q, e = r >> 9, rr = r & 511, kb = rr >> 6, nb = rr & 63;
            transpose_item(in[30] + (size_t)e * DFF * DM, DFF, DM, WdnT, kb, nb, e * 2048 + 32 * nb, scr, C.lane); }
    }
}

constexpr int NPHASE = 10;
struct Args { const float* in[33]; float* out; unsigned char* ws; int ph_lo, ph_hi; };
__global__ void __launch_bounds__(512, 2) mk_fwd(Args args) {
    extern __shared__ __attribute__((aligned(16))) unsigned char lds_raw[];
    Ctx C; C.lds = (LAS unsigned char*)lds_raw; C.tid = threadIdx.x; C.lane = C.tid & 63; C.wave = __builtin_amdgcn_readfirstlane(C.tid >> 6);
    C.G = gridDim.x; { const int bx = blockIdx.x; C.vcu = (C.G % 8 == 0) ? (bx % 8) * (C.G / 8) + bx / 8 : bx; }
    unsigned char* ws = args.ws; const float* const* in = args.in;
    volatile LAS unsigned* MISC = (volatile LAS unsigned*)(C.lds + MISC_OFF);
    if (C.tid < 16) MISC[C.tid] = 0u;
    __syncthreads();
    unsigned* barw = (unsigned*)(ws + WS_CTL) + CW_BAR;
    XcdBarrier bar; bar.bar = barw; bar.x = 0; bar.st = nullptr;
    const int lo = args.ph_lo, hi = args.ph_hi;
    if (hi - lo > 1) bar = xcd_barrier_post(barw, MISC);
#ifndef PH_MASK
#define PH_MASK 0x3ff
#endif
#define IN(k) (((PH_MASK >> (k)) & 1) && lo <= (k) && (k) < hi)
#define SEAM(k) do { if (IN(k) && IN((k) + 1)) xcd_barrier(bar); } while (0)
#ifndef WGM_PROJ
#define WGM_PROJ 4
#endif
#ifndef WGM_N2K
#define WGM_N2K 2
#endif
#ifndef GEMM_SP2
#define GEMM_SP2 true
#endif
#ifndef GEMM_ALIGN
#define GEMM_ALIGN true
#endif
#ifndef PROBE_MASK
#define PROBE_MASK 0
#endif
#define REPS(k) (((PROBE_MASK >> (k)) & 1) ? 2 : 1)
#define REPSEAM(k, rep) do { if ((rep) + 1 < REPS(k)) xcd_barrier(bar); } while (0)
    LAS unsigned char* lds = C.lds;
    bf16_t* MG = (bf16_t*)args.out;

    if (IN(0)) { _Pragma("unroll") for (int rep = 0; rep < REPS(0); ++rep) { p0_prologue(C, in, ws); REPSEAM(0, rep); } } SEAM(0);

    if (IN(1)) { _Pragma("unroll") for (int rep = 0; rep < REPS(1); ++rep) {
        pg8::Gemm g{(const bf16_t*)(ws + WS_HBF), (const bf16_t*)(ws + WS_WIN), T, INC, DM, nullptr, nullptr, 0}; pg8::StaticOrder S; S.init(T, INC, C.G, (int)blockIdx.x, WGM_PROJ);
        EpiProj E{(bf16_t*)(ws + WS_U), (bf16_t*)(ws + WS_Q), (bf16_t*)(ws + WS_K), (bf16_t*)(ws + WS_V), (bf16_t*)(ws + WS_SGS), (bf16_t*)(ws + WS_SGA)};
        pg8::gemm_phase<EpiProj, pg8::StaticOrder, GEMM_ALIGN, GEMM_SP2, false>(lds, g, S, E);
        p1_meta_proj(C, ws);
        REPSEAM(1, rep);
    } } SEAM(1);

    if (IN(2)) { _Pragma("unroll") for (int rep = 0; rep < REPS(2); ++rep) { p2_scan(C, in, ws); REPSEAM(2, rep); } } SEAM(2);

    if (IN(3)) { _Pragma("unroll") for (int rep = 0; rep < REPS(3); ++rep) {
        { pg8::Gemm g{(const bf16_t*)(ws + WS_YPRE), (const bf16_t*)(ws + WS_WGLU), T, SSMW, SSMW, nullptr, nullptr, 0}; pg8::StaticOrder S; S.init(T, SSMW, C.G, (int)blockIdx.x);
          EpiGlu E{(const bf16_t*)(ws + WS_YPRE), (bf16_t*)(ws + WS_YSSM)};
          pg8::gemm_phase<EpiGlu, pg8::StaticOrder, GEMM_ALIGN, GEMM_SP2, false>(lds, g, S, E); }
        p3_attention(C, in, ws);
        REPSEAM(3, rep);
    } } SEAM(3);

    if (IN(4)) { _Pragma("unroll") for (int rep = 0; rep < REPS(4); ++rep) {
        { pg8::Gemm g{(const bf16_t*)(ws + WS_YSSM), (const bf16_t*)(ws + WS_WBS), T, DM, SSMW, (const bf16_t*)(ws + WS_YATT), (const bf16_t*)(ws + WS_WBA), AW}; pg8::StaticOrder S; S.init(T, DM, C.G, (int)blockIdx.x, WGM_N2K);
          EpiMergeF E{(const bf16_t*)(ws + WS_SGS), (const bf16_t*)(ws + WS_SGA), MG};
          pg8::gemm_phase<EpiMergeF, pg8::StaticOrder, GEMM_ALIGN, GEMM_SP2, false, true>(lds, g, S, E); }
        REPSEAM(4, rep);
    } } SEAM(4);

    if (IN(5)) { _Pragma("unroll") for (int rep = 0; rep < REPS(5); ++rep) {
        pg8::Gemm g{MG, (const bf16_t*)(ws + WS_WO), T, DM, DM, nullptr, nullptr, 0}; pg8::StaticOrder S; S.init(T, DM, C.G, (int)blockIdx.x, WGM_N2K);
        EpiZ E{(const bf16_t*)(ws + WS_HBF), (bf16_t*)(ws + WS_Z)};
        pg8::gemm_phase<EpiZ, pg8::StaticOrder, GEMM_ALIGN, GEMM_SP2, false>(lds, g, S, E);
        REPSEAM(5, rep);
    } } SEAM(5);

    if (IN(6)) { p6_ln1_router(C, in, ws); } SEAM(6);

    if (IN(7)) { _Pragma("unroll") for (int rep = 0; rep < REPS(7); ++rep) {
        const int NBLK = build_moe_tables(C, ws);
        MoeOrder S{C.G, C.vcu, 2, NBLK, (const LAS int*)(lds + MISC_OFF + 512), (const LAS int*)(lds + MISC_OFF + 64), (const LAS int*)(lds + MISC_OFF + 320), (const int*)(ws + WS_LIST)};
        pg8::Gemm g{(const bf16_t*)(ws + WS_H1), (const bf16_t*)(ws + WS_WUP), T, NE * 1024, DM, nullptr, nullptr, 0};
        EpiSwiglu E{(bf16_t*)(ws + WS_HB), (const int*)(ws + WS_LIST), (const float*)(ws + WS_WGT), (int*)(ws + WS_POSE), (float*)(ws + WS_POSW)};
        pg8::gemm_phase<EpiSwiglu, MoeOrder, GEMM_ALIGN, GEMM_SP2, true>(lds, g, S, E);
        p7_convert_down(C, in, ws);
        REPSEAM(7, rep);
    } } SEAM(7);

    if (IN(8)) { _Pragma("unroll") for (int rep = 0; rep < REPS(8); ++rep) {
        const int NBLK = build_moe_tables(C, ws);
        MoeOrder S{C.G, C.vcu, 3, NBLK, (const LAS int*)(lds + MISC_OFF + 512), (const LAS int*)(lds + MISC_OFF + 64), (const LAS int*)(lds + MISC_OFF + 320), (const int*)(ws + WS_LIST)};
        pg8::Gemm g{(const bf16_t*)(ws + WS_HB), (const bf16_t*)(ws + WS_WDN), NBLK * 256, NE * DM, DFF, nullptr, nullptr, 0};
        EpiDown E{(const int*)(ws + WS_POSE), (const float*)(ws + WS_POSW), (bf16_t*)(ws + WS_YK)};
        pg8::gemm_phase<EpiDown, MoeOrder, GEMM_ALIGN, GEMM_SP2, false>(lds, g, S, E);
        REPSEAM(8, rep);
    } } SEAM(8);

    if (IN(9)) { _Pragma("unroll") for (int rep = 0; rep < REPS(9); ++rep) { p9_ln2(C, in, ws, args.out); REPSEAM(9, rep); } }
#undef IN
#undef SEAM
}

extern "C" void kernel_launch(void* const* d_in, const int* in_sizes, int n_in, void* d_out, int out_size, void* d_ws, size_t ws_size, hipStream_t stream) {
    static int grid = 0;
    if (grid == 0) {
        if (n_in != 33 || in_sizes[0] != T * DM || out_size != T * DM || ws_size < WS_END) { fprintf(stderr, "kernel_launch: unexpected shapes (n_in %d, in0 %d, out %d, ws %zu)\n", n_in, n_in > 0 ? in_sizes[0] : -1, out_size, ws_size); grid = -1; return; }
        int dev = 0, cus = 0, per_cu = 0;
        if (hipGetDevice(&dev) != hipSuccess || hipDeviceGetAttribute(&cus, hipDeviceAttributeMultiprocessorCount, dev) != hipSuccess) { grid = -1; return; }
        if (hipFuncSetAttribute((const void*)mk_fwd, hipFuncAttributeMaxDynamicSharedMemorySize, LDS_BYTES) != hipSuccess) { fprintf(stderr, "kernel_launch: hipFuncSetAttribute failed\n"); grid = -1; return; }
        if (hipOccupancyMaxActiveBlocksPerMultiprocessor(&per_cu, (const void*)mk_fwd, 512, LDS_BYTES) != hipSuccess || per_cu < 1) { fprintf(stderr, "kernel_launch: occupancy query reports %d blocks per CU\n", per_cu); }
        (void)hipGetLastError();
        grid = cus;
    }
    if (grid < 0) return;
    (void)hipMemsetAsync((char*)d_ws + WS_CTL, 0, CTL_ZERO_BYTES, stream);
    Args a{};
    for (int i = 0; i < 33; ++i) a.in[i] = (const float*)d_in[i];
    a.out = (float*)d_out; a.ws = (unsigned char*)d_ws;
#if MK_PER_PHASE
    for (int p = 0; p < NPHASE; ++p) { a.ph_lo = p; a.ph_hi = p + 1; hipLaunchKernelGGL(mk_fwd, dim3(grid), dim3(512), LDS_BYTES, stream, a); }
#else
    a.ph_lo = 0; a.ph_hi = NPHASE; hipLaunchKernelGGL(mk_fwd, dim3(grid), dim3(512), LDS_BYTES, stream, a);
#endif
}
```

```cpp
#include <hip/hip_runtime.h>
#include <stdint.h>
#include <stdio.h>

#ifndef ATT_PROBE
#define ATT_PROBE 0
#endif
#ifndef MK_PER_PHASE
#define MK_PER_PHASE 0
#endif

#define GAS __attribute__((address_space(1)))
#define LAS __attribute__((address_space(3)))
typedef unsigned short bf16_t;
typedef short bf16x8 __attribute__((ext_vector_type(8)));
typedef short s16x4 __attribute__((ext_vector_type(4)));
typedef float f32x2 __attribute__((ext_vector_type(2)));
typedef float f32x4 __attribute__((ext_vector_type(4)));
typedef float f32x16 __attribute__((ext_vector_type(16)));
typedef unsigned u32x2 __attribute__((ext_vector_type(2)));
typedef unsigned u32x4 __attribute__((ext_vector_type(4)));

constexpr int NB_ = 16, SEQ = 2048, DM = 2048, T = NB_ * SEQ, NMETA = 16;
constexpr int SSMW = 512, AW = 1024, INC = 7680, NGRP = 32, NST = 64;
constexpr int NE = 32, DFF = 512, CAP = T;
constexpr float LN_EPS = 1e-5f;
constexpr float ALPHA = 1.189207115002721f;
constexpr float QSCALE = 0.125f * 1.4426950408889634f;

__device__ __forceinline__ unsigned cvt_pk_bf16(float lo, float hi) { unsigned r; asm volatile("v_cvt_pk_bf16_f32 %0, %1, %2" : "=v"(r) : "v"(lo), "v"(hi)); return r; }
__device__ __forceinline__ float bf_lo(unsigned w) { return __uint_as_float(w << 16); }
__device__ __forceinline__ float bf_hi(unsigned w) { return __uint_as_float(w & 0xffff0000u); }
__device__ __forceinline__ float sigmoidf_(float x) { return __builtin_amdgcn_rcpf(1.0f + __expf(-x)); }
__device__ __forceinline__ float wave_sum(float v) {
#pragma unroll
    for (int o = 1; o < 64; o <<= 1) v += __shfl_xor(v, o);
    return v;
}

namespace pg8 {
constexpr int BM = 256, BK = 64, HALF = 128, HTB = HALF * BK * 2, STAGE_BYTES = 8 * HTB, NXCD = 8, WGM = 4;
__host__ __device__ __forceinline__ int lds_byte(int r, int c) { const int st = (r >> 4) * 2 + (c >> 5), rr = r & 15, cc = c & 31, ob = rr * 64 + cc * 2; return st * 1024 + (ob ^ (((ob >> 9) & 1) << 5)); }
__host__ __device__ __forceinline__ void stage_rc(int b, int& R, int& C) { const int st = b / 1024, sb = b % 1024, swz = sb ^ (((sb >> 9) & 1) << 5); R = (st >> 1) * 16 + swz / 64; C = (st & 1) * 32 + (swz % 64) / 2; }
__host__ __device__ __forceinline__ int perm32(int rho) { const int n = rho >> 4, i = rho & 15; return 8 * (i >> 2) + 4 * n + (i & 3); }

struct Unit { int pm, pn, e, s0, cnt; };
struct Gemm { const bf16_t* A; const bf16_t* Bt; int M, N, K; const bf16_t* A2; const bf16_t* Bt2; int K2; };

struct StaticOrder {
    int nM, nN, nwg, G, c, wgm;
    __device__ void init(int M, int N, int G_, int c_, int wgm_ = WGM) { nM = M / BM; nN = N / BM; nwg = nM * nN; G = G_; c = c_; wgm = wgm_; }
    __device__ bool next(int i, Unit& u) const {
        const long L = (long)i * G + c; if (L >= nwg) return false;
        int wgid = (int)L; { const int q = nwg / NXCD, r = nwg % NXCD, xcd = wgid % NXCD, off = wgid / NXCD; wgid = (xcd < r ? xcd * (q + 1) : r * (q + 1) + (xcd - r) * q) + off; }
        const int nig = wgm * nN, gid = wgid / nig, fm = gid * wgm, gsz = (nM - fm) < wgm ? (nM - fm) : wgm;
        u.pm = fm + ((wgid % nig) % gsz); u.pn = (wgid % nig) / gsz; u.e = 0; u.s0 = 0; u.cnt = 0; return true;
    }
    __device__ __forceinline__ int arow(const Unit&, int) const { return 0; }
};

template <class Epi, class Sched, bool ALIGN_EPI, bool SP2, bool GATHER, bool DUAL = false>
__device__ __forceinline__ void gemm_phase(LAS unsigned char* lds, const Gemm g, const Sched& S, const Epi& E) {
    const int tid = threadIdx.x, wid = __builtin_amdgcn_readfirstlane(tid >> 6), lane = tid & 63, wr = wid >> 2, wc = wid & 3, fr = lane & 15, fq = lane >> 4;
    const int K = g.K, K2 = DUAL ? g.K2 : 0, nt1 = K / BK, nt = (K + K2) / BK;
    unsigned voffA[2], voffB[2], voffA2[2] = {0u, 0u}, voffB2[2] = {0u, 0u}; int stR[2], stC[2];
#pragma unroll
    for (int i = 0; i < 2; ++i) { int R, C; stage_rc(tid * 16 + i * 8192, R, C); const int Rb = Epi::PERM ? ((R & ~31) + perm32(R & 31)) : R;
        stR[i] = R; stC[i] = C; voffA[i] = (unsigned)(R * K + C) * 2u; voffB[i] = (unsigned)(Rb * K + C) * 2u;
        if constexpr (DUAL) { voffA2[i] = (unsigned)(R * K2 + C) * 2u; voffB2[i] = (unsigned)(Rb * K2 + C) * 2u; } }
    const size_t kstep = (size_t)(BK * 2);
    const size_t hstep = (size_t)HALF * K * 2;
    const size_t tstep = 2 * hstep;
    const size_t hstep2 = (size_t)HALF * K2 * 2, tstep2 = 2 * hstep2;
    const unsigned ldsw = (unsigned)wid * 1024u;
    const int aoff = lds_byte(wr * 64 + fr, fq * 8), boff = lds_byte(wc * 32 + fr, fq * 8);
#define PG8_SA(b, h) (((b) * 2 + (h)) * HTB)
#define PG8_SB(b, h) ((4 + (b) * 2 + (h)) * HTB)
#define PG8_STAGE(bufoff, gbase, voff) do { _Pragma("unroll") for (int _i = 0; _i < 2; ++_i) \
        __builtin_amdgcn_global_load_lds((const unsigned*)((const char*)(gbase) + (voff)[_i]), (LAS unsigned*)(lds + (bufoff) + ldsw + _i * 8192), 16, 0, 0); } while (0)
#define PG8_STAGE_A(bufoff, kbase, h, VO) do { if constexpr (GATHER) { PG8_STAGE(bufoff, kbase, VO[h]); } else { PG8_STAGE(bufoff, (kbase) + (h) * hstep, voffA); } } while (0)
#define PG8_STAGE_AX(bufoff, kbase, h, VO, HS, VA) do { if constexpr (GATHER) { PG8_STAGE(bufoff, kbase, VO[h]); } else { PG8_STAGE(bufoff, (kbase) + (h) * (HS), VA); } } while (0)
#define PG8_LDA(dst, b, h) do { _Pragma("unroll") for (int m = 0; m < 4; ++m) _Pragma("unroll") for (int k = 0; k < 2; ++k) dst[m][k] = *(const LAS bf16x8*)(lds + PG8_SA(b, h) + aoff + m * 2048 + k * 1024); } while (0)
#define PG8_LDB(dst, b, h) do { _Pragma("unroll") for (int n = 0; n < 2; ++n) _Pragma("unroll") for (int k = 0; k < 2; ++k) dst[n][k] = *(const LAS bf16x8*)(lds + PG8_SB(b, h) + boff + n * 2048 + k * 1024); } while (0)
#define PG8_MMA(ai, bj, At, Bt) do { __builtin_amdgcn_s_setprio(1); _Pragma("unroll") for (int m = 0; m < 4; ++m) _Pragma("unroll") for (int n = 0; n < 2; ++n) _Pragma("unroll") for (int k = 0; k < 2; ++k) \
        acc[ai][bj][m][n] = __builtin_amdgcn_mfma_f32_16x16x32_bf16(Bt[n][k], At[m][k], acc[ai][bj][m][n], 0, 0, 0); __builtin_amdgcn_s_setprio(0); } while (0)
#define PG8_WAIT_V(n) asm volatile("s_waitcnt vmcnt(" #n ")" ::: "memory")
#define PG8_WAIT_L(n) asm volatile("s_waitcnt lgkmcnt(" #n ")" ::: "memory")
#define PG8_BAR __builtin_amdgcn_s_barrier()
#define PG8_SCHED __builtin_amdgcn_sched_barrier(0)
#define PG8_GOFF(VO, U) do { _Pragma("unroll") for (int _h = 0; _h < 2; ++_h) _Pragma("unroll") for (int _i = 0; _i < 2; ++_i) \
        VO[_h][_i] = (unsigned)S.arow(U, _h * HALF + stR[_i]) * (unsigned)(K * 2) + (unsigned)(stC[_i] * 2); } while (0)
    Unit cur, nxt; int ui = 0;
    if (!S.next(0, cur)) return;
    f32x4 acc[2][2][4][2];
#pragma unroll
    for (int a = 0; a < 2; ++a)
#pragma unroll
        for (int b = 0; b < 2; ++b)
#pragma unroll
            for (int m = 0; m < 4; ++m)
#pragma unroll
                for (int n = 0; n < 2; ++n) acc[a][b][m][n] = (f32x4){0.f, 0.f, 0.f, 0.f};
    bf16x8 At[4][2], B0[2][2], B1[2][2];
    unsigned cvo[2][2] = {{0u, 0u}, {0u, 0u}}, nvo[2][2] = {{0u, 0u}, {0u, 0u}};
    const char* cA = GATHER ? (const char*)g.A : (const char*)g.A + (size_t)cur.pm * tstep; const char* cB = (const char*)g.Bt + (size_t)cur.pn * tstep;
    if constexpr (GATHER) { PG8_GOFF(cvo, cur); }
    if constexpr (SP2) {
        PG8_STAGE(PG8_SB(0, 0), cB, voffB); PG8_STAGE(PG8_SB(0, 1), cB + hstep, voffB); PG8_STAGE_A(PG8_SA(0, 0), cA, 0, cvo); PG8_STAGE_A(PG8_SA(0, 1), cA, 1, cvo);
        if (wr == 1) PG8_BAR;
        PG8_WAIT_V(2); PG8_BAR;
        PG8_STAGE(PG8_SB(1, 0), cB + kstep, voffB); PG8_STAGE_A(PG8_SA(1, 0), cA + kstep, 0, cvo); PG8_STAGE(PG8_SB(1, 1), cB + hstep + kstep, voffB);
        PG8_WAIT_V(6); PG8_BAR;
    } else {
        PG8_STAGE(PG8_SB(0, 0), cB, voffB); PG8_STAGE_A(PG8_SA(0, 0), cA, 0, cvo); PG8_STAGE(PG8_SB(0, 1), cB + hstep, voffB); PG8_STAGE_A(PG8_SA(0, 1), cA, 1, cvo);
        if (wr == 1) PG8_BAR;
        PG8_WAIT_V(4); PG8_BAR;
        PG8_STAGE(PG8_SB(1, 0), cB + kstep, voffB); PG8_STAGE_A(PG8_SA(1, 0), cA + kstep, 0, cvo); PG8_STAGE(PG8_SB(1, 1), cB + hstep + kstep, voffB);
        PG8_WAIT_V(6); PG8_BAR;
    }
    for (;;) {
        const bool has_next = S.next(ui + 1, nxt);
        const char* nA = GATHER ? cA : (has_next ? (const char*)g.A + (size_t)nxt.pm * tstep : cA); const char* nB = has_next ? (const char*)g.Bt + (size_t)nxt.pn * tstep : cB;
        if constexpr (GATHER) { if (has_next) { PG8_GOFF(nvo, nxt); } else {
#pragma unroll
            for (int h = 0; h < 2; ++h)
#pragma unroll
                for (int i = 0; i < 2; ++i) nvo[h][i] = cvo[h][i]; } }
        const char* cA2 = DUAL ? (const char*)g.A2 + (size_t)cur.pm * tstep2 : cA; const char* cB2 = DUAL ? (const char*)g.Bt2 + (size_t)cur.pn * tstep2 : cB;
        for (int t = 0; t < nt; t += 2) {
            const bool last = (t == nt - 2);
            const bool s1 = DUAL && (t + 1 >= nt1), s2 = DUAL && !last && (t + 2 >= nt1);
            const char* a1 = s1 ? cA2 + (size_t)(t + 1 - nt1) * kstep : cA + (size_t)(t + 1) * kstep;
            const char* a2 = last ? nA : (s2 ? cA2 + (size_t)(t + 2 - nt1) * kstep : cA + (size_t)(t + 2) * kstep);
            const char* b2 = last ? nB : (s2 ? cB2 + (size_t)(t + 2 - nt1) * kstep : cB + (size_t)(t + 2) * kstep);
            const char* a3 = a2 + kstep; const char* b3 = b2 + kstep;
            const size_t hs1 = s1 ? hstep2 : hstep, hs2 = s2 ? hstep2 : hstep;
            unsigned vA1[2], vA2[2], vB2[2];
#pragma unroll
            for (int i = 0; i < 2; ++i) { vA1[i] = s1 ? voffA2[i] : voffA[i]; vA2[i] = s2 ? voffA2[i] : voffA[i]; vB2[i] = s2 ? voffB2[i] : voffB[i]; }
            unsigned svo[2][2];
#pragma unroll
            for (int h = 0; h < 2; ++h)
#pragma unroll
                for (int i = 0; i < 2; ++i) svo[h][i] = last ? nvo[h][i] : cvo[h][i];
            if constexpr (SP2) {
            PG8_LDB(B0, 0, 0); PG8_LDB(B1, 0, 1); PG8_SCHED; PG8_LDA(At, 0, 0); PG8_STAGE_AX(PG8_SA(1, 1), a1, 1, cvo, hs1, vA1);
            PG8_WAIT_V(8); PG8_WAIT_L(0); PG8_BAR; PG8_MMA(0, 0, At, B0); PG8_MMA(0, 1, At, B1); PG8_BAR; PG8_SCHED;
            PG8_LDA(At, 0, 1); PG8_STAGE(PG8_SB(0, 0), b2, vB2); PG8_STAGE(PG8_SB(0, 1), b2 + hs2, vB2); PG8_STAGE_AX(PG8_SA(0, 0), a2, 0, svo, hs2, vA2);
            PG8_WAIT_V(8); PG8_WAIT_L(0); PG8_BAR; PG8_MMA(1, 0, At, B0); PG8_MMA(1, 1, At, B1); PG8_BAR; PG8_SCHED;
            PG8_LDB(B0, 1, 0); PG8_LDB(B1, 1, 1); PG8_SCHED; PG8_LDA(At, 1, 0); PG8_STAGE_AX(PG8_SA(0, 1), a2, 1, svo, hs2, vA2);
            PG8_WAIT_V(8); PG8_WAIT_L(0); PG8_BAR; PG8_MMA(0, 0, At, B0); PG8_MMA(0, 1, At, B1); PG8_BAR; PG8_SCHED;
            PG8_LDA(At, 1, 1); PG8_STAGE(PG8_SB(1, 0), b3, vB2); PG8_STAGE(PG8_SB(1, 1), b3 + hs2, vB2); PG8_STAGE_AX(PG8_SA(1, 0), a3, 0, svo, hs2, vA2);
            PG8_WAIT_V(8); PG8_WAIT_L(0); PG8_BAR; PG8_MMA(1, 0, At, B0); PG8_MMA(1, 1, At, B1); PG8_BAR; PG8_SCHED;
            } else {
            PG8_LDB(B0, 0, 0); PG8_SCHED; PG8_LDA(At, 0, 0); PG8_STAGE_AX(PG8_SA(1, 1), a1, 1, cvo, hs1, vA1);
            PG8_WAIT_L(8); PG8_BAR; PG8_WAIT_L(0); PG8_MMA(0, 0, At, B0); PG8_BAR; PG8_SCHED;
            PG8_LDB(B1, 0, 1); PG8_STAGE(PG8_SB(0, 0), b2, vB2);
            PG8_BAR; PG8_WAIT_L(0); PG8_MMA(0, 1, At, B1); PG8_BAR;
            PG8_LDA(At, 0, 1); PG8_STAGE_AX(PG8_SA(0, 0), a2, 0, svo, hs2, vA2);
            PG8_BAR; PG8_WAIT_L(0); PG8_MMA(1, 0, At, B0); PG8_BAR; PG8_SCHED;
            PG8_STAGE(PG8_SB(0, 1), b2 + hs2, vB2);
            PG8_WAIT_V(6); PG8_BAR; PG8_MMA(1, 1, At, B1); PG8_BAR;
            PG8_LDB(B0, 1, 0); PG8_SCHED; PG8_LDA(At, 1, 0); PG8_STAGE_AX(PG8_SA(0, 1), a2, 1, svo, hs2, vA2);
            PG8_WAIT_L(8); PG8_BAR; PG8_WAIT_L(0); PG8_MMA(0, 0, At, B0); PG8_BAR; PG8_SCHED;
            PG8_LDB(B1, 1, 1); PG8_STAGE(PG8_SB(1, 0), b3, vB2);
            PG8_BAR; PG8_WAIT_L(0); PG8_MMA(0, 1, At, B1); PG8_BAR;
            PG8_LDA(At, 1, 1); PG8_STAGE_AX(PG8_SA(1, 0), a3, 0, svo, hs2, vA2);
            PG8_BAR; PG8_WAIT_L(0); PG8_MMA(1, 0, At, B0); PG8_BAR; PG8_SCHED;
            PG8_STAGE(PG8_SB(1, 1), b3 + hs2, vB2);
            PG8_WAIT_V(6); PG8_BAR; PG8_MMA(1, 1, At, B1); PG8_BAR;
            }
            if constexpr (DUAL) { if (t + 2 == nt1) E.mid(acc, cur, wr, wc, fr, fq); }
        }
        if constexpr (ALIGN_EPI) { if (wr == 0) PG8_BAR; }
        E(acc, cur, wr, wc, fr, fq);
        if (!has_next) break;
#pragma unroll
        for (int a = 0; a < 2; ++a)
#pragma unroll
            for (int b = 0; b < 2; ++b)
#pragma unroll
                for (int m = 0; m < 4; ++m)
#pragma unroll
                    for (int n = 0; n < 2; ++n) acc[a][b][m][n] = (f32x4){0.f, 0.f, 0.f, 0.f};
        cur = nxt; cA = nA; cB = nB; ++ui;
#pragma unroll
        for (int h = 0; h < 2; ++h)
#pragma unroll
            for (int i = 0; i < 2; ++i) cvo[h][i] = nvo[h][i];
        if constexpr (ALIGN_EPI) { if (wr == 1) PG8_BAR; }
    }
    PG8_WAIT_V(0);
    if constexpr (!ALIGN_EPI) { if (wr == 0) PG8_BAR; }
    PG8_BAR;
#undef PG8_SA
#undef PG8_SB
#undef PG8_STAGE
#undef PG8_STAGE_A
#undef PG8_STAGE_AX
#undef PG8_LDA
#undef PG8_LDB
#undef PG8_MMA
#undef PG8_WAIT_V
#undef PG8_WAIT_L
#undef PG8_BAR
#undef PG8_SCHED
#undef PG8_GOFF
}
}

constexpr size_t MiB = 1u << 20;
constexpr size_t WS_CTL = 0, CTL_ZERO_BYTES = 1 * MiB;
constexpr size_t WS_HMETA = 1 * MiB;
constexpr size_t WS_UMETA = WS_HMETA + 128 * 1024;
constexpr size_t WS_KMETA = WS_HMETA + 256 * 1024;
constexpr size_t WS_VMETA = WS_HMETA + 384 * 1024;
constexpr size_t WS_SSMAB = WS_HMETA + 512 * 1024;
constexpr size_t WS_SSMBB = WS_HMETA + 576 * 1024;
constexpr size_t WS_WRT = 2 * MiB;
constexpr size_t WS_WIN = 3 * MiB;
constexpr size_t WS_WGLU = 33 * MiB;
constexpr size_t WS_WBS = 34 * MiB;
constexpr size_t WS_WBA = 36 * MiB;
constexpr size_t WS_WO = 40 * MiB;
constexpr size_t WS_WUP = 48 * MiB;
constexpr size_t WS_WDN = 176 * MiB;
constexpr size_t WS_HBF = 240 * MiB;
constexpr size_t WS_U = 368 * MiB;
constexpr size_t WS_Q = 400 * MiB;
constexpr size_t WS_K = 464 * MiB;
constexpr size_t WS_V = 528 * MiB;
constexpr size_t WS_SGS = 592 * MiB;
constexpr size_t WS_SGA = 720 * MiB;
constexpr size_t WS_YPRE = 848 * MiB;
constexpr size_t WS_YSSM = 880 * MiB;
constexpr size_t WS_YATT = 912 * MiB;
constexpr size_t WS_END = 976 * MiB;
constexpr size_t WS_Z = 368 * MiB;
constexpr size_t WS_H1 = 624 * MiB;
constexpr size_t WS_HB = 752 * MiB;
constexpr size_t WS_YK = 368 * MiB;
constexpr size_t WS_LIST = 848 * MiB;
constexpr size_t WS_WGT = 852 * MiB;
constexpr size_t WS_POSE = 853 * MiB;
constexpr size_t WS_POSW = 854 * MiB;
constexpr int CW_ECNT = 64;
constexpr int CW_CONV = 192;
constexpr int CW_BAR = 4096;

constexpr int RING_BYTES = 131072;
constexpr int MISC_OFF = RING_BYTES;
constexpr int LDS_BYTES = 139264;

#define XB_TMO      128
#define XB_XCNT(j)  (256  + 64 * (j))
#define XB_XSUB(j)  (1280 + 64 * (j))
#define XB_XGEN(j)  (2304 + 64 * (j))
#define XB_TOP      3328
#define XB_TOPGEN   3392
#define XCD_BAR_WORDS 3456
#define XB_SPIN_CAP (1u << 18)
__device__ __forceinline__ unsigned xb_ld(unsigned* p)              { return __hip_atomic_load(p, __ATOMIC_RELAXED, __HIP_MEMORY_SCOPE_AGENT); }
__device__ __forceinline__ unsigned xb_add(unsigned* p, unsigned v) { return __hip_atomic_fetch_add(p, v, __ATOMIC_RELAXED, __HIP_MEMORY_SCOPE_AGENT); }
__device__ __forceinline__ unsigned xb_xcc_id() { return (unsigned)__builtin_amdgcn_s_getreg((3 << 11) | 20) & 0xFu; }
#define XB_SPIN(cond, bar) do { unsigned _sp = 0; while (cond) { __builtin_amdgcn_s_sleep(1); \
    if ((++_sp & 255u) == 0u) { if (xb_ld(&(bar)[XB_TMO])) break; if (_sp > XB_SPIN_CAP) { atomicAdd(&(bar)[XB_TMO], 1u); break; } } } } while (0)
struct XcdBarrier { unsigned* bar; unsigned x; volatile LAS unsigned* st; };
__device__ __forceinline__ XcdBarrier xcd_barrier_post(unsigned* bar, volatile LAS unsigned* st) {
    XcdBarrier b; b.bar = bar; b.x = xb_xcc_id(); b.st = st;
    if (threadIdx.x == 0) (void)xb_add(&bar[XB_XCNT(b.x)], 1u);
    return b;
}
__device__ __forceinline__ void xcd_barrier_complete(unsigned* bar, unsigned x, unsigned& nloc, unsigned& nx) {
    const unsigned G = gridDim.x * gridDim.y * gridDim.z;
    unsigned sum, cnt, mine, sp = 0u;
    for (;;) {
        sum = 0u; cnt = 0u; mine = 0u;
#pragma unroll
        for (unsigned j = 0; j < 16; ++j) { const unsigned c = xb_ld(&bar[XB_XCNT(j)]); sum += c; cnt += (c > 0u) ? 1u : 0u; mine = (j == x) ? c : mine; }
        if (sum == G) break;
        __builtin_amdgcn_s_sleep(1);
        if ((++sp & 255u) == 0u) { if (xb_ld(&bar[XB_TMO])) break; if (sp > XB_SPIN_CAP) { atomicAdd(&bar[XB_TMO], 1u); break; } }
    }
    nloc = mine > 0u ? mine : 1u; nx = cnt > 0u ? cnt : 1u;
}
__device__ __forceinline__ void xcd_barrier(const XcdBarrier& b) {
    asm volatile("s_waitcnt vmcnt(0)" ::: "memory");
    __syncthreads();
    if (threadIdx.x == 0) {
        unsigned* bar = b.bar;
        __builtin_amdgcn_s_waitcnt(0);
        unsigned nloc = b.st[0], nx = b.st[1];
        if (nloc == 0u) { xcd_barrier_complete(bar, b.x, nloc, nx); b.st[0] = nloc; b.st[1] = nx; }
        const unsigned old = xb_add(&bar[XB_XSUB(b.x)], 1u);
        const unsigned gen = old / nloc;
        if (old + 1u == (gen + 1u) * nloc) {
            __builtin_amdgcn_fence(__ATOMIC_RELEASE, "agent");
            asm volatile("s_waitcnt vmcnt(0)" ::: "memory");
            const unsigned og = xb_add(&bar[XB_TOP], 1u);
            const unsigned tg = og / nx;
            if (og + 1u == (tg + 1u) * nx) xb_add(&bar[XB_TOPGEN], 1u);
            else XB_SPIN(xb_ld(&bar[XB_TOPGEN]) == tg, bar);
            __builtin_amdgcn_fence(__ATOMIC_ACQUIRE, "agent");
            xb_add(&bar[XB_XGEN(b.x)], 1u);
            asm volatile("s_waitcnt vmcnt(0)" ::: "memory");
        } else {
            XB_SPIN(xb_ld(&bar[XB_XGEN(b.x)]) == gen, bar);
            __builtin_amdgcn_fence(__ATOMIC_ACQUIRE, "agent");
            asm volatile("s_waitcnt vmcnt(0)" ::: "memory");
        }
    }
    __syncthreads();
}

using pg8::Unit;
__device__ __forceinline__ u32x4 pack8(const f32x4 v0, const f32x4 v1) { u32x4 w; w.x = cvt_pk_bf16(v0[0], v0[1]); w.y = cvt_pk_bf16(v0[2], v0[3]); w.z = cvt_pk_bf16(v1[0], v1[1]); w.w = cvt_pk_bf16(v1[2], v1[3]); return w; }
__device__ __forceinline__ void unpack8(const u32x4 w, f32x4& v0, f32x4& v1) { v0 = (f32x4){bf_lo(w.x), bf_hi(w.x), bf_lo(w.y), bf_hi(w.y)}; v1 = (f32x4){bf_lo(w.z), bf_hi(w.z), bf_lo(w.w), bf_hi(w.w)}; }

struct EpiProj {
    static constexpr bool PERM = true;
    bf16_t *U, *Q, *K, *V, *RHO, *SGA;
    __device__ __forceinline__ void operator()(const f32x4 (&acc)[2][2][4][2], const Unit& u, int wr, int wc, int fr, int fq) const {
        const int pn = u.pn;
        if (pn >= 14) {
            const int row0 = u.pm * 256 + wr * 64 + fr, col0 = (pn - 14) * 128 + wc * 32 + 8 * fq;
#pragma unroll
            for (int ai = 0; ai < 2; ++ai)
#pragma unroll
                for (int m = 0; m < 4; ++m) { const size_t off = (size_t)(row0 + ai * 128 + m * 16) * DM + col0; f32x4 r0, r1, a0, a1;
#pragma unroll
                    for (int j = 0; j < 4; ++j) { const float es0 = __expf(-acc[ai][0][m][0][j]), es1 = __expf(-acc[ai][0][m][1][j]), ea0 = __expf(-acc[ai][1][m][0][j]), ea1 = __expf(-acc[ai][1][m][1][j]);
                        a0[j] = __builtin_amdgcn_rcpf(1.f + ea0); a1[j] = __builtin_amdgcn_rcpf(1.f + ea1);
                        r0[j] = (1.f + ea0) * __builtin_amdgcn_rcpf(1.f + es0); r1[j] = (1.f + ea1) * __builtin_amdgcn_rcpf(1.f + es1); }
                    *(u32x4*)(RHO + off) = pack8(r0, r1); *(u32x4*)(SGA + off) = pack8(a0, a1); }
            return;
        }
        bf16_t* base; int ldc, ct, mode;
        if (pn < 2) { base = U; ldc = 512; ct = pn; mode = 0; }
        else if (pn < 6) { base = Q; ldc = 1024; ct = pn - 2; mode = 1; }
        else if (pn < 10) { base = K; ldc = 1024; ct = pn - 6; mode = 0; }
        else { base = V; ldc = 1024; ct = pn - 10; mode = 0; }
        const int row0 = u.pm * 256 + wr * 64 + fr, col0 = ct * 256 + wc * 32 + 8 * fq;
#pragma unroll
        for (int ai = 0; ai < 2; ++ai)
#pragma unroll
            for (int m = 0; m < 4; ++m) { bf16_t* rowp = base + (size_t)(row0 + ai * 128 + m * 16) * ldc + col0;
#pragma unroll
                for (int bj = 0; bj < 2; ++bj) { f32x4 v0 = acc[ai][bj][m][0], v1 = acc[ai][bj][m][1];
                    if (mode == 1) { v0 = v0 * QSCALE; v1 = v1 * QSCALE; }
                    *(u32x4*)(rowp + bj * 128) = pack8(v0, v1); } }
    }
};
struct EpiGlu {
    static constexpr bool PERM = true;
    const bf16_t* YPRE; bf16_t* YSSM;
    __device__ __forceinline__ void operator()(const f32x4 (&acc)[2][2][4][2], const Unit& u, int wr, int wc, int fr, int fq) const {
        const int row0 = u.pm * 256 + wr * 64 + fr, col0 = u.pn * 256 + wc * 32 + 8 * fq;
#pragma unroll
        for (int ai = 0; ai < 2; ++ai)
#pragma unroll
            for (int m = 0; m < 4; ++m) { const size_t off = (size_t)(row0 + ai * 128 + m * 16) * SSMW + col0;
#pragma unroll
                for (int bj = 0; bj < 2; ++bj) { const u32x4 yw = *(const u32x4*)(YPRE + off + bj * 128); f32x4 y0, y1; unpack8(yw, y0, y1);
                    f32x4 v0 = acc[ai][bj][m][0], v1 = acc[ai][bj][m][1];
#pragma unroll
                    for (int j = 0; j < 4; ++j) { v0[j] = y0[j] * sigmoidf_(v0[j]); v1[j] = y1[j] * sigmoidf_(v1[j]); }
                    *(u32x4*)(YSSM + off + bj * 128) = pack8(v0, v1); } }
    }
};
template <int SECOND> struct EpiMerge {
    static constexpr bool PERM = true;
    const bf16_t* SG; bf16_t* MG;
    __device__ __forceinline__ void operator()(const f32x4 (&acc)[2][2][4][2], const Unit& u, int wr, int wc, int fr, int fq) const {
        const int row0 = u.pm * 256 + wr * 64 + fr, col0 = u.pn * 256 + wc * 32 + 8 * fq;
#pragma unroll
        for (int ai = 0; ai < 2; ++ai)
#pragma unroll
            for (int m = 0; m < 4; ++m) { const size_t off = (size_t)(row0 + ai * 128 + m * 16) * DM + col0;
#pragma unroll
                for (int bj = 0; bj < 2; ++bj) { const u32x4 gw = *(const u32x4*)(SG + off + bj * 128); f32x4 g0, g1; unpack8(gw, g0, g1);
                    f32x4 v0 = acc[ai][bj][m][0] * g0, v1 = acc[ai][bj][m][1] * g1;
                    if (SECOND) { const u32x4 pw = *(const u32x4*)(MG + off + bj * 128); f32x4 p0, p1; unpack8(pw, p0, p1); v0 = v0 + p0; v1 = v1 + p1; }
                    *(u32x4*)(MG + off + bj * 128) = pack8(v0, v1); } }
    }
};
struct EpiMergeF {
    static constexpr bool PERM = true;
    const bf16_t* SGS; const bf16_t* SGA; bf16_t* MG;
    __device__ __forceinline__ void mid(f32x4 (&acc)[2][2][4][2], const Unit& u, int wr, int wc, int fr, int fq) const {
        asm volatile("" : "+v"(fr), "+v"(fq));
        const int row0 = u.pm * 256 + wr * 64 + fr, col0 = u.pn * 256 + wc * 32 + 8 * fq;
        const bf16_t* sp = SGS + (size_t)row0 * DM + col0;
        u32x4 sw[2][2];
        sw[0][0] = *(const u32x4*)(sp); sw[0][1] = *(const u32x4*)(sp + 128);
#pragma unroll
        for (int g = 0; g < 8; ++g) { const int ai = g >> 2, m = g & 3;
            if (g < 7) { const int g1 = g + 1; const bf16_t* sq = sp + (size_t)((g1 >> 2) * 128 + (g1 & 3) * 16) * DM;
                sw[g1 & 1][0] = *(const u32x4*)(sq); sw[g1 & 1][1] = *(const u32x4*)(sq + 128); }
            asm volatile("" ::: "memory");
#pragma unroll
            for (int bj = 0; bj < 2; ++bj) { f32x4 s0, s1; unpack8(sw[g & 1][bj], s0, s1);
                acc[ai][bj][m][0] = acc[ai][bj][m][0] * s0; acc[ai][bj][m][1] = acc[ai][bj][m][1] * s1; }
        }
    }
    __device__ __forceinline__ void operator()(const f32x4 (&acc)[2][2][4][2], const Unit& u, int wr, int wc, int fr, int fq) const {
        const int row0 = u.pm * 256 + wr * 64 + fr, col0 = u.pn * 256 + wc * 32 + 8 * fq;
#pragma unroll
        for (int ai = 0; ai < 2; ++ai)
#pragma unroll
            for (int m = 0; m < 4; ++m) { const size_t off = (size_t)(row0 + ai * 128 + m * 16) * DM + col0;
#pragma unroll
                for (int bj = 0; bj < 2; ++bj) { const u32x4 gw = *(const u32x4*)(SGA + off + bj * 128); f32x4 g0, g1; unpack8(gw, g0, g1);
                    *(u32x4*)(MG + off + bj * 128) = pack8(acc[ai][bj][m][0] * g0, acc[ai][bj][m][1] * g1); } }
    }
};
struct EpiZ {
    static constexpr bool PERM = true;
    const bf16_t* HBF; bf16_t* Z;
    __device__ __forceinline__ void operator()(const f32x4 (&acc)[2][2][4][2], const Unit& u, int wr, int wc, int fr, int fq) const {
        const int row0 = u.pm * 256 + wr * 64 + fr, col0 = u.pn * 256 + wc * 32 + 8 * fq;
#pragma unroll
        for (int ai = 0; ai < 2; ++ai)
#pragma unroll
            for (int m = 0; m < 4; ++m) { const size_t off = (size_t)(row0 + ai * 128 + m * 16) * DM + col0;
#pragma unroll
                for (int bj = 0; bj < 2; ++bj) { const u32x4 hw = *(const u32x4*)(HBF + off + bj * 128); f32x4 h0, h1; unpack8(hw, h0, h1);
                    *(u32x4*)(Z + off + bj * 128) = pack8(acc[ai][bj][m][0] + h0 * ALPHA, acc[ai][bj][m][1] + h1 * ALPHA); } }
    }
};
struct EpiSwiglu {
    static constexpr bool PERM = true;
    bf16_t* HB; const int* LIST; const float* WGT; int* POSE; float* POSW;
    __device__ __forceinline__ void operator()(const f32x4 (&acc)[2][2][4][2], const Unit& u, int wr, int wc, int fr, int fq) const {
        const int row0 = u.pm * 256 + wr * 64 + fr, col0 = (u.pn & 3) * 128 + wc * 32 + 8 * fq;
#pragma unroll
        for (int ai = 0; ai < 2; ++ai)
#pragma unroll
            for (int m = 0; m < 4; ++m) { f32x4 v0, v1;
#pragma unroll
                for (int j = 0; j < 4; ++j) { const float g0 = acc[ai][0][m][0][j], g1 = acc[ai][0][m][1][j];
                    v0[j] = g0 * sigmoidf_(g0) * acc[ai][1][m][0][j]; v1[j] = g1 * sigmoidf_(g1) * acc[ai][1][m][1][j]; }
                *(u32x4*)(HB + (size_t)(row0 + ai * 128 + m * 16) * DFF + col0) = pack8(v0, v1); }
        if ((u.pn & 3) == 0 && wc == 0 && fq == 0) {
#pragma unroll
            for (int ai = 0; ai < 2; ++ai)
#pragma unroll
                for (int m = 0; m < 4; ++m) { const int r = wr * 64 + fr + ai * 128 + m * 16, slot = u.s0 + r; int entry = -1; float w = 0.f;
                    if (slot < u.cnt) { entry = LIST[(size_t)u.e * CAP + slot]; w = WGT[entry]; }
                    POSE[u.pm * 256 + r] = entry; POSW[u.pm * 256 + r] = w; }
        }
    }
};
struct EpiDown {
    static constexpr bool PERM = true;
    const int* POSE; const float* POSW; bf16_t* YK;
    __device__ __forceinline__ void operator()(const f32x4 (&acc)[2][2][4][2], const Unit& u, int wr, int wc, int fr, int fq) const {
        const int r0 = u.pm * 256 + wr * 64 + fr, col0 = (u.pn & 7) * 256 + wc * 32 + 8 * fq;
        int en[2][4]; float ww[2][4];
#pragma unroll
        for (int ai = 0; ai < 2; ++ai)
#pragma unroll
            for (int m = 0; m < 4; ++m) { en[ai][m] = POSE[r0 + ai * 128 + m * 16]; ww[ai][m] = POSW[r0 + ai * 128 + m * 16]; }
#pragma unroll
        for (int ai = 0; ai < 2; ++ai)
#pragma unroll
            for (int m = 0; m < 4; ++m) {
                if (en[ai][m] >= 0) { const float w = ww[ai][m]; bf16_t* rowp = YK + (size_t)en[ai][m] * DM + col0;
#pragma unroll
                    for (int bj = 0; bj < 2; ++bj) *(u32x4*)(rowp + bj * 128) = pack8(acc[ai][bj][m][0] * w, acc[ai][bj][m][1] * w); } }
    }
};
struct MoeOrder {
    int G, c, shift, NB; const LAS int* blkexp; const LAS int* blkstart; const LAS int* cntE; const int* LIST;
    __device__ __forceinline__ bool next(int i, Unit& u) const {
        const long L = (long)i * G + c; if (L >= ((long)NB << shift)) return false;
        const int blk = (int)(L >> shift), tile = (int)(L & ((1 << shift) - 1)), e = blkexp[blk];
        u.pm = blk; u.pn = (e << shift) + tile; u.e = e; u.s0 = (blk - blkstart[e]) * 256; u.cnt = cntE[e]; return true;
    }
    __device__ __forceinline__ int arow(const Unit& u, int r) const { const int slot = u.s0 + r; const int entry = slot < u.cnt ? LIST[(size_t)u.e * CAP + slot] : 0; return entry >> 1; }
};

struct Ctx { LAS unsigned char* lds; int tid, lane, wave, vcu, G; };

__device__ __forceinline__ void transpose_item(const float* W, int K, int N, bf16_t* WT, int kb, int nb, int dst_row0, LAS float* scr, int lane) {
    const int k0 = 64 * kb, n0 = 32 * nb;
    float tv[32];
#pragma unroll
    for (int i = 0; i < 32; ++i) tv[i] = W[(size_t)(k0 + 2 * i + (lane >> 5)) * N + n0 + (lane & 31)];
#pragma unroll
    for (int i = 0; i < 32; ++i) scr[(2 * i + (lane >> 5)) * 33 + (lane & 31)] = tv[i];
    asm volatile("s_waitcnt lgkmcnt(0)" ::: "memory");
    const int c = lane & 7;
#pragma unroll
    for (int j = 0; j < 4; ++j) { const int n = (lane >> 3) + 8 * j; const LAS float* s = scr + (8 * c) * 33 + n;
        u32x4 o; o.x = cvt_pk_bf16(s[0 * 33], s[1 * 33]); o.y = cvt_pk_bf16(s[2 * 33], s[3 * 33]); o.z = cvt_pk_bf16(s[4 * 33], s[5 * 33]); o.w = cvt_pk_bf16(s[6 * 33], s[7 * 33]);
        *(u32x4*)(WT + (size_t)(dst_row0 + n) * K + k0 + 8 * c) = o; }
    asm volatile("s_waitcnt lgkmcnt(0)" ::: "memory");
}
__device__ __forceinline__ void ln_stats(f32x4 (&v)[8], float& mean, float& rstd) {
    float s = 0.f;
#pragma unroll
    for (int j = 0; j < 8; ++j) s += (v[j].x + v[j].y) + (v[j].z + v[j].w);
    mean = wave_sum(s) * (1.f / DM); float s2 = 0.f;
#pragma unroll
    for (int j = 0; j < 8; ++j) { const f32x4 d = v[j] - mean; s2 += (d.x * d.x + d.y * d.y) + (d.z * d.z + d.w * d.w); }
    rstd = 1.f / sqrtf(wave_sum(s2) * (1.f / DM) + LN_EPS);
}

__device__ __forceinline__ void p0_prologue(const Ctx& C, const float* const* in, unsigned char* ws) {
    LAS float* scr = (LAS float*)(C.lds + C.wave * 16384);
    const int gw = C.vcu * 8 + C.wave, NGW = C.G * 8;
    bf16_t* WinT = (bf16_t*)(ws + WS_WIN); bf16_t* WgluT = (bf16_t*)(ws + WS_WGLU); bf16_t* WbsT = (bf16_t*)(ws + WS_WBS); bf16_t* WbaT = (bf16_t*)(ws + WS_WBA);
    bf16_t* WoT = (bf16_t*)(ws + WS_WO); bf16_t* WupT = (bf16_t*)(ws + WS_WUP);
    constexpr int I_WIN = (DM / 64) * (INC / 32), I_GLU = (SSMW / 64) * (SSMW / 32), I_BS = (SSMW / 64) * (DM / 32), I_BA = (AW / 64) * (DM / 32), I_WO = (DM / 64) * (DM / 32);
    constexpr int I_EXP = NE * 512;
    constexpr int NITEMS = I_WIN + I_GLU + I_BS + I_BA + I_WO + 2 * I_EXP;
    for (int it = gw; it < NITEMS; it += NGW) {
        int r = it;
        if (r < I_WIN) { const int nblk = INC / 32, nb = r % nblk, n0 = 32 * nb;
            const int drow = n0 < 3584 ? n0 : (n0 < 5632 ? 3584 + ((n0 - 3584) >> 7) * 256 + ((n0 - 3584) & 127) : 3584 + ((n0 - 5632) >> 7) * 256 + 128 + ((n0 - 5632) & 127));
            transpose_item(in[4], DM, INC, WinT, r / nblk, nb, drow, scr, C.lane); continue; } r -= I_WIN;
        if (r < I_GLU) { const int nblk = SSMW / 32; transpose_item(in[13], SSMW, SSMW, WgluT, r / nblk, r % nblk, 32 * (r % nblk), scr, C.lane); continue; } r -= I_GLU;
        if (r < I_BS) { const int nblk = DM / 32; transpose_item(in[19], SSMW, DM, WbsT, r / nblk, r % nblk, 32 * (r % nblk), scr, C.lane); continue; } r -= I_BS;
        if (r < I_BA) { const int nblk = DM / 32; transpose_item(in[20], AW, DM, WbaT, r / nblk, r % nblk, 32 * (r % nblk), scr, C.lane); continue; } r -= I_BA;
        if (r < I_WO) { const int nblk = DM / 32; transpose_item(in[21], DM, DM, WoT, r / nblk, r % nblk, 32 * (r % nblk), scr, C.lane); continue; } r -= I_WO;
        if (r < 2 * I_EXP) { const int up = r >= I_EXP ? 1 : 0; r -= up * I_EXP; const int e = r >> 9, rr = r & 511, kb = rr >> 4, nb = rr & 15, n0 = 32 * nb;
            transpose_item(in[28 + up] + (size_t)e * DM * DFF, DM, DFF, WupT, kb, nb, e * 1024 + (n0 >> 7) * 256 + up * 128 + (n0 & 127), scr, C.lane); continue; }
    }
    const int gt = C.vcu * 512 + C.tid, NGT = C.G * 512;
    { float* WrT = (float*)(ws + WS_WRT);
      for (int i = gt; i < 36 * DM; i += NGT) { const int n = i / DM, k = i % DM; WrT[i] = n < 4 ? in[24][k * 4 + n] : in[26][k * 32 + (n - 4)]; } }
    { u32x4* kz = (u32x4*)(ws + WS_KMETA + 16 * 1024 * 2); u32x4* vz = (u32x4*)(ws + WS_VMETA + 16 * 1024 * 2);
      for (int i = gt; i < 48 * 1024 * 2 / 16; i += NGT) { kz[i] = (u32x4){0u, 0u, 0u, 0u}; vz[i] = (u32x4){0u, 0u, 0u, 0u}; } }
    { float* AB = (float*)(ws + WS_SSMAB); float* BB = (float*)(ws + WS_SSMBB);
      for (int i = gt; i < NGRP * NST; i += NGT) { const int g = i >> 6;
        const double lre = fmin((double)in[5][i], -1e-4), lim = (double)in[6][i], dt = exp((double)in[7][g]);
        const double mag = exp(lre * dt), abr = mag * cos(lim * dt), abi = mag * sin(lim * dt), den = lre * lre + lim * lim, nr = abr - 1.0, ni = abi;
        const double zr = (nr * lre + ni * lim) / den, zi = (ni * lre - nr * lim) / den;
        AB[i] = (float)abr; AB[NGRP * NST + i] = (float)abi;
#pragma unroll 4
        for (int c = 0; c < 16; ++c) { const double br = (double)in[8][i * 16 + c], bi = (double)in[9][i * 16 + c];
            BB[i * 16 + c] = (float)(zr * br - zi * bi); BB[NGRP * NST * 16 + i * 16 + c] = (float)(zr * bi + zi * br); } } }
    const float* lg = in[2]; const float* lb = in[3];
    bf16_t* HBF = (bf16_t*)(ws + WS_HBF);
    for (int m = gw; m < T + NMETA; m += 2 * NGW) {
        const int m2 = (m + NGW < T + NMETA) ? m + NGW : m;
        const float* xa = m >= T ? in[1] + (size_t)(m - T) * DM : in[0] + (size_t)m * DM; const float* xb = m2 >= T ? in[1] + (size_t)(m2 - T) * DM : in[0] + (size_t)m2 * DM;
        f32x4 va[8], vb[8];
#pragma unroll
        for (int j = 0; j < 8; ++j) { va[j] = *(const f32x4*)(xa + 256 * j + 4 * C.lane); vb[j] = *(const f32x4*)(xb + 256 * j + 4 * C.lane); }
        float meana, rstda, meanb, rstdb; ln_stats(va, meana, rstda); ln_stats(vb, meanb, rstdb);
#pragma unroll
        for (int rr = 0; rr < 2; ++rr) { const int mm = rr ? m2 : m; if (rr == 1 && m2 == m) break; const bool meta = mm >= T;
#pragma unroll
            for (int j = 0; j < 8; ++j) { const f32x4 gg = *(const f32x4*)(lg + 256 * j + 4 * C.lane), bb = *(const f32x4*)(lb + 256 * j + 4 * C.lane);
                const f32x4 o = rr ? (vb[j] - meanb) * rstdb * gg + bb : (va[j] - meana) * rstda * gg + bb;
                if (meta) *(f32x4*)((float*)(ws + WS_HMETA) + (size_t)(mm - T) * DM + 256 * j + 4 * C.lane) = o;
                else { u32x2 w; w.x = cvt_pk_bf16(o.x, o.y); w.y = cvt_pk_bf16(o.z, o.w); *(u32x2*)(HBF + (size_t)mm * DM + 256 * j + 4 * C.lane) = w; } } }
    }
}

__device__ __forceinline__ void p1_meta_proj(const Ctx& C, unsigned char* ws) {
    const bf16_t* WinT = (const bf16_t*)(ws + WS_WIN); const float* HM = (const float*)(ws + WS_HMETA);
    const int gw = C.vcu * 8 + C.wave, NGW = C.G * 8;
    for (int it = gw; it < 640; it += NGW) {
        const int nidx = 4 * it; const int col0 = nidx < 512 ? nidx : (nidx < 1536 ? 1536 + (nidx - 512) : 2560 + (nidx - 1536));
        float acc[16][4];
#pragma unroll
        for (int r = 0; r < 16; ++r)
#pragma unroll
            for (int c = 0; c < 4; ++c) acc[r][c] = 0.f;
#pragma unroll 1
        for (int j = 0; j < 4; ++j) { const int k0 = j * 512 + C.lane * 8;
            f32x4 w0[4], w1[4];
#pragma unroll
            for (int c = 0; c < 4; ++c) { const u32x4 ww = *(const u32x4*)(WinT + (size_t)(col0 + c) * DM + k0); unpack8(ww, w0[c], w1[c]); }
#pragma unroll
            for (int r = 0; r < 16; ++r) { const f32x4 h0 = *(const f32x4*)(HM + r * DM + k0), h1 = *(const f32x4*)(HM + r * DM + k0 + 4);
#pragma unroll
                for (int c = 0; c < 4; ++c) { const f32x4 p = h0 * w0[c] + h1 * w1[c]; acc[r][c] += (p.x + p.y) + (p.z + p.w); } } }
        float mine = 0.f;
#pragma unroll
        for (int r = 0; r < 16; ++r)
#pragma unroll
            for (int c = 0; c < 4; ++c) { const float s = wave_sum(acc[r][c]); mine = (C.lane == r * 4 + c) ? s : mine; }
        const int r = C.lane >> 2, c = C.lane & 3;
        if (nidx < 512) ((float*)(ws + WS_UMETA))[r * SSMW + nidx + c] = mine;
        else if (nidx < 1536) ((bf16_t*)(ws + WS_KMETA))[r * AW + (nidx - 512) + c] = (bf16_t)(cvt_pk_bf16(mine, 0.f) & 0xffffu);
        else ((bf16_t*)(ws + WS_VMETA))[r * AW + (nidx - 1536) + c] = (bf16_t)(cvt_pk_bf16(mine, 0.f) & 0xffffu);
    }
}

__device__ __forceinline__ float gelu_tanh(float x) { const float u = 1.5957691216057308f * (x + 0.044715f * x * x * x); return x * __builtin_amdgcn_rcpf(1.0f + __expf(-u)); }
template <bool STORE> __device__ __forceinline__ void scan16(f32x16 (&bu)[4], float (&sre)[2], float (&sim)[2], const float (&are)[2], const float (&aim)[2]) {
#pragma unroll
    for (int reg = 0; reg < 16; ++reg)
#pragma unroll
        for (int st = 0; st < 2; ++st) {
            const float nre = __builtin_fmaf(are[st], sre[st], __builtin_fmaf(-aim[st], sim[st], bu[st][reg]));
            const float nim = __builtin_fmaf(are[st], sim[st], __builtin_fmaf(aim[st], sre[st], bu[2 + st][reg]));
            sre[st] = nre; sim[st] = nim;
            if (STORE) { bu[st][reg] = nre; bu[2 + st][reg] = nim; } }
}
__device__ __forceinline__ void p2_scan(const Ctx& C, const float* const* in, unsigned char* ws) {
    const int lane = C.lane, wave = C.wave, r32 = lane & 31, hi = lane >> 5, fr = lane & 15, fq = lane >> 4;
    const bf16_t* U = (const bf16_t*)(ws + WS_U); const float* UM = (const float*)(ws + WS_UMETA); bf16_t* YPRE = (bf16_t*)(ws + WS_YPRE);
    const float* AB = (const float*)(ws + WS_SSMAB); const float* BB = (const float*)(ws + WS_SSMBB);
    LAS unsigned char* Sl = C.lds + wave * 10752;
    LAS unsigned char* Yl = Sl + 9728;
    LAS float* E = (LAS float*)(C.lds + 86016);
    const int hc = 2 * wave + hi;
    const int urow = ((r32 >> 2) & 1) * 128 + (r32 & 3) + 4 * (r32 >> 3);
    for (int item = C.vcu; item < NB_ * NGRP; item += C.G) {
        const int b = item >> 5, g = item & 31;
        const bf16_t* Ub = U + ((size_t)b * SEQ + wave * 256) * SSMW + 16 * g;
        bf16x8 ufa[8];
#pragma unroll
        for (int blk = 0; blk < 8; ++blk) ufa[blk] = *(const bf16x8*)(Ub + (size_t)(16 * blk + urow) * SSMW + 8 * hi);
        float are[2], aim[2];
#pragma unroll
        for (int st = 0; st < 2; ++st) { are[st] = AB[g * 64 + 32 * st + r32]; aim[st] = AB[NGRP * NST + g * 64 + 32 * st + r32]; }
        bf16x8 Bf[4];
#pragma unroll
        for (int ri = 0; ri < 2; ++ri)
#pragma unroll
            for (int st = 0; st < 2; ++st) { const float* src = BB + ri * (NGRP * NST * 16) + (g * 64 + 32 * st + r32) * 16 + 8 * hi;
                const f32x4 x0 = *(const f32x4*)src, x1 = *(const f32x4*)(src + 4); Bf[2 * ri + st] = __builtin_bit_cast(bf16x8, pack8(x0, x1)); }
        bf16x8 Cf[5];
#pragma unroll
        for (int ks = 0; ks < 4; ++ks) { const int r0 = 8 * ks + 2 * fq; const float* cre = in[10] + (g * 16 + fr) * 64; const float* cim = in[11] + (g * 16 + fr) * 64;
            const f32x4 x0 = (f32x4){cre[r0], cre[32 + r0], -cim[r0], -cim[32 + r0]}, x1 = (f32x4){cre[r0 + 1], cre[33 + r0], -cim[r0 + 1], -cim[33 + r0]};
            Cf[ks] = __builtin_bit_cast(bf16x8, pack8(x0, x1)); }
        { const float dsk = in[12][g * 16 + fr]; f32x4 x0, x1;
#pragma unroll
          for (int j = 0; j < 4; ++j) { x0[j] = (fq < 2 && 8 * fq + j == fr) ? dsk : 0.f; x1[j] = (fq < 2 && 8 * fq + 4 + j == fr) ? dsk : 0.f; }
          Cf[4] = __builtin_bit_cast(bf16x8, pack8(x0, x1)); }
        float sre[2] = {0.f, 0.f}, sim[2] = {0.f, 0.f}, mre[2] = {0.f, 0.f}, mim[2] = {0.f, 0.f};
        if (wave == 0) {
            f32x4 x0 = (f32x4){0.f, 0.f, 0.f, 0.f}, x1 = x0;
            if (((r32 >> 2) & 1) == 0) { const float* src = UM + ((r32 & 3) + 4 * (r32 >> 3)) * SSMW + 16 * g + 8 * hi; x0 = *(const f32x4*)src; x1 = *(const f32x4*)(src + 4); }
            const bf16x8 uf = __builtin_bit_cast(bf16x8, pack8(x0, x1));
            f32x16 bu[4];
#pragma unroll
            for (int t = 0; t < 4; ++t) bu[t] = __builtin_amdgcn_mfma_f32_32x32x16_bf16(uf, Bf[t], (f32x16){}, 0, 0, 0);
            scan16<false>(bu, sre, sim, are, aim);
            mre[0] = sre[0]; mre[1] = sre[1]; mim[0] = sim[0]; mim[1] = sim[1];
        }
#pragma unroll
        for (int blk = 0; blk < 8; ++blk) {
            f32x16 bu[4];
#pragma unroll
            for (int t = 0; t < 4; ++t) bu[t] = __builtin_amdgcn_mfma_f32_32x32x16_bf16(ufa[blk], Bf[t], (f32x16){}, 0, 0, 0);
            scan16<false>(bu, sre, sim, are, aim);
        }
#pragma unroll
        for (int st = 0; st < 2; ++st) { E[hc * 128 + st * 64 + r32] = sre[st]; E[hc * 128 + st * 64 + 32 + r32] = sim[st]; }
        __syncthreads();
        {
            float pr[2], pi[2], cr[2], ci[2];
#pragma unroll
            for (int st = 0; st < 2; ++st) { pr[st] = are[st]; pi[st] = aim[st];
#pragma unroll
                for (int k = 0; k < 7; ++k) { const float nr = pr[st] * pr[st] - pi[st] * pi[st], ni = 2.f * pr[st] * pi[st]; pr[st] = nr; pi[st] = ni; }
                cr[st] = E[st * 64 + r32]; ci[st] = E[st * 64 + 32 + r32]; }
            for (int j = 1; j < 2 * wave + 1; ++j) {
                const bool on = j < hc;
#pragma unroll
                for (int st = 0; st < 2; ++st) { const float er = E[j * 128 + st * 64 + r32], ei = E[j * 128 + st * 64 + 32 + r32];
                    const float nr = pr[st] * cr[st] - pi[st] * ci[st] + er, ni = pr[st] * ci[st] + pi[st] * cr[st] + ei; cr[st] = on ? nr : cr[st]; ci[st] = on ? ni : ci[st]; } }
#pragma unroll
            for (int st = 0; st < 2; ++st) { sre[st] = hc == 0 ? mre[st] : cr[st]; sim[st] = hc == 0 ? mim[st] : ci[st]; }
        }
#pragma unroll
        for (int blk = 0; blk < 8; ++blk) {
            f32x16 bu[4];
#pragma unroll
            for (int t = 0; t < 4; ++t) bu[t] = __builtin_amdgcn_mfma_f32_32x32x16_bf16(ufa[blk], Bf[t], (f32x16){}, 0, 0, 0);
            scan16<true>(bu, sre, sim, are, aim);
#pragma unroll
            for (int reg = 0; reg < 16; ++reg) { const int row = (reg & 3) + 8 * (reg >> 2) + 4 * hi;
                u32x2 w; w.x = cvt_pk_bf16(bu[0][reg], bu[1][reg]); w.y = cvt_pk_bf16(bu[2][reg], bu[3][reg]);
                *(LAS u32x2*)(Sl + row * 304 + r32 * 8) = w; }
            *(LAS bf16x8*)(Sl + r32 * 304 + (128 + 8 * hi) * 2) = ufa[blk];
            f32x4 y[2];
#pragma unroll
            for (int mt = 0; mt < 2; ++mt) { y[mt] = (f32x4){0.f, 0.f, 0.f, 0.f};
#pragma unroll
                for (int ks = 0; ks < 4; ++ks) { const bf16x8 af = *(const LAS bf16x8*)(Sl + (16 * mt + fr) * 304 + (32 * ks + 8 * fq) * 2);
                    y[mt] = __builtin_amdgcn_mfma_f32_16x16x32_bf16(af, Cf[ks], y[mt], 0, 0, 0); }
                bf16x8 au = *(const LAS bf16x8*)(Sl + (16 * mt + fr) * 304 + (128 + 8 * (fq & 1)) * 2); if (fq >= 2) au = (bf16x8){};
                y[mt] = __builtin_amdgcn_mfma_f32_16x16x32_bf16(au, Cf[4], y[mt], 0, 0, 0); }
#pragma unroll
            for (int mt = 0; mt < 2; ++mt)
#pragma unroll
                for (int reg = 0; reg < 4; ++reg) *(LAS bf16_t*)(Yl + (16 * mt + 4 * fq + reg) * 32 + fr * 2) = (bf16_t)(cvt_pk_bf16(gelu_tanh(y[mt][reg]), 0.f) & 0xffffu);
            const u32x4 yo = *(const LAS u32x4*)(Yl + (lane >> 1) * 32 + (lane & 1) * 16);
            { const int row = lane >> 1, tok = ((row >> 2) & 1) * 128 + 16 * blk + (row & 3) + 4 * (row >> 3);
              *(u32x4*)(YPRE + ((size_t)b * SEQ + wave * 256 + tok) * SSMW + 16 * g + 8 * (lane & 1)) = yo; }
        }
        __syncthreads();
    }
}

__device__ __forceinline__ int crow(int r, int hi) { return (r & 3) + 8 * (r >> 2) + 4 * hi; }
typedef short v4i16_t __attribute__((ext_vector_type(4)));
__device__ __forceinline__ s16x4 vtr(const LAS unsigned char* p) { return __builtin_bit_cast(s16x4, __builtin_amdgcn_ds_read_tr16_b64_v4i16((LAS v4i16_t*)p)); }
__device__ __forceinline__ float half_swap_max(float x) { auto rr = __builtin_amdgcn_permlane32_swap(__float_as_uint(x), __float_as_uint(x), false, false); return fmaxf(__uint_as_float(rr[0]), __uint_as_float(rr[1])); }
__device__ __forceinline__ float half_swap_sum(float x) { auto rr = __builtin_amdgcn_permlane32_swap(__float_as_uint(x), __float_as_uint(x), false, false); return __uint_as_float(rr[0]) + __uint_as_float(rr[1]); }

__device__ __forceinline__ void attn_pv(f32x16 (&o)[4], const bf16x8 (&pa)[4], unsigned vaddr) {
    s16x4 vl[2][4], vh[2][4];
#define ATT_VRD(SET, D) do { _Pragma("unroll") for (int ks_ = 0; ks_ < 4; ++ks_) { \
        asm volatile("ds_read_b64_tr_b16 %0, %1 offset:%2" : "=&v"(vl[SET][ks_]) : "v"(vaddr), "i"((D) * 4096 + ks_ * 1024) : "memory"); \
        asm volatile("ds_read_b64_tr_b16 %0, %1 offset:%2" : "=&v"(vh[SET][ks_]) : "v"(vaddr), "i"((D) * 4096 + ks_ * 1024 + 512) : "memory"); } } while (0)
    __builtin_amdgcn_sched_barrier(0);
    ATT_VRD(0, 0);
#pragma unroll
    for (int d = 0; d < 4; ++d) {
        if (d == 0) { ATT_VRD(1, 1); } else if (d == 1) { ATT_VRD(0, 2); } else if (d == 2) { ATT_VRD(1, 3); }
        if (d < 3) asm volatile("s_waitcnt lgkmcnt(8)" ::: "memory"); else asm volatile("s_waitcnt lgkmcnt(0)" ::: "memory");
        __builtin_amdgcn_sched_barrier(0);
#pragma unroll
        for (int ks = 0; ks < 4; ++ks) { const s16x4 lo = vl[d & 1][ks], hv = vh[d & 1][ks];
            const bf16x8 vf = (bf16x8){lo[0], lo[1], lo[2], lo[3], hv[0], hv[1], hv[2], hv[3]};
            o[d] = __builtin_amdgcn_mfma_f32_32x32x16_bf16(pa[ks], vf, o[d], 0, 0, 0); }
        __builtin_amdgcn_sched_barrier(0);
    }
#undef ATT_VRD
}
__device__ __forceinline__ void attn_qk(f32x16& p0, f32x16& p1, const LAS unsigned char* kb, const bf16x8 (&qr)[4]) {
    p0 = (f32x16){}; p1 = (f32x16){};
#pragma unroll
    for (int d0 = 0; d0 < 4; ++d0) { const bf16x8 b0 = *(const LAS bf16x8*)(kb + d0 * 2048), b1 = *(const LAS bf16x8*)(kb + d0 * 2048 + 512);
        p0 = __builtin_amdgcn_mfma_f32_32x32x16_bf16(b0, qr[d0], p0, 0, 0, 0); p1 = __builtin_amdgcn_mfma_f32_32x32x16_bf16(b1, qr[d0], p1, 0, 0, 0); }
}
__device__ __forceinline__ void attn_softmax(const bool FIRST, f32x16& p0, f32x16& p1, f32x16 (&o)[4], float& mrun, float& lrun, bf16x8 (&pa)[4], LAS float* wsf, int r32, int hi) {
    if (FIRST) {
        asm volatile("" ::: "memory");
#pragma unroll
        for (int r = 0; r < 16; ++r) { if (r >= 8) p0[r] = -__builtin_inff(); p1[r] = -__builtin_inff(); } }
    float rmA = fmaxf(p0[0], p0[1]), rmB = fmaxf(p0[2], p0[3]), rmC = fmaxf(p1[0], p1[1]), rmD = fmaxf(p1[2], p1[3]);
#pragma unroll
    for (int r = 4; r < 16; r += 4) { rmA = fmaxf(rmA, fmaxf(p0[r], p0[r + 1])); rmB = fmaxf(rmB, fmaxf(p0[r + 2], p0[r + 3])); rmC = fmaxf(rmC, fmaxf(p1[r], p1[r + 1])); rmD = fmaxf(rmD, fmaxf(p1[r + 2], p1[r + 3])); }
    const float rm = half_swap_max(fmaxf(fmaxf(rmA, rmB), fmaxf(rmC, rmD)));
    if (FIRST) mrun = rm;
    else if (__any(rm > mrun + 8.0f)) {
        const float mnew = fmaxf(mrun, rm), alpha = __builtin_amdgcn_exp2f(mrun - mnew);
        lrun *= alpha; mrun = mnew;
        if (hi == 0) wsf[r32] = alpha;
        f32x4 a4[4];
#pragma unroll
        for (int gq = 0; gq < 4; ++gq) a4[gq] = *(const LAS f32x4*)(wsf + 8 * gq + 4 * hi);
#pragma unroll
        for (int d = 0; d < 4; ++d)
#pragma unroll
            for (int r = 0; r < 16; ++r) o[d][r] *= a4[r >> 2][r & 3];
    }
    float psA = 0.f, psB = 0.f, psC = 0.f, psD = 0.f;
#pragma unroll
    for (int r = 0; r < 16; r += 2) { p0[r] = __builtin_amdgcn_exp2f(p0[r] - mrun); p0[r + 1] = __builtin_amdgcn_exp2f(p0[r + 1] - mrun); p1[r] = __builtin_amdgcn_exp2f(p1[r] - mrun); p1[r + 1] = __builtin_amdgcn_exp2f(p1[r + 1] - mrun);
        psA += p0[r]; psB += p0[r + 1]; psC += p1[r]; psD += p1[r + 1]; }
    lrun += (psA + psB) + (psC + psD);
    u32x4 w;
    w = (u32x4){cvt_pk_bf16(p0[0], p0[1]), cvt_pk_bf16(p0[2], p0[3]), cvt_pk_bf16(p0[4], p0[5]), cvt_pk_bf16(p0[6], p0[7])}; pa[0] = __builtin_bit_cast(bf16x8, w);
    w = (u32x4){cvt_pk_bf16(p0[8], p0[9]), cvt_pk_bf16(p0[10], p0[11]), cvt_pk_bf16(p0[12], p0[13]), cvt_pk_bf16(p0[14], p0[15])}; pa[1] = __builtin_bit_cast(bf16x8, w);
    w = (u32x4){cvt_pk_bf16(p1[0], p1[1]), cvt_pk_bf16(p1[2], p1[3]), cvt_pk_bf16(p1[4], p1[5]), cvt_pk_bf16(p1[6], p1[7])}; pa[2] = __builtin_bit_cast(bf16x8, w);
    w = (u32x4){cvt_pk_bf16(p1[8], p1[9]), cvt_pk_bf16(p1[10], p1[11]), cvt_pk_bf16(p1[12], p1[13]), cvt_pk_bf16(p1[14], p1[15])}; pa[3] = __builtin_bit_cast(bf16x8, w);
}
__device__ __forceinline__ void glds16(const void* gsrc, unsigned lds_dst) { unsigned keep;
    asm volatile("s_mov_b32 %0, m0\n\ts_mov_b32 m0, %2\n\ts_nop 0\n\tglobal_load_lds_dwordx4 %1, off\n\ts_mov_b32 m0, %0" : "=&s"(keep) : "v"(gsrc), "s"(lds_dst) : "memory"); }
__device__ __forceinline__ void attn_unit(const Ctx& C, const bf16_t* Qg, const bf16_t* Kg, const bf16_t* Vg, const bf16_t* KM, const bf16_t* VM, bf16_t* Y,
                                          const float* subg, float lam, int b, int h, int qt, bool prefetched, int nqt, bf16x8 (&qr)[4], bool rb) {
    LAS unsigned char* lds = C.lds;
    const int lane = C.lane, wave = C.wave, r32 = lane & 31, hi = lane >> 5, qb = wave >> 1, map = wave & 1;
    const int q0 = qt * 128 + qb * 32;
    const size_t rowb = (size_t)b * SEQ;
    if (!prefetched) { const bf16_t* qp = Qg + (rowb + q0 + r32) * AW + h * 128 + map * 64 + hi * 8;
#pragma unroll
      for (int d0 = 0; d0 < 4; ++d0) qr[d0] = *(const bf16x8*)(qp + d0 * 16); }
    const int NT = 2 * qt + 3;
    const bool skip_last = (qb < 2);
    f32x16 o[4];
#pragma unroll
    for (int d = 0; d < 4; ++d) o[d] = (f32x16){};
    float mrun = -__builtin_inff(), lrun = 0.f;
    LAS float* wsf = (LAS float*)(lds + MISC_OFF + 4096 + wave * 256);
    const bf16_t* Kb = Kg + rowb * AW; const bf16_t* Vb = Vg + rowb * AW;
#define ATT_DMA(step, stage) do { const bf16_t* ks_ = (step) == 0 ? KM : Kb; const bf16_t* vs_ = (step) == 0 ? VM : Vb; const int row0_ = (step) == 0 ? 0 : ((step) - 1) * 64; \
    _Pragma("unroll") for (int i_ = 0; i_ < 2; ++i_) { const int p_ = 2 * wave + i_; \
        __builtin_amdgcn_global_load_lds((const unsigned*)(ks_ + (size_t)(row0_ + lane) * AW + h * 128 + (p_ >> 3) * 64 + (p_ & 7) * 8), (LAS unsigned*)(lds + (stage) * 32768 + p_ * 1024), 16, 0, 0); \
        __builtin_amdgcn_global_load_lds((const unsigned*)(vs_ + (size_t)(row0_ + 16 * (p_ & 3) + (lane >> 2)) * AW + h * 128 + (p_ >> 2) * 32 + (lane & 3) * 8), (LAS unsigned*)(lds + (stage) * 32768 + 16384 + p_ * 1024), 16, 0, 0); } } while (0)
    const int myNT = skip_last ? NT - 1 : NT;
    bf16x8 pa[4];
#pragma unroll
    for (int k = 0; k < 4; ++k) pa[k] = (bf16x8){};
    if (!prefetched) ATT_DMA(0, 0);
    asm volatile("s_waitcnt vmcnt(0)" ::: "memory"); __syncthreads();
    int stage = 0;
#pragma unroll 1
    for (int s = 0; s <= NT; ++s) {
        const int stn = stage == 2 ? 0 : stage + 1, stp = stage == 0 ? 2 : stage - 1;
        if (s + 1 < NT) ATT_DMA(s + 1, stn);
        if (rb && s >= 1 && s <= myNT) attn_pv(o, pa, (unsigned)(uintptr_t)(lds + stp * 32768 + 16384 + ((lane >> 4) & 1) * 32 + (lane & 3) * 8 + (4 * hi + ((lane & 15) >> 2)) * 64));
        if (s < myNT) {
            f32x16 p0, p1; attn_qk(p0, p1, lds + stage * 32768 + map * 8192 + hi * 1024 + r32 * 16, qr);
            attn_softmax(s == 0, p0, p1, o, mrun, lrun, pa, wsf, r32, hi);
            if (!rb) attn_pv(o, pa, (unsigned)(uintptr_t)(lds + stage * 32768 + 16384 + ((lane >> 4) & 1) * 32 + (lane & 3) * 8 + (4 * hi + ((lane & 15) >> 2)) * 64));
        }
        asm volatile("s_waitcnt vmcnt(0)" ::: "memory"); __syncthreads();
        stage = stn;
    }
#undef ATT_DMA
    bf16x8 qn[4];
#pragma unroll
    for (int d0 = 0; d0 < 4; ++d0) qn[d0] = qr[d0];
    if (nqt >= 0) {
        const unsigned lds0 = (unsigned)(uintptr_t)lds;
#pragma unroll
        for (int i = 0; i < 2; ++i) { const int p = 2 * wave + i;
            glds16(KM + (size_t)lane * AW + h * 128 + (p >> 3) * 64 + (p & 7) * 8, (unsigned)__builtin_amdgcn_readfirstlane(lds0 + p * 1024));
            glds16(VM + (size_t)(16 * (p & 3) + (lane >> 2)) * AW + h * 128 + (p >> 2) * 32 + (lane & 3) * 8, (unsigned)__builtin_amdgcn_readfirstlane(lds0 + 16384 + p * 1024)); }
        const bf16_t* qp = Qg + (rowb + nqt * 128 + qb * 32 + r32) * AW + h * 128 + map * 64 + hi * 8;
#pragma unroll
        for (int d0 = 0; d0 < 4; ++d0) qn[d0] = *(const bf16x8*)(qp + d0 * 16);
    }
    { const float ltot = half_swap_sum(lrun); const float inv = (map ? lam : 1.0f) / ltot;
      if (hi == 0) wsf[r32] = inv;
      f32x4 a4[4];
#pragma unroll
      for (int gq = 0; gq < 4; ++gq) a4[gq] = *(const LAS f32x4*)(wsf + 8 * gq + 4 * hi);
#pragma unroll
      for (int d = 0; d < 4; ++d)
#pragma unroll
          for (int r = 0; r < 16; ++r) o[d][r] *= a4[r >> 2][r & 3]; }
    LAS float* X = (LAS float*)(lds + 32768 + qb * 16384);
    if (map == 1) {
#pragma unroll
        for (int d = 0; d < 4; ++d)
#pragma unroll
            for (int r = 0; r < 16; ++r) X[crow(r, hi) * 128 + 32 * d + r32] = o[d][r];
    }
    __syncthreads();
    if (map == 0) {
        float ssq[16];
#pragma unroll
        for (int r = 0; r < 16; ++r) ssq[r] = 0.f;
#pragma unroll
        for (int d = 0; d < 4; ++d)
#pragma unroll
            for (int r = 0; r < 16; ++r) { const float v = o[d][r] - X[crow(r, hi) * 128 + 32 * d + r32]; o[d][r] = v; ssq[r] += v * v; }
#pragma unroll
        for (int r = 0; r < 16; ++r) {
#pragma unroll
            for (int off = 1; off < 32; off <<= 1) ssq[r] += __shfl_xor(ssq[r], off);
            ssq[r] = 0.8f / sqrtf(ssq[r] * (1.f / 128.f) + LN_EPS); }
        LAS bf16_t* Yt = (LAS bf16_t*)X;
#pragma unroll
        for (int d = 0; d < 4; ++d) { const float gg = subg[32 * d + r32];
#pragma unroll
            for (int r = 0; r < 16; ++r) Yt[crow(r, hi) * 128 + 32 * d + r32] = (bf16_t)(cvt_pk_bf16(o[d][r] * ssq[r] * gg, 0.f) & 0xffffu); }
#pragma unroll
        for (int i = 0; i < 8; ++i) { const int id = i * 64 + lane, row = id >> 4, ch = id & 15;
            *(u32x4*)(Y + (rowb + q0 + row) * AW + h * 128 + ch * 8) = *(const LAS u32x4*)(Yt + row * 128 + ch * 8); }
    }
#pragma unroll
    for (int d0 = 0; d0 < 4; ++d0) qr[d0] = qn[d0];
    __syncthreads();
}
__device__ __forceinline__ void p3_attention(const Ctx& C, const float* const* in, unsigned char* ws) {
    const bf16_t* Q = (const bf16_t*)(ws + WS_Q); const bf16_t* K = (const bf16_t*)(ws + WS_K); const bf16_t* V = (const bf16_t*)(ws + WS_V);
    const bf16_t* KM = (const bf16_t*)(ws + WS_KMETA); const bf16_t* VM = (const bf16_t*)(ws + WS_VMETA); bf16_t* Y = (bf16_t*)(ws + WS_YATT);
    const float l1 = wave_sum(in[14][C.lane] * in[15][C.lane]), l2 = wave_sum(in[16][C.lane] * in[17][C.lane]);
    const float lam = expf(l1) - expf(l2) + 0.2f;
    LAS unsigned* rc = (LAS unsigned*)(C.lds + MISC_OFF + 6144);
    if (C.tid < 4) rc[C.tid] = 0;
    __syncthreads();
    bool rb;
    { const unsigned simd = (unsigned)__builtin_amdgcn_s_getreg(2308) & 3u;
      unsigned r = 0; if (C.lane == 0) r = __hip_atomic_fetch_add(rc + simd, 1u, __ATOMIC_RELAXED, __HIP_MEMORY_SCOPE_WORKGROUP);
      rb = (__builtin_amdgcn_readfirstlane((int)r) & 1) != 0; }
#ifndef ATT_REP
#define ATT_REP 1
#endif
    for (int vv = C.vcu; vv < 256 * ATT_REP; vv += C.G) { const int v = vv & 255;
        const int bh = v >> 1, sft = v & 1;
        bf16x8 qr[4];
#pragma unroll
        for (int d0 = 0; d0 < 4; ++d0) qr[d0] = (bf16x8){};
#pragma unroll 1
        for (int i = 0; i < 8; ++i) { const int qt = (i & 1) ? (15 - sft - (i & ~1)) : (sft + (i & ~1)); const int i1 = i + 1;
            const int nqt = i1 < 8 ? ((i1 & 1) ? (15 - sft - (i1 & ~1)) : (sft + (i1 & ~1))) : -1;
            attn_unit(C, Q, K, V, KM, VM, Y, in[18], lam, bh >> 3, bh & 7, qt, i > 0, nqt, qr, rb); }
    }
}

__device__ __forceinline__ void p6_ln1_router(const Ctx& C, const float* const* in, unsigned char* ws) {
    const int lane = C.lane, wave = C.wave, tid = C.tid;
    const bf16_t* Z = (const bf16_t*)(ws + WS_Z); bf16_t* H1 = (bf16_t*)(ws + WS_H1); const float* WrT = (const float*)(ws + WS_WRT);
    int* LIST = (int*)(ws + WS_LIST); float* WGT = (float*)(ws + WS_WGT); unsigned* ECNT = (unsigned*)(ws + WS_CTL) + CW_ECNT;
    const float* lg = in[22]; const float* lb = in[23];
    LAS float* WB = (LAS float*)C.lds;
    LAS unsigned char* XB = C.lds + 98304;
    LAS int* RE = (LAS int*)(XB);
    LAS float* RW = (LAS float*)(XB + 1024);
    LAS int* CL = (LAS int*)(XB + 2048);
    LAS int* BS = (LAS int*)(XB + 2048 + 128);
    LAS int* SL = (LAS int*)(XB + 2048 + 256);
    LAS float* LG = (LAS float*)(XB + 4096) + wave * 80;
    for (int rbk = C.vcu; rbk < T / 128; rbk += C.G) {
        if (tid < 32) CL[tid] = 0;
#pragma unroll 1
        for (int step = 0; step < 8; ++step) {
            const int lr0 = step * 16 + 2 * wave; const size_t row0 = (size_t)rbk * 128 + lr0;
            int l4 = 4 * lane; asm volatile("" : "+v"(l4));
            f32x4 v0[8], v1[8];
#pragma unroll
            for (int j = 0; j < 8; ++j) { const u32x2 z0 = *(const u32x2*)(Z + row0 * DM + 256 * j + l4), z1 = *(const u32x2*)(Z + (row0 + 1) * DM + 256 * j + l4);
                v0[j] = (f32x4){bf_lo(z0.x), bf_hi(z0.x), bf_lo(z0.y), bf_hi(z0.y)}; v1[j] = (f32x4){bf_lo(z1.x), bf_hi(z1.x), bf_lo(z1.y), bf_hi(z1.y)}; }
            float mean0, rstd0, mean1, rstd1; ln_stats(v0, mean0, rstd0); ln_stats(v1, mean1, rstd1);
#pragma unroll
            for (int j = 0; j < 8; ++j) { const f32x4 gg = *(const f32x4*)(lg + 256 * j + l4), bb = *(const f32x4*)(lb + 256 * j + l4);
                v0[j] = (v0[j] - mean0) * rstd0 * gg + bb; v1[j] = (v1[j] - mean1) * rstd1 * gg + bb;
                u32x2 w; w.x = cvt_pk_bf16(v0[j].x, v0[j].y); w.y = cvt_pk_bf16(v0[j].z, v0[j].w); *(u32x2*)(H1 + row0 * DM + 256 * j + l4) = w;
                w.x = cvt_pk_bf16(v1[j].x, v1[j].y); w.y = cvt_pk_bf16(v1[j].z, v1[j].w); *(u32x2*)(H1 + (row0 + 1) * DM + 256 * j + l4) = w; }
#pragma unroll 1
            for (int ng = 0; ng < 3; ++ng) {
                __syncthreads();
                int tq = tid; asm volatile("" : "+v"(tq));
#pragma unroll
                for (int i = 0; i < 12; ++i) { const int idx = tq + 512 * i, n = idx >> 9, c4 = idx & 511;
                    *(LAS f32x4*)(WB + n * 2048 + 4 * c4) = *(const f32x4*)(WrT + (size_t)(12 * ng + n) * DM + 4 * c4); }
                __syncthreads();
#pragma unroll 1
                for (int n = 0; n < 12; ++n) { float pa = 0.f, pb = 0.f;
#pragma unroll
                    for (int j = 0; j < 8; ++j) { const f32x4 w4 = *(const LAS f32x4*)(WB + n * 2048 + 256 * j + l4);
                        const f32x4 a = v0[j] * w4, bq = v1[j] * w4; pa += (a.x + a.y) + (a.z + a.w); pb += (bq.x + bq.y) + (bq.z + bq.w); }
                    const float sa = wave_sum(pa), sb = wave_sum(pb); if (lane == 0) { LG[12 * ng + n] = sa; LG[40 + 12 * ng + n] = sb; } }
            }
            if (lane < 2) {
                const LAS float* L = LG + 40 * lane;
                int gi = 0; float gm = L[0] + in[25][0];
                for (int n = 1; n < 4; ++n) { const float x = L[n] + in[25][n]; if (x > gm) { gm = x; gi = n; } }
                float gs = 0.f;
                for (int n = 0; n < 4; ++n) gs += __expf(L[n] + in[25][n] - gm);
                const float gval = 1.0f / gs;
                int i1 = 0; float m1 = L[4 + gi * 8] + in[27][gi * 8];
                for (int j = 1; j < 8; ++j) { const float x = L[4 + gi * 8 + j] + in[27][gi * 8 + j]; if (x > m1) { m1 = x; i1 = j; } }
                int i2 = -1; float m2 = -__builtin_inff();
                for (int j = 0; j < 8; ++j) { const float x = L[4 + gi * 8 + j] + in[27][gi * 8 + j]; if (j != i1 && x > m2) { m2 = x; i2 = j; } }
                const float tt = __expf(m2 - m1), w1 = gval / (1.f + tt), w2 = gval * tt / (1.f + tt);
                const int lr = lr0 + lane; RE[lr * 2] = gi * 8 + i1; RE[lr * 2 + 1] = gi * 8 + i2; RW[lr * 2] = w1; RW[lr * 2 + 1] = w2;
            }
        }
        __syncthreads();
        int e = 0;
        if (tid < 256) { e = RE[tid]; SL[tid] = __hip_atomic_fetch_add(&CL[e], 1, __ATOMIC_RELAXED, __HIP_MEMORY_SCOPE_WORKGROUP); }
        __syncthreads();
        if (tid < 32) BS[tid] = (int)__hip_atomic_fetch_add(&ECNT[tid], (unsigned)CL[tid], __ATOMIC_RELAXED, __HIP_MEMORY_SCOPE_AGENT);
        __syncthreads();
        if (tid < 256) { const int entry = (rbk * 128 + (tid >> 1)) * 2 + (tid & 1); LIST[(size_t)e * CAP + BS[e] + SL[tid]] = entry; WGT[entry] = RW[tid]; }
        __syncthreads();
    }
}

__device__ __forceinline__ void p9_ln2(const Ctx& C, const float* const* in, unsigned char* ws, float* out) {
    const bf16_t* H1 = (const bf16_t*)(ws + WS_H1); const bf16_t* YK = (const bf16_t*)(ws + WS_YK);
    const float* lg = in[31]; const float* lb = in[32];
    const int gw = C.vcu * 8 + C.wave, NGW = C.G * 8, lane = C.lane;
    for (int m = gw; m < T; m += 2 * NGW) {
        const int m2 = (m + NGW < T) ? m + NGW : m;
        u32x2 ha[8], ya0[8], ya1[8], hb[8], yb0[8], yb1[8];
#pragma unroll
        for (int j = 0; j < 8; ++j) { const size_t c = 256 * j + 4 * lane;
            ha[j] = *(const u32x2*)(H1 + (size_t)m * DM + c); ya0[j] = *(const u32x2*)(YK + (size_t)(2 * m) * DM + c); ya1[j] = *(const u32x2*)(YK + (size_t)(2 * m + 1) * DM + c);
            hb[j] = *(const u32x2*)(H1 + (size_t)m2 * DM + c); yb0[j] = *(const u32x2*)(YK + (size_t)(2 * m2) * DM + c); yb1[j] = *(const u32x2*)(YK + (size_t)(2 * m2 + 1) * DM + c); }
#pragma unroll
        for (int rr = 0; rr < 2; ++rr) {
            f32x4 v[8];
#pragma unroll
            for (int j = 0; j < 8; ++j) { const u32x2 hw = rr ? hb[j] : ha[j], y0 = rr ? yb0[j] : ya0[j], y1 = rr ? yb1[j] : ya1[j];
                v[j] = (f32x4){bf_lo(hw.x), bf_hi(hw.x), bf_lo(hw.y), bf_hi(hw.y)} * ALPHA + (f32x4){bf_lo(y0.x), bf_hi(y0.x), bf_lo(y0.y), bf_hi(y0.y)} + (f32x4){bf_lo(y1.x), bf_hi(y1.x), bf_lo(y1.y), bf_hi(y1.y)}; }
            float mean, rstd; ln_stats(v, mean, rstd);
            const int mm = rr ? m2 : m;
            if (rr == 0 || m2 != m) {
#pragma unroll
                for (int j = 0; j < 8; ++j) { const f32x4 gg = *(const f32x4*)(lg + 256 * j + 4 * lane), bb = *(const f32x4*)(lb + 256 * j + 4 * lane);
                    *(f32x4*)(out + (size_t)mm * DM + 256 * j + 4 * lane) = (v[j] - mean) * rstd * gg + bb; } }
        }
    }
}

__device__ __forceinline__ int build_moe_tables(const Ctx& C, unsigned char* ws) {
    LAS int* blkstart = (LAS int*)(C.lds + MISC_OFF + 64); LAS int* cntE = (LAS int*)(C.lds + MISC_OFF + 320); LAS int* blkexp = (LAS int*)(C.lds + MISC_OFF + 512);
    unsigned* ECNT = (unsigned*)(ws + WS_CTL) + CW_ECNT;
    __syncthreads();
    if (C.tid < 32) cntE[C.tid] = (int)__hip_atomic_load(&ECNT[C.tid], __ATOMIC_RELAXED, __HIP_MEMORY_SCOPE_AGENT);
    __syncthreads();
    if (C.tid == 0) { int s = 0; for (int e = 0; e < NE; ++e) { blkstart[e] = s; s += (cntE[e] + 255) >> 8; } blkstart[NE] = s; }
    __syncthreads();
    const int NBLK = blkstart[NE];
    if (C.tid < NBLK && C.tid < 320) { int e = 0; for (int j = 1; j < NE; ++j) if (blkstart[j] <= C.tid) e = j; blkexp[C.tid] = e; }
    __syncthreads();
    return NBLK < 320 ? NBLK : 320;
}

__device__ __forceinline__ void p7_convert_down(const Ctx& C, const float* const* in, unsigned char* ws) {
    LAS float* scr = (LAS float*)(C.lds + C.wave * 16384);
    unsigned* ctr = (unsigned*)(ws + WS_CTL) + CW_CONV; bf16_t* WdnT = (bf16_t*)(ws + WS_WDN);
    constexpr int NCH = NE * 512 / 16;
    for (;;) {
        unsigned ch = 0; if (C.lane == 0) ch = __hip_atomic_fetch_add(ctr, 1u, __ATOMIC_RELAXED, __HIP_MEMORY_SCOPE_AGENT);
        ch = (unsigned)__builtin_amdgcn_readfirstlane((int)ch);
        if (ch >= (unsigned)NCH) break;
#pragma unroll 1
        for (int q = 0; q < 16; ++q) { const int r = (int)ch * 16 + q, e = r >> 9, rr = r & 511, kb = rr >> 6, nb = rr & 63;
            transpose_item(in[30] + (size_t)e * DFF * DM, DFF, DM, WdnT, kb, nb, e * 2048 + 32 * nb, scr, C.lane); }
    }
}

constexpr int NPHASE = 10;
struct Args { const float* in[33]; float* out; unsigned char* ws; int ph_lo, ph_hi; };
__global__ void __launch_bounds__(512, 2) mk_fwd(Args args) {
    extern __shared__ __attribute__((aligned(16))) unsigned char lds_raw[];
    Ctx C; C.lds = (LAS unsigned char*)lds_raw; C.tid = threadIdx.x; C.lane = C.tid & 63; C.wave = __builtin_amdgcn_readfirstlane(C.tid >> 6);
    C.G = gridDim.x; { const int bx = blockIdx.x; C.vcu = (C.G % 8 == 0) ? (bx % 8) * (C.G / 8) + bx / 8 : bx; }
    unsigned char* ws = args.ws; const float* const* in = args.in;
    volatile LAS unsigned* MISC = (volatile LAS unsigned*)(C.lds + MISC_OFF);
    if (C.tid < 16) MISC[C.tid] = 0u;
    __syncthreads();
    unsigned* barw = (unsigned*)(ws + WS_CTL) + CW_BAR;
    XcdBarrier bar; bar.bar = barw; bar.x = 0; bar.st = nullptr;
    const int lo = args.ph_lo, hi = args.ph_hi;
    if (hi - lo > 1) bar = xcd_barrier_post(barw, MISC);
#ifndef PH_MASK
#define PH_MASK 0x3ff
#endif
#define IN(k) (((PH_MASK >> (k)) & 1) && lo <= (k) && (k) < hi)
#define SEAM(k) do { if (IN(k) && IN((k) + 1)) xcd_barrier(bar); } while (0)
#ifndef WGM_PROJ
#define WGM_PROJ 4
#endif
#ifndef WGM_N2K
#define WGM_N2K 2
#endif
#ifndef GEMM_SP2
#define GEMM_SP2 true
#endif
#ifndef GEMM_ALIGN
#define GEMM_ALIGN true
#endif
#ifndef PROBE_MASK
#define PROBE_MASK 0
#endif
#define REPS(k) (((PROBE_MASK >> (k)) & 1) ? 2 : 1)
#define REPSEAM(k, rep) do { if ((rep) + 1 < REPS(k)) xcd_barrier(bar); } while (0)
    LAS unsigned char* lds = C.lds;
    bf16_t* MG = (bf16_t*)args.out;

    if (IN(0)) { _Pragma("unroll") for (int rep = 0; rep < REPS(0); ++rep) { p0_prologue(C, in, ws); REPSEAM(0, rep); } } SEAM(0);

    if (IN(1)) { _Pragma("unroll") for (int rep = 0; rep < REPS(1); ++rep) {
        pg8::Gemm g{(const bf16_t*)(ws + WS_HBF), (const bf16_t*)(ws + WS_WIN), T, INC, DM, nullptr, nullptr, 0}; pg8::StaticOrder S; S.init(T, INC, C.G, (int)blockIdx.x, WGM_PROJ);
        EpiProj E{(bf16_t*)(ws + WS_U), (bf16_t*)(ws + WS_Q), (bf16_t*)(ws + WS_K), (bf16_t*)(ws + WS_V), (bf16_t*)(ws + WS_SGS), (bf16_t*)(ws + WS_SGA)};
        pg8::gemm_phase<EpiProj, pg8::StaticOrder, GEMM_ALIGN, GEMM_SP2, false>(lds, g, S, E);
        p1_meta_proj(C, ws);
        REPSEAM(1, rep);
    } } SEAM(1);

    if (IN(2)) { _Pragma("unroll") for (int rep = 0; rep < REPS(2); ++rep) { p2_scan(C, in, ws); REPSEAM(2, rep); } } SEAM(2);

    if (IN(3)) { _Pragma("unroll") for (int rep = 0; rep < REPS(3); ++rep) {
        { pg8::Gemm g{(const bf16_t*)(ws + WS_YPRE), (const bf16_t*)(ws + WS_WGLU), T, SSMW, SSMW, nullptr, nullptr, 0}; pg8::StaticOrder S; S.init(T, SSMW, C.G, (int)blockIdx.x);
          EpiGlu E{(const bf16_t*)(ws + WS_YPRE), (bf16_t*)(ws + WS_YSSM)};
          pg8::gemm_phase<EpiGlu, pg8::StaticOrder, GEMM_ALIGN, GEMM_SP2, false>(lds, g, S, E); }
        p3_attention(C, in, ws);
        REPSEAM(3, rep);
    } } SEAM(3);

    if (IN(4)) { _Pragma("unroll") for (int rep = 0; rep < REPS(4); ++rep) {
        { pg8::Gemm g{(const bf16_t*)(ws + WS_YSSM), (const bf16_t*)(ws + WS_WBS), T, DM, SSMW, (const bf16_t*)(ws + WS_YATT), (const bf16_t*)(ws + WS_WBA), AW}; pg8::StaticOrder S; S.init(T, DM, C.G, (int)blockIdx.x, WGM_N2K);
          EpiMergeF E{(const bf16_t*)(ws + WS_SGS), (const bf16_t*)(ws + WS_SGA), MG};
          pg8::gemm_phase<EpiMergeF, pg8::StaticOrder, GEMM_ALIGN, GEMM_SP2, false, true>(lds, g, S, E); }
        REPSEAM(4, rep);
    } } SEAM(4);

    if (IN(5)) { _Pragma("unroll") for (int rep = 0; rep < REPS(5); ++rep) {
        pg8::Gemm g{MG, (const bf16_t*)(ws + WS_WO), T, DM, DM, nullptr, nullptr, 0}; pg8::StaticOrder S; S.init(T, DM, C.G, (int)blockIdx.x, WGM_N2K);
        EpiZ E{(const bf16_t*)(ws + WS_HBF), (bf16_t*)(ws + WS_Z)};
        pg8::gemm_phase<EpiZ, pg8::StaticOrder, GEMM_ALIGN, GEMM_SP2, false>(lds, g, S, E);
        REPSEAM(5, rep);
    } } SEAM(5);

    if (IN(6)) { p6_ln1_router(C, in, ws); } SEAM(6);

    if (IN(7)) { _Pragma("unroll") for (int rep = 0; rep < REPS(7); ++rep) {
        const int NBLK = build_moe_tables(C, ws);
        MoeOrder S{C.G, C.vcu, 2, NBLK, (const LAS int*)(lds + MISC_OFF + 512), (const LAS int*)(lds + MISC_OFF + 64), (const LAS int*)(lds + MISC_OFF + 320), (const int*)(ws + WS_LIST)};
        pg8::Gemm g{(const bf16_t*)(ws + WS_H1), (const bf16_t*)(ws + WS_WUP), T, NE * 1024, DM, nullptr, nullptr, 0};
        EpiSwiglu E{(bf16_t*)(ws + WS_HB), (const int*)(ws + WS_LIST), (const float*)(ws + WS_WGT), (int*)(ws + WS_POSE), (float*)(ws + WS_POSW)};
        pg8::gemm_phase<EpiSwiglu, MoeOrder, GEMM_ALIGN, GEMM_SP2, true>(lds, g, S, E);
        p7_convert_down(C, in, ws);
        REPSEAM(7, rep);
    } } SEAM(7);

    if (IN(8)) { _Pragma("unroll") for (int rep = 0; rep < REPS(8); ++rep) {
        const int NBLK = build_moe_tables(C, ws);
        MoeOrder S{C.G, C.vcu, 3, NBLK, (const LAS int*)(lds + MISC_OFF + 512), (const LAS int*)(lds + MISC_OFF + 64), (const LAS int*)(lds + MISC_OFF + 320), (const int*)(ws + WS_LIST)};
        pg8::Gemm g{(const bf16_t*)(ws + WS_HB), (const bf16_t*)(ws + WS_WDN), NBLK * 256, NE * DM, DFF, nullptr, nullptr, 0};
        EpiDown E{(const int*)(ws + WS_POSE), (const float*)(ws + WS_POSW), (bf16_t*)(ws + WS_YK)};
        pg8::gemm_phase<EpiDown, MoeOrder, GEMM_ALIGN, GEMM_SP2, false>(lds, g, S, E);
        REPSEAM(8, rep);
    } } SEAM(8);

    if (IN(9)) { _Pragma("unroll") for (int rep = 0; rep < REPS(9); ++rep) { p9_ln2(C, in, ws, args.out); REPSEAM(9, rep); } }
#undef IN
#undef SEAM
}

extern "C" void kernel_launch(void* const* d_in, const int* in_sizes, int n_in, void* d_out, int out_size, void* d_ws, size_t ws_size, hipStream_t stream) {
    static int grid = 0;
    if (grid == 0) {
        if (n_in != 33 || in_sizes[0] != T * DM || out_size != T * DM || ws_size < WS_END) { fprintf(stderr, "kernel_launch: unexpected shapes (n_in %d, in0 %d, out %d, ws %zu)\n", n_in, n_in > 0 ? in_sizes[0] : -1, out_size, ws_size); grid = -1; return; }
        int dev = 0, cus = 0, per_cu = 0;
        if (hipGetDevice(&dev) != hipSuccess || hipDeviceGetAttribute(&cus, hipDeviceAttributeMultiprocessorCount, dev) != hipSuccess) { grid = -1; return; }
        if (hipFuncSetAttribute((const void*)mk_fwd, hipFuncAttributeMaxDynamicSharedMemorySize, LDS_BYTES) != hipSuccess) { fprintf(stderr, "kernel_launch: hipFuncSetAttribute failed\n"); grid = -1; return; }
        if (hipOccupancyMaxActiveBlocksPerMultiprocessor(&per_cu, (const void*)mk_fwd, 512, LDS_BYTES) != hipSuccess || per_cu < 1) { fprintf(stderr, "kernel_launch: occupancy query reports %d blocks per CU\n", per_cu); }
        (void)hipGetLastError();
        grid = cus;
    }
    if (grid < 0) return;
    (void)hipMemsetAsync((char*)d_ws + WS_CTL, 0, CTL_ZERO_BYTES, stream);
    Args a{};
    for (int i = 0; i < 33; ++i) a.in[i] = (const float*)d_in[i];
    a.out = (float*)d_out; a.ws = (unsigned char*)d_ws;
#if MK_PER_PHASE
    for (int p = 0; p < NPHASE; ++p) { a.ph_lo = p; a.ph_hi = p + 1; hipLaunchKernelGGL(mk_fwd, dim3(grid), dim3(512), LDS_BYTES, stream, a); }
#else
    a.ph_lo = 0; a.ph_hi = NPHASE; hipLaunchKernelGGL(mk_fwd, dim3(grid), dim3(512), LDS_BYTES, stream, a);
#endif
}
```

```cpp
#include <hip/hip_runtime.h>
#include <stdint.h>
#include <stdio.h>

#ifndef ATT_PROBE
#define ATT_PROBE 0
#endif
#ifndef MK_PER_PHASE
#define MK_PER_PHASE 0
#endif

#define GAS __attribute__((address_space(1)))
#define LAS __attribute__((address_space(3)))
typedef unsigned short bf16_t;
typedef short bf16x8 __attribute__((ext_vector_type(8)));
typedef short s16x4 __attribute__((ext_vector_type(4)));
typedef float f32x2 __attribute__((ext_vector_type(2)));
typedef float f32x4 __attribute__((ext_vector_type(4)));
typedef float f32x16 __attribute__((ext_vector_type(16)));
typedef unsigned u32x2 __attribute__((ext_vector_type(2)));
typedef unsigned u32x4 __attribute__((ext_vector_type(4)));

constexpr int NB_ = 16, SEQ = 2048, DM = 2048, T = NB_ * SEQ, NMETA = 16;
constexpr int SSMW = 512, AW = 1024, INC = 7680, NGRP = 32, NST = 64;
constexpr int NE = 32, DFF = 512, CAP = T;
constexpr float LN_EPS = 1e-5f;
constexpr float ALPHA = 1.189207115002721f;
constexpr float QSCALE = 0.125f * 1.4426950408889634f;

__device__ __forceinline__ unsigned cvt_pk_bf16(float lo, float hi) { unsigned r; asm volatile("v_cvt_pk_bf16_f32 %0, %1, %2" : "=v"(r) : "v"(lo), "v"(hi)); return r; }
__device__ __forceinline__ float bf_lo(unsigned w) { return __uint_as_float(w << 16); }
__device__ __forceinline__ float bf_hi(unsigned w) { return __uint_as_float(w & 0xffff0000u); }
__device__ __forceinline__ float sigmoidf_(float x) { return __builtin_amdgcn_rcpf(1.0f + __expf(-x)); }
template <int CTRL> __device__ __forceinline__ float dpp_f(float v) { return __int_as_float(__builtin_amdgcn_update_dpp(0, __float_as_int(v), CTRL, 0xf, 0xf, true)); }
__device__ __forceinline__ float wave_sum(float v) {
    v += dpp_f<0xB1>(v);
    v += dpp_f<0x4E>(v);
    v += dpp_f<0x141>(v);
    v += dpp_f<0x140>(v);
    { auto r = __builtin_amdgcn_permlane16_swap(__float_as_uint(v), __float_as_uint(v), false, false); v = __uint_as_float(r[0]) + __uint_as_float(r[1]); }
    { auto r = __builtin_amdgcn_permlane32_swap(__float_as_uint(v), __float_as_uint(v), false, false); v = __uint_as_float(r[0]) + __uint_as_float(r[1]); }
    return v;
}

namespace pg8 {
constexpr int BM = 256, BK = 64, HALF = 128, HTB = HALF * BK * 2, STAGE_BYTES = 8 * HTB, NXCD = 8, WGM = 4;
__host__ __device__ __forceinline__ int lds_byte(int r, int c) { const int st = (r >> 4) * 2 + (c >> 5), rr = r & 15, cc = c & 31, ob = rr * 64 + cc * 2; return st * 1024 + (ob ^ (((ob >> 9) & 1) << 5)); }
__host__ __device__ __forceinline__ void stage_rc(int b, int& R, int& C) { const int st = b / 1024, sb = b % 1024, swz = sb ^ (((sb >> 9) & 1) << 5); R = (st >> 1) * 16 + swz / 64; C = (st & 1) * 32 + (swz % 64) / 2; }
__host__ __device__ __forceinline__ int perm32(int rho) { const int n = rho >> 4, i = rho & 15; return 8 * (i >> 2) + 4 * n + (i & 3); }

struct Unit { int pm, pn, e, s0, cnt; };
struct Gemm { const bf16_t* A; const bf16_t* Bt; int M, N, K; const bf16_t* A2; const bf16_t* Bt2; int K2; };

struct StaticOrder {
    int nM, nN, nwg, G, c, wgm;
    __device__ void init(int M, int N, int G_, int c_, int wgm_ = WGM) { nM = M / BM; nN = N / BM; nwg = nM * nN; G = G_; c = c_; wgm = wgm_; }
    __device__ bool next(int i, Unit& u) const {
        const long L = (long)i * G + c; if (L >= nwg) return false;
        int wgid = (int)L; { const int q = nwg / NXCD, r = nwg % NXCD, xcd = wgid % NXCD, off = wgid / NXCD; wgid = (xcd < r ? xcd * (q + 1) : r * (q + 1) + (xcd - r) * q) + off; }
        const int nig = wgm * nN, gid = wgid / nig, fm = gid * wgm, gsz = (nM - fm) < wgm ? (nM - fm) : wgm;
        u.pm = fm + ((wgid % nig) % gsz); u.pn = (wgid % nig) / gsz; u.e = 0; u.s0 = 0; u.cnt = 0; return true;
    }
    __device__ __forceinline__ int arow(const Unit&, int) const { return 0; }
};

template <class Epi, class Sched, bool ALIGN_EPI, bool SP2, bool GATHER, bool DUAL = false>
__device__ __forceinline__ void gemm_phase(LAS unsigned char* lds, const Gemm g, const Sched& S, const Epi& E) {
    const int tid = threadIdx.x, wid = __builtin_amdgcn_readfirstlane(tid >> 6), lane = tid & 63, wr = wid >> 2, wc = wid & 3, fr = lane & 15, fq = lane >> 4;
    const int K = g.K, K2 = DUAL ? g.K2 : 0, nt1 = K / BK, nt = (K + K2) / BK;
    unsigned voffA[2], voffB[2], voffA2[2] = {0u, 0u}, voffB2[2] = {0u, 0u}; int stR[2], stC[2];
#pragma unroll
    for (int i = 0; i < 2; ++i) { int R, C; stage_rc(tid * 16 + i * 8192, R, C); const int Rb = Epi::PERM ? ((R & ~31) + perm32(R & 31)) : R;
        stR[i] = R; stC[i] = C; voffA[i] = (unsigned)(R * K + C) * 2u; voffB[i] = (unsigned)(Rb * K + C) * 2u;
        if constexpr (DUAL) { voffA2[i] = (unsigned)(R * K2 + C) * 2u; voffB2[i] = (unsigned)(Rb * K2 + C) * 2u; } }
    const size_t kstep = (size_t)(BK * 2);
    const size_t hstep = (size_t)HALF * K * 2;
    const size_t tstep = 2 * hstep;
    const size_t hstep2 = (size_t)HALF * K2 * 2, tstep2 = 2 * hstep2;
    const unsigned ldsw = (unsigned)wid * 1024u;
    const int aoff = lds_byte(wr * 64 + fr, fq * 8), boff = lds_byte(wc * 32 + fr, fq * 8);
#define PG8_SA(b, h) (((b) * 2 + (h)) * HTB)
#define PG8_SB(b, h) ((4 + (b) * 2 + (h)) * HTB)
#define PG8_STAGE(bufoff, gbase, voff) do { _Pragma("unroll") for (int _i = 0; _i < 2; ++_i) \
        __builtin_amdgcn_global_load_lds((const unsigned*)((const char*)(gbase) + (voff)[_i]), (LAS unsigned*)(lds + (bufoff) + ldsw + _i * 8192), 16, 0, 0); } while (0)
#define PG8_STAGE_A(bufoff, kbase, h, VO) do { if constexpr (GATHER) { PG8_STAGE(bufoff, kbase, VO[h]); } else { PG8_STAGE(bufoff, (kbase) + (h) * hstep, voffA); } } while (0)
#define PG8_STAGE_AX(bufoff, kbase, h, VO, HS, VA) do { if constexpr (GATHER) { PG8_STAGE(bufoff, kbase, VO[h]); } else { PG8_STAGE(bufoff, (kbase) + (h) * (HS), VA); } } while (0)
#define PG8_LDA(dst, b, h) do { _Pragma("unroll") for (int m = 0; m < 4; ++m) _Pragma("unroll") for (int k = 0; k < 2; ++k) dst[m][k] = *(const LAS bf16x8*)(lds + PG8_SA(b, h) + aoff + m * 2048 + k * 1024); } while (0)
#define PG8_LDB(dst, b, h) do { _Pragma("unroll") for (int n = 0; n < 2; ++n) _Pragma("unroll") for (int k = 0; k < 2; ++k) dst[n][k] = *(const LAS bf16x8*)(lds + PG8_SB(b, h) + boff + n * 2048 + k * 1024); } while (0)
#define PG8_MMA(ai, bj, At, Bt) do { __builtin_amdgcn_s_setprio(1); _Pragma("unroll") for (int m = 0; m < 4; ++m) _Pragma("unroll") for (int n = 0; n < 2; ++n) _Pragma("unroll") for (int k = 0; k < 2; ++k) \
        acc[ai][bj][m][n] = __builtin_amdgcn_mfma_f32_16x16x32_bf16(Bt[n][k], At[m][k], acc[ai][bj][m][n], 0, 0, 0); __builtin_amdgcn_s_setprio(0); } while (0)
#define PG8_WAIT_V(n) asm volatile("s_waitcnt vmcnt(" #n ")" ::: "memory")
#define PG8_WAIT_L(n) asm volatile("s_waitcnt lgkmcnt(" #n ")" ::: "memory")
#define PG8_BAR __builtin_amdgcn_s_barrier()
#define PG8_SCHED __builtin_amdgcn_sched_barrier(0)
#define PG8_GOFF(VO, U) do { _Pragma("unroll") for (int _h = 0; _h < 2; ++_h) _Pragma("unroll") for (int _i = 0; _i < 2; ++_i) \
        VO[_h][_i] = (unsigned)S.arow(U, _h * HALF + stR[_i]) * (unsigned)(K * 2) + (unsigned)(stC[_i] * 2); } while (0)
    Unit cur, nxt; int ui = 0;
    if (!S.next(0, cur)) return;
    f32x4 acc[2][2][4][2];
#pragma unroll
    for (int a = 0; a < 2; ++a)
#pragma unroll
        for (int b = 0; b < 2; ++b)
#pragma unroll
            for (int m = 0; m < 4; ++m)
#pragma unroll
                for (int n = 0; n < 2; ++n) acc[a][b][m][n] = (f32x4){0.f, 0.f, 0.f, 0.f};
    bf16x8 At[4][2], B0[2][2], B1[2][2];
    unsigned cvo[2][2] = {{0u, 0u}, {0u, 0u}}, nvo[2][2] = {{0u, 0u}, {0u, 0u}};
    const char* cA = GATHER ? (const char*)g.A : (const char*)g.A + (size_t)cur.pm * tstep; const char* cB = (const char*)g.Bt + (size_t)cur.pn * tstep;
    if constexpr (GATHER) { PG8_GOFF(cvo, cur); }
    if constexpr (SP2) {
        PG8_STAGE(PG8_SB(0, 0), cB, voffB); PG8_STAGE(PG8_SB(0, 1), cB + hstep, voffB); PG8_STAGE_A(PG8_SA(0, 0), cA, 0, cvo); PG8_STAGE_A(PG8_SA(0, 1), cA, 1, cvo);
        if (wr == 1) PG8_BAR;
        PG8_WAIT_V(2); PG8_BAR;
        PG8_STAGE(PG8_SB(1, 0), cB + kstep, voffB); PG8_STAGE_A(PG8_SA(1, 0), cA + kstep, 0, cvo); PG8_STAGE(PG8_SB(1, 1), cB + hstep + kstep, voffB);
        PG8_WAIT_V(6); PG8_BAR;
    } else {
        PG8_STAGE(PG8_SB(0, 0), cB, voffB); PG8_STAGE_A(PG8_SA(0, 0), cA, 0, cvo); PG8_STAGE(PG8_SB(0, 1), cB + hstep, voffB); PG8_STAGE_A(PG8_SA(0, 1), cA, 1, cvo);
        if (wr == 1) PG8_BAR;
        PG8_WAIT_V(4); PG8_BAR;
        PG8_STAGE(PG8_SB(1, 0), cB + kstep, voffB); PG8_STAGE_A(PG8_SA(1, 0), cA + kstep, 0, cvo); PG8_STAGE(PG8_SB(1, 1), cB + hstep + kstep, voffB);
        PG8_WAIT_V(6); PG8_BAR;
    }
    for (;;) {
        const bool has_next = S.next(ui + 1, nxt);
        const char* nA = GATHER ? cA : (has_next ? (const char*)g.A + (size_t)nxt.pm * tstep : cA); const char* nB = has_next ? (const char*)g.Bt + (size_t)nxt.pn * tstep : cB;
        if constexpr (GATHER) { if (has_next) { PG8_GOFF(nvo, nxt); } else {
#pragma unroll
            for (int h = 0; h < 2; ++h)
#pragma unroll
                for (int i = 0; i < 2; ++i) nvo[h][i] = cvo[h][i]; } }
        const char* cA2 = DUAL ? (const char*)g.A2 + (size_t)cur.pm * tstep2 : cA; const char* cB2 = DUAL ? (const char*)g.Bt2 + (size_t)cur.pn * tstep2 : cB;
        for (int t = 0; t < nt; t += 2) {
            const bool last = (t == nt - 2);
            const bool s1 = DUAL && (t + 1 >= nt1), s2 = DUAL && !last && (t + 2 >= nt1);
            const char* a1 = s1 ? cA2 + (size_t)(t + 1 - nt1) * kstep : cA + (size_t)(t + 1) * kstep;
            const char* a2 = last ? nA : (s2 ? cA2 + (size_t)(t + 2 - nt1) * kstep : cA + (size_t)(t + 2) * kstep);
            const char* b2 = last ? nB : (s2 ? cB2 + (size_t)(t + 2 - nt1) * kstep : cB + (size_t)(t + 2) * kstep);
            const char* a3 = a2 + kstep; const char* b3 = b2 + kstep;
            const size_t hs1 = s1 ? hstep2 : hstep, hs2 = s2 ? hstep2 : hstep;
            unsigned vA1[2], vA2[2], vB2[2];
#pragma unroll
            for (int i = 0; i < 2; ++i) { vA1[i] = s1 ? voffA2[i] : voffA[i]; vA2[i] = s2 ? voffA2[i] : voffA[i]; vB2[i] = s2 ? voffB2[i] : voffB[i]; }
            unsigned svo[2][2];
#pragma unroll
            for (int h = 0; h < 2; ++h)
#pragma unroll
                for (int i = 0; i < 2; ++i) svo[h][i] = last ? nvo[h][i] : cvo[h][i];
            if constexpr (SP2) {
            PG8_LDB(B0, 0, 0); PG8_LDB(B1, 0, 1); PG8_SCHED; PG8_LDA(At, 0, 0); PG8_STAGE_AX(PG8_SA(1, 1), a1, 1, cvo, hs1, vA1);
            PG8_WAIT_V(8); PG8_WAIT_L(0); PG8_BAR; PG8_MMA(0, 0, At, B0); PG8_MMA(0, 1, At, B1); PG8_BAR; PG8_SCHED;
            PG8_LDA(At, 0, 1); PG8_STAGE(PG8_SB(0, 0), b2, vB2); PG8_STAGE(PG8_SB(0, 1), b2 + hs2, vB2); PG8_STAGE_AX(PG8_SA(0, 0), a2, 0, svo, hs2, vA2);
            PG8_WAIT_V(8); PG8_WAIT_L(0); PG8_BAR; PG8_MMA(1, 0, At, B0); PG8_MMA(1, 1, At, B1); PG8_BAR; PG8_SCHED;
            PG8_LDB(B0, 1, 0); PG8_LDB(B1, 1, 1); PG8_SCHED; PG8_LDA(At, 1, 0); PG8_STAGE_AX(PG8_SA(0, 1), a2, 1, svo, hs2, vA2);
            PG8_WAIT_V(8); PG8_WAIT_L(0); PG8_BAR; PG8_MMA(0, 0, At, B0); PG8_MMA(0, 1, At, B1); PG8_BAR; PG8_SCHED;
            PG8_LDA(At, 1, 1); PG8_STAGE(PG8_SB(1, 0), b3, vB2); PG8_STAGE(PG8_SB(1, 1), b3 + hs2, vB2); PG8_STAGE_AX(PG8_SA(1, 0), a3, 0, svo, hs2, vA2);
            PG8_WAIT_V(8); PG8_WAIT_L(0); PG8_BAR; PG8_MMA(1, 0, At, B0); PG8_MMA(1, 1, At, B1); PG8_BAR; PG8_SCHED;
            } else {
            PG8_LDB(B0, 0, 0); PG8_SCHED; PG8_LDA(At, 0, 0); PG8_STAGE_AX(PG8_SA(1, 1), a1, 1, cvo, hs1, vA1);
            PG8_WAIT_L(8); PG8_BAR; PG8_WAIT_L(0); PG8_MMA(0, 0, At, B0); PG8_BAR; PG8_SCHED;
            PG8_LDB(B1, 0, 1); PG8_STAGE(PG8_SB(0, 0), b2, vB2);
            PG8_BAR; PG8_WAIT_L(0); PG8_MMA(0, 1, At, B1); PG8_BAR;
            PG8_LDA(At, 0, 1); PG8_STAGE_AX(PG8_SA(0, 0), a2, 0, svo, hs2, vA2);
            PG8_BAR; PG8_WAIT_L(0); PG8_MMA(1, 0, At, B0); PG8_BAR; PG8_SCHED;
            PG8_STAGE(PG8_SB(0, 1), b2 + hs2, vB2);
            PG8_WAIT_V(6); PG8_BAR; PG8_MMA(1, 1, At, B1); PG8_BAR;
            PG8_LDB(B0, 1, 0); PG8_SCHED; PG8_LDA(At, 1, 0); PG8_STAGE_AX(PG8_SA(0, 1), a2, 1, svo, hs2, vA2);
            PG8_WAIT_L(8); PG8_BAR; PG8_WAIT_L(0); PG8_MMA(0, 0, At, B0); PG8_BAR; PG8_SCHED;
            PG8_LDB(B1, 1, 1); PG8_STAGE(PG8_SB(1, 0), b3, vB2);
            PG8_BAR; PG8_WAIT_L(0); PG8_MMA(0, 1, At, B1); PG8_BAR;
            PG8_LDA(At, 1, 1); PG8_STAGE_AX(PG8_SA(1, 0), a3, 0, svo, hs2, vA2);
            PG8_BAR; PG8_WAIT_L(0); PG8_MMA(1, 0, At, B0); PG8_BAR; PG8_SCHED;
            PG8_STAGE(PG8_SB(1, 1), b3 + hs2, vB2);
            PG8_WAIT_V(6); PG8_BAR; PG8_MMA(1, 1, At, B1); PG8_BAR;
            }
            if constexpr (DUAL) { if (t + 2 == nt1) E.mid(acc, cur, wr, wc, fr, fq); }
        }
        if constexpr (ALIGN_EPI) { if (wr == 0) PG8_BAR; }
        E(acc, cur, wr, wc, fr, fq);
        if (!has_next) break;
#pragma unroll
        for (int a = 0; a < 2; ++a)
#pragma unroll
            for (int b = 0; b < 2; ++b)
#pragma unroll
                for (int m = 0; m < 4; ++m)
#pragma unroll
                    for (int n = 0; n < 2; ++n) acc[a][b][m][n] = (f32x4){0.f, 0.f, 0.f, 0.f};
        cur = nxt; cA = nA; cB = nB; ++ui;
#pragma unroll
        for (int h = 0; h < 2; ++h)
#pragma unroll
            for (int i = 0; i < 2; ++i) cvo[h][i] = nvo[h][i];
        if constexpr (ALIGN_EPI) { if (wr == 1) PG8_BAR; }
    }
    PG8_WAIT_V(0);
    if constexpr (!ALIGN_EPI) { if (wr == 0) PG8_BAR; }
    PG8_BAR;
#undef PG8_SA
#undef PG8_SB
#undef PG8_STAGE
#undef PG8_STAGE_A
#undef PG8_STAGE_AX
#undef PG8_LDA
#undef PG8_LDB
#undef PG8_MMA
#undef PG8_WAIT_V
#undef PG8_WAIT_L
#undef PG8_BAR
#undef PG8_SCHED
#undef PG8_GOFF
}
}

constexpr size_t MiB = 1u << 20;
constexpr size_t WS_CTL = 0, CTL_ZERO_BYTES = 1 * MiB;
constexpr size_t WS_HMETA = 1 * MiB;
constexpr size_t WS_UMETA = WS_HMETA + 128 * 1024;
constexpr size_t WS_KMETA = WS_HMETA + 256 * 1024;
constexpr size_t WS_VMETA = WS_HMETA + 384 * 1024;
constexpr size_t WS_SSMAB = WS_HMETA + 512 * 1024;
constexpr size_t WS_SSMBB = WS_HMETA + 576 * 1024;
constexpr size_t WS_WRT = 2 * MiB;
constexpr size_t WS_WIN = 3 * MiB;
constexpr size_t WS_WGLU = 33 * MiB;
constexpr size_t WS_WBS = 34 * MiB;
constexpr size_t WS_WBA = 36 * MiB;
constexpr size_t WS_WO = 40 * MiB;
constexpr size_t WS_WUP = 48 * MiB;
constexpr size_t WS_WDN = 176 * MiB;
constexpr size_t WS_HBF = 240 * MiB;
constexpr size_t WS_U = 368 * MiB;
constexpr size_t WS_Q = 400 * MiB;
constexpr size_t WS_K = 464 * MiB;
constexpr size_t WS_V = 528 * MiB;
constexpr size_t WS_SGS = 592 * MiB;
constexpr size_t WS_SGA = 720 * MiB;
constexpr size_t WS_YPRE = 848 * MiB;
constexpr size_t WS_YSSM = 880 * MiB;
constexpr size_t WS_YATT = 912 * MiB;
constexpr size_t WS_END = 976 * MiB;
constexpr size_t WS_Z = 368 * MiB;
constexpr size_t WS_H1 = 624 * MiB;
constexpr size_t WS_HB = 752 * MiB;
constexpr size_t WS_YK = 368 * MiB;
constexpr size_t WS_LIST = 848 * MiB;
constexpr size_t WS_WGT = 852 * MiB;
constexpr size_t WS_POSE = 853 * MiB;
constexpr size_t WS_POSW = 854 * MiB;
constexpr int CW_ECNT = 64;
constexpr int CW_CONV = 192;
constexpr int CW_BAR = 4096;

constexpr int RING_BYTES = 131072;
constexpr int MISC_OFF = RING_BYTES;
constexpr int LDS_BYTES = 139264;

#define XB_TMO      128
#define XB_XCNT(j)  (256  + 64 * (j))
#define XB_XSUB(j)  (1280 + 64 * (j))
#define XB_XGEN(j)  (2304 + 64 * (j))
#define XB_TOP      3328
#define XB_TOPGEN   3392
#define XCD_BAR_WORDS 3456
#define XB_SPIN_CAP (1u << 18)
__device__ __forceinline__ unsigned xb_ld(unsigned* p)              { return __hip_atomic_load(p, __ATOMIC_RELAXED, __HIP_MEMORY_SCOPE_AGENT); }
__device__ __forceinline__ unsigned xb_add(unsigned* p, unsigned v) { return __hip_atomic_fetch_add(p, v, __ATOMIC_RELAXED, __HIP_MEMORY_SCOPE_AGENT); }
__device__ __forceinline__ unsigned xb_xcc_id() { return (unsigned)__builtin_amdgcn_s_getreg((3 << 11) | 20) & 0xFu; }
#define XB_SPIN(cond, bar) do { unsigned _sp = 0; while (cond) { __builtin_amdgcn_s_sleep(1); \
    if ((++_sp & 255u) == 0u) { if (xb_ld(&(bar)[XB_TMO])) break; if (_sp > XB_SPIN_CAP) { atomicAdd(&(bar)[XB_TMO], 1u); break; } } } } while (0)
struct XcdBarrier { unsigned* bar; unsigned x; volatile LAS unsigned* st; };
__device__ __forceinline__ XcdBarrier xcd_barrier_post(unsigned* bar, volatile LAS unsigned* st) {
    XcdBarrier b; b.bar = bar; b.x = xb_xcc_id(); b.st = st;
    if (threadIdx.x == 0) (void)xb_add(&bar[XB_XCNT(b.x)], 1u);
    return b;
}
__device__ __forceinline__ void xcd_barrier_complete(unsigned* bar, unsigned x, unsigned& nloc, unsigned& nx) {
    const unsigned G = gridDim.x * gridDim.y * gridDim.z;
    unsigned sum, cnt, mine, sp = 0u;
    for (;;) {
        sum = 0u; cnt = 0u; mine = 0u;
#pragma unroll
        for (unsigned j = 0; j < 16; ++j) { const unsigned c = xb_ld(&bar[XB_XCNT(j)]); sum += c; cnt += (c > 0u) ? 1u : 0u; mine = (j == x) ? c : mine; }
        if (sum == G) break;
        __builtin_amdgcn_s_sleep(1);
        if ((++sp & 255u) == 0u) { if (xb_ld(&bar[XB_TMO])) break; if (sp > XB_SPIN_CAP) { atomicAdd(&bar[XB_TMO], 1u); break; } }
    }
    nloc = mine > 0u ? mine : 1u; nx = cnt > 0u ? cnt : 1u;
}
__device__ __forceinline__ void xcd_barrier(const XcdBarrier& b) {
    asm volatile("s_waitcnt vmcnt(0)" ::: "memory");
    __syncthreads();
    if (threadIdx.x == 0) {
        unsigned* bar = b.bar;
        __builtin_amdgcn_s_waitcnt(0);
        unsigned nloc = b.st[0], nx = b.st[1];
        if (nloc == 0u) { xcd_barrier_complete(bar, b.x, nloc, nx); b.st[0] = nloc; b.st[1] = nx; }
        const unsigned old = xb_add(&bar[XB_XSUB(b.x)], 1u);
        const unsigned gen = old / nloc;
        if (old + 1u == (gen + 1u) * nloc) {
            __builtin_amdgcn_fence(__ATOMIC_RELEASE, "agent");
            asm volatile("s_waitcnt vmcnt(0)" ::: "memory");
            const unsigned og = xb_add(&bar[XB_TOP], 1u);
            const unsigned tg = og / nx;
            if (og + 1u == (tg + 1u) * nx) xb_add(&bar[XB_TOPGEN], 1u);
            else XB_SPIN(xb_ld(&bar[XB_TOPGEN]) == tg, bar);
            __builtin_amdgcn_fence(__ATOMIC_ACQUIRE, "agent");
            xb_add(&bar[XB_XGEN(b.x)], 1u);
            asm volatile("s_waitcnt vmcnt(0)" ::: "memory");
        } else {
            XB_SPIN(xb_ld(&bar[XB_XGEN(b.x)]) == gen, bar);
            __builtin_amdgcn_fence(__ATOMIC_ACQUIRE, "agent");
            asm volatile("s_waitcnt vmcnt(0)" ::: "memory");
        }
    }
    __syncthreads();
}

using pg8::Unit;
__device__ __forceinline__ u32x4 pack8(const f32x4 v0, const f32x4 v1) { u32x4 w; w.x = cvt_pk_bf16(v0[0], v0[1]); w.y = cvt_pk_bf16(v0[2], v0[3]); w.z = cvt_pk_bf16(v1[0], v1[1]); w.w = cvt_pk_bf16(v1[2], v1[3]); return w; }
__device__ __forceinline__ void unpack8(const u32x4 w, f32x4& v0, f32x4& v1) { v0 = (f32x4){bf_lo(w.x), bf_hi(w.x), bf_lo(w.y), bf_hi(w.y)}; v1 = (f32x4){bf_lo(w.z), bf_hi(w.z), bf_lo(w.w), bf_hi(w.w)}; }

struct EpiProj {
    static constexpr bool PERM = true;
    bf16_t *U, *Q, *K, *V, *RHO, *SGA;
    __device__ __forceinline__ void operator()(const f32x4 (&acc)[2][2][4][2], const Unit& u, int wr, int wc, int fr, int fq) const {
        const int pn = u.pn;
        if (pn >= 14) {
            const int row0 = u.pm * 256 + wr * 64 + fr, col0 = (pn - 14) * 128 + wc * 32 + 8 * fq;
#pragma unroll
            for (int ai = 0; ai < 2; ++ai)
#pragma unroll
                for (int m = 0; m < 4; ++m) { const size_t off = (size_t)(row0 + ai * 128 + m * 16) * DM + col0; f32x4 r0, r1, a0, a1;
#pragma unroll
                    for (int j = 0; j < 4; ++j) { const float es0 = __expf(-acc[ai][0][m][0][j]), es1 = __expf(-acc[ai][0][m][1][j]), ea0 = __expf(-acc[ai][1][m][0][j]), ea1 = __expf(-acc[ai][1][m][1][j]);
                        a0[j] = __builtin_amdgcn_rcpf(1.f + ea0); a1[j] = __builtin_amdgcn_rcpf(1.f + ea1);
                        r0[j] = (1.f + ea0) * __builtin_amdgcn_rcpf(1.f + es0); r1[j] = (1.f + ea1) * __builtin_amdgcn_rcpf(1.f + es1); }
                    *(u32x4*)(RHO + off) = pack8(r0, r1); *(u32x4*)(SGA + off) = pack8(a0, a1); }
            return;
        }
        bf16_t* base; int ldc, ct, mode;
        if (pn < 2) { base = U; ldc = 512; ct = pn; mode = 0; }
        else if (pn < 6) { base = Q; ldc = 1024; ct = pn - 2; mode = 1; }
        else if (pn < 10) { base = K; ldc = 1024; ct = pn - 6; mode = 0; }
        else { base = V; ldc = 1024; ct = pn - 10; mode = 0; }
        const int row0 = u.pm * 256 + wr * 64 + fr, col0 = ct * 256 + wc * 32 + 8 * fq;
#pragma unroll
        for (int ai = 0; ai < 2; ++ai)
#pragma unroll
            for (int m = 0; m < 4; ++m) { bf16_t* rowp = base + (size_t)(row0 + ai * 128 + m * 16) * ldc + col0;
#pragma unroll
                for (int bj = 0; bj < 2; ++bj) { f32x4 v0 = acc[ai][bj][m][0], v1 = acc[ai][bj][m][1];
                    if (mode == 1) { v0 = v0 * QSCALE; v1 = v1 * QSCALE; }
                    *(u32x4*)(rowp + bj * 128) = pack8(v0, v1); } }
    }
};
struct EpiGlu {
    static constexpr bool PERM = true;
    const bf16_t* YPRE; bf16_t* YSSM;
    __device__ __forceinline__ void operator()(const f32x4 (&acc)[2][2][4][2], const Unit& u, int wr, int wc, int fr, int fq) const {
        const int row0 = u.pm * 256 + wr * 64 + fr, col0 = u.pn * 256 + wc * 32 + 8 * fq;
#pragma unroll
        for (int ai = 0; ai < 2; ++ai)
#pragma unroll
            for (int m = 0; m < 4; ++m) { const size_t off = (size_t)(row0 + ai * 128 + m * 16) * SSMW + col0;
#pragma unroll
                for (int bj = 0; bj < 2; ++bj) { const u32x4 yw = *(const u32x4*)(YPRE + off + bj * 128); f32x4 y0, y1; unpack8(yw, y0, y1);
                    f32x4 v0 = acc[ai][bj][m][0], v1 = acc[ai][bj][m][1];
#pragma unroll
                    for (int j = 0; j < 4; ++j) { v0[j] = y0[j] * sigmoidf_(v0[j]); v1[j] = y1[j] * sigmoidf_(v1[j]); }
                    *(u32x4*)(YSSM + off + bj * 128) = pack8(v0, v1); } }
    }
};
template <int SECOND> struct EpiMerge {
    static constexpr bool PERM = true;
    const bf16_t* SG; bf16_t* MG;
    __device__ __forceinline__ void operator()(const f32x4 (&acc)[2][2][4][2], const Unit& u, int wr, int wc, int fr, int fq) const {
        const int row0 = u.pm * 256 + wr * 64 + fr, col0 = u.pn * 256 + wc * 32 + 8 * fq;
#pragma unroll
        for (int ai = 0; ai < 2; ++ai)
#pragma unroll
            for (int m = 0; m < 4; ++m) { const size_t off = (size_t)(row0 + ai * 128 + m * 16) * DM + col0;
#pragma unroll
                for (int bj = 0; bj < 2; ++bj) { const u32x4 gw = *(const u32x4*)(SG + off + bj * 128); f32x4 g0, g1; unpack8(gw, g0, g1);
                    f32x4 v0 = acc[ai][bj][m][0] * g0, v1 = acc[ai][bj][m][1] * g1;
                    if (SECOND) { const u32x4 pw = *(const u32x4*)(MG + off + bj * 128); f32x4 p0, p1; unpack8(pw, p0, p1); v0 = v0 + p0; v1 = v1 + p1; }
                    *(u32x4*)(MG + off + bj * 128) = pack8(v0, v1); } }
    }
};
struct EpiMergeF {
    static constexpr bool PERM = true;
    const bf16_t* SGS; const bf16_t* SGA; bf16_t* MG;
    __device__ __forceinline__ void mid(f32x4 (&acc)[2][2][4][2], const Unit& u, int wr, int wc, int fr, int fq) const {
        asm volatile("" : "+v"(fr), "+v"(fq));
        const int row0 = u.pm * 256 + wr * 64 + fr, col0 = u.pn * 256 + wc * 32 + 8 * fq;
        const bf16_t* sp = SGS + (size_t)row0 * DM + col0;
        u32x4 sw[2][2];
        sw[0][0] = *(const u32x4*)(sp); sw[0][1] = *(const u32x4*)(sp + 128);
#pragma unroll
        for (int g = 0; g < 8; ++g) { const int ai = g >> 2, m = g & 3;
            if (g < 7) { const int g1 = g + 1; const bf16_t* sq = sp + (size_t)((g1 >> 2) * 128 + (g1 & 3) * 16) * DM;
                sw[g1 & 1][0] = *(const u32x4*)(sq); sw[g1 & 1][1] = *(const u32x4*)(sq + 128); }
            asm volatile("" ::: "memory");
#pragma unroll
            for (int bj = 0; bj < 2; ++bj) { f32x4 s0, s1; unpack8(sw[g & 1][bj], s0, s1);
                acc[ai][bj][m][0] = acc[ai][bj][m][0] * s0; acc[ai][bj][m][1] = acc[ai][bj][m][1] * s1; }
        }
    }
    __device__ __forceinline__ void operator()(const f32x4 (&acc)[2][2][4][2], const Unit& u, int wr, int wc, int fr, int fq) const {
        const int row0 = u.pm * 256 + wr * 64 + fr, col0 = u.pn * 256 + wc * 32 + 8 * fq;
#pragma unroll
        for (int ai = 0; ai < 2; ++ai)
#pragma unroll
            for (int m = 0; m < 4; ++m) { const size_t off = (size_t)(row0 + ai * 128 + m * 16) * DM + col0;
#pragma unroll
                for (int bj = 0; bj < 2; ++bj) { const u32x4 gw = *(const u32x4*)(SGA + off + bj * 128); f32x4 g0, g1; unpack8(gw, g0, g1);
                    *(u32x4*)(MG + off + bj * 128) = pack8(acc[ai][bj][m][0] * g0, acc[ai][bj][m][1] * g1); } }
    }
};
struct EpiZ {
    static constexpr bool PERM = true;
    const bf16_t* HBF; bf16_t* Z;
    __device__ __forceinline__ void operator()(const f32x4 (&acc)[2][2][4][2], const Unit& u, int wr, int wc, int fr, int fq) const {
        const int row0 = u.pm * 256 + wr * 64 + fr, col0 = u.pn * 256 + wc * 32 + 8 * fq;
#pragma unroll
        for (int ai = 0; ai < 2; ++ai)
#pragma unroll
            for (int m = 0; m < 4; ++m) { const size_t off = (size_t)(row0 + ai * 128 + m * 16) * DM + col0;
#pragma unroll
                for (int bj = 0; bj < 2; ++bj) { const u32x4 hw = *(const u32x4*)(HBF + off + bj * 128); f32x4 h0, h1; unpack8(hw, h0, h1);
                    *(u32x4*)(Z + off + bj * 128) = pack8(acc[ai][bj][m][0] + h0 * ALPHA, acc[ai][bj][m][1] + h1 * ALPHA); } }
    }
};
struct EpiSwiglu {
    static constexpr bool PERM = true;
    bf16_t* HB; const int* LIST; const float* WGT; int* POSE; float* POSW;
    __device__ __forceinline__ void operator()(const f32x4 (&acc)[2][2][4][2], const Unit& u, int wr, int wc, int fr, int fq) const {
        const int row0 = u.pm * 256 + wr * 64 + fr, col0 = (u.pn & 3) * 128 + wc * 32 + 8 * fq;
#pragma unroll
        for (int ai = 0; ai < 2; ++ai)
#pragma unroll
            for (int m = 0; m < 4; ++m) { f32x4 v0, v1;
#pragma unroll
                for (int j = 0; j < 4; ++j) { const float g0 = acc[ai][0][m][0][j], g1 = acc[ai][0][m][1][j];
                    v0[j] = g0 * sigmoidf_(g0) * acc[ai][1][m][0][j]; v1[j] = g1 * sigmoidf_(g1) * acc[ai][1][m][1][j]; }
                *(u32x4*)(HB + (size_t)(row0 + ai * 128 + m * 16) * DFF + col0) = pack8(v0, v1); }
        if ((u.pn & 3) == 0 && wc == 0 && fq == 0) {
#pragma unroll
            for (int ai = 0; ai < 2; ++ai)
#pragma unroll
                for (int m = 0; m < 4; ++m) { const int r = wr * 64 + fr + ai * 128 + m * 16, slot = u.s0 + r; int entry = -1; float w = 0.f;
                    if (slot < u.cnt) { entry = LIST[(size_t)u.e * CAP + slot]; w = WGT[entry]; }
                    POSE[u.pm * 256 + r] = entry; POSW[u.pm * 256 + r] = w; }
        }
    }
};
struct EpiDown {
    static constexpr bool PERM = true;
    const int* POSE; const float* POSW; bf16_t* YK;
    __device__ __forceinline__ void operator()(const f32x4 (&acc)[2][2][4][2], const Unit& u, int wr, int wc, int fr, int fq) const {
        const int r0 = u.pm * 256 + wr * 64 + fr, col0 = (u.pn & 7) * 256 + wc * 32 + 8 * fq;
        int en[2][4]; float ww[2][4];
#pragma unroll
        for (int ai = 0; ai < 2; ++ai)
#pragma unroll
            for (int m = 0; m < 4; ++m) { en[ai][m] = POSE[r0 + ai * 128 + m * 16]; ww[ai][m] = POSW[r0 + ai * 128 + m * 16]; }
#pragma unroll
        for (int ai = 0; ai < 2; ++ai)
#pragma unroll
            for (int m = 0; m < 4; ++m) {
                if (en[ai][m] >= 0) { const float w = ww[ai][m]; bf16_t* rowp = YK + (size_t)en[ai][m] * DM + col0;
#pragma unroll
                    for (int bj = 0; bj < 2; ++bj) *(u32x4*)(rowp + bj * 128) = pack8(acc[ai][bj][m][0] * w, acc[ai][bj][m][1] * w); } }
    }
};
struct MoeOrder {
    int G, c, shift, NB; const LAS int* blkexp; const LAS int* blkstart; const LAS int* cntE; const int* LIST;
    __device__ __forceinline__ bool next(int i, Unit& u) const {
        const long L = (long)i * G + c; if (L >= ((long)NB << shift)) return false;
        const int blk = (int)(L >> shift), tile = (int)(L & ((1 << shift) - 1)), e = blkexp[blk];
        u.pm = blk; u.pn = (e << shift) + tile; u.e = e; u.s0 = (blk - blkstart[e]) * 256; u.cnt = cntE[e]; return true;
    }
    __device__ __forceinline__ int arow(const Unit& u, int r) const { const int slot = u.s0 + r; const int entry = slot < u.cnt ? LIST[(size_t)u.e * CAP + slot] : 0; return entry >> 1; }
};

struct Ctx { LAS unsigned char* lds; int tid, lane, wave, vcu, G; };

__device__ __forceinline__ void transpose_item(const float* W, int K, int N, bf16_t* WT, int kb, int nb, int dst_row0, LAS float* scr, int lane) {
    const int k0 = 64 * kb, n0 = 32 * nb;
    float tv[32];
#pragma unroll
    for (int i = 0; i < 32; ++i) tv[i] = W[(size_t)(k0 + 2 * i + (lane >> 5)) * N + n0 + (lane & 31)];
#pragma unroll
    for (int i = 0; i < 32; ++i) scr[(2 * i + (lane >> 5)) * 33 + (lane & 31)] = tv[i];
    asm volatile("s_waitcnt lgkmcnt(0)" ::: "memory");
    const int c = lane & 7;
#pragma unroll
    for (int j = 0; j < 4; ++j) { const int n = (lane >> 3) + 8 * j; const LAS float* s = scr + (8 * c) * 33 + n;
        u32x4 o; o.x = cvt_pk_bf16(s[0 * 33], s[1 * 33]); o.y = cvt_pk_bf16(s[2 * 33], s[3 * 33]); o.z = cvt_pk_bf16(s[4 * 33], s[5 * 33]); o.w = cvt_pk_bf16(s[6 * 33], s[7 * 33]);
        *(u32x4*)(WT + (size_t)(dst_row0 + n) * K + k0 + 8 * c) = o; }
    asm volatile("s_waitcnt lgkmcnt(0)" ::: "memory");
}
__device__ __forceinline__ void ln_stats(f32x4 (&v)[8], float& mean, float& rstd) {
    float s = 0.f;
#pragma unroll
    for (int j = 0; j < 8; ++j) s += (v[j].x + v[j].y) + (v[j].z + v[j].w);
    mean = wave_sum(s) * (1.f / DM); float s2 = 0.f;
#pragma unroll
    for (int j = 0; j < 8; ++j) { const f32x4 d = v[j] - mean; s2 += (d.x * d.x + d.y * d.y) + (d.z * d.z + d.w * d.w); }
    rstd = 1.f / sqrtf(wave_sum(s2) * (1.f / DM) + LN_EPS);
}

__device__ __forceinline__ void p0_prologue(const Ctx& C, const float* const* in, unsigned char* ws) {
    LAS float* scr = (LAS float*)(C.lds + C.wave * 16384);
    const int gw = C.vcu * 8 + C.wave, NGW = C.G * 8;
    bf16_t* WinT = (bf16_t*)(ws + WS_WIN); bf16_t* WgluT = (bf16_t*)(ws + WS_WGLU); bf16_t* WbsT = (bf16_t*)(ws + WS_WBS); bf16_t* WbaT = (bf16_t*)(ws + WS_WBA);
    bf16_t* WoT = (bf16_t*)(ws + WS_WO); bf16_t* WupT = (bf16_t*)(ws + WS_WUP);
    constexpr int I_WIN = (DM / 64) * (INC / 32), I_GLU = (SSMW / 64) * (SSMW / 32), I_BS = (SSMW / 64) * (DM / 32), I_BA = (AW / 64) * (DM / 32), I_WO = (DM / 64) * (DM / 32);
    constexpr int I_EXP = NE * 512;
    constexpr int NITEMS = I_WIN + I_GLU + I_BS + I_BA + I_WO + 2 * I_EXP;
    for (int it = gw; it < NITEMS; it += NGW) {
        int r = it;
        if (r < I_WIN) { const int nblk = INC / 32, nb = r % nblk, n0 = 32 * nb;
            const int drow = n0 < 3584 ? n0 : (n0 < 5632 ? 3584 + ((n0 - 3584) >> 7) * 256 + ((n0 - 3584) & 127) : 3584 + ((n0 - 5632) >> 7) * 256 + 128 + ((n0 - 5632) & 127));
            transpose_item(in[4], DM, INC, WinT, r / nblk, nb, drow, scr, C.lane); continue; } r -= I_WIN;
        if (r < I_GLU) { const int nblk = SSMW / 32; transpose_item(in[13], SSMW, SSMW, WgluT, r / nblk, r % nblk, 32 * (r % nblk), scr, C.lane); continue; } r -= I_GLU;
        if (r < I_BS) { const int nblk = DM / 32; transpose_item(in[19], SSMW, DM, WbsT, r / nblk, r % nblk, 32 * (r % nblk), scr, C.lane); continue; } r -= I_BS;
        if (r < I_BA) { const int nblk = DM / 32; transpose_item(in[20], AW, DM, WbaT, r / nblk, r % nblk, 32 * (r % nblk), scr, C.lane); continue; } r -= I_BA;
        if (r < I_WO) { const int nblk = DM / 32; transpose_item(in[21], DM, DM, WoT, r / nblk, r % nblk, 32 * (r % nblk), scr, C.lane); continue; } r -= I_WO;
        if (r < 2 * I_EXP) { const int up = r >= I_EXP ? 1 : 0; r -= up * I_EXP; const int e = r >> 9, rr = r & 511, kb = rr >> 4, nb = rr & 15, n0 = 32 * nb;
            transpose_item(in[28 + up] + (size_t)e * DM * DFF, DM, DFF, WupT, kb, nb, e * 1024 + (n0 >> 7) * 256 + up * 128 + (n0 & 127), scr, C.lane); continue; }
    }
    const int gt = C.vcu * 512 + C.tid, NGT = C.G * 512;
    { float* WrT = (float*)(ws + WS_WRT);
      for (int i = gt; i < 36 * DM; i += NGT) { const int n = i / DM, k = i % DM; WrT[i] = n < 4 ? in[24][k * 4 + n] : in[26][k * 32 + (n - 4)]; } }
    { u32x4* kz = (u32x4*)(ws + WS_KMETA + 16 * 1024 * 2); u32x4* vz = (u32x4*)(ws + WS_VMETA + 16 * 1024 * 2);
      for (int i = gt; i < 48 * 1024 * 2 / 16; i += NGT) { kz[i] = (u32x4){0u, 0u, 0u, 0u}; vz[i] = (u32x4){0u, 0u, 0u, 0u}; } }
    { float* AB = (float*)(ws + WS_SSMAB); float* BB = (float*)(ws + WS_SSMBB);
      for (int i = gt; i < NGRP * NST; i += NGT) { const int g = i >> 6;
        const double lre = fmin((double)in[5][i], -1e-4), lim = (double)in[6][i], dt = exp((double)in[7][g]);
        const double mag = exp(lre * dt), abr = mag * cos(lim * dt), abi = mag * sin(lim * dt), den = lre * lre + lim * lim, nr = abr - 1.0, ni = abi;
        const double zr = (nr * lre + ni * lim) / den, zi = (ni * lre - nr * lim) / den;
        AB[i] = (float)abr; AB[NGRP * NST + i] = (float)abi;
#pragma unroll 4
        for (int c = 0; c < 16; ++c) { const double br = (double)in[8][i * 16 + c], bi = (double)in[9][i * 16 + c];
            BB[i * 16 + c] = (float)(zr * br - zi * bi); BB[NGRP * NST * 16 + i * 16 + c] = (float)(zr * bi + zi * br); } } }
    const float* lg = in[2]; const float* lb = in[3];
    bf16_t* HBF = (bf16_t*)(ws + WS_HBF);
    for (int m = gw; m < T + NMETA; m += 2 * NGW) {
        const int m2 = (m + NGW < T + NMETA) ? m + NGW : m;
        const float* xa = m >= T ? in[1] + (size_t)(m - T) * DM : in[0] + (size_t)m * DM; const float* xb = m2 >= T ? in[1] + (size_t)(m2 - T) * DM : in[0] + (size_t)m2 * DM;
        f32x4 va[8], vb[8];
#pragma unroll
        for (int j = 0; j < 8; ++j) { va[j] = *(const f32x4*)(xa + 256 * j + 4 * C.lane); vb[j] = *(const f32x4*)(xb + 256 * j + 4 * C.lane); }
        float meana, rstda, meanb, rstdb; ln_stats(va, meana, rstda); ln_stats(vb, meanb, rstdb);
#pragma unroll
        for (int rr = 0; rr < 2; ++rr) { const int mm = rr ? m2 : m; if (rr == 1 && m2 == m) break; const bool meta = mm >= T;
#pragma unroll
            for (int j = 0; j < 8; ++j) { const f32x4 gg = *(const f32x4*)(lg + 256 * j + 4 * C.lane), bb = *(const f32x4*)(lb + 256 * j + 4 * C.lane);
                const f32x4 o = rr ? (vb[j] - meanb) * rstdb * gg + bb : (va[j] - meana) * rstda * gg + bb;
                if (meta) *(f32x4*)((float*)(ws + WS_HMETA) + (size_t)(mm - T) * DM + 256 * j + 4 * C.lane) = o;
                else { u32x2 w; w.x = cvt_pk_bf16(o.x, o.y); w.y = cvt_pk_bf16(o.z, o.w); *(u32x2*)(HBF + (size_t)mm * DM + 256 * j + 4 * C.lane) = w; } } }
    }
}

__device__ __forceinline__ void p1_meta_proj(const Ctx& C, unsigned char* ws) {
    const bf16_t* WinT = (const bf16_t*)(ws + WS_WIN); const float* HM = (const float*)(ws + WS_HMETA);
    const int gw = C.vcu * 8 + C.wave, NGW = C.G * 8;
    for (int it = gw; it < 640; it += NGW) {
        const int nidx = 4 * it; const int col0 = nidx < 512 ? nidx : (nidx < 1536 ? 1536 + (nidx - 512) : 2560 + (nidx - 1536));
        float acc[16][4];
#pragma unroll
        for (int r = 0; r < 16; ++r)
#pragma unroll
            for (int c = 0; c < 4; ++c) acc[r][c] = 0.f;
#pragma unroll 1
        for (int j = 0; j < 4; ++j) { const int k0 = j * 512 + C.lane * 8;
            f32x4 w0[4], w1[4];
#pragma unroll
            for (int c = 0; c < 4; ++c) { const u32x4 ww = *(const u32x4*)(WinT + (size_t)(col0 + c) * DM + k0); unpack8(ww, w0[c], w1[c]); }
#pragma unroll
            for (int r = 0; r < 16; ++r) { const f32x4 h0 = *(const f32x4*)(HM + r * DM + k0), h1 = *(const f32x4*)(HM + r * DM + k0 + 4);
#pragma unroll
                for (int c = 0; c < 4; ++c) { const f32x4 p = h0 * w0[c] + h1 * w1[c]; acc[r][c] += (p.x + p.y) + (p.z + p.w); } } }
        float mine = 0.f;
#pragma unroll
        for (int r = 0; r < 16; ++r)
#pragma unroll
            for (int c = 0; c < 4; ++c) { const float s = wave_sum(acc[r][c]); mine = (C.lane == r * 4 + c) ? s : mine; }
        const int r = C.lane >> 2, c = C.lane & 3;
        if (nidx < 512) ((float*)(ws + WS_UMETA))[r * SSMW + nidx + c] = mine;
        else if (nidx < 1536) ((bf16_t*)(ws + WS_KMETA))[r * AW + (nidx - 512) + c] = (bf16_t)(cvt_pk_bf16(mine, 0.f) & 0xffffu);
        else ((bf16_t*)(ws + WS_VMETA))[r * AW + (nidx - 1536) + c] = (bf16_t)(cvt_pk_bf16(mine, 0.f) & 0xffffu);
    }
}

__device__ __forceinline__ float gelu_tanh(float x) { const float u = 1.5957691216057308f * (x + 0.044715f * x * x * x); return x * __builtin_amdgcn_rcpf(1.0f + __expf(-u)); }
template <bool STORE> __device__ __forceinline__ void scan16(f32x16 (&bu)[4], float (&sre)[2], float (&sim)[2], const float (&are)[2], const float (&aim)[2]) {
#pragma unroll
    for (int reg = 0; reg < 16; ++reg)
#pragma unroll
        for (int st = 0; st < 2; ++st) {
            const float nre = __builtin_fmaf(are[st], sre[st], __builtin_fmaf(-aim[st], sim[st], bu[st][reg]));
            const float nim = __builtin_fmaf(are[st], sim[st], __builtin_fmaf(aim[st], sre[st], bu[2 + st][reg]));
            sre[st] = nre; sim[st] = nim;
            if (STORE) { bu[st][reg] = nre; bu[2 + st][reg] = nim; } }
}
__device__ __forceinline__ void p2_scan(const Ctx& C, const float* const* in, unsigned char* ws) {
    const int lane = C.lane, wave = C.wave, r32 = lane & 31, hi = lane >> 5, fr = lane & 15, fq = lane >> 4;
    const bf16_t* U = (const bf16_t*)(ws + WS_U); const float* UM = (const float*)(ws + WS_UMETA); bf16_t* YPRE = (bf16_t*)(ws + WS_YPRE);
    const float* AB = (const float*)(ws + WS_SSMAB); const float* BB = (const float*)(ws + WS_SSMBB);
    LAS unsigned char* Sl = C.lds + wave * 10752;
    LAS unsigned char* Yl = Sl + 9728;
    LAS float* E = (LAS float*)(C.lds + 86016);
    const int hc = 2 * wave + hi;
    const int urow = ((r32 >> 2) & 1) * 128 + (r32 & 3) + 4 * (r32 >> 3);
    for (int item = C.vcu; item < NB_ * NGRP; item += C.G) {
        const int b = item >> 5, g = item & 31;
        const bf16_t* Ub = U + ((size_t)b * SEQ + wave * 256) * SSMW + 16 * g;
        bf16x8 ufa[8];
#pragma unroll
        for (int blk = 0; blk < 8; ++blk) ufa[blk] = *(const bf16x8*)(Ub + (size_t)(16 * blk + urow) * SSMW + 8 * hi);
        float are[2], aim[2];
#pragma unroll
        for (int st = 0; st < 2; ++st) { are[st] = AB[g * 64 + 32 * st + r32]; aim[st] = AB[NGRP * NST + g * 64 + 32 * st + r32]; }
        bf16x8 Bf[4];
#pragma unroll
        for (int ri = 0; ri < 2; ++ri)
#pragma unroll
            for (int st = 0; st < 2; ++st) { const float* src = BB + ri * (NGRP * NST * 16) + (g * 64 + 32 * st + r32) * 16 + 8 * hi;
                const f32x4 x0 = *(const f32x4*)src, x1 = *(const f32x4*)(src + 4); Bf[2 * ri + st] = __builtin_bit_cast(bf16x8, pack8(x0, x1)); }
        bf16x8 Cf[5];
#pragma unroll
        for (int ks = 0; ks < 4; ++ks) { const int r0 = 8 * ks + 2 * fq; const float* cre = in[10] + (g * 16 + fr) * 64; const float* cim = in[11] + (g * 16 + fr) * 64;
            const f32x4 x0 = (f32x4){cre[r0], cre[32 + r0], -cim[r0], -cim[32 + r0]}, x1 = (f32x4){cre[r0 + 1], cre[33 + r0], -cim[r0 + 1], -cim[33 + r0]};
            Cf[ks] = __builtin_bit_cast(bf16x8, pack8(x0, x1)); }
        { const float dsk = in[12][g * 16 + fr]; f32x4 x0, x1;
#pragma unroll
          for (int j = 0; j < 4; ++j) { x0[j] = (fq < 2 && 8 * fq + j == fr) ? dsk : 0.f; x1[j] = (fq < 2 && 8 * fq + 4 + j == fr) ? dsk : 0.f; }
          Cf[4] = __builtin_bit_cast(bf16x8, pack8(x0, x1)); }
        float sre[2] = {0.f, 0.f}, sim[2] = {0.f, 0.f}, mre[2] = {0.f, 0.f}, mim[2] = {0.f, 0.f};
        if (wave == 0) {
            f32x4 x0 = (f32x4){0.f, 0.f, 0.f, 0.f}, x1 = x0;
            if (((r32 >> 2) & 1) == 0) { const float* src = UM + ((r32 & 3) + 4 * (r32 >> 3)) * SSMW + 16 * g + 8 * hi; x0 = *(const f32x4*)src; x1 = *(const f32x4*)(src + 4); }
            const bf16x8 uf = __builtin_bit_cast(bf16x8, pack8(x0, x1));
            f32x16 bu[4];
#pragma unroll
            for (int t = 0; t < 4; ++t) bu[t] = __builtin_amdgcn_mfma_f32_32x32x16_bf16(uf, Bf[t], (f32x16){}, 0, 0, 0);
            scan16<false>(bu, sre, sim, are, aim);
            mre[0] = sre[0]; mre[1] = sre[1]; mim[0] = sim[0]; mim[1] = sim[1];
        }
#pragma unroll
        for (int blk = 0; blk < 8; ++blk) {
            f32x16 bu[4];
#pragma unroll
            for (int t = 0; t < 4; ++t) bu[t] = __builtin_amdgcn_mfma_f32_32x32x16_bf16(ufa[blk], Bf[t], (f32x16){}, 0, 0, 0);
            scan16<false>(bu, sre, sim, are, aim);
        }
#pragma unroll
        for (int st = 0; st < 2; ++st) { E[hc * 128 + st * 64 + r32] = sre[st]; E[hc * 128 + st * 64 + 32 + r32] = sim[st]; }
        __syncthreads();
        {
            float pr[2], pi[2], cr[2], ci[2];
#pragma unroll
            for (int st = 0; st < 2; ++st) { pr[st] = are[st]; pi[st] = aim[st];
#pragma unroll
                for (int k = 0; k < 7; ++k) { const float nr = pr[st] * pr[st] - pi[st] * pi[st], ni = 2.f * pr[st] * pi[st]; pr[st] = nr; pi[st] = ni; }
                cr[st] = E[st * 64 + r32]; ci[st] = E[st * 64 + 32 + r32]; }
            for (int j = 1; j < 2 * wave + 1; ++j) {
                const bool on = j < hc;
#pragma unroll
                for (int st = 0; st < 2; ++st) { const float er = E[j * 128 + st * 64 + r32], ei = E[j * 128 + st * 64 + 32 + r32];
                    const float nr = pr[st] * cr[st] - pi[st] * ci[st] + er, ni = pr[st] * ci[st] + pi[st] * cr[st] + ei; cr[st] = on ? nr : cr[st]; ci[st] = on ? ni : ci[st]; } }
#pragma unroll
            for (int st = 0; st < 2; ++st) { sre[st] = hc == 0 ? mre[st] : cr[st]; sim[st] = hc == 0 ? mim[st] : ci[st]; }
        }
#pragma unroll
        for (int blk = 0; blk < 8; ++blk) {
            f32x16 bu[4];
#pragma unroll
            for (int t = 0; t < 4; ++t) bu[t] = __builtin_amdgcn_mfma_f32_32x32x16_bf16(ufa[blk], Bf[t], (f32x16){}, 0, 0, 0);
            scan16<true>(bu, sre, sim, are, aim);
#pragma unroll
            for (int reg = 0; reg < 16; ++reg) { const int row = (reg & 3) + 8 * (reg >> 2) + 4 * hi;
                u32x2 w; w.x = cvt_pk_bf16(bu[0][reg], bu[1][reg]); w.y = cvt_pk_bf16(bu[2][reg], bu[3][reg]);
                *(LAS u32x2*)(Sl + row * 304 + r32 * 8) = w; }
            *(LAS bf16x8*)(Sl + r32 * 304 + (128 + 8 * hi) * 2) = ufa[blk];
            f32x4 y[2];
#pragma unroll
            for (int mt = 0; mt < 2; ++mt) { y[mt] = (f32x4){0.f, 0.f, 0.f, 0.f};
#pragma unroll
                for (int ks = 0; ks < 4; ++ks) { const bf16x8 af = *(const LAS bf16x8*)(Sl + (16 * mt + fr) * 304 + (32 * ks + 8 * fq) * 2);
                    y[mt] = __builtin_amdgcn_mfma_f32_16x16x32_bf16(af, Cf[ks], y[mt], 0, 0, 0); }
                bf16x8 au = *(const LAS bf16x8*)(Sl + (16 * mt + fr) * 304 + (128 + 8 * (fq & 1)) * 2); if (fq >= 2) au = (bf16x8){};
                y[mt] = __builtin_amdgcn_mfma_f32_16x16x32_bf16(au, Cf[4], y[mt], 0, 0, 0); }
#pragma unroll
            for (int mt = 0; mt < 2; ++mt)
#pragma unroll
                for (int reg = 0; reg < 4; ++reg) *(LAS bf16_t*)(Yl + (16 * mt + 4 * fq + reg) * 32 + fr * 2) = (bf16_t)(cvt_pk_bf16(gelu_tanh(y[mt][reg]), 0.f) & 0xffffu);
            const u32x4 yo = *(const LAS u32x4*)(Yl + (lane >> 1) * 32 + (lane & 1) * 16);
            { const int row = lane >> 1, tok = ((row >> 2) & 1) * 128 + 16 * blk + (row & 3) + 4 * (row >> 3);
              *(u32x4*)(YPRE + ((size_t)b * SEQ + wave * 256 + tok) * SSMW + 16 * g + 8 * (lane & 1)) = yo; }
        }
        __syncthreads();
    }
}

__device__ __forceinline__ int crow(int r, int hi) { return (r & 3) + 8 * (r >> 2) + 4 * hi; }
typedef short v4i16_t __attribute__((ext_vector_type(4)));
__device__ __forceinline__ s16x4 vtr(const LAS unsigned char* p) { return __builtin_bit_cast(s16x4, __builtin_amdgcn_ds_read_tr16_b64_v4i16((LAS v4i16_t*)p)); }
__device__ __forceinline__ float half_swap_max(float x) { auto rr = __builtin_amdgcn_permlane32_swap(__float_as_uint(x), __float_as_uint(x), false, false); return fmaxf(__uint_as_float(rr[0]), __uint_as_float(rr[1])); }
__device__ __forceinline__ float half_swap_sum(float x) { auto rr = __builtin_amdgcn_permlane32_swap(__float_as_uint(x), __float_as_uint(x), false, false); return __uint_as_float(rr[0]) + __uint_as_float(rr[1]); }

__device__ __forceinline__ void attn_pv(f32x16 (&o)[4], const bf16x8 (&pa)[4], unsigned vaddr) {
    s16x4 vl[2][4], vh[2][4];
#define ATT_VRD(SET, D) do { _Pragma("unroll") for (int ks_ = 0; ks_ < 4; ++ks_) { \
        asm volatile("ds_read_b64_tr_b16 %0, %1 offset:%2" : "=&v"(vl[SET][ks_]) : "v"(vaddr), "i"((D) * 4096 + ks_ * 1024) : "memory"); \
        asm volatile("ds_read_b64_tr_b16 %0, %1 offset:%2" : "=&v"(vh[SET][ks_]) : "v"(vaddr), "i"((D) * 4096 + ks_ * 1024 + 512) : "memory"); } } while (0)
    __builtin_amdgcn_sched_barrier(0);
    ATT_VRD(0, 0);
#pragma unroll
    for (int d = 0; d < 4; ++d) {
        if (d == 0) { ATT_VRD(1, 1); } else if (d == 1) { ATT_VRD(0, 2); } else if (d == 2) { ATT_VRD(1, 3); }
        if (d < 3) asm volatile("s_waitcnt lgkmcnt(8)" ::: "memory"); else asm volatile("s_waitcnt lgkmcnt(0)" ::: "memory");
        __builtin_amdgcn_sched_barrier(0);
#pragma unroll
        for (int ks = 0; ks < 4; ++ks) { const s16x4 lo = vl[d & 1][ks], hv = vh[d & 1][ks];
            const bf16x8 vf = (bf16x8){lo[0], lo[1], lo[2], lo[3], hv[0], hv[1], hv[2], hv[3]};
            o[d] = __builtin_amdgcn_mfma_f32_32x32x16_bf16(pa[ks], vf, o[d], 0, 0, 0); }
        __builtin_amdgcn_sched_barrier(0);
    }
#undef ATT_VRD
}
__device__ __forceinline__ void attn_qk(f32x16& p0, f32x16& p1, const LAS unsigned char* kb, const bf16x8 (&qr)[4]) {
    p0 = (f32x16){}; p1 = (f32x16){};
#pragma unroll
    for (int d0 = 0; d0 < 4; ++d0) { const bf16x8 b0 = *(const LAS bf16x8*)(kb + d0 * 2048), b1 = *(const LAS bf16x8*)(kb + d0 * 2048 + 512);
        p0 = __builtin_amdgcn_mfma_f32_32x32x16_bf16(b0, qr[d0], p0, 0, 0, 0); p1 = __builtin_amdgcn_mfma_f32_32x32x16_bf16(b1, qr[d0], p1, 0, 0, 0); }
}
__device__ __forceinline__ void attn_softmax(const bool FIRST, f32x16& p0, f32x16& p1, f32x16 (&o)[4], float& mrun, float& lrun, bf16x8 (&pa)[4], LAS float* wsf, int r32, int hi) {
    if (FIRST) {
        asm volatile("" ::: "memory");
#pragma unroll
        for (int r = 0; r < 16; ++r) { if (r >= 8) p0[r] = -__builtin_inff(); p1[r] = -__builtin_inff(); } }
    float rmA = fmaxf(p0[0], p0[1]), rmB = fmaxf(p0[2], p0[3]), rmC = fmaxf(p1[0], p1[1]), rmD = fmaxf(p1[2], p1[3]);
#pragma unroll
    for (int r = 4; r < 16; r += 4) { rmA = fmaxf(rmA, fmaxf(p0[r], p0[r + 1])); rmB = fmaxf(rmB, fmaxf(p0[r + 2], p0[r + 3])); rmC = fmaxf(rmC, fmaxf(p1[r], p1[r + 1])); rmD = fmaxf(rmD, fmaxf(p1[r + 2], p1[r + 3])); }
    const float rm = half_swap_max(fmaxf(fmaxf(rmA, rmB), fmaxf(rmC, rmD)));
    if (FIRST) mrun = rm;
    else if (__any(rm > mrun + 8.0f)) {
        const float mnew = fmaxf(mrun, rm), alpha = __builtin_amdgcn_exp2f(mrun - mnew);
        lrun *= alpha; mrun = mnew;
        if (hi == 0) wsf[r32] = alpha;
        f32x4 a4[4];
#pragma unroll
        for (int gq = 0; gq < 4; ++gq) a4[gq] = *(const LAS f32x4*)(wsf + 8 * gq + 4 * hi);
#pragma unroll
        for (int d = 0; d < 4; ++d)
#pragma unroll
            for (int r = 0; r < 16; ++r) o[d][r] *= a4[r >> 2][r & 3];
    }
    float psA = 0.f, psB = 0.f, psC = 0.f, psD = 0.f;
#pragma unroll
    for (int r = 0; r < 16; r += 2) { p0[r] = __builtin_amdgcn_exp2f(p0[r] - mrun); p0[r + 1] = __builtin_amdgcn_exp2f(p0[r + 1] - mrun); p1[r] = __builtin_amdgcn_exp2f(p1[r] - mrun); p1[r + 1] = __builtin_amdgcn_exp2f(p1[r + 1] - mrun);
        psA += p0[r]; psB += p0[r + 1]; psC += p1[r]; psD += p1[r + 1]; }
    lrun += (psA + psB) + (psC + psD);
    u32x4 w;
    w = (u32x4){cvt_pk_bf16(p0[0], p0[1]), cvt_pk_bf16(p0[2], p0[3]), cvt_pk_bf16(p0[4], p0[5]), cvt_pk_bf16(p0[6], p0[7])}; pa[0] = __builtin_bit_cast(bf16x8, w);
    w = (u32x4){cvt_pk_bf16(p0[8], p0[9]), cvt_pk_bf16(p0[10], p0[11]), cvt_pk_bf16(p0[12], p0[13]), cvt_pk_bf16(p0[14], p0[15])}; pa[1] = __builtin_bit_cast(bf16x8, w);
    w = (u32x4){cvt_pk_bf16(p1[0], p1[1]), cvt_pk_bf16(p1[2], p1[3]), cvt_pk_bf16(p1[4], p1[5]), cvt_pk_bf16(p1[6], p1[7])}; pa[2] = __builtin_bit_cast(bf16x8, w);
    w = (u32x4){cvt_pk_bf16(p1[8], p1[9]), cvt_pk_bf16(p1[10], p1[11]), cvt_pk_bf16(p1[12], p1[13]), cvt_pk_bf16(p1[14], p1[15])}; pa[3] = __builtin_bit_cast(bf16x8, w);
}
__device__ __forceinline__ void glds16(const void* gsrc, unsigned lds_dst) { unsigned keep;
    asm volatile("s_mov_b32 %0, m0\n\ts_mov_b32 m0, %2\n\ts_nop 0\n\tglobal_load_lds_dwordx4 %1, off\n\ts_mov_b32 m0, %0" : "=&s"(keep) : "v"(gsrc), "s"(lds_dst) : "memory"); }
__device__ __forceinline__ void attn_unit(const Ctx& C, const bf16_t* Qg, const bf16_t* Kg, const bf16_t* Vg, const bf16_t* KM, const bf16_t* VM, bf16_t* Y,
                                          const float* subg, float lam, int b, int h, int qt, bool prefetched, int nqt, bf16x8 (&qr)[4], bool rb) {
    LAS unsigned char* lds = C.lds;
    const int lane = C.lane, wave = C.wave, r32 = lane & 31, hi = lane >> 5, qb = wave >> 1, map = wave & 1;
    const int q0 = qt * 128 + qb * 32;
    const size_t rowb = (size_t)b * SEQ;
    if (!prefetched) { const bf16_t* qp = Qg + (rowb + q0 + r32) * AW + h * 128 + map * 64 + hi * 8;
#pragma unroll
      for (int d0 = 0; d0 < 4; ++d0) qr[d0] = *(const bf16x8*)(qp + d0 * 16); }
    const int NT = 2 * qt + 3;
    const bool skip_last = (qb < 2);
    f32x16 o[4];
#pragma unroll
    for (int d = 0; d < 4; ++d) o[d] = (f32x16){};
    float mrun = -__builtin_inff(), lrun = 0.f;
    LAS float* wsf = (LAS float*)(lds + MISC_OFF + 4096 + wave * 256);
    const bf16_t* Kb = Kg + rowb * AW; const bf16_t* Vb = Vg + rowb * AW;
#define ATT_DMA(step, stage) do { const bf16_t* ks_ = (step) == 0 ? KM : Kb; const bf16_t* vs_ = (step) == 0 ? VM : Vb; const int row0_ = (step) == 0 ? 0 : ((step) - 1) * 64; \
    _Pragma("unroll") for (int i_ = 0; i_ < 2; ++i_) { const int p_ = 2 * wave + i_; \
        __builtin_amdgcn_global_load_lds((const unsigned*)(ks_ + (size_t)(row0_ + lane) * AW + h * 128 + (p_ >> 3) * 64 + (p_ & 7) * 8), (LAS unsigned*)(lds + (stage) * 32768 + p_ * 1024), 16, 0, 0); \
        __builtin_amdgcn_global_load_lds((const unsigned*)(vs_ + (size_t)(row0_ + 16 * (p_ & 3) + (lane >> 2)) * AW + h * 128 + (p_ >> 2) * 32 + (lane & 3) * 8), (LAS unsigned*)(lds + (stage) * 32768 + 16384 + p_ * 1024), 16, 0, 0); } } while (0)
    const int myNT = skip_last ? NT - 1 : NT;
    bf16x8 pa[4];
#pragma unroll
    for (int k = 0; k < 4; ++k) pa[k] = (bf16x8){};
    if (!prefetched) ATT_DMA(0, 0);
    asm volatile("s_waitcnt vmcnt(0)" ::: "memory"); __syncthreads();
    int stage = 0;
#pragma unroll 1
    for (int s = 0; s <= NT; ++s) {
        const int stn = stage == 2 ? 0 : stage + 1, stp = stage == 0 ? 2 : stage - 1;
        if (s + 1 < NT) ATT_DMA(s + 1, stn);
        if (rb && s >= 1 && s <= myNT) attn_pv(o, pa, (unsigned)(uintptr_t)(lds + stp * 32768 + 16384 + ((lane >> 4) & 1) * 32 + (lane & 3) * 8 + (4 * hi + ((lane & 15) >> 2)) * 64));
        if (s < myNT) {
            f32x16 p0, p1; attn_qk(p0, p1, lds + stage * 32768 + map * 8192 + hi * 1024 + r32 * 16, qr);
            attn_softmax(s == 0, p0, p1, o, mrun, lrun, pa, wsf, r32, hi);
            if (!rb) attn_pv(o, pa, (unsigned)(uintptr_t)(lds + stage * 32768 + 16384 + ((lane >> 4) & 1) * 32 + (lane & 3) * 8 + (4 * hi + ((lane & 15) >> 2)) * 64));
        }
        asm volatile("s_waitcnt vmcnt(0)" ::: "memory"); __syncthreads();
        stage = stn;
    }
#undef ATT_DMA
    bf16x8 qn[4];
#pragma unroll
    for (int d0 = 0; d0 < 4; ++d0) qn[d0] = qr[d0];
    if (nqt >= 0) {
        const unsigned lds0 = (unsigned)(uintptr_t)lds;
#pragma unroll
        for (int i = 0; i < 2; ++i) { const int p = 2 * wave + i;
            glds16(KM + (size_t)lane * AW + h * 128 + (p >> 3) * 64 + (p & 7) * 8, (unsigned)__builtin_amdgcn_readfirstlane(lds0 + p * 1024));
            glds16(VM + (size_t)(16 * (p & 3) + (lane >> 2)) * AW + h * 128 + (p >> 2) * 32 + (lane & 3) * 8, (unsigned)__builtin_amdgcn_readfirstlane(lds0 + 16384 + p * 1024)); }
        const bf16_t* qp = Qg + (rowb + nqt * 128 + qb * 32 + r32) * AW + h * 128 + map * 64 + hi * 8;
#pragma unroll
        for (int d0 = 0; d0 < 4; ++d0) qn[d0] = *(const bf16x8*)(qp + d0 * 16);
    }
    { const float ltot = half_swap_sum(lrun); const float inv = (map ? lam : 1.0f) / ltot;
      if (hi == 0) wsf[r32] = inv;
      f32x4 a4[4];
#pragma unroll
      for (int gq = 0; gq < 4; ++gq) a4[gq] = *(const LAS f32x4*)(wsf + 8 * gq + 4 * hi);
#pragma unroll
      for (int d = 0; d < 4; ++d)
#pragma unroll
          for (int r = 0; r < 16; ++r) o[d][r] *= a4[r >> 2][r & 3]; }
    LAS float* X = (LAS float*)(lds + 32768 + qb * 16384);
    if (map == 1) {
#pragma unroll
        for (int d = 0; d < 4; ++d)
#pragma unroll
            for (int r = 0; r < 16; ++r) X[crow(r, hi) * 128 + 32 * d + r32] = o[d][r];
    }
    __syncthreads();
    if (map == 0) {
        float ssq[16];
#pragma unroll
        for (int r = 0; r < 16; ++r) ssq[r] = 0.f;
#pragma unroll
        for (int d = 0; d < 4; ++d)
#pragma unroll
            for (int r = 0; r < 16; ++r) { const float v = o[d][r] - X[crow(r, hi) * 128 + 32 * d + r32]; o[d][r] = v; ssq[r] += v * v; }
#pragma unroll
        for (int r = 0; r < 16; ++r) {
#pragma unroll
            for (int off = 1; off < 32; off <<= 1) ssq[r] += __shfl_xor(ssq[r], off);
            ssq[r] = 0.8f / sqrtf(ssq[r] * (1.f / 128.f) + LN_EPS); }
        LAS bf16_t* Yt = (LAS bf16_t*)X;
#pragma unroll
        for (int d = 0; d < 4; ++d) { const float gg = subg[32 * d + r32];
#pragma unroll
            for (int r = 0; r < 16; ++r) Yt[crow(r, hi) * 128 + 32 * d + r32] = (bf16_t)(cvt_pk_bf16(o[d][r] * ssq[r] * gg, 0.f) & 0xffffu); }
#pragma unroll
        for (int i = 0; i < 8; ++i) { const int id = i * 64 + lane, row = id >> 4, ch = id & 15;
            *(u32x4*)(Y + (rowb + q0 + row) * AW + h * 128 + ch * 8) = *(const LAS u32x4*)(Yt + row * 128 + ch * 8); }
    }
#pragma unroll
    for (int d0 = 0; d0 < 4; ++d0) qr[d0] = qn[d0];
    __syncthreads();
}
__device__ __forceinline__ void p3_attention(const Ctx& C, const float* const* in, unsigned char* ws) {
    const bf16_t* Q = (const bf16_t*)(ws + WS_Q); const bf16_t* K = (const bf16_t*)(ws + WS_K); const bf16_t* V = (const bf16_t*)(ws + WS_V);
    const bf16_t* KM = (const bf16_t*)(ws + WS_KMETA); const bf16_t* VM = (const bf16_t*)(ws + WS_VMETA); bf16_t* Y = (bf16_t*)(ws + WS_YATT);
    const float l1 = wave_sum(in[14][C.lane] * in[15][C.lane]), l2 = wave_sum(in[16][C.lane] * in[17][C.lane]);
    const float lam = expf(l1) - expf(l2) + 0.2f;
    LAS unsigned* rc = (LAS unsigned*)(C.lds + MISC_OFF + 6144);
    if (C.tid < 4) rc[C.tid] = 0;
    __syncthreads();
    bool rb;
    { const unsigned simd = (unsigned)__builtin_amdgcn_s_getreg(2308) & 3u;
      unsigned r = 0; if (C.lane == 0) r = __hip_atomic_fetch_add(rc + simd, 1u, __ATOMIC_RELAXED, __HIP_MEMORY_SCOPE_WORKGROUP);
      rb = (__builtin_amdgcn_readfirstlane((int)r) & 1) != 0; }
#ifndef ATT_REP
#define ATT_REP 1
#endif
    for (int vv = C.vcu; vv < 256 * ATT_REP; vv += C.G) { const int v = vv & 255;
        const int bh = v >> 1, sft = v & 1;
        bf16x8 qr[4];
#pragma unroll
        for (int d0 = 0; d0 < 4; ++d0) qr[d0] = (bf16x8){};
#pragma unroll 1
        for (int i = 0; i < 8; ++i) { const int qt = (i & 1) ? (15 - sft - (i & ~1)) : (sft + (i & ~1)); const int i1 = i + 1;
            const int nqt = i1 < 8 ? ((i1 & 1) ? (15 - sft - (i1 & ~1)) : (sft + (i1 & ~1))) : -1;
            attn_unit(C, Q, K, V, KM, VM, Y, in[18], lam, bh >> 3, bh & 7, qt, i > 0, nqt, qr, rb); }
    }
}

__device__ __forceinline__ void p6_ln1_router(const Ctx& C, const float* const* in, unsigned char* ws) {
    const int lane = C.lane, wave = C.wave, tid = C.tid;
    const bf16_t* Z = (const bf16_t*)(ws + WS_Z); bf16_t* H1 = (bf16_t*)(ws + WS_H1); const float* WrT = (const float*)(ws + WS_WRT);
    int* LIST = (int*)(ws + WS_LIST); float* WGT = (float*)(ws + WS_WGT); unsigned* ECNT = (unsigned*)(ws + WS_CTL) + CW_ECNT;
    const float* lg = in[22]; const float* lb = in[23];
    LAS float* WB = (LAS float*)C.lds;
    LAS unsigned char* XB = C.lds + 98304;
    LAS int* RE = (LAS int*)(XB);
    LAS float* RW = (LAS float*)(XB + 1024);
    LAS int* CL = (LAS int*)(XB + 2048);
    LAS int* BS = (LAS int*)(XB + 2048 + 128);
    LAS int* SL = (LAS int*)(XB + 2048 + 256);
    LAS float* LG = (LAS float*)(XB + 4096) + wave * 80;
    for (int rbk = C.vcu; rbk < T / 128; rbk += C.G) {
        if (tid < 32) CL[tid] = 0;
#pragma unroll 1
        for (int step = 0; step < 8; ++step) {
            const int lr0 = step * 16 + 2 * wave; const size_t row0 = (size_t)rbk * 128 + lr0;
            int l4 = 4 * lane; asm volatile("" : "+v"(l4));
            f32x4 v0[8], v1[8];
#pragma unroll
            for (int j = 0; j < 8; ++j) { const u32x2 z0 = *(const u32x2*)(Z + row0 * DM + 256 * j + l4), z1 = *(const u32x2*)(Z + (row0 + 1) * DM + 256 * j + l4);
                v0[j] = (f32x4){bf_lo(z0.x), bf_hi(z0.x), bf_lo(z0.y), bf_hi(z0.y)}; v1[j] = (f32x4){bf_lo(z1.x), bf_hi(z1.x), bf_lo(z1.y), bf_hi(z1.y)}; }
            float mean0, rstd0, mean1, rstd1; ln_stats(v0, mean0, rstd0); ln_stats(v1, mean1, rstd1);
#pragma unroll
            for (int j = 0; j < 8; ++j) { const f32x4 gg = *(const f32x4*)(lg + 256 * j + l4), bb = *(const f32x4*)(lb + 256 * j + l4);
                v0[j] = (v0[j] - mean0) * rstd0 * gg + bb; v1[j] = (v1[j] - mean1) * rstd1 * gg + bb;
                u32x2 w; w.x = cvt_pk_bf16(v0[j].x, v0[j].y); w.y = cvt_pk_bf16(v0[j].z, v0[j].w); *(u32x2*)(H1 + row0 * DM + 256 * j + l4) = w;
                w.x = cvt_pk_bf16(v1[j].x, v1[j].y); w.y = cvt_pk_bf16(v1[j].z, v1[j].w); *(u32x2*)(H1 + (row0 + 1) * DM + 256 * j + l4) = w; }
#pragma unroll 1
            for (int ng = 0; ng < 3; ++ng) {
                __syncthreads();
                int tq = tid; asm volatile("" : "+v"(tq));
#pragma unroll
                for (int i = 0; i < 12; ++i) { const int idx = tq + 512 * i, n = idx >> 9, c4 = idx & 511;
                    *(LAS f32x4*)(WB + n * 2048 + 4 * c4) = *(const f32x4*)(WrT + (size_t)(12 * ng + n) * DM + 4 * c4); }
                __syncthreads();
#pragma unroll 1
                for (int n = 0; n < 12; ++n) { float pa = 0.f, pb = 0.f;
#pragma unroll
                    for (int j = 0; j < 8; ++j) { const f32x4 w4 = *(const LAS f32x4*)(WB + n * 2048 + 256 * j + l4);
                        const f32x4 a = v0[j] * w4, bq = v1[j] * w4; pa += (a.x + a.y) + (a.z + a.w); pb += (bq.x + bq.y) + (bq.z + bq.w); }
                    const float sa = wave_sum(pa), sb = wave_sum(pb); if (lane == 0) { LG[12 * ng + n] = sa; LG[40 + 12 * ng + n] = sb; } }
            }
            if (lane < 2) {
                const LAS float* L = LG + 40 * lane;
                int gi = 0; float gm = L[0] + in[25][0];
                for (int n = 1; n < 4; ++n) { const float x = L[n] + in[25][n]; if (x > gm) { gm = x; gi = n; } }
                float gs = 0.f;
                for (int n = 0; n < 4; ++n) gs += __expf(L[n] + in[25][n] - gm);
                const float gval = 1.0f / gs;
                int i1 = 0; float m1 = L[4 + gi * 8] + in[27][gi * 8];
                for (int j = 1; j < 8; ++j) { const float x = L[4 + gi * 8 + j] + in[27][gi * 8 + j]; if (x > m1) { m1 = x; i1 = j; } }
                int i2 = -1; float m2 = -__builtin_inff();
                for (int j = 0; j < 8; ++j) { const float x = L[4 + gi * 8 + j] + in[27][gi * 8 + j]; if (j != i1 && x > m2) { m2 = x; i2 = j; } }
                const float tt = __expf(m2 - m1), w1 = gval / (1.f + tt), w2 = gval * tt / (1.f + tt);
                const int lr = lr0 + lane; RE[lr * 2] = gi * 8 + i1; RE[lr * 2 + 1] = gi * 8 + i2; RW[lr * 2] = w1; RW[lr * 2 + 1] = w2;
            }
        }
        __syncthreads();
        int e = 0;
        if (tid < 256) { e = RE[tid]; SL[tid] = __hip_atomic_fetch_add(&CL[e], 1, __ATOMIC_RELAXED, __HIP_MEMORY_SCOPE_WORKGROUP); }
        __syncthreads();
        if (tid < 32) BS[tid] = (int)__hip_atomic_fetch_add(&ECNT[tid], (unsigned)CL[tid], __ATOMIC_RELAXED, __HIP_MEMORY_SCOPE_AGENT);
        __syncthreads();
        if (tid < 256) { const int entry = (rbk * 128 + (tid >> 1)) * 2 + (tid & 1); LIST[(size_t)e * CAP + BS[e] + SL[tid]] = entry; WGT[entry] = RW[tid]; }
        __syncthreads();
    }
}

__device__ __forceinline__ void p9_ln2(const Ctx& C, const float* const* in, unsigned char* ws, float* out) {
    const bf16_t* H1 = (const bf16_t*)(ws + WS_H1); const bf16_t* YK = (const bf16_t*)(ws + WS_YK);
    const float* lg = in[31]; const float* lb = in[32];
    const int gw = C.vcu * 8 + C.wave, NGW = C.G * 8, lane = C.lane;
    for (int m = gw; m < T; m += 2 * NGW) {
        const int m2 = (m + NGW < T) ? m + NGW : m;
        u32x2 ha[8], ya0[8], ya1[8], hb[8], yb0[8], yb1[8];
#pragma unroll
        for (int j = 0; j < 8; ++j) { const size_t c = 256 * j + 4 * lane;
            ha[j] = *(const u32x2*)(H1 + (size_t)m * DM + c); ya0[j] = *(const u32x2*)(YK + (size_t)(2 * m) * DM + c); ya1[j] = *(const u32x2*)(YK + (size_t)(2 * m + 1) * DM + c);
            hb[j] = *(const u32x2*)(H1 + (size_t)m2 * DM + c); yb0[j] = *(const u32x2*)(YK + (size_t)(2 * m2) * DM + c); yb1[j] = *(const u32x2*)(YK + (size_t)(2 * m2 + 1) * DM + c); }
#pragma unroll
        for (int rr = 0; rr < 2; ++rr) {
            f32x4 v[8];
#pragma unroll
            for (int j = 0; j < 8; ++j) { const u32x2 hw = rr ? hb[j] : ha[j], y0 = rr ? yb0[j] : ya0[j], y1 = rr ? yb1[j] : ya1[j];
                v[j] = (f32x4){bf_lo(hw.x), bf_hi(hw.x), bf_lo(hw.y), bf_hi(hw.y)} * ALPHA + (f32x4){bf_lo(y0.x), bf_hi(y0.x), bf_lo(y0.y), bf_hi(y0.y)} + (f32x4){bf_lo(y1.x), bf_hi(y1.x), bf_lo(y1.y), bf_hi(y1.y)}; }
            float mean, rstd; ln_stats(v, mean, rstd);
            const int mm = rr ? m2 : m;
            if (rr == 0 || m2 != m) {
#pragma unroll
                for (int j = 0; j < 8; ++j) { const f32x4 gg = *(const f32x4*)(lg + 256 * j + 4 * lane), bb = *(const f32x4*)(lb + 256 * j + 4 * lane);
                    *(f32x4*)(out + (size_t)mm * DM + 256 * j + 4 * lane) = (v[j] - mean) * rstd * gg + bb; } }
        }
    }
}

__device__ __forceinline__ int build_moe_tables(const Ctx& C, unsigned char* ws) {
    LAS int* blkstart = (LAS int*)(C.lds + MISC_OFF + 64); LAS int* cntE = (LAS int*)(C.lds + MISC_OFF + 320); LAS int* blkexp = (LAS int*)(C.lds + MISC_OFF + 512);
    unsigned* ECNT = (unsigned*)(ws + WS_CTL) + CW_ECNT;
    __syncthreads();
    if (C.tid < 32) cntE[C.tid] = (int)__hip_atomic_load(&ECNT[C.tid], __ATOMIC_RELAXED, __HIP_MEMORY_SCOPE_AGENT);
    __syncthreads();
    if (C.tid == 0) { int s = 0; for (int e = 0; e < NE; ++e) { blkstart[e] = s; s += (cntE[e] + 255) >> 8; } blkstart[NE] = s; }
    __syncthreads();
    const int NBLK = blkstart[NE];
    if (C.tid < NBLK && C.tid < 320) { int e = 0; for (int j = 1; j < NE; ++j) if (blkstart[j] <= C.tid) e = j; blkexp[C.tid] = e; }
    __syncthreads();
    return NBLK < 320 ? NBLK : 320;
}

__device__ __forceinline__ void p7_convert_down(const Ctx& C, const float* const* in, unsigned char* ws) {
    LAS float* scr = (LAS float*)(C.lds + C.wave * 16384);
    unsigned* ctr = (unsigned*)(ws + WS_CTL) + CW_CONV; bf16_t* WdnT = (bf16_t*)(ws + WS_WDN);
    constexpr int NCH = NE * 512 / 16;
    for (;;) {
        unsigned ch = 0; if (C.lane == 0) ch = __hip_atomic_fetch_add(ctr, 1u, __ATOMIC_RELAXED, __HIP_MEMORY_SCOPE_AGENT);
        ch = (unsigned)__builtin_amdgcn_readfirstlane((int)ch);
        if (ch >= (unsigned)NCH) break;
#pragma unroll 1
        for (int q = 0; q < 16; ++q) { const int r = (int)ch * 16 + q, e = r >> 9, rr = r & 511, kb = rr >> 6, nb = rr & 63;
            transpose_item(in[30] + (size_t)e * DFF * DM, DFF, DM, WdnT, kb, nb, e * 2048 + 32 * nb, scr, C.lane); }
    }
}

constexpr int NPHASE = 10;
struct Args { const float* in[33]; float* out; unsigned char* ws; int ph_lo, ph_hi; };
__global__ void __launch_bounds__(512, 2) mk_fwd(Args args) {
    extern __shared__ __attribute__((aligned(16))) unsigned char lds_raw[];
    Ctx C; C.lds = (LAS unsigned char*)lds_raw; C.tid = threadIdx.x; C.lane = C.tid & 63; C.wave = __builtin_amdgcn_readfirstlane(C.tid >> 6);
    C.G = gridDim.x; { const int bx = blockIdx.x; C.vcu = (C.G % 8 == 0) ? (bx % 8) * (C.G / 8) + bx / 8 : bx; }
    unsigned char* ws = args.ws; const float* const* in = args.in;
    volatile LAS unsigned* MISC = (volatile LAS unsigned*)(C.lds + MISC_OFF);
    if (C.tid < 16) MISC[C.tid] = 0u;
    __syncthreads();
    unsigned* barw = (unsigned*)(ws + WS_CTL) + CW_BAR;
    XcdBarrier bar; bar.bar = barw; bar.x = 0; bar.st = nullptr;
    const int lo = args.ph_lo, hi = args.ph_hi;
    if (hi - lo > 1) bar = xcd_barrier_post(barw, MISC);
#ifndef PH_MASK
#define PH_MASK 0x3ff
#endif
#define IN(k) (((PH_MASK >> (k)) & 1) && lo <= (k) && (k) < hi)
#define SEAM(k) do { if (IN(k) && IN((k) + 1)) xcd_barrier(bar); } while (0)
#ifndef WGM_PROJ
#define WGM_PROJ 4
#endif
#ifndef WGM_N2K
#define WGM_N2K 2
#endif
#ifndef GEMM_SP2
#define GEMM_SP2 true
#endif
#ifndef GEMM_ALIGN
#define GEMM_ALIGN true
#endif
#ifndef PROBE_MASK
#define PROBE_MASK 0
#endif
#define REPS(k) (((PROBE_MASK >> (k)) & 1) ? 2 : 1)
#define REPSEAM(k, rep) do { if ((rep) + 1 < REPS(k)) xcd_barrier(bar); } while (0)
    LAS unsigned char* lds = C.lds;
    bf16_t* MG = (bf16_t*)args.out;

    if (IN(0)) { _Pragma("unroll") for (int rep = 0; rep < REPS(0); ++rep) { p0_prologue(C, in, ws); REPSEAM(0, rep); } } SEAM(0);

    if (IN(1)) { _Pragma("unroll") for (int rep = 0; rep < REPS(1); ++rep) {
        pg8::Gemm g{(const bf16_t*)(ws + WS_HBF), (const bf16_t*)(ws + WS_WIN), T, INC, DM, nullptr, nullptr, 0}; pg8::StaticOrder S; S.init(T, INC, C.G, (int)blockIdx.x, WGM_PROJ);
        EpiProj E{(bf16_t*)(ws + WS_U), (bf16_t*)(ws + WS_Q), (bf16_t*)(ws + WS_K), (bf16_t*)(ws + WS_V), (bf16_t*)(ws + WS_SGS), (bf16_t*)(ws + WS_SGA)};
        pg8::gemm_phase<EpiProj, pg8::StaticOrder, GEMM_ALIGN, GEMM_SP2, false>(lds, g, S, E);
        p1_meta_proj(C, ws);
        REPSEAM(1, rep);
    } } SEAM(1);

    if (IN(2)) { _Pragma("unroll") for (int rep = 0; rep < REPS(2); ++rep) { p2_scan(C, in, ws); REPSEAM(2, rep); } } SEAM(2);

    if (IN(3)) { _Pragma("unroll") for (int rep = 0; rep < REPS(3); ++rep) {
        { pg8::Gemm g{(const bf16_t*)(ws + WS_YPRE), (const bf16_t*)(ws + WS_WGLU), T, SSMW, SSMW, nullptr, nullptr, 0}; pg8::StaticOrder S; S.init(T, SSMW, C.G, (int)blockIdx.x);
          EpiGlu E{(const bf16_t*)(ws + WS_YPRE), (bf16_t*)(ws + WS_YSSM)};
          pg8::gemm_phase<EpiGlu, pg8::StaticOrder, GEMM_ALIGN, GEMM_SP2, false>(lds, g, S, E); }
        p3_attention(C, in, ws);
        REPSEAM(3, rep);
    } } SEAM(3);

    if (IN(4)) { _Pragma("unroll") for (int rep = 0; rep < REPS(4); ++rep) {
        { pg8::Gemm g{(const bf16_t*)(ws + WS_YSSM), (const bf16_t*)(ws + WS_WBS), T, DM, SSMW, (const bf16_t*)(ws + WS_YATT), (const bf16_t*)(ws + WS_WBA), AW}; pg8::StaticOrder S; S.init(T, DM, C.G, (int)blockIdx.x, WGM_N2K);
          EpiMergeF E{(const bf16_t*)(ws + WS_SGS), (const bf16_t*)(ws + WS_SGA), MG};
          pg8::gemm_phase<EpiMergeF, pg8::StaticOrder, GEMM_ALIGN, GEMM_SP2, false, true>(lds, g, S, E); }
        REPSEAM(4, rep);
    } } SEAM(4);

    if (IN(5)) { _Pragma("unroll") for (int rep = 0; rep < REPS(5); ++rep) {
        pg8::Gemm g{MG, (const bf16_t*)(ws + WS_WO), T, DM, DM, nullptr, nullptr, 0}; pg8::StaticOrder S; S.init(T, DM, C.G, (int)blockIdx.x, WGM_N2K);
        EpiZ E{(const bf16_t*)(ws + WS_HBF), (bf16_t*)(ws + WS_Z)};
        pg8::gemm_phase<EpiZ, pg8::StaticOrder, GEMM_ALIGN, GEMM_SP2, false>(lds, g, S, E);
        REPSEAM(5, rep);
    } } SEAM(5);

    if (IN(6)) { p6_ln1_router(C, in, ws); } SEAM(6);

    if (IN(7)) { _Pragma("unroll") for (int rep = 0; rep < REPS(7); ++rep) {
        const int NBLK = build_moe_tables(C, ws);
        MoeOrder S{C.G, C.vcu, 2, NBLK, (const LAS int*)(lds + MISC_OFF + 512), (const LAS int*)(lds + MISC_OFF + 64), (const LAS int*)(lds + MISC_OFF + 320), (const int*)(ws + WS_LIST)};
        pg8::Gemm g{(const bf16_t*)(ws + WS_H1), (const bf16_t*)(ws + WS_WUP), T, NE * 1024, DM, nullptr, nullptr, 0};
        EpiSwiglu E{(bf16_t*)(ws + WS_HB), (const int*)(ws + WS_LIST), (const float*)(ws + WS_WGT), (int*)(ws + WS_POSE), (float*)(ws + WS_POSW)};
        pg8::gemm_phase<EpiSwiglu, MoeOrder, GEMM_ALIGN, GEMM_SP2, true>(lds, g, S, E);
        p7_convert_down(C, in, ws);
        REPSEAM(7, rep);
    } } SEAM(7);

    if (IN(8)) { _Pragma("unroll") for (int rep = 0; rep < REPS(8); ++rep) {
        const int NBLK = build_moe_tables(C, ws);
        MoeOrder S{C.G, C.vcu, 3, NBLK, (const LAS int*)(lds + MISC_OFF + 512), (const LAS int*)(lds + MISC_OFF + 64), (const LAS int*)(lds + MISC_OFF + 320), (const int*)(ws + WS_LIST)};
        pg8::Gemm g{(const bf16_t*)(ws + WS_HB), (const bf16_t*)(ws + WS_WDN), NBLK * 256, NE * DM, DFF, nullptr, nullptr, 0};
        EpiDown E{(const int*)(ws + WS_POSE), (const float*)(ws + WS_POSW), (bf16_t*)(ws + WS_YK)};
        pg8::gemm_phase<EpiDown, MoeOrder, GEMM_ALIGN, GEMM_SP2, false>(lds, g, S, E);
        REPSEAM(8, rep);
    } } SEAM(8);

    if (IN(9)) { _Pragma("unroll") for (int rep = 0; rep < REPS(9); ++rep) { p9_ln2(C, in, ws, args.out); REPSEAM(9, rep); } }
#undef IN
#undef SEAM
}

extern "C" void kernel_launch(void* const* d_in, const int* in_sizes, int n_in, void* d_out, int out_size, void* d_ws, size_t ws_size, hipStream_t stream) {
    static int grid = 0;
    if (grid == 0) {
        if (n_in != 33 || in_sizes[0] != T * DM || out_size != T * DM || ws_size < WS_END) { fprintf(stderr, "kernel_launch: unexpected shapes (n_in %d, in0 %d, out %d, ws %zu)\n", n_in, n_in > 0 ? in_sizes[0] : -1, out_size, ws_size); grid = -1; return; }
        int dev = 0, cus = 0, per_cu = 0;
        if (hipGetDevice(&dev) != hipSuccess || hipDeviceGetAttribute(&cus, hipDeviceAttributeMultiprocessorCount, dev) != hipSuccess) { grid = -1; return; }
        if (hipFuncSetAttribute((const void*)mk_fwd, hipFuncAttributeMaxDynamicSharedMemorySize, LDS_BYTES) != hipSuccess) { fprintf(stderr, "kernel_launch: hipFuncSetAttribute failed\n"); grid = -1; return; }
        if (hipOccupancyMaxActiveBlocksPerMultiprocessor(&per_cu, (const void*)mk_fwd, 512, LDS_BYTES) != hipSuccess || per_cu < 1) { fprintf(stderr, "kernel_launch: occupancy query reports %d blocks per CU\n", per_cu); }
        (void)hipGetLastError();
        grid = cus;
    }
    if (grid < 0) return;
    (void)hipMemsetAsync((char*)d_ws + WS_CTL, 0, CTL_ZERO_BYTES, stream);
    Args a{};
    for (int i = 0; i < 33; ++i) a.in[i] = (const float*)d_in[i];
    a.out = (float*)d_out; a.ws = (unsigned char*)d_ws;
#if MK_PER_PHASE
    for (int p = 0; p < NPHASE; ++p) { a.ph_lo = p; a.ph_hi = p + 1; hipLaunchKernelGGL(mk_fwd, dim3(grid), dim3(512), LDS_BYTES, stream, a); }
#else
    a.ph_lo = 0; a.ph_hi = NPHASE; hipLaunchKernelGGL(mk_fwd, dim3(grid), dim3(512), LDS_BYTES, stream, a);
#endif
}
```

```cpp
#include <hip/hip_runtime.h>
#include <stdint.h>
#include <stdio.h>

#ifndef ATT_PROBE
#define ATT_PROBE 0
#endif
#ifndef MK_PER_PHASE
#define MK_PER_PHASE 0
#endif

#define GAS __attribute__((address_space(1)))
#define LAS __attribute__((address_space(3)))
typedef unsigned short bf16_t;
typedef short bf16x8 __attribute__((ext_vector_type(8)));
typedef short s16x4 __attribute__((ext_vector_type(4)));
typedef float f32x2 __attribute__((ext_vector_type(2)));
typedef float f32x4 __attribute__((ext_vector_type(4)));
typedef float f32x16 __attribute__((ext_vector_type(16)));
typedef unsigned u32x2 __attribute__((ext_vector_type(2)));
typedef unsigned u32x4 __attribute__((ext_vector_type(4)));

constexpr int NB_ = 16, SEQ = 2048, DM = 2048, T = NB_ * SEQ, NMETA = 16;
constexpr int SSMW = 512, AW = 1024, INC = 7680, NGRP = 32, NST = 64;
constexpr int NE = 32, DFF = 512, CAP = T;
constexpr float LN_EPS = 1e-5f;
constexpr float ALPHA = 1.189207115002721f;
constexpr float QSCALE = 0.125f * 1.4426950408889634f;

__device__ __forceinline__ unsigned cvt_pk_bf16(float lo, float hi) { unsigned r; asm volatile("v_cvt_pk_bf16_f32 %0, %1, %2" : "=v"(r) : "v"(lo), "v"(hi)); return r; }
__device__ __forceinline__ float bf_lo(unsigned w) { return __uint_as_float(w << 16); }
__device__ __forceinline__ float bf_hi(unsigned w) { return __uint_as_float(w & 0xffff0000u); }
__device__ __forceinline__ float sigmoidf_(float x) { return __builtin_amdgcn_rcpf(1.0f + __expf(-x)); }
template <int CTRL> __device__ __forceinline__ float dpp_f(float v) { return __int_as_float(__builtin_amdgcn_update_dpp(0, __float_as_int(v), CTRL, 0xf, 0xf, true)); }
__device__ __forceinline__ float wave_sum(float v) {
    v += dpp_f<0xB1>(v);
    v += dpp_f<0x4E>(v);
    v += dpp_f<0x141>(v);
    v += dpp_f<0x140>(v);
    { auto r = __builtin_amdgcn_permlane16_swap(__float_as_uint(v), __float_as_uint(v), false, false); v = __uint_as_float(r[0]) + __uint_as_float(r[1]); }
    { auto r = __builtin_amdgcn_permlane32_swap(__float_as_uint(v), __float_as_uint(v), false, false); v = __uint_as_float(r[0]) + __uint_as_float(r[1]); }
    return v;
}

namespace pg8 {
constexpr int BM = 256, BK = 64, HALF = 128, HTB = HALF * BK * 2, STAGE_BYTES = 8 * HTB, NXCD = 8, WGM = 4;
__host__ __device__ __forceinline__ int lds_byte(int r, int c) { const int st = (r >> 4) * 2 + (c >> 5), rr = r & 15, cc = c & 31, ob = rr * 64 + cc * 2; return st * 1024 + (ob ^ (((ob >> 9) & 1) << 5)); }
__host__ __device__ __forceinline__ void stage_rc(int b, int& R, int& C) { const int st = b / 1024, sb = b % 1024, swz = sb ^ (((sb >> 9) & 1) << 5); R = (st >> 1) * 16 + swz / 64; C = (st & 1) * 32 + (swz % 64) / 2; }
__host__ __device__ __forceinline__ int perm32(int rho) { const int n = rho >> 4, i = rho & 15; return 8 * (i >> 2) + 4 * n + (i & 3); }

struct Unit { int pm, pn, e, s0, cnt; };
struct Gemm { const bf16_t* A; const bf16_t* Bt; int M, N, K; const bf16_t* A2; const bf16_t* Bt2; int K2; };

struct StaticOrder {
    int nM, nN, nwg, G, c, wgm;
    __device__ void init(int M, int N, int G_, int c_, int wgm_ = WGM) { nM = M / BM; nN = N / BM; nwg = nM * nN; G = G_; c = c_; wgm = wgm_; }
    __device__ bool next(int i, Unit& u) const {
        const long L = (long)i * G + c; if (L >= nwg) return false;
        int wgid = (int)L; { const int q = nwg / NXCD, r = nwg % NXCD, xcd = wgid % NXCD, off = wgid / NXCD; wgid = (xcd < r ? xcd * (q + 1) : r * (q + 1) + (xcd - r) * q) + off; }
        const int nig = wgm * nN, gid = wgid / nig, fm = gid * wgm, gsz = (nM - fm) < wgm ? (nM - fm) : wgm;
        u.pm = fm + ((wgid % nig) % gsz); u.pn = (wgid % nig) / gsz; u.e = 0; u.s0 = 0; u.cnt = 0; return true;
    }
    __device__ __forceinline__ int arow(const Unit&, int) const { return 0; }
};

template <class Epi, class Sched, bool ALIGN_EPI, bool SP2, bool GATHER, bool DUAL = false>
__device__ __forceinline__ void gemm_phase(LAS unsigned char* lds, const Gemm g, const Sched& S, const Epi& E) {
    const int tid = threadIdx.x, wid = __builtin_amdgcn_readfirstlane(tid >> 6), lane = tid & 63, wr = wid >> 2, wc = wid & 3, fr = lane & 15, fq = lane >> 4;
    const int K = g.K, K2 = DUAL ? g.K2 : 0, nt1 = K / BK, nt = (K + K2) / BK;
    unsigned voffA[2], voffB[2], voffA2[2] = {0u, 0u}, voffB2[2] = {0u, 0u}; int stR[2], stC[2];
#pragma unroll
    for (int i = 0; i < 2; ++i) { int R, C; stage_rc(tid * 16 + i * 8192, R, C); const int Rb = Epi::PERM ? ((R & ~31) + perm32(R & 31)) : R;
        stR[i] = R; stC[i] = C; voffA[i] = (unsigned)(R * K + C) * 2u; voffB[i] = (unsigned)(Rb * K + C) * 2u;
        if constexpr (DUAL) { voffA2[i] = (unsigned)(R * K2 + C) * 2u; voffB2[i] = (unsigned)(Rb * K2 + C) * 2u; } }
    const size_t kstep = (size_t)(BK * 2);
    const size_t hstep = (size_t)HALF * K * 2;
    const size_t tstep = 2 * hstep;
    const size_t hstep2 = (size_t)HALF * K2 * 2, tstep2 = 2 * hstep2;
    const unsigned ldsw = (unsigned)wid * 1024u;
    const int aoff = lds_byte(wr * 64 + fr, fq * 8), boff = lds_byte(wc * 32 + fr, fq * 8);
#define PG8_SA(b, h) (((b) * 2 + (h)) * HTB)
#define PG8_SB(b, h) ((4 + (b) * 2 + (h)) * HTB)
#define PG8_STAGE(bufoff, gbase, voff) do { _Pragma("unroll") for (int _i = 0; _i < 2; ++_i) \
        __builtin_amdgcn_global_load_lds((const unsigned*)((const char*)(gbase) + (voff)[_i]), (LAS unsigned*)(lds + (bufoff) + ldsw + _i * 8192), 16, 0, 0); } while (0)
#define PG8_STAGE_A(bufoff, kbase, h, VO) do { if constexpr (GATHER) { PG8_STAGE(bufoff, kbase, VO[h]); } else { PG8_STAGE(bufoff, (kbase) + (h) * hstep, voffA); } } while (0)
#define PG8_STAGE_AX(bufoff, kbase, h, VO, HS, VA) do { if constexpr (GATHER) { PG8_STAGE(bufoff, kbase, VO[h]); } else { PG8_STAGE(bufoff, (kbase) + (h) * (HS), VA); } } while (0)
#define PG8_LDA(dst, b, h) do { _Pragma("unroll") for (int m = 0; m < 4; ++m) _Pragma("unroll") for (int k = 0; k < 2; ++k) dst[m][k] = *(const LAS bf16x8*)(lds + PG8_SA(b, h) + aoff + m * 2048 + k * 1024); } while (0)
#define PG8_LDB(dst, b, h) do { _Pragma("unroll") for (int n = 0; n < 2; ++n) _Pragma("unroll") for (int k = 0; k < 2; ++k) dst[n][k] = *(const LAS bf16x8*)(lds + PG8_SB(b, h) + boff + n * 2048 + k * 1024); } while (0)
#define PG8_MMA(ai, bj, At, Bt) do { __builtin_amdgcn_s_setprio(1); _Pragma("unroll") for (int m = 0; m < 4; ++m) _Pragma("unroll") for (int n = 0; n < 2; ++n) _Pragma("unroll") for (int k = 0; k < 2; ++k) \
        acc[ai][bj][m][n] = __builtin_amdgcn_mfma_f32_16x16x32_bf16(Bt[n][k], At[m][k], acc[ai][bj][m][n], 0, 0, 0); __builtin_amdgcn_s_setprio(0); } while (0)
#define PG8_WAIT_V(n) asm volatile("s_waitcnt vmcnt(" #n ")" ::: "memory")
#define PG8_WAIT_L(n) asm volatile("s_waitcnt lgkmcnt(" #n ")" ::: "memory")
#define PG8_BAR __builtin_amdgcn_s_barrier()
#define PG8_SCHED __builtin_amdgcn_sched_barrier(0)
#define PG8_GOFF(VO, U) do { _Pragma("unroll") for (int _h = 0; _h < 2; ++_h) _Pragma("unroll") for (int _i = 0; _i < 2; ++_i) \
        VO[_h][_i] = (unsigned)S.arow(U, _h * HALF + stR[_i]) * (unsigned)(K * 2) + (unsigned)(stC[_i] * 2); } while (0)
    Unit cur, nxt; int ui = 0;
    if (!S.next(0, cur)) return;
    f32x4 acc[2][2][4][2];
#pragma unroll
    for (int a = 0; a < 2; ++a)
#pragma unroll
        for (int b = 0; b < 2; ++b)
#pragma unroll
            for (int m = 0; m < 4; ++m)
#pragma unroll
                for (int n = 0; n < 2; ++n) acc[a][b][m][n] = (f32x4){0.f, 0.f, 0.f, 0.f};
    bf16x8 At[4][2], B0[2][2], B1[2][2];
    unsigned cvo[2][2] = {{0u, 0u}, {0u, 0u}}, nvo[2][2] = {{0u, 0u}, {0u, 0u}};
    const char* cA = GATHER ? (const char*)g.A : (const char*)g.A + (size_t)cur.pm * tstep; const char* cB = (const char*)g.Bt + (size_t)cur.pn * tstep;
    if constexpr (GATHER) { PG8_GOFF(cvo, cur); }
    if constexpr (SP2) {
        PG8_STAGE(PG8_SB(0, 0), cB, voffB); PG8_STAGE(PG8_SB(0, 1), cB + hstep, voffB); PG8_STAGE_A(PG8_SA(0, 0), cA, 0, cvo); PG8_STAGE_A(PG8_SA(0, 1), cA, 1, cvo);
        if (wr == 1) PG8_BAR;
        PG8_WAIT_V(2); PG8_BAR;
        PG8_STAGE(PG8_SB(1, 0), cB + kstep, voffB); PG8_STAGE_A(PG8_SA(1, 0), cA + kstep, 0, cvo); PG8_STAGE(PG8_SB(1, 1), cB + hstep + kstep, voffB);
        PG8_WAIT_V(6); PG8_BAR;
    } else {
        PG8_STAGE(PG8_SB(0, 0), cB, voffB); PG8_STAGE_A(PG8_SA(0, 0), cA, 0, cvo); PG8_STAGE(PG8_SB(0, 1), cB + hstep, voffB); PG8_STAGE_A(PG8_SA(0, 1), cA, 1, cvo);
        if (wr == 1) PG8_BAR;
        PG8_WAIT_V(4); PG8_BAR;
        PG8_STAGE(PG8_SB(1, 0), cB + kstep, voffB); PG8_STAGE_A(PG8_SA(1, 0), cA + kstep, 0, cvo); PG8_STAGE(PG8_SB(1, 1), cB + hstep + kstep, voffB);
        PG8_WAIT_V(6); PG8_BAR;
    }
    for (;;) {
        const bool has_next = S.next(ui + 1, nxt);
        const char* nA = GATHER ? cA : (has_next ? (const char*)g.A + (size_t)nxt.pm * tstep : cA); const char* nB = has_next ? (const char*)g.Bt + (size_t)nxt.pn * tstep : cB;
        if constexpr (GATHER) { if (has_next) { PG8_GOFF(nvo, nxt); } else {
#pragma unroll
            for (int h = 0; h < 2; ++h)
#pragma unroll
                for (int i = 0; i < 2; ++i) nvo[h][i] = cvo[h][i]; } }
        const char* cA2 = DUAL ? (const char*)g.A2 + (size_t)cur.pm * tstep2 : cA; const char* cB2 = DUAL ? (const char*)g.Bt2 + (size_t)cur.pn * tstep2 : cB;
        for (int t = 0; t < nt; t += 2) {
            const bool last = (t == nt - 2);
            const bool s1 = DUAL && (t + 1 >= nt1), s2 = DUAL && !last && (t + 2 >= nt1);
            const char* a1 = s1 ? cA2 + (size_t)(t + 1 - nt1) * kstep : cA + (size_t)(t + 1) * kstep;
            const char* a2 = last ? nA : (s2 ? cA2 + (size_t)(t + 2 - nt1) * kstep : cA + (size_t)(t + 2) * kstep);
            const char* b2 = last ? nB : (s2 ? cB2 + (size_t)(t + 2 - nt1) * kstep : cB + (size_t)(t + 2) * kstep);
            const char* a3 = a2 + kstep; const char* b3 = b2 + kstep;
            const size_t hs1 = s1 ? hstep2 : hstep, hs2 = s2 ? hstep2 : hstep;
            unsigned vA1[2], vA2[2], vB2[2];
#pragma unroll
            for (int i = 0; i < 2; ++i) { vA1[i] = s1 ? voffA2[i] : voffA[i]; vA2[i] = s2 ? voffA2[i] : voffA[i]; vB2[i] = s2 ? voffB2[i] : voffB[i]; }
            unsigned svo[2][2];
#pragma unroll
            for (int h = 0; h < 2; ++h)
#pragma unroll
                for (int i = 0; i < 2; ++i) svo[h][i] = last ? nvo[h][i] : cvo[h][i];
            if constexpr (SP2) {
            PG8_LDB(B0, 0, 0); PG8_LDB(B1, 0, 1); PG8_SCHED; PG8_LDA(At, 0, 0); PG8_STAGE_AX(PG8_SA(1, 1), a1, 1, cvo, hs1, vA1);
            PG8_WAIT_V(8); PG8_WAIT_L(0); PG8_BAR; PG8_MMA(0, 0, At, B0); PG8_MMA(0, 1, At, B1); PG8_BAR; PG8_SCHED;
            PG8_LDA(At, 0, 1); PG8_STAGE(PG8_SB(0, 0), b2, vB2); PG8_STAGE(PG8_SB(0, 1), b2 + hs2, vB2); PG8_STAGE_AX(PG8_SA(0, 0), a2, 0, svo, hs2, vA2);
            PG8_WAIT_V(8); PG8_WAIT_L(0); PG8_BAR; PG8_MMA(1, 0, At, B0); PG8_MMA(1, 1, At, B1); PG8_BAR; PG8_SCHED;
            PG8_LDB(B0, 1, 0); PG8_LDB(B1, 1, 1); PG8_SCHED; PG8_LDA(At, 1, 0); PG8_STAGE_AX(PG8_SA(0, 1), a2, 1, svo, hs2, vA2);
            PG8_WAIT_V(8); PG8_WAIT_L(0); PG8_BAR; PG8_MMA(0, 0, At, B0); PG8_MMA(0, 1, At, B1); PG8_BAR; PG8_SCHED;
            PG8_LDA(At, 1, 1); PG8_STAGE(PG8_SB(1, 0), b3, vB2); PG8_STAGE(PG8_SB(1, 1), b3 + hs2, vB2); PG8_STAGE_AX(PG8_SA(1, 0), a3, 0, svo, hs2, vA2);
            PG8_WAIT_V(8); PG8_WAIT_L(0); PG8_BAR; PG8_MMA(1, 0, At, B0); PG8_MMA(1, 1, At, B1); PG8_BAR; PG8_SCHED;
            } else {
            PG8_LDB(B0, 0, 0); PG8_SCHED; PG8_LDA(At, 0, 0); PG8_STAGE_AX(PG8_SA(1, 1), a1, 1, cvo, hs1, vA1);
            PG8_WAIT_L(8); PG8_BAR; PG8_WAIT_L(0); PG8_MMA(0, 0, At, B0); PG8_BAR; PG8_SCHED;
            PG8_LDB(B1, 0, 1); PG8_STAGE(PG8_SB(0, 0), b2, vB2);
            PG8_BAR; PG8_WAIT_L(0); PG8_MMA(0, 1, At, B1); PG8_BAR;
            PG8_LDA(At, 0, 1); PG8_STAGE_AX(PG8_SA(0, 0), a2, 0, svo, hs2, vA2);
            PG8_BAR; PG8_WAIT_L(0); PG8_MMA(1, 0, At, B0); PG8_BAR; PG8_SCHED;
            PG8_STAGE(PG8_SB(0, 1), b2 + hs2, vB2);
            PG8_WAIT_V(6); PG8_BAR; PG8_MMA(1, 1, At, B1); PG8_BAR;
            PG8_LDB(B0, 1, 0); PG8_SCHED; PG8_LDA(At, 1, 0); PG8_STAGE_AX(PG8_SA(0, 1), a2, 1, svo, hs2, vA2);
            PG8_WAIT_L(8); PG8_BAR; PG8_WAIT_L(0); PG8_MMA(0, 0, At, B0); PG8_BAR; PG8_SCHED;
            PG8_LDB(B1, 1, 1); PG8_STAGE(PG8_SB(1, 0), b3, vB2);
            PG8_BAR; PG8_WAIT_L(0); PG8_MMA(0, 1, At, B1); PG8_BAR;
            PG8_LDA(At, 1, 1); PG8_STAGE_AX(PG8_SA(1, 0), a3, 0, svo, hs2, vA2);
            PG8_BAR; PG8_WAIT_L(0); PG8_MMA(1, 0, At, B0); PG8_BAR; PG8_SCHED;
            PG8_STAGE(PG8_SB(1, 1), b3 + hs2, vB2);
            PG8_WAIT_V(6); PG8_BAR; PG8_MMA(1, 1, At, B1); PG8_BAR;
            }
            if constexpr (DUAL) { if (t + 2 == nt1) E.mid(acc, cur, wr, wc, fr, fq); }
        }
        if constexpr (ALIGN_EPI) { if (wr == 0) PG8_BAR; }
        E(acc, cur, wr, wc, fr, fq);
        if (!has_next) break;
#pragma unroll
        for (int a = 0; a < 2; ++a)
#pragma unroll
            for (int b = 0; b < 2; ++b)
#pragma unroll
                for (int m = 0; m < 4; ++m)
#pragma unroll
                    for (int n = 0; n < 2; ++n) acc[a][b][m][n] = (f32x4){0.f, 0.f, 0.f, 0.f};
        cur = nxt; cA = nA; cB = nB; ++ui;
#pragma unroll
        for (int h = 0; h < 2; ++h)
#pragma unroll
            for (int i = 0; i < 2; ++i) cvo[h][i] = nvo[h][i];
        if constexpr (ALIGN_EPI) { if (wr == 1) PG8_BAR; }
    }
    PG8_WAIT_V(0);
    if constexpr (!ALIGN_EPI) { if (wr == 0) PG8_BAR; }
    PG8_BAR;
#undef PG8_SA
#undef PG8_SB
#undef PG8_STAGE
#undef PG8_STAGE_A
#undef PG8_STAGE_AX
#undef PG8_LDA
#undef PG8_LDB
#undef PG8_MMA
#undef PG8_WAIT_V
#undef PG8_WAIT_L
#undef PG8_BAR
#undef PG8_SCHED
#undef PG8_GOFF
}
}

constexpr size_t MiB = 1u << 20;
constexpr size_t WS_CTL = 0, CTL_ZERO_BYTES = 1 * MiB;
constexpr size_t WS_HMETA = 1 * MiB;
constexpr size_t WS_UMETA = WS_HMETA + 128 * 1024;
constexpr size_t WS_KMETA = WS_HMETA + 256 * 1024;
constexpr size_t WS_VMETA = WS_HMETA + 384 * 1024;
constexpr size_t WS_SSMAB = WS_HMETA + 512 * 1024;
constexpr size_t WS_SSMBB = WS_HMETA + 576 * 1024;
constexpr size_t WS_WRT = 2 * MiB;
constexpr size_t WS_WIN = 3 * MiB;
constexpr size_t WS_WGLU = 33 * MiB;
constexpr size_t WS_WBS = 34 * MiB;
constexpr size_t WS_WBA = 36 * MiB;
constexpr size_t WS_WO = 40 * MiB;
constexpr size_t WS_WUP = 48 * MiB;
constexpr size_t WS_WDN = 176 * MiB;
constexpr size_t WS_HBF = 240 * MiB;
constexpr size_t WS_U = 368 * MiB;
constexpr size_t WS_Q = 400 * MiB;
constexpr size_t WS_K = 464 * MiB;
constexpr size_t WS_V = 528 * MiB;
constexpr size_t WS_SGS = 592 * MiB;
constexpr size_t WS_SGA = 720 * MiB;
constexpr size_t WS_YPRE = 848 * MiB;
constexpr size_t WS_YSSM = 880 * MiB;
constexpr size_t WS_YATT = 912 * MiB;
constexpr size_t WS_END = 976 * MiB;
constexpr size_t WS_Z = 368 * MiB;
constexpr size_t WS_H1 = 624 * MiB;
constexpr size_t WS_HB = 752 * MiB;
constexpr size_t WS_YK = 368 * MiB;
constexpr size_t WS_LIST = 848 * MiB;
constexpr size_t WS_WGT = 852 * MiB;
constexpr size_t WS_POSE = 853 * MiB;
constexpr size_t WS_POSW = 854 * MiB;
constexpr int CW_ECNT = 64;
constexpr int CW_CONV = 192;
constexpr int CW_BAR = 4096;

constexpr int RING_BYTES = 131072;
constexpr int MISC_OFF = RING_BYTES;
constexpr int LDS_BYTES = 139264;

#define XB_TMO      128
#define XB_XCNT(j)  (256  + 64 * (j))
#define XB_XSUB(j)  (1280 + 64 * (j))
#define XB_XGEN(j)  (2304 + 64 * (j))
#define XB_TOP      3328
#define XB_TOPGEN   3392
#define XCD_BAR_WORDS 3456
#define XB_SPIN_CAP (1u << 18)
__device__ __forceinline__ unsigned xb_ld(unsigned* p)              { return __hip_atomic_load(p, __ATOMIC_RELAXED, __HIP_MEMORY_SCOPE_AGENT); }
__device__ __forceinline__ unsigned xb_add(unsigned* p, unsigned v) { return __hip_atomic_fetch_add(p, v, __ATOMIC_RELAXED, __HIP_MEMORY_SCOPE_AGENT); }
__device__ __forceinline__ unsigned xb_xcc_id() { return (unsigned)__builtin_amdgcn_s_getreg((3 << 11) | 20) & 0xFu; }
#define XB_SPIN(cond, bar) do { unsigned _sp = 0; while (cond) { __builtin_amdgcn_s_sleep(1); \
    if ((++_sp & 255u) == 0u) { if (xb_ld(&(bar)[XB_TMO])) break; if (_sp > XB_SPIN_CAP) { atomicAdd(&(bar)[XB_TMO], 1u); break; } } } } while (0)
struct XcdBarrier { unsigned* bar; unsigned x; volatile LAS unsigned* st; };
__device__ __forceinline__ XcdBarrier xcd_barrier_post(unsigned* bar, volatile LAS unsigned* st) {
    XcdBarrier b; b.bar = bar; b.x = xb_xcc_id(); b.st = st;
    if (threadIdx.x == 0) (void)xb_add(&bar[XB_XCNT(b.x)], 1u);
    return b;
}
__device__ __forceinline__ void xcd_barrier_complete(unsigned* bar, unsigned x, unsigned& nloc, unsigned& nx) {
    const unsigned G = gridDim.x * gridDim.y * gridDim.z;
    unsigned sum, cnt, mine, sp = 0u;
    for (;;) {
        sum = 0u; cnt = 0u; mine = 0u;
#pragma unroll
        for (unsigned j = 0; j < 16; ++j) { const unsigned c = xb_ld(&bar[XB_XCNT(j)]); sum += c; cnt += (c > 0u) ? 1u : 0u; mine = (j == x) ? c : mine; }
        if (sum == G) break;
        __builtin_amdgcn_s_sleep(1);
        if ((++sp & 255u) == 0u) { if (xb_ld(&bar[XB_TMO])) break; if (sp > XB_SPIN_CAP) { atomicAdd(&bar[XB_TMO], 1u); break; } }
    }
    nloc = mine > 0u ? mine : 1u; nx = cnt > 0u ? cnt : 1u;
}
__device__ __forceinline__ void xcd_barrier(const XcdBarrier& b) {
    asm volatile("s_waitcnt vmcnt(0)" ::: "memory");
    __syncthreads();
    if (threadIdx.x == 0) {
        unsigned* bar = b.bar;
        __builtin_amdgcn_s_waitcnt(0);
        unsigned nloc = b.st[0], nx = b.st[1];
        if (nloc == 0u) { xcd_barrier_complete(bar, b.x, nloc, nx); b.st[0] = nloc; b.st[1] = nx; }
        const unsigned old = xb_add(&bar[XB_XSUB(b.x)], 1u);
        const unsigned gen = old / nloc;
        if (old + 1u == (gen + 1u) * nloc) {
            __builtin_amdgcn_fence(__ATOMIC_RELEASE, "agent");
            asm volatile("s_waitcnt vmcnt(0)" ::: "memory");
            const unsigned og = xb_add(&bar[XB_TOP], 1u);
            const unsigned tg = og / nx;
            if (og + 1u == (tg + 1u) * nx) xb_add(&bar[XB_TOPGEN], 1u);
            else XB_SPIN(xb_ld(&bar[XB_TOPGEN]) == tg, bar);
            __builtin_amdgcn_fence(__ATOMIC_ACQUIRE, "agent");
            xb_add(&bar[XB_XGEN(b.x)], 1u);
            asm volatile("s_waitcnt vmcnt(0)" ::: "memory");
        } else {
            XB_SPIN(xb_ld(&bar[XB_XGEN(b.x)]) == gen, bar);
            __builtin_amdgcn_fence(__ATOMIC_ACQUIRE, "agent");
            asm volatile("s_waitcnt vmcnt(0)" ::: "memory");
        }
    }
    __syncthreads();
}

using pg8::Unit;
__device__ __forceinline__ u32x4 pack8(const f32x4 v0, const f32x4 v1) { u32x4 w; w.x = cvt_pk_bf16(v0[0], v0[1]); w.y = cvt_pk_bf16(v0[2], v0[3]); w.z = cvt_pk_bf16(v1[0], v1[1]); w.w = cvt_pk_bf16(v1[2], v1[3]); return w; }
__device__ __forceinline__ void unpack8(const u32x4 w, f32x4& v0, f32x4& v1) { v0 = (f32x4){bf_lo(w.x), bf_hi(w.x), bf_lo(w.y), bf_hi(w.y)}; v1 = (f32x4){bf_lo(w.z), bf_hi(w.z), bf_lo(w.w), bf_hi(w.w)}; }

struct EpiProj {
    static constexpr bool PERM = true;
    bf16_t *U, *Q, *K, *V, *RHO, *SGA;
    __device__ __forceinline__ void operator()(const f32x4 (&acc)[2][2][4][2], const Unit& u, int wr, int wc, int fr, int fq) const {
        const int pn = u.pn;
        if (pn >= 14) {
            const int row0 = u.pm * 256 + wr * 64 + fr, col0 = (pn - 14) * 128 + wc * 32 + 8 * fq;
#pragma unroll
            for (int ai = 0; ai < 2; ++ai)
#pragma unroll
                for (int m = 0; m < 4; ++m) { const size_t off = (size_t)(row0 + ai * 128 + m * 16) * DM + col0; f32x4 r0, r1, a0, a1;
#pragma unroll
                    for (int j = 0; j < 4; ++j) { const float es0 = __expf(-acc[ai][0][m][0][j]), es1 = __expf(-acc[ai][0][m][1][j]), ea0 = __expf(-acc[ai][1][m][0][j]), ea1 = __expf(-acc[ai][1][m][1][j]);
                        a0[j] = __builtin_amdgcn_rcpf(1.f + ea0); a1[j] = __builtin_amdgcn_rcpf(1.f + ea1);
                        r0[j] = (1.f + ea0) * __builtin_amdgcn_rcpf(1.f + es0); r1[j] = (1.f + ea1) * __builtin_amdgcn_rcpf(1.f + es1); }
                    *(u32x4*)(RHO + off) = pack8(r0, r1); *(u32x4*)(SGA + off) = pack8(a0, a1); }
            return;
        }
        bf16_t* base; int ldc, ct, mode;
        if (pn < 2) { base = U; ldc = 512; ct = pn; mode = 0; }
        else if (pn < 6) { base = Q; ldc = 1024; ct = pn - 2; mode = 1; }
        else if (pn < 10) { base = K; ldc = 1024; ct = pn - 6; mode = 0; }
        else { base = V; ldc = 1024; ct = pn - 10; mode = 0; }
        const int row0 = u.pm * 256 + wr * 64 + fr, col0 = ct * 256 + wc * 32 + 8 * fq;
#pragma unroll
        for (int ai = 0; ai < 2; ++ai)
#pragma unroll
            for (int m = 0; m < 4; ++m) { bf16_t* rowp = base + (size_t)(row0 + ai * 128 + m * 16) * ldc + col0;
#pragma unroll
                for (int bj = 0; bj < 2; ++bj) { f32x4 v0 = acc[ai][bj][m][0], v1 = acc[ai][bj][m][1];
                    if (mode == 1) { v0 = v0 * QSCALE; v1 = v1 * QSCALE; }
                    *(u32x4*)(rowp + bj * 128) = pack8(v0, v1); } }
    }
};
struct EpiGlu {
    static constexpr bool PERM = true;
    const bf16_t* YPRE; bf16_t* YSSM;
    __device__ __forceinline__ void operator()(const f32x4 (&acc)[2][2][4][2], const Unit& u, int wr, int wc, int fr, int fq) const {
        const int row0 = u.pm * 256 + wr * 64 + fr, col0 = u.pn * 256 + wc * 32 + 8 * fq;
#pragma unroll
        for (int ai = 0; ai < 2; ++ai)
#pragma unroll
            for (int m = 0; m < 4; ++m) { const size_t off = (size_t)(row0 + ai * 128 + m * 16) * SSMW + col0;
#pragma unroll
                for (int bj = 0; bj < 2; ++bj) { const u32x4 yw = *(const u32x4*)(YPRE + off + bj * 128); f32x4 y0, y1; unpack8(yw, y0, y1);
                    f32x4 v0 = acc[ai][bj][m][0], v1 = acc[ai][bj][m][1];
#pragma unroll
                    for (int j = 0; j < 4; ++j) { v0[j] = y0[j] * sigmoidf_(v0[j]); v1[j] = y1[j] * sigmoidf_(v1[j]); }
                    *(u32x4*)(YSSM + off + bj * 128) = pack8(v0, v1); } }
    }
};
template <int SECOND> struct EpiMerge {
    static constexpr bool PERM = true;
    const bf16_t* SG; bf16_t* MG;
    __device__ __forceinline__ void operator()(const f32x4 (&acc)[2][2][4][2], const Unit& u, int wr, int wc, int fr, int fq) const {
        const int row0 = u.pm * 256 + wr * 64 + fr, col0 = u.pn * 256 + wc * 32 + 8 * fq;
#pragma unroll
        for (int ai = 0; ai < 2; ++ai)
#pragma unroll
            for (int m = 0; m < 4; ++m) { const size_t off = (size_t)(row0 + ai * 128 + m * 16) * DM + col0;
#pragma unroll
                for (int bj = 0; bj < 2; ++bj) { const u32x4 gw = *(const u32x4*)(SG + off + bj * 128); f32x4 g0, g1; unpack8(gw, g0, g1);
                    f32x4 v0 = acc[ai][bj][m][0] * g0, v1 = acc[ai][bj][m][1] * g1;
                    if (SECOND) { const u32x4 pw = *(const u32x4*)(MG + off + bj * 128); f32x4 p0, p1; unpack8(pw, p0, p1); v0 = v0 + p0; v1 = v1 + p1; }
                    *(u32x4*)(MG + off + bj * 128) = pack8(v0, v1); } }
    }
};
struct EpiMergeF {
    static constexpr bool PERM = true;
    const bf16_t* SGS; const bf16_t* SGA; bf16_t* MG;
    __device__ __forceinline__ void mid(f32x4 (&acc)[2][2][4][2], const Unit& u, int wr, int wc, int fr, int fq) const {
        asm volatile("" : "+v"(fr), "+v"(fq));
        const int row0 = u.pm * 256 + wr * 64 + fr, col0 = u.pn * 256 + wc * 32 + 8 * fq;
        const bf16_t* sp = SGS + (size_t)row0 * DM + col0;
        u32x4 sw[2][2];
        sw[0][0] = *(const u32x4*)(sp); sw[0][1] = *(const u32x4*)(sp + 128);
#pragma unroll
        for (int g = 0; g < 8; ++g) { const int ai = g >> 2, m = g & 3;
            if (g < 7) { const int g1 = g + 1; const bf16_t* sq = sp + (size_t)((g1 >> 2) * 128 + (g1 & 3) * 16) * DM;
                sw[g1 & 1][0] = *(const u32x4*)(sq); sw[g1 & 1][1] = *(const u32x4*)(sq + 128); }
            asm volatile("" ::: "memory");
#pragma unroll
            for (int bj = 0; bj < 2; ++bj) { f32x4 s0, s1; unpack8(sw[g & 1][bj], s0, s1);
                acc[ai][bj][m][0] = acc[ai][bj][m][0] * s0; acc[ai][bj][m][1] = acc[ai][bj][m][1] * s1; }
        }
    }
    __device__ __forceinline__ void operator()(const f32x4 (&acc)[2][2][4][2], const Unit& u, int wr, int wc, int fr, int fq) const {
        const int row0 = u.pm * 256 + wr * 64 + fr, col0 = u.pn * 256 + wc * 32 + 8 * fq;
#pragma unroll
        for (int ai = 0; ai < 2; ++ai)
#pragma unroll
            for (int m = 0; m < 4; ++m) { const size_t off = (size_t)(row0 + ai * 128 + m * 16) * DM + col0;
#pragma unroll
                for (int bj = 0; bj < 2; ++bj) { const u32x4 gw = *(const u32x4*)(SGA + off + bj * 128); f32x4 g0, g1; unpack8(gw, g0, g1);
                    *(u32x4*)(MG + off + bj * 128) = pack8(acc[ai][bj][m][0] * g0, acc[ai][bj][m][1] * g1); } }
    }
};
struct EpiZ {
    static constexpr bool PERM = true;
    const bf16_t* HBF; bf16_t* Z;
    __device__ __forceinline__ void operator()(const f32x4 (&acc)[2][2][4][2], const Unit& u, int wr, int wc, int fr, int fq) const {
        const int row0 = u.pm * 256 + wr * 64 + fr, col0 = u.pn * 256 + wc * 32 + 8 * fq;
#pragma unroll
        for (int ai = 0; ai < 2; ++ai)
#pragma unroll
            for (int m = 0; m < 4; ++m) { const size_t off = (size_t)(row0 + ai * 128 + m * 16) * DM + col0;
#pragma unroll
                for (int bj = 0; bj < 2; ++bj) { const u32x4 hw = *(const u32x4*)(HBF + off + bj * 128); f32x4 h0, h1; unpack8(hw, h0, h1);
                    *(u32x4*)(Z + off + bj * 128) = pack8(acc[ai][bj][m][0] + h0 * ALPHA, acc[ai][bj][m][1] + h1 * ALPHA); } }
    }
};
struct EpiSwiglu {
    static constexpr bool PERM = true;
    bf16_t* HB; const int* LIST; const float* WGT; int* POSE; float* POSW;
    __device__ __forceinline__ void operator()(const f32x4 (&acc)[2][2][4][2], const Unit& u, int wr, int wc, int fr, int fq) const {
        const int row0 = u.pm * 256 + wr * 64 + fr, col0 = (u.pn & 3) * 128 + wc * 32 + 8 * fq;
#pragma unroll
        for (int ai = 0; ai < 2; ++ai)
#pragma unroll
            for (int m = 0; m < 4; ++m) { f32x4 v0, v1;
#pragma unroll
                for (int j = 0; j < 4; ++j) { const float g0 = acc[ai][0][m][0][j], g1 = acc[ai][0][m][1][j];
                    v0[j] = g0 * sigmoidf_(g0) * acc[ai][1][m][0][j]; v1[j] = g1 * sigmoidf_(g1) * acc[ai][1][m][1][j]; }
                *(u32x4*)(HB + (size_t)(row0 + ai * 128 + m * 16) * DFF + col0) = pack8(v0, v1); }
        if ((u.pn & 3) == 0 && wc == 0 && fq == 0) {
#pragma unroll
            for (int ai = 0; ai < 2; ++ai)
#pragma unroll
                for (int m = 0; m < 4; ++m) { const int r = wr * 64 + fr + ai * 128 + m * 16, slot = u.s0 + r; int entry = -1; float w = 0.f;
                    if (slot < u.cnt) { entry = LIST[(size_t)u.e * CAP + slot]; w = WGT[entry]; }
                    POSE[u.pm * 256 + r] = entry; POSW[u.pm * 256 + r] = w; }
        }
    }
};
struct EpiDown {
    static constexpr bool PERM = true;
    const int* POSE; const float* POSW; bf16_t* YK;
    __device__ __forceinline__ void operator()(const f32x4 (&acc)[2][2][4][2], const Unit& u, int wr, int wc, int fr, int fq) const {
        const int r0 = u.pm * 256 + wr * 64 + fr, col0 = (u.pn & 7) * 256 + wc * 32 + 8 * fq;
        int en[2][4]; float ww[2][4];
#pragma unroll
        for (int ai = 0; ai < 2; ++ai)
#pragma unroll
            for (int m = 0; m < 4; ++m) { en[ai][m] = POSE[r0 + ai * 128 + m * 16]; ww[ai][m] = POSW[r0 + ai * 128 + m * 16]; }
#pragma unroll
        for (int ai = 0; ai < 2; ++ai)
#pragma unroll
            for (int m = 0; m < 4; ++m) {
                if (en[ai][m] >= 0) { const float w = ww[ai][m]; bf16_t* rowp = YK + (size_t)en[ai][m] * DM + col0;
#pragma unroll
                    for (int bj = 0; bj < 2; ++bj) *(u32x4*)(rowp + bj * 128) = pack8(acc[ai][bj][m][0] * w, acc[ai][bj][m][1] * w); } }
    }
};
struct MoeOrder {
    int G, c, shift, NB; const LAS int* blkexp; const LAS int* blkstart; const LAS int* cntE; const int* LIST;
    __device__ __forceinline__ bool next(int i, Unit& u) const {
        const long L = (long)i * G + c; if (L >= ((long)NB << shift)) return false;
        const int blk = (int)(L >> shift), tile = (int)(L & ((1 << shift) - 1)), e = blkexp[blk];
        u.pm = blk; u.pn = (e << shift) + tile; u.e = e; u.s0 = (blk - blkstart[e]) * 256; u.cnt = cntE[e]; return true;
    }
    __device__ __forceinline__ int arow(const Unit& u, int r) const { const int slot = u.s0 + r; const int entry = slot < u.cnt ? LIST[(size_t)u.e * CAP + slot] : 0; return entry >> 1; }
};

struct Ctx { LAS unsigned char* lds; int tid, lane, wave, vcu, G; };

__device__ __forceinline__ void transpose_item(const float* W, int K, int N, bf16_t* WT, int kb, int nb, int dst_row0, LAS float* scr, int lane) {
    const int k0 = 64 * kb, n0 = 32 * nb;
    float tv[32];
#pragma unroll
    for (int i = 0; i < 32; ++i) tv[i] = W[(size_t)(k0 + 2 * i + (lane >> 5)) * N + n0 + (lane & 31)];
#pragma unroll
    for (int i = 0; i < 32; ++i) scr[(2 * i + (lane >> 5)) * 33 + (lane & 31)] = tv[i];
    asm volatile("s_waitcnt lgkmcnt(0)" ::: "memory");
    const int c = lane & 7;
#pragma unroll
    for (int j = 0; j < 4; ++j) { const int n = (lane >> 3) + 8 * j; const LAS float* s = scr + (8 * c) * 33 + n;
        u32x4 o; o.x = cvt_pk_bf16(s[0 * 33], s[1 * 33]); o.y = cvt_pk_bf16(s[2 * 33], s[3 * 33]); o.z = cvt_pk_bf16(s[4 * 33], s[5 * 33]); o.w = cvt_pk_bf16(s[6 * 33], s[7 * 33]);
        *(u32x4*)(WT + (size_t)(dst_row0 + n) * K + k0 + 8 * c) = o; }
    asm volatile("s_waitcnt lgkmcnt(0)" ::: "memory");
}
__device__ __forceinline__ void ln_stats(f32x4 (&v)[8], float& mean, float& rstd) {
    float s = 0.f;
#pragma unroll
    for (int j = 0; j < 8; ++j) s += (v[j].x + v[j].y) + (v[j].z + v[j].w);
    mean = wave_sum(s) * (1.f / DM); float s2 = 0.f;
#pragma unroll
    for (int j = 0; j < 8; ++j) { const f32x4 d = v[j] - mean; s2 += (d.x * d.x + d.y * d.y) + (d.z * d.z + d.w * d.w); }
    rstd = 1.f / sqrtf(wave_sum(s2) * (1.f / DM) + LN_EPS);
}

__device__ __forceinline__ void p0_prologue(const Ctx& C, const float* const* in, unsigned char* ws) {
    LAS float* scr = (LAS float*)(C.lds + C.wave * 16384);
    const int gw = C.vcu * 8 + C.wave, NGW = C.G * 8;
    bf16_t* WinT = (bf16_t*)(ws + WS_WIN); bf16_t* WgluT = (bf16_t*)(ws + WS_WGLU); bf16_t* WbsT = (bf16_t*)(ws + WS_WBS); bf16_t* WbaT = (bf16_t*)(ws + WS_WBA);
    bf16_t* WoT = (bf16_t*)(ws + WS_WO); bf16_t* WupT = (bf16_t*)(ws + WS_WUP);
    constexpr int I_WIN = (DM / 64) * (INC / 32), I_GLU = (SSMW / 64) * (SSMW / 32), I_BS = (SSMW / 64) * (DM / 32), I_BA = (AW / 64) * (DM / 32), I_WO = (DM / 64) * (DM / 32);
    constexpr int I_EXP = NE * 512;
    constexpr int NITEMS = I_WIN + I_GLU + I_BS + I_BA + I_WO + 2 * I_EXP;
    for (int it = gw; it < NITEMS; it += NGW) {
        int r = it;
        if (r < I_WIN) { const int nblk = INC / 32, nb = r % nblk, n0 = 32 * nb;
            const int drow = n0 < 3584 ? n0 : (n0 < 5632 ? 3584 + ((n0 - 3584) >> 7) * 256 + ((n0 - 3584) & 127) : 3584 + ((n0 - 5632) >> 7) * 256 + 128 + ((n0 - 5632) & 127));
            transpose_item(in[4], DM, INC, WinT, r / nblk, nb, drow, scr, C.lane); continue; } r -= I_WIN;
        if (r < I_GLU) { const int nblk = SSMW / 32; transpose_item(in[13], SSMW, SSMW, WgluT, r / nblk, r % nblk, 32 * (r % nblk), scr, C.lane); continue; } r -= I_GLU;
        if (r < I_BS) { const int nblk = DM / 32; transpose_item(in[19], SSMW, DM, WbsT, r / nblk, r % nblk, 32 * (r % nblk), scr, C.lane); continue; } r -= I_BS;
        if (r < I_BA) { const int nblk = DM / 32; transpose_item(in[20], AW, DM, WbaT, r / nblk, r % nblk, 32 * (r % nblk), scr, C.lane); continue; } r -= I_BA;
        if (r < I_WO) { const int nblk = DM / 32; transpose_item(in[21], DM, DM, WoT, r / nblk, r % nblk, 32 * (r % nblk), scr, C.lane); continue; } r -= I_WO;
        if (r < 2 * I_EXP) { const int up = r >= I_EXP ? 1 : 0; r -= up * I_EXP; const int e = r >> 9, rr = r & 511, kb = rr >> 4, nb = rr & 15, n0 = 32 * nb;
            transpose_item(in[28 + up] + (size_t)e * DM * DFF, DM, DFF, WupT, kb, nb, e * 1024 + (n0 >> 7) * 256 + up * 128 + (n0 & 127), scr, C.lane); continue; }
    }
    const int gt = C.vcu * 512 + C.tid, NGT = C.G * 512;
    { float* WrT = (float*)(ws + WS_WRT);
      for (int i = gt; i < 36 * DM; i += NGT) { const int n = i / DM, k = i % DM; WrT[i] = n < 4 ? in[24][k * 4 + n] : in[26][k * 32 + (n - 4)]; } }
    { u32x4* kz = (u32x4*)(ws + WS_KMETA + 16 * 1024 * 2); u32x4* vz = (u32x4*)(ws + WS_VMETA + 16 * 1024 * 2);
      for (int i = gt; i < 48 * 1024 * 2 / 16; i += NGT) { kz[i] = (u32x4){0u, 0u, 0u, 0u}; vz[i] = (u32x4){0u, 0u, 0u, 0u}; } }
    { float* AB = (float*)(ws + WS_SSMAB); float* BB = (float*)(ws + WS_SSMBB);
      for (int i = gt; i < NGRP * NST; i += NGT) { const int g = i >> 6;
        const double lre = fmin((double)in[5][i], -1e-4), lim = (double)in[6][i], dt = exp((double)in[7][g]);
        const double mag = exp(lre * dt), abr = mag * cos(lim * dt), abi = mag * sin(lim * dt), den = lre * lre + lim * lim, nr = abr - 1.0, ni = abi;
        const double zr = (nr * lre + ni * lim) / den, zi = (ni * lre - nr * lim) / den;
        AB[i] = (float)abr; AB[NGRP * NST + i] = (float)abi;
#pragma unroll 4
        for (int c = 0; c < 16; ++c) { const double br = (double)in[8][i * 16 + c], bi = (double)in[9][i * 16 + c];
            BB[i * 16 + c] = (float)(zr * br - zi * bi); BB[NGRP * NST * 16 + i * 16 + c] = (float)(zr * bi + zi * br); } } }
    const float* lg = in[2]; const float* lb = in[3];
    bf16_t* HBF = (bf16_t*)(ws + WS_HBF);
    for (int m = gw; m < T + NMETA; m += 2 * NGW) {
        const int m2 = (m + NGW < T + NMETA) ? m + NGW : m;
        const float* xa = m >= T ? in[1] + (size_t)(m - T) * DM : in[0] + (size_t)m * DM; const float* xb = m2 >= T ? in[1] + (size_t)(m2 - T) * DM : in[0] + (size_t)m2 * DM;
        f32x4 va[8], vb[8];
#pragma unroll
        for (int j = 0; j < 8; ++j) { va[j] = *(const f32x4*)(xa + 256 * j + 4 * C.lane); vb[j] = *(const f32x4*)(xb + 256 * j + 4 * C.lane); }
        float meana, rstda, meanb, rstdb; ln_stats(va, meana, rstda); ln_stats(vb, meanb, rstdb);
#pragma unroll
        for (int rr = 0; rr < 2; ++rr) { const int mm = rr ? m2 : m; if (rr == 1 && m2 == m) break; const bool meta = mm >= T;
#pragma unroll
            for (int j = 0; j < 8; ++j) { const f32x4 gg = *(const f32x4*)(lg + 256 * j + 4 * C.lane), bb = *(const f32x4*)(lb + 256 * j + 4 * C.lane);
                const f32x4 o = rr ? (vb[j] - meanb) * rstdb * gg + bb : (va[j] - meana) * rstda * gg + bb;
                if (meta) *(f32x4*)((float*)(ws + WS_HMETA) + (size_t)(mm - T) * DM + 256 * j + 4 * C.lane) = o;
                else { u32x2 w; w.x = cvt_pk_bf16(o.x, o.y); w.y = cvt_pk_bf16(o.z, o.w); *(u32x2*)(HBF + (size_t)mm * DM + 256 * j + 4 * C.lane) = w; } } }
    }
}

__device__ __forceinline__ void p1_meta_proj(const Ctx& C, unsigned char* ws) {
    const bf16_t* WinT = (const bf16_t*)(ws + WS_WIN); const float* HM = (const float*)(ws + WS_HMETA);
    const int gw = C.vcu * 8 + C.wave, NGW = C.G * 8;
    for (int it = gw; it < 640; it += NGW) {
        const int nidx = 4 * it; const int col0 = nidx < 512 ? nidx : (nidx < 1536 ? 1536 + (nidx - 512) : 2560 + (nidx - 1536));
        float acc[16][4];
#pragma unroll
        for (int r = 0; r < 16; ++r)
#pragma unroll
            for (int c = 0; c < 4; ++c) acc[r][c] = 0.f;
#pragma unroll 1
        for (int j = 0; j < 4; ++j) { const int k0 = j * 512 + C.lane * 8;
            f32x4 w0[4], w1[4];
#pragma unroll
            for (int c = 0; c < 4; ++c) { const u32x4 ww = *(const u32x4*)(WinT + (size_t)(col0 + c) * DM + k0); unpack8(ww, w0[c], w1[c]); }
#pragma unroll
            for (int r = 0; r < 16; ++r) { const f32x4 h0 = *(const f32x4*)(HM + r * DM + k0), h1 = *(const f32x4*)(HM + r * DM + k0 + 4);
#pragma unroll
                for (int c = 0; c < 4; ++c) { const f32x4 p = h0 * w0[c] + h1 * w1[c]; acc[r][c] += (p.x + p.y) + (p.z + p.w); } } }
        float mine = 0.f;
#pragma unroll
        for (int r = 0; r < 16; ++r)
#pragma unroll
            for (int c = 0; c < 4; ++c) { const float s = wave_sum(acc[r][c]); mine = (C.lane == r * 4 + c) ? s : mine; }
        const int r = C.lane >> 2, c = C.lane & 3;
        if (nidx < 512) ((float*)(ws + WS_UMETA))[r * SSMW + nidx + c] = mine;
        else if (nidx < 1536) ((bf16_t*)(ws + WS_KMETA))[r * AW + (nidx - 512) + c] = (bf16_t)(cvt_pk_bf16(mine, 0.f) & 0xffffu);
        else ((bf16_t*)(ws + WS_VMETA))[r * AW + (nidx - 1536) + c] = (bf16_t)(cvt_pk_bf16(mine, 0.f) & 0xffffu);
    }
}

__device__ __forceinline__ float gelu_tanh(float x) { const float u = 1.5957691216057308f * (x + 0.044715f * x * x * x); return x * __builtin_amdgcn_rcpf(1.0f + __expf(-u)); }
template <bool STORE> __device__ __forceinline__ void scan16(f32x16 (&bu)[4], float (&sre)[2], float (&sim)[2], const float (&are)[2], const float (&aim)[2]) {
#pragma unroll
    for (int reg = 0; reg < 16; ++reg)
#pragma unroll
        for (int st = 0; st < 2; ++st) {
            const float nre = __builtin_fmaf(are[st], sre[st], __builtin_fmaf(-aim[st], sim[st], bu[st][reg]));
            const float nim = __builtin_fmaf(are[st], sim[st], __builtin_fmaf(aim[st], sre[st], bu[2 + st][reg]));
            sre[st] = nre; sim[st] = nim;
            if (STORE) { bu[st][reg] = nre; bu[2 + st][reg] = nim; } }
}
__device__ __forceinline__ void p2_scan(const Ctx& C, const float* const* in, unsigned char* ws) {
    const int lane = C.lane, wave = C.wave, r32 = lane & 31, hi = lane >> 5, fr = lane & 15, fq = lane >> 4;
    const bf16_t* U = (const bf16_t*)(ws + WS_U); const float* UM = (const float*)(ws + WS_UMETA); bf16_t* YPRE = (bf16_t*)(ws + WS_YPRE);
    const float* AB = (const float*)(ws + WS_SSMAB); const float* BB = (const float*)(ws + WS_SSMBB);
    LAS unsigned char* Sl = C.lds + wave * 10752;
    LAS unsigned char* Yl = Sl + 9728;
    LAS float* E = (LAS float*)(C.lds + 86016);
    const int hc = 2 * wave + hi;
    const int urow = ((r32 >> 2) & 1) * 128 + (r32 & 3) + 4 * (r32 >> 3);
    for (int item = C.vcu; item < NB_ * NGRP; item += C.G) {
        const int b = item >> 5, g = item & 31;
        const bf16_t* Ub = U + ((size_t)b * SEQ + wave * 256) * SSMW + 16 * g;
        bf16x8 ufa[8];
#pragma unroll
        for (int blk = 0; blk < 8; ++blk) ufa[blk] = *(const bf16x8*)(Ub + (size_t)(16 * blk + urow) * SSMW + 8 * hi);
        float are[2], aim[2];
#pragma unroll
        for (int st = 0; st < 2; ++st) { are[st] = AB[g * 64 + 32 * st + r32]; aim[st] = AB[NGRP * NST + g * 64 + 32 * st + r32]; }
        bf16x8 Bf[4];
#pragma unroll
        for (int ri = 0; ri < 2; ++ri)
#pragma unroll
            for (int st = 0; st < 2; ++st) { const float* src = BB + ri * (NGRP * NST * 16) + (g * 64 + 32 * st + r32) * 16 + 8 * hi;
                const f32x4 x0 = *(const f32x4*)src, x1 = *(const f32x4*)(src + 4); Bf[2 * ri + st] = __builtin_bit_cast(bf16x8, pack8(x0, x1)); }
        bf16x8 Cf[5];
#pragma unroll
        for (int ks = 0; ks < 4; ++ks) { const int r0 = 8 * ks + 2 * fq; const float* cre = in[10] + (g * 16 + fr) * 64; const float* cim = in[11] + (g * 16 + fr) * 64;
            const f32x4 x0 = (f32x4){cre[r0], cre[32 + r0], -cim[r0], -cim[32 + r0]}, x1 = (f32x4){cre[r0 + 1], cre[33 + r0], -cim[r0 + 1], -cim[33 + r0]};
            Cf[ks] = __builtin_bit_cast(bf16x8, pack8(x0, x1)); }
        { const float dsk = in[12][g * 16 + fr]; f32x4 x0, x1;
#pragma unroll
          for (int j = 0; j < 4; ++j) { x0[j] = (fq < 2 && 8 * fq + j == fr) ? dsk : 0.f; x1[j] = (fq < 2 && 8 * fq + 4 + j == fr) ? dsk : 0.f; }
          Cf[4] = __builtin_bit_cast(bf16x8, pack8(x0, x1)); }
        float sre[2] = {0.f, 0.f}, sim[2] = {0.f, 0.f}, mre[2] = {0.f, 0.f}, mim[2] = {0.f, 0.f};
        if (wave == 0) {
            f32x4 x0 = (f32x4){0.f, 0.f, 0.f, 0.f}, x1 = x0;
            if (((r32 >> 2) & 1) == 0) { const float* src = UM + ((r32 & 3) + 4 * (r32 >> 3)) * SSMW + 16 * g + 8 * hi; x0 = *(const f32x4*)src; x1 = *(const f32x4*)(src + 4); }
            const bf16x8 uf = __builtin_bit_cast(bf16x8, pack8(x0, x1));
            f32x16 bu[4];
#pragma unroll
            for (int t = 0; t < 4; ++t) bu[t] = __builtin_amdgcn_mfma_f32_32x32x16_bf16(uf, Bf[t], (f32x16){}, 0, 0, 0);
            scan16<false>(bu, sre, sim, are, aim);
            mre[0] = sre[0]; mre[1] = sre[1]; mim[0] = sim[0]; mim[1] = sim[1];
        }
#pragma unroll
        for (int blk = 0; blk < 8; ++blk) {
            f32x16 bu[4];
#pragma unroll
            for (int t = 0; t < 4; ++t) bu[t] = __builtin_amdgcn_mfma_f32_32x32x16_bf16(ufa[blk], Bf[t], (f32x16){}, 0, 0, 0);
            scan16<false>(bu, sre, sim, are, aim);
        }
#pragma unroll
        for (int st = 0; st < 2; ++st) { E[hc * 128 + st * 64 + r32] = sre[st]; E[hc * 128 + st * 64 + 32 + r32] = sim[st]; }
        __syncthreads();
        {
            float pr[2], pi[2], cr[2], ci[2];
#pragma unroll
            for (int st = 0; st < 2; ++st) { pr[st] = are[st]; pi[st] = aim[st];
#pragma unroll
                for (int k = 0; k < 7; ++k) { const float nr = pr[st] * pr[st] - pi[st] * pi[st], ni = 2.f * pr[st] * pi[st]; pr[st] = nr; pi[st] = ni; }
                cr[st] = E[st * 64 + r32]; ci[st] = E[st * 64 + 32 + r32]; }
            for (int j = 1; j < 2 * wave + 1; ++j) {
                const bool on = j < hc;
#pragma unroll
                for (int st = 0; st < 2; ++st) { const float er = E[j * 128 + st * 64 + r32], ei = E[j * 128 + st * 64 + 32 + r32];
                    const float nr = pr[st] * cr[st] - pi[st] * ci[st] + er, ni = pr[st] * ci[st] + pi[st] * cr[st] + ei; cr[st] = on ? nr : cr[st]; ci[st] = on ? ni : ci[st]; } }
#pragma unroll
            for (int st = 0; st < 2; ++st) { sre[st] = hc == 0 ? mre[st] : cr[st]; sim[st] = hc == 0 ? mim[st] : ci[st]; }
        }
#pragma unroll
        for (int blk = 0; blk < 8; ++blk) {
            f32x16 bu[4];
#pragma unroll
            for (int t = 0; t < 4; ++t) bu[t] = __builtin_amdgcn_mfma_f32_32x32x16_bf16(ufa[blk], Bf[t], (f32x16){}, 0, 0, 0);
            scan16<true>(bu, sre, sim, are, aim);
#pragma unroll
            for (int reg = 0; reg < 16; ++reg) { const int row = (reg & 3) + 8 * (reg >> 2) + 4 * hi;
                u32x2 w; w.x = cvt_pk_bf16(bu[0][reg], bu[1][reg]); w.y = cvt_pk_bf16(bu[2][reg], bu[3][reg]);
                *(LAS u32x2*)(Sl + row * 304 + r32 * 8) = w; }
            *(LAS bf16x8*)(Sl + r32 * 304 + (128 + 8 * hi) * 2) = ufa[blk];
            f32x4 y[2];
#pragma unroll
            for (int mt = 0; mt < 2; ++mt) { y[mt] = (f32x4){0.f, 0.f, 0.f, 0.f};
#pragma unroll
                for (int ks = 0; ks < 4; ++ks) { const bf16x8 af = *(const LAS bf16x8*)(Sl + (16 * mt + fr) * 304 + (32 * ks + 8 * fq) * 2);
                    y[mt] = __builtin_amdgcn_mfma_f32_16x16x32_bf16(af, Cf[ks], y[mt], 0, 0, 0); }
                bf16x8 au = *(const LAS bf16x8*)(Sl + (16 * mt + fr) * 304 + (128 + 8 * (fq & 1)) * 2); if (fq >= 2) au = (bf16x8){};
                y[mt] = __builtin_amdgcn_mfma_f32_16x16x32_bf16(au, Cf[4], y[mt], 0, 0, 0); }
#pragma unroll
            for (int mt = 0; mt < 2; ++mt)
#pragma unroll
                for (int reg = 0; reg < 4; ++reg) *(LAS bf16_t*)(Yl + (16 * mt + 4 * fq + reg) * 32 + fr * 2) = (bf16_t)(cvt_pk_bf16(gelu_tanh(y[mt][reg]), 0.f) & 0xffffu);
            const u32x4 yo = *(const LAS u32x4*)(Yl + (lane >> 1) * 32 + (lane & 1) * 16);
            { const int row = lane >> 1, tok = ((row >> 2) & 1) * 128 + 16 * blk + (row & 3) + 4 * (row >> 3);
              *(u32x4*)(YPRE + ((size_t)b * SEQ + wave * 256 + tok) * SSMW + 16 * g + 8 * (lane & 1)) = yo; }
        }
        __syncthreads();
    }
}

__device__ __forceinline__ int crow(int r, int hi) { return (r & 3) + 8 * (r >> 2) + 4 * hi; }
typedef short v4i16_t __attribute__((ext_vector_type(4)));
__device__ __forceinline__ s16x4 vtr(const LAS unsigned char* p) { return __builtin_bit_cast(s16x4, __builtin_amdgcn_ds_read_tr16_b64_v4i16((LAS v4i16_t*)p)); }
__device__ __forceinline__ float half_swap_max(float x) { auto rr = __builtin_amdgcn_permlane32_swap(__float_as_uint(x), __float_as_uint(x), false, false); return fmaxf(__uint_as_float(rr[0]), __uint_as_float(rr[1])); }
__device__ __forceinline__ float half_swap_sum(float x) { auto rr = __builtin_amdgcn_permlane32_swap(__float_as_uint(x), __float_as_uint(x), false, false); return __uint_as_float(rr[0]) + __uint_as_float(rr[1]); }

__device__ __forceinline__ void attn_pv(f32x16 (&o)[4], const bf16x8 (&pa)[4], unsigned vaddr) {
    s16x4 vl[2][4], vh[2][4];
#define ATT_VRD(SET, D) do { _Pragma("unroll") for (int ks_ = 0; ks_ < 4; ++ks_) { \
        asm volatile("ds_read_b64_tr_b16 %0, %1 offset:%2" : "=&v"(vl[SET][ks_]) : "v"(vaddr), "i"((D) * 4096 + ks_ * 1024) : "memory"); \
        asm volatile("ds_read_b64_tr_b16 %0, %1 offset:%2" : "=&v"(vh[SET][ks_]) : "v"(vaddr), "i"((D) * 4096 + ks_ * 1024 + 512) : "memory"); } } while (0)
    __builtin_amdgcn_sched_barrier(0);
    ATT_VRD(0, 0);
#pragma unroll
    for (int d = 0; d < 4; ++d) {
        if (d == 0) { ATT_VRD(1, 1); } else if (d == 1) { ATT_VRD(0, 2); } else if (d == 2) { ATT_VRD(1, 3); }
        if (d < 3) asm volatile("s_waitcnt lgkmcnt(8)" ::: "memory"); else asm volatile("s_waitcnt lgkmcnt(0)" ::: "memory");
        __builtin_amdgcn_sched_barrier(0);
#pragma unroll
        for (int ks = 0; ks < 4; ++ks) { const s16x4 lo = vl[d & 1][ks], hv = vh[d & 1][ks];
            const bf16x8 vf = (bf16x8){lo[0], lo[1], lo[2], lo[3], hv[0], hv[1], hv[2], hv[3]};
            o[d] = __builtin_amdgcn_mfma_f32_32x32x16_bf16(pa[ks], vf, o[d], 0, 0, 0); }
        __builtin_amdgcn_sched_barrier(0);
    }
#undef ATT_VRD
}
__device__ __forceinline__ void attn_qk(f32x16& p0, f32x16& p1, const LAS unsigned char* kb, const bf16x8 (&qr)[4]) {
    p0 = (f32x16){}; p1 = (f32x16){};
#pragma unroll
    for (int d0 = 0; d0 < 4; ++d0) { const bf16x8 b0 = *(const LAS bf16x8*)(kb + d0 * 2048), b1 = *(const LAS bf16x8*)(kb + d0 * 2048 + 512);
        p0 = __builtin_amdgcn_mfma_f32_32x32x16_bf16(b0, qr[d0], p0, 0, 0, 0); p1 = __builtin_amdgcn_mfma_f32_32x32x16_bf16(b1, qr[d0], p1, 0, 0, 0); }
}
__device__ __forceinline__ void attn_softmax(const bool FIRST, f32x16& p0, f32x16& p1, f32x16 (&o)[4], float& mrun, float& lrun, bf16x8 (&pa)[4], LAS float* wsf, int r32, int hi) {
    if (FIRST) {
        asm volatile("" ::: "memory");
#pragma unroll
        for (int r = 0; r < 16; ++r) { if (r >= 8) p0[r] = -__builtin_inff(); p1[r] = -__builtin_inff(); } }
    float rmA = fmaxf(p0[0], p0[1]), rmB = fmaxf(p0[2], p0[3]), rmC = fmaxf(p1[0], p1[1]), rmD = fmaxf(p1[2], p1[3]);
#pragma unroll
    for (int r = 4; r < 16; r += 4) { rmA = fmaxf(rmA, fmaxf(p0[r], p0[r + 1])); rmB = fmaxf(rmB, fmaxf(p0[r + 2], p0[r + 3])); rmC = fmaxf(rmC, fmaxf(p1[r], p1[r + 1])); rmD = fmaxf(rmD, fmaxf(p1[r + 2], p1[r + 3])); }
    const float rm = half_swap_max(fmaxf(fmaxf(rmA, rmB), fmaxf(rmC, rmD)));
    if (FIRST) mrun = rm;
    else if (__any(rm > mrun + 8.0f)) {
        const float mnew = fmaxf(mrun, rm), alpha = __builtin_amdgcn_exp2f(mrun - mnew);
        lrun *= alpha; mrun = mnew;
        if (hi == 0) wsf[r32] = alpha;
        f32x4 a4[4];
#pragma unroll
        for (int gq = 0; gq < 4; ++gq) a4[gq] = *(const LAS f32x4*)(wsf + 8 * gq + 4 * hi);
#pragma unroll
        for (int d = 0; d < 4; ++d)
#pragma unroll
            for (int r = 0; r < 16; ++r) o[d][r] *= a4[r >> 2][r & 3];
    }
    float psA = 0.f, psB = 0.f, psC = 0.f, psD = 0.f;
#pragma unroll
    for (int r = 0; r < 16; r += 2) { p0[r] = __builtin_amdgcn_exp2f(p0[r] - mrun); p0[r + 1] = __builtin_amdgcn_exp2f(p0[r + 1] - mrun); p1[r] = __builtin_amdgcn_exp2f(p1[r] - mrun); p1[r + 1] = __builtin_amdgcn_exp2f(p1[r + 1] - mrun);
        psA += p0[r]; psB += p0[r + 1]; psC += p1[r]; psD += p1[r + 1]; }
    lrun += (psA + psB) + (psC + psD);
    u32x4 w;
    w = (u32x4){cvt_pk_bf16(p0[0], p0[1]), cvt_pk_bf16(p0[2], p0[3]), cvt_pk_bf16(p0[4], p0[5]), cvt_pk_bf16(p0[6], p0[7])}; pa[0] = __builtin_bit_cast(bf16x8, w);
    w = (u32x4){cvt_pk_bf16(p0[8], p0[9]), cvt_pk_bf16(p0[10], p0[11]), cvt_pk_bf16(p0[12], p0[13]), cvt_pk_bf16(p0[14], p0[15])}; pa[1] = __builtin_bit_cast(bf16x8, w);
    w = (u32x4){cvt_pk_bf16(p1[0], p1[1]), cvt_pk_bf16(p1[2], p1[3]), cvt_pk_bf16(p1[4], p1[5]), cvt_pk_bf16(p1[6], p1[7])}; pa[2] = __builtin_bit_cast(bf16x8, w);
    w = (u32x4){cvt_pk_bf16(p1[8], p1[9]), cvt_pk_bf16(p1[10], p1[11]), cvt_pk_bf16(p1[12], p1[13]), cvt_pk_bf16(p1[14], p1[15])}; pa[3] = __builtin_bit_cast(bf16x8, w);
}
__device__ __forceinline__ void glds16(const void* gsrc, unsigned lds_dst) { unsigned keep;
    asm volatile("s_mov_b32 %0, m0\n\ts_mov_b32 m0, %2\n\ts_nop 0\n\tglobal_load_lds_dwordx4 %1, off\n\ts_mov_b32 m0, %0" : "=&s"(keep) : "v"(gsrc), "s"(lds_dst) : "memory"); }
__device__ __forceinline__ void attn_unit(const Ctx& C, const bf16_t* Qg, const bf16_t* Kg, const bf16_t* Vg, const bf16_t* KM, const bf16_t* VM, bf16_t* Y,
                                          const float* subg, float lam, int b, int h, int qt, bool prefetched, int nqt, bf16x8 (&qr)[4], bool rb) {
    LAS unsigned char* lds = C.lds;
    const int lane = C.lane, wave = C.wave, r32 = lane & 31, hi = lane >> 5, qb = wave >> 1, map = wave & 1;
    const int q0 = qt * 128 + qb * 32;
    const size_t rowb = (size_t)b * SEQ;
    if (!prefetched) { const bf16_t* qp = Qg + (rowb + q0 + r32) * AW + h * 128 + map * 64 + hi * 8;
#pragma unroll
      for (int d0 = 0; d0 < 4; ++d0) qr[d0] = *(const bf16x8*)(qp + d0 * 16); }
    const int NT = 2 * qt + 3;
    const bool skip_last = (qb < 2);
    f32x16 o[4];
#pragma unroll
    for (int d = 0; d < 4; ++d) o[d] = (f32x16){};
    float mrun = -__builtin_inff(), lrun = 0.f;
    LAS float* wsf = (LAS float*)(lds + MISC_OFF + 4096 + wave * 256);
    const bf16_t* Kb = Kg + rowb * AW; const bf16_t* Vb = Vg + rowb * AW;
#define ATT_DMA(step, stage) do { const bf16_t* ks_ = (step) == 0 ? KM : Kb; const bf16_t* vs_ = (step) == 0 ? VM : Vb; const int row0_ = (step) == 0 ? 0 : ((step) - 1) * 64; \
    _Pragma("unroll") for (int i_ = 0; i_ < 2; ++i_) { const int p_ = 2 * wave + i_; \
        __builtin_amdgcn_global_load_lds((const unsigned*)(ks_ + (size_t)(row0_ + lane) * AW + h * 128 + (p_ >> 3) * 64 + (p_ & 7) * 8), (LAS unsigned*)(lds + (stage) * 32768 + p_ * 1024), 16, 0, 0); \
        __builtin_amdgcn_global_load_lds((const unsigned*)(vs_ + (size_t)(row0_ + 16 * (p_ & 3) + (lane >> 2)) * AW + h * 128 + (p_ >> 2) * 32 + (lane & 3) * 8), (LAS unsigned*)(lds + (stage) * 32768 + 16384 + p_ * 1024), 16, 0, 0); } } while (0)
    const int myNT = skip_last ? NT - 1 : NT;
    bf16x8 pa[4];
#pragma unroll
    for (int k = 0; k < 4; ++k) pa[k] = (bf16x8){};
    if (!prefetched) ATT_DMA(0, 0);
    asm volatile("s_waitcnt vmcnt(0)" ::: "memory"); __syncthreads();
    int stage = 0;
#pragma unroll 1
    for (int s = 0; s <= NT; ++s) {
        const int stn = stage == 2 ? 0 : stage + 1, stp = stage == 0 ? 2 : stage - 1;
        if (s + 1 < NT) ATT_DMA(s + 1, stn);
        if (rb && s >= 1 && s <= myNT) attn_pv(o, pa, (unsigned)(uintptr_t)(lds + stp * 32768 + 16384 + ((lane >> 4) & 1) * 32 + (lane & 3) * 8 + (4 * hi + ((lane & 15) >> 2)) * 64));
        if (s < myNT) {
            f32x16 p0, p1; attn_qk(p0, p1, lds + stage * 32768 + map * 8192 + hi * 1024 + r32 * 16, qr);
            attn_softmax(s == 0, p0, p1, o, mrun, lrun, pa, wsf, r32, hi);
            if (!rb) attn_pv(o, pa, (unsigned)(uintptr_t)(lds + stage * 32768 + 16384 + ((lane >> 4) & 1) * 32 + (lane & 3) * 8 + (4 * hi + ((lane & 15) >> 2)) * 64));
        }
        asm volatile("s_waitcnt vmcnt(0)" ::: "memory"); __syncthreads();
        stage = stn;
    }
#undef ATT_DMA
    bf16x8 qn[4];
#pragma unroll
    for (int d0 = 0; d0 < 4; ++d0) qn[d0] = qr[d0];
    if (nqt >= 0) {
        const unsigned lds0 = (unsigned)(uintptr_t)lds;
#pragma unroll
        for (int i = 0; i < 2; ++i) { const int p = 2 * wave + i;
            glds16(KM + (size_t)lane * AW + h * 128 + (p >> 3) * 64 + (p & 7) * 8, (unsigned)__builtin_amdgcn_readfirstlane(lds0 + p * 1024));
            glds16(VM + (size_t)(16 * (p & 3) + (lane >> 2)) * AW + h * 128 + (p >> 2) * 32 + (lane & 3) * 8, (unsigned)__builtin_amdgcn_readfirstlane(lds0 + 16384 + p * 1024)); }
        const bf16_t* qp = Qg + (rowb + nqt * 128 + qb * 32 + r32) * AW + h * 128 + map * 64 + hi * 8;
#pragma unroll
        for (int d0 = 0; d0 < 4; ++d0) qn[d0] = *(const bf16x8*)(qp + d0 * 16);
    }
    { const float ltot = half_swap_sum(lrun); const float inv = (map ? lam : 1.0f) / ltot;
      if (hi == 0) wsf[r32] = inv;
      f32x4 a4[4];
#pragma unroll
      for (int gq = 0; gq < 4; ++gq) a4[gq] = *(const LAS f32x4*)(wsf + 8 * gq + 4 * hi);
#pragma unroll
      for (int d = 0; d < 4; ++d)
#pragma unroll
          for (int r = 0; r < 16; ++r) o[d][r] *= a4[r >> 2][r & 3]; }
    LAS float* X = (LAS float*)(lds + 32768 + qb * 16384);
    if (map == 1) {
#pragma unroll
        for (int d = 0; d < 4; ++d)
#pragma unroll
            for (int r = 0; r < 16; ++r) X[crow(r, hi) * 128 + 32 * d + r32] = o[d][r];
    }
    __syncthreads();
    if (map == 0) {
        float ssq[16];
#pragma unroll
        for (int r = 0; r < 16; ++r) ssq[r] = 0.f;
#pragma unroll
        for (int d = 0; d < 4; ++d)
#pragma unroll
            for (int r = 0; r < 16; ++r) { const float v = o[d][r] - X[crow(r, hi) * 128 + 32 * d + r32]; o[d][r] = v; ssq[r] += v * v; }
#pragma unroll
        for (int r = 0; r < 16; ++r) {
            { float v = ssq[r]; v += dpp_f<0xB1>(v); v += dpp_f<0x4E>(v); v += dpp_f<0x141>(v); v += dpp_f<0x140>(v);
              auto r2 = __builtin_amdgcn_permlane16_swap(__float_as_uint(v), __float_as_uint(v), false, false); ssq[r] = __uint_as_float(r2[0]) + __uint_as_float(r2[1]); }
            ssq[r] = 0.8f / sqrtf(ssq[r] * (1.f / 128.f) + LN_EPS); }
        LAS bf16_t* Yt = (LAS bf16_t*)X;
#pragma unroll
        for (int d = 0; d < 4; ++d) { const float gg = subg[32 * d + r32];
#pragma unroll
            for (int r = 0; r < 16; ++r) Yt[crow(r, hi) * 128 + 32 * d + r32] = (bf16_t)(cvt_pk_bf16(o[d][r] * ssq[r] * gg, 0.f) & 0xffffu); }
#pragma unroll
        for (int i = 0; i < 8; ++i) { const int id = i * 64 + lane, row = id >> 4, ch = id & 15;
            *(u32x4*)(Y + (rowb + q0 + row) * AW + h * 128 + ch * 8) = *(const LAS u32x4*)(Yt + row * 128 + ch * 8); }
    }
#pragma unroll
    for (int d0 = 0; d0 < 4; ++d0) qr[d0] = qn[d0];
    __syncthreads();
}
__device__ __forceinline__ void p3_attention(const Ctx& C, const float* const* in, unsigned char* ws) {
    const bf16_t* Q = (const bf16_t*)(ws + WS_Q); const bf16_t* K = (const bf16_t*)(ws + WS_K); const bf16_t* V = (const bf16_t*)(ws + WS_V);
    const bf16_t* KM = (const bf16_t*)(ws + WS_KMETA); const bf16_t* VM = (const bf16_t*)(ws + WS_VMETA); bf16_t* Y = (bf16_t*)(ws + WS_YATT);
    const float l1 = wave_sum(in[14][C.lane] * in[15][C.lane]), l2 = wave_sum(in[16][C.lane] * in[17][C.lane]);
    const float lam = expf(l1) - expf(l2) + 0.2f;
    LAS unsigned* rc = (LAS unsigned*)(C.lds + MISC_OFF + 6144);
    if (C.tid < 4) rc[C.tid] = 0;
    __syncthreads();
    bool rb;
    { const unsigned simd = (unsigned)__builtin_amdgcn_s_getreg(2308) & 3u;
      unsigned r = 0; if (C.lane == 0) r = __hip_atomic_fetch_add(rc + simd, 1u, __ATOMIC_RELAXED, __HIP_MEMORY_SCOPE_WORKGROUP);
      rb = (__builtin_amdgcn_readfirstlane((int)r) & 1) != 0; }
#ifndef ATT_REP
#define ATT_REP 1
#endif
    for (int vv = C.vcu; vv < 256 * ATT_REP; vv += C.G) { const int v = vv & 255;
        const int bh = v >> 1, sft = v & 1;
        bf16x8 qr[4];
#pragma unroll
        for (int d0 = 0; d0 < 4; ++d0) qr[d0] = (bf16x8){};
#pragma unroll 1
        for (int i = 0; i < 8; ++i) { const int qt = (i & 1) ? (15 - sft - (i & ~1)) : (sft + (i & ~1)); const int i1 = i + 1;
            const int nqt = i1 < 8 ? ((i1 & 1) ? (15 - sft - (i1 & ~1)) : (sft + (i1 & ~1))) : -1;
            attn_unit(C, Q, K, V, KM, VM, Y, in[18], lam, bh >> 3, bh & 7, qt, i > 0, nqt, qr, rb); }
    }
}

__device__ __forceinline__ void p6_ln1_router(const Ctx& C, const float* const* in, unsigned char* ws) {
    const int lane = C.lane, wave = C.wave, tid = C.tid;
    const bf16_t* Z = (const bf16_t*)(ws + WS_Z); bf16_t* H1 = (bf16_t*)(ws + WS_H1); const float* WrT = (const float*)(ws + WS_WRT);
    int* LIST = (int*)(ws + WS_LIST); float* WGT = (float*)(ws + WS_WGT); unsigned* ECNT = (unsigned*)(ws + WS_CTL) + CW_ECNT;
    const float* lg = in[22]; const float* lb = in[23];
    LAS float* WB = (LAS float*)C.lds;
    LAS unsigned char* XB = C.lds + 98304;
    LAS int* RE = (LAS int*)(XB);
    LAS float* RW = (LAS float*)(XB + 1024);
    LAS int* CL = (LAS int*)(XB + 2048);
    LAS int* BS = (LAS int*)(XB + 2048 + 128);
    LAS int* SL = (LAS int*)(XB + 2048 + 256);
    LAS float* LG = (LAS float*)(XB + 4096) + wave * 80;
    for (int rbk = C.vcu; rbk < T / 128; rbk += C.G) {
        if (tid < 32) CL[tid] = 0;
#pragma unroll 1
        for (int step = 0; step < 8; ++step) {
            const int lr0 = step * 16 + 2 * wave; const size_t row0 = (size_t)rbk * 128 + lr0;
            int l4 = 4 * lane; asm volatile("" : "+v"(l4));
            f32x4 v0[8], v1[8];
#pragma unroll
            for (int j = 0; j < 8; ++j) { const u32x2 z0 = *(const u32x2*)(Z + row0 * DM + 256 * j + l4), z1 = *(const u32x2*)(Z + (row0 + 1) * DM + 256 * j + l4);
                v0[j] = (f32x4){bf_lo(z0.x), bf_hi(z0.x), bf_lo(z0.y), bf_hi(z0.y)}; v1[j] = (f32x4){bf_lo(z1.x), bf_hi(z1.x), bf_lo(z1.y), bf_hi(z1.y)}; }
            float mean0, rstd0, mean1, rstd1; ln_stats(v0, mean0, rstd0); ln_stats(v1, mean1, rstd1);
#pragma unroll
            for (int j = 0; j < 8; ++j) { const f32x4 gg = *(const f32x4*)(lg + 256 * j + l4), bb = *(const f32x4*)(lb + 256 * j + l4);
                v0[j] = (v0[j] - mean0) * rstd0 * gg + bb; v1[j] = (v1[j] - mean1) * rstd1 * gg + bb;
                u32x2 w; w.x = cvt_pk_bf16(v0[j].x, v0[j].y); w.y = cvt_pk_bf16(v0[j].z, v0[j].w); *(u32x2*)(H1 + row0 * DM + 256 * j + l4) = w;
                w.x = cvt_pk_bf16(v1[j].x, v1[j].y); w.y = cvt_pk_bf16(v1[j].z, v1[j].w); *(u32x2*)(H1 + (row0 + 1) * DM + 256 * j + l4) = w; }
#pragma unroll 1
            for (int ng = 0; ng < 3; ++ng) {
                __syncthreads();
                int tq = tid; asm volatile("" : "+v"(tq));
#pragma unroll
                for (int i = 0; i < 12; ++i) { const int idx = tq + 512 * i, n = idx >> 9, c4 = idx & 511;
                    *(LAS f32x4*)(WB + n * 2048 + 4 * c4) = *(const f32x4*)(WrT + (size_t)(12 * ng + n) * DM + 4 * c4); }
                __syncthreads();
#pragma unroll 1
                for (int n = 0; n < 12; ++n) { f32x4 qa = (f32x4){0.f, 0.f, 0.f, 0.f}, qb = qa;
#pragma unroll
                    for (int j = 0; j < 8; ++j) { const f32x4 w4 = *(const LAS f32x4*)(WB + n * 2048 + 256 * j + l4);
                        qa = v0[j] * w4 + qa; qb = v1[j] * w4 + qb; }
                    const float sa = wave_sum((qa.x + qa.y) + (qa.z + qa.w)), sb = wave_sum((qb.x + qb.y) + (qb.z + qb.w)); if (lane == 0) { LG[12 * ng + n] = sa; LG[40 + 12 * ng + n] = sb; } }
            }
            if (lane < 2) {
                const LAS float* L = LG + 40 * lane;
                int gi = 0; float gm = L[0] + in[25][0];
                for (int n = 1; n < 4; ++n) { const float x = L[n] + in[25][n]; if (x > gm) { gm = x; gi = n; } }
                float gs = 0.f;
                for (int n = 0; n < 4; ++n) gs += __expf(L[n] + in[25][n] - gm);
                const float gval = 1.0f / gs;
                int i1 = 0; float m1 = L[4 + gi * 8] + in[27][gi * 8];
                for (int j = 1; j < 8; ++j) { const float x = L[4 + gi * 8 + j] + in[27][gi * 8 + j]; if (x > m1) { m1 = x; i1 = j; } }
                int i2 = -1; float m2 = -__builtin_inff();
                for (int j = 0; j < 8; ++j) { const float x = L[4 + gi * 8 + j] + in[27][gi * 8 + j]; if (j != i1 && x > m2) { m2 = x; i2 = j; } }
                const float tt = __expf(m2 - m1), w1 = gval / (1.f + tt), w2 = gval * tt / (1.f + tt);
                const int lr = lr0 + lane; RE[lr * 2] = gi * 8 + i1; RE[lr * 2 + 1] = gi * 8 + i2; RW[lr * 2] = w1; RW[lr * 2 + 1] = w2;
            }
        }
        __syncthreads();
        int e = 0;
        if (tid < 256) { e = RE[tid]; SL[tid] = __hip_atomic_fetch_add(&CL[e], 1, __ATOMIC_RELAXED, __HIP_MEMORY_SCOPE_WORKGROUP); }
        __syncthreads();
        if (tid < 32) BS[tid] = (int)__hip_atomic_fetch_add(&ECNT[tid], (unsigned)CL[tid], __ATOMIC_RELAXED, __HIP_MEMORY_SCOPE_AGENT);
        __syncthreads();
        if (tid < 256) { const int entry = (rbk * 128 + (tid >> 1)) * 2 + (tid & 1); LIST[(size_t)e * CAP + BS[e] + SL[tid]] = entry; WGT[entry] = RW[tid]; }
        __syncthreads();
    }
}

__device__ __forceinline__ void p9_ln2(const Ctx& C, const float* const* in, unsigned char* ws, float* out) {
    const bf16_t* H1 = (const bf16_t*)(ws + WS_H1); const bf16_t* YK = (const bf16_t*)(ws + WS_YK);
    const float* lg = in[31]; const float* lb = in[32];
    const int gw = C.vcu * 8 + C.wave, NGW = C.G * 8, lane = C.lane;
    for (int m = gw; m < T; m += 2 * NGW) {
        const int m2 = (m + NGW < T) ? m + NGW : m;
        u32x2 ha[8], ya0[8], ya1[8], hb[8], yb0[8], yb1[8];
#pragma unroll
        for (int j = 0; j < 8; ++j) { const size_t c = 256 * j + 4 * lane;
            ha[j] = *(const u32x2*)(H1 + (size_t)m * DM + c); ya0[j] = *(const u32x2*)(YK + (size_t)(2 * m) * DM + c); ya1[j] = *(const u32x2*)(YK + (size_t)(2 * m + 1) * DM + c);
            hb[j] = *(const u32x2*)(H1 + (size_t)m2 * DM + c); yb0[j] = *(const u32x2*)(YK + (size_t)(2 * m2) * DM + c); yb1[j] = *(const u32x2*)(YK + (size_t)(2 * m2 + 1) * DM + c); }
#pragma unroll
        for (int rr = 0; rr < 2; ++rr) {
            f32x4 v[8];
#pragma unroll
            for (int j = 0; j < 8; ++j) { const u32x2 hw = rr ? hb[j] : ha[j], y0 = rr ? yb0[j] : ya0[j], y1 = rr ? yb1[j] : ya1[j];
                v[j] = (f32x4){bf_lo(hw.x), bf_hi(hw.x), bf_lo(hw.y), bf_hi(hw.y)} * ALPHA + (f32x4){bf_lo(y0.x), bf_hi(y0.x), bf_lo(y0.y), bf_hi(y0.y)} + (f32x4){bf_lo(y1.x), bf_hi(y1.x), bf_lo(y1.y), bf_hi(y1.y)}; }
            float mean, rstd; ln_stats(v, mean, rstd);
            const int mm = rr ? m2 : m;
            if (rr == 0 || m2 != m) {
#pragma unroll
                for (int j = 0; j < 8; ++j) { const f32x4 gg = *(const f32x4*)(lg + 256 * j + 4 * lane), bb = *(const f32x4*)(lb + 256 * j + 4 * lane);
                    *(f32x4*)(out + (size_t)mm * DM + 256 * j + 4 * lane) = (v[j] - mean) * rstd * gg + bb; } }
        }
    }
}

__device__ __forceinline__ int build_moe_tables(const Ctx& C, unsigned char* ws) {
    LAS int* blkstart = (LAS int*)(C.lds + MISC_OFF + 64); LAS int* cntE = (LAS int*)(C.lds + MISC_OFF + 320); LAS int* blkexp = (LAS int*)(C.lds + MISC_OFF + 512);
    unsigned* ECNT = (unsigned*)(ws + WS_CTL) + CW_ECNT;
    __syncthreads();
    if (C.tid < 32) cntE[C.tid] = (int)__hip_atomic_load(&ECNT[C.tid], __ATOMIC_RELAXED, __HIP_MEMORY_SCOPE_AGENT);
    __syncthreads();
    if (C.tid == 0) { int s = 0; for (int e = 0; e < NE; ++e) { blkstart[e] = s; s += (cntE[e] + 255) >> 8; } blkstart[NE] = s; }
    __syncthreads();
    const int NBLK = blkstart[NE];
    if (C.tid < NBLK && C.tid < 320) { int e = 0; for (int j = 1; j < NE; ++j) if (blkstart[j] <= C.tid) e = j; blkexp[C.tid] = e; }
    __syncthreads();
    return NBLK < 320 ? NBLK : 320;
}

__device__ __forceinline__ void p7_convert_down(const Ctx& C, const float* const* in, unsigned char* ws) {
    LAS float* scr = (LAS float*)(C.lds + C.wave * 16384);
    unsigned* ctr = (unsigned*)(ws + WS_CTL) + CW_CONV; bf16_t* WdnT = (bf16_t*)(ws + WS_WDN);
    constexpr int NCH = NE * 512 / 16;
    for (;;) {
        unsigned ch = 0; if (C.lane == 0) ch = __hip_atomic_fetch_add(ctr, 1u, __ATOMIC_RELAXED, __HIP_MEMORY_SCOPE_AGENT);
        ch = (unsigned)__builtin_amdgcn_readfirstlane((int)ch);
        if (ch >= (unsigned)NCH) break;
#pragma unroll 1
        for (int q = 0; q < 16; ++q) { const int r = (int)ch * 16 + q, e = r >> 9, rr = r & 511, kb = rr >> 6, nb = rr & 63;
            transpose_item(in[30] + (size_t)e * DFF * DM, DFF, DM, WdnT, kb, nb, e * 2048 + 32 * nb, scr, C.lane); }
    }
}

constexpr int NPHASE = 10;
struct Args { const float* in[33]; float* out; unsigned char* ws; int ph_lo, ph_hi; };
__global__ void __launch_bounds__(512, 2) mk_fwd(Args args) {
    extern __shared__ __attribute__((aligned(16))) unsigned char lds_raw[];
    Ctx C; C.lds = (LAS unsigned char*)lds_raw; C.tid = threadIdx.x; C.lane = C.tid & 63; C.wave = __builtin_amdgcn_readfirstlane(C.tid >> 6);
    C.G = gridDim.x; { const int bx = blockIdx.x; C.vcu = (C.G % 8 == 0) ? (bx % 8) * (C.G / 8) + bx / 8 : bx; }
    unsigned char* ws = args.ws; const float* const* in = args.in;
    volatile LAS unsigned* MISC = (volatile LAS unsigned*)(C.lds + MISC_OFF);
    if (C.tid < 16) MISC[C.tid] = 0u;
    __syncthreads();
    unsigned* barw = (unsigned*)(ws + WS_CTL) + CW_BAR;
    XcdBarrier bar; bar.bar = barw; bar.x = 0; bar.st = nullptr;
    const int lo = args.ph_lo, hi = args.ph_hi;
    if (hi - lo > 1) bar = xcd_barrier_post(barw, MISC);
#ifndef PH_MASK
#define PH_MASK 0x3ff
#endif
#define IN(k) (((PH_MASK >> (k)) & 1) && lo <= (k) && (k) < hi)
#define SEAM(k) do { if (IN(k) && IN((k) + 1)) xcd_barrier(bar); } while (0)
#ifndef WGM_PROJ
#define WGM_PROJ 4
#endif
#ifndef WGM_N2K
#define WGM_N2K 2
#endif
#ifndef GEMM_SP2
#define GEMM_SP2 true
#endif
#ifndef GEMM_ALIGN
#define GEMM_ALIGN true
#endif
#ifndef PROBE_MASK
#define PROBE_MASK 0
#endif
#define REPS(k) (((PROBE_MASK >> (k)) & 1) ? 2 : 1)
#define REPSEAM(k, rep) do { if ((rep) + 1 < REPS(k)) xcd_barrier(bar); } while (0)
    LAS unsigned char* lds = C.lds;
    bf16_t* MG = (bf16_t*)args.out;

    if (IN(0)) { _Pragma("unroll") for (int rep = 0; rep < REPS(0); ++rep) { p0_prologue(C, in, ws); REPSEAM(0, rep); } } SEAM(0);

    if (IN(1)) { _Pragma("unroll") for (int rep = 0; rep < REPS(1); ++rep) {
        pg8::Gemm g{(const bf16_t*)(ws + WS_HBF), (const bf16_t*)(ws + WS_WIN), T, INC, DM, nullptr, nullptr, 0}; pg8::StaticOrder S; S.init(T, INC, C.G, (int)blockIdx.x, WGM_PROJ);
        EpiProj E{(bf16_t*)(ws + WS_U), (bf16_t*)(ws + WS_Q), (bf16_t*)(ws + WS_K), (bf16_t*)(ws + WS_V), (bf16_t*)(ws + WS_SGS), (bf16_t*)(ws + WS_SGA)};
        pg8::gemm_phase<EpiProj, pg8::StaticOrder, GEMM_ALIGN, GEMM_SP2, false>(lds, g, S, E);
        p1_meta_proj(C, ws);
        REPSEAM(1, rep);
    } } SEAM(1);

    if (IN(2)) { _Pragma("unroll") for (int rep = 0; rep < REPS(2); ++rep) { p2_scan(C, in, ws); REPSEAM(2, rep); } } SEAM(2);

    if (IN(3)) { _Pragma("unroll") for (int rep = 0; rep < REPS(3); ++rep) {
        { pg8::Gemm g{(const bf16_t*)(ws + WS_YPRE), (const bf16_t*)(ws + WS_WGLU), T, SSMW, SSMW, nullptr, nullptr, 0}; pg8::StaticOrder S; S.init(T, SSMW, C.G, (int)blockIdx.x);
          EpiGlu E{(const bf16_t*)(ws + WS_YPRE), (bf16_t*)(ws + WS_YSSM)};
          pg8::gemm_phase<EpiGlu, pg8::StaticOrder, GEMM_ALIGN, GEMM_SP2, false>(lds, g, S, E); }
        p3_attention(C, in, ws);
        REPSEAM(3, rep);
    } } SEAM(3);

    if (IN(4)) { _Pragma("unroll") for (int rep = 0; rep < REPS(4); ++rep) {
        { pg8::Gemm g{(const bf16_t*)(ws + WS_YSSM), (const bf16_t*)(ws + WS_WBS), T, DM, SSMW, (const bf16_t*)(ws + WS_YATT), (const bf16_t*)(ws + WS_WBA), AW}; pg8::StaticOrder S; S.init(T, DM, C.G, (int)blockIdx.x, WGM_N2K);
          EpiMergeF E{(const bf16_t*)(ws + WS_SGS), (const bf16_t*)(ws + WS_SGA), MG};
          pg8::gemm_phase<EpiMergeF, pg8::StaticOrder, GEMM_ALIGN, GEMM_SP2, false, true>(lds, g, S, E); }
        REPSEAM(4, rep);
    } } SEAM(4);

    if (IN(5)) { _Pragma("unroll") for (int rep = 0; rep < REPS(5); ++rep) {
        pg8::Gemm g{MG, (const bf16_t*)(ws + WS_WO), T, DM, DM, nullptr, nullptr, 0}; pg8::StaticOrder S; S.init(T, DM, C.G, (int)blockIdx.x, WGM_N2K);
        EpiZ E{(const bf16_t*)(ws + WS_HBF), (bf16_t*)(ws + WS_Z)};
        pg8::gemm_phase<EpiZ, pg8::StaticOrder, GEMM_ALIGN, GEMM_SP2, false>(lds, g, S, E);
        REPSEAM(5, rep);
    } } SEAM(5);

    if (IN(6)) { p6_ln1_router(C, in, ws); } SEAM(6);

    if (IN(7)) { _Pragma("unroll") for (int rep = 0; rep < REPS(7); ++rep) {
        const int NBLK = build_moe_tables(C, ws);
        MoeOrder S{C.G, C.vcu, 2, NBLK, (const LAS int*)(lds + MISC_OFF + 512), (const LAS int*)(lds + MISC_OFF + 64), (const LAS int*)(lds + MISC_OFF + 320), (const int*)(ws + WS_LIST)};
        pg8::Gemm g{(const bf16_t*)(ws + WS_H1), (const bf16_t*)(ws + WS_WUP), T, NE * 1024, DM, nullptr, nullptr, 0};
        EpiSwiglu E{(bf16_t*)(ws + WS_HB), (const int*)(ws + WS_LIST), (const float*)(ws + WS_WGT), (int*)(ws + WS_POSE), (float*)(ws + WS_POSW)};
        pg8::gemm_phase<EpiSwiglu, MoeOrder, GEMM_ALIGN, GEMM_SP2, true>(lds, g, S, E);
        p7_convert_down(C, in, ws);
        REPSEAM(7, rep);
    } } SEAM(7);

    if (IN(8)) { _Pragma("unroll") for (int rep = 0; rep < REPS(8); ++rep) {
        const int NBLK = build_moe_tables(C, ws);
        MoeOrder S{C.G, C.vcu, 3, NBLK, (const LAS int*)(lds + MISC_OFF + 512), (const LAS int*)(lds + MISC_OFF + 64), (const LAS int*)(lds + MISC_OFF + 320), (const int*)(ws + WS_LIST)};
        pg8::Gemm g{(const bf16_t*)(ws + WS_HB), (const bf16_t*)(ws + WS_WDN), NBLK * 256, NE * DM, DFF, nullptr, nullptr, 0};
        EpiDown E{(const int*)(ws + WS_POSE), (const float*)(ws + WS_POSW), (bf16_t*)(ws + WS_YK)};
        pg8::gemm_phase<EpiDown, MoeOrder, GEMM_ALIGN, GEMM_SP2, false>(lds, g, S, E);
        REPSEAM(8, rep);
    } } SEAM(8);

    if (IN(9)) { _Pragma("unroll") for (int rep = 0; rep < REPS(9); ++rep) { p9_ln2(C, in, ws, args.out); REPSEAM(9, rep); } }
#undef IN
#undef SEAM
}

extern "C" void kernel_launch(void* const* d_in, const int* in_sizes, int n_in, void* d_out, int out_size, void* d_ws, size_t ws_size, hipStream_t stream) {
    static int grid = 0;
    if (grid == 0) {
        if (n_in != 33 || in_sizes[0] != T * DM || out_size != T * DM || ws_size < WS_END) { fprintf(stderr, "kernel_launch: unexpected shapes (n_in %d, in0 %d, out %d, ws %zu)\n", n_in, n_in > 0 ? in_sizes[0] : -1, out_size, ws_size); grid = -1; return; }
        int dev = 0, cus = 0, per_cu = 0;
        if (hipGetDevice(&dev) != hipSuccess || hipDeviceGetAttribute(&cus, hipDeviceAttributeMultiprocessorCount, dev) != hipSuccess) { grid = -1; return; }
        if (hipFuncSetAttribute((const void*)mk_fwd, hipFuncAttributeMaxDynamicSharedMemorySize, LDS_BYTES) != hipSuccess) { fprintf(stderr, "kernel_launch: hipFuncSetAttribute failed\n"); grid = -1; return; }
        if (hipOccupancyMaxActiveBlocksPerMultiprocessor(&per_cu, (const void*)mk_fwd, 512, LDS_BYTES) != hipSuccess || per_cu < 1) { fprintf(stderr, "kernel_launch: occupancy query reports %d blocks per CU\n", per_cu); }
        (void)hipGetLastError();
        grid = cus;
    }
    if (grid < 0) return;
    (void)hipMemsetAsync((char*)d_ws + WS_CTL, 0, CTL_ZERO_BYTES, stream);
    Args a{};
    for (int i = 0; i < 33; ++i) a.in[i] = (const float*)d_in[i];
    a.out = (float*)d_out; a.ws = (unsigned char*)d_ws;
#if MK_PER_PHASE
    for (int p = 0; p < NPHASE; ++p) { a.ph_lo = p; a.ph_hi = p + 1; hipLaunchKernelGGL(mk_fwd, dim3(grid), dim3(512), LDS_BYTES, stream, a); }
#else
    a.ph_lo = 0; a.ph_hi = NPHASE; hipLaunchKernelGGL(mk_fwd, dim3(grid), dim3(512), LDS_BYTES, stream, a);
#endif
}
```

```cpp
#include <hip/hip_runtime.h>
#include <stdint.h>
#include <stdio.h>

#ifndef ATT_PROBE
#define ATT_PROBE 0
#endif
#ifndef MK_PER_PHASE
#define MK_PER_PHASE 0
#endif

#define GAS __attribute__((address_space(1)))
#define LAS __attribute__((address_space(3)))
typedef unsigned short bf16_t;
typedef short bf16x8 __attribute__((ext_vector_type(8)));
typedef short s16x4 __attribute__((ext_vector_type(4)));
typedef float f32x2 __attribute__((ext_vector_type(2)));
typedef float f32x4 __attribute__((ext_vector_type(4)));
typedef float f32x16 __attribute__((ext_vector_type(16)));
typedef unsigned u32x2 __attribute__((ext_vector_type(2)));
typedef unsigned u32x4 __attribute__((ext_vector_type(4)));

constexpr int NB_ = 16, SEQ = 2048, DM = 2048, T = NB_ * SEQ, NMETA = 16;
constexpr int SSMW = 512, AW = 1024, INC = 7680, NGRP = 32, NST = 64;
constexpr int NE = 32, DFF = 512, CAP = T;
constexpr float LN_EPS = 1e-5f;
constexpr float ALPHA = 1.189207115002721f;
constexpr float QSCALE = 0.125f * 1.4426950408889634f;

__device__ __forceinline__ unsigned cvt_pk_bf16(float lo, float hi) { unsigned r; asm volatile("v_cvt_pk_bf16_f32 %0, %1, %2" : "=v"(r) : "v"(lo), "v"(hi)); return r; }
__device__ __forceinline__ float bf_lo(unsigned w) { return __uint_as_float(w << 16); }
__device__ __forceinline__ float bf_hi(unsigned w) { return __uint_as_float(w & 0xffff0000u); }
__device__ __forceinline__ float sigmoidf_(float x) { return __builtin_amdgcn_rcpf(1.0f + __expf(-x)); }
template <int CTRL> __device__ __forceinline__ float dpp_f(float v) { return __int_as_float(__builtin_amdgcn_update_dpp(0, __float_as_int(v), CTRL, 0xf, 0xf, true)); }
__device__ __forceinline__ float wave_sum(float v) {
    v += dpp_f<0xB1>(v);
    v += dpp_f<0x4E>(v);
    v += dpp_f<0x141>(v);
    v += dpp_f<0x140>(v);
    { auto r = __builtin_amdgcn_permlane16_swap(__float_as_uint(v), __float_as_uint(v), false, false); v = __uint_as_float(r[0]) + __uint_as_float(r[1]); }
    { auto r = __builtin_amdgcn_permlane32_swap(__float_as_uint(v), __float_as_uint(v), false, false); v = __uint_as_float(r[0]) + __uint_as_float(r[1]); }
    return v;
}

namespace pg8 {
constexpr int BM = 256, BK = 64, HALF = 128, HTB = HALF * BK * 2, STAGE_BYTES = 8 * HTB, NXCD = 8, WGM = 4;
__host__ __device__ __forceinline__ int lds_byte(int r, int c) { const int st = (r >> 4) * 2 + (c >> 5), rr = r & 15, cc = c & 31, ob = rr * 64 + cc * 2; return st * 1024 + (ob ^ (((ob >> 9) & 1) << 5)); }
__host__ __device__ __forceinline__ void stage_rc(int b, int& R, int& C) { const int st = b / 1024, sb = b % 1024, swz = sb ^ (((sb >> 9) & 1) << 5); R = (st >> 1) * 16 + swz / 64; C = (st & 1) * 32 + (swz % 64) / 2; }
__host__ __device__ __forceinline__ int perm32(int rho) { const int n = rho >> 4, i = rho & 15; return 8 * (i >> 2) + 4 * n + (i & 3); }

struct Unit { int pm, pn, e, s0, cnt; };
struct Gemm { const bf16_t* A; const bf16_t* Bt; int M, N, K; const bf16_t* A2; const bf16_t* Bt2; int K2; };

struct StaticOrder {
    int nM, nN, nwg, G, c, wgm;
    __device__ void init(int M, int N, int G_, int c_, int wgm_ = WGM) { nM = M / BM; nN = N / BM; nwg = nM * nN; G = G_; c = c_; wgm = wgm_; }
    __device__ bool next(int i, Unit& u) const {
        const long L = (long)i * G + c; if (L >= nwg) return false;
        int wgid = (int)L; { const int q = nwg / NXCD, r = nwg % NXCD, xcd = wgid % NXCD, off = wgid / NXCD; wgid = (xcd < r ? xcd * (q + 1) : r * (q + 1) + (xcd - r) * q) + off; }
        const int nig = wgm * nN, gid = wgid / nig, fm = gid * wgm, gsz = (nM - fm) < wgm ? (nM - fm) : wgm;
        u.pm = fm + ((wgid % nig) % gsz); u.pn = (wgid % nig) / gsz; u.e = 0; u.s0 = 0; u.cnt = 0; return true;
    }
    __device__ __forceinline__ int arow(const Unit&, int) const { return 0; }
};

template <class Epi, class Sched, bool ALIGN_EPI, bool SP2, bool GATHER, bool DUAL = false>
__device__ __forceinline__ void gemm_phase(LAS unsigned char* lds, const Gemm g, const Sched& S, const Epi& E) {
    const int tid = threadIdx.x, wid = __builtin_amdgcn_readfirstlane(tid >> 6), lane = tid & 63, wr = wid >> 2, wc = wid & 3, fr = lane & 15, fq = lane >> 4;
    const int K = g.K, K2 = DUAL ? g.K2 : 0, nt1 = K / BK, nt = (K + K2) / BK;
    unsigned voffA[2], voffB[2], voffA2[2] = {0u, 0u}, voffB2[2] = {0u, 0u}; int stR[2], stC[2];
#pragma unroll
    for (int i = 0; i < 2; ++i) { int R, C; stage_rc(tid * 16 + i * 8192, R, C); const int Rb = Epi::PERM ? ((R & ~31) + perm32(R & 31)) : R;
        stR[i] = R; stC[i] = C; voffA[i] = (unsigned)(R * K + C) * 2u; voffB[i] = (unsigned)(Rb * K + C) * 2u;
        if constexpr (DUAL) { voffA2[i] = (unsigned)(R * K2 + C) * 2u; voffB2[i] = (unsigned)(Rb * K2 + C) * 2u; } }
    const size_t kstep = (size_t)(BK * 2);
    const size_t hstep = (size_t)HALF * K * 2;
    const size_t tstep = 2 * hstep;
    const size_t hstep2 = (size_t)HALF * K2 * 2, tstep2 = 2 * hstep2;
    const unsigned ldsw = (unsigned)wid * 1024u;
    const int aoff = lds_byte(wr * 64 + fr, fq * 8), boff = lds_byte(wc * 32 + fr, fq * 8);
#define PG8_SA(b, h) (((b) * 2 + (h)) * HTB)
#define PG8_SB(b, h) ((4 + (b) * 2 + (h)) * HTB)
#define PG8_STAGE(bufoff, gbase, voff) do { _Pragma("unroll") for (int _i = 0; _i < 2; ++_i) \
        __builtin_amdgcn_global_load_lds((const unsigned*)((const char*)(gbase) + (voff)[_i]), (LAS unsigned*)(lds + (bufoff) + ldsw + _i * 8192), 16, 0, 0); } while (0)
#define PG8_STAGE_A(bufoff, kbase, h, VO) do { if constexpr (GATHER) { PG8_STAGE(bufoff, kbase, VO[h]); } else { PG8_STAGE(bufoff, (kbase) + (h) * hstep, voffA); } } while (0)
#define PG8_STAGE_AX(bufoff, kbase, h, VO, HS, VA) do { if constexpr (GATHER) { PG8_STAGE(bufoff, kbase, VO[h]); } else { PG8_STAGE(bufoff, (kbase) + (h) * (HS), VA); } } while (0)
#define PG8_LDA(dst, b, h) do { _Pragma("unroll") for (int m = 0; m < 4; ++m) _Pragma("unroll") for (int k = 0; k < 2; ++k) dst[m][k] = *(const LAS bf16x8*)(lds + PG8_SA(b, h) + aoff + m * 2048 + k * 1024); } while (0)
#define PG8_LDB(dst, b, h) do { _Pragma("unroll") for (int n = 0; n < 2; ++n) _Pragma("unroll") for (int k = 0; k < 2; ++k) dst[n][k] = *(const LAS bf16x8*)(lds + PG8_SB(b, h) + boff + n * 2048 + k * 1024); } while (0)
#define PG8_MMA(ai, bj, At, Bt) do { __builtin_amdgcn_s_setprio(1); _Pragma("unroll") for (int m = 0; m < 4; ++m) _Pragma("unroll") for (int n = 0; n < 2; ++n) _Pragma("unroll") for (int k = 0; k < 2; ++k) \
        acc[ai][bj][m][n] = __builtin_amdgcn_mfma_f32_16x16x32_bf16(Bt[n][k], At[m][k], acc[ai][bj][m][n], 0, 0, 0); __builtin_amdgcn_s_setprio(0); } while (0)
#define PG8_WAIT_V(n) asm volatile("s_waitcnt vmcnt(" #n ")" ::: "memory")
#define PG8_WAIT_L(n) asm volatile("s_waitcnt lgkmcnt(" #n ")" ::: "memory")
#define PG8_BAR __builtin_amdgcn_s_barrier()
#define PG8_SCHED __builtin_amdgcn_sched_barrier(0)
#define PG8_GOFF(VO, U) do { _Pragma("unroll") for (int _h = 0; _h < 2; ++_h) _Pragma("unroll") for (int _i = 0; _i < 2; ++_i) \
        VO[_h][_i] = (unsigned)S.arow(U, _h * HALF + stR[_i]) * (unsigned)(K * 2) + (unsigned)(stC[_i] * 2); } while (0)
    Unit cur, nxt; int ui = 0;
    if (!S.next(0, cur)) return;
    f32x4 acc[2][2][4][2];
#pragma unroll
    for (int a = 0; a < 2; ++a)
#pragma unroll
        for (int b = 0; b < 2; ++b)
#pragma unroll
            for (int m = 0; m < 4; ++m)
#pragma unroll
                for (int n = 0; n < 2; ++n) acc[a][b][m][n] = (f32x4){0.f, 0.f, 0.f, 0.f};
    bf16x8 At[4][2], B0[2][2], B1[2][2];
    unsigned cvo[2][2] = {{0u, 0u}, {0u, 0u}}, nvo[2][2] = {{0u, 0u}, {0u, 0u}};
    const char* cA = GATHER ? (const char*)g.A : (const char*)g.A + (size_t)cur.pm * tstep; const char* cB = (const char*)g.Bt + (size_t)cur.pn * tstep;
    if constexpr (GATHER) { PG8_GOFF(cvo, cur); }
    if constexpr (SP2) {
        PG8_STAGE(PG8_SB(0, 0), cB, voffB); PG8_STAGE(PG8_SB(0, 1), cB + hstep, voffB); PG8_STAGE_A(PG8_SA(0, 0), cA, 0, cvo); PG8_STAGE_A(PG8_SA(0, 1), cA, 1, cvo);
        if (wr == 1) PG8_BAR;
        PG8_WAIT_V(2); PG8_BAR;
        PG8_STAGE(PG8_SB(1, 0), cB + kstep, voffB); PG8_STAGE_A(PG8_SA(1, 0), cA + kstep, 0, cvo); PG8_STAGE(PG8_SB(1, 1), cB + hstep + kstep, voffB);
        PG8_WAIT_V(6); PG8_BAR;
    } else {
        PG8_STAGE(PG8_SB(0, 0), cB, voffB); PG8_STAGE_A(PG8_SA(0, 0), cA, 0, cvo); PG8_STAGE(PG8_SB(0, 1), cB + hstep, voffB); PG8_STAGE_A(PG8_SA(0, 1), cA, 1, cvo);
        if (wr == 1) PG8_BAR;
        PG8_WAIT_V(4); PG8_BAR;
        PG8_STAGE(PG8_SB(1, 0), cB + kstep, voffB); PG8_STAGE_A(PG8_SA(1, 0), cA + kstep, 0, cvo); PG8_STAGE(PG8_SB(1, 1), cB + hstep + kstep, voffB);
        PG8_WAIT_V(6); PG8_BAR;
    }
    for (;;) {
        const bool has_next = S.next(ui + 1, nxt);
        const char* nA = GATHER ? cA : (has_next ? (const char*)g.A + (size_t)nxt.pm * tstep : cA); const char* nB = has_next ? (const char*)g.Bt + (size_t)nxt.pn * tstep : cB;
        if constexpr (GATHER) { if (has_next) { PG8_GOFF(nvo, nxt); } else {
#pragma unroll
            for (int h = 0; h < 2; ++h)
#pragma unroll
                for (int i = 0; i < 2; ++i) nvo[h][i] = cvo[h][i]; } }
        const char* cA2 = DUAL ? (const char*)g.A2 + (size_t)cur.pm * tstep2 : cA; const char* cB2 = DUAL ? (const char*)g.Bt2 + (size_t)cur.pn * tstep2 : cB;
        for (int t = 0; t < nt; t += 2) {
            const bool last = (t == nt - 2);
            const bool s1 = DUAL && (t + 1 >= nt1), s2 = DUAL && !last && (t + 2 >= nt1);
            const char* a1 = s1 ? cA2 + (size_t)(t + 1 - nt1) * kstep : cA + (size_t)(t + 1) * kstep;
            const char* a2 = last ? nA : (s2 ? cA2 + (size_t)(t + 2 - nt1) * kstep : cA + (size_t)(t + 2) * kstep);
            const char* b2 = last ? nB : (s2 ? cB2 + (size_t)(t + 2 - nt1) * kstep : cB + (size_t)(t + 2) * kstep);
            const char* a3 = a2 + kstep; const char* b3 = b2 + kstep;
            const size_t hs1 = s1 ? hstep2 : hstep, hs2 = s2 ? hstep2 : hstep;
            unsigned vA1[2], vA2[2], vB2[2];
#pragma unroll
            for (int i = 0; i < 2; ++i) { vA1[i] = s1 ? voffA2[i] : voffA[i]; vA2[i] = s2 ? voffA2[i] : voffA[i]; vB2[i] = s2 ? voffB2[i] : voffB[i]; }
            unsigned svo[2][2];
#pragma unroll
            for (int h = 0; h < 2; ++h)
#pragma unroll
                for (int i = 0; i < 2; ++i) svo[h][i] = last ? nvo[h][i] : cvo[h][i];
            if constexpr (SP2) {
            PG8_LDB(B0, 0, 0); PG8_LDB(B1, 0, 1); PG8_SCHED; PG8_LDA(At, 0, 0); PG8_STAGE_AX(PG8_SA(1, 1), a1, 1, cvo, hs1, vA1);
            PG8_WAIT_V(8); PG8_WAIT_L(0); PG8_BAR; PG8_MMA(0, 0, At, B0); PG8_MMA(0, 1, At, B1); PG8_BAR; PG8_SCHED;
            PG8_LDA(At, 0, 1); PG8_STAGE(PG8_SB(0, 0), b2, vB2); PG8_STAGE(PG8_SB(0, 1), b2 + hs2, vB2); PG8_STAGE_AX(PG8_SA(0, 0), a2, 0, svo, hs2, vA2);
            PG8_WAIT_V(8); PG8_WAIT_L(0); PG8_BAR; PG8_MMA(1, 0, At, B0); PG8_MMA(1, 1, At, B1); PG8_BAR; PG8_SCHED;
            PG8_LDB(B0, 1, 0); PG8_LDB(B1, 1, 1); PG8_SCHED; PG8_LDA(At, 1, 0); PG8_STAGE_AX(PG8_SA(0, 1), a2, 1, svo, hs2, vA2);
            PG8_WAIT_V(8); PG8_WAIT_L(0); PG8_BAR; PG8_MMA(0, 0, At, B0); PG8_MMA(0, 1, At, B1); PG8_BAR; PG8_SCHED;
            PG8_LDA(At, 1, 1); PG8_STAGE(PG8_SB(1, 0), b3, vB2); PG8_STAGE(PG8_SB(1, 1), b3 + hs2, vB2); PG8_STAGE_AX(PG8_SA(1, 0), a3, 0, svo, hs2, vA2);
            PG8_WAIT_V(8); PG8_WAIT_L(0); PG8_BAR; PG8_MMA(1, 0, At, B0); PG8_MMA(1, 1, At, B1); PG8_BAR; PG8_SCHED;
            } else {
            PG8_LDB(B0, 0, 0); PG8_SCHED; PG8_LDA(At, 0, 0); PG8_STAGE_AX(PG8_SA(1, 1), a1, 1, cvo, hs1, vA1);
            PG8_WAIT_L(8); PG8_BAR; PG8_WAIT_L(0); PG8_MMA(0, 0, At, B0); PG8_BAR; PG8_SCHED;
            PG8_LDB(B1, 0, 1); PG8_STAGE(PG8_SB(0, 0), b2, vB2);
            PG8_BAR; PG8_WAIT_L(0); PG8_MMA(0, 1, At, B1); PG8_BAR;
            PG8_LDA(At, 0, 1); PG8_STAGE_AX(PG8_SA(0, 0), a2, 0, svo, hs2, vA2);
            PG8_BAR; PG8_WAIT_L(0); PG8_MMA(1, 0, At, B0); PG8_BAR; PG8_SCHED;
            PG8_STAGE(PG8_SB(0, 1), b2 + hs2, vB2);
            PG8_WAIT_V(6); PG8_BAR; PG8_MMA(1, 1, At, B1); PG8_BAR;
            PG8_LDB(B0, 1, 0); PG8_SCHED; PG8_LDA(At, 1, 0); PG8_STAGE_AX(PG8_SA(0, 1), a2, 1, svo, hs2, vA2);
            PG8_WAIT_L(8); PG8_BAR; PG8_WAIT_L(0); PG8_MMA(0, 0, At, B0); PG8_BAR; PG8_SCHED;
            PG8_LDB(B1, 1, 1); PG8_STAGE(PG8_SB(1, 0), b3, vB2);
            PG8_BAR; PG8_WAIT_L(0); PG8_MMA(0, 1, At, B1); PG8_BAR;
            PG8_LDA(At, 1, 1); PG8_STAGE_AX(PG8_SA(1, 0), a3, 0, svo, hs2, vA2);
            PG8_BAR; PG8_WAIT_L(0); PG8_MMA(1, 0, At, B0); PG8_BAR; PG8_SCHED;
            PG8_STAGE(PG8_SB(1, 1), b3 + hs2, vB2);
            PG8_WAIT_V(6); PG8_BAR; PG8_MMA(1, 1, At, B1); PG8_BAR;
            }
            if constexpr (DUAL) { if (t + 2 == nt1) E.mid(acc, cur, wr, wc, fr, fq); }
        }
        if constexpr (ALIGN_EPI) { if (wr == 0) PG8_BAR; }
        E(acc, cur, wr, wc, fr, fq);
        if (!has_next) break;
#pragma unroll
        for (int a = 0; a < 2; ++a)
#pragma unroll
            for (int b = 0; b < 2; ++b)
#pragma unroll
                for (int m = 0; m < 4; ++m)
#pragma unroll
                    for (int n = 0; n < 2; ++n) acc[a][b][m][n] = (f32x4){0.f, 0.f, 0.f, 0.f};
        cur = nxt; cA = nA; cB = nB; ++ui;
#pragma unroll
        for (int h = 0; h < 2; ++h)
#pragma unroll
            for (int i = 0; i < 2; ++i) cvo[h][i] = nvo[h][i];
        if constexpr (ALIGN_EPI) { if (wr == 1) PG8_BAR; }
    }
    PG8_WAIT_V(0);
    if constexpr (!ALIGN_EPI) { if (wr == 0) PG8_BAR; }
    PG8_BAR;
#undef PG8_SA
#undef PG8_SB
#undef PG8_STAGE
#undef PG8_STAGE_A
#undef PG8_STAGE_AX
#undef PG8_LDA
#undef PG8_LDB
#undef PG8_MMA
#undef PG8_WAIT_V
#undef PG8_WAIT_L
#undef PG8_BAR
#undef PG8_SCHED
#undef PG8_GOFF
}
}

constexpr size_t MiB = 1u << 20;
constexpr size_t WS_CTL = 0, CTL_ZERO_BYTES = 1 * MiB;
constexpr size_t WS_HMETA = 1 * MiB;
constexpr size_t WS_UMETA = WS_HMETA + 128 * 1024;
constexpr size_t WS_KMETA = WS_HMETA + 256 * 1024;
constexpr size_t WS_VMETA = WS_HMETA + 384 * 1024;
constexpr size_t WS_SSMAB = WS_HMETA + 512 * 1024;
constexpr size_t WS_SSMBB = WS_HMETA + 576 * 1024;
constexpr size_t WS_WRT = 2 * MiB;
constexpr size_t WS_WIN = 3 * MiB;
constexpr size_t WS_WGLU = 33 * MiB;
constexpr size_t WS_WBS = 34 * MiB;
constexpr size_t WS_WBA = 36 * MiB;
constexpr size_t WS_WO = 40 * MiB;
constexpr size_t WS_WUP = 48 * MiB;
constexpr size_t WS_WDN = 176 * MiB;
constexpr size_t WS_HBF = 240 * MiB;
constexpr size_t WS_U = 368 * MiB;
constexpr size_t WS_Q = 400 * MiB;
constexpr size_t WS_K = 464 * MiB;
constexpr size_t WS_V = 528 * MiB;
constexpr size_t WS_SGS = 592 * MiB;
constexpr size_t WS_SGA = 720 * MiB;
constexpr size_t WS_YPRE = 848 * MiB;
constexpr size_t WS_YSSM = 880 * MiB;
constexpr size_t WS_YATT = 912 * MiB;
constexpr size_t WS_END = 976 * MiB;
constexpr size_t WS_Z = 368 * MiB;
constexpr size_t WS_H1 = 624 * MiB;
constexpr size_t WS_HB = 752 * MiB;
constexpr size_t WS_YK = 368 * MiB;
constexpr size_t WS_LIST = 848 * MiB;
constexpr size_t WS_WGT = 852 * MiB;
constexpr size_t WS_POSE = 853 * MiB;
constexpr size_t WS_POSW = 854 * MiB;
constexpr int CW_ECNT = 64;
constexpr int CW_CONV = 192;
constexpr int CW_BAR = 4096;

constexpr int RING_BYTES = 131072;
constexpr int MISC_OFF = RING_BYTES;
constexpr int LDS_BYTES = 139264;

#define XB_TMO      128
#define XB_XCNT(j)  (256  + 64 * (j))
#define XB_XSUB(j)  (1280 + 64 * (j))
#define XB_XGEN(j)  (2304 + 64 * (j))
#define XB_TOP      3328
#define XB_TOPGEN   3392
#define XCD_BAR_WORDS 3456
#define XB_SPIN_CAP (1u << 18)
__device__ __forceinline__ unsigned xb_ld(unsigned* p)              { return __hip_atomic_load(p, __ATOMIC_RELAXED, __HIP_MEMORY_SCOPE_AGENT); }
__device__ __forceinline__ unsigned xb_add(unsigned* p, unsigned v) { return __hip_atomic_fetch_add(p, v, __ATOMIC_RELAXED, __HIP_MEMORY_SCOPE_AGENT); }
__device__ __forceinline__ unsigned xb_xcc_id() { return (unsigned)__builtin_amdgcn_s_getreg((3 << 11) | 20) & 0xFu; }
#define XB_SPIN(cond, bar) do { unsigned _sp = 0; while (cond) { __builtin_amdgcn_s_sleep(1); \
    if ((++_sp & 255u) == 0u) { if (xb_ld(&(bar)[XB_TMO])) break; if (_sp > XB_SPIN_CAP) { atomicAdd(&(bar)[XB_TMO], 1u); break; } } } } while (0)
struct XcdBarrier { unsigned* bar; unsigned x; volatile LAS unsigned* st; };
__device__ __forceinline__ XcdBarrier xcd_barrier_post(unsigned* bar, volatile LAS unsigned* st) {
    XcdBarrier b; b.bar = bar; b.x = xb_xcc_id(); b.st = st;
    if (threadIdx.x == 0) (void)xb_add(&bar[XB_XCNT(b.x)], 1u);
    return b;
}
__device__ __forceinline__ void xcd_barrier_complete(unsigned* bar, unsigned x, unsigned& nloc, unsigned& nx) {
    const unsigned G = gridDim.x * gridDim.y * gridDim.z;
    unsigned sum, cnt, mine, sp = 0u;
    for (;;) {
        sum = 0u; cnt = 0u; mine = 0u;
#pragma unroll
        for (unsigned j = 0; j < 16; ++j) { const unsigned c = xb_ld(&bar[XB_XCNT(j)]); sum += c; cnt += (c > 0u) ? 1u : 0u; mine = (j == x) ? c : mine; }
        if (sum == G) break;
        __builtin_amdgcn_s_sleep(1);
        if ((++sp & 255u) == 0u) { if (xb_ld(&bar[XB_TMO])) break; if (sp > XB_SPIN_CAP) { atomicAdd(&bar[XB_TMO], 1u); break; } }
    }
    nloc = mine > 0u ? mine : 1u; nx = cnt > 0u ? cnt : 1u;
}
__device__ __forceinline__ void xcd_barrier(const XcdBarrier& b) {
    asm volatile("s_waitcnt vmcnt(0)" ::: "memory");
    __syncthreads();
    if (threadIdx.x == 0) {
        unsigned* bar = b.bar;
        __builtin_amdgcn_s_waitcnt(0);
        unsigned nloc = b.st[0], nx = b.st[1];
        if (nloc == 0u) { xcd_barrier_complete(bar, b.x, nloc, nx); b.st[0] = nloc; b.st[1] = nx; }
        const unsigned old = xb_add(&bar[XB_XSUB(b.x)], 1u);
        const unsigned gen = old / nloc;
        if (old + 1u == (gen + 1u) * nloc) {
            __builtin_amdgcn_fence(__ATOMIC_RELEASE, "agent");
            asm volatile("s_waitcnt vmcnt(0)" ::: "memory");
            const unsigned og = xb_add(&bar[XB_TOP], 1u);
            const unsigned tg = og / nx;
            if (og + 1u == (tg + 1u) * nx) xb_add(&bar[XB_TOPGEN], 1u);
            else XB_SPIN(xb_ld(&bar[XB_TOPGEN]) == tg, bar);
            __builtin_amdgcn_fence(__ATOMIC_ACQUIRE, "agent");
            xb_add(&bar[XB_XGEN(b.x)], 1u);
            asm volatile("s_waitcnt vmcnt(0)" ::: "memory");
        } else {
            XB_SPIN(xb_ld(&bar[XB_XGEN(b.x)]) == gen, bar);
            __builtin_amdgcn_fence(__ATOMIC_ACQUIRE, "agent");
            asm volatile("s_waitcnt vmcnt(0)" ::: "memory");
        }
    }
    __syncthreads();
}

using pg8::Unit;
__device__ __forceinline__ u32x4 pack8(const f32x4 v0, const f32x4 v1) { u32x4 w; w.x = cvt_pk_bf16(v0[0], v0[1]); w.y = cvt_pk_bf16(v0[2], v0[3]); w.z = cvt_pk_bf16(v1[0], v1[1]); w.w = cvt_pk_bf16(v1[2], v1[3]); return w; }
__device__ __forceinline__ void unpack8(const u32x4 w, f32x4& v0, f32x4& v1) { v0 = (f32x4){bf_lo(w.x), bf_hi(w.x), bf_lo(w.y), bf_hi(w.y)}; v1 = (f32x4){bf_lo(w.z), bf_hi(w.z), bf_lo(w.w), bf_hi(w.w)}; }

struct EpiProj {
    static constexpr bool PERM = true;
    bf16_t *U, *Q, *K, *V, *RHO, *SGA;
    __device__ __forceinline__ void operator()(const f32x4 (&acc)[2][2][4][2], const Unit& u, int wr, int wc, int fr, int fq) const {
        const int pn = u.pn;
        if (pn >= 14) {
            const int row0 = u.pm * 256 + wr * 64 + fr, col0 = (pn - 14) * 128 + wc * 32 + 8 * fq;
#pragma unroll
            for (int ai = 0; ai < 2; ++ai)
#pragma unroll
                for (int m = 0; m < 4; ++m) { const size_t off = (size_t)(row0 + ai * 128 + m * 16) * DM + col0; f32x4 r0, r1, a0, a1;
#pragma unroll
                    for (int j = 0; j < 4; ++j) { const float es0 = __expf(-acc[ai][0][m][0][j]), es1 = __expf(-acc[ai][0][m][1][j]), ea0 = __expf(-acc[ai][1][m][0][j]), ea1 = __expf(-acc[ai][1][m][1][j]);
                        a0[j] = __builtin_amdgcn_rcpf(1.f + ea0); a1[j] = __builtin_amdgcn_rcpf(1.f + ea1);
                        r0[j] = (1.f + ea0) * __builtin_amdgcn_rcpf(1.f + es0); r1[j] = (1.f + ea1) * __builtin_amdgcn_rcpf(1.f + es1); }
                    *(u32x4*)(RHO + off) = pack8(r0, r1); *(u32x4*)(SGA + off) = pack8(a0, a1); }
            return;
        }
        bf16_t* base; int ldc, ct, mode;
        if (pn < 2) { base = U; ldc = 512; ct = pn; mode = 0; }
        else if (pn < 6) { base = Q; ldc = 1024; ct = pn - 2; mode = 1; }
        else if (pn < 10) { base = K; ldc = 1024; ct = pn - 6; mode = 0; }
        else { base = V; ldc = 1024; ct = pn - 10; mode = 0; }
        const int row0 = u.pm * 256 + wr * 64 + fr, col0 = ct * 256 + wc * 32 + 8 * fq;
#pragma unroll
        for (int ai = 0; ai < 2; ++ai)
#pragma unroll
            for (int m = 0; m < 4; ++m) { bf16_t* rowp = base + (size_t)(row0 + ai * 128 + m * 16) * ldc + col0;
#pragma unroll
                for (int bj = 0; bj < 2; ++bj) { f32x4 v0 = acc[ai][bj][m][0], v1 = acc[ai][bj][m][1];
                    if (mode == 1) { v0 = v0 * QSCALE; v1 = v1 * QSCALE; }
                    *(u32x4*)(rowp + bj * 128) = pack8(v0, v1); } }
    }
};
struct EpiGlu {
    static constexpr bool PERM = true;
    const bf16_t* YPRE; bf16_t* YSSM;
    __device__ __forceinline__ void operator()(const f32x4 (&acc)[2][2][4][2], const Unit& u, int wr, int wc, int fr, int fq) const {
        const int row0 = u.pm * 256 + wr * 64 + fr, col0 = u.pn * 256 + wc * 32 + 8 * fq;
#pragma unroll
        for (int ai = 0; ai < 2; ++ai)
#pragma unroll
            for (int m = 0; m < 4; ++m) { const size_t off = (size_t)(row0 + ai * 128 + m * 16) * SSMW + col0;
#pragma unroll
                for (int bj = 0; bj < 2; ++bj) { const u32x4 yw = *(const u32x4*)(YPRE + off + bj * 128); f32x4 y0, y1; unpack8(yw, y0, y1);
                    f32x4 v0 = acc[ai][bj][m][0], v1 = acc[ai][bj][m][1];
#pragma unroll
                    for (int j = 0; j < 4; ++j) { v0[j] = y0[j] * sigmoidf_(v0[j]); v1[j] = y1[j] * sigmoidf_(v1[j]); }
                    *(u32x4*)(YSSM + off + bj * 128) = pack8(v0, v1); } }
    }
};
template <int SECOND> struct EpiMerge {
    static constexpr bool PERM = true;
    const bf16_t* SG; bf16_t* MG;
    __device__ __forceinline__ void operator()(const f32x4 (&acc)[2][2][4][2], const Unit& u, int wr, int wc, int fr, int fq) const {
        const int row0 = u.pm * 256 + wr * 64 + fr, col0 = u.pn * 256 + wc * 32 + 8 * fq;
#pragma unroll
        for (int ai = 0; ai < 2; ++ai)
#pragma unroll
            for (int m = 0; m < 4; ++m) { const size_t off = (size_t)(row0 + ai * 128 + m * 16) * DM + col0;
#pragma unroll
                for (int bj = 0; bj < 2; ++bj) { const u32x4 gw = *(const u32x4*)(SG + off + bj * 128); f32x4 g0, g1; unpack8(gw, g0, g1);
                    f32x4 v0 = acc[ai][bj][m][0] * g0, v1 = acc[ai][bj][m][1] * g1;
                    if (SECOND) { const u32x4 pw = *(const u32x4*)(MG + off + bj * 128); f32x4 p0, p1; unpack8(pw, p0, p1); v0 = v0 + p0; v1 = v1 + p1; }
                    *(u32x4*)(MG + off + bj * 128) = pack8(v0, v1); } }
    }
};
struct EpiMergeF {
    static constexpr bool PERM = true;
    const bf16_t* SGS; const bf16_t* SGA; bf16_t* MG;
    __device__ __forceinline__ void mid(f32x4 (&acc)[2][2][4][2], const Unit& u, int wr, int wc, int fr, int fq) const {
        asm volatile("" : "+v"(fr), "+v"(fq));
        const int row0 = u.pm * 256 + wr * 64 + fr, col0 = u.pn * 256 + wc * 32 + 8 * fq;
        const bf16_t* sp = SGS + (size_t)row0 * DM + col0;
        u32x4 sw[2][2];
        sw[0][0] = *(const u32x4*)(sp); sw[0][1] = *(const u32x4*)(sp + 128);
#pragma unroll
        for (int g = 0; g < 8; ++g) { const int ai = g >> 2, m = g & 3;
            if (g < 7) { const int g1 = g + 1; const bf16_t* sq = sp + (size_t)((g1 >> 2) * 128 + (g1 & 3) * 16) * DM;
                sw[g1 & 1][0] = *(const u32x4*)(sq); sw[g1 & 1][1] = *(const u32x4*)(sq + 128); }
            asm volatile("" ::: "memory");
#pragma unroll
            for (int bj = 0; bj < 2; ++bj) { f32x4 s0, s1; unpack8(sw[g & 1][bj], s0, s1);
                acc[ai][bj][m][0] = acc[ai][bj][m][0] * s0; acc[ai][bj][m][1] = acc[ai][bj][m][1] * s1; }
        }
    }
    __device__ __forceinline__ void operator()(const f32x4 (&acc)[2][2][4][2], const Unit& u, int wr, int wc, int fr, int fq) const {
        const int row0 = u.pm * 256 + wr * 64 + fr, col0 = u.pn * 256 + wc * 32 + 8 * fq;
#pragma unroll
        for (int ai = 0; ai < 2; ++ai)
#pragma unroll
            for (int m = 0; m < 4; ++m) { const size_t off = (size_t)(row0 + ai * 128 + m * 16) * DM + col0;
#pragma unroll
                for (int bj = 0; bj < 2; ++bj) { const u32x4 gw = *(const u32x4*)(SGA + off + bj * 128); f32x4 g0, g1; unpack8(gw, g0, g1);
                    *(u32x4*)(MG + off + bj * 128) = pack8(acc[ai][bj][m][0] * g0, acc[ai][bj][m][1] * g1); } }
    }
};
struct EpiZ {
    static constexpr bool PERM = true;
    const bf16_t* HBF; bf16_t* Z;
    __device__ __forceinline__ void operator()(const f32x4 (&acc)[2][2][4][2], const Unit& u, int wr, int wc, int fr, int fq) const {
        const int row0 = u.pm * 256 + wr * 64 + fr, col0 = u.pn * 256 + wc * 32 + 8 * fq;
#pragma unroll
        for (int ai = 0; ai < 2; ++ai)
#pragma unroll
            for (int m = 0; m < 4; ++m) { const size_t off = (size_t)(row0 + ai * 128 + m * 16) * DM + col0;
#pragma unroll
                for (int bj = 0; bj < 2; ++bj) { const u32x4 hw = *(const u32x4*)(HBF + off + bj * 128); f32x4 h0, h1; unpack8(hw, h0, h1);
                    *(u32x4*)(Z + off + bj * 128) = pack8(acc[ai][bj][m][0] + h0 * ALPHA, acc[ai][bj][m][1] + h1 * ALPHA); } }
    }
};
struct EpiSwiglu {
    static constexpr bool PERM = true;
    bf16_t* HB; const int* LIST; const float* WGT; int* POSE; float* POSW;
    __device__ __forceinline__ void operator()(const f32x4 (&acc)[2][2][4][2], const Unit& u, int wr, int wc, int fr, int fq) const {
        const int row0 = u.pm * 256 + wr * 64 + fr, col0 = (u.pn & 3) * 128 + wc * 32 + 8 * fq;
#pragma unroll
        for (int ai = 0; ai < 2; ++ai)
#pragma unroll
            for (int m = 0; m < 4; ++m) { f32x4 v0, v1;
#pragma unroll
                for (int j = 0; j < 4; ++j) { const float g0 = acc[ai][0][m][0][j], g1 = acc[ai][0][m][1][j];
                    v0[j] = g0 * sigmoidf_(g0) * acc[ai][1][m][0][j]; v1[j] = g1 * sigmoidf_(g1) * acc[ai][1][m][1][j]; }
                *(u32x4*)(HB + (size_t)(row0 + ai * 128 + m * 16) * DFF + col0) = pack8(v0, v1); }
        if ((u.pn & 3) == 0 && wc == 0 && fq == 0) {
#pragma unroll
            for (int ai = 0; ai < 2; ++ai)
#pragma unroll
                for (int m = 0; m < 4; ++m) { const int r = wr * 64 + fr + ai * 128 + m * 16, slot = u.s0 + r; int entry = -1; float w = 0.f;
                    if (slot < u.cnt) { entry = LIST[(size_t)u.e * CAP + slot]; w = WGT[entry]; }
                    POSE[u.pm * 256 + r] = entry; POSW[u.pm * 256 + r] = w; }
        }
    }
};
struct EpiDown {
    static constexpr bool PERM = true;
    const int* POSE; const float* POSW; bf16_t* YK;
    __device__ __forceinline__ void operator()(const f32x4 (&acc)[2][2][4][2], const Unit& u, int wr, int wc, int fr, int fq) const {
        const int r0 = u.pm * 256 + wr * 64 + fr, col0 = (u.pn & 7) * 256 + wc * 32 + 8 * fq;
        int en[2][4]; float ww[2][4];
#pragma unroll
        for (int ai = 0; ai < 2; ++ai)
#pragma unroll
            for (int m = 0; m < 4; ++m) { en[ai][m] = POSE[r0 + ai * 128 + m * 16]; ww[ai][m] = POSW[r0 + ai * 128 + m * 16]; }
#pragma unroll
        for (int ai = 0; ai < 2; ++ai)
#pragma unroll
            for (int m = 0; m < 4; ++m) {
                if (en[ai][m] >= 0) { const float w = ww[ai][m]; bf16_t* rowp = YK + (size_t)en[ai][m] * DM + col0;
#pragma unroll
                    for (int bj = 0; bj < 2; ++bj) *(u32x4*)(rowp + bj * 128) = pack8(acc[ai][bj][m][0] * w, acc[ai][bj][m][1] * w); } }
    }
};
struct MoeOrder {
    int G, c, shift, NB; const LAS int* blkexp; const LAS int* blkstart; const LAS int* cntE; const int* LIST;
    __device__ __forceinline__ bool next(int i, Unit& u) const {
        const long L = (long)i * G + c; if (L >= ((long)NB << shift)) return false;
        const int blk = (int)(L >> shift), tile = (int)(L & ((1 << shift) - 1)), e = blkexp[blk];
        u.pm = blk; u.pn = (e << shift) + tile; u.e = e; u.s0 = (blk - blkstart[e]) * 256; u.cnt = cntE[e]; return true;
    }
    __device__ __forceinline__ int arow(const Unit& u, int r) const { const int slot = u.s0 + r; const int entry = slot < u.cnt ? LIST[(size_t)u.e * CAP + slot] : 0; return entry >> 1; }
};

struct Ctx { LAS unsigned char* lds; int tid, lane, wave, vcu, G; };

__device__ __forceinline__ void transpose_item(const float* W, int K, int N, bf16_t* WT, int kb, int nb, int dst_row0, LAS float* scr, int lane) {
    const int k0 = 64 * kb, n0 = 32 * nb;
    float tv[32];
#pragma unroll
    for (int i = 0; i < 32; ++i) tv[i] = W[(size_t)(k0 + 2 * i + (lane >> 5)) * N + n0 + (lane & 31)];
#pragma unroll
    for (int i = 0; i < 32; ++i) scr[(2 * i + (lane >> 5)) * 33 + (lane & 31)] = tv[i];
    asm volatile("s_waitcnt lgkmcnt(0)" ::: "memory");
    const int c = lane & 7;
#pragma unroll
    for (int j = 0; j < 4; ++j) { const int n = (lane >> 3) + 8 * j; const LAS float* s = scr + (8 * c) * 33 + n;
        u32x4 o; o.x = cvt_pk_bf16(s[0 * 33], s[1 * 33]); o.y = cvt_pk_bf16(s[2 * 33], s[3 * 33]); o.z = cvt_pk_bf16(s[4 * 33], s[5 * 33]); o.w = cvt_pk_bf16(s[6 * 33], s[7 * 33]);
        *(u32x4*)(WT + (size_t)(dst_row0 + n) * K + k0 + 8 * c) = o; }
    asm volatile("s_waitcnt lgkmcnt(0)" ::: "memory");
}
__device__ __forceinline__ void ln_stats(f32x4 (&v)[8], float& mean, float& rstd) {
    float s = 0.f;
#pragma unroll
    for (int j = 0; j < 8; ++j) s += (v[j].x + v[j].y) + (v[j].z + v[j].w);
    mean = wave_sum(s) * (1.f / DM); float s2 = 0.f;
#pragma unroll
    for (int j = 0; j < 8; ++j) { const f32x4 d = v[j] - mean; s2 += (d.x * d.x + d.y * d.y) + (d.z * d.z + d.w * d.w); }
    rstd = 1.f / sqrtf(wave_sum(s2) * (1.f / DM) + LN_EPS);
}

__device__ __forceinline__ void p0_prologue(const Ctx& C, const float* const* in, unsigned char* ws) {
    LAS float* scr = (LAS float*)(C.lds + C.wave * 16384);
    const int gw = C.vcu * 8 + C.wave, NGW = C.G * 8;
    bf16_t* WinT = (bf16_t*)(ws + WS_WIN); bf16_t* WgluT = (bf16_t*)(ws + WS_WGLU); bf16_t* WbsT = (bf16_t*)(ws + WS_WBS); bf16_t* WbaT = (bf16_t*)(ws + WS_WBA);
    bf16_t* WoT = (bf16_t*)(ws + WS_WO); bf16_t* WupT = (bf16_t*)(ws + WS_WUP);
    constexpr int I_WIN = (DM / 64) * (INC / 32), I_GLU = (SSMW / 64) * (SSMW / 32), I_BS = (SSMW / 64) * (DM / 32), I_BA = (AW / 64) * (DM / 32), I_WO = (DM / 64) * (DM / 32);
    constexpr int I_EXP = NE * 512;
    constexpr int NITEMS = I_WIN + I_GLU + I_BS + I_BA + I_WO + 2 * I_EXP;
    for (int it = gw; it < NITEMS; it += NGW) {
        int r = it;
        if (r < I_WIN) { const int nblk = INC / 32, nb = r % nblk, n0 = 32 * nb;
            const int drow = n0 < 3584 ? n0 : (n0 < 5632 ? 3584 + ((n0 - 3584) >> 7) * 256 + ((n0 - 3584) & 127) : 3584 + ((n0 - 5632) >> 7) * 256 + 128 + ((n0 - 5632) & 127));
            transpose_item(in[4], DM, INC, WinT, r / nblk, nb, drow, scr, C.lane); continue; } r -= I_WIN;
        if (r < I_GLU) { const int nblk = SSMW / 32; transpose_item(in[13], SSMW, SSMW, WgluT, r / nblk, r % nblk, 32 * (r % nblk), scr, C.lane); continue; } r -= I_GLU;
        if (r < I_BS) { const int nblk = DM / 32; transpose_item(in[19], SSMW, DM, WbsT, r / nblk, r % nblk, 32 * (r % nblk), scr, C.lane); continue; } r -= I_BS;
        if (r < I_BA) { const int nblk = DM / 32; transpose_item(in[20], AW, DM, WbaT, r / nblk, r % nblk, 32 * (r % nblk), scr, C.lane); continue; } r -= I_BA;
        if (r < I_WO) { const int nblk = DM / 32; transpose_item(in[21], DM, DM, WoT, r / nblk, r % nblk, 32 * (r % nblk), scr, C.lane); continue; } r -= I_WO;
        if (r < 2 * I_EXP) { const int up = r >= I_EXP ? 1 : 0; r -= up * I_EXP; const int e = r >> 9, rr = r & 511, kb = rr >> 4, nb = rr & 15, n0 = 32 * nb;
            transpose_item(in[28 + up] + (size_t)e * DM * DFF, DM, DFF, WupT, kb, nb, e * 1024 + (n0 >> 7) * 256 + up * 128 + (n0 & 127), scr, C.lane); continue; }
    }
    const int gt = C.vcu * 512 + C.tid, NGT = C.G * 512;
    { float* WrT = (float*)(ws + WS_WRT);
      for (int i = gt; i < 36 * DM; i += NGT) { const int n = i / DM, k = i % DM; WrT[i] = n < 4 ? in[24][k * 4 + n] : in[26][k * 32 + (n - 4)]; } }
    { u32x4* kz = (u32x4*)(ws + WS_KMETA + 16 * 1024 * 2); u32x4* vz = (u32x4*)(ws + WS_VMETA + 16 * 1024 * 2);
      for (int i = gt; i < 48 * 1024 * 2 / 16; i += NGT) { kz[i] = (u32x4){0u, 0u, 0u, 0u}; vz[i] = (u32x4){0u, 0u, 0u, 0u}; } }
    { float* AB = (float*)(ws + WS_SSMAB); float* BB = (float*)(ws + WS_SSMBB);
      for (int i = gt; i < NGRP * NST; i += NGT) { const int g = i >> 6;
        const double lre = fmin((double)in[5][i], -1e-4), lim = (double)in[6][i], dt = exp((double)in[7][g]);
        const double mag = exp(lre * dt), abr = mag * cos(lim * dt), abi = mag * sin(lim * dt), den = lre * lre + lim * lim, nr = abr - 1.0, ni = abi;
        const double zr = (nr * lre + ni * lim) / den, zi = (ni * lre - nr * lim) / den;
        AB[i] = (float)abr; AB[NGRP * NST + i] = (float)abi;
#pragma unroll 4
        for (int c = 0; c < 16; ++c) { const double br = (double)in[8][i * 16 + c], bi = (double)in[9][i * 16 + c];
            BB[i * 16 + c] = (float)(zr * br - zi * bi); BB[NGRP * NST * 16 + i * 16 + c] = (float)(zr * bi + zi * br); } } }
    const float* lg = in[2]; const float* lb = in[3];
    bf16_t* HBF = (bf16_t*)(ws + WS_HBF);
    for (int m = gw; m < T + NMETA; m += 2 * NGW) {
        const int m2 = (m + NGW < T + NMETA) ? m + NGW : m;
        const float* xa = m >= T ? in[1] + (size_t)(m - T) * DM : in[0] + (size_t)m * DM; const float* xb = m2 >= T ? in[1] + (size_t)(m2 - T) * DM : in[0] + (size_t)m2 * DM;
        f32x4 va[8], vb[8];
#pragma unroll
        for (int j = 0; j < 8; ++j) { va[j] = *(const f32x4*)(xa + 256 * j + 4 * C.lane); vb[j] = *(const f32x4*)(xb + 256 * j + 4 * C.lane); }
        float meana, rstda, meanb, rstdb; ln_stats(va, meana, rstda); ln_stats(vb, meanb, rstdb);
#pragma unroll
        for (int rr = 0; rr < 2; ++rr) { const int mm = rr ? m2 : m; if (rr == 1 && m2 == m) break; const bool meta = mm >= T;
#pragma unroll
            for (int j = 0; j < 8; ++j) { const f32x4 gg = *(const f32x4*)(lg + 256 * j + 4 * C.lane), bb = *(const f32x4*)(lb + 256 * j + 4 * C.lane);
                const f32x4 o = rr ? (vb[j] - meanb) * rstdb * gg + bb : (va[j] - meana) * rstda * gg + bb;
                if (meta) *(f32x4*)((float*)(ws + WS_HMETA) + (size_t)(mm - T) * DM + 256 * j + 4 * C.lane) = o;
                else { u32x2 w; w.x = cvt_pk_bf16(o.x, o.y); w.y = cvt_pk_bf16(o.z, o.w); *(u32x2*)(HBF + (size_t)mm * DM + 256 * j + 4 * C.lane) = w; } } }
    }
}

__device__ __forceinline__ void p1_meta_proj(const Ctx& C, unsigned char* ws) {
    const bf16_t* WinT = (const bf16_t*)(ws + WS_WIN); const float* HM = (const float*)(ws + WS_HMETA);
    const int gw = C.vcu * 8 + C.wave, NGW = C.G * 8;
    for (int it = gw; it < 640; it += NGW) {
        const int nidx = 4 * it; const int col0 = nidx < 512 ? nidx : (nidx < 1536 ? 1536 + (nidx - 512) : 2560 + (nidx - 1536));
        float acc[16][4];
#pragma unroll
        for (int r = 0; r < 16; ++r)
#pragma unroll
            for (int c = 0; c < 4; ++c) acc[r][c] = 0.f;
#pragma unroll 1
        for (int j = 0; j < 4; ++j) { const int k0 = j * 512 + C.lane * 8;
            f32x4 w0[4], w1[4];
#pragma unroll
            for (int c = 0; c < 4; ++c) { const u32x4 ww = *(const u32x4*)(WinT + (size_t)(col0 + c) * DM + k0); unpack8(ww, w0[c], w1[c]); }
#pragma unroll
            for (int r = 0; r < 16; ++r) { const f32x4 h0 = *(const f32x4*)(HM + r * DM + k0), h1 = *(const f32x4*)(HM + r * DM + k0 + 4);
#pragma unroll
                for (int c = 0; c < 4; ++c) { const f32x4 p = h0 * w0[c] + h1 * w1[c]; acc[r][c] += (p.x + p.y) + (p.z + p.w); } } }
        float mine = 0.f;
#pragma unroll
        for (int r = 0; r < 16; ++r)
#pragma unroll
            for (int c = 0; c < 4; ++c) { const float s = wave_sum(acc[r][c]); mine = (C.lane == r * 4 + c) ? s : mine; }
        const int r = C.lane >> 2, c = C.lane & 3;
        if (nidx < 512) ((float*)(ws + WS_UMETA))[r * SSMW + nidx + c] = mine;
        else if (nidx < 1536) ((bf16_t*)(ws + WS_KMETA))[r * AW + (nidx - 512) + c] = (bf16_t)(cvt_pk_bf16(mine, 0.f) & 0xffffu);
        else ((bf16_t*)(ws + WS_VMETA))[r * AW + (nidx - 1536) + c] = (bf16_t)(cvt_pk_bf16(mine, 0.f) & 0xffffu);
    }
}

__device__ __forceinline__ float gelu_tanh(float x) { const float u = 1.5957691216057308f * (x + 0.044715f * x * x * x); return x * __builtin_amdgcn_rcpf(1.0f + __expf(-u)); }
template <bool STORE> __device__ __forceinline__ void scan16(f32x16 (&bu)[4], float (&sre)[2], float (&sim)[2], const float (&are)[2], const float (&aim)[2]) {
#pragma unroll
    for (int reg = 0; reg < 16; ++reg)
#pragma unroll
        for (int st = 0; st < 2; ++st) {
            const float nre = __builtin_fmaf(are[st], sre[st], __builtin_fmaf(-aim[st], sim[st], bu[st][reg]));
            const float nim = __builtin_fmaf(are[st], sim[st], __builtin_fmaf(aim[st], sre[st], bu[2 + st][reg]));
            sre[st] = nre; sim[st] = nim;
            if (STORE) { bu[st][reg] = nre; bu[2 + st][reg] = nim; } }
}
__device__ __forceinline__ void p2_scan(const Ctx& C, const float* const* in, unsigned char* ws) {
    const int lane = C.lane, wave = C.wave, r32 = lane & 31, hi = lane >> 5, fr = lane & 15, fq = lane >> 4;
    const bf16_t* U = (const bf16_t*)(ws + WS_U); const float* UM = (const float*)(ws + WS_UMETA); bf16_t* YPRE = (bf16_t*)(ws + WS_YPRE);
    const float* AB = (const float*)(ws + WS_SSMAB); const float* BB = (const float*)(ws + WS_SSMBB);
    LAS unsigned char* Sl = C.lds + wave * 10752;
    LAS unsigned char* Yl = Sl + 9728;
    LAS float* E = (LAS float*)(C.lds + 86016);
    const int hc = 2 * wave + hi;
    const int urow = ((r32 >> 2) & 1) * 128 + (r32 & 3) + 4 * (r32 >> 3);
    for (int item = C.vcu; item < NB_ * NGRP; item += C.G) {
        const int b = item >> 5, g = item & 31;
        const bf16_t* Ub = U + ((size_t)b * SEQ + wave * 256) * SSMW + 16 * g;
        bf16x8 ufa[8];
#pragma unroll
        for (int blk = 0; blk < 8; ++blk) ufa[blk] = *(const bf16x8*)(Ub + (size_t)(16 * blk + urow) * SSMW + 8 * hi);
        float are[2], aim[2];
#pragma unroll
        for (int st = 0; st < 2; ++st) { are[st] = AB[g * 64 + 32 * st + r32]; aim[st] = AB[NGRP * NST + g * 64 + 32 * st + r32]; }
        bf16x8 Bf[4];
#pragma unroll
        for (int ri = 0; ri < 2; ++ri)
#pragma unroll
            for (int st = 0; st < 2; ++st) { const float* src = BB + ri * (NGRP * NST * 16) + (g * 64 + 32 * st + r32) * 16 + 8 * hi;
                const f32x4 x0 = *(const f32x4*)src, x1 = *(const f32x4*)(src + 4); Bf[2 * ri + st] = __builtin_bit_cast(bf16x8, pack8(x0, x1)); }
        bf16x8 Cf[5];
#pragma unroll
        for (int ks = 0; ks < 4; ++ks) { const int r0 = 8 * ks + 2 * fq; const float* cre = in[10] + (g * 16 + fr) * 64; const float* cim = in[11] + (g * 16 + fr) * 64;
            const f32x4 x0 = (f32x4){cre[r0], cre[32 + r0], -cim[r0], -cim[32 + r0]}, x1 = (f32x4){cre[r0 + 1], cre[33 + r0], -cim[r0 + 1], -cim[33 + r0]};
            Cf[ks] = __builtin_bit_cast(bf16x8, pack8(x0, x1)); }
        { const float dsk = in[12][g * 16 + fr]; f32x4 x0, x1;
#pragma unroll
          for (int j = 0; j < 4; ++j) { x0[j] = (fq < 2 && 8 * fq + j == fr) ? dsk : 0.f; x1[j] = (fq < 2 && 8 * fq + 4 + j == fr) ? dsk : 0.f; }
          Cf[4] = __builtin_bit_cast(bf16x8, pack8(x0, x1)); }
        float sre[2] = {0.f, 0.f}, sim[2] = {0.f, 0.f}, mre[2] = {0.f, 0.f}, mim[2] = {0.f, 0.f};
        if (wave == 0) {
            f32x4 x0 = (f32x4){0.f, 0.f, 0.f, 0.f}, x1 = x0;
            if (((r32 >> 2) & 1) == 0) { const float* src = UM + ((r32 & 3) + 4 * (r32 >> 3)) * SSMW + 16 * g + 8 * hi; x0 = *(const f32x4*)src; x1 = *(const f32x4*)(src + 4); }
            const bf16x8 uf = __builtin_bit_cast(bf16x8, pack8(x0, x1));
            f32x16 bu[4];
#pragma unroll
            for (int t = 0; t < 4; ++t) bu[t] = __builtin_amdgcn_mfma_f32_32x32x16_bf16(uf, Bf[t], (f32x16){}, 0, 0, 0);
            scan16<false>(bu, sre, sim, are, aim);
            mre[0] = sre[0]; mre[1] = sre[1]; mim[0] = sim[0]; mim[1] = sim[1];
        }
#pragma unroll
        for (int blk = 0; blk < 8; ++blk) {
            f32x16 bu[4];
#pragma unroll
            for (int t = 0; t < 4; ++t) bu[t] = __builtin_amdgcn_mfma_f32_32x32x16_bf16(ufa[blk], Bf[t], (f32x16){}, 0, 0, 0);
            scan16<false>(bu, sre, sim, are, aim);
        }
#pragma unroll
        for (int st = 0; st < 2; ++st) { E[hc * 128 + st * 64 + r32] = sre[st]; E[hc * 128 + st * 64 + 32 + r32] = sim[st]; }
        __syncthreads();
        {
            float pr[2], pi[2], cr[2], ci[2];
#pragma unroll
            for (int st = 0; st < 2; ++st) { pr[st] = are[st]; pi[st] = aim[st];
#pragma unroll
                for (int k = 0; k < 7; ++k) { const float nr = pr[st] * pr[st] - pi[st] * pi[st], ni = 2.f * pr[st] * pi[st]; pr[st] = nr; pi[st] = ni; }
                cr[st] = E[st * 64 + r32]; ci[st] = E[st * 64 + 32 + r32]; }
            for (int j = 1; j < 2 * wave + 1; ++j) {
                const bool on = j < hc;
#pragma unroll
                for (int st = 0; st < 2; ++st) { const float er = E[j * 128 + st * 64 + r32], ei = E[j * 128 + st * 64 + 32 + r32];
                    const float nr = pr[st] * cr[st] - pi[st] * ci[st] + er, ni = pr[st] * ci[st] + pi[st] * cr[st] + ei; cr[st] = on ? nr : cr[st]; ci[st] = on ? ni : ci[st]; } }
#pragma unroll
            for (int st = 0; st < 2; ++st) { sre[st] = hc == 0 ? mre[st] : cr[st]; sim[st] = hc == 0 ? mim[st] : ci[st]; }
        }
#pragma unroll
        for (int blk = 0; blk < 8; ++blk) {
            f32x16 bu[4];
#pragma unroll
            for (int t = 0; t < 4; ++t) bu[t] = __builtin_amdgcn_mfma_f32_32x32x16_bf16(ufa[blk], Bf[t], (f32x16){}, 0, 0, 0);
            scan16<true>(bu, sre, sim, are, aim);
#pragma unroll
            for (int reg = 0; reg < 16; ++reg) { const int row = (reg & 3) + 8 * (reg >> 2) + 4 * hi;
                u32x2 w; w.x = cvt_pk_bf16(bu[0][reg], bu[1][reg]); w.y = cvt_pk_bf16(bu[2][reg], bu[3][reg]);
                *(LAS u32x2*)(Sl + row * 304 + r32 * 8) = w; }
            *(LAS bf16x8*)(Sl + r32 * 304 + (128 + 8 * hi) * 2) = ufa[blk];
            f32x4 y[2];
#pragma unroll
            for (int mt = 0; mt < 2; ++mt) { y[mt] = (f32x4){0.f, 0.f, 0.f, 0.f};
#pragma unroll
                for (int ks = 0; ks < 4; ++ks) { const bf16x8 af = *(const LAS bf16x8*)(Sl + (16 * mt + fr) * 304 + (32 * ks + 8 * fq) * 2);
                    y[mt] = __builtin_amdgcn_mfma_f32_16x16x32_bf16(af, Cf[ks], y[mt], 0, 0, 0); }
                bf16x8 au = *(const LAS bf16x8*)(Sl + (16 * mt + fr) * 304 + (128 + 8 * (fq & 1)) * 2); if (fq >= 2) au = (bf16x8){};
                y[mt] = __builtin_amdgcn_mfma_f32_16x16x32_bf16(au, Cf[4], y[mt], 0, 0, 0); }
#pragma unroll
            for (int mt = 0; mt < 2; ++mt)
#pragma unroll
                for (int reg = 0; reg < 4; ++reg) *(LAS bf16_t*)(Yl + (16 * mt + 4 * fq + reg) * 32 + fr * 2) = (bf16_t)(cvt_pk_bf16(gelu_tanh(y[mt][reg]), 0.f) & 0xffffu);
            const u32x4 yo = *(const LAS u32x4*)(Yl + (lane >> 1) * 32 + (lane & 1) * 16);
            { const int row = lane >> 1, tok = ((row >> 2) & 1) * 128 + 16 * blk + (row & 3) + 4 * (row >> 3);
              *(u32x4*)(YPRE + ((size_t)b * SEQ + wave * 256 + tok) * SSMW + 16 * g + 8 * (lane & 1)) = yo; }
        }
        __syncthreads();
    }
}

__device__ __forceinline__ int crow(int r, int hi) { return (r & 3) + 8 * (r >> 2) + 4 * hi; }
typedef short v4i16_t __attribute__((ext_vector_type(4)));
__device__ __forceinline__ s16x4 vtr(const LAS unsigned char* p) { return __builtin_bit_cast(s16x4, __builtin_amdgcn_ds_read_tr16_b64_v4i16((LAS v4i16_t*)p)); }
__device__ __forceinline__ float half_swap_max(float x) { auto rr = __builtin_amdgcn_permlane32_swap(__float_as_uint(x), __float_as_uint(x), false, false); return fmaxf(__uint_as_float(rr[0]), __uint_as_float(rr[1])); }
__device__ __forceinline__ float half_swap_sum(float x) { auto rr = __builtin_amdgcn_permlane32_swap(__float_as_uint(x), __float_as_uint(x), false, false); return __uint_as_float(rr[0]) + __uint_as_float(rr[1]); }

__device__ __forceinline__ void attn_pv(f32x16 (&o)[4], const bf16x8 (&pa)[4], unsigned vaddr) {
    s16x4 vl[2][4], vh[2][4];
#define ATT_VRD(SET, D) do { _Pragma("unroll") for (int ks_ = 0; ks_ < 4; ++ks_) { \
        asm volatile("ds_read_b64_tr_b16 %0, %1 offset:%2" : "=&v"(vl[SET][ks_]) : "v"(vaddr), "i"((D) * 4096 + ks_ * 1024) : "memory"); \
        asm volatile("ds_read_b64_tr_b16 %0, %1 offset:%2" : "=&v"(vh[SET][ks_]) : "v"(vaddr), "i"((D) * 4096 + ks_ * 1024 + 512) : "memory"); } } while (0)
    __builtin_amdgcn_sched_barrier(0);
    ATT_VRD(0, 0);
#pragma unroll
    for (int d = 0; d < 4; ++d) {
        if (d == 0) { ATT_VRD(1, 1); } else if (d == 1) { ATT_VRD(0, 2); } else if (d == 2) { ATT_VRD(1, 3); }
        if (d < 3) asm volatile("s_waitcnt lgkmcnt(8)" ::: "memory"); else asm volatile("s_waitcnt lgkmcnt(0)" ::: "memory");
        __builtin_amdgcn_sched_barrier(0);
#pragma unroll
        for (int ks = 0; ks < 4; ++ks) { const s16x4 lo = vl[d & 1][ks], hv = vh[d & 1][ks];
            const bf16x8 vf = (bf16x8){lo[0], lo[1], lo[2], lo[3], hv[0], hv[1], hv[2], hv[3]};
            o[d] = __builtin_amdgcn_mfma_f32_32x32x16_bf16(pa[ks], vf, o[d], 0, 0, 0); }
        __builtin_amdgcn_sched_barrier(0);
    }
#undef ATT_VRD
}
__device__ __forceinline__ void attn_qk(f32x16& p0, f32x16& p1, const LAS unsigned char* kb, const bf16x8 (&qr)[4]) {
    p0 = (f32x16){}; p1 = (f32x16){};
#pragma unroll
    for (int d0 = 0; d0 < 4; ++d0) { const bf16x8 b0 = *(const LAS bf16x8*)(kb + d0 * 2048), b1 = *(const LAS bf16x8*)(kb + d0 * 2048 + 512);
        p0 = __builtin_amdgcn_mfma_f32_32x32x16_bf16(b0, qr[d0], p0, 0, 0, 0); p1 = __builtin_amdgcn_mfma_f32_32x32x16_bf16(b1, qr[d0], p1, 0, 0, 0); }
}
__device__ __forceinline__ void attn_softmax(const bool FIRST, f32x16& p0, f32x16& p1, f32x16 (&o)[4], float& mrun, float& lrun, bf16x8 (&pa)[4], LAS float* wsf, int r32, int hi) {
    if (FIRST) {
        asm volatile("" ::: "memory");
#pragma unroll
        for (int r = 0; r < 16; ++r) { if (r >= 8) p0[r] = -__builtin_inff(); p1[r] = -__builtin_inff(); } }
    float rmA = fmaxf(p0[0], p0[1]), rmB = fmaxf(p0[2], p0[3]), rmC = fmaxf(p1[0], p1[1]), rmD = fmaxf(p1[2], p1[3]);
#pragma unroll
    for (int r = 4; r < 16; r += 4) { rmA = fmaxf(rmA, fmaxf(p0[r], p0[r + 1])); rmB = fmaxf(rmB, fmaxf(p0[r + 2], p0[r + 3])); rmC = fmaxf(rmC, fmaxf(p1[r], p1[r + 1])); rmD = fmaxf(rmD, fmaxf(p1[r + 2], p1[r + 3])); }
    const float rm = half_swap_max(fmaxf(fmaxf(rmA, rmB), fmaxf(rmC, rmD)));
    if (FIRST) mrun = rm;
    else if (__any(rm > mrun + 8.0f)) {
        const float mnew = fmaxf(mrun, rm), alpha = __builtin_amdgcn_exp2f(mrun - mnew);
        lrun *= alpha; mrun = mnew;
        if (hi == 0) wsf[r32] = alpha;
        f32x4 a4[4];
#pragma unroll
        for (int gq = 0; gq < 4; ++gq) a4[gq] = *(const LAS f32x4*)(wsf + 8 * gq + 4 * hi);
#pragma unroll
        for (int d = 0; d < 4; ++d)
#pragma unroll
            for (int r = 0; r < 16; ++r) o[d][r] *= a4[r >> 2][r & 3];
    }
    float psA = 0.f, psB = 0.f, psC = 0.f, psD = 0.f;
#pragma unroll
    for (int r = 0; r < 16; r += 2) { p0[r] = __builtin_amdgcn_exp2f(p0[r] - mrun); p0[r + 1] = __builtin_amdgcn_exp2f(p0[r + 1] - mrun); p1[r] = __builtin_amdgcn_exp2f(p1[r] - mrun); p1[r + 1] = __builtin_amdgcn_exp2f(p1[r + 1] - mrun);
        psA += p0[r]; psB += p0[r + 1]; psC += p1[r]; psD += p1[r + 1]; }
    lrun += (psA + psB) + (psC + psD);
    u32x4 w;
    w = (u32x4){cvt_pk_bf16(p0[0], p0[1]), cvt_pk_bf16(p0[2], p0[3]), cvt_pk_bf16(p0[4], p0[5]), cvt_pk_bf16(p0[6], p0[7])}; pa[0] = __builtin_bit_cast(bf16x8, w);
    w = (u32x4){cvt_pk_bf16(p0[8], p0[9]), cvt_pk_bf16(p0[10], p0[11]), cvt_pk_bf16(p0[12], p0[13]), cvt_pk_bf16(p0[14], p0[15])}; pa[1] = __builtin_bit_cast(bf16x8, w);
    w = (u32x4){cvt_pk_bf16(p1[0], p1[1]), cvt_pk_bf16(p1[2], p1[3]), cvt_pk_bf16(p1[4], p1[5]), cvt_pk_bf16(p1[6], p1[7])}; pa[2] = __builtin_bit_cast(bf16x8, w);
    w = (u32x4){cvt_pk_bf16(p1[8], p1[9]), cvt_pk_bf16(p1[10], p1[11]), cvt_pk_bf16(p1[12], p1[13]), cvt_pk_bf16(p1[14], p1[15])}; pa[3] = __builtin_bit_cast(bf16x8, w);
}
__device__ __forceinline__ void glds16(const void* gsrc, unsigned lds_dst) { unsigned keep;
    asm volatile("s_mov_b32 %0, m0\n\ts_mov_b32 m0, %2\n\ts_nop 0\n\tglobal_load_lds_dwordx4 %1, off\n\ts_mov_b32 m0, %0" : "=&s"(keep) : "v"(gsrc), "s"(lds_dst) : "memory"); }
__device__ __forceinline__ void attn_unit(const Ctx& C, const bf16_t* Qg, const bf16_t* Kg, const bf16_t* Vg, const bf16_t* KM, const bf16_t* VM, bf16_t* Y,
                                          const float* subg, float lam, int b, int h, int qt, bool prefetched, int nqt, bf16x8 (&qr)[4], bool rb) {
    LAS unsigned char* lds = C.lds;
    const int lane = C.lane, wave = C.wave, r32 = lane & 31, hi = lane >> 5, qb = wave >> 1, map = wave & 1;
    const int q0 = qt * 128 + qb * 32;
    const size_t rowb = (size_t)b * SEQ;
    if (!prefetched) { const bf16_t* qp = Qg + (rowb + q0 + r32) * AW + h * 128 + map * 64 + hi * 8;
#pragma unroll
      for (int d0 = 0; d0 < 4; ++d0) qr[d0] = *(const bf16x8*)(qp + d0 * 16); }
    const int NT = 2 * qt + 3;
    const bool skip_last = (qb < 2);
    f32x16 o[4];
#pragma unroll
    for (int d = 0; d < 4; ++d) o[d] = (f32x16){};
    float mrun = -__builtin_inff(), lrun = 0.f;
    LAS float* wsf = (LAS float*)(lds + MISC_OFF + 4096 + wave * 256);
    const bf16_t* Kb = Kg + rowb * AW; const bf16_t* Vb = Vg + rowb * AW;
#define ATT_DMA(step, stage) do { const bf16_t* ks_ = (step) == 0 ? KM : Kb; const bf16_t* vs_ = (step) == 0 ? VM : Vb; const int row0_ = (step) == 0 ? 0 : ((step) - 1) * 64; \
    _Pragma("unroll") for (int i_ = 0; i_ < 2; ++i_) { const int p_ = 2 * wave + i_; \
        __builtin_amdgcn_global_load_lds((const unsigned*)(ks_ + (size_t)(row0_ + lane) * AW + h * 128 + (p_ >> 3) * 64 + (p_ & 7) * 8), (LAS unsigned*)(lds + (stage) * 32768 + p_ * 1024), 16, 0, 0); \
        __builtin_amdgcn_global_load_lds((const unsigned*)(vs_ + (size_t)(row0_ + 16 * (p_ & 3) + (lane >> 2)) * AW + h * 128 + (p_ >> 2) * 32 + (lane & 3) * 8), (LAS unsigned*)(lds + (stage) * 32768 + 16384 + p_ * 1024), 16, 0, 0); } } while (0)
    const int myNT = skip_last ? NT - 1 : NT;
    bf16x8 pa[4];
#pragma unroll
    for (int k = 0; k < 4; ++k) pa[k] = (bf16x8){};
    if (!prefetched) ATT_DMA(0, 0);
    asm volatile("s_waitcnt vmcnt(0)" ::: "memory"); __syncthreads();
    int stage = 0;
#pragma unroll 1
    for (int s = 0; s <= NT; ++s) {
        const int stn = stage == 2 ? 0 : stage + 1, stp = stage == 0 ? 2 : stage - 1;
        if (s + 1 < NT) ATT_DMA(s + 1, stn);
        if (rb && s >= 1 && s <= myNT) attn_pv(o, pa, (unsigned)(uintptr_t)(lds + stp * 32768 + 16384 + ((lane >> 4) & 1) * 32 + (lane & 3) * 8 + (4 * hi + ((lane & 15) >> 2)) * 64));
        if (s < myNT) {
            f32x16 p0, p1; attn_qk(p0, p1, lds + stage * 32768 + map * 8192 + hi * 1024 + r32 * 16, qr);
            attn_softmax(s == 0, p0, p1, o, mrun, lrun, pa, wsf, r32, hi);
            if (!rb) attn_pv(o, pa, (unsigned)(uintptr_t)(lds + stage * 32768 + 16384 + ((lane >> 4) & 1) * 32 + (lane & 3) * 8 + (4 * hi + ((lane & 15) >> 2)) * 64));
        }
        asm volatile("s_waitcnt vmcnt(0)" ::: "memory"); __syncthreads();
        stage = stn;
    }
#undef ATT_DMA
    bf16x8 qn[4];
#pragma unroll
    for (int d0 = 0; d0 < 4; ++d0) qn[d0] = qr[d0];
    if (nqt >= 0) {
        const unsigned lds0 = (unsigned)(uintptr_t)lds;
#pragma unroll
        for (int i = 0; i < 2; ++i) { const int p = 2 * wave + i;
            glds16(KM + (size_t)lane * AW + h * 128 + (p >> 3) * 64 + (p & 7) * 8, (unsigned)__builtin_amdgcn_readfirstlane(lds0 + p * 1024));
            glds16(VM + (size_t)(16 * (p & 3) + (lane >> 2)) * AW + h * 128 + (p >> 2) * 32 + (lane & 3) * 8, (unsigned)__builtin_amdgcn_readfirstlane(lds0 + 16384 + p * 1024)); }
        const bf16_t* qp = Qg + (rowb + nqt * 128 + qb * 32 + r32) * AW + h * 128 + map * 64 + hi * 8;
#pragma unroll
        for (int d0 = 0; d0 < 4; ++d0) qn[d0] = *(const bf16x8*)(qp + d0 * 16);
    }
    { const float ltot = half_swap_sum(lrun); const float inv = (map ? lam : 1.0f) / ltot;
      if (hi == 0) wsf[r32] = inv;
      f32x4 a4[4];
#pragma unroll
      for (int gq = 0; gq < 4; ++gq) a4[gq] = *(const LAS f32x4*)(wsf + 8 * gq + 4 * hi);
#pragma unroll
      for (int d = 0; d < 4; ++d)
#pragma unroll
          for (int r = 0; r < 16; ++r) o[d][r] *= a4[r >> 2][r & 3]; }
    LAS float* X = (LAS float*)(lds + 32768 + qb * 16384);
    if (map == 1) {
#pragma unroll
        for (int d = 0; d < 4; ++d)
#pragma unroll
            for (int r = 0; r < 16; ++r) X[crow(r, hi) * 128 + 32 * d + r32] = o[d][r];
    }
    __syncthreads();
    if (map == 0) {
        float ssq[16];
#pragma unroll
        for (int r = 0; r < 16; ++r) ssq[r] = 0.f;
#pragma unroll
        for (int d = 0; d < 4; ++d)
#pragma unroll
            for (int r = 0; r < 16; ++r) { const float v = o[d][r] - X[crow(r, hi) * 128 + 32 * d + r32]; o[d][r] = v; ssq[r] += v * v; }
#pragma unroll
        for (int r = 0; r < 16; ++r) {
            { float v = ssq[r]; v += dpp_f<0xB1>(v); v += dpp_f<0x4E>(v); v += dpp_f<0x141>(v); v += dpp_f<0x140>(v);
              auto r2 = __builtin_amdgcn_permlane16_swap(__float_as_uint(v), __float_as_uint(v), false, false); ssq[r] = __uint_as_float(r2[0]) + __uint_as_float(r2[1]); }
            ssq[r] = 0.8f / sqrtf(ssq[r] * (1.f / 128.f) + LN_EPS); }
        LAS bf16_t* Yt = (LAS bf16_t*)X;
#pragma unroll
        for (int d = 0; d < 4; ++d) { const float gg = subg[32 * d + r32];
#pragma unroll
            for (int r = 0; r < 16; ++r) Yt[crow(r, hi) * 128 + 32 * d + r32] = (bf16_t)(cvt_pk_bf16(o[d][r] * ssq[r] * gg, 0.f) & 0xffffu); }
#pragma unroll
        for (int i = 0; i < 8; ++i) { const int id = i * 64 + lane, row = id >> 4, ch = id & 15;
            *(u32x4*)(Y + (rowb + q0 + row) * AW + h * 128 + ch * 8) = *(const LAS u32x4*)(Yt + row * 128 + ch * 8); }
    }
#pragma unroll
    for (int d0 = 0; d0 < 4; ++d0) qr[d0] = qn[d0];
    __syncthreads();
}
__device__ __forceinline__ void p3_attention(const Ctx& C, const float* const* in, unsigned char* ws) {
    const bf16_t* Q = (const bf16_t*)(ws + WS_Q); const bf16_t* K = (const bf16_t*)(ws + WS_K); const bf16_t* V = (const bf16_t*)(ws + WS_V);
    const bf16_t* KM = (const bf16_t*)(ws + WS_KMETA); const bf16_t* VM = (const bf16_t*)(ws + WS_VMETA); bf16_t* Y = (bf16_t*)(ws + WS_YATT);
    const float l1 = wave_sum(in[14][C.lane] * in[15][C.lane]), l2 = wave_sum(in[16][C.lane] * in[17][C.lane]);
    const float lam = expf(l1) - expf(l2) + 0.2f;
    LAS unsigned* rc = (LAS unsigned*)(C.lds + MISC_OFF + 6144);
    if (C.tid < 4) rc[C.tid] = 0;
    __syncthreads();
    bool rb;
    { const unsigned simd = (unsigned)__builtin_amdgcn_s_getreg(2308) & 3u;
      unsigned r = 0; if (C.lane == 0) r = __hip_atomic_fetch_add(rc + simd, 1u, __ATOMIC_RELAXED, __HIP_MEMORY_SCOPE_WORKGROUP);
      rb = (__builtin_amdgcn_readfirstlane((int)r) & 1) != 0; }
#ifndef ATT_REP
#define ATT_REP 1
#endif
    for (int vv = C.vcu; vv < 256 * ATT_REP; vv += C.G) { const int v = vv & 255;
        const int bh = v >> 1, sft = v & 1;
        bf16x8 qr[4];
#pragma unroll
        for (int d0 = 0; d0 < 4; ++d0) qr[d0] = (bf16x8){};
#pragma unroll 1
        for (int i = 0; i < 8; ++i) { const int qt = (i & 1) ? (15 - sft - (i & ~1)) : (sft + (i & ~1)); const int i1 = i + 1;
            const int nqt = i1 < 8 ? ((i1 & 1) ? (15 - sft - (i1 & ~1)) : (sft + (i1 & ~1))) : -1;
            attn_unit(C, Q, K, V, KM, VM, Y, in[18], lam, bh >> 3, bh & 7, qt, i > 0, nqt, qr, rb); }
    }
}

__device__ __forceinline__ void p6_ln1_router(const Ctx& C, const float* const* in, unsigned char* ws) {
    const int lane = C.lane, wave = C.wave, tid = C.tid;
    const bf16_t* Z = (const bf16_t*)(ws + WS_Z); bf16_t* H1 = (bf16_t*)(ws + WS_H1); const float* WrT = (const float*)(ws + WS_WRT);
    int* LIST = (int*)(ws + WS_LIST); float* WGT = (float*)(ws + WS_WGT); unsigned* ECNT = (unsigned*)(ws + WS_CTL) + CW_ECNT;
    const float* lg = in[22]; const float* lb = in[23];
    LAS float* WB = (LAS float*)C.lds;
    LAS unsigned char* XB = C.lds + 98304;
    LAS int* RE = (LAS int*)(XB);
    LAS float* RW = (LAS float*)(XB + 1024);
    LAS int* CL = (LAS int*)(XB + 2048);
    LAS int* BS = (LAS int*)(XB + 2048 + 128);
    LAS int* SL = (LAS int*)(XB + 2048 + 256);
    LAS float* LG = (LAS float*)(XB + 4096) + wave * 80;
    for (int rbk = C.vcu; rbk < T / 128; rbk += C.G) {
        if (tid < 32) CL[tid] = 0;
#pragma unroll 1
        for (int step = 0; step < 8; ++step) {
            const int lr0 = step * 16 + 2 * wave; const size_t row0 = (size_t)rbk * 128 + lr0;
            int l4 = 4 * lane; asm volatile("" : "+v"(l4));
            f32x4 v0[8], v1[8];
#pragma unroll
            for (int j = 0; j < 8; ++j) { const u32x2 z0 = *(const u32x2*)(Z + row0 * DM + 256 * j + l4), z1 = *(const u32x2*)(Z + (row0 + 1) * DM + 256 * j + l4);
                v0[j] = (f32x4){bf_lo(z0.x), bf_hi(z0.x), bf_lo(z0.y), bf_hi(z0.y)}; v1[j] = (f32x4){bf_lo(z1.x), bf_hi(z1.x), bf_lo(z1.y), bf_hi(z1.y)}; }
            float mean0, rstd0, mean1, rstd1; ln_stats(v0, mean0, rstd0); ln_stats(v1, mean1, rstd1);
#pragma unroll
            for (int j = 0; j < 8; ++j) { const f32x4 gg = *(const f32x4*)(lg + 256 * j + l4), bb = *(const f32x4*)(lb + 256 * j + l4);
                v0[j] = (v0[j] - mean0) * rstd0 * gg + bb; v1[j] = (v1[j] - mean1) * rstd1 * gg + bb;
                u32x2 w; w.x = cvt_pk_bf16(v0[j].x, v0[j].y); w.y = cvt_pk_bf16(v0[j].z, v0[j].w); *(u32x2*)(H1 + row0 * DM + 256 * j + l4) = w;
                w.x = cvt_pk_bf16(v1[j].x, v1[j].y); w.y = cvt_pk_bf16(v1[j].z, v1[j].w); *(u32x2*)(H1 + (row0 + 1) * DM + 256 * j + l4) = w; }
#pragma unroll 1
            for (int ng = 0; ng < 3; ++ng) {
                __syncthreads();
                int tq = tid; asm volatile("" : "+v"(tq));
#pragma unroll
                for (int i = 0; i < 12; ++i) { const int idx = tq + 512 * i, n = idx >> 9, c4 = idx & 511;
                    *(LAS f32x4*)(WB + n * 2048 + 4 * c4) = *(const f32x4*)(WrT + (size_t)(12 * ng + n) * DM + 4 * c4); }
                __syncthreads();
#pragma unroll 1
                for (int q = 0; q < 6; ++q) {
                    f32x4 qa0 = (f32x4){0.f, 0.f, 0.f, 0.f}, qb0 = qa0, qa1 = qa0, qb1 = qa0;
#pragma unroll
                    for (int j = 0; j < 8; ++j) { const f32x4 w4 = *(const LAS f32x4*)(WB + (2 * q) * 2048 + 256 * j + l4), x4 = *(const LAS f32x4*)(WB + (2 * q + 1) * 2048 + 256 * j + l4);
                        qa0 = v0[j] * w4 + qa0; qb0 = v1[j] * w4 + qb0; qa1 = v0[j] * x4 + qa1; qb1 = v1[j] * x4 + qb1; }
                    const float pa0 = (qa0.x + qa0.y) + (qa0.z + qa0.w), pb0 = (qb0.x + qb0.y) + (qb0.z + qb0.w), pa1 = (qa1.x + qa1.y) + (qa1.z + qa1.w), pb1 = (qb1.x + qb1.y) + (qb1.z + qb1.w);
                    auto h0 = __builtin_amdgcn_permlane32_swap(__float_as_uint(pa0), __float_as_uint(pb0), false, false); const float w0 = __uint_as_float(h0[0]) + __uint_as_float(h0[1]);
                    auto h1 = __builtin_amdgcn_permlane32_swap(__float_as_uint(pa1), __float_as_uint(pb1), false, false); const float w1 = __uint_as_float(h1[0]) + __uint_as_float(h1[1]);
                    auto h2 = __builtin_amdgcn_permlane16_swap(__float_as_uint(w0), __float_as_uint(w1), false, false); float z = __uint_as_float(h2[0]) + __uint_as_float(h2[1]);
                    z += dpp_f<0xB1>(z); z += dpp_f<0x4E>(z); z += dpp_f<0x141>(z); z += dpp_f<0x140>(z);
                    if ((lane & 15) == 0) LG[(lane >> 5) * 40 + 12 * ng + 2 * q + ((lane >> 4) & 1)] = z; }
            }
            if (lane < 2) {
                const LAS float* L = LG + 40 * lane;
                int gi = 0; float gm = L[0] + in[25][0];
                for (int n = 1; n < 4; ++n) { const float x = L[n] + in[25][n]; if (x > gm) { gm = x; gi = n; } }
                float gs = 0.f;
                for (int n = 0; n < 4; ++n) gs += __expf(L[n] + in[25][n] - gm);
                const float gval = 1.0f / gs;
                int i1 = 0; float m1 = L[4 + gi * 8] + in[27][gi * 8];
                for (int j = 1; j < 8; ++j) { const float x = L[4 + gi * 8 + j] + in[27][gi * 8 + j]; if (x > m1) { m1 = x; i1 = j; } }
                int i2 = -1; float m2 = -__builtin_inff();
                for (int j = 0; j < 8; ++j) { const float x = L[4 + gi * 8 + j] + in[27][gi * 8 + j]; if (j != i1 && x > m2) { m2 = x; i2 = j; } }
                const float tt = __expf(m2 - m1), w1 = gval / (1.f + tt), w2 = gval * tt / (1.f + tt);
                const int lr = lr0 + lane; RE[lr * 2] = gi * 8 + i1; RE[lr * 2 + 1] = gi * 8 + i2; RW[lr * 2] = w1; RW[lr * 2 + 1] = w2;
            }
        }
        __syncthreads();
        int e = 0;
        if (tid < 256) { e = RE[tid]; SL[tid] = __hip_atomic_fetch_add(&CL[e], 1, __ATOMIC_RELAXED, __HIP_MEMORY_SCOPE_WORKGROUP); }
        __syncthreads();
        if (tid < 32) BS[tid] = (int)__hip_atomic_fetch_add(&ECNT[tid], (unsigned)CL[tid], __ATOMIC_RELAXED, __HIP_MEMORY_SCOPE_AGENT);
        __syncthreads();
        if (tid < 256) { const int entry = (rbk * 128 + (tid >> 1)) * 2 + (tid & 1); LIST[(size_t)e * CAP + BS[e] + SL[tid]] = entry; WGT[entry] = RW[tid]; }
        __syncthreads();
    }
}

__device__ __forceinline__ void p9_ln2(const Ctx& C, const float* const* in, unsigned char* ws, float* out) {
    const bf16_t* H1 = (const bf16_t*)(ws + WS_H1); const bf16_t* YK = (const bf16_t*)(ws + WS_YK);
    const float* lg = in[31]; const float* lb = in[32];
    const int gw = C.vcu * 8 + C.wave, NGW = C.G * 8, lane = C.lane;
    for (int m = gw; m < T; m += 2 * NGW) {
        const int m2 = (m + NGW < T) ? m + NGW : m;
        u32x2 ha[8], ya0[8], ya1[8], hb[8], yb0[8], yb1[8];
#pragma unroll
        for (int j = 0; j < 8; ++j) { const size_t c = 256 * j + 4 * lane;
            ha[j] = *(const u32x2*)(H1 + (size_t)m * DM + c); ya0[j] = *(const u32x2*)(YK + (size_t)(2 * m) * DM + c); ya1[j] = *(const u32x2*)(YK + (size_t)(2 * m + 1) * DM + c);
            hb[j] = *(const u32x2*)(H1 + (size_t)m2 * DM + c); yb0[j] = *(const u32x2*)(YK + (size_t)(2 * m2) * DM + c); yb1[j] = *(const u32x2*)(YK + (size_t)(2 * m2 + 1) * DM + c); }
#pragma unroll
        for (int rr = 0; rr < 2; ++rr) {
            f32x4 v[8];
#pragma unroll
            for (int j = 0; j < 8; ++j) { const u32x2 hw = rr ? hb[j] : ha[j], y0 = rr ? yb0[j] : ya0[j], y1 = rr ? yb1[j] : ya1[j];
                v[j] = (f32x4){bf_lo(hw.x), bf_hi(hw.x), bf_lo(hw.y), bf_hi(hw.y)} * ALPHA + (f32x4){bf_lo(y0.x), bf_hi(y0.x), bf_lo(y0.y), bf_hi(y0.y)} + (f32x4){bf_lo(y1.x), bf_hi(y1.x), bf_lo(y1.y), bf_hi(y1.y)}; }
            float mean, rstd; ln_stats(v, mean, rstd);
            const int mm = rr ? m2 : m;
            if (rr == 0 || m2 != m) {
#pragma unroll
                for (int j = 0; j < 8; ++j) { const f32x4 gg = *(const f32x4*)(lg + 256 * j + 4 * lane), bb = *(const f32x4*)(lb + 256 * j + 4 * lane);
                    *(f32x4*)(out + (size_t)mm * DM + 256 * j + 4 * lane) = (v[j] - mean) * rstd * gg + bb; } }
        }
    }
}

__device__ __forceinline__ int build_moe_tables(const Ctx& C, unsigned char* ws) {
    LAS int* blkstart = (LAS int*)(C.lds + MISC_OFF + 64); LAS int* cntE = (LAS int*)(C.lds + MISC_OFF + 320); LAS int* blkexp = (LAS int*)(C.lds + MISC_OFF + 512);
    unsigned* ECNT = (unsigned*)(ws + WS_CTL) + CW_ECNT;
    __syncthreads();
    if (C.tid < 32) cntE[C.tid] = (int)__hip_atomic_load(&ECNT[C.tid], __ATOMIC_RELAXED, __HIP_MEMORY_SCOPE_AGENT);
    __syncthreads();
    if (C.tid == 0) { int s = 0; for (int e = 0; e < NE; ++e) { blkstart[e] = s; s += (cntE[e] + 255) >> 8; } blkstart[NE] = s; }
    __syncthreads();
    const int NBLK = blkstart[NE];
    if (C.tid < NBLK && C.tid < 320) { int e = 0; for (int j = 1; j < NE; ++j) if (blkstart[j] <= C.tid) e = j; blkexp[C.tid] = e; }
    __syncthreads();
    return NBLK < 320 ? NBLK : 320;
}

__device__ __forceinline__ void p7_convert_down(const Ctx& C, const float* const* in, unsigned char* ws) {
    LAS float* scr = (LAS float*)(C.lds + C.wave * 16384);
    unsigned* ctr = (unsigned*)(ws + WS_CTL) + CW_CONV; bf16_t* WdnT = (bf16_t*)(ws + WS_WDN);
    constexpr int NCH = NE * 512 / 16;
    for (;;) {
        unsigned ch = 0; if (C.lane == 0) ch = __hip_atomic_fetch_add(ctr, 1u, __ATOMIC_RELAXED, __HIP_MEMORY_SCOPE_AGENT);
        ch = (unsigned)__builtin_amdgcn_readfirstlane((int)ch);
        if (ch >= (unsigned)NCH) break;
#pragma unroll 1
        for (int q = 0; q < 16; ++q) { const int r = (int)ch * 16 + q, e = r >> 9, rr = r & 511, kb = rr >> 6, nb = rr & 63;
            transpose_item(in[30] + (size_t)e * DFF * DM, DFF, DM, WdnT, kb, nb, e * 2048 + 32 * nb, scr, C.lane); }
    }
}

constexpr int NPHASE = 10;
struct Args { const float* in[33]; float* out; unsigned char* ws; int ph_lo, ph_hi; };
__global__ void __launch_bounds__(512, 2) mk_fwd(Args args) {
    extern __shared__ __attribute__((aligned(16))) unsigned char lds_raw[];
    Ctx C; C.lds = (LAS unsigned char*)lds_raw; C.tid = threadIdx.x; C.lane = C.tid & 63; C.wave = __builtin_amdgcn_readfirstlane(C.tid >> 6);
    C.G = gridDim.x; { const int bx = blockIdx.x; C.vcu = (C.G % 8 == 0) ? (bx % 8) * (C.G / 8) + bx / 8 : bx; }
    unsigned char* ws = args.ws; const float* const* in = args.in;
    volatile LAS unsigned* MISC = (volatile LAS unsigned*)(C.lds + MISC_OFF);
    if (C.tid < 16) MISC[C.tid] = 0u;
    __syncthreads();
    unsigned* barw = (unsigned*)(ws + WS_CTL) + CW_BAR;
    XcdBarrier bar; bar.bar = barw; bar.x = 0; bar.st = nullptr;
    const int lo = args.ph_lo, hi = args.ph_hi;
    if (hi - lo > 1) bar = xcd_barrier_post(barw, MISC);
#ifndef PH_MASK
#define PH_MASK 0x3ff
#endif
#define IN(k) (((PH_MASK >> (k)) & 1) && lo <= (k) && (k) < hi)
#define SEAM(k) do { if (IN(k) && IN((k) + 1)) xcd_barrier(bar); } while (0)
#ifndef WGM_PROJ
#define WGM_PROJ 4
#endif
#ifndef WGM_N2K
#define WGM_N2K 2
#endif
#ifndef GEMM_SP2
#define GEMM_SP2 true
#endif
#ifndef GEMM_ALIGN
#define GEMM_ALIGN true
#endif
#ifndef PROBE_MASK
#define PROBE_MASK 0
#endif
#define REPS(k) (((PROBE_MASK >> (k)) & 1) ? 2 : 1)
#define REPSEAM(k, rep) do { if ((rep) + 1 < REPS(k)) xcd_barrier(bar); } while (0)
    LAS unsigned char* lds = C.lds;
    bf16_t* MG = (bf16_t*)args.out;

    if (IN(0)) { _Pragma("unroll") for (int rep = 0; rep < REPS(0); ++rep) { p0_prologue(C, in, ws); REPSEAM(0, rep); } } SEAM(0);

    if (IN(1)) { _Pragma("unroll") for (int rep = 0; rep < REPS(1); ++rep) {
        pg8::Gemm g{(const bf16_t*)(ws + WS_HBF), (const bf16_t*)(ws + WS_WIN), T, INC, DM, nullptr, nullptr, 0}; pg8::StaticOrder S; S.init(T, INC, C.G, (int)blockIdx.x, WGM_PROJ);
        EpiProj E{(bf16_t*)(ws + WS_U), (bf16_t*)(ws + WS_Q), (bf16_t*)(ws + WS_K), (bf16_t*)(ws + WS_V), (bf16_t*)(ws + WS_SGS), (bf16_t*)(ws + WS_SGA)};
        pg8::gemm_phase<EpiProj, pg8::StaticOrder, GEMM_ALIGN, GEMM_SP2, false>(lds, g, S, E);
        p1_meta_proj(C, ws);
        REPSEAM(1, rep);
    } } SEAM(1);

    if (IN(2)) { _Pragma("unroll") for (int rep = 0; rep < REPS(2); ++rep) { p2_scan(C, in, ws); REPSEAM(2, rep); } } SEAM(2);

    if (IN(3)) { _Pragma("unroll") for (int rep = 0; rep < REPS(3); ++rep) {
        { pg8::Gemm g{(const bf16_t*)(ws + WS_YPRE), (const bf16_t*)(ws + WS_WGLU), T, SSMW, SSMW, nullptr, nullptr, 0}; pg8::StaticOrder S; S.init(T, SSMW, C.G, (int)blockIdx.x);
          EpiGlu E{(const bf16_t*)(ws + WS_YPRE), (bf16_t*)(ws + WS_YSSM)};
          pg8::gemm_phase<EpiGlu, pg8::StaticOrder, GEMM_ALIGN, GEMM_SP2, false>(lds, g, S, E); }
        p3_attention(C, in, ws);
        REPSEAM(3, rep);
    } } SEAM(3);

    if (IN(4)) { _Pragma("unroll") for (int rep = 0; rep < REPS(4); ++rep) {
        { pg8::Gemm g{(const bf16_t*)(ws + WS_YSSM), (const bf16_t*)(ws + WS_WBS), T, DM, SSMW, (const bf16_t*)(ws + WS_YATT), (const bf16_t*)(ws + WS_WBA), AW}; pg8::StaticOrder S; S.init(T, DM, C.G, (int)blockIdx.x, WGM_N2K);
          EpiMergeF E{(const bf16_t*)(ws + WS_SGS), (const bf16_t*)(ws + WS_SGA), MG};
          pg8::gemm_phase<EpiMergeF, pg8::StaticOrder, GEMM_ALIGN, GEMM_SP2, false, true>(lds, g, S, E); }
        REPSEAM(4, rep);
    } } SEAM(4);

    if (IN(5)) { _Pragma("unroll") for (int rep = 0; rep < REPS(5); ++rep) {
        pg8::Gemm g{MG, (const bf16_t*)(ws + WS_WO), T, DM, DM, nullptr, nullptr, 0}; pg8::StaticOrder S; S.init(T, DM, C.G, (int)blockIdx.x, WGM_N2K);
        EpiZ E{(const bf16_t*)(ws + WS_HBF), (bf16_t*)(ws + WS_Z)};
        pg8::gemm_phase<EpiZ, pg8::StaticOrder, GEMM_ALIGN, GEMM_SP2, false>(lds, g, S, E);
        REPSEAM(5, rep);
    } } SEAM(5);

    if (IN(6)) { p6_ln1_router(C, in, ws); } SEAM(6);

    if (IN(7)) { _Pragma("unroll") for (int rep = 0; rep < REPS(7); ++rep) {
        const int NBLK = build_moe_tables(C, ws);
        MoeOrder S{C.G, C.vcu, 2, NBLK, (const LAS int*)(lds + MISC_OFF + 512), (const LAS int*)(lds + MISC_OFF + 64), (const LAS int*)(lds + MISC_OFF + 320), (const int*)(ws + WS_LIST)};
        pg8::Gemm g{(const bf16_t*)(ws + WS_H1), (const bf16_t*)(ws + WS_WUP), T, NE * 1024, DM, nullptr, nullptr, 0};
        EpiSwiglu E{(bf16_t*)(ws + WS_HB), (const int*)(ws + WS_LIST), (const float*)(ws + WS_WGT), (int*)(ws + WS_POSE), (float*)(ws + WS_POSW)};
        pg8::gemm_phase<EpiSwiglu, MoeOrder, GEMM_ALIGN, GEMM_SP2, true>(lds, g, S, E);
        p7_convert_down(C, in, ws);
        REPSEAM(7, rep);
    } } SEAM(7);

    if (IN(8)) { _Pragma("unroll") for (int rep = 0; rep < REPS(8); ++rep) {
        const int NBLK = build_moe_tables(C, ws);
        MoeOrder S{C.G, C.vcu, 3, NBLK, (const LAS int*)(lds + MISC_OFF + 512), (const LAS int*)(lds + MISC_OFF + 64), (const LAS int*)(lds + MISC_OFF + 320), (const int*)(ws + WS_LIST)};
        pg8::Gemm g{(const bf16_t*)(ws + WS_HB), (const bf16_t*)(ws + WS_WDN), NBLK * 256, NE * DM, DFF, nullptr, nullptr, 0};
        EpiDown E{(const int*)(ws + WS_POSE), (const float*)(ws + WS_POSW), (bf16_t*)(ws + WS_YK)};
        pg8::gemm_phase<EpiDown, MoeOrder, GEMM_ALIGN, GEMM_SP2, false>(lds, g, S, E);
        REPSEAM(8, rep);
    } } SEAM(8);

    if (IN(9)) { _Pragma("unroll") for (int rep = 0; rep < REPS(9); ++rep) { p9_ln2(C, in, ws, args.out); REPSEAM(9, rep); } }
#undef IN
#undef SEAM
}

extern "C" void kernel_launch(void* const* d_in, const int* in_sizes, int n_in, void* d_out, int out_size, void* d_ws, size_t ws_size, hipStream_t stream) {
    static int grid = 0;
    if (grid == 0) {
        if (n_in != 33 || in_sizes[0] != T * DM || out_size != T * DM || ws_size < WS_END) { fprintf(stderr, "kernel_launch: unexpected shapes (n_in %d, in0 %d, out %d, ws %zu)\n", n_in, n_in > 0 ? in_sizes[0] : -1, out_size, ws_size); grid = -1; return; }
        int dev = 0, cus = 0, per_cu = 0;
        if (hipGetDevice(&dev) != hipSuccess || hipDeviceGetAttribute(&cus, hipDeviceAttributeMultiprocessorCount, dev) != hipSuccess) { grid = -1; return; }
        if (hipFuncSetAttribute((const void*)mk_fwd, hipFuncAttributeMaxDynamicSharedMemorySize, LDS_BYTES) != hipSuccess) { fprintf(stderr, "kernel_launch: hipFuncSetAttribute failed\n"); grid = -1; return; }
        if (hipOccupancyMaxActiveBlocksPerMultiprocessor(&per_cu, (const void*)mk_fwd, 512, LDS_BYTES) != hipSuccess || per_cu < 1) { fprintf(stderr, "kernel_launch: occupancy query reports %d blocks per CU\n", per_cu); }
        (void)hipGetLastError();
        grid = cus;
    }
    if (grid < 0) return;
    (void)hipMemsetAsync((char*)d_ws + WS_CTL, 0, CTL_ZERO_BYTES, stream);
    Args a{};
    for (int i = 0; i < 33; ++i) a.in[i] = (const float*)d_in[i];
    a.out = (float*)d_out; a.ws = (unsigned char*)d_ws;
#if MK_PER_PHASE
    for (int p = 0; p < NPHASE; ++p) { a.ph_lo = p; a.ph_hi = p + 1; hipLaunchKernelGGL(mk_fwd, dim3(grid), dim3(512), LDS_BYTES, stream, a); }
#else
    a.ph_lo = 0; a.ph_hi = NPHASE; hipLaunchKernelGGL(mk_fwd, dim3(grid), dim3(512), LDS_BYTES, stream, a);
#endif
}
```

```cpp
#include <hip/hip_runtime.h>
#include <stdint.h>
#include <stdio.h>

#ifndef ATT_PROBE
#define ATT_PROBE 0
#endif
#ifndef MK_PER_PHASE
#define MK_PER_PHASE 0
#endif

#define GAS __attribute__((address_space(1)))
#define LAS __attribute__((address_space(3)))
typedef unsigned short bf16_t;
typedef short bf16x8 __attribute__((ext_vector_type(8)));
typedef short s16x4 __attribute__((ext_vector_type(4)));
typedef float f32x2 __attribute__((ext_vector_type(2)));
typedef float f32x4 __attribute__((ext_vector_type(4)));
typedef float f32x16 __attribute__((ext_vector_type(16)));
typedef unsigned u32x2 __attribute__((ext_vector_type(2)));
typedef unsigned u32x4 __attribute__((ext_vector_type(4)));

constexpr int NB_ = 16, SEQ = 2048, DM = 2048, T = NB_ * SEQ, NMETA = 16;
constexpr int SSMW = 512, AW = 1024, INC = 7680, NGRP = 32, NST = 64;
constexpr int NE = 32, DFF = 512, CAP = T;
constexpr float LN_EPS = 1e-5f;
constexpr float ALPHA = 1.189207115002721f;
constexpr float QSCALE = 0.125f * 1.4426950408889634f;

__device__ __forceinline__ unsigned cvt_pk_bf16(float lo, float hi) { unsigned r; asm volatile("v_cvt_pk_bf16_f32 %0, %1, %2" : "=v"(r) : "v"(lo), "v"(hi)); return r; }
__device__ __forceinline__ float bf_lo(unsigned w) { return __uint_as_float(w << 16); }
__device__ __forceinline__ float bf_hi(unsigned w) { return __uint_as_float(w & 0xffff0000u); }
__device__ __forceinline__ float sigmoidf_(float x) { return __builtin_amdgcn_rcpf(1.0f + __expf(-x)); }
template <int CTRL> __device__ __forceinline__ float dpp_f(float v) { return __int_as_float(__builtin_amdgcn_update_dpp(0, __float_as_int(v), CTRL, 0xf, 0xf, true)); }
__device__ __forceinline__ float wave_sum(float v) {
    v += dpp_f<0xB1>(v);
    v += dpp_f<0x4E>(v);
    v += dpp_f<0x141>(v);
    v += dpp_f<0x140>(v);
    { auto r = __builtin_amdgcn_permlane16_swap(__float_as_uint(v), __float_as_uint(v), false, false); v = __uint_as_float(r[0]) + __uint_as_float(r[1]); }
    { auto r = __builtin_amdgcn_permlane32_swap(__float_as_uint(v), __float_as_uint(v), false, false); v = __uint_as_float(r[0]) + __uint_as_float(r[1]); }
    return v;
}

namespace pg8 {
constexpr int BM = 256, BK = 64, HALF = 128, HTB = HALF * BK * 2, STAGE_BYTES = 8 * HTB, NXCD = 8, WGM = 4;
__host__ __device__ __forceinline__ int lds_byte(int r, int c) { const int st = (r >> 4) * 2 + (c >> 5), rr = r & 15, cc = c & 31, ob = rr * 64 + cc * 2; return st * 1024 + (ob ^ (((ob >> 9) & 1) << 5)); }
__host__ __device__ __forceinline__ void stage_rc(int b, int& R, int& C) { const int st = b / 1024, sb = b % 1024, swz = sb ^ (((sb >> 9) & 1) << 5); R = (st >> 1) * 16 + swz / 64; C = (st & 1) * 32 + (swz % 64) / 2; }
__host__ __device__ __forceinline__ int perm32(int rho) { const int n = rho >> 4, i = rho & 15; return 8 * (i >> 2) + 4 * n + (i & 3); }

struct Unit { int pm, pn, e, s0, cnt; };
struct Gemm { const bf16_t* A; const bf16_t* Bt; int M, N, K; const bf16_t* A2; const bf16_t* Bt2; int K2; };

struct StaticOrder {
    int nM, nN, nwg, G, c, wgm;
    __device__ void init(int M, int N, int G_, int c_, int wgm_ = WGM) { nM = M / BM; nN = N / BM; nwg = nM * nN; G = G_; c = c_; wgm = wgm_; }
    __device__ bool next(int i, Unit& u) const {
        const long L = (long)i * G + c; if (L >= nwg) return false;
        int wgid = (int)L; { const int q = nwg / NXCD, r = nwg % NXCD, xcd = wgid % NXCD, off = wgid / NXCD; wgid = (xcd < r ? xcd * (q + 1) : r * (q + 1) + (xcd - r) * q) + off; }
        const int nig = wgm * nN, gid = wgid / nig, fm = gid * wgm, gsz = (nM - fm) < wgm ? (nM - fm) : wgm;
        u.pm = fm + ((wgid % nig) % gsz); u.pn = (wgid % nig) / gsz; u.e = 0; u.s0 = 0; u.cnt = 0; return true;
    }
    __device__ __forceinline__ int arow(const Unit&, int) const { return 0; }
};

template <class Epi, class Sched, bool ALIGN_EPI, bool SP2, bool GATHER, bool DUAL = false>
__device__ __forceinline__ void gemm_phase(LAS unsigned char* lds, const Gemm g, const Sched& S, const Epi& E) {
    const int tid = threadIdx.x, wid = __builtin_amdgcn_readfirstlane(tid >> 6), lane = tid & 63, wr = wid >> 2, wc = wid & 3, fr = lane & 15, fq = lane >> 4;
    const int K = g.K, K2 = DUAL ? g.K2 : 0, nt1 = K / BK, nt = (K + K2) / BK;
    unsigned voffA[2], voffB[2], voffA2[2] = {0u, 0u}, voffB2[2] = {0u, 0u}; int stR[2], stC[2];
#pragma unroll
    for (int i = 0; i < 2; ++i) { int R, C; stage_rc(tid * 16 + i * 8192, R, C); const int Rb = Epi::PERM ? ((R & ~31) + perm32(R & 31)) : R;
        stR[i] = R; stC[i] = C; voffA[i] = (unsigned)(R * K + C) * 2u; voffB[i] = (unsigned)(Rb * K + C) * 2u;
        if constexpr (DUAL) { voffA2[i] = (unsigned)(R * K2 + C) * 2u; voffB2[i] = (unsigned)(Rb * K2 + C) * 2u; } }
    const size_t kstep = (size_t)(BK * 2);
    const size_t hstep = (size_t)HALF * K * 2;
    const size_t tstep = 2 * hstep;
    const size_t hstep2 = (size_t)HALF * K2 * 2, tstep2 = 2 * hstep2;
    const unsigned ldsw = (unsigned)wid * 1024u;
    const int aoff = lds_byte(wr * 64 + fr, fq * 8), boff = lds_byte(wc * 32 + fr, fq * 8);
#define PG8_SA(b, h) (((b) * 2 + (h)) * HTB)
#define PG8_SB(b, h) ((4 + (b) * 2 + (h)) * HTB)
#define PG8_STAGE(bufoff, gbase, voff) do { _Pragma("unroll") for (int _i = 0; _i < 2; ++_i) \
        __builtin_amdgcn_global_load_lds((const unsigned*)((const char*)(gbase) + (voff)[_i]), (LAS unsigned*)(lds + (bufoff) + ldsw + _i * 8192), 16, 0, 0); } while (0)
#define PG8_STAGE_A(bufoff, kbase, h, VO) do { if constexpr (GATHER) { PG8_STAGE(bufoff, kbase, VO[h]); } else { PG8_STAGE(bufoff, (kbase) + (h) * hstep, voffA); } } while (0)
#define PG8_STAGE_AX(bufoff, kbase, h, VO, HS, VA) do { if constexpr (GATHER) { PG8_STAGE(bufoff, kbase, VO[h]); } else { PG8_STAGE(bufoff, (kbase) + (h) * (HS), VA); } } while (0)
#define PG8_LDA(dst, b, h) do { _Pragma("unroll") for (int m = 0; m < 4; ++m) _Pragma("unroll") for (int k = 0; k < 2; ++k) dst[m][k] = *(const LAS bf16x8*)(lds + PG8_SA(b, h) + aoff + m * 2048 + k * 1024); } while (0)
#define PG8_LDB(dst, b, h) do { _Pragma("unroll") for (int n = 0; n < 2; ++n) _Pragma("unroll") for (int k = 0; k < 2; ++k) dst[n][k] = *(const LAS bf16x8*)(lds + PG8_SB(b, h) + boff + n * 2048 + k * 1024); } while (0)
#define PG8_MMA(ai, bj, At, Bt) do { __builtin_amdgcn_s_setprio(1); _Pragma("unroll") for (int m = 0; m < 4; ++m) _Pragma("unroll") for (int n = 0; n < 2; ++n) _Pragma("unroll") for (int k = 0; k < 2; ++k) \
        acc[ai][bj][m][n] = __builtin_amdgcn_mfma_f32_16x16x32_bf16(Bt[n][k], At[m][k], acc[ai][bj][m][n], 0, 0, 0); __builtin_amdgcn_s_setprio(0); } while (0)
#define PG8_WAIT_V(n) asm volatile("s_waitcnt vmcnt(" #n ")" ::: "memory")
#define PG8_WAIT_L(n) asm volatile("s_waitcnt lgkmcnt(" #n ")" ::: "memory")
#define PG8_BAR __builtin_amdgcn_s_barrier()
#define PG8_SCHED __builtin_amdgcn_sched_barrier(0)
#define PG8_GOFF(VO, U) do { _Pragma("unroll") for (int _h = 0; _h < 2; ++_h) _Pragma("unroll") for (int _i = 0; _i < 2; ++_i) \
        VO[_h][_i] = (unsigned)S.arow(U, _h * HALF + stR[_i]) * (unsigned)(K * 2) + (unsigned)(stC[_i] * 2); } while (0)
    Unit cur, nxt; int ui = 0;
    if (!S.next(0, cur)) return;
    f32x4 acc[2][2][4][2];
#pragma unroll
    for (int a = 0; a < 2; ++a)
#pragma unroll
        for (int b = 0; b < 2; ++b)
#pragma unroll
            for (int m = 0; m < 4; ++m)
#pragma unroll
                for (int n = 0; n < 2; ++n) acc[a][b][m][n] = (f32x4){0.f, 0.f, 0.f, 0.f};
    bf16x8 At[4][2], B0[2][2], B1[2][2];
    unsigned cvo[2][2] = {{0u, 0u}, {0u, 0u}}, nvo[2][2] = {{0u, 0u}, {0u, 0u}};
    const char* cA = GATHER ? (const char*)g.A : (const char*)g.A + (size_t)cur.pm * tstep; const char* cB = (const char*)g.Bt + (size_t)cur.pn * tstep;
    if constexpr (GATHER) { PG8_GOFF(cvo, cur); }
    if constexpr (SP2) {
        PG8_STAGE(PG8_SB(0, 0), cB, voffB); PG8_STAGE(PG8_SB(0, 1), cB + hstep, voffB); PG8_STAGE_A(PG8_SA(0, 0), cA, 0, cvo); PG8_STAGE_A(PG8_SA(0, 1), cA, 1, cvo);
        if (wr == 1) PG8_BAR;
        PG8_WAIT_V(2); PG8_BAR;
        PG8_STAGE(PG8_SB(1, 0), cB + kstep, voffB); PG8_STAGE_A(PG8_SA(1, 0), cA + kstep, 0, cvo); PG8_STAGE(PG8_SB(1, 1), cB + hstep + kstep, voffB);
        PG8_WAIT_V(6); PG8_BAR;
    } else {
        PG8_STAGE(PG8_SB(0, 0), cB, voffB); PG8_STAGE_A(PG8_SA(0, 0), cA, 0, cvo); PG8_STAGE(PG8_SB(0, 1), cB + hstep, voffB); PG8_STAGE_A(PG8_SA(0, 1), cA, 1, cvo);
        if (wr == 1) PG8_BAR;
        PG8_WAIT_V(4); PG8_BAR;
        PG8_STAGE(PG8_SB(1, 0), cB + kstep, voffB); PG8_STAGE_A(PG8_SA(1, 0), cA + kstep, 0, cvo); PG8_STAGE(PG8_SB(1, 1), cB + hstep + kstep, voffB);
        PG8_WAIT_V(6); PG8_BAR;
    }
    for (;;) {
        const bool has_next = S.next(ui + 1, nxt);
        const char* nA = GATHER ? cA : (has_next ? (const char*)g.A + (size_t)nxt.pm * tstep : cA); const char* nB = has_next ? (const char*)g.Bt + (size_t)nxt.pn * tstep : cB;
        if constexpr (GATHER) { if (has_next) { PG8_GOFF(nvo, nxt); } else {
#pragma unroll
            for (int h = 0; h < 2; ++h)
#pragma unroll
                for (int i = 0; i < 2; ++i) nvo[h][i] = cvo[h][i]; } }
        const char* cA2 = DUAL ? (const char*)g.A2 + (size_t)cur.pm * tstep2 : cA; const char* cB2 = DUAL ? (const char*)g.Bt2 + (size_t)cur.pn * tstep2 : cB;
        for (int t = 0; t < nt; t += 2) {
            const bool last = (t == nt - 2);
            const bool s1 = DUAL && (t + 1 >= nt1), s2 = DUAL && !last && (t + 2 >= nt1);
            const char* a1 = s1 ? cA2 + (size_t)(t + 1 - nt1) * kstep : cA + (size_t)(t + 1) * kstep;
            const char* a2 = last ? nA : (s2 ? cA2 + (size_t)(t + 2 - nt1) * kstep : cA + (size_t)(t + 2) * kstep);
            const char* b2 = last ? nB : (s2 ? cB2 + (size_t)(t + 2 - nt1) * kstep : cB + (size_t)(t + 2) * kstep);
            const char* a3 = a2 + kstep; const char* b3 = b2 + kstep;
            const size_t hs1 = s1 ? hstep2 : hstep, hs2 = s2 ? hstep2 : hstep;
            unsigned vA1[2], vA2[2], vB2[2];
#pragma unroll
            for (int i = 0; i < 2; ++i) { vA1[i] = s1 ? voffA2[i] : voffA[i]; vA2[i] = s2 ? voffA2[i] : voffA[i]; vB2[i] = s2 ? voffB2[i] : voffB[i]; }
            unsigned svo[2][2];
#pragma unroll
            for (int h = 0; h < 2; ++h)
#pragma unroll
                for (int i = 0; i < 2; ++i) svo[h][i] = last ? nvo[h][i] : cvo[h][i];
            if constexpr (SP2) {
            PG8_LDB(B0, 0, 0); PG8_LDB(B1, 0, 1); PG8_SCHED; PG8_LDA(At, 0, 0); PG8_STAGE_AX(PG8_SA(1, 1), a1, 1, cvo, hs1, vA1);
            PG8_WAIT_V(8); PG8_WAIT_L(0); PG8_BAR; PG8_MMA(0, 0, At, B0); PG8_MMA(0, 1, At, B1); PG8_BAR; PG8_SCHED;
            PG8_LDA(At, 0, 1); PG8_STAGE(PG8_SB(0, 0), b2, vB2); PG8_STAGE(PG8_SB(0, 1), b2 + hs2, vB2); PG8_STAGE_AX(PG8_SA(0, 0), a2, 0, svo, hs2, vA2);
            PG8_WAIT_V(8); PG8_WAIT_L(0); PG8_BAR; PG8_MMA(1, 0, At, B0); PG8_MMA(1, 1, At, B1); PG8_BAR; PG8_SCHED;
            PG8_LDB(B0, 1, 0); PG8_LDB(B1, 1, 1); PG8_SCHED; PG8_LDA(At, 1, 0); PG8_STAGE_AX(PG8_SA(0, 1), a2, 1, svo, hs2, vA2);
            PG8_WAIT_V(8); PG8_WAIT_L(0); PG8_BAR; PG8_MMA(0, 0, At, B0); PG8_MMA(0, 1, At, B1); PG8_BAR; PG8_SCHED;
            PG8_LDA(At, 1, 1); PG8_STAGE(PG8_SB(1, 0), b3, vB2); PG8_STAGE(PG8_SB(1, 1), b3 + hs2, vB2); PG8_STAGE_AX(PG8_SA(1, 0), a3, 0, svo, hs2, vA2);
            PG8_WAIT_V(8); PG8_WAIT_L(0); PG8_BAR; PG8_MMA(1, 0, At, B0); PG8_MMA(1, 1, At, B1); PG8_BAR; PG8_SCHED;
            } else {
            PG8_LDB(B0, 0, 0); PG8_SCHED; PG8_LDA(At, 0, 0); PG8_STAGE_AX(PG8_SA(1, 1), a1, 1, cvo, hs1, vA1);
            PG8_WAIT_L(8); PG8_BAR; PG8_WAIT_L(0); PG8_MMA(0, 0, At, B0); PG8_BAR; PG8_SCHED;
            PG8_LDB(B1, 0, 1); PG8_STAGE(PG8_SB(0, 0), b2, vB2);
            PG8_BAR; PG8_WAIT_L(0); PG8_MMA(0, 1, At, B1); PG8_BAR;
            PG8_LDA(At, 0, 1); PG8_STAGE_AX(PG8_SA(0, 0), a2, 0, svo, hs2, vA2);
            PG8_BAR; PG8_WAIT_L(0); PG8_MMA(1, 0, At, B0); PG8_BAR; PG8_SCHED;
            PG8_STAGE(PG8_SB(0, 1), b2 + hs2, vB2);
            PG8_WAIT_V(6); PG8_BAR; PG8_MMA(1, 1, At, B1); PG8_BAR;
            PG8_LDB(B0, 1, 0); PG8_SCHED; PG8_LDA(At, 1, 0); PG8_STAGE_AX(PG8_SA(0, 1), a2, 1, svo, hs2, vA2);
            PG8_WAIT_L(8); PG8_BAR; PG8_WAIT_L(0); PG8_MMA(0, 0, At, B0); PG8_BAR; PG8_SCHED;
            PG8_LDB(B1, 1, 1); PG8_STAGE(PG8_SB(1, 0), b3, vB2);
            PG8_BAR; PG8_WAIT_L(0); PG8_MMA(0, 1, At, B1); PG8_BAR;
            PG8_LDA(At, 1, 1); PG8_STAGE_AX(PG8_SA(1, 0), a3, 0, svo, hs2, vA2);
            PG8_BAR; PG8_WAIT_L(0); PG8_MMA(1, 0, At, B0); PG8_BAR; PG8_SCHED;
            PG8_STAGE(PG8_SB(1, 1), b3 + hs2, vB2);
            PG8_WAIT_V(6); PG8_BAR; PG8_MMA(1, 1, At, B1); PG8_BAR;
            }
            if constexpr (DUAL) { if (t + 2 == nt1) E.mid(acc, cur, wr, wc, fr, fq); }
        }
        if constexpr (ALIGN_EPI) { if (wr == 0) PG8_BAR; }
        E(acc, cur, wr, wc, fr, fq);
        if (!has_next) break;
#pragma unroll
        for (int a = 0; a < 2; ++a)
#pragma unroll
            for (int b = 0; b < 2; ++b)
#pragma unroll
                for (int m = 0; m < 4; ++m)
#pragma unroll
                    for (int n = 0; n < 2; ++n) acc[a][b][m][n] = (f32x4){0.f, 0.f, 0.f, 0.f};
        cur = nxt; cA = nA; cB = nB; ++ui;
#pragma unroll
        for (int h = 0; h < 2; ++h)
#pragma unroll
            for (int i = 0; i < 2; ++i) cvo[h][i] = nvo[h][i];
        if constexpr (ALIGN_EPI) { if (wr == 1) PG8_BAR; }
    }
    PG8_WAIT_V(0);
    if constexpr (!ALIGN_EPI) { if (wr == 0) PG8_BAR; }
    PG8_BAR;
#undef PG8_SA
#undef PG8_SB
#undef PG8_STAGE
#undef PG8_STAGE_A
#undef PG8_STAGE_AX
#undef PG8_LDA
#undef PG8_LDB
#undef PG8_MMA
#undef PG8_WAIT_V
#undef PG8_WAIT_L
#undef PG8_BAR
#undef PG8_SCHED
#undef PG8_GOFF
}
}

constexpr size_t MiB = 1u << 20;
constexpr size_t WS_CTL = 0, CTL_ZERO_BYTES = 1 * MiB;
constexpr size_t WS_HMETA = 1 * MiB;
constexpr size_t WS_UMETA = WS_HMETA + 128 * 1024;
constexpr size_t WS_KMETA = WS_HMETA + 256 * 1024;
constexpr size_t WS_VMETA = WS_HMETA + 384 * 1024;
constexpr size_t WS_SSMAB = WS_HMETA + 512 * 1024;
constexpr size_t WS_SSMBB = WS_HMETA + 576 * 1024;
constexpr size_t WS_WRT = 2 * MiB;
constexpr size_t WS_WIN = 3 * MiB;
constexpr size_t WS_WGLU = 33 * MiB;
constexpr size_t WS_WBS = 34 * MiB;
constexpr size_t WS_WBA = 36 * MiB;
constexpr size_t WS_WO = 40 * MiB;
constexpr size_t WS_WUP = 48 * MiB;
constexpr size_t WS_WDN = 176 * MiB;
constexpr size_t WS_HBF = 240 * MiB;
constexpr size_t WS_U = 368 * MiB;
constexpr size_t WS_Q = 400 * MiB;
constexpr size_t WS_K = 464 * MiB;
constexpr size_t WS_V = 528 * MiB;
constexpr size_t WS_SGS = 592 * MiB;
constexpr size_t WS_SGA = 720 * MiB;
constexpr size_t WS_YPRE = 848 * MiB;
constexpr size_t WS_YSSM = 880 * MiB;
constexpr size_t WS_YATT = 912 * MiB;
constexpr size_t WS_END = 976 * MiB;
constexpr size_t WS_Z = 368 * MiB;
constexpr size_t WS_H1 = 624 * MiB;
constexpr size_t WS_HB = 752 * MiB;
constexpr size_t WS_YK = 368 * MiB;
constexpr size_t WS_LIST = 848 * MiB;
constexpr size_t WS_WGT = 852 * MiB;
constexpr size_t WS_POSE = 853 * MiB;
constexpr size_t WS_POSW = 854 * MiB;
constexpr int CW_ECNT = 64;
constexpr int CW_CONV = 192;
constexpr int CW_BAR = 4096;

constexpr int RING_BYTES = 131072;
constexpr int MISC_OFF = RING_BYTES;
constexpr int LDS_BYTES = 139264;

#define XB_TMO      128
#define XB_XCNT(j)  (256  + 64 * (j))
#define XB_XSUB(j)  (1280 + 64 * (j))
#define XB_XGEN(j)  (2304 + 64 * (j))
#define XB_TOP      3328
#define XB_TOPGEN   3392
#define XCD_BAR_WORDS 3456
#define XB_SPIN_CAP (1u << 18)
__device__ __forceinline__ unsigned xb_ld(unsigned* p)              { return __hip_atomic_load(p, __ATOMIC_RELAXED, __HIP_MEMORY_SCOPE_AGENT); }
__device__ __forceinline__ unsigned xb_add(unsigned* p, unsigned v) { return __hip_atomic_fetch_add(p, v, __ATOMIC_RELAXED, __HIP_MEMORY_SCOPE_AGENT); }
__device__ __forceinline__ unsigned xb_xcc_id() { return (unsigned)__builtin_amdgcn_s_getreg((3 << 11) | 20) & 0xFu; }
#define XB_SPIN(cond, bar) do { unsigned _sp = 0; while (cond) { __builtin_amdgcn_s_sleep(1); \
    if ((++_sp & 255u) == 0u) { if (xb_ld(&(bar)[XB_TMO])) break; if (_sp > XB_SPIN_CAP) { atomicAdd(&(bar)[XB_TMO], 1u); break; } } } } while (0)
struct XcdBarrier { unsigned* bar; unsigned x; volatile LAS unsigned* st; };
__device__ __forceinline__ XcdBarrier xcd_barrier_post(unsigned* bar, volatile LAS unsigned* st) {
    XcdBarrier b; b.bar = bar; b.x = xb_xcc_id(); b.st = st;
    if (threadIdx.x == 0) (void)xb_add(&bar[XB_XCNT(b.x)], 1u);
    return b;
}
__device__ __forceinline__ void xcd_barrier_complete(unsigned* bar, unsigned x, unsigned& nloc, unsigned& nx) {
    const unsigned G = gridDim.x * gridDim.y * gridDim.z;
    unsigned sum, cnt, mine, sp = 0u;
    for (;;) {
        sum = 0u; cnt = 0u; mine = 0u;
#pragma unroll
        for (unsigned j = 0; j < 16; ++j) { const unsigned c = xb_ld(&bar[XB_XCNT(j)]); sum += c; cnt += (c > 0u) ? 1u : 0u; mine = (j == x) ? c : mine; }
        if (sum == G) break;
        __builtin_amdgcn_s_sleep(1);
        if ((++sp & 255u) == 0u) { if (xb_ld(&bar[XB_TMO])) break; if (sp > XB_SPIN_CAP) { atomicAdd(&bar[XB_TMO], 1u); break; } }
    }
    nloc = mine > 0u ? mine : 1u; nx = cnt > 0u ? cnt : 1u;
}
__device__ __forceinline__ void xcd_barrier(const XcdBarrier& b) {
    asm volatile("s_waitcnt vmcnt(0)" ::: "memory");
    __syncthreads();
    if (threadIdx.x == 0) {
        unsigned* bar = b.bar;
        __builtin_amdgcn_s_waitcnt(0);
        unsigned nloc = b.st[0], nx = b.st[1];
        if (nloc == 0u) { xcd_barrier_complete(bar, b.x, nloc, nx); b.st[0] = nloc; b.st[1] = nx; }
        const unsigned old = xb_add(&bar[XB_XSUB(b.x)], 1u);
        const unsigned gen = old / nloc;
        if (old + 1u == (gen + 1u) * nloc) {
            __builtin_amdgcn_fence(__ATOMIC_RELEASE, "agent");
            asm volatile("s_waitcnt vmcnt(0)" ::: "memory");
            const unsigned og = xb_add(&bar[XB_TOP], 1u);
            const unsigned tg = og / nx;
            if (og + 1u == (tg + 1u) * nx) xb_add(&bar[XB_TOPGEN], 1u);
            else XB_SPIN(xb_ld(&bar[XB_TOPGEN]) == tg, bar);
            __builtin_amdgcn_fence(__ATOMIC_ACQUIRE, "agent");
            xb_add(&bar[XB_XGEN(b.x)], 1u);
            asm volatile("s_waitcnt vmcnt(0)" ::: "memory");
        } else {
            XB_SPIN(xb_ld(&bar[XB_XGEN(b.x)]) == gen, bar);
            __builtin_amdgcn_fence(__ATOMIC_ACQUIRE, "agent");
            asm volatile("s_waitcnt vmcnt(0)" ::: "memory");
        }
    }
    __syncthreads();
}

using pg8::Unit;
__device__ __forceinline__ u32x4 pack8(const f32x4 v0, const f32x4 v1) { u32x4 w; w.x = cvt_pk_bf16(v0[0], v0[1]); w.y = cvt_pk_bf16(v0[2], v0[3]); w.z = cvt_pk_bf16(v1[0], v1[1]); w.w = cvt_pk_bf16(v1[2], v1[3]); return w; }
__device__ __forceinline__ void unpack8(const u32x4 w, f32x4& v0, f32x4& v1) { v0 = (f32x4){bf_lo(w.x), bf_hi(w.x), bf_lo(w.y), bf_hi(w.y)}; v1 = (f32x4){bf_lo(w.z), bf_hi(w.z), bf_lo(w.w), bf_hi(w.w)}; }

struct EpiProj {
    static constexpr bool PERM = true;
    bf16_t *U, *Q, *K, *V, *RHO, *SGA;
    __device__ __forceinline__ void operator()(const f32x4 (&acc)[2][2][4][2], const Unit& u, int wr, int wc, int fr, int fq) const {
        const int pn = u.pn;
        if (pn >= 14) {
            const int row0 = u.pm * 256 + wr * 64 + fr, col0 = (pn - 14) * 128 + wc * 32 + 8 * fq;
#pragma unroll
            for (int ai = 0; ai < 2; ++ai)
#pragma unroll
                for (int m = 0; m < 4; ++m) { const size_t off = (size_t)(row0 + ai * 128 + m * 16) * DM + col0; f32x4 r0, r1, a0, a1;
#pragma unroll
                    for (int j = 0; j < 4; ++j) { const float es0 = __expf(-acc[ai][0][m][0][j]), es1 = __expf(-acc[ai][0][m][1][j]), ea0 = __expf(-acc[ai][1][m][0][j]), ea1 = __expf(-acc[ai][1][m][1][j]);
                        a0[j] = __builtin_amdgcn_rcpf(1.f + ea0); a1[j] = __builtin_amdgcn_rcpf(1.f + ea1);
                        r0[j] = (1.f + ea0) * __builtin_amdgcn_rcpf(1.f + es0); r1[j] = (1.f + ea1) * __builtin_amdgcn_rcpf(1.f + es1); }
                    *(u32x4*)(RHO + off) = pack8(r0, r1); *(u32x4*)(SGA + off) = pack8(a0, a1); }
            return;
        }
        bf16_t* base; int ldc, ct, mode;
        if (pn < 2) { base = U; ldc = 512; ct = pn; mode = 0; }
        else if (pn < 6) { base = Q; ldc = 1024; ct = pn - 2; mode = 1; }
        else if (pn < 10) { base = K; ldc = 1024; ct = pn - 6; mode = 0; }
        else { base = V; ldc = 1024; ct = pn - 10; mode = 0; }
        const int row0 = u.pm * 256 + wr * 64 + fr, col0 = ct * 256 + wc * 32 + 8 * fq;
#pragma unroll
        for (int ai = 0; ai < 2; ++ai)
#pragma unroll
            for (int m = 0; m < 4; ++m) { bf16_t* rowp = base + (size_t)(row0 + ai * 128 + m * 16) * ldc + col0;
#pragma unroll
                for (int bj = 0; bj < 2; ++bj) { f32x4 v0 = acc[ai][bj][m][0], v1 = acc[ai][bj][m][1];
                    if (mode == 1) { v0 = v0 * QSCALE; v1 = v1 * QSCALE; }
                    *(u32x4*)(rowp + bj * 128) = pack8(v0, v1); } }
    }
};
struct EpiGlu {
    static constexpr bool PERM = true;
    const bf16_t* YPRE; bf16_t* YSSM;
    __device__ __forceinline__ void operator()(const f32x4 (&acc)[2][2][4][2], const Unit& u, int wr, int wc, int fr, int fq) const {
        const int row0 = u.pm * 256 + wr * 64 + fr, col0 = u.pn * 256 + wc * 32 + 8 * fq;
#pragma unroll
        for (int ai = 0; ai < 2; ++ai)
#pragma unroll
            for (int m = 0; m < 4; ++m) { const size_t off = (size_t)(row0 + ai * 128 + m * 16) * SSMW + col0;
#pragma unroll
                for (int bj = 0; bj < 2; ++bj) { const u32x4 yw = *(const u32x4*)(YPRE + off + bj * 128); f32x4 y0, y1; unpack8(yw, y0, y1);
                    f32x4 v0 = acc[ai][bj][m][0], v1 = acc[ai][bj][m][1];
#pragma unroll
                    for (int j = 0; j < 4; ++j) { v0[j] = y0[j] * sigmoidf_(v0[j]); v1[j] = y1[j] * sigmoidf_(v1[j]); }
                    *(u32x4*)(YSSM + off + bj * 128) = pack8(v0, v1); } }
    }
};
template <int SECOND> struct EpiMerge {
    static constexpr bool PERM = true;
    const bf16_t* SG; bf16_t* MG;
    __device__ __forceinline__ void operator()(const f32x4 (&acc)[2][2][4][2], const Unit& u, int wr, int wc, int fr, int fq) const {
        const int row0 = u.pm * 256 + wr * 64 + fr, col0 = u.pn * 256 + wc * 32 + 8 * fq;
#pragma unroll
        for (int ai = 0; ai < 2; ++ai)
#pragma unroll
            for (int m = 0; m < 4; ++m) { const size_t off = (size_t)(row0 + ai * 128 + m * 16) * DM + col0;
#pragma unroll
                for (int bj = 0; bj < 2; ++bj) { const u32x4 gw = *(const u32x4*)(SG + off + bj * 128); f32x4 g0, g1; unpack8(gw, g0, g1);
                    f32x4 v0 = acc[ai][bj][m][0] * g0, v1 = acc[ai][bj][m][1] * g1;
                    if (SECOND) { const u32x4 pw = *(const u32x4*)(MG + off + bj * 128); f32x4 p0, p1; unpack8(pw, p0, p1); v0 = v0 + p0; v1 = v1 + p1; }
                    *(u32x4*)(MG + off + bj * 128) = pack8(v0, v1); } }
    }
};
struct EpiMergeF {
    static constexpr bool PERM = true;
    const bf16_t* SGS; const bf16_t* SGA; bf16_t* MG;
    __device__ __forceinline__ void mid(f32x4 (&acc)[2][2][4][2], const Unit& u, int wr, int wc, int fr, int fq) const {
        asm volatile("" : "+v"(fr), "+v"(fq));
        const int row0 = u.pm * 256 + wr * 64 + fr, col0 = u.pn * 256 + wc * 32 + 8 * fq;
        const bf16_t* sp = SGS + (size_t)row0 * DM + col0;
        u32x4 sw[2][2];
        sw[0][0] = *(const u32x4*)(sp); sw[0][1] = *(const u32x4*)(sp + 128);
#pragma unroll
        for (int g = 0; g < 8; ++g) { const int ai = g >> 2, m = g & 3;
            if (g < 7) { const int g1 = g + 1; const bf16_t* sq = sp + (size_t)((g1 >> 2) * 128 + (g1 & 3) * 16) * DM;
                sw[g1 & 1][0] = *(const u32x4*)(sq); sw[g1 & 1][1] = *(const u32x4*)(sq + 128); }
            asm volatile("" ::: "memory");
#pragma unroll
            for (int bj = 0; bj < 2; ++bj) { f32x4 s0, s1; unpack8(sw[g & 1][bj], s0, s1);
                acc[ai][bj][m][0] = acc[ai][bj][m][0] * s0; acc[ai][bj][m][1] = acc[ai][bj][m][1] * s1; }
        }
    }
    __device__ __forceinline__ void operator()(const f32x4 (&acc)[2][2][4][2], const Unit& u, int wr, int wc, int fr, int fq) const {
        const int row0 = u.pm * 256 + wr * 64 + fr, col0 = u.pn * 256 + wc * 32 + 8 * fq;
#pragma unroll
        for (int ai = 0; ai < 2; ++ai)
#pragma unroll
            for (int m = 0; m < 4; ++m) { const size_t off = (size_t)(row0 + ai * 128 + m * 16) * DM + col0;
#pragma unroll
                for (int bj = 0; bj < 2; ++bj) { const u32x4 gw = *(const u32x4*)(SGA + off + bj * 128); f32x4 g0, g1; unpack8(gw, g0, g1);
                    *(u32x4*)(MG + off + bj * 128) = pack8(acc[ai][bj][m][0] * g0, acc[ai][bj][m][1] * g1); } }
    }
};
struct EpiZ {
    static constexpr bool PERM = true;
    const bf16_t* HBF; bf16_t* Z;
    __device__ __forceinline__ void operator()(const f32x4 (&acc)[2][2][4][2], const Unit& u, int wr, int wc, int fr, int fq) const {
        const int row0 = u.pm * 256 + wr * 64 + fr, col0 = u.pn * 256 + wc * 32 + 8 * fq;
#pragma unroll
        for (int ai = 0; ai < 2; ++ai)
#pragma unroll
            for (int m = 0; m < 4; ++m) { const size_t off = (size_t)(row0 + ai * 128 + m * 16) * DM + col0;
#pragma unroll
                for (int bj = 0; bj < 2; ++bj) { const u32x4 hw = *(const u32x4*)(HBF + off + bj * 128); f32x4 h0, h1; unpack8(hw, h0, h1);
                    *(u32x4*)(Z + off + bj * 128) = pack8(acc[ai][bj][m][0] + h0 * ALPHA, acc[ai][bj][m][1] + h1 * ALPHA); } }
    }
};
struct EpiSwiglu {
    static constexpr bool PERM = true;
    bf16_t* HB; const int* LIST; const float* WGT; int* POSE; float* POSW;
    __device__ __forceinline__ void operator()(const f32x4 (&acc)[2][2][4][2], const Unit& u, int wr, int wc, int fr, int fq) const {
        const int row0 = u.pm * 256 + wr * 64 + fr, col0 = (u.pn & 3) * 128 + wc * 32 + 8 * fq;
#pragma unroll
        for (int ai = 0; ai < 2; ++ai)
#pragma unroll
            for (int m = 0; m < 4; ++m) { f32x4 v0, v1;
#pragma unroll
                for (int j = 0; j < 4; ++j) { const float g0 = acc[ai][0][m][0][j], g1 = acc[ai][0][m][1][j];
                    v0[j] = g0 * sigmoidf_(g0) * acc[ai][1][m][0][j]; v1[j] = g1 * sigmoidf_(g1) * acc[ai][1][m][1][j]; }
                *(u32x4*)(HB + (size_t)(row0 + ai * 128 + m * 16) * DFF + col0) = pack8(v0, v1); }
        if ((u.pn & 3) == 0 && wc == 0 && fq == 0) {
#pragma unroll
            for (int ai = 0; ai < 2; ++ai)
#pragma unroll
                for (int m = 0; m < 4; ++m) { const int r = wr * 64 + fr + ai * 128 + m * 16, slot = u.s0 + r; int entry = -1; float w = 0.f;
                    if (slot < u.cnt) { entry = LIST[(size_t)u.e * CAP + slot]; w = WGT[entry]; }
                    POSE[u.pm * 256 + r] = entry; POSW[u.pm * 256 + r] = w; }
        }
    }
};
struct EpiDown {
    static constexpr bool PERM = true;
    const int* POSE; const float* POSW; bf16_t* YK;
    __device__ __forceinline__ void operator()(const f32x4 (&acc)[2][2][4][2], const Unit& u, int wr, int wc, int fr, int fq) const {
        const int r0 = u.pm * 256 + wr * 64 + fr, col0 = (u.pn & 7) * 256 + wc * 32 + 8 * fq;
        int en[2][4]; float ww[2][4];
#pragma unroll
        for (int ai = 0; ai < 2; ++ai)
#pragma unroll
            for (int m = 0; m < 4; ++m) { en[ai][m] = POSE[r0 + ai * 128 + m * 16]; ww[ai][m] = POSW[r0 + ai * 128 + m * 16]; }
#pragma unroll
        for (int ai = 0; ai < 2; ++ai)
#pragma unroll
            for (int m = 0; m < 4; ++m) {
                if (en[ai][m] >= 0) { const float w = ww[ai][m]; bf16_t* rowp = YK + (size_t)en[ai][m] * DM + col0;
#pragma unroll
                    for (int bj = 0; bj < 2; ++bj) *(u32x4*)(rowp + bj * 128) = pack8(acc[ai][bj][m][0] * w, acc[ai][bj][m][1] * w); } }
    }
};
struct MoeOrder {
    int G, c, shift, NB; const LAS int* blkexp; const LAS int* blkstart; const LAS int* cntE; const int* LIST;
    __device__ __forceinline__ bool next(int i, Unit& u) const {
        const long L = (long)i * G + c; if (L >= ((long)NB << shift)) return false;
        const int blk = (int)(L >> shift), tile = (int)(L & ((1 << shift) - 1)), e = blkexp[blk];
        u.pm = blk; u.pn = (e << shift) + tile; u.e = e; u.s0 = (blk - blkstart[e]) * 256; u.cnt = cntE[e]; return true;
    }
    __device__ __forceinline__ int arow(const Unit& u, int r) const { const int slot = u.s0 + r; const int entry = slot < u.cnt ? LIST[(size_t)u.e * CAP + slot] : 0; return entry >> 1; }
};

struct Ctx { LAS unsigned char* lds; int tid, lane, wave, vcu, G; };

__device__ __forceinline__ void transpose_item(const float* W, int K, int N, bf16_t* WT, int kb, int nb, int dst_row0, LAS float* scr, int lane) {
    const int k0 = 64 * kb, n0 = 32 * nb;
    float tv[32];
#pragma unroll
    for (int i = 0; i < 32; ++i) tv[i] = W[(size_t)(k0 + 2 * i + (lane >> 5)) * N + n0 + (lane & 31)];
#pragma unroll
    for (int i = 0; i < 32; ++i) scr[(2 * i + (lane >> 5)) * 33 + (lane & 31)] = tv[i];
    asm volatile("s_waitcnt lgkmcnt(0)" ::: "memory");
    const int c = lane & 7;
#pragma unroll
    for (int j = 0; j < 4; ++j) { const int n = (lane >> 3) + 8 * j; const LAS float* s = scr + (8 * c) * 33 + n;
        u32x4 o; o.x = cvt_pk_bf16(s[0 * 33], s[1 * 33]); o.y = cvt_pk_bf16(s[2 * 33], s[3 * 33]); o.z = cvt_pk_bf16(s[4 * 33], s[5 * 33]); o.w = cvt_pk_bf16(s[6 * 33], s[7 * 33]);
        *(u32x4*)(WT + (size_t)(dst_row0 + n) * K + k0 + 8 * c) = o; }
    asm volatile("s_waitcnt lgkmcnt(0)" ::: "memory");
}
__device__ __forceinline__ void ln_stats(f32x4 (&v)[8], float& mean, float& rstd) {
    float s = 0.f;
#pragma unroll
    for (int j = 0; j < 8; ++j) s += (v[j].x + v[j].y) + (v[j].z + v[j].w);
    mean = wave_sum(s) * (1.f / DM); float s2 = 0.f;
#pragma unroll
    for (int j = 0; j < 8; ++j) { const f32x4 d = v[j] - mean; s2 += (d.x * d.x + d.y * d.y) + (d.z * d.z + d.w * d.w); }
    rstd = 1.f / sqrtf(wave_sum(s2) * (1.f / DM) + LN_EPS);
}

__device__ __forceinline__ void p0_prologue(const Ctx& C, const float* const* in, unsigned char* ws) {
    LAS float* scr = (LAS float*)(C.lds + C.wave * 16384);
    const int gw = C.vcu * 8 + C.wave, NGW = C.G * 8;
    bf16_t* WinT = (bf16_t*)(ws + WS_WIN); bf16_t* WgluT = (bf16_t*)(ws + WS_WGLU); bf16_t* WbsT = (bf16_t*)(ws + WS_WBS); bf16_t* WbaT = (bf16_t*)(ws + WS_WBA);
    bf16_t* WoT = (bf16_t*)(ws + WS_WO); bf16_t* WupT = (bf16_t*)(ws + WS_WUP);
    constexpr int I_WIN = (DM / 64) * (INC / 32), I_GLU = (SSMW / 64) * (SSMW / 32), I_BS = (SSMW / 64) * (DM / 32), I_BA = (AW / 64) * (DM / 32), I_WO = (DM / 64) * (DM / 32);
    constexpr int I_EXP = NE * 512;
    constexpr int NITEMS = I_WIN + I_GLU + I_BS + I_BA + I_WO + 2 * I_EXP;
    for (int it = gw; it < NITEMS; it += NGW) {
        int r = it;
        if (r < I_WIN) { const int nblk = INC / 32, nb = r % nblk, n0 = 32 * nb;
            const int drow = n0 < 3584 ? n0 : (n0 < 5632 ? 3584 + ((n0 - 3584) >> 7) * 256 + ((n0 - 3584) & 127) : 3584 + ((n0 - 5632) >> 7) * 256 + 128 + ((n0 - 5632) & 127));
            transpose_item(in[4], DM, INC, WinT, r / nblk, nb, drow, scr, C.lane); continue; } r -= I_WIN;
        if (r < I_GLU) { const int nblk = SSMW / 32; transpose_item(in[13], SSMW, SSMW, WgluT, r / nblk, r % nblk, 32 * (r % nblk), scr, C.lane); continue; } r -= I_GLU;
        if (r < I_BS) { const int nblk = DM / 32; transpose_item(in[19], SSMW, DM, WbsT, r / nblk, r % nblk, 32 * (r % nblk), scr, C.lane); continue; } r -= I_BS;
        if (r < I_BA) { const int nblk = DM / 32; transpose_item(in[20], AW, DM, WbaT, r / nblk, r % nblk, 32 * (r % nblk), scr, C.lane); continue; } r -= I_BA;
        if (r < I_WO) { const int nblk = DM / 32; transpose_item(in[21], DM, DM, WoT, r / nblk, r % nblk, 32 * (r % nblk), scr, C.lane); continue; } r -= I_WO;
        if (r < 2 * I_EXP) { const int up = r >= I_EXP ? 1 : 0; r -= up * I_EXP; const int e = r >> 9, rr = r & 511, kb = rr >> 4, nb = rr & 15, n0 = 32 * nb;
            transpose_item(in[28 + up] + (size_t)e * DM * DFF, DM, DFF, WupT, kb, nb, e * 1024 + (n0 >> 7) * 256 + up * 128 + (n0 & 127), scr, C.lane); continue; }
    }
    const int gt = C.vcu * 512 + C.tid, NGT = C.G * 512;
    { float* WrT = (float*)(ws + WS_WRT);
      for (int i = gt; i < 36 * DM; i += NGT) { const int n = i / DM, k = i % DM; WrT[i] = n < 4 ? in[24][k * 4 + n] : in[26][k * 32 + (n - 4)]; } }
    { u32x4* kz = (u32x4*)(ws + WS_KMETA + 16 * 1024 * 2); u32x4* vz = (u32x4*)(ws + WS_VMETA + 16 * 1024 * 2);
      for (int i = gt; i < 48 * 1024 * 2 / 16; i += NGT) { kz[i] = (u32x4){0u, 0u, 0u, 0u}; vz[i] = (u32x4){0u, 0u, 0u, 0u}; } }
    { float* AB = (float*)(ws + WS_SSMAB); float* BB = (float*)(ws + WS_SSMBB);
      for (int i = gt; i < NGRP * NST; i += NGT) { const int g = i >> 6;
        const double lre = fmin((double)in[5][i], -1e-4), lim = (double)in[6][i], dt = exp((double)in[7][g]);
        const double mag = exp(lre * dt), abr = mag * cos(lim * dt), abi = mag * sin(lim * dt), den = lre * lre + lim * lim, nr = abr - 1.0, ni = abi;
        const double zr = (nr * lre + ni * lim) / den, zi = (ni * lre - nr * lim) / den;
        AB[i] = (float)abr; AB[NGRP * NST + i] = (float)abi;
#pragma unroll 4
        for (int c = 0; c < 16; ++c) { const double br = (double)in[8][i * 16 + c], bi = (double)in[9][i * 16 + c];
            BB[i * 16 + c] = (float)(zr * br - zi * bi); BB[NGRP * NST * 16 + i * 16 + c] = (float)(zr * bi + zi * br); } } }
    const float* lg = in[2]; const float* lb = in[3];
    bf16_t* HBF = (bf16_t*)(ws + WS_HBF);
    for (int m = gw; m < T + NMETA; m += 2 * NGW) {
        const int m2 = (m + NGW < T + NMETA) ? m + NGW : m;
        const float* xa = m >= T ? in[1] + (size_t)(m - T) * DM : in[0] + (size_t)m * DM; const float* xb = m2 >= T ? in[1] + (size_t)(m2 - T) * DM : in[0] + (size_t)m2 * DM;
        f32x4 va[8], vb[8];
#pragma unroll
        for (int j = 0; j < 8; ++j) { va[j] = *(const f32x4*)(xa + 256 * j + 4 * C.lane); vb[j] = *(const f32x4*)(xb + 256 * j + 4 * C.lane); }
        float meana, rstda, meanb, rstdb; ln_stats(va, meana, rstda); ln_stats(vb, meanb, rstdb);
#pragma unroll
        for (int rr = 0; rr < 2; ++rr) { const int mm = rr ? m2 : m; if (rr == 1 && m2 == m) break; const bool meta = mm >= T;
#pragma unroll
            for (int j = 0; j < 8; ++j) { const f32x4 gg = *(const f32x4*)(lg + 256 * j + 4 * C.lane), bb = *(const f32x4*)(lb + 256 * j + 4 * C.lane);
                const f32x4 o = rr ? (vb[j] - meanb) * rstdb * gg + bb : (va[j] - meana) * rstda * gg + bb;
                if (meta) *(f32x4*)((float*)(ws + WS_HMETA) + (size_t)(mm - T) * DM + 256 * j + 4 * C.lane) = o;
                else { u32x2 w; w.x = cvt_pk_bf16(o.x, o.y); w.y = cvt_pk_bf16(o.z, o.w); *(u32x2*)(HBF + (size_t)mm * DM + 256 * j + 4 * C.lane) = w; } } }
    }
}

__device__ __forceinline__ void p1_meta_proj(const Ctx& C, unsigned char* ws) {
    const bf16_t* WinT = (const bf16_t*)(ws + WS_WIN); const float* HM = (const float*)(ws + WS_HMETA);
    const int gw = C.vcu * 8 + C.wave, NGW = C.G * 8;
    for (int it = gw; it < 640; it += NGW) {
        const int nidx = 4 * it; const int col0 = nidx < 512 ? nidx : (nidx < 1536 ? 1536 + (nidx - 512) : 2560 + (nidx - 1536));
        float acc[16][4];
#pragma unroll
        for (int r = 0; r < 16; ++r)
#pragma unroll
            for (int c = 0; c < 4; ++c) acc[r][c] = 0.f;
#pragma unroll 1
        for (int j = 0; j < 4; ++j) { const int k0 = j * 512 + C.lane * 8;
            f32x4 w0[4], w1[4];
#pragma unroll
            for (int c = 0; c < 4; ++c) { const u32x4 ww = *(const u32x4*)(WinT + (size_t)(col0 + c) * DM + k0); unpack8(ww, w0[c], w1[c]); }
#pragma unroll
            for (int r = 0; r < 16; ++r) { const f32x4 h0 = *(const f32x4*)(HM + r * DM + k0), h1 = *(const f32x4*)(HM + r * DM + k0 + 4);
#pragma unroll
                for (int c = 0; c < 4; ++c) { const f32x4 p = h0 * w0[c] + h1 * w1[c]; acc[r][c] += (p.x + p.y) + (p.z + p.w); } } }
        float mine = 0.f;
#pragma unroll
        for (int r = 0; r < 16; ++r)
#pragma unroll
            for (int c = 0; c < 4; ++c) { const float s = wave_sum(acc[r][c]); mine = (C.lane == r * 4 + c) ? s : mine; }
        const int r = C.lane >> 2, c = C.lane & 3;
        if (nidx < 512) ((float*)(ws + WS_UMETA))[r * SSMW + nidx + c] = mine;
        else if (nidx < 1536) ((bf16_t*)(ws + WS_KMETA))[r * AW + (nidx - 512) + c] = (bf16_t)(cvt_pk_bf16(mine, 0.f) & 0xffffu);
        else ((bf16_t*)(ws + WS_VMETA))[r * AW + (nidx - 1536) + c] = (bf16_t)(cvt_pk_bf16(mine, 0.f) & 0xffffu);
    }
}

__device__ __forceinline__ float gelu_tanh(float x) { const float u = 1.5957691216057308f * (x + 0.044715f * x * x * x); return x * __builtin_amdgcn_rcpf(1.0f + __expf(-u)); }
template <bool STORE> __device__ __forceinline__ void scan16(f32x16 (&bu)[4], float (&sre)[2], float (&sim)[2], const float (&are)[2], const float (&aim)[2]) {
#pragma unroll
    for (int reg = 0; reg < 16; ++reg)
#pragma unroll
        for (int st = 0; st < 2; ++st) {
            const float nre = __builtin_fmaf(are[st], sre[st], __builtin_fmaf(-aim[st], sim[st], bu[st][reg]));
            const float nim = __builtin_fmaf(are[st], sim[st], __builtin_fmaf(aim[st], sre[st], bu[2 + st][reg]));
            sre[st] = nre; sim[st] = nim;
            if (STORE) { bu[st][reg] = nre; bu[2 + st][reg] = nim; } }
}
__device__ __forceinline__ void p2_scan(const Ctx& C, const float* const* in, unsigned char* ws) {
    const int lane = C.lane, wave = C.wave, r32 = lane & 31, hi = lane >> 5, fr = lane & 15, fq = lane >> 4;
    const bf16_t* U = (const bf16_t*)(ws + WS_U); const float* UM = (const float*)(ws + WS_UMETA); bf16_t* YPRE = (bf16_t*)(ws + WS_YPRE);
    const float* AB = (const float*)(ws + WS_SSMAB); const float* BB = (const float*)(ws + WS_SSMBB);
    LAS unsigned char* Sl = C.lds + wave * 10752;
    LAS unsigned char* Yl = Sl + 9728;
    LAS float* E = (LAS float*)(C.lds + 86016);
    const int hc = 2 * wave + hi;
    const int urow = ((r32 >> 2) & 1) * 128 + (r32 & 3) + 4 * (r32 >> 3);
    for (int item = C.vcu; item < NB_ * NGRP; item += C.G) {
        const int b = item >> 5, g = item & 31;
        const bf16_t* Ub = U + ((size_t)b * SEQ + wave * 256) * SSMW + 16 * g;
        bf16x8 ufa[8];
#pragma unroll
        for (int blk = 0; blk < 8; ++blk) ufa[blk] = *(const bf16x8*)(Ub + (size_t)(16 * blk + urow) * SSMW + 8 * hi);
        float are[2], aim[2];
#pragma unroll
        for (int st = 0; st < 2; ++st) { are[st] = AB[g * 64 + 32 * st + r32]; aim[st] = AB[NGRP * NST + g * 64 + 32 * st + r32]; }
        bf16x8 Bf[4];
#pragma unroll
        for (int ri = 0; ri < 2; ++ri)
#pragma unroll
            for (int st = 0; st < 2; ++st) { const float* src = BB + ri * (NGRP * NST * 16) + (g * 64 + 32 * st + r32) * 16 + 8 * hi;
                const f32x4 x0 = *(const f32x4*)src, x1 = *(const f32x4*)(src + 4); Bf[2 * ri + st] = __builtin_bit_cast(bf16x8, pack8(x0, x1)); }
        bf16x8 Cf[5];
#pragma unroll
        for (int ks = 0; ks < 4; ++ks) { const int r0 = 8 * ks + 2 * fq; const float* cre = in[10] + (g * 16 + fr) * 64; const float* cim = in[11] + (g * 16 + fr) * 64;
            const f32x4 x0 = (f32x4){cre[r0], cre[32 + r0], -cim[r0], -cim[32 + r0]}, x1 = (f32x4){cre[r0 + 1], cre[33 + r0], -cim[r0 + 1], -cim[33 + r0]};
            Cf[ks] = __builtin_bit_cast(bf16x8, pack8(x0, x1)); }
        { const float dsk = in[12][g * 16 + fr]; f32x4 x0, x1;
#pragma unroll
          for (int j = 0; j < 4; ++j) { x0[j] = (fq < 2 && 8 * fq + j == fr) ? dsk : 0.f; x1[j] = (fq < 2 && 8 * fq + 4 + j == fr) ? dsk : 0.f; }
          Cf[4] = __builtin_bit_cast(bf16x8, pack8(x0, x1)); }
        float sre[2] = {0.f, 0.f}, sim[2] = {0.f, 0.f}, mre[2] = {0.f, 0.f}, mim[2] = {0.f, 0.f};
        if (wave == 0) {
            f32x4 x0 = (f32x4){0.f, 0.f, 0.f, 0.f}, x1 = x0;
            if (((r32 >> 2) & 1) == 0) { const float* src = UM + ((r32 & 3) + 4 * (r32 >> 3)) * SSMW + 16 * g + 8 * hi; x0 = *(const f32x4*)src; x1 = *(const f32x4*)(src + 4); }
            const bf16x8 uf = __builtin_bit_cast(bf16x8, pack8(x0, x1));
            f32x16 bu[4];
#pragma unroll
            for (int t = 0; t < 4; ++t) bu[t] = __builtin_amdgcn_mfma_f32_32x32x16_bf16(uf, Bf[t], (f32x16){}, 0, 0, 0);
            scan16<false>(bu, sre, sim, are, aim);
            mre[0] = sre[0]; mre[1] = sre[1]; mim[0] = sim[0]; mim[1] = sim[1];
        }
#pragma unroll
        for (int blk = 0; blk < 8; ++blk) {
            f32x16 bu[4];
#pragma unroll
            for (int t = 0; t < 4; ++t) bu[t] = __builtin_amdgcn_mfma_f32_32x32x16_bf16(ufa[blk], Bf[t], (f32x16){}, 0, 0, 0);
            scan16<false>(bu, sre, sim, are, aim);
        }
#pragma unroll
        for (int st = 0; st < 2; ++st) { E[hc * 128 + st * 64 + r32] = sre[st]; E[hc * 128 + st * 64 + 32 + r32] = sim[st]; }
        __syncthreads();
        {
            float pr[2], pi[2], cr[2], ci[2];
#pragma unroll
            for (int st = 0; st < 2; ++st) { pr[st] = are[st]; pi[st] = aim[st];
#pragma unroll
                for (int k = 0; k < 7; ++k) { const float nr = pr[st] * pr[st] - pi[st] * pi[st], ni = 2.f * pr[st] * pi[st]; pr[st] = nr; pi[st] = ni; }
                cr[st] = E[st * 64 + r32]; ci[st] = E[st * 64 + 32 + r32]; }
            for (int j = 1; j < 2 * wave + 1; ++j) {
                const bool on = j < hc;
#pragma unroll
                for (int st = 0; st < 2; ++st) { const float er = E[j * 128 + st * 64 + r32], ei = E[j * 128 + st * 64 + 32 + r32];
                    const float nr = pr[st] * cr[st] - pi[st] * ci[st] + er, ni = pr[st] * ci[st] + pi[st] * cr[st] + ei; cr[st] = on ? nr : cr[st]; ci[st] = on ? ni : ci[st]; } }
#pragma unroll
            for (int st = 0; st < 2; ++st) { sre[st] = hc == 0 ? mre[st] : cr[st]; sim[st] = hc == 0 ? mim[st] : ci[st]; }
        }
#pragma unroll
        for (int blk = 0; blk < 8; ++blk) {
            f32x16 bu[4];
#pragma unroll
            for (int t = 0; t < 4; ++t) bu[t] = __builtin_amdgcn_mfma_f32_32x32x16_bf16(ufa[blk], Bf[t], (f32x16){}, 0, 0, 0);
            scan16<true>(bu, sre, sim, are, aim);
#pragma unroll
            for (int reg = 0; reg < 16; ++reg) { const int row = (reg & 3) + 8 * (reg >> 2) + 4 * hi;
                u32x2 w; w.x = cvt_pk_bf16(bu[0][reg], bu[1][reg]); w.y = cvt_pk_bf16(bu[2][reg], bu[3][reg]);
                *(LAS u32x2*)(Sl + row * 304 + r32 * 8) = w; }
            *(LAS bf16x8*)(Sl + r32 * 304 + (128 + 8 * hi) * 2) = ufa[blk];
            f32x4 y[2];
#pragma unroll
            for (int mt = 0; mt < 2; ++mt) { y[mt] = (f32x4){0.f, 0.f, 0.f, 0.f};
#pragma unroll
                for (int ks = 0; ks < 4; ++ks) { const bf16x8 af = *(const LAS bf16x8*)(Sl + (16 * mt + fr) * 304 + (32 * ks + 8 * fq) * 2);
                    y[mt] = __builtin_amdgcn_mfma_f32_16x16x32_bf16(af, Cf[ks], y[mt], 0, 0, 0); }
                bf16x8 au = *(const LAS bf16x8*)(Sl + (16 * mt + fr) * 304 + (128 + 8 * (fq & 1)) * 2); if (fq >= 2) au = (bf16x8){};
                y[mt] = __builtin_amdgcn_mfma_f32_16x16x32_bf16(au, Cf[4], y[mt], 0, 0, 0); }
#pragma unroll
            for (int mt = 0; mt < 2; ++mt)
#pragma unroll
                for (int reg = 0; reg < 4; ++reg) *(LAS bf16_t*)(Yl + (16 * mt + 4 * fq + reg) * 32 + fr * 2) = (bf16_t)(cvt_pk_bf16(gelu_tanh(y[mt][reg]), 0.f) & 0xffffu);
            const u32x4 yo = *(const LAS u32x4*)(Yl + (lane >> 1) * 32 + (lane & 1) * 16);
            { const int row = lane >> 1, tok = ((row >> 2) & 1) * 128 + 16 * blk + (row & 3) + 4 * (row >> 3);
              *(u32x4*)(YPRE + ((size_t)b * SEQ + wave * 256 + tok) * SSMW + 16 * g + 8 * (lane & 1)) = yo; }
        }
        __syncthreads();
    }
}

__device__ __forceinline__ int crow(int r, int hi) { return (r & 3) + 8 * (r >> 2) + 4 * hi; }
typedef short v4i16_t __attribute__((ext_vector_type(4)));
__device__ __forceinline__ s16x4 vtr(const LAS unsigned char* p) { return __builtin_bit_cast(s16x4, __builtin_amdgcn_ds_read_tr16_b64_v4i16((LAS v4i16_t*)p)); }
__device__ __forceinline__ float half_swap_max(float x) { auto rr = __builtin_amdgcn_permlane32_swap(__float_as_uint(x), __float_as_uint(x), false, false); return fmaxf(__uint_as_float(rr[0]), __uint_as_float(rr[1])); }
__device__ __forceinline__ float half_swap_sum(float x) { auto rr = __builtin_amdgcn_permlane32_swap(__float_as_uint(x), __float_as_uint(x), false, false); return __uint_as_float(rr[0]) + __uint_as_float(rr[1]); }

__device__ __forceinline__ void attn_pv(f32x16 (&o)[4], const bf16x8 (&pa)[4], unsigned vaddr) {
    s16x4 vl[2][4], vh[2][4];
#define ATT_VRD(SET, D) do { _Pragma("unroll") for (int ks_ = 0; ks_ < 4; ++ks_) { \
        asm volatile("ds_read_b64_tr_b16 %0, %1 offset:%2" : "=&v"(vl[SET][ks_]) : "v"(vaddr), "i"((D) * 4096 + ks_ * 1024) : "memory"); \
        asm volatile("ds_read_b64_tr_b16 %0, %1 offset:%2" : "=&v"(vh[SET][ks_]) : "v"(vaddr), "i"((D) * 4096 + ks_ * 1024 + 512) : "memory"); } } while (0)
    __builtin_amdgcn_sched_barrier(0);
    ATT_VRD(0, 0);
#pragma unroll
    for (int d = 0; d < 4; ++d) {
        if (d == 0) { ATT_VRD(1, 1); } else if (d == 1) { ATT_VRD(0, 2); } else if (d == 2) { ATT_VRD(1, 3); }
        if (d < 3) asm volatile("s_waitcnt lgkmcnt(8)" ::: "memory"); else asm volatile("s_waitcnt lgkmcnt(0)" ::: "memory");
        __builtin_amdgcn_sched_barrier(0);
#pragma unroll
        for (int ks = 0; ks < 4; ++ks) { const s16x4 lo = vl[d & 1][ks], hv = vh[d & 1][ks];
            const bf16x8 vf = (bf16x8){lo[0], lo[1], lo[2], lo[3], hv[0], hv[1], hv[2], hv[3]};
            o[d] = __builtin_amdgcn_mfma_f32_32x32x16_bf16(pa[ks], vf, o[d], 0, 0, 0); }
        __builtin_amdgcn_sched_barrier(0);
    }
#undef ATT_VRD
}
__device__ __forceinline__ void attn_qk(f32x16& p0, f32x16& p1, const LAS unsigned char* kb, const bf16x8 (&qr)[4]) {
    p0 = (f32x16){}; p1 = (f32x16){};
#pragma unroll
    for (int d0 = 0; d0 < 4; ++d0) { const bf16x8 b0 = *(const LAS bf16x8*)(kb + d0 * 2048), b1 = *(const LAS bf16x8*)(kb + d0 * 2048 + 512);
        p0 = __builtin_amdgcn_mfma_f32_32x32x16_bf16(b0, qr[d0], p0, 0, 0, 0); p1 = __builtin_amdgcn_mfma_f32_32x32x16_bf16(b1, qr[d0], p1, 0, 0, 0); }
}
__device__ __forceinline__ void attn_softmax(const bool FIRST, f32x16& p0, f32x16& p1, f32x16 (&o)[4], float& mrun, float& lrun, bf16x8 (&pa)[4], LAS float* wsf, int r32, int hi) {
    if (FIRST) {
        asm volatile("" ::: "memory");
#pragma unroll
        for (int r = 0; r < 16; ++r) { if (r >= 8) p0[r] = -__builtin_inff(); p1[r] = -__builtin_inff(); } }
    float rmA = fmaxf(p0[0], p0[1]), rmB = fmaxf(p0[2], p0[3]), rmC = fmaxf(p1[0], p1[1]), rmD = fmaxf(p1[2], p1[3]);
#pragma unroll
    for (int r = 4; r < 16; r += 4) { rmA = fmaxf(rmA, fmaxf(p0[r], p0[r + 1])); rmB = fmaxf(rmB, fmaxf(p0[r + 2], p0[r + 3])); rmC = fmaxf(rmC, fmaxf(p1[r], p1[r + 1])); rmD = fmaxf(rmD, fmaxf(p1[r + 2], p1[r + 3])); }
    const float rm = half_swap_max(fmaxf(fmaxf(rmA, rmB), fmaxf(rmC, rmD)));
    if (FIRST) mrun = rm;
    else if (__any(rm > mrun + 8.0f)) {
        const float mnew = fmaxf(mrun, rm), alpha = __builtin_amdgcn_exp2f(mrun - mnew);
        lrun *= alpha; mrun = mnew;
        if (hi == 0) wsf[r32] = alpha;
        f32x4 a4[4];
#pragma unroll
        for (int gq = 0; gq < 4; ++gq) a4[gq] = *(const LAS f32x4*)(wsf + 8 * gq + 4 * hi);
#pragma unroll
        for (int d = 0; d < 4; ++d)
#pragma unroll
            for (int r = 0; r < 16; ++r) o[d][r] *= a4[r >> 2][r & 3];
    }
    float psA = 0.f, psB = 0.f, psC = 0.f, psD = 0.f;
#pragma unroll
    for (int r = 0; r < 16; r += 2) { p0[r] = __builtin_amdgcn_exp2f(p0[r] - mrun); p0[r + 1] = __builtin_amdgcn_exp2f(p0[r + 1] - mrun); p1[r] = __builtin_amdgcn_exp2f(p1[r] - mrun); p1[r + 1] = __builtin_amdgcn_exp2f(p1[r + 1] - mrun);
        psA += p0[r]; psB += p0[r + 1]; psC += p1[r]; psD += p1[r + 1]; }
    lrun += (psA + psB) + (psC + psD);
    u32x4 w;
    w = (u32x4){cvt_pk_bf16(p0[0], p0[1]), cvt_pk_bf16(p0[2], p0[3]), cvt_pk_bf16(p0[4], p0[5]), cvt_pk_bf16(p0[6], p0[7])}; pa[0] = __builtin_bit_cast(bf16x8, w);
    w = (u32x4){cvt_pk_bf16(p0[8], p0[9]), cvt_pk_bf16(p0[10], p0[11]), cvt_pk_bf16(p0[12], p0[13]), cvt_pk_bf16(p0[14], p0[15])}; pa[1] = __builtin_bit_cast(bf16x8, w);
    w = (u32x4){cvt_pk_bf16(p1[0], p1[1]), cvt_pk_bf16(p1[2], p1[3]), cvt_pk_bf16(p1[4], p1[5]), cvt_pk_bf16(p1[6], p1[7])}; pa[2] = __builtin_bit_cast(bf16x8, w);
    w = (u32x4){cvt_pk_bf16(p1[8], p1[9]), cvt_pk_bf16(p1[10], p1[11]), cvt_pk_bf16(p1[12], p1[13]), cvt_pk_bf16(p1[14], p1[15])}; pa[3] = __builtin_bit_cast(bf16x8, w);
}
__device__ __forceinline__ void glds16(const void* gsrc, unsigned lds_dst) { unsigned keep;
    asm volatile("s_mov_b32 %0, m0\n\ts_mov_b32 m0, %2\n\ts_nop 0\n\tglobal_load_lds_dwordx4 %1, off\n\ts_mov_b32 m0, %0" : "=&s"(keep) : "v"(gsrc), "s"(lds_dst) : "memory"); }
__device__ __forceinline__ void attn_unit(const Ctx& C, const bf16_t* Qg, const bf16_t* Kg, const bf16_t* Vg, const bf16_t* KM, const bf16_t* VM, bf16_t* Y,
                                          const float* subg, float lam, int b, int h, int qt, bool prefetched, int nqt, bf16x8 (&qr)[4], bool rb) {
    LAS unsigned char* lds = C.lds;
    const int lane = C.lane, wave = C.wave, r32 = lane & 31, hi = lane >> 5, qb = wave >> 1, map = wave & 1;
    const int q0 = qt * 128 + qb * 32;
    const size_t rowb = (size_t)b * SEQ;
    if (!prefetched) { const bf16_t* qp = Qg + (rowb + q0 + r32) * AW + h * 128 + map * 64 + hi * 8;
#pragma unroll
      for (int d0 = 0; d0 < 4; ++d0) qr[d0] = *(const bf16x8*)(qp + d0 * 16); }
    const int NT = 2 * qt + 3;
    const bool skip_last = (qb < 2);
    f32x16 o[4];
#pragma unroll
    for (int d = 0; d < 4; ++d) o[d] = (f32x16){};
    float mrun = -__builtin_inff(), lrun = 0.f;
    LAS float* wsf = (LAS float*)(lds + MISC_OFF + 4096 + wave * 256);
    const bf16_t* Kb = Kg + rowb * AW; const bf16_t* Vb = Vg + rowb * AW;
#define ATT_DMA(step, stage) do { const bf16_t* ks_ = (step) == 0 ? KM : Kb; const bf16_t* vs_ = (step) == 0 ? VM : Vb; const int row0_ = (step) == 0 ? 0 : ((step) - 1) * 64; \
    _Pragma("unroll") for (int i_ = 0; i_ < 2; ++i_) { const int p_ = 2 * wave + i_; \
        __builtin_amdgcn_global_load_lds((const unsigned*)(ks_ + (size_t)(row0_ + lane) * AW + h * 128 + (p_ >> 3) * 64 + (p_ & 7) * 8), (LAS unsigned*)(lds + (stage) * 32768 + p_ * 1024), 16, 0, 0); \
        __builtin_amdgcn_global_load_lds((const unsigned*)(vs_ + (size_t)(row0_ + 16 * (p_ & 3) + (lane >> 2)) * AW + h * 128 + (p_ >> 2) * 32 + (lane & 3) * 8), (LAS unsigned*)(lds + (stage) * 32768 + 16384 + p_ * 1024), 16, 0, 0); } } while (0)
    const int myNT = skip_last ? NT - 1 : NT;
    bf16x8 pa[4];
#pragma unroll
    for (int k = 0; k < 4; ++k) pa[k] = (bf16x8){};
    if (!prefetched) ATT_DMA(0, 0);
    asm volatile("s_waitcnt vmcnt(0)" ::: "memory"); __syncthreads();
    int stage = 0;
#pragma unroll 1
    for (int s = 0; s <= NT; ++s) {
        const int stn = stage == 2 ? 0 : stage + 1, stp = stage == 0 ? 2 : stage - 1;
        if (s + 1 < NT) ATT_DMA(s + 1, stn);
        if (rb && s >= 1 && s <= myNT) attn_pv(o, pa, (unsigned)(uintptr_t)(lds + stp * 32768 + 16384 + ((lane >> 4) & 1) * 32 + (lane & 3) * 8 + (4 * hi + ((lane & 15) >> 2)) * 64));
        if (s < myNT) {
            f32x16 p0, p1; attn_qk(p0, p1, lds + stage * 32768 + map * 8192 + hi * 1024 + r32 * 16, qr);
            attn_softmax(s == 0, p0, p1, o, mrun, lrun, pa, wsf, r32, hi);
            if (!rb) attn_pv(o, pa, (unsigned)(uintptr_t)(lds + stage * 32768 + 16384 + ((lane >> 4) & 1) * 32 + (lane & 3) * 8 + (4 * hi + ((lane & 15) >> 2)) * 64));
        }
        asm volatile("s_waitcnt vmcnt(0)" ::: "memory"); __syncthreads();
        stage = stn;
    }
#undef ATT_DMA
    bf16x8 qn[4];
#pragma unroll
    for (int d0 = 0; d0 < 4; ++d0) qn[d0] = qr[d0];
    if (nqt >= 0) {
        const unsigned lds0 = (unsigned)(uintptr_t)lds;
#pragma unroll
        for (int i = 0; i < 2; ++i) { const int p = 2 * wave + i;
            glds16(KM + (size_t)lane * AW + h * 128 + (p >> 3) * 64 + (p & 7) * 8, (unsigned)__builtin_amdgcn_readfirstlane(lds0 + p * 1024));
            glds16(VM + (size_t)(16 * (p & 3) + (lane >> 2)) * AW + h * 128 + (p >> 2) * 32 + (lane & 3) * 8, (unsigned)__builtin_amdgcn_readfirstlane(lds0 + 16384 + p * 1024)); }
        const bf16_t* qp = Qg + (rowb + nqt * 128 + qb * 32 + r32) * AW + h * 128 + map * 64 + hi * 8;
#pragma unroll
        for (int d0 = 0; d0 < 4; ++d0) qn[d0] = *(const bf16x8*)(qp + d0 * 16);
    }
    { const float ltot = half_swap_sum(lrun); const float inv = (map ? lam : 1.0f) / ltot;
      if (hi == 0) wsf[r32] = inv;
      f32x4 a4[4];
#pragma unroll
      for (int gq = 0; gq < 4; ++gq) a4[gq] = *(const LAS f32x4*)(wsf + 8 * gq + 4 * hi);
#pragma unroll
      for (int d = 0; d < 4; ++d)
#pragma unroll
          for (int r = 0; r < 16; ++r) o[d][r] *= a4[r >> 2][r & 3]; }
    LAS float* X = (LAS float*)(lds + 32768 + qb * 16384);
    if (map == 1) {
#pragma unroll
        for (int d = 0; d < 4; ++d)
#pragma unroll
            for (int r = 0; r < 16; ++r) X[crow(r, hi) * 128 + 32 * d + r32] = o[d][r];
    }
    __syncthreads();
    if (map == 0) {
        float ssq[16];
#pragma unroll
        for (int r = 0; r < 16; ++r) ssq[r] = 0.f;
#pragma unroll
        for (int d = 0; d < 4; ++d)
#pragma unroll
            for (int r = 0; r < 16; ++r) { const float v = o[d][r] - X[crow(r, hi) * 128 + 32 * d + r32]; o[d][r] = v; ssq[r] += v * v; }
#pragma unroll
        for (int r = 0; r < 16; ++r) {
            { float v = ssq[r]; v += dpp_f<0xB1>(v); v += dpp_f<0x4E>(v); v += dpp_f<0x141>(v); v += dpp_f<0x140>(v);
              auto r2 = __builtin_amdgcn_permlane16_swap(__float_as_uint(v), __float_as_uint(v), false, false); ssq[r] = __uint_as_float(r2[0]) + __uint_as_float(r2[1]); }
            ssq[r] = 0.8f / sqrtf(ssq[r] * (1.f / 128.f) + LN_EPS); }
        LAS bf16_t* Yt = (LAS bf16_t*)X;
#pragma unroll
        for (int d = 0; d < 4; ++d) { const float gg = subg[32 * d + r32];
#pragma unroll
            for (int r = 0; r < 16; ++r) Yt[crow(r, hi) * 128 + 32 * d + r32] = (bf16_t)(cvt_pk_bf16(o[d][r] * ssq[r] * gg, 0.f) & 0xffffu); }
#pragma unroll
        for (int i = 0; i < 8; ++i) { const int id = i * 64 + lane, row = id >> 4, ch = id & 15;
            *(u32x4*)(Y + (rowb + q0 + row) * AW + h * 128 + ch * 8) = *(const LAS u32x4*)(Yt + row * 128 + ch * 8); }
    }
#pragma unroll
    for (int d0 = 0; d0 < 4; ++d0) qr[d0] = qn[d0];
    __syncthreads();
}
__device__ __forceinline__ void p3_attention(const Ctx& C, const float* const* in, unsigned char* ws) {
    const bf16_t* Q = (const bf16_t*)(ws + WS_Q); const bf16_t* K = (const bf16_t*)(ws + WS_K); const bf16_t* V = (const bf16_t*)(ws + WS_V);
    const bf16_t* KM = (const bf16_t*)(ws + WS_KMETA); const bf16_t* VM = (const bf16_t*)(ws + WS_VMETA); bf16_t* Y = (bf16_t*)(ws + WS_YATT);
    const float l1 = wave_sum(in[14][C.lane] * in[15][C.lane]), l2 = wave_sum(in[16][C.lane] * in[17][C.lane]);
    const float lam = expf(l1) - expf(l2) + 0.2f;
    LAS unsigned* rc = (LAS unsigned*)(C.lds + MISC_OFF + 6144);
    if (C.tid < 4) rc[C.tid] = 0;
    __syncthreads();
    bool rb;
    { const unsigned simd = (unsigned)__builtin_amdgcn_s_getreg(2308) & 3u;
      unsigned r = 0; if (C.lane == 0) r = __hip_atomic_fetch_add(rc + simd, 1u, __ATOMIC_RELAXED, __HIP_MEMORY_SCOPE_WORKGROUP);
      rb = (__builtin_amdgcn_readfirstlane((int)r) & 1) != 0; }
#ifndef ATT_REP
#define ATT_REP 1
#endif
    for (int vv = C.vcu; vv < 256 * ATT_REP; vv += C.G) { const int v = vv & 255;
        const int bh = v >> 1, sft = v & 1;
        bf16x8 qr[4];
#pragma unroll
        for (int d0 = 0; d0 < 4; ++d0) qr[d0] = (bf16x8){};
#pragma unroll 1
        for (int i = 0; i < 8; ++i) { const int qt = (i & 1) ? (15 - sft - (i & ~1)) : (sft + (i & ~1)); const int i1 = i + 1;
            const int nqt = i1 < 8 ? ((i1 & 1) ? (15 - sft - (i1 & ~1)) : (sft + (i1 & ~1))) : -1;
            attn_unit(C, Q, K, V, KM, VM, Y, in[18], lam, bh >> 3, bh & 7, qt, i > 0, nqt, qr, rb); }
    }
}

__device__ __forceinline__ void p6_ln1_router(const Ctx& C, const float* const* in, unsigned char* ws) {
    const int lane = C.lane, wave = C.wave, tid = C.tid;
    const bf16_t* Z = (const bf16_t*)(ws + WS_Z); bf16_t* H1 = (bf16_t*)(ws + WS_H1); const float* WrT = (const float*)(ws + WS_WRT);
    int* LIST = (int*)(ws + WS_LIST); float* WGT = (float*)(ws + WS_WGT); unsigned* ECNT = (unsigned*)(ws + WS_CTL) + CW_ECNT;
    const float* lg = in[22]; const float* lb = in[23];
    LAS float* WB = (LAS float*)C.lds;
    LAS unsigned char* XB = C.lds + 98304;
    LAS int* RE = (LAS int*)(XB);
    LAS float* RW = (LAS float*)(XB + 1024);
    LAS int* CL = (LAS int*)(XB + 2048);
    LAS int* BS = (LAS int*)(XB + 2048 + 128);
    LAS int* SL = (LAS int*)(XB + 2048 + 256);
    LAS float* LG = (LAS float*)(XB + 4096) + wave * 160;
    for (int rbk = C.vcu; rbk < T / 128; rbk += C.G) {
        if (tid < 32) CL[tid] = 0;
#pragma unroll 1
        for (int step = 0; step < 4; ++step) {
            const int lr0 = step * 32 + 4 * wave; const size_t row0 = (size_t)rbk * 128 + lr0;
            int l4 = 4 * lane; asm volatile("" : "+v"(l4));
            f32x4 v[4][8];
#pragma unroll
            for (int rr = 0; rr < 4; ++rr)
#pragma unroll
                for (int j = 0; j < 8; ++j) { const u32x2 z0 = *(const u32x2*)(Z + (row0 + rr) * DM + 256 * j + l4);
                    v[rr][j] = (f32x4){bf_lo(z0.x), bf_hi(z0.x), bf_lo(z0.y), bf_hi(z0.y)}; }
#pragma unroll
            for (int rr = 0; rr < 4; ++rr) { float mean, rstd; ln_stats(v[rr], mean, rstd);
#pragma unroll
                for (int j = 0; j < 8; ++j) { const f32x4 gg = *(const f32x4*)(lg + 256 * j + l4), bb = *(const f32x4*)(lb + 256 * j + l4);
                    v[rr][j] = (v[rr][j] - mean) * rstd * gg + bb;
                    u32x2 w; w.x = cvt_pk_bf16(v[rr][j].x, v[rr][j].y); w.y = cvt_pk_bf16(v[rr][j].z, v[rr][j].w); *(u32x2*)(H1 + (row0 + rr) * DM + 256 * j + l4) = w; } }
#pragma unroll 1
            for (int ng = 0; ng < 3; ++ng) {
                __syncthreads();
                int tq = tid; asm volatile("" : "+v"(tq));
#pragma unroll
                for (int i = 0; i < 12; ++i) { const int idx = tq + 512 * i, n = idx >> 9, c4 = idx & 511;
                    *(LAS f32x4*)(WB + n * 2048 + 4 * c4) = *(const f32x4*)(WrT + (size_t)(12 * ng + n) * DM + 4 * c4); }
                __syncthreads();
#pragma unroll 1
                for (int q = 0; q < 6; ++q) {
                    f32x4 qa[4], qb[4];
#pragma unroll
                    for (int rr = 0; rr < 4; ++rr) { qa[rr] = (f32x4){0.f, 0.f, 0.f, 0.f}; qb[rr] = qa[rr]; }
#pragma unroll
                    for (int j = 0; j < 8; ++j) { const f32x4 w4 = *(const LAS f32x4*)(WB + (2 * q) * 2048 + 256 * j + l4), x4 = *(const LAS f32x4*)(WB + (2 * q + 1) * 2048 + 256 * j + l4);
#pragma unroll
                        for (int rr = 0; rr < 4; ++rr) { qa[rr] = v[rr][j] * w4 + qa[rr]; qb[rr] = v[rr][j] * x4 + qb[rr]; } }
                    float pa[4], pb[4];
#pragma unroll
                    for (int rr = 0; rr < 4; ++rr) { pa[rr] = (qa[rr].x + qa[rr].y) + (qa[rr].z + qa[rr].w); pb[rr] = (qb[rr].x + qb[rr].y) + (qb[rr].z + qb[rr].w); }
#pragma unroll
                    for (int pr = 0; pr < 2; ++pr) {
                        auto h0 = __builtin_amdgcn_permlane32_swap(__float_as_uint(pa[2 * pr]), __float_as_uint(pa[2 * pr + 1]), false, false); const float w0 = __uint_as_float(h0[0]) + __uint_as_float(h0[1]);
                        auto h1 = __builtin_amdgcn_permlane32_swap(__float_as_uint(pb[2 * pr]), __float_as_uint(pb[2 * pr + 1]), false, false); const float w1 = __uint_as_float(h1[0]) + __uint_as_float(h1[1]);
                        auto h2 = __builtin_amdgcn_permlane16_swap(__float_as_uint(w0), __float_as_uint(w1), false, false); float z = __uint_as_float(h2[0]) + __uint_as_float(h2[1]);
                        z += dpp_f<0xB1>(z); z += dpp_f<0x4E>(z); z += dpp_f<0x141>(z); z += dpp_f<0x140>(z);
                        if ((lane & 15) == 0) LG[(2 * pr + (lane >> 5)) * 40 + 12 * ng + 2 * q + ((lane >> 4) & 1)] = z; } }
            }
            if (lane < 4) {
                const LAS float* L = LG + 40 * lane;
                int gi = 0; float gm = L[0] + in[25][0];
                for (int n = 1; n < 4; ++n) { const float x = L[n] + in[25][n]; if (x > gm) { gm = x; gi = n; } }
                float gs = 0.f;
                for (int n = 0; n < 4; ++n) gs += __expf(L[n] + in[25][n] - gm);
                const float gval = 1.0f / gs;
                int i1 = 0; float m1 = L[4 + gi * 8] + in[27][gi * 8];
                for (int j = 1; j < 8; ++j) { const float x = L[4 + gi * 8 + j] + in[27][gi * 8 + j]; if (x > m1) { m1 = x; i1 = j; } }
                int i2 = -1; float m2 = -__builtin_inff();
                for (int j = 0; j < 8; ++j) { const float x = L[4 + gi * 8 + j] + in[27][gi * 8 + j]; if (j != i1 && x > m2) { m2 = x; i2 = j; } }
                const float tt = __expf(m2 - m1), w1 = gval / (1.f + tt), w2 = gval * tt / (1.f + tt);
                const int lr = lr0 + lane; RE[lr * 2] = gi * 8 + i1; RE[lr * 2 + 1] = gi * 8 + i2; RW[lr * 2] = w1; RW[lr * 2 + 1] = w2;
            }
        }
        __syncthreads();
        int e = 0;
        if (tid < 256) { e = RE[tid]; SL[tid] = __hip_atomic_fetch_add(&CL[e], 1, __ATOMIC_RELAXED, __HIP_MEMORY_SCOPE_WORKGROUP); }
        __syncthreads();
        if (tid < 32) BS[tid] = (int)__hip_atomic_fetch_add(&ECNT[tid], (unsigned)CL[tid], __ATOMIC_RELAXED, __HIP_MEMORY_SCOPE_AGENT);
        __syncthreads();
        if (tid < 256) { const int entry = (rbk * 128 + (tid >> 1)) * 2 + (tid & 1); LIST[(size_t)e * CAP + BS[e] + SL[tid]] = entry; WGT[entry] = RW[tid]; }
        __syncthreads();
    }
}

__device__ __forceinline__ void p9_ln2(const Ctx& C, const float* const* in, unsigned char* ws, float* out) {
    const bf16_t* H1 = (const bf16_t*)(ws + WS_H1); const bf16_t* YK = (const bf16_t*)(ws + WS_YK);
    const float* lg = in[31]; const float* lb = in[32];
    const int gw = C.vcu * 8 + C.wave, NGW = C.G * 8, lane = C.lane;
    for (int m = gw; m < T; m += 2 * NGW) {
        const int m2 = (m + NGW < T) ? m + NGW : m;
        u32x2 ha[8], ya0[8], ya1[8], hb[8], yb0[8], yb1[8];
#pragma unroll
        for (int j = 0; j < 8; ++j) { const size_t c = 256 * j + 4 * lane;
            ha[j] = *(const u32x2*)(H1 + (size_t)m * DM + c); ya0[j] = *(const u32x2*)(YK + (size_t)(2 * m) * DM + c); ya1[j] = *(const u32x2*)(YK + (size_t)(2 * m + 1) * DM + c);
            hb[j] = *(const u32x2*)(H1 + (size_t)m2 * DM + c); yb0[j] = *(const u32x2*)(YK + (size_t)(2 * m2) * DM + c); yb1[j] = *(const u32x2*)(YK + (size_t)(2 * m2 + 1) * DM + c); }
#pragma unroll
        for (int rr = 0; rr < 2; ++rr) {
            f32x4 v[8];
#pragma unroll
            for (int j = 0; j < 8; ++j) { const u32x2 hw = rr ? hb[j] : ha[j], y0 = rr ? yb0[j] : ya0[j], y1 = rr ? yb1[j] : ya1[j];
                v[j] = (f32x4){bf_lo(hw.x), bf_hi(hw.x), bf_lo(hw.y), bf_hi(hw.y)} * ALPHA + (f32x4){bf_lo(y0.x), bf_hi(y0.x), bf_lo(y0.y), bf_hi(y0.y)} + (f32x4){bf_lo(y1.x), bf_hi(y1.x), bf_lo(y1.y), bf_hi(y1.y)}; }
            float mean, rstd; ln_stats(v, mean, rstd);
            const int mm = rr ? m2 : m;
            if (rr == 0 || m2 != m) {
#pragma unroll
                for (int j = 0; j < 8; ++j) { const f32x4 gg = *(const f32x4*)(lg + 256 * j + 4 * lane), bb = *(const f32x4*)(lb + 256 * j + 4 * lane);
                    *(f32x4*)(out + (size_t)mm * DM + 256 * j + 4 * lane) = (v[j] - mean) * rstd * gg + bb; } }
        }
    }
}

__device__ __forceinline__ int build_moe_tables(const Ctx& C, unsigned char* ws) {
    LAS int* blkstart = (LAS int*)(C.lds + MISC_OFF + 64); LAS int* cntE = (LAS int*)(C.lds + MISC_OFF + 320); LAS int* blkexp = (LAS int*)(C.lds + MISC_OFF + 512);
    unsigned* ECNT = (unsigned*)(ws + WS_CTL) + CW_ECNT;
    __syncthreads();
    if (C.tid < 32) cntE[C.tid] = (int)__hip_atomic_load(&ECNT[C.tid], __ATOMIC_RELAXED, __HIP_MEMORY_SCOPE_AGENT);
    __syncthreads();
    if (C.tid == 0) { int s = 0; for (int e = 0; e < NE; ++e) { blkstart[e] = s; s += (cntE[e] + 255) >> 8; } blkstart[NE] = s; }
    __syncthreads();
    const int NBLK = blkstart[NE];
    if (C.tid < NBLK && C.tid < 320) { int e = 0; for (int j = 1; j < NE; ++j) if (blkstart[j] <= C.tid) e = j; blkexp[C.tid] = e; }
    __syncthreads();
    return NBLK < 320 ? NBLK : 320;
}

__device__ __forceinline__ void p7_convert_down(const Ctx& C, const float* const* in, unsigned char* ws) {
    LAS float* scr = (LAS float*)(C.lds + C.wave * 16384);
    unsigned* ctr = (unsigned*)(ws + WS_CTL) + CW_CONV; bf16_t* WdnT = (bf16_t*)(ws + WS_WDN);
    constexpr int NCH = NE * 512 / 16;
    for (;;) {
        unsigned ch = 0; if (C.lane == 0) ch = __hip_atomic_fetch_add(ctr, 1u, __ATOMIC_RELAXED, __HIP_MEMORY_SCOPE_AGENT);
        ch = (unsigned)__builtin_amdgcn_readfirstlane((int)ch);
        if (ch >= (unsigned)NCH) break;
#pragma unroll 1
        for (int q = 0; q < 16; ++q) { const int r = (int)ch * 16 + q, e = r >> 9, rr = r & 511, kb = rr >> 6, nb = rr & 63;
            transpose_item(in[30] + (size_t)e * DFF * DM, DFF, DM, WdnT, kb, nb, e * 2048 + 32 * nb, scr, C.lane); }
    }
}

constexpr int NPHASE = 10;
struct Args { const float* in[33]; float* out; unsigned char* ws; int ph_lo, ph_hi; };
__global__ void __launch_bounds__(512, 2) mk_fwd(Args args) {
    extern __shared__ __attribute__((aligned(16))) unsigned char lds_raw[];
    Ctx C; C.lds = (LAS unsigned char*)lds_raw; C.tid = threadIdx.x; C.lane = C.tid & 63; C.wave = __builtin_amdgcn_readfirstlane(C.tid >> 6);
    C.G = gridDim.x; { const int bx = blockIdx.x; C.vcu = (C.G % 8 == 0) ? (bx % 8) * (C.G / 8) + bx / 8 : bx; }
    unsigned char* ws = args.ws; const float* const* in = args.in;
    volatile LAS unsigned* MISC = (volatile LAS unsigned*)(C.lds + MISC_OFF);
    if (C.tid < 16) MISC[C.tid] = 0u;
    __syncthreads();
    unsigned* barw = (unsigned*)(ws + WS_CTL) + CW_BAR;
    XcdBarrier bar; bar.bar = barw; bar.x = 0; bar.st = nullptr;
    const int lo = args.ph_lo, hi = args.ph_hi;
    if (hi - lo > 1) bar = xcd_barrier_post(barw, MISC);
#ifndef PH_MASK
#define PH_MASK 0x3ff
#endif
#define IN(k) (((PH_MASK >> (k)) & 1) && lo <= (k) && (k) < hi)
#define SEAM(k) do { if (IN(k) && IN((k) + 1)) xcd_barrier(bar); } while (0)
#ifndef WGM_PROJ
#define WGM_PROJ 4
#endif
#ifndef WGM_N2K
#define WGM_N2K 2
#endif
#ifndef GEMM_SP2
#define GEMM_SP2 true
#endif
#ifndef GEMM_ALIGN
#define GEMM_ALIGN true
#endif
#ifndef PROBE_MASK
#define PROBE_MASK 0
#endif
#define REPS(k) (((PROBE_MASK >> (k)) & 1) ? 2 : 1)
#define REPSEAM(k, rep) do { if ((rep) + 1 < REPS(k)) xcd_barrier(bar); } while (0)
    LAS unsigned char* lds = C.lds;
    bf16_t* MG = (bf16_t*)args.out;

    if (IN(0)) { _Pragma("unroll") for (int rep = 0; rep < REPS(0); ++rep) { p0_prologue(C, in, ws); REPSEAM(0, rep); } } SEAM(0);

    if (IN(1)) { _Pragma("unroll") for (int rep = 0; rep < REPS(1); ++rep) {
        pg8::Gemm g{(const bf16_t*)(ws + WS_HBF), (const bf16_t*)(ws + WS_WIN), T, INC, DM, nullptr, nullptr, 0}; pg8::StaticOrder S; S.init(T, INC, C.G, (int)blockIdx.x, WGM_PROJ);
        EpiProj E{(bf16_t*)(ws + WS_U), (bf16_t*)(ws + WS_Q), (bf16_t*)(ws + WS_K), (bf16_t*)(ws + WS_V), (bf16_t*)(ws + WS_SGS), (bf16_t*)(ws + WS_SGA)};
        pg8::gemm_phase<EpiProj, pg8::StaticOrder, GEMM_ALIGN, GEMM_SP2, false>(lds, g, S, E);
        p1_meta_proj(C, ws);
        REPSEAM(1, rep);
    } } SEAM(1);

    if (IN(2)) { _Pragma("unroll") for (int rep = 0; rep < REPS(2); ++rep) { p2_scan(C, in, ws); REPSEAM(2, rep); } } SEAM(2);

    if (IN(3)) { _Pragma("unroll") for (int rep = 0; rep < REPS(3); ++rep) {
        { pg8::Gemm g{(const bf16_t*)(ws + WS_YPRE), (const bf16_t*)(ws + WS_WGLU), T, SSMW, SSMW, nullptr, nullptr, 0}; pg8::StaticOrder S; S.init(T, SSMW, C.G, (int)blockIdx.x);
          EpiGlu E{(const bf16_t*)(ws + WS_YPRE), (bf16_t*)(ws + WS_YSSM)};
          pg8::gemm_phase<EpiGlu, pg8::StaticOrder, GEMM_ALIGN, GEMM_SP2, false>(lds, g, S, E); }
        p3_attention(C, in, ws);
        REPSEAM(3, rep);
    } } SEAM(3);

    if (IN(4)) { _Pragma("unroll") for (int rep = 0; rep < REPS(4); ++rep) {
        { pg8::Gemm g{(const bf16_t*)(ws + WS_YSSM), (const bf16_t*)(ws + WS_WBS), T, DM, SSMW, (const bf16_t*)(ws + WS_YATT), (const bf16_t*)(ws + WS_WBA), AW}; pg8::StaticOrder S; S.init(T, DM, C.G, (int)blockIdx.x, WGM_N2K);
          EpiMergeF E{(const bf16_t*)(ws + WS_SGS), (const bf16_t*)(ws + WS_SGA), MG};
          pg8::gemm_phase<EpiMergeF, pg8::StaticOrder, GEMM_ALIGN, GEMM_SP2, false, true>(lds, g, S, E); }
        REPSEAM(4, rep);
    } } SEAM(4);

    if (IN(5)) { _Pragma("unroll") for (int rep = 0; rep < REPS(5); ++rep) {
        pg8::Gemm g{MG, (const bf16_t*)(ws + WS_WO), T, DM, DM, nullptr, nullptr, 0}; pg8::StaticOrder S; S.init(T, DM, C.G, (int)blockIdx.x, WGM_N2K);
        EpiZ E{(const bf16_t*)(ws + WS_HBF), (bf16_t*)(ws + WS_Z)};
        pg8::gemm_phase<EpiZ, pg8::StaticOrder, GEMM_ALIGN, GEMM_SP2, false>(lds, g, S, E);
        REPSEAM(5, rep);
    } } SEAM(5);

    if (IN(6)) { p6_ln1_router(C, in, ws); } SEAM(6);

    if (IN(7)) { _Pragma("unroll") for (int rep = 0; rep < REPS(7); ++rep) {
        const int NBLK = build_moe_tables(C, ws);
        MoeOrder S{C.G, C.vcu, 2, NBLK, (const LAS int*)(lds + MISC_OFF + 512), (const LAS int*)(lds + MISC_OFF + 64), (const LAS int*)(lds + MISC_OFF + 320), (const int*)(ws + WS_LIST)};
        pg8::Gemm g{(const bf16_t*)(ws + WS_H1), (const bf16_t*)(ws + WS_WUP), T, NE * 1024, DM, nullptr, nullptr, 0};
        EpiSwiglu E{(bf16_t*)(ws + WS_HB), (const int*)(ws + WS_LIST), (const float*)(ws + WS_WGT), (int*)(ws + WS_POSE), (float*)(ws + WS_POSW)};
        pg8::gemm_phase<EpiSwiglu, MoeOrder, GEMM_ALIGN, GEMM_SP2, true>(lds, g, S, E);
        p7_convert_down(C, in, ws);
        REPSEAM(7, rep);
    } } SEAM(7);

    if (IN(8)) { _Pragma("unroll") for (int rep = 0; rep < REPS(8); ++rep) {
        const int NBLK = build_moe_tables(C, ws);
        MoeOrder S{C.G, C.vcu, 3, NBLK, (const LAS int*)(lds + MISC_OFF + 512), (const LAS int*)(lds + MISC_OFF + 64), (const LAS int*)(lds + MISC_OFF + 320), (const int*)(ws + WS_LIST)};
        pg8::Gemm g{(const bf16_t*)(ws + WS_HB), (const bf16_t*)(ws + WS_WDN), NBLK * 256, NE * DM, DFF, nullptr, nullptr, 0};
        EpiDown E{(const int*)(ws + WS_POSE), (const float*)(ws + WS_POSW), (bf16_t*)(ws + WS_YK)};
        pg8::gemm_phase<EpiDown, MoeOrder, GEMM_ALIGN, GEMM_SP2, false>(lds, g, S, E);
        REPSEAM(8, rep);
    } } SEAM(8);

    if (IN(9)) { _Pragma("unroll") for (int rep = 0; rep < REPS(9); ++rep) { p9_ln2(C, in, ws, args.out); REPSEAM(9, rep); } }
#undef IN
#undef SEAM
}

extern "C" void kernel_launch(void* const* d_in, const int* in_sizes, int n_in, void* d_out, int out_size, void* d_ws, size_t ws_size, hipStream_t stream) {
    static int grid = 0;
    if (grid == 0) {
        if (n_in != 33 || in_sizes[0] != T * DM || out_size != T * DM || ws_size < WS_END) { fprintf(stderr, "kernel_launch: unexpected shapes (n_in %d, in0 %d, out %d, ws %zu)\n", n_in, n_in > 0 ? in_sizes[0] : -1, out_size, ws_size); grid = -1; return; }
        int dev = 0, cus = 0, per_cu = 0;
        if (hipGetDevice(&dev) != hipSuccess || hipDeviceGetAttribute(&cus, hipDeviceAttributeMultiprocessorCount, dev) != hipSuccess) { grid = -1; return; }
        if (hipFuncSetAttribute((const void*)mk_fwd, hipFuncAttributeMaxDynamicSharedMemorySize, LDS_BYTES) != hipSuccess) { fprintf(stderr, "kernel_launch: hipFuncSetAttribute failed\n"); grid = -1; return; }
        if (hipOccupancyMaxActiveBlocksPerMultiprocessor(&per_cu, (const void*)mk_fwd, 512, LDS_BYTES) != hipSuccess || per_cu < 1) { fprintf(stderr, "kernel_launch: occupancy query reports %d blocks per CU\n", per_cu); }
        (void)hipGetLastError();
        grid = cus;
    }
    if (grid < 0) return;
    (void)hipMemsetAsync((char*)d_ws + WS_CTL, 0, CTL_ZERO_BYTES, stream);
    Args a{};
    for (int i = 0; i < 33; ++i) a.in[i] = (const float*)d_in[i];
    a.out = (float*)d_out; a.ws = (unsigned char*)d_ws;
#if MK_PER_PHASE
    for (int p = 0; p < NPHASE; ++p) { a.ph_lo = p; a.ph_hi = p + 1; hipLaunchKernelGGL(mk_fwd, dim3(grid), dim3(512), LDS_BYTES, stream, a); }
#else
    a.ph_lo = 0; a.ph_hi = NPHASE; hipLaunchKernelGGL(mk_fwd, dim3(grid), dim3(512), LDS_BYTES, stream, a);
#endif
}
```

```cpp
#include <hip/hip_runtime.h>
#include <stdint.h>
#include <stdio.h>

#ifndef ATT_PROBE
#define ATT_PROBE 0
#endif
#ifndef MK_PER_PHASE
#define MK_PER_PHASE 0
#endif

#define GAS __attribute__((address_space(1)))
#define LAS __attribute__((address_space(3)))
typedef unsigned short bf16_t;
typedef short bf16x8 __attribute__((ext_vector_type(8)));
typedef short s16x4 __attribute__((ext_vector_type(4)));
typedef float f32x2 __attribute__((ext_vector_type(2)));
typedef float f32x4 __attribute__((ext_vector_type(4)));
typedef float f32x16 __attribute__((ext_vector_type(16)));
typedef unsigned u32x2 __attribute__((ext_vector_type(2)));
typedef unsigned u32x4 __attribute__((ext_vector_type(4)));

constexpr int NB_ = 16, SEQ = 2048, DM = 2048, T = NB_ * SEQ, NMETA = 16;
constexpr int SSMW = 512, AW = 1024, INC = 7680, NGRP = 32, NST = 64;
constexpr int NE = 32, DFF = 512, CAP = T;
constexpr float LN_EPS = 1e-5f;
constexpr float ALPHA = 1.189207115002721f;
constexpr float QSCALE = 0.125f * 1.4426950408889634f;

__device__ __forceinline__ unsigned cvt_pk_bf16(float lo, float hi) { unsigned r; asm volatile("v_cvt_pk_bf16_f32 %0, %1, %2" : "=v"(r) : "v"(lo), "v"(hi)); return r; }
__device__ __forceinline__ float bf_lo(unsigned w) { return __uint_as_float(w << 16); }
__device__ __forceinline__ float bf_hi(unsigned w) { return __uint_as_float(w & 0xffff0000u); }
__device__ __forceinline__ float sigmoidf_(float x) { return __builtin_amdgcn_rcpf(1.0f + __expf(-x)); }
template <int CTRL> __device__ __forceinline__ float dpp_f(float v) { return __int_as_float(__builtin_amdgcn_update_dpp(0, __float_as_int(v), CTRL, 0xf, 0xf, true)); }
__device__ __forceinline__ float wave_sum(float v) {
    v += dpp_f<0xB1>(v);
    v += dpp_f<0x4E>(v);
    v += dpp_f<0x141>(v);
    v += dpp_f<0x140>(v);
    { auto r = __builtin_amdgcn_permlane16_swap(__float_as_uint(v), __float_as_uint(v), false, false); v = __uint_as_float(r[0]) + __uint_as_float(r[1]); }
    { auto r = __builtin_amdgcn_permlane32_swap(__float_as_uint(v), __float_as_uint(v), false, false); v = __uint_as_float(r[0]) + __uint_as_float(r[1]); }
    return v;
}

namespace pg8 {
constexpr int BM = 256, BK = 64, HALF = 128, HTB = HALF * BK * 2, STAGE_BYTES = 8 * HTB, NXCD = 8, WGM = 4;
__host__ __device__ __forceinline__ int lds_byte(int r, int c) { const int st = (r >> 4) * 2 + (c >> 5), rr = r & 15, cc = c & 31, ob = rr * 64 + cc * 2; return st * 1024 + (ob ^ (((ob >> 9) & 1) << 5)); }
__host__ __device__ __forceinline__ void stage_rc(int b, int& R, int& C) { const int st = b / 1024, sb = b % 1024, swz = sb ^ (((sb >> 9) & 1) << 5); R = (st >> 1) * 16 + swz / 64; C = (st & 1) * 32 + (swz % 64) / 2; }
__host__ __device__ __forceinline__ int perm32(int rho) { const int n = rho >> 4, i = rho & 15; return 8 * (i >> 2) + 4 * n + (i & 3); }

struct Unit { int pm, pn, e, s0, cnt; };
struct Gemm { const bf16_t* A; const bf16_t* Bt; int M, N, K; const bf16_t* A2; const bf16_t* Bt2; int K2; };

struct StaticOrder {
    int nM, nN, nwg, G, c, wgm;
    __device__ void init(int M, int N, int G_, int c_, int wgm_ = WGM) { nM = M / BM; nN = N / BM; nwg = nM * nN; G = G_; c = c_; wgm = wgm_; }
    __device__ bool next(int i, Unit& u) const {
        const long L = (long)i * G + c; if (L >= nwg) return false;
        int wgid = (int)L; { const int q = nwg / NXCD, r = nwg % NXCD, xcd = wgid % NXCD, off = wgid / NXCD; wgid = (xcd < r ? xcd * (q + 1) : r * (q + 1) + (xcd - r) * q) + off; }
        const int nig = wgm * nN, gid = wgid / nig, fm = gid * wgm, gsz = (nM - fm) < wgm ? (nM - fm) : wgm;
        u.pm = fm + ((wgid % nig) % gsz); u.pn = (wgid % nig) / gsz; u.e = 0; u.s0 = 0; u.cnt = 0; return true;
    }
    __device__ __forceinline__ int arow(const Unit&, int) const { return 0; }
};

template <class Epi, class Sched, bool ALIGN_EPI, bool SP2, bool GATHER, bool DUAL = false>
__device__ __forceinline__ void gemm_phase(LAS unsigned char* lds, const Gemm g, const Sched& S, const Epi& E) {
    const int tid = threadIdx.x, wid = __builtin_amdgcn_readfirstlane(tid >> 6), lane = tid & 63, wr = wid >> 2, wc = wid & 3, fr = lane & 15, fq = lane >> 4;
    const int K = g.K, K2 = DUAL ? g.K2 : 0, nt1 = K / BK, nt = (K + K2) / BK;
    unsigned voffA[2], voffB[2], voffA2[2] = {0u, 0u}, voffB2[2] = {0u, 0u}; int stR[2], stC[2];
#pragma unroll
    for (int i = 0; i < 2; ++i) { int R, C; stage_rc(tid * 16 + i * 8192, R, C); const int Rb = Epi::PERM ? ((R & ~31) + perm32(R & 31)) : R;
        stR[i] = R; stC[i] = C; voffA[i] = (unsigned)(R * K + C) * 2u; voffB[i] = (unsigned)(Rb * K + C) * 2u;
        if constexpr (DUAL) { voffA2[i] = (unsigned)(R * K2 + C) * 2u; voffB2[i] = (unsigned)(Rb * K2 + C) * 2u; } }
    const size_t kstep = (size_t)(BK * 2);
    const size_t hstep = (size_t)HALF * K * 2;
    const size_t tstep = 2 * hstep;
    const size_t hstep2 = (size_t)HALF * K2 * 2, tstep2 = 2 * hstep2;
    const unsigned ldsw = (unsigned)wid * 1024u;
    const int aoff = lds_byte(wr * 64 + fr, fq * 8), boff = lds_byte(wc * 32 + fr, fq * 8);
#define PG8_SA(b, h) (((b) * 2 + (h)) * HTB)
#define PG8_SB(b, h) ((4 + (b) * 2 + (h)) * HTB)
#define PG8_STAGE(bufoff, gbase, voff) do { _Pragma("unroll") for (int _i = 0; _i < 2; ++_i) \
        __builtin_amdgcn_global_load_lds((const unsigned*)((const char*)(gbase) + (voff)[_i]), (LAS unsigned*)(lds + (bufoff) + ldsw + _i * 8192), 16, 0, 0); } while (0)
#define PG8_STAGE_A(bufoff, kbase, h, VO) do { if constexpr (GATHER) { PG8_STAGE(bufoff, kbase, VO[h]); } else { PG8_STAGE(bufoff, (kbase) + (h) * hstep, voffA); } } while (0)
#define PG8_STAGE_AX(bufoff, kbase, h, VO, HS, VA) do { if constexpr (GATHER) { PG8_STAGE(bufoff, kbase, VO[h]); } else { PG8_STAGE(bufoff, (kbase) + (h) * (HS), VA); } } while (0)
#define PG8_LDA(dst, b, h) do { _Pragma("unroll") for (int m = 0; m < 4; ++m) _Pragma("unroll") for (int k = 0; k < 2; ++k) dst[m][k] = *(const LAS bf16x8*)(lds + PG8_SA(b, h) + aoff + m * 2048 + k * 1024); } while (0)
#define PG8_LDB(dst, b, h) do { _Pragma("unroll") for (int n = 0; n < 2; ++n) _Pragma("unroll") for (int k = 0; k < 2; ++k) dst[n][k] = *(const LAS bf16x8*)(lds + PG8_SB(b, h) + boff + n * 2048 + k * 1024); } while (0)
#define PG8_MMA(ai, bj, At, Bt) do { __builtin_amdgcn_s_setprio(1); _Pragma("unroll") for (int m = 0; m < 4; ++m) _Pragma("unroll") for (int n = 0; n < 2; ++n) _Pragma("unroll") for (int k = 0; k < 2; ++k) \
        acc[ai][bj][m][n] = __builtin_amdgcn_mfma_f32_16x16x32_bf16(Bt[n][k], At[m][k], acc[ai][bj][m][n], 0, 0, 0); __builtin_amdgcn_s_setprio(0); } while (0)
#define PG8_WAIT_V(n) asm volatile("s_waitcnt vmcnt(" #n ")" ::: "memory")
#define PG8_WAIT_L(n) asm volatile("s_waitcnt lgkmcnt(" #n ")" ::: "memory")
#define PG8_BAR __builtin_amdgcn_s_barrier()
#define PG8_SCHED __builtin_amdgcn_sched_barrier(0)
#define PG8_GOFF(VO, U) do { _Pragma("unroll") for (int _h = 0; _h < 2; ++_h) _Pragma("unroll") for (int _i = 0; _i < 2; ++_i) \
        VO[_h][_i] = (unsigned)S.arow(U, _h * HALF + stR[_i]) * (unsigned)(K * 2) + (unsigned)(stC[_i] * 2); } while (0)
    Unit cur, nxt; int ui = 0;
    if (!S.next(0, cur)) return;
    f32x4 acc[2][2][4][2];
#pragma unroll
    for (int a = 0; a < 2; ++a)
#pragma unroll
        for (int b = 0; b < 2; ++b)
#pragma unroll
            for (int m = 0; m < 4; ++m)
#pragma unroll
                for (int n = 0; n < 2; ++n) acc[a][b][m][n] = (f32x4){0.f, 0.f, 0.f, 0.f};
    bf16x8 At[4][2], B0[2][2], B1[2][2];
    unsigned cvo[2][2] = {{0u, 0u}, {0u, 0u}}, nvo[2][2] = {{0u, 0u}, {0u, 0u}};
    const char* cA = GATHER ? (const char*)g.A : (const char*)g.A + (size_t)cur.pm * tstep; const char* cB = (const char*)g.Bt + (size_t)cur.pn * tstep;
    if constexpr (GATHER) { PG8_GOFF(cvo, cur); }
    if constexpr (SP2) {
        PG8_STAGE(PG8_SB(0, 0), cB, voffB); PG8_STAGE(PG8_SB(0, 1), cB + hstep, voffB); PG8_STAGE_A(PG8_SA(0, 0), cA, 0, cvo); PG8_STAGE_A(PG8_SA(0, 1), cA, 1, cvo);
        if (wr == 1) PG8_BAR;
        PG8_WAIT_V(2); PG8_BAR;
        PG8_STAGE(PG8_SB(1, 0), cB + kstep, voffB); PG8_STAGE_A(PG8_SA(1, 0), cA + kstep, 0, cvo); PG8_STAGE(PG8_SB(1, 1), cB + hstep + kstep, voffB);
        PG8_WAIT_V(6); PG8_BAR;
    } else {
        PG8_STAGE(PG8_SB(0, 0), cB, voffB); PG8_STAGE_A(PG8_SA(0, 0), cA, 0, cvo); PG8_STAGE(PG8_SB(0, 1), cB + hstep, voffB); PG8_STAGE_A(PG8_SA(0, 1), cA, 1, cvo);
        if (wr == 1) PG8_BAR;
        PG8_WAIT_V(4); PG8_BAR;
        PG8_STAGE(PG8_SB(1, 0), cB + kstep, voffB); PG8_STAGE_A(PG8_SA(1, 0), cA + kstep, 0, cvo); PG8_STAGE(PG8_SB(1, 1), cB + hstep + kstep, voffB);
        PG8_WAIT_V(6); PG8_BAR;
    }
    for (;;) {
        const bool has_next = S.next(ui + 1, nxt);
        const char* nA = GATHER ? cA : (has_next ? (const char*)g.A + (size_t)nxt.pm * tstep : cA); const char* nB = has_next ? (const char*)g.Bt + (size_t)nxt.pn * tstep : cB;
        if constexpr (GATHER) { if (has_next) { PG8_GOFF(nvo, nxt); } else {
#pragma unroll
            for (int h = 0; h < 2; ++h)
#pragma unroll
                for (int i = 0; i < 2; ++i) nvo[h][i] = cvo[h][i]; } }
        const char* cA2 = DUAL ? (const char*)g.A2 + (size_t)cur.pm * tstep2 : cA; const char* cB2 = DUAL ? (const char*)g.Bt2 + (size_t)cur.pn * tstep2 : cB;
        for (int t = 0; t < nt; t += 2) {
            const bool last = (t == nt - 2);
            const bool s1 = DUAL && (t + 1 >= nt1), s2 = DUAL && !last && (t + 2 >= nt1);
            const char* a1 = s1 ? cA2 + (size_t)(t + 1 - nt1) * kstep : cA + (size_t)(t + 1) * kstep;
            const char* a2 = last ? nA : (s2 ? cA2 + (size_t)(t + 2 - nt1) * kstep : cA + (size_t)(t + 2) * kstep);
            const char* b2 = last ? nB : (s2 ? cB2 + (size_t)(t + 2 - nt1) * kstep : cB + (size_t)(t + 2) * kstep);
            const char* a3 = a2 + kstep; const char* b3 = b2 + kstep;
            const size_t hs1 = s1 ? hstep2 : hstep, hs2 = s2 ? hstep2 : hstep;
            unsigned vA1[2], vA2[2], vB2[2];
#pragma unroll
            for (int i = 0; i < 2; ++i) { vA1[i] = s1 ? voffA2[i] : voffA[i]; vA2[i] = s2 ? voffA2[i] : voffA[i]; vB2[i] = s2 ? voffB2[i] : voffB[i]; }
            unsigned svo[2][2];
#pragma unroll
            for (int h = 0; h < 2; ++h)
#pragma unroll
                for (int i = 0; i < 2; ++i) svo[h][i] = last ? nvo[h][i] : cvo[h][i];
            if constexpr (SP2) {
            PG8_LDB(B0, 0, 0); PG8_LDB(B1, 0, 1); PG8_SCHED; PG8_LDA(At, 0, 0); PG8_STAGE_AX(PG8_SA(1, 1), a1, 1, cvo, hs1, vA1);
            PG8_WAIT_V(8); PG8_WAIT_L(0); PG8_BAR; PG8_MMA(0, 0, At, B0); PG8_MMA(0, 1, At, B1); PG8_BAR; PG8_SCHED;
            PG8_LDA(At, 0, 1); PG8_STAGE(PG8_SB(0, 0), b2, vB2); PG8_STAGE(PG8_SB(0, 1), b2 + hs2, vB2); PG8_STAGE_AX(PG8_SA(0, 0), a2, 0, svo, hs2, vA2);
            PG8_WAIT_V(8); PG8_WAIT_L(0); PG8_BAR; PG8_MMA(1, 0, At, B0); PG8_MMA(1, 1, At, B1); PG8_BAR; PG8_SCHED;
            PG8_LDB(B0, 1, 0); PG8_LDB(B1, 1, 1); PG8_SCHED; PG8_LDA(At, 1, 0); PG8_STAGE_AX(PG8_SA(0, 1), a2, 1, svo, hs2, vA2);
            PG8_WAIT_V(8); PG8_WAIT_L(0); PG8_BAR; PG8_MMA(0, 0, At, B0); PG8_MMA(0, 1, At, B1); PG8_BAR; PG8_SCHED;
            PG8_LDA(At, 1, 1); PG8_STAGE(PG8_SB(1, 0), b3, vB2); PG8_STAGE(PG8_SB(1, 1), b3 + hs2, vB2); PG8_STAGE_AX(PG8_SA(1, 0), a3, 0, svo, hs2, vA2);
            PG8_WAIT_V(8); PG8_WAIT_L(0); PG8_BAR; PG8_MMA(1, 0, At, B0); PG8_MMA(1, 1, At, B1); PG8_BAR; PG8_SCHED;
            } else {
            PG8_LDB(B0, 0, 0); PG8_SCHED; PG8_LDA(At, 0, 0); PG8_STAGE_AX(PG8_SA(1, 1), a1, 1, cvo, hs1, vA1);
            PG8_WAIT_L(8); PG8_BAR; PG8_WAIT_L(0); PG8_MMA(0, 0, At, B0); PG8_BAR; PG8_SCHED;
            PG8_LDB(B1, 0, 1); PG8_STAGE(PG8_SB(0, 0), b2, vB2);
            PG8_BAR; PG8_WAIT_L(0); PG8_MMA(0, 1, At, B1); PG8_BAR;
            PG8_LDA(At, 0, 1); PG8_STAGE_AX(PG8_SA(0, 0), a2, 0, svo, hs2, vA2);
            PG8_BAR; PG8_WAIT_L(0); PG8_MMA(1, 0, At, B0); PG8_BAR; PG8_SCHED;
            PG8_STAGE(PG8_SB(0, 1), b2 + hs2, vB2);
            PG8_WAIT_V(6); PG8_BAR; PG8_MMA(1, 1, At, B1); PG8_BAR;
            PG8_LDB(B0, 1, 0); PG8_SCHED; PG8_LDA(At, 1, 0); PG8_STAGE_AX(PG8_SA(0, 1), a2, 1, svo, hs2, vA2);
            PG8_WAIT_L(8); PG8_BAR; PG8_WAIT_L(0); PG8_MMA(0, 0, At, B0); PG8_BAR; PG8_SCHED;
            PG8_LDB(B1, 1, 1); PG8_STAGE(PG8_SB(1, 0), b3, vB2);
            PG8_BAR; PG8_WAIT_L(0); PG8_MMA(0, 1, At, B1); PG8_BAR;
            PG8_LDA(At, 1, 1); PG8_STAGE_AX(PG8_SA(1, 0), a3, 0, svo, hs2, vA2);
            PG8_BAR; PG8_WAIT_L(0); PG8_MMA(1, 0, At, B0); PG8_BAR; PG8_SCHED;
            PG8_STAGE(PG8_SB(1, 1), b3 + hs2, vB2);
            PG8_WAIT_V(6); PG8_BAR; PG8_MMA(1, 1, At, B1); PG8_BAR;
            }
            if constexpr (DUAL) { if (t + 2 == nt1) E.mid(acc, cur, wr, wc, fr, fq); }
        }
        if constexpr (ALIGN_EPI) { if (wr == 0) PG8_BAR; }
        E(acc, cur, wr, wc, fr, fq);
        if (!has_next) break;
#pragma unroll
        for (int a = 0; a < 2; ++a)
#pragma unroll
            for (int b = 0; b < 2; ++b)
#pragma unroll
                for (int m = 0; m < 4; ++m)
#pragma unroll
                    for (int n = 0; n < 2; ++n) acc[a][b][m][n] = (f32x4){0.f, 0.f, 0.f, 0.f};
        cur = nxt; cA = nA; cB = nB; ++ui;
#pragma unroll
        for (int h = 0; h < 2; ++h)
#pragma unroll
            for (int i = 0; i < 2; ++i) cvo[h][i] = nvo[h][i];
        if constexpr (ALIGN_EPI) { if (wr == 1) PG8_BAR; }
    }
    PG8_WAIT_V(0);
    if constexpr (!ALIGN_EPI) { if (wr == 0) PG8_BAR; }
    PG8_BAR;
#undef PG8_SA
#undef PG8_SB
#undef PG8_STAGE
#undef PG8_STAGE_A
#undef PG8_STAGE_AX
#undef PG8_LDA
#undef PG8_LDB
#undef PG8_MMA
#undef PG8_WAIT_V
#undef PG8_WAIT_L
#undef PG8_BAR
#undef PG8_SCHED
#undef PG8_GOFF
}
}

constexpr size_t MiB = 1u << 20;
constexpr size_t WS_CTL = 0, CTL_ZERO_BYTES = 1 * MiB;
constexpr size_t WS_HMETA = 1 * MiB;
constexpr size_t WS_UMETA = WS_HMETA + 128 * 1024;
constexpr size_t WS_KMETA = WS_HMETA + 256 * 1024;
constexpr size_t WS_VMETA = WS_HMETA + 384 * 1024;
constexpr size_t WS_SSMAB = WS_HMETA + 512 * 1024;
constexpr size_t WS_SSMBB = WS_HMETA + 576 * 1024;
constexpr size_t WS_WRT = 2 * MiB;
constexpr size_t WS_WIN = 3 * MiB;
constexpr size_t WS_WGLU = 33 * MiB;
constexpr size_t WS_WBS = 34 * MiB;
constexpr size_t WS_WBA = 36 * MiB;
constexpr size_t WS_WO = 40 * MiB;
constexpr size_t WS_WUP = 48 * MiB;
constexpr size_t WS_WDN = 176 * MiB;
constexpr size_t WS_HBF = 240 * MiB;
constexpr size_t WS_U = 368 * MiB;
constexpr size_t WS_Q = 400 * MiB;
constexpr size_t WS_K = 464 * MiB;
constexpr size_t WS_V = 528 * MiB;
constexpr size_t WS_SGS = 592 * MiB;
constexpr size_t WS_SGA = 720 * MiB;
constexpr size_t WS_YPRE = 848 * MiB;
constexpr size_t WS_YSSM = 880 * MiB;
constexpr size_t WS_YATT = 912 * MiB;
constexpr size_t WS_END = 976 * MiB;
constexpr size_t WS_Z = 368 * MiB;
constexpr size_t WS_H1 = 624 * MiB;
constexpr size_t WS_HB = 752 * MiB;
constexpr size_t WS_YK = 368 * MiB;
constexpr size_t WS_LIST = 848 * MiB;
constexpr size_t WS_WGT = 852 * MiB;
constexpr size_t WS_POSE = 853 * MiB;
constexpr size_t WS_POSW = 854 * MiB;
constexpr int CW_ECNT = 64;
constexpr int CW_CONV = 192;
constexpr int CW_BAR = 4096;

constexpr int RING_BYTES = 131072;
constexpr int MISC_OFF = RING_BYTES;
constexpr int LDS_BYTES = 139264;

#define XB_TMO      128
#define XB_XCNT(j)  (256  + 64 * (j))
#define XB_XSUB(j)  (1280 + 64 * (j))
#define XB_XGEN(j)  (2304 + 64 * (j))
#define XB_TOP      3328
#define XB_TOPGEN   3392
#define XCD_BAR_WORDS 3456
#define XB_SPIN_CAP (1u << 18)
__device__ __forceinline__ unsigned xb_ld(unsigned* p)              { return __hip_atomic_load(p, __ATOMIC_RELAXED, __HIP_MEMORY_SCOPE_AGENT); }
__device__ __forceinline__ unsigned xb_add(unsigned* p, unsigned v) { return __hip_atomic_fetch_add(p, v, __ATOMIC_RELAXED, __HIP_MEMORY_SCOPE_AGENT); }
__device__ __forceinline__ unsigned xb_xcc_id() { return (unsigned)__builtin_amdgcn_s_getreg((3 << 11) | 20) & 0xFu; }
#define XB_SPIN(cond, bar) do { unsigned _sp = 0; while (cond) { __builtin_amdgcn_s_sleep(1); \
    if ((++_sp & 255u) == 0u) { if (xb_ld(&(bar)[XB_TMO])) break; if (_sp > XB_SPIN_CAP) { atomicAdd(&(bar)[XB_TMO], 1u); break; } } } } while (0)
struct XcdBarrier { unsigned* bar; unsigned x; volatile LAS unsigned* st; };
__device__ __forceinline__ XcdBarrier xcd_barrier_post(unsigned* bar, volatile LAS unsigned* st) {
    XcdBarrier b; b.bar = bar; b.x = xb_xcc_id(); b.st = st;
    if (threadIdx.x == 0) (void)xb_add(&bar[XB_XCNT(b.x)], 1u);
    return b;
}
__device__ __forceinline__ void xcd_barrier_complete(unsigned* bar, unsigned x, unsigned& nloc, unsigned& nx) {
    const unsigned G = gridDim.x * gridDim.y * gridDim.z;
    unsigned sum, cnt, mine, sp = 0u;
    for (;;) {
        sum = 0u; cnt = 0u; mine = 0u;
#pragma unroll
        for (unsigned j = 0; j < 16; ++j) { const unsigned c = xb_ld(&bar[XB_XCNT(j)]); sum += c; cnt += (c > 0u) ? 1u : 0u; mine = (j == x) ? c : mine; }
        if (sum == G) break;
        __builtin_amdgcn_s_sleep(1);
        if ((++sp & 255u) == 0u) { if (xb_ld(&bar[XB_TMO])) break; if (sp > XB_SPIN_CAP) { atomicAdd(&bar[XB_TMO], 1u); break; } }
    }
    nloc = mine > 0u ? mine : 1u; nx = cnt > 0u ? cnt : 1u;
}
__device__ __forceinline__ void xcd_barrier(const XcdBarrier& b) {
    asm volatile("s_waitcnt vmcnt(0)" ::: "memory");
    __syncthreads();
    if (threadIdx.x == 0) {
        unsigned* bar = b.bar;
        __builtin_amdgcn_s_waitcnt(0);
        unsigned nloc = b.st[0], nx = b.st[1];
        if (nloc == 0u) { xcd_barrier_complete(bar, b.x, nloc, nx); b.st[0] = nloc; b.st[1] = nx; }
        const unsigned old = xb_add(&bar[XB_XSUB(b.x)], 1u);
        const unsigned gen = old / nloc;
        if (old + 1u == (gen + 1u) * nloc) {
            __builtin_amdgcn_fence(__ATOMIC_RELEASE, "agent");
            asm volatile("s_waitcnt vmcnt(0)" ::: "memory");
            const unsigned og = xb_add(&bar[XB_TOP], 1u);
            const unsigned tg = og / nx;
            if (og + 1u == (tg + 1u) * nx) xb_add(&bar[XB_TOPGEN], 1u);
            else XB_SPIN(xb_ld(&bar[XB_TOPGEN]) == tg, bar);
            __builtin_amdgcn_fence(__ATOMIC_ACQUIRE, "agent");
            xb_add(&bar[XB_XGEN(b.x)], 1u);
            asm volatile("s_waitcnt vmcnt(0)" ::: "memory");
        } else {
            XB_SPIN(xb_ld(&bar[XB_XGEN(b.x)]) == gen, bar);
            __builtin_amdgcn_fence(__ATOMIC_ACQUIRE, "agent");
            asm volatile("s_waitcnt vmcnt(0)" ::: "memory");
        }
    }
    __syncthreads();
}

using pg8::Unit;
__device__ __forceinline__ u32x4 pack8(const f32x4 v0, const f32x4 v1) { u32x4 w; w.x = cvt_pk_bf16(v0[0], v0[1]); w.y = cvt_pk_bf16(v0[2], v0[3]); w.z = cvt_pk_bf16(v1[0], v1[1]); w.w = cvt_pk_bf16(v1[2], v1[3]); return w; }
__device__ __forceinline__ void unpack8(const u32x4 w, f32x4& v0, f32x4& v1) { v0 = (f32x4){bf_lo(w.x), bf_hi(w.x), bf_lo(w.y), bf_hi(w.y)}; v1 = (f32x4){bf_lo(w.z), bf_hi(w.z), bf_lo(w.w), bf_hi(w.w)}; }

struct EpiProj {
    static constexpr bool PERM = true;
    bf16_t *U, *Q, *K, *V, *RHO, *SGA;
    __device__ __forceinline__ void operator()(const f32x4 (&acc)[2][2][4][2], const Unit& u, int wr, int wc, int fr, int fq) const {
        const int pn = u.pn;
        if (pn >= 14) {
            const int row0 = u.pm * 256 + wr * 64 + fr, col0 = (pn - 14) * 128 + wc * 32 + 8 * fq;
#pragma unroll
            for (int ai = 0; ai < 2; ++ai)
#pragma unroll
                for (int m = 0; m < 4; ++m) { const size_t off = (size_t)(row0 + ai * 128 + m * 16) * DM + col0; f32x4 r0, r1, a0, a1;
#pragma unroll
                    for (int j = 0; j < 4; ++j) { const float es0 = __expf(-acc[ai][0][m][0][j]), es1 = __expf(-acc[ai][0][m][1][j]), ea0 = __expf(-acc[ai][1][m][0][j]), ea1 = __expf(-acc[ai][1][m][1][j]);
                        a0[j] = __builtin_amdgcn_rcpf(1.f + ea0); a1[j] = __builtin_amdgcn_rcpf(1.f + ea1);
                        r0[j] = (1.f + ea0) * __builtin_amdgcn_rcpf(1.f + es0); r1[j] = (1.f + ea1) * __builtin_amdgcn_rcpf(1.f + es1); }
                    *(u32x4*)(RHO + off) = pack8(r0, r1); *(u32x4*)(SGA + off) = pack8(a0, a1); }
            return;
        }
        bf16_t* base; int ldc, ct, mode;
        if (pn < 2) { base = U; ldc = 512; ct = pn; mode = 0; }
        else if (pn < 6) { base = Q; ldc = 1024; ct = pn - 2; mode = 1; }
        else if (pn < 10) { base = K; ldc = 1024; ct = pn - 6; mode = 0; }
        else { base = V; ldc = 1024; ct = pn - 10; mode = 0; }
        const int row0 = u.pm * 256 + wr * 64 + fr, col0 = ct * 256 + wc * 32 + 8 * fq;
#pragma unroll
        for (int ai = 0; ai < 2; ++ai)
#pragma unroll
            for (int m = 0; m < 4; ++m) { bf16_t* rowp = base + (size_t)(row0 + ai * 128 + m * 16) * ldc + col0;
#pragma unroll
                for (int bj = 0; bj < 2; ++bj) { f32x4 v0 = acc[ai][bj][m][0], v1 = acc[ai][bj][m][1];
                    if (mode == 1) { v0 = v0 * QSCALE; v1 = v1 * QSCALE; }
                    *(u32x4*)(rowp + bj * 128) = pack8(v0, v1); } }
    }
};
struct EpiGlu {
    static constexpr bool PERM = true;
    const bf16_t* YPRE; bf16_t* YSSM;
    __device__ __forceinline__ void operator()(const f32x4 (&acc)[2][2][4][2], const Unit& u, int wr, int wc, int fr, int fq) const {
        const int row0 = u.pm * 256 + wr * 64 + fr, col0 = u.pn * 256 + wc * 32 + 8 * fq;
#pragma unroll
        for (int ai = 0; ai < 2; ++ai)
#pragma unroll
            for (int m = 0; m < 4; ++m) { const size_t off = (size_t)(row0 + ai * 128 + m * 16) * SSMW + col0;
#pragma unroll
                for (int bj = 0; bj < 2; ++bj) { const u32x4 yw = *(const u32x4*)(YPRE + off + bj * 128); f32x4 y0, y1; unpack8(yw, y0, y1);
                    f32x4 v0 = acc[ai][bj][m][0], v1 = acc[ai][bj][m][1];
#pragma unroll
                    for (int j = 0; j < 4; ++j) { v0[j] = y0[j] * sigmoidf_(v0[j]); v1[j] = y1[j] * sigmoidf_(v1[j]); }
                    *(u32x4*)(YSSM + off + bj * 128) = pack8(v0, v1); } }
    }
};
template <int SECOND> struct EpiMerge {
    static constexpr bool PERM = true;
    const bf16_t* SG; bf16_t* MG;
    __device__ __forceinline__ void operator()(const f32x4 (&acc)[2][2][4][2], const Unit& u, int wr, int wc, int fr, int fq) const {
        const int row0 = u.pm * 256 + wr * 64 + fr, col0 = u.pn * 256 + wc * 32 + 8 * fq;
#pragma unroll
        for (int ai = 0; ai < 2; ++ai)
#pragma unroll
            for (int m = 0; m < 4; ++m) { const size_t off = (size_t)(row0 + ai * 128 + m * 16) * DM + col0;
#pragma unroll
                for (int bj = 0; bj < 2; ++bj) { const u32x4 gw = *(const u32x4*)(SG + off + bj * 128); f32x4 g0, g1; unpack8(gw, g0, g1);
                    f32x4 v0 = acc[ai][bj][m][0] * g0, v1 = acc[ai][bj][m][1] * g1;
                    if (SECOND) { const u32x4 pw = *(const u32x4*)(MG + off + bj * 128); f32x4 p0, p1; unpack8(pw, p0, p1); v0 = v0 + p0; v1 = v1 + p1; }
                    *(u32x4*)(MG + off + bj * 128) = pack8(v0, v1); } }
    }
};
struct EpiMergeF {
    static constexpr bool PERM = true;
    const bf16_t* SGS; const bf16_t* SGA; bf16_t* MG;
    __device__ __forceinline__ void mid(f32x4 (&acc)[2][2][4][2], const Unit& u, int wr, int wc, int fr, int fq) const {
        asm volatile("" : "+v"(fr), "+v"(fq));
        const int row0 = u.pm * 256 + wr * 64 + fr, col0 = u.pn * 256 + wc * 32 + 8 * fq;
        const bf16_t* sp = SGS + (size_t)row0 * DM + col0;
        u32x4 sw[2][2];
        sw[0][0] = *(const u32x4*)(sp); sw[0][1] = *(const u32x4*)(sp + 128);
#pragma unroll
        for (int g = 0; g < 8; ++g) { const int ai = g >> 2, m = g & 3;
            if (g < 7) { const int g1 = g + 1; const bf16_t* sq = sp + (size_t)((g1 >> 2) * 128 + (g1 & 3) * 16) * DM;
                sw[g1 & 1][0] = *(const u32x4*)(sq); sw[g1 & 1][1] = *(const u32x4*)(sq + 128); }
            asm volatile("" ::: "memory");
#pragma unroll
            for (int bj = 0; bj < 2; ++bj) { f32x4 s0, s1; unpack8(sw[g & 1][bj], s0, s1);
                acc[ai][bj][m][0] = acc[ai][bj][m][0] * s0; acc[ai][bj][m][1] = acc[ai][bj][m][1] * s1; }
        }
    }
    __device__ __forceinline__ void operator()(const f32x4 (&acc)[2][2][4][2], const Unit& u, int wr, int wc, int fr, int fq) const {
        const int row0 = u.pm * 256 + wr * 64 + fr, col0 = u.pn * 256 + wc * 32 + 8 * fq;
#pragma unroll
        for (int ai = 0; ai < 2; ++ai)
#pragma unroll
            for (int m = 0; m < 4; ++m) { const size_t off = (size_t)(row0 + ai * 128 + m * 16) * DM + col0;
#pragma unroll
                for (int bj = 0; bj < 2; ++bj) { const u32x4 gw = *(const u32x4*)(SGA + off + bj * 128); f32x4 g0, g1; unpack8(gw, g0, g1);
                    *(u32x4*)(MG + off + bj * 128) = pack8(acc[ai][bj][m][0] * g0, acc[ai][bj][m][1] * g1); } }
    }
};
struct EpiZ {
    static constexpr bool PERM = true;
    const bf16_t* HBF; bf16_t* Z;
    __device__ __forceinline__ void operator()(const f32x4 (&acc)[2][2][4][2], const Unit& u, int wr, int wc, int fr, int fq) const {
        const int row0 = u.pm * 256 + wr * 64 + fr, col0 = u.pn * 256 + wc * 32 + 8 * fq;
#pragma unroll
        for (int ai = 0; ai < 2; ++ai)
#pragma unroll
            for (int m = 0; m < 4; ++m) { const size_t off = (size_t)(row0 + ai * 128 + m * 16) * DM + col0;
#pragma unroll
                for (int bj = 0; bj < 2; ++bj) { const u32x4 hw = *(const u32x4*)(HBF + off + bj * 128); f32x4 h0, h1; unpack8(hw, h0, h1);
                    *(u32x4*)(Z + off + bj * 128) = pack8(acc[ai][bj][m][0] + h0 * ALPHA, acc[ai][bj][m][1] + h1 * ALPHA); } }
    }
};
struct EpiSwiglu {
    static constexpr bool PERM = true;
    bf16_t* HB; const int* LIST; const float* WGT; int* POSE; float* POSW;
    __device__ __forceinline__ void operator()(const f32x4 (&acc)[2][2][4][2], const Unit& u, int wr, int wc, int fr, int fq) const {
        const int row0 = u.pm * 256 + wr * 64 + fr, col0 = (u.pn & 3) * 128 + wc * 32 + 8 * fq;
#pragma unroll
        for (int ai = 0; ai < 2; ++ai)
#pragma unroll
            for (int m = 0; m < 4; ++m) { f32x4 v0, v1;
#pragma unroll
                for (int j = 0; j < 4; ++j) { const float g0 = acc[ai][0][m][0][j], g1 = acc[ai][0][m][1][j];
                    v0[j] = g0 * sigmoidf_(g0) * acc[ai][1][m][0][j]; v1[j] = g1 * sigmoidf_(g1) * acc[ai][1][m][1][j]; }
                *(u32x4*)(HB + (size_t)(row0 + ai * 128 + m * 16) * DFF + col0) = pack8(v0, v1); }
        if ((u.pn & 3) == 0 && wc == 0 && fq == 0) {
#pragma unroll
            for (int ai = 0; ai < 2; ++ai)
#pragma unroll
                for (int m = 0; m < 4; ++m) { const int r = wr * 64 + fr + ai * 128 + m * 16, slot = u.s0 + r; int entry = -1; float w = 0.f;
                    if (slot < u.cnt) { entry = LIST[(size_t)u.e * CAP + slot]; w = WGT[entry]; }
                    POSE[u.pm * 256 + r] = entry; POSW[u.pm * 256 + r] = w; }
        }
    }
};
struct EpiDown {
    static constexpr bool PERM = true;
    const int* POSE; const float* POSW; bf16_t* YK;
    __device__ __forceinline__ void operator()(const f32x4 (&acc)[2][2][4][2], const Unit& u, int wr, int wc, int fr, int fq) const {
        const int r0 = u.pm * 256 + wr * 64 + fr, col0 = (u.pn & 7) * 256 + wc * 32 + 8 * fq;
        int en[2][4]; float ww[2][4];
#pragma unroll
        for (int ai = 0; ai < 2; ++ai)
#pragma unroll
            for (int m = 0; m < 4; ++m) { en[ai][m] = POSE[r0 + ai * 128 + m * 16]; ww[ai][m] = POSW[r0 + ai * 128 + m * 16]; }
#pragma unroll
        for (int ai = 0; ai < 2; ++ai)
#pragma unroll
            for (int m = 0; m < 4; ++m) {
                if (en[ai][m] >= 0) { const float w = ww[ai][m]; bf16_t* rowp = YK + (size_t)en[ai][m] * DM + col0;
#pragma unroll
                    for (int bj = 0; bj < 2; ++bj) *(u32x4*)(rowp + bj * 128) = pack8(acc[ai][bj][m][0] * w, acc[ai][bj][m][1] * w); } }
    }
};
struct MoeOrder {
    int G, c, shift, NB; const LAS int* blkexp; const LAS int* blkstart; const LAS int* cntE; const int* LIST;
    __device__ __forceinline__ bool next(int i, Unit& u) const {
        const long L = (long)i * G + c; if (L >= ((long)NB << shift)) return false;
        const int blk = (int)(L >> shift), tile = (int)(L & ((1 << shift) - 1)), e = blkexp[blk];
        u.pm = blk; u.pn = (e << shift) + tile; u.e = e; u.s0 = (blk - blkstart[e]) * 256; u.cnt = cntE[e]; return true;
    }
    __device__ __forceinline__ int arow(const Unit& u, int r) const { const int slot = u.s0 + r; const int entry = slot < u.cnt ? LIST[(size_t)u.e * CAP + slot] : 0; return entry >> 1; }
};

struct Ctx { LAS unsigned char* lds; int tid, lane, wave, vcu, G; };

__device__ __forceinline__ void transpose_item(const float* W, int K, int N, bf16_t* WT, int kb, int nb, int dst_row0, LAS float* scr, int lane) {
    const int k0 = 64 * kb, n0 = 32 * nb;
    float tv[32];
#pragma unroll
    for (int i = 0; i < 32; ++i) tv[i] = W[(size_t)(k0 + 2 * i + (lane >> 5)) * N + n0 + (lane & 31)];
#pragma unroll
    for (int i = 0; i < 32; ++i) scr[(2 * i + (lane >> 5)) * 33 + (lane & 31)] = tv[i];
    asm volatile("s_waitcnt lgkmcnt(0)" ::: "memory");
    const int c = lane & 7;
#pragma unroll
    for (int j = 0; j < 4; ++j) { const int n = (lane >> 3) + 8 * j; const LAS float* s = scr + (8 * c) * 33 + n;
        u32x4 o; o.x = cvt_pk_bf16(s[0 * 33], s[1 * 33]); o.y = cvt_pk_bf16(s[2 * 33], s[3 * 33]); o.z = cvt_pk_bf16(s[4 * 33], s[5 * 33]); o.w = cvt_pk_bf16(s[6 * 33], s[7 * 33]);
        *(u32x4*)(WT + (size_t)(dst_row0 + n) * K + k0 + 8 * c) = o; }
    asm volatile("s_waitcnt lgkmcnt(0)" ::: "memory");
}
__device__ __forceinline__ void ln_stats(f32x4 (&v)[8], float& mean, float& rstd) {
    float s = 0.f;
#pragma unroll
    for (int j = 0; j < 8; ++j) s += (v[j].x + v[j].y) + (v[j].z + v[j].w);
    mean = wave_sum(s) * (1.f / DM); float s2 = 0.f;
#pragma unroll
    for (int j = 0; j < 8; ++j) { const f32x4 d = v[j] - mean; s2 += (d.x * d.x + d.y * d.y) + (d.z * d.z + d.w * d.w); }
    rstd = 1.f / sqrtf(wave_sum(s2) * (1.f / DM) + LN_EPS);
}

__device__ __forceinline__ void p0_prologue(const Ctx& C, const float* const* in, unsigned char* ws) {
    LAS float* scr = (LAS float*)(C.lds + C.wave * 16384);
    const int gw = C.vcu * 8 + C.wave, NGW = C.G * 8;
    bf16_t* WinT = (bf16_t*)(ws + WS_WIN); bf16_t* WgluT = (bf16_t*)(ws + WS_WGLU); bf16_t* WbsT = (bf16_t*)(ws + WS_WBS); bf16_t* WbaT = (bf16_t*)(ws + WS_WBA);
    bf16_t* WoT = (bf16_t*)(ws + WS_WO); bf16_t* WupT = (bf16_t*)(ws + WS_WUP);
    constexpr int I_WIN = (DM / 64) * (INC / 32), I_GLU = (SSMW / 64) * (SSMW / 32), I_BS = (SSMW / 64) * (DM / 32), I_BA = (AW / 64) * (DM / 32), I_WO = (DM / 64) * (DM / 32);
    constexpr int I_EXP = NE * 512;
    constexpr int NITEMS = I_WIN + I_GLU + I_BS + I_BA + I_WO + 2 * I_EXP;
    for (int it = gw; it < NITEMS; it += NGW) {
        int r = it;
        if (r < I_WIN) { const int nblk = INC / 32, nb = r % nblk, n0 = 32 * nb;
            const int drow = n0 < 3584 ? n0 : (n0 < 5632 ? 3584 + ((n0 - 3584) >> 7) * 256 + ((n0 - 3584) & 127) : 3584 + ((n0 - 5632) >> 7) * 256 + 128 + ((n0 - 5632) & 127));
            transpose_item(in[4], DM, INC, WinT, r / nblk, nb, drow, scr, C.lane); continue; } r -= I_WIN;
        if (r < I_GLU) { const int nblk = SSMW / 32; transpose_item(in[13], SSMW, SSMW, WgluT, r / nblk, r % nblk, 32 * (r % nblk), scr, C.lane); continue; } r -= I_GLU;
        if (r < I_BS) { const int nblk = DM / 32; transpose_item(in[19], SSMW, DM, WbsT, r / nblk, r % nblk, 32 * (r % nblk), scr, C.lane); continue; } r -= I_BS;
        if (r < I_BA) { const int nblk = DM / 32; transpose_item(in[20], AW, DM, WbaT, r / nblk, r % nblk, 32 * (r % nblk), scr, C.lane); continue; } r -= I_BA;
        if (r < I_WO) { const int nblk = DM / 32; transpose_item(in[21], DM, DM, WoT, r / nblk, r % nblk, 32 * (r % nblk), scr, C.lane); continue; } r -= I_WO;
        if (r < 2 * I_EXP) { const int up = r >= I_EXP ? 1 : 0; r -= up * I_EXP; const int e = r >> 9, rr = r & 511, kb = rr >> 4, nb = rr & 15, n0 = 32 * nb;
            transpose_item(in[28 + up] + (size_t)e * DM * DFF, DM, DFF, WupT, kb, nb, e * 1024 + (n0 >> 7) * 256 + up * 128 + (n0 & 127), scr, C.lane); continue; }
    }
    const int gt = C.vcu * 512 + C.tid, NGT = C.G * 512;
    { float* WrT = (float*)(ws + WS_WRT);
      for (int i = gt; i < 36 * DM; i += NGT) { const int n = i / DM, k = i % DM; WrT[i] = n < 4 ? in[24][k * 4 + n] : in[26][k * 32 + (n - 4)]; } }
    { u32x4* kz = (u32x4*)(ws + WS_KMETA + 16 * 1024 * 2); u32x4* vz = (u32x4*)(ws + WS_VMETA + 16 * 1024 * 2);
      for (int i = gt; i < 48 * 1024 * 2 / 16; i += NGT) { kz[i] = (u32x4){0u, 0u, 0u, 0u}; vz[i] = (u32x4){0u, 0u, 0u, 0u}; } }
    { float* AB = (float*)(ws + WS_SSMAB); float* BB = (float*)(ws + WS_SSMBB);
      for (int i = gt; i < NGRP * NST; i += NGT) { const int g = i >> 6;
        const double lre = fmin((double)in[5][i], -1e-4), lim = (double)in[6][i], dt = exp((double)in[7][g]);
        const double mag = exp(lre * dt), abr = mag * cos(lim * dt), abi = mag * sin(lim * dt), den = lre * lre + lim * lim, nr = abr - 1.0, ni = abi;
        const double zr = (nr * lre + ni * lim) / den, zi = (ni * lre - nr * lim) / den;
        AB[i] = (float)abr; AB[NGRP * NST + i] = (float)abi;
#pragma unroll 4
        for (int c = 0; c < 16; ++c) { const double br = (double)in[8][i * 16 + c], bi = (double)in[9][i * 16 + c];
            BB[i * 16 + c] = (float)(zr * br - zi * bi); BB[NGRP * NST * 16 + i * 16 + c] = (float)(zr * bi + zi * br); } } }
    const float* lg = in[2]; const float* lb = in[3];
    bf16_t* HBF = (bf16_t*)(ws + WS_HBF);
    for (int m = gw; m < T + NMETA; m += 2 * NGW) {
        const int m2 = (m + NGW < T + NMETA) ? m + NGW : m;
        const float* xa = m >= T ? in[1] + (size_t)(m - T) * DM : in[0] + (size_t)m * DM; const float* xb = m2 >= T ? in[1] + (size_t)(m2 - T) * DM : in[0] + (size_t)m2 * DM;
        f32x4 va[8], vb[8];
#pragma unroll
        for (int j = 0; j < 8; ++j) { va[j] = *(const f32x4*)(xa + 256 * j + 4 * C.lane); vb[j] = *(const f32x4*)(xb + 256 * j + 4 * C.lane); }
        float meana, rstda, meanb, rstdb; ln_stats(va, meana, rstda); ln_stats(vb, meanb, rstdb);
#pragma unroll
        for (int rr = 0; rr < 2; ++rr) { const int mm = rr ? m2 : m; if (rr == 1 && m2 == m) break; const bool meta = mm >= T;
#pragma unroll
            for (int j = 0; j < 8; ++j) { const f32x4 gg = *(const f32x4*)(lg + 256 * j + 4 * C.lane), bb = *(const f32x4*)(lb + 256 * j + 4 * C.lane);
                const f32x4 o = rr ? (vb[j] - meanb) * rstdb * gg + bb : (va[j] - meana) * rstda * gg + bb;
                if (meta) *(f32x4*)((float*)(ws + WS_HMETA) + (size_t)(mm - T) * DM + 256 * j + 4 * C.lane) = o;
                else { u32x2 w; w.x = cvt_pk_bf16(o.x, o.y); w.y = cvt_pk_bf16(o.z, o.w); *(u32x2*)(HBF + (size_t)mm * DM + 256 * j + 4 * C.lane) = w; } } }
    }
}

__device__ __forceinline__ void p1_meta_proj(const Ctx& C, unsigned char* ws) {
    const bf16_t* WinT = (const bf16_t*)(ws + WS_WIN); const float* HM = (const float*)(ws + WS_HMETA);
    const int gw = C.vcu * 8 + C.wave, NGW = C.G * 8;
    for (int it = gw; it < 640; it += NGW) {
        const int nidx = 4 * it; const int col0 = nidx < 512 ? nidx : (nidx < 1536 ? 1536 + (nidx - 512) : 2560 + (nidx - 1536));
        float acc[16][4];
#pragma unroll
        for (int r = 0; r < 16; ++r)
#pragma unroll
            for (int c = 0; c < 4; ++c) acc[r][c] = 0.f;
#pragma unroll 1
        for (int j = 0; j < 4; ++j) { const int k0 = j * 512 + C.lane * 8;
            f32x4 w0[4], w1[4];
#pragma unroll
            for (int c = 0; c < 4; ++c) { const u32x4 ww = *(const u32x4*)(WinT + (size_t)(col0 + c) * DM + k0); unpack8(ww, w0[c], w1[c]); }
#pragma unroll
            for (int r = 0; r < 16; ++r) { const f32x4 h0 = *(const f32x4*)(HM + r * DM + k0), h1 = *(const f32x4*)(HM + r * DM + k0 + 4);
#pragma unroll
                for (int c = 0; c < 4; ++c) { const f32x4 p = h0 * w0[c] + h1 * w1[c]; acc[r][c] += (p.x + p.y) + (p.z + p.w); } } }
        float mine = 0.f;
#pragma unroll
        for (int r = 0; r < 16; ++r)
#pragma unroll
            for (int c = 0; c < 4; ++c) { const float s = wave_sum(acc[r][c]); mine = (C.lane == r * 4 + c) ? s : mine; }
        const int r = C.lane >> 2, c = C.lane & 3;
        if (nidx < 512) ((float*)(ws + WS_UMETA))[r * SSMW + nidx + c] = mine;
        else if (nidx < 1536) ((bf16_t*)(ws + WS_KMETA))[r * AW + (nidx - 512) + c] = (bf16_t)(cvt_pk_bf16(mine, 0.f) & 0xffffu);
        else ((bf16_t*)(ws + WS_VMETA))[r * AW + (nidx - 1536) + c] = (bf16_t)(cvt_pk_bf16(mine, 0.f) & 0xffffu);
    }
}

__device__ __forceinline__ float gelu_tanh(float x) { const float u = 1.5957691216057308f * (x + 0.044715f * x * x * x); return x * __builtin_amdgcn_rcpf(1.0f + __expf(-u)); }
template <bool STORE> __device__ __forceinline__ void scan16(f32x16 (&bu)[4], float (&sre)[2], float (&sim)[2], const float (&are)[2], const float (&aim)[2]) {
#pragma unroll
    for (int reg = 0; reg < 16; ++reg)
#pragma unroll
        for (int st = 0; st < 2; ++st) {
            const float nre = __builtin_fmaf(are[st], sre[st], __builtin_fmaf(-aim[st], sim[st], bu[st][reg]));
            const float nim = __builtin_fmaf(are[st], sim[st], __builtin_fmaf(aim[st], sre[st], bu[2 + st][reg]));
            sre[st] = nre; sim[st] = nim;
            if (STORE) { bu[st][reg] = nre; bu[2 + st][reg] = nim; } }
}
__device__ __forceinline__ void p2_scan(const Ctx& C, const float* const* in, unsigned char* ws) {
    const int lane = C.lane, wave = C.wave, r32 = lane & 31, hi = lane >> 5, fr = lane & 15, fq = lane >> 4;
    const bf16_t* U = (const bf16_t*)(ws + WS_U); const float* UM = (const float*)(ws + WS_UMETA); bf16_t* YPRE = (bf16_t*)(ws + WS_YPRE);
    const float* AB = (const float*)(ws + WS_SSMAB); const float* BB = (const float*)(ws + WS_SSMBB);
    LAS unsigned char* Sl = C.lds + wave * 10752;
    LAS unsigned char* Yl = Sl + 9728;
    LAS float* E = (LAS float*)(C.lds + 86016);
    const int hc = 2 * wave + hi;
    const int urow = ((r32 >> 2) & 1) * 128 + (r32 & 3) + 4 * (r32 >> 3);
    for (int item = C.vcu; item < NB_ * NGRP; item += C.G) {
        const int b = item >> 5, g = item & 31;
        const bf16_t* Ub = U + ((size_t)b * SEQ + wave * 256) * SSMW + 16 * g;
        bf16x8 ufa[8];
#pragma unroll
        for (int blk = 0; blk < 8; ++blk) ufa[blk] = *(const bf16x8*)(Ub + (size_t)(16 * blk + urow) * SSMW + 8 * hi);
        float are[2], aim[2];
#pragma unroll
        for (int st = 0; st < 2; ++st) { are[st] = AB[g * 64 + 32 * st + r32]; aim[st] = AB[NGRP * NST + g * 64 + 32 * st + r32]; }
        bf16x8 Bf[4];
#pragma unroll
        for (int ri = 0; ri < 2; ++ri)
#pragma unroll
            for (int st = 0; st < 2; ++st) { const float* src = BB + ri * (NGRP * NST * 16) + (g * 64 + 32 * st + r32) * 16 + 8 * hi;
                const f32x4 x0 = *(const f32x4*)src, x1 = *(const f32x4*)(src + 4); Bf[2 * ri + st] = __builtin_bit_cast(bf16x8, pack8(x0, x1)); }
        bf16x8 Cf[5];
#pragma unroll
        for (int ks = 0; ks < 4; ++ks) { const int r0 = 8 * ks + 2 * fq; const float* cre = in[10] + (g * 16 + fr) * 64; const float* cim = in[11] + (g * 16 + fr) * 64;
            const f32x4 x0 = (f32x4){cre[r0], cre[32 + r0], -cim[r0], -cim[32 + r0]}, x1 = (f32x4){cre[r0 + 1], cre[33 + r0], -cim[r0 + 1], -cim[33 + r0]};
            Cf[ks] = __builtin_bit_cast(bf16x8, pack8(x0, x1)); }
        { const float dsk = in[12][g * 16 + fr]; f32x4 x0, x1;
#pragma unroll
          for (int j = 0; j < 4; ++j) { x0[j] = (fq < 2 && 8 * fq + j == fr) ? dsk : 0.f; x1[j] = (fq < 2 && 8 * fq + 4 + j == fr) ? dsk : 0.f; }
          Cf[4] = __builtin_bit_cast(bf16x8, pack8(x0, x1)); }
        float sre[2] = {0.f, 0.f}, sim[2] = {0.f, 0.f}, mre[2] = {0.f, 0.f}, mim[2] = {0.f, 0.f};
        if (wave == 0) {
            f32x4 x0 = (f32x4){0.f, 0.f, 0.f, 0.f}, x1 = x0;
            if (((r32 >> 2) & 1) == 0) { const float* src = UM + ((r32 & 3) + 4 * (r32 >> 3)) * SSMW + 16 * g + 8 * hi; x0 = *(const f32x4*)src; x1 = *(const f32x4*)(src + 4); }
            const bf16x8 uf = __builtin_bit_cast(bf16x8, pack8(x0, x1));
            f32x16 bu[4];
#pragma unroll
            for (int t = 0; t < 4; ++t) bu[t] = __builtin_amdgcn_mfma_f32_32x32x16_bf16(uf, Bf[t], (f32x16){}, 0, 0, 0);
            scan16<false>(bu, sre, sim, are, aim);
            mre[0] = sre[0]; mre[1] = sre[1]; mim[0] = sim[0]; mim[1] = sim[1];
        }
#pragma unroll
        for (int blk = 0; blk < 8; ++blk) {
            f32x16 bu[4];
#pragma unroll
            for (int t = 0; t < 4; ++t) bu[t] = __builtin_amdgcn_mfma_f32_32x32x16_bf16(ufa[blk], Bf[t], (f32x16){}, 0, 0, 0);
            scan16<false>(bu, sre, sim, are, aim);
        }
#pragma unroll
        for (int st = 0; st < 2; ++st) { E[hc * 128 + st * 64 + r32] = sre[st]; E[hc * 128 + st * 64 + 32 + r32] = sim[st]; }
        __syncthreads();
        {
            float pr[2], pi[2], cr[2], ci[2];
#pragma unroll
            for (int st = 0; st < 2; ++st) { pr[st] = are[st]; pi[st] = aim[st];
#pragma unroll
                for (int k = 0; k < 7; ++k) { const float nr = pr[st] * pr[st] - pi[st] * pi[st], ni = 2.f * pr[st] * pi[st]; pr[st] = nr; pi[st] = ni; }
                cr[st] = E[st * 64 + r32]; ci[st] = E[st * 64 + 32 + r32]; }
            for (int j = 1; j < 2 * wave + 1; ++j) {
                const bool on = j < hc;
#pragma unroll
                for (int st = 0; st < 2; ++st) { const float er = E[j * 128 + st * 64 + r32], ei = E[j * 128 + st * 64 + 32 + r32];
                    const float nr = pr[st] * cr[st] - pi[st] * ci[st] + er, ni = pr[st] * ci[st] + pi[st] * cr[st] + ei; cr[st] = on ? nr : cr[st]; ci[st] = on ? ni : ci[st]; } }
#pragma unroll
            for (int st = 0; st < 2; ++st) { sre[st] = hc == 0 ? mre[st] : cr[st]; sim[st] = hc == 0 ? mim[st] : ci[st]; }
        }
#pragma unroll
        for (int blk = 0; blk < 8; ++blk) {
            f32x16 bu[4];
#pragma unroll
            for (int t = 0; t < 4; ++t) bu[t] = __builtin_amdgcn_mfma_f32_32x32x16_bf16(ufa[blk], Bf[t], (f32x16){}, 0, 0, 0);
            scan16<true>(bu, sre, sim, are, aim);
#pragma unroll
            for (int reg = 0; reg < 16; ++reg) { const int row = (reg & 3) + 8 * (reg >> 2) + 4 * hi;
                u32x2 w; w.x = cvt_pk_bf16(bu[0][reg], bu[1][reg]); w.y = cvt_pk_bf16(bu[2][reg], bu[3][reg]);
                *(LAS u32x2*)(Sl + row * 304 + r32 * 8) = w; }
            *(LAS bf16x8*)(Sl + r32 * 304 + (128 + 8 * hi) * 2) = ufa[blk];
            f32x4 y[2];
#pragma unroll
            for (int mt = 0; mt < 2; ++mt) { y[mt] = (f32x4){0.f, 0.f, 0.f, 0.f};
#pragma unroll
                for (int ks = 0; ks < 4; ++ks) { const bf16x8 af = *(const LAS bf16x8*)(Sl + (16 * mt + fr) * 304 + (32 * ks + 8 * fq) * 2);
                    y[mt] = __builtin_amdgcn_mfma_f32_16x16x32_bf16(af, Cf[ks], y[mt], 0, 0, 0); }
                bf16x8 au = *(const LAS bf16x8*)(Sl + (16 * mt + fr) * 304 + (128 + 8 * (fq & 1)) * 2); if (fq >= 2) au = (bf16x8){};
                y[mt] = __builtin_amdgcn_mfma_f32_16x16x32_bf16(au, Cf[4], y[mt], 0, 0, 0); }
#pragma unroll
            for (int mt = 0; mt < 2; ++mt)
#pragma unroll
                for (int reg = 0; reg < 4; ++reg) *(LAS bf16_t*)(Yl + (16 * mt + 4 * fq + reg) * 32 + fr * 2) = (bf16_t)(cvt_pk_bf16(gelu_tanh(y[mt][reg]), 0.f) & 0xffffu);
            const u32x4 yo = *(const LAS u32x4*)(Yl + (lane >> 1) * 32 + (lane & 1) * 16);
            { const int row = lane >> 1, tok = ((row >> 2) & 1) * 128 + 16 * blk + (row & 3) + 4 * (row >> 3);
              *(u32x4*)(YPRE + ((size_t)b * SEQ + wave * 256 + tok) * SSMW + 16 * g + 8 * (lane & 1)) = yo; }
        }
        __syncthreads();
    }
}

__device__ __forceinline__ int crow(int r, int hi) { return (r & 3) + 8 * (r >> 2) + 4 * hi; }
typedef short v4i16_t __attribute__((ext_vector_type(4)));
__device__ __forceinline__ s16x4 vtr(const LAS unsigned char* p) { return __builtin_bit_cast(s16x4, __builtin_amdgcn_ds_read_tr16_b64_v4i16((LAS v4i16_t*)p)); }
__device__ __forceinline__ float half_swap_max(float x) { auto rr = __builtin_amdgcn_permlane32_swap(__float_as_uint(x), __float_as_uint(x), false, false); return fmaxf(__uint_as_float(rr[0]), __uint_as_float(rr[1])); }
__device__ __forceinline__ float half_swap_sum(float x) { auto rr = __builtin_amdgcn_permlane32_swap(__float_as_uint(x), __float_as_uint(x), false, false); return __uint_as_float(rr[0]) + __uint_as_float(rr[1]); }

__device__ __forceinline__ void attn_pv(f32x16 (&o)[4], const bf16x8 (&pa)[4], unsigned vaddr) {
    s16x4 vl[2][4], vh[2][4];
#define ATT_VRD(SET, D) do { _Pragma("unroll") for (int ks_ = 0; ks_ < 4; ++ks_) { \
        asm volatile("ds_read_b64_tr_b16 %0, %1 offset:%2" : "=&v"(vl[SET][ks_]) : "v"(vaddr), "i"((D) * 4096 + ks_ * 1024) : "memory"); \
        asm volatile("ds_read_b64_tr_b16 %0, %1 offset:%2" : "=&v"(vh[SET][ks_]) : "v"(vaddr), "i"((D) * 4096 + ks_ * 1024 + 512) : "memory"); } } while (0)
    __builtin_amdgcn_sched_barrier(0);
    ATT_VRD(0, 0);
#pragma unroll
    for (int d = 0; d < 4; ++d) {
        if (d == 0) { ATT_VRD(1, 1); } else if (d == 1) { ATT_VRD(0, 2); } else if (d == 2) { ATT_VRD(1, 3); }
        if (d < 3) asm volatile("s_waitcnt lgkmcnt(8)" ::: "memory"); else asm volatile("s_waitcnt lgkmcnt(0)" ::: "memory");
        __builtin_amdgcn_sched_barrier(0);
        __builtin_amdgcn_s_setprio(1);
#pragma unroll
        for (int ks = 0; ks < 4; ++ks) { const s16x4 lo = vl[d & 1][ks], hv = vh[d & 1][ks];
            const bf16x8 vf = (bf16x8){lo[0], lo[1], lo[2], lo[3], hv[0], hv[1], hv[2], hv[3]};
            o[d] = __builtin_amdgcn_mfma_f32_32x32x16_bf16(pa[ks], vf, o[d], 0, 0, 0); }
        __builtin_amdgcn_s_setprio(0);
        __builtin_amdgcn_sched_barrier(0);
    }
#undef ATT_VRD
}
__device__ __forceinline__ void attn_qk(f32x16& p0, f32x16& p1, const LAS unsigned char* kb, const bf16x8 (&qr)[4]) {
    p0 = (f32x16){}; p1 = (f32x16){};
    __builtin_amdgcn_s_setprio(1);
#pragma unroll
    for (int d0 = 0; d0 < 4; ++d0) { const bf16x8 b0 = *(const LAS bf16x8*)(kb + d0 * 2048), b1 = *(const LAS bf16x8*)(kb + d0 * 2048 + 512);
        p0 = __builtin_amdgcn_mfma_f32_32x32x16_bf16(b0, qr[d0], p0, 0, 0, 0); p1 = __builtin_amdgcn_mfma_f32_32x32x16_bf16(b1, qr[d0], p1, 0, 0, 0); }
    __builtin_amdgcn_s_setprio(0);
}
__device__ __forceinline__ void attn_softmax(const bool FIRST, f32x16& p0, f32x16& p1, f32x16 (&o)[4], float& mrun, float& lrun, bf16x8 (&pa)[4], LAS float* wsf, int r32, int hi) {
    if (FIRST) {
        asm volatile("" ::: "memory");
#pragma unroll
        for (int r = 0; r < 16; ++r) { if (r >= 8) p0[r] = -__builtin_inff(); p1[r] = -__builtin_inff(); } }
    float rmA = fmaxf(p0[0], p0[1]), rmB = fmaxf(p0[2], p0[3]), rmC = fmaxf(p1[0], p1[1]), rmD = fmaxf(p1[2], p1[3]);
#pragma unroll
    for (int r = 4; r < 16; r += 4) { rmA = fmaxf(rmA, fmaxf(p0[r], p0[r + 1])); rmB = fmaxf(rmB, fmaxf(p0[r + 2], p0[r + 3])); rmC = fmaxf(rmC, fmaxf(p1[r], p1[r + 1])); rmD = fmaxf(rmD, fmaxf(p1[r + 2], p1[r + 3])); }
    const float rm = half_swap_max(fmaxf(fmaxf(rmA, rmB), fmaxf(rmC, rmD)));
    if (FIRST) mrun = rm;
    else if (__any(rm > mrun + 8.0f)) {
        const float mnew = fmaxf(mrun, rm), alpha = __builtin_amdgcn_exp2f(mrun - mnew);
        lrun *= alpha; mrun = mnew;
        if (hi == 0) wsf[r32] = alpha;
        f32x4 a4[4];
#pragma unroll
        for (int gq = 0; gq < 4; ++gq) a4[gq] = *(const LAS f32x4*)(wsf + 8 * gq + 4 * hi);
#pragma unroll
        for (int d = 0; d < 4; ++d)
#pragma unroll
            for (int r = 0; r < 16; ++r) o[d][r] *= a4[r >> 2][r & 3];
    }
    float psA = 0.f, psB = 0.f, psC = 0.f, psD = 0.f;
#pragma unroll
    for (int r = 0; r < 16; r += 2) { p0[r] = __builtin_amdgcn_exp2f(p0[r] - mrun); p0[r + 1] = __builtin_amdgcn_exp2f(p0[r + 1] - mrun); p1[r] = __builtin_amdgcn_exp2f(p1[r] - mrun); p1[r + 1] = __builtin_amdgcn_exp2f(p1[r + 1] - mrun);
        psA += p0[r]; psB += p0[r + 1]; psC += p1[r]; psD += p1[r + 1]; }
    lrun += (psA + psB) + (psC + psD);
    u32x4 w;
    w = (u32x4){cvt_pk_bf16(p0[0], p0[1]), cvt_pk_bf16(p0[2], p0[3]), cvt_pk_bf16(p0[4], p0[5]), cvt_pk_bf16(p0[6], p0[7])}; pa[0] = __builtin_bit_cast(bf16x8, w);
    w = (u32x4){cvt_pk_bf16(p0[8], p0[9]), cvt_pk_bf16(p0[10], p0[11]), cvt_pk_bf16(p0[12], p0[13]), cvt_pk_bf16(p0[14], p0[15])}; pa[1] = __builtin_bit_cast(bf16x8, w);
    w = (u32x4){cvt_pk_bf16(p1[0], p1[1]), cvt_pk_bf16(p1[2], p1[3]), cvt_pk_bf16(p1[4], p1[5]), cvt_pk_bf16(p1[6], p1[7])}; pa[2] = __builtin_bit_cast(bf16x8, w);
    w = (u32x4){cvt_pk_bf16(p1[8], p1[9]), cvt_pk_bf16(p1[10], p1[11]), cvt_pk_bf16(p1[12], p1[13]), cvt_pk_bf16(p1[14], p1[15])}; pa[3] = __builtin_bit_cast(bf16x8, w);
}
__device__ __forceinline__ void glds16(const void* gsrc, unsigned lds_dst) { unsigned keep;
    asm volatile("s_mov_b32 %0, m0\n\ts_mov_b32 m0, %2\n\ts_nop 0\n\tglobal_load_lds_dwordx4 %1, off\n\ts_mov_b32 m0, %0" : "=&s"(keep) : "v"(gsrc), "s"(lds_dst) : "memory"); }
__device__ __forceinline__ void attn_unit(const Ctx& C, const bf16_t* Qg, const bf16_t* Kg, const bf16_t* Vg, const bf16_t* KM, const bf16_t* VM, bf16_t* Y,
                                          const float* subg, float lam, int b, int h, int qt, bool prefetched, int nqt, bf16x8 (&qr)[4], bool rb) {
    LAS unsigned char* lds = C.lds;
    const int lane = C.lane, wave = C.wave, r32 = lane & 31, hi = lane >> 5, qb = wave >> 1, map = wave & 1;
    const int q0 = qt * 128 + qb * 32;
    const size_t rowb = (size_t)b * SEQ;
    if (!prefetched) { const bf16_t* qp = Qg + (rowb + q0 + r32) * AW + h * 128 + map * 64 + hi * 8;
#pragma unroll
      for (int d0 = 0; d0 < 4; ++d0) qr[d0] = *(const bf16x8*)(qp + d0 * 16); }
    const int NT = 2 * qt + 3;
    const bool skip_last = (qb < 2);
    f32x16 o[4];
#pragma unroll
    for (int d = 0; d < 4; ++d) o[d] = (f32x16){};
    float mrun = -__builtin_inff(), lrun = 0.f;
    LAS float* wsf = (LAS float*)(lds + MISC_OFF + 4096 + wave * 256);
    const bf16_t* Kb = Kg + rowb * AW; const bf16_t* Vb = Vg + rowb * AW;
#define ATT_DMA(step, stage) do { const bf16_t* ks_ = (step) == 0 ? KM : Kb; const bf16_t* vs_ = (step) == 0 ? VM : Vb; const int row0_ = (step) == 0 ? 0 : ((step) - 1) * 64; \
    _Pragma("unroll") for (int i_ = 0; i_ < 2; ++i_) { const int p_ = 2 * wave + i_; \
        __builtin_amdgcn_global_load_lds((const unsigned*)(ks_ + (size_t)(row0_ + lane) * AW + h * 128 + (p_ >> 3) * 64 + (p_ & 7) * 8), (LAS unsigned*)(lds + (stage) * 32768 + p_ * 1024), 16, 0, 0); \
        __builtin_amdgcn_global_load_lds((const unsigned*)(vs_ + (size_t)(row0_ + 16 * (p_ & 3) + (lane >> 2)) * AW + h * 128 + (p_ >> 2) * 32 + (lane & 3) * 8), (LAS unsigned*)(lds + (stage) * 32768 + 16384 + p_ * 1024), 16, 0, 0); } } while (0)
    const int myNT = skip_last ? NT - 1 : NT;
    bf16x8 pa[4];
#pragma unroll
    for (int k = 0; k < 4; ++k) pa[k] = (bf16x8){};
    if (!prefetched) ATT_DMA(0, 0);
    asm volatile("s_waitcnt vmcnt(0)" ::: "memory"); __syncthreads();
    int stage = 0;
#pragma unroll 1
    for (int s = 0; s <= NT; ++s) {
        const int stn = stage == 2 ? 0 : stage + 1, stp = stage == 0 ? 2 : stage - 1;
        if (s + 1 < NT) ATT_DMA(s + 1, stn);
        if (rb && s >= 1 && s <= myNT) attn_pv(o, pa, (unsigned)(uintptr_t)(lds + stp * 32768 + 16384 + ((lane >> 4) & 1) * 32 + (lane & 3) * 8 + (4 * hi + ((lane & 15) >> 2)) * 64));
        if (s < myNT) {
            f32x16 p0, p1; attn_qk(p0, p1, lds + stage * 32768 + map * 8192 + hi * 1024 + r32 * 16, qr);
            attn_softmax(s == 0, p0, p1, o, mrun, lrun, pa, wsf, r32, hi);
            if (!rb) attn_pv(o, pa, (unsigned)(uintptr_t)(lds + stage * 32768 + 16384 + ((lane >> 4) & 1) * 32 + (lane & 3) * 8 + (4 * hi + ((lane & 15) >> 2)) * 64));
        }
        asm volatile("s_waitcnt vmcnt(0)" ::: "memory"); __syncthreads();
        stage = stn;
    }
#undef ATT_DMA
    bf16x8 qn[4];
#pragma unroll
    for (int d0 = 0; d0 < 4; ++d0) qn[d0] = qr[d0];
    if (nqt >= 0) {
        const unsigned lds0 = (unsigned)(uintptr_t)lds;
#pragma unroll
        for (int i = 0; i < 2; ++i) { const int p = 2 * wave + i;
            glds16(KM + (size_t)lane * AW + h * 128 + (p >> 3) * 64 + (p & 7) * 8, (unsigned)__builtin_amdgcn_readfirstlane(lds0 + p * 1024));
            glds16(VM + (size_t)(16 * (p & 3) + (lane >> 2)) * AW + h * 128 + (p >> 2) * 32 + (lane & 3) * 8, (unsigned)__builtin_amdgcn_readfirstlane(lds0 + 16384 + p * 1024)); }
        const bf16_t* qp = Qg + (rowb + nqt * 128 + qb * 32 + r32) * AW + h * 128 + map * 64 + hi * 8;
#pragma unroll
        for (int d0 = 0; d0 < 4; ++d0) qn[d0] = *(const bf16x8*)(qp + d0 * 16);
    }
    { const float ltot = half_swap_sum(lrun); const float inv = (map ? lam : 1.0f) / ltot;
      if (hi == 0) wsf[r32] = inv;
      f32x4 a4[4];
#pragma unroll
      for (int gq = 0; gq < 4; ++gq) a4[gq] = *(const LAS f32x4*)(wsf + 8 * gq + 4 * hi);
#pragma unroll
      for (int d = 0; d < 4; ++d)
#pragma unroll
          for (int r = 0; r < 16; ++r) o[d][r] *= a4[r >> 2][r & 3]; }
    LAS float* X = (LAS float*)(lds + 32768 + qb * 16384);
    if (map == 1) {
#pragma unroll
        for (int d = 0; d < 4; ++d)
#pragma unroll
            for (int r = 0; r < 16; ++r) X[crow(r, hi) * 128 + 32 * d + r32] = o[d][r];
    }
    __syncthreads();
    if (map == 0) {
        float ssq[16];
#pragma unroll
        for (int r = 0; r < 16; ++r) ssq[r] = 0.f;
#pragma unroll
        for (int d = 0; d < 4; ++d)
#pragma unroll
            for (int r = 0; r < 16; ++r) { const float v = o[d][r] - X[crow(r, hi) * 128 + 32 * d + r32]; o[d][r] = v; ssq[r] += v * v; }
#pragma unroll
        for (int r = 0; r < 16; ++r) {
            { float v = ssq[r]; v += dpp_f<0xB1>(v); v += dpp_f<0x4E>(v); v += dpp_f<0x141>(v); v += dpp_f<0x140>(v);
              auto r2 = __builtin_amdgcn_permlane16_swap(__float_as_uint(v), __float_as_uint(v), false, false); ssq[r] = __uint_as_float(r2[0]) + __uint_as_float(r2[1]); }
            ssq[r] = 0.8f / sqrtf(ssq[r] * (1.f / 128.f) + LN_EPS); }
        LAS bf16_t* Yt = (LAS bf16_t*)X;
#pragma unroll
        for (int d = 0; d < 4; ++d) { const float gg = subg[32 * d + r32];
#pragma unroll
            for (int r = 0; r < 16; ++r) Yt[crow(r, hi) * 128 + 32 * d + r32] = (bf16_t)(cvt_pk_bf16(o[d][r] * ssq[r] * gg, 0.f) & 0xffffu); }
#pragma unroll
        for (int i = 0; i < 8; ++i) { const int id = i * 64 + lane, row = id >> 4, ch = id & 15;
            *(u32x4*)(Y + (rowb + q0 + row) * AW + h * 128 + ch * 8) = *(const LAS u32x4*)(Yt + row * 128 + ch * 8); }
    }
#pragma unroll
    for (int d0 = 0; d0 < 4; ++d0) qr[d0] = qn[d0];
    __syncthreads();
}
__device__ __forceinline__ void p3_attention(const Ctx& C, const float* const* in, unsigned char* ws) {
    const bf16_t* Q = (const bf16_t*)(ws + WS_Q); const bf16_t* K = (const bf16_t*)(ws + WS_K); const bf16_t* V = (const bf16_t*)(ws + WS_V);
    const bf16_t* KM = (const bf16_t*)(ws + WS_KMETA); const bf16_t* VM = (const bf16_t*)(ws + WS_VMETA); bf16_t* Y = (bf16_t*)(ws + WS_YATT);
    const float l1 = wave_sum(in[14][C.lane] * in[15][C.lane]), l2 = wave_sum(in[16][C.lane] * in[17][C.lane]);
    const float lam = expf(l1) - expf(l2) + 0.2f;
    LAS unsigned* rc = (LAS unsigned*)(C.lds + MISC_OFF + 6144);
    if (C.tid < 4) rc[C.tid] = 0;
    __syncthreads();
    bool rb;
    { const unsigned simd = (unsigned)__builtin_amdgcn_s_getreg(2308) & 3u;
      unsigned r = 0; if (C.lane == 0) r = __hip_atomic_fetch_add(rc + simd, 1u, __ATOMIC_RELAXED, __HIP_MEMORY_SCOPE_WORKGROUP);
      rb = (__builtin_amdgcn_readfirstlane((int)r) & 1) != 0; }
#ifndef ATT_REP
#define ATT_REP 1
#endif
    for (int vv = C.vcu; vv < 256 * ATT_REP; vv += C.G) { const int v = vv & 255;
        const int bh = v >> 1, sft = v & 1;
        bf16x8 qr[4];
#pragma unroll
        for (int d0 = 0; d0 < 4; ++d0) qr[d0] = (bf16x8){};
#pragma unroll 1
        for (int i = 0; i < 8; ++i) { const int qt = (i & 1) ? (15 - sft - (i & ~1)) : (sft + (i & ~1)); const int i1 = i + 1;
            const int nqt = i1 < 8 ? ((i1 & 1) ? (15 - sft - (i1 & ~1)) : (sft + (i1 & ~1))) : -1;
            attn_unit(C, Q, K, V, KM, VM, Y, in[18], lam, bh >> 3, bh & 7, qt, i > 0, nqt, qr, rb); }
    }
}

__device__ __forceinline__ void p6_ln1_router(const Ctx& C, const float* const* in, unsigned char* ws) {
    const int lane = C.lane, wave = C.wave, tid = C.tid;
    const bf16_t* Z = (const bf16_t*)(ws + WS_Z); bf16_t* H1 = (bf16_t*)(ws + WS_H1); const float* WrT = (const float*)(ws + WS_WRT);
    int* LIST = (int*)(ws + WS_LIST); float* WGT = (float*)(ws + WS_WGT); unsigned* ECNT = (unsigned*)(ws + WS_CTL) + CW_ECNT;
    const float* lg = in[22]; const float* lb = in[23];
    LAS float* WB = (LAS float*)C.lds;
    LAS unsigned char* XB = C.lds + 98304;
    LAS int* RE = (LAS int*)(XB);
    LAS float* RW = (LAS float*)(XB + 1024);
    LAS int* CL = (LAS int*)(XB + 2048);
    LAS int* BS = (LAS int*)(XB + 2048 + 128);
    LAS int* SL = (LAS int*)(XB + 2048 + 256);
    LAS float* LG = (LAS float*)(XB + 4096) + wave * 160;
    for (int rbk = C.vcu; rbk < T / 128; rbk += C.G) {
        if (tid < 32) CL[tid] = 0;
#pragma unroll 1
        for (int step = 0; step < 4; ++step) {
            const int lr0 = step * 32 + 4 * wave; const size_t row0 = (size_t)rbk * 128 + lr0;
            int l4 = 4 * lane; asm volatile("" : "+v"(l4));
            f32x4 v[4][8];
#pragma unroll
            for (int rr = 0; rr < 4; ++rr)
#pragma unroll
                for (int j = 0; j < 8; ++j) { const u32x2 z0 = *(const u32x2*)(Z + (row0 + rr) * DM + 256 * j + l4);
                    v[rr][j] = (f32x4){bf_lo(z0.x), bf_hi(z0.x), bf_lo(z0.y), bf_hi(z0.y)}; }
#pragma unroll
            for (int rr = 0; rr < 4; ++rr) { float mean, rstd; ln_stats(v[rr], mean, rstd);
#pragma unroll
                for (int j = 0; j < 8; ++j) { const f32x4 gg = *(const f32x4*)(lg + 256 * j + l4), bb = *(const f32x4*)(lb + 256 * j + l4);
                    v[rr][j] = (v[rr][j] - mean) * rstd * gg + bb;
                    u32x2 w; w.x = cvt_pk_bf16(v[rr][j].x, v[rr][j].y); w.y = cvt_pk_bf16(v[rr][j].z, v[rr][j].w); *(u32x2*)(H1 + (row0 + rr) * DM + 256 * j + l4) = w; } }
#pragma unroll 1
            for (int ng = 0; ng < 3; ++ng) {
                __syncthreads();
                int tq = tid; asm volatile("" : "+v"(tq));
#pragma unroll
                for (int i = 0; i < 12; ++i) { const int idx = tq + 512 * i, n = idx >> 9, c4 = idx & 511;
                    *(LAS f32x4*)(WB + n * 2048 + 4 * c4) = *(const f32x4*)(WrT + (size_t)(12 * ng + n) * DM + 4 * c4); }
                __syncthreads();
#pragma unroll 1
                for (int q = 0; q < 6; ++q) {
                    f32x4 qa[4], qb[4];
#pragma unroll
                    for (int rr = 0; rr < 4; ++rr) { qa[rr] = (f32x4){0.f, 0.f, 0.f, 0.f}; qb[rr] = qa[rr]; }
#pragma unroll
                    for (int j = 0; j < 8; ++j) { const f32x4 w4 = *(const LAS f32x4*)(WB + (2 * q) * 2048 + 256 * j + l4), x4 = *(const LAS f32x4*)(WB + (2 * q + 1) * 2048 + 256 * j + l4);
#pragma unroll
                        for (int rr = 0; rr < 4; ++rr) { qa[rr] = v[rr][j] * w4 + qa[rr]; qb[rr] = v[rr][j] * x4 + qb[rr]; } }
                    float pa[4], pb[4];
#pragma unroll
                    for (int rr = 0; rr < 4; ++rr) { pa[rr] = (qa[rr].x + qa[rr].y) + (qa[rr].z + qa[rr].w); pb[rr] = (qb[rr].x + qb[rr].y) + (qb[rr].z + qb[rr].w); }
#pragma unroll
                    for (int pr = 0; pr < 2; ++pr) {
                        auto h0 = __builtin_amdgcn_permlane32_swap(__float_as_uint(pa[2 * pr]), __float_as_uint(pa[2 * pr + 1]), false, false); const float w0 = __uint_as_float(h0[0]) + __uint_as_float(h0[1]);
                        auto h1 = __builtin_amdgcn_permlane32_swap(__float_as_uint(pb[2 * pr]), __float_as_uint(pb[2 * pr + 1]), false, false); const float w1 = __uint_as_float(h1[0]) + __uint_as_float(h1[1]);
                        auto h2 = __builtin_amdgcn_permlane16_swap(__float_as_uint(w0), __float_as_uint(w1), false, false); float z = __uint_as_float(h2[0]) + __uint_as_float(h2[1]);
                        z += dpp_f<0xB1>(z); z += dpp_f<0x4E>(z); z += dpp_f<0x141>(z); z += dpp_f<0x140>(z);
                        if ((lane & 15) == 0) LG[(2 * pr + (lane >> 5)) * 40 + 12 * ng + 2 * q + ((lane >> 4) & 1)] = z; } }
            }
            if (lane < 4) {
                const LAS float* L = LG + 40 * lane;
                int gi = 0; float gm = L[0] + in[25][0];
                for (int n = 1; n < 4; ++n) { const float x = L[n] + in[25][n]; if (x > gm) { gm = x; gi = n; } }
                float gs = 0.f;
                for (int n = 0; n < 4; ++n) gs += __expf(L[n] + in[25][n] - gm);
                const float gval = 1.0f / gs;
                int i1 = 0; float m1 = L[4 + gi * 8] + in[27][gi * 8];
                for (int j = 1; j < 8; ++j) { const float x = L[4 + gi * 8 + j] + in[27][gi * 8 + j]; if (x > m1) { m1 = x; i1 = j; } }
                int i2 = -1; float m2 = -__builtin_inff();
                for (int j = 0; j < 8; ++j) { const float x = L[4 + gi * 8 + j] + in[27][gi * 8 + j]; if (j != i1 && x > m2) { m2 = x; i2 = j; } }
                const float tt = __expf(m2 - m1), w1 = gval / (1.f + tt), w2 = gval * tt / (1.f + tt);
                const int lr = lr0 + lane; RE[lr * 2] = gi * 8 + i1; RE[lr * 2 + 1] = gi * 8 + i2; RW[lr * 2] = w1; RW[lr * 2 + 1] = w2;
            }
        }
        __syncthreads();
        int e = 0;
        if (tid < 256) { e = RE[tid]; SL[tid] = __hip_atomic_fetch_add(&CL[e], 1, __ATOMIC_RELAXED, __HIP_MEMORY_SCOPE_WORKGROUP); }
        __syncthreads();
        if (tid < 32) BS[tid] = (int)__hip_atomic_fetch_add(&ECNT[tid], (unsigned)CL[tid], __ATOMIC_RELAXED, __HIP_MEMORY_SCOPE_AGENT);
        __syncthreads();
        if (tid < 256) { const int entry = (rbk * 128 + (tid >> 1)) * 2 + (tid & 1); LIST[(size_t)e * CAP + BS[e] + SL[tid]] = entry; WGT[entry] = RW[tid]; }
        __syncthreads();
    }
}

__device__ __forceinline__ void p9_ln2(const Ctx& C, const float* const* in, unsigned char* ws, float* out) {
    const bf16_t* H1 = (const bf16_t*)(ws + WS_H1); const bf16_t* YK = (const bf16_t*)(ws + WS_YK);
    const float* lg = in[31]; const float* lb = in[32];
    const int gw = C.vcu * 8 + C.wave, NGW = C.G * 8, lane = C.lane;
    for (int m = gw; m < T; m += 2 * NGW) {
        const int m2 = (m + NGW < T) ? m + NGW : m;
        u32x2 ha[8], ya0[8], ya1[8], hb[8], yb0[8], yb1[8];
#pragma unroll
        for (int j = 0; j < 8; ++j) { const size_t c = 256 * j + 4 * lane;
            ha[j] = *(const u32x2*)(H1 + (size_t)m * DM + c); ya0[j] = *(const u32x2*)(YK + (size_t)(2 * m) * DM + c); ya1[j] = *(const u32x2*)(YK + (size_t)(2 * m + 1) * DM + c);
            hb[j] = *(const u32x2*)(H1 + (size_t)m2 * DM + c); yb0[j] = *(const u32x2*)(YK + (size_t)(2 * m2) * DM + c); yb1[j] = *(const u32x2*)(YK + (size_t)(2 * m2 + 1) * DM + c); }
#pragma unroll
        for (int rr = 0; rr < 2; ++rr) {
            f32x4 v[8];
#pragma unroll
            for (int j = 0; j < 8; ++j) { const u32x2 hw = rr ? hb[j] : ha[j], y0 = rr ? yb0[j] : ya0[j], y1 = rr ? yb1[j] : ya1[j];
                v[j] = (f32x4){bf_lo(hw.x), bf_hi(hw.x), bf_lo(hw.y), bf_hi(hw.y)} * ALPHA + (f32x4){bf_lo(y0.x), bf_hi(y0.x), bf_lo(y0.y), bf_hi(y0.y)} + (f32x4){bf_lo(y1.x), bf_hi(y1.x), bf_lo(y1.y), bf_hi(y1.y)}; }
            float mean, rstd; ln_stats(v, mean, rstd);
            const int mm = rr ? m2 : m;
            if (rr == 0 || m2 != m) {
#pragma unroll
                for (int j = 0; j < 8; ++j) { const f32x4 gg = *(const f32x4*)(lg + 256 * j + 4 * lane), bb = *(const f32x4*)(lb + 256 * j + 4 * lane);
                    *(f32x4*)(out + (size_t)mm * DM + 256 * j + 4 * lane) = (v[j] - mean) * rstd * gg + bb; } }
        }
    }
}

__device__ __forceinline__ int build_moe_tables(const Ctx& C, unsigned char* ws) {
    LAS int* blkstart = (LAS int*)(C.lds + MISC_OFF + 64); LAS int* cntE = (LAS int*)(C.lds + MISC_OFF + 320); LAS int* blkexp = (LAS int*)(C.lds + MISC_OFF + 512);
    unsigned* ECNT = (unsigned*)(ws + WS_CTL) + CW_ECNT;
    __syncthreads();
    if (C.tid < 32) cntE[C.tid] = (int)__hip_atomic_load(&ECNT[C.tid], __ATOMIC_RELAXED, __HIP_MEMORY_SCOPE_AGENT);
    __syncthreads();
    if (C.tid == 0) { int s = 0; for (int e = 0; e < NE; ++e) { blkstart[e] = s; s += (cntE[e] + 255) >> 8; } blkstart[NE] = s; }
    __syncthreads();
    const int NBLK = blkstart[NE];
    if (C.tid < NBLK && C.tid < 320) { int e = 0; for (int j = 1; j < NE; ++j) if (blkstart[j] <= C.tid) e = j; blkexp[C.tid] = e; }
    __syncthreads();
    return NBLK < 320 ? NBLK : 320;
}

__device__ __forceinline__ void p7_convert_down(const Ctx& C, const float* const* in, unsigned char* ws) {
    LAS float* scr = (LAS float*)(C.lds + C.wave * 16384);
    unsigned* ctr = (unsigned*)(ws + WS_CTL) + CW_CONV; bf16_t* WdnT = (bf16_t*)(ws + WS_WDN);
    constexpr int NCH = NE * 512 / 16;
    for (;;) {
        unsigned ch = 0; if (C.lane == 0) ch = __hip_atomic_fetch_add(ctr, 1u, __ATOMIC_RELAXED, __HIP_MEMORY_SCOPE_AGENT);
        ch = (unsigned)__builtin_amdgcn_readfirstlane((int)ch);
        if (ch >= (unsigned)NCH) break;
#pragma unroll 1
        for (int q = 0; q < 16; ++q) { const int r = (int)ch * 16 + q, e = r >> 9, rr = r & 511, kb = rr >> 6, nb = rr & 63;
            transpose_item(in[30] + (size_t)e * DFF * DM, DFF, DM, WdnT, kb, nb, e * 2048 + 32 * nb, scr, C.lane); }
    }
}

constexpr int NPHASE = 10;
struct Args { const float* in[33]; float* out; unsigned char* ws; int ph_lo, ph_hi; };
__global__ void __launch_bounds__(512, 2) mk_fwd(Args args) {
    extern __shared__ __attribute__((aligned(16))) unsigned char lds_raw[];
    Ctx C; C.lds = (LAS unsigned char*)lds_raw; C.tid = threadIdx.x; C.lane = C.tid & 63; C.wave = __builtin_amdgcn_readfirstlane(C.tid >> 6);
    C.G = gridDim.x; { const int bx = blockIdx.x; C.vcu = (C.G % 8 == 0) ? (bx % 8) * (C.G / 8) + bx / 8 : bx; }
    unsigned char* ws = args.ws; const float* const* in = args.in;
    volatile LAS unsigned* MISC = (volatile LAS unsigned*)(C.lds + MISC_OFF);
    if (C.tid < 16) MISC[C.tid] = 0u;
    __syncthreads();
    unsigned* barw = (unsigned*)(ws + WS_CTL) + CW_BAR;
    XcdBarrier bar; bar.bar = barw; bar.x = 0; bar.st = nullptr;
    const int lo = args.ph_lo, hi = args.ph_hi;
    if (hi - lo > 1) bar = xcd_barrier_post(barw, MISC);
#ifndef PH_MASK
#define PH_MASK 0x3ff
#endif
#define IN(k) (((PH_MASK >> (k)) & 1) && lo <= (k) && (k) < hi)
#define SEAM(k) do { if (IN(k) && IN((k) + 1)) xcd_barrier(bar); } while (0)
#ifndef WGM_PROJ
#define WGM_PROJ 4
#endif
#ifndef WGM_N2K
#define WGM_N2K 2
#endif
#ifndef GEMM_SP2
#define GEMM_SP2 true
#endif
#ifndef GEMM_ALIGN
#define GEMM_ALIGN true
#endif
#ifndef PROBE_MASK
#define PROBE_MASK 0
#endif
#define REPS(k) (((PROBE_MASK >> (k)) & 1) ? 2 : 1)
#define REPSEAM(k, rep) do { if ((rep) + 1 < REPS(k)) xcd_barrier(bar); } while (0)
    LAS unsigned char* lds = C.lds;
    bf16_t* MG = (bf16_t*)args.out;

    if (IN(0)) { _Pragma("unroll") for (int rep = 0; rep < REPS(0); ++rep) { p0_prologue(C, in, ws); REPSEAM(0, rep); } } SEAM(0);

    if (IN(1)) { _Pragma("unroll") for (int rep = 0; rep < REPS(1); ++rep) {
        pg8::Gemm g{(const bf16_t*)(ws + WS_HBF), (const bf16_t*)(ws + WS_WIN), T, INC, DM, nullptr, nullptr, 0}; pg8::StaticOrder S; S.init(T, INC, C.G, (int)blockIdx.x, WGM_PROJ);
        EpiProj E{(bf16_t*)(ws + WS_U), (bf16_t*)(ws + WS_Q), (bf16_t*)(ws + WS_K), (bf16_t*)(ws + WS_V), (bf16_t*)(ws + WS_SGS), (bf16_t*)(ws + WS_SGA)};
        pg8::gemm_phase<EpiProj, pg8::StaticOrder, GEMM_ALIGN, GEMM_SP2, false>(lds, g, S, E);
        p1_meta_proj(C, ws);
        REPSEAM(1, rep);
    } } SEAM(1);

    if (IN(2)) { _Pragma("unroll") for (int rep = 0; rep < REPS(2); ++rep) { p2_scan(C, in, ws); REPSEAM(2, rep); } } SEAM(2);

    if (IN(3)) { _Pragma("unroll") for (int rep = 0; rep < REPS(3); ++rep) {
        { pg8::Gemm g{(const bf16_t*)(ws + WS_YPRE), (const bf16_t*)(ws + WS_WGLU), T, SSMW, SSMW, nullptr, nullptr, 0}; pg8::StaticOrder S; S.init(T, SSMW, C.G, (int)blockIdx.x);
          EpiGlu E{(const bf16_t*)(ws + WS_YPRE), (bf16_t*)(ws + WS_YSSM)};
          pg8::gemm_phase<EpiGlu, pg8::StaticOrder, GEMM_ALIGN, GEMM_SP2, false>(lds, g, S, E); }
        p3_attention(C, in, ws);
        REPSEAM(3, rep);
    } } SEAM(3);

    if (IN(4)) { _Pragma("unroll") for (int rep = 0; rep < REPS(4); ++rep) {
        { pg8::Gemm g{(const bf16_t*)(ws + WS_YSSM), (const bf16_t*)(ws + WS_WBS), T, DM, SSMW, (const bf16_t*)(ws + WS_YATT), (const bf16_t*)(ws + WS_WBA), AW}; pg8::StaticOrder S; S.init(T, DM, C.G, (int)blockIdx.x, WGM_N2K);
          EpiMergeF E{(const bf16_t*)(ws + WS_SGS), (const bf16_t*)(ws + WS_SGA), MG};
          pg8::gemm_phase<EpiMergeF, pg8::StaticOrder, GEMM_ALIGN, GEMM_SP2, false, true>(lds, g, S, E); }
        REPSEAM(4, rep);
    } } SEAM(4);

    if (IN(5)) { _Pragma("unroll") for (int rep = 0; rep < REPS(5); ++rep) {
        pg8::Gemm g{MG, (const bf16_t*)(ws + WS_WO), T, DM, DM, nullptr, nullptr, 0}; pg8::StaticOrder S; S.init(T, DM, C.G, (int)blockIdx.x, WGM_N2K);
        EpiZ E{(const bf16_t*)(ws + WS_HBF), (bf16_t*)(ws + WS_Z)};
        pg8::gemm_phase<EpiZ, pg8::StaticOrder, GEMM_ALIGN, GEMM_SP2, false>(lds, g, S, E);
        REPSEAM(5, rep);
    } } SEAM(5);

    if (IN(6)) { p6_ln1_router(C, in, ws); } SEAM(6);

    if (IN(7)) { _Pragma("unroll") for (int rep = 0; rep < REPS(7); ++rep) {
        const int NBLK = build_moe_tables(C, ws);
        MoeOrder S{C.G, C.vcu, 2, NBLK, (const LAS int*)(lds + MISC_OFF + 512), (const LAS int*)(lds + MISC_OFF + 64), (const LAS int*)(lds + MISC_OFF + 320), (const int*)(ws + WS_LIST)};
        pg8::Gemm g{(const bf16_t*)(ws + WS_H1), (const bf16_t*)(ws + WS_WUP), T, NE * 1024, DM, nullptr, nullptr, 0};
        EpiSwiglu E{(bf16_t*)(ws + WS_HB), (const int*)(ws + WS_LIST), (const float*)(ws + WS_WGT), (int*)(ws + WS_POSE), (float*)(ws + WS_POSW)};
        pg8::gemm_phase<EpiSwiglu, MoeOrder, GEMM_ALIGN, GEMM_SP2, true>(lds, g, S, E);
        p7_convert_down(C, in, ws);
        REPSEAM(7, rep);
    } } SEAM(7);

    if (IN(8)) { _Pragma("unroll") for (int rep = 0; rep < REPS(8); ++rep) {
        const int NBLK = build_moe_tables(C, ws);
        MoeOrder S{C.G, C.vcu, 3, NBLK, (const LAS int*)(lds + MISC_OFF + 512), (const LAS int*)(lds + MISC_OFF + 64), (const LAS int*)(lds + MISC_OFF + 320), (const int*)(ws + WS_LIST)};
        pg8::Gemm g{(const bf16_t*)(ws + WS_HB), (const bf16_t*)(ws + WS_WDN), NBLK * 256, NE * DM, DFF, nullptr, nullptr, 0};
        EpiDown E{(const int*)(ws + WS_POSE), (const float*)(ws + WS_POSW), (bf16_t*)(ws + WS_YK)};
        pg8::gemm_phase<EpiDown, MoeOrder, GEMM_ALIGN, GEMM_SP2, false>(lds, g, S, E);
        REPSEAM(8, rep);
    } } SEAM(8);

    if (IN(9)) { _Pragma("unroll") for (int rep = 0; rep < REPS(9); ++rep) { p9_ln2(C, in, ws, args.out); REPSEAM(9, rep); } }
#undef IN
#undef SEAM
}

extern "C" void kernel_launch(void* const* d_in, const int* in_sizes, int n_in, void* d_out, int out_size, void* d_ws, size_t ws_size, hipStream_t stream) {
    static int grid = 0;
    if (grid == 0) {
        if (n_in != 33 || in_sizes[0] != T * DM || out_size != T * DM || ws_size < WS_END) { fprintf(stderr, "kernel_launch: unexpected shapes (n_in %d, in0 %d, out %d, ws %zu)\n", n_in, n_in > 0 ? in_sizes[0] : -1, out_size, ws_size); grid = -1; return; }
        int dev = 0, cus = 0, per_cu = 0;
        if (hipGetDevice(&dev) != hipSuccess || hipDeviceGetAttribute(&cus, hipDeviceAttributeMultiprocessorCount, dev) != hipSuccess) { grid = -1; return; }
        if (hipFuncSetAttribute((const void*)mk_fwd, hipFuncAttributeMaxDynamicSharedMemorySize, LDS_BYTES) != hipSuccess) { fprintf(stderr, "kernel_launch: hipFuncSetAttribute failed\n"); grid = -1; return; }
        if (hipOccupancyMaxActiveBlocksPerMultiprocessor(&per_cu, (const void*)mk_fwd, 512, LDS_BYTES) != hipSuccess || per_cu < 1) { fprintf(stderr, "kernel_launch: occupancy query reports %d blocks per CU\n", per_cu); }
        (void)hipGetLastError();
        grid = cus;
    }
    if (grid < 0) return;
    (void)hipMemsetAsync((char*)d_ws + WS_CTL, 0, CTL_ZERO_BYTES, stream);
    Args a{};
    for (int i = 0; i < 33; ++i) a.in[i] = (const float*)d_in[i];
    a.out = (float*)d_out; a.ws = (unsigned char*)d_ws;
#if MK_PER_PHASE
    for (int p = 0; p < NPHASE; ++p) { a.ph_lo = p; a.ph_hi = p + 1; hipLaunchKernelGGL(mk_fwd, dim3(grid), dim3(512), LDS_BYTES, stream, a); }
#else
    a.ph_lo = 0; a.ph_hi = NPHASE; hipLaunchKernelGGL(mk_fwd, dim3(grid), dim3(512), LDS_BYTES, stream, a);
#endif
}
```
